# Optimizing an MI355X kernel written in HIP

```python
import jax, jax.numpy as jnp
from jax import lax
import numpy as np

D_MODEL = 1024
BATCH = 8
SEQ = 4096
DEPTH = 2

CHUNK = 64
Q_BLOCK = 2 * CHUNK
HEAD_DIM = 64
CONV_CH = 256
CONV_W = 3
SB_HEADS = 6
FOX_HEADS = 6
SB_DIM = SB_HEADS * HEAD_DIM
FOX_DIM = FOX_HEADS * HEAD_DIM
D_MIX = CONV_CH + SB_DIM + FOX_DIM
D_IN = 3 * CONV_CH + 3 * SB_DIM + 3 * FOX_DIM + FOX_HEADS
N_MOD = 6
N_EXPERTS = 32
TOP_K = 4
D_EXPERT = D_MODEL
SWIGLU_ALPHA = 1.702
SWIGLU_LIMIT = 7.0
EPS = 1e-6

kernel_name = 'hybrid_conv_stickbreak_fox_moe_adaln'


def _rms(x):
    xf = x.astype(jnp.float32)
    return (xf * lax.rsqrt(jnp.mean(xf * xf, axis=-1, keepdims=True) + EPS)).astype(x.dtype)


def rms_norm(x, g):
    return _rms(x) * g


def short_conv_mixer(gb, gc, u, conv_w):
    v = gc * u
    y = lax.conv_general_dilated(v, conv_w[:, None, :], window_strides=(1,), padding=[(CONV_W - 1, 0)],
                                 dimension_numbers=('NWC', 'WIO', 'NWC'), feature_group_count=CONV_CH)
    return gb * y


def _query_blocks(t):
    b, h, s = t.shape[:3]
    t = t.reshape((b, h, s // Q_BLOCK, Q_BLOCK) + t.shape[3:])
    return jnp.moveaxis(t, 2, 0)


def _merge_blocks(o):
    nb, b, h, qb, d = o.shape
    return o.transpose(1, 0, 3, 2, 4).reshape(b, nb * qb, h * d)


def stick_breaking_attention(q, k, v):
    s = q.shape[2]
    scale = q.shape[-1] ** -0.5
    kpos = jnp.arange(s)

    def block(args):
        qb, start = args
        z = jnp.einsum('bhqd,bhkd->bhqk', qb, k, preferred_element_type=jnp.float32) * scale
        qpos = start + jnp.arange(Q_BLOCK)
        strict = kpos[None, :] < qpos[:, None]
        log_beta = jax.nn.log_sigmoid(z)
        log_1mb = jnp.where(strict, jax.nn.log_sigmoid(-z), 0.0)
        rest = lax.cumsum(log_1mb, axis=3, reverse=True) - log_1mb
        w = jnp.where(strict, jnp.exp(log_beta + rest), 0.0)
        return jnp.einsum('bhqk,bhkd->bhqd', w.astype(v.dtype), v)

    starts = jnp.arange(s // Q_BLOCK, dtype=jnp.int32) * Q_BLOCK
    return _merge_blocks(lax.map(block, (_query_blocks(q), starts)))


def forgetting_attention(q, k, v, log_f):
    s = q.shape[2]
    scale = q.shape[-1] ** -0.5
    kpos = jnp.arange(s)
    cum = lax.cumsum(log_f, axis=2)

    def block(args):
        qb, fq, start = args
        logits = jnp.einsum('bhqd,bhkd->bhqk', qb, k, preferred_element_type=jnp.float32) * scale
        logits = logits + (fq[..., None] - cum[:, :, None, :])
        qpos = start + jnp.arange(Q_BLOCK)
        causal = kpos[None, :] <= qpos[:, None]
        p = jax.nn.softmax(jnp.where(causal, logits, -jnp.inf), axis=-1)
        return jnp.einsum('bhqk,bhkd->bhqd', p.astype(v.dtype), v)

    starts = jnp.arange(s // Q_BLOCK, dtype=jnp.int32) * Q_BLOCK
    return _merge_blocks(lax.map(block, (_query_blocks(q), _query_blocks(cum), starts)))


def moe_ffn(h, router_w, router_b, w_mlp1, b_mlp1, w_mlp2, b_mlp2):
    b, s, d = h.shape
    xt = h.reshape(b * s, d)
    logits = (xt @ router_w + router_b).astype(jnp.float32)
    top_vals, top_idx = lax.top_k(logits, TOP_K)
    top_w = jax.nn.softmax(top_vals, axis=-1)
    combine = jnp.einsum('tk,tke->et', top_w, jax.nn.one_hot(top_idx, N_EXPERTS, dtype=jnp.float32))

    def expert_step(acc, params):
        w1, b1, w2, b2, gate_e = params
        u = xt @ w1 + b1
        glu = jnp.minimum(u[:, ::2], SWIGLU_LIMIT)
        lin = jnp.clip(u[:, 1::2], -SWIGLU_LIMIT, SWIGLU_LIMIT)
        a = glu * jax.nn.sigmoid(SWIGLU_ALPHA * glu) * (lin + 1)
        out = a @ w2 + b2
        return acc + gate_e[:, None] * out.astype(jnp.float32), None

    acc0 = jnp.zeros((b * s, d), jnp.float32)
    acc, _ = lax.scan(expert_step, acc0, (w_mlp1, b_mlp1, w_mlp2, b_mlp2, combine))
    return acc.astype(h.dtype).reshape(b, s, d)


def hybrid_layer(x, c, norm1_g, w_ada, b_ada, w_in, conv_w, sb_q_g, sb_k_g, fox_q_g, fox_k_g, fox_f_b,
                 out_norm_g, w_out, norm2_g, router_w, router_b, w_mlp1, b_mlp1, w_mlp2, b_mlp2):
    b, s, d = x.shape
    mod = (jax.nn.silu(c) @ w_ada + b_ada).reshape(b, N_MOD, 1, d)
    shift1, scale1, gate1, shift2, scale2, gate2 = (mod[:, i] for i in range(N_MOD))

    h = rms_norm(x, norm1_g) * (1 + scale1) + shift1
    proj = h @ w_in
    cuts = [int(v) for v in np.cumsum([CONV_CH] * 3 + [SB_DIM] * 3 + [FOX_DIM] * 3)]
    cb, cc, cu, sq, sk, sv, fq, fk, fv, flog = jnp.split(proj, cuts, axis=-1)

    def heads(t, n):
        return t.reshape(b, s, n, HEAD_DIM).transpose(0, 2, 1, 3)

    y_conv = short_conv_mixer(cb, cc, cu, conv_w)
    y_sb = stick_breaking_attention(rms_norm(heads(sq, SB_HEADS), sb_q_g),
                                    rms_norm(heads(sk, SB_HEADS), sb_k_g), heads(sv, SB_HEADS))
    log_f = jax.nn.log_sigmoid((flog + fox_f_b).astype(jnp.float32)).transpose(0, 2, 1)
    y_fox = forgetting_attention(rms_norm(heads(fq, FOX_HEADS), fox_q_g),
                                 rms_norm(heads(fk, FOX_HEADS), fox_k_g), heads(fv, FOX_HEADS), log_f)
    y = jnp.concatenate([y_conv, y_sb, y_fox], axis=-1)
    y = _rms(y.reshape(b, s, D_MIX // HEAD_DIM, HEAD_DIM)).reshape(b, s, D_MIX) * out_norm_g
    x = x + gate1 * (y @ w_out)

    h2 = rms_norm(x, norm2_g) * (1 + scale2) + shift2
    return x + gate2 * moe_ffn(h2, router_w, router_b, w_mlp1, b_mlp1, w_mlp2, b_mlp2)


def setup_inputs(seed: int = 0) -> dict:
    key = jax.random.key(seed)
    ks = jax.random.split(key, 24)
    nrm = jax.random.normal
    f32 = jnp.float32
    L, D, E = DEPTH, D_MODEL, N_EXPERTS
    return {
        'x': nrm(ks[0], (BATCH, SEQ, D), f32),
        'c': nrm(ks[1], (BATCH, D), f32),
        'norm1_g': 1.0 + 0.05 * nrm(ks[2], (L, D), f32),
        'w_ada': 0.5 * D ** -0.5 * nrm(ks[3], (L, D, N_MOD * D), f32),
        'b_ada': 0.02 * nrm(ks[4], (L, N_MOD * D), f32),
        'w_in': D ** -0.5 * nrm(ks[5], (L, D, D_IN), f32),
        'conv_w': CONV_W ** -0.5 * nrm(ks[6], (L, CONV_W, CONV_CH), f32),
        'sb_q_g': 1.0 + 0.05 * nrm(ks[7], (L, HEAD_DIM), f32),
        'sb_k_g': 1.0 + 0.05 * nrm(ks[8], (L, HEAD_DIM), f32),
        'fox_q_g': 1.0 + 0.05 * nrm(ks[9], (L, HEAD_DIM), f32),
        'fox_k_g': 1.0 + 0.05 * nrm(ks[10], (L, HEAD_DIM), f32),
        'fox_f_b': 2.0 + 0.5 * nrm(ks[11], (L, FOX_HEADS), f32),
        'out_norm_g': 1.0 + 0.05 * nrm(ks[12], (L, D_MIX), f32),
        'w_out': D_MIX ** -0.5 * nrm(ks[13], (L, D_MIX, D), f32),
        'norm2_g': 1.0 + 0.05 * nrm(ks[14], (L, D), f32),
        'router_w': D ** -0.5 * nrm(ks[15], (L, D, E), f32),
        'router_b': 0.01 * nrm(ks[16], (L, E), f32),
        'w_mlp1': D ** -0.5 * nrm(ks[17], (L, E, D, 2 * D_EXPERT), f32),
        'b_mlp1': 0.01 * nrm(ks[18], (L, E, 2 * D_EXPERT), f32),
        'w_mlp2': D_EXPERT ** -0.5 * nrm(ks[19], (L, E, D_EXPERT, D), f32),
        'b_mlp2': 0.01 * nrm(ks[20], (L, E, D), f32),
    }


def reference(x, c, norm1_g, w_ada, b_ada, w_in, conv_w, sb_q_g, sb_k_g, fox_q_g, fox_k_g, fox_f_b,
              out_norm_g, w_out, norm2_g, router_w, router_b, w_mlp1, b_mlp1, w_mlp2, b_mlp2):
    for l in range(DEPTH):
        x = hybrid_layer(x, c, norm1_g[l], w_ada[l], b_ada[l], w_in[l], conv_w[l], sb_q_g[l], sb_k_g[l],
                         fox_q_g[l], fox_k_g[l], fox_f_b[l], out_norm_g[l], w_out[l], norm2_g[l],
                         router_w[l], router_b[l], w_mlp1[l], b_mlp1[l], w_mlp2[l], b_mlp2[l])
    return x
```

```cpp
#include <hip/hip_runtime.h>
#include <cstdio>
#include <cstdint>

#define GAS __attribute__((address_space(1)))
#define LAS __attribute__((address_space(3)))
typedef unsigned short bf16;
typedef unsigned v4u __attribute__((ext_vector_type(4)));
typedef unsigned v2u __attribute__((ext_vector_type(2)));
typedef float f32x4 __attribute__((ext_vector_type(4)));
typedef float f32x2 __attribute__((ext_vector_type(2)));
typedef float f32x16 __attribute__((ext_vector_type(16)));
typedef short bf16x8 __attribute__((ext_vector_type(8)));
typedef _Float16 f16x8 __attribute__((ext_vector_type(8)));
typedef _Float16 f16x2 __attribute__((ext_vector_type(2)));

namespace pg8 {
constexpr int BM = 256, BK = 64, HALF = 128, HTB = HALF * BK * 2  , STAGE_BYTES = 8 * HTB, NXCD = 8, WGM = 8;

__host__ __device__ __forceinline__ int lds_byte(int r, int c) { const int st = (r >> 4) * 2 + (c >> 5), rr = r & 15, cc = c & 31, ob = rr * 64 + cc * 2; return st * 1024 + (ob ^ (((ob >> 9) & 1) << 5)); }
__host__ __device__ __forceinline__ void stage_rc(int b, int& R, int& C) { const int st = b / 1024, sb = b % 1024, swz = sb ^ (((sb >> 9) & 1) << 5); R = (st >> 1) * 16 + swz / 64; C = (st & 1) * 32 + (swz % 64) / 2; }
__host__ __device__ __forceinline__ int perm32(int rho) { const int n = rho >> 4, i = rho & 15; return 8 * (i >> 2) + 4 * n + (i & 3); }

struct Unit { int pm, pn, pb; };
struct Gemm { const bf16* A; const bf16* Bt; const int* rowmap; int K; };

__device__ __forceinline__ unsigned cvt_pk_bf16(float lo, float hi) { unsigned r; asm volatile("v_cvt_pk_bf16_f32 %0, %1, %2" : "=v"(r) : "v"(lo), "v"(hi)); return r; }

template <class Epi, class Sched, bool GATHER>
__device__ __forceinline__ void gemm_phase(LAS unsigned char* lds, const Gemm g, const Sched& S, const Epi& E) {
    int tid_ = threadIdx.x; asm volatile("" : "+v"(tid_));
    const int tid = tid_, wid = __builtin_amdgcn_readfirstlane(tid >> 6), lane = tid & 63, wr = wid >> 2, wc = wid & 3, fr = lane & 15, fq = lane >> 4;
    const int K = g.K, nt = K / BK;
    unsigned voffA[2], voffB[2]; int RA[2], CA[2];
#pragma unroll
    for (int i = 0; i < 2; ++i) { int R, C; stage_rc(tid * 16 + i * 8192, R, C); const int Rb = Epi::PERM ? ((R & ~31) + perm32(R & 31)) : R; RA[i] = R; CA[i] = C;
        voffA[i] = (unsigned)(R * K + C) * 2u; voffB[i] = (unsigned)(Rb * K + C) * 2u; }
    const size_t kstep = (size_t)(BK * 2);
    const size_t hstep = (size_t)HALF * K * 2;
    const size_t tstep = 2 * hstep;
    const unsigned ldsw = (unsigned)wid * 1024u;
    const int aoff = lds_byte(wr * 64 + fr, fq * 8), boff = lds_byte(wc * 32 + fr, fq * 8);
#define PG8_SA(b, h) (((b) * 2 + (h)) * HTB)
#define PG8_SB(b, h) ((4 + (b) * 2 + (h)) * HTB)
#define PG8_STAGE(bufoff, gbase, voff) do { _Pragma("unroll") for (int _i = 0; _i < 2; ++_i) \
        __builtin_amdgcn_global_load_lds((const unsigned*)((const char*)(gbase) + (voff)[_i]), (LAS unsigned*)(lds + (bufoff) + ldsw + _i * 8192), 16, 0, 0); } while (0)
#define PG8_STAGEA(bufoff, pbase, h, nx) do { if constexpr (GATHER) { _Pragma("unroll") for (int _i = 0; _i < 2; ++_i) \
        __builtin_amdgcn_global_load_lds((const unsigned*)((const char*)(pbase) + ((nx) ? gn[h][_i] : gc[h][_i])), (LAS unsigned*)(lds + (bufoff) + ldsw + _i * 8192), 16, 0, 0); } \
        else { PG8_STAGE(bufoff, (const char*)(pbase) + (h) * hstep, voffA); } } while (0)
#define PG8_LDA(dst, b, h) do { _Pragma("unroll") for (int m = 0; m < 4; ++m) _Pragma("unroll") for (int k = 0; k < 2; ++k) dst[m][k] = *(const LAS bf16x8*)(lds + PG8_SA(b, h) + aoff + m * 2048 + k * 1024); } while (0)
#define PG8_LDB(dst, b, h) do { _Pragma("unroll") for (int n = 0; n < 2; ++n) _Pragma("unroll") for (int k = 0; k < 2; ++k) dst[n][k] = *(const LAS bf16x8*)(lds + PG8_SB(b, h) + boff + n * 2048 + k * 1024); } while (0)
#define PG8_MMA(ai, bj, At, Bt) do { __builtin_amdgcn_s_setprio(1); _Pragma("unroll") for (int m = 0; m < 4; ++m) _Pragma("unroll") for (int n = 0; n < 2; ++n) _Pragma("unroll") for (int k = 0; k < 2; ++k) \
        acc[ai][bj][m][n] = __builtin_amdgcn_mfma_f32_16x16x32_bf16(Bt[n][k], At[m][k], acc[ai][bj][m][n], 0, 0, 0); __builtin_amdgcn_s_setprio(0); } while (0)
#define PG8_WAIT_V(n) asm volatile("s_waitcnt vmcnt(" #n ")" ::: "memory")
#define PG8_WAIT_L(n) asm volatile("s_waitcnt lgkmcnt(" #n ")" ::: "memory")
#define PG8_BAR __builtin_amdgcn_s_barrier()
#define PG8_SCHED __builtin_amdgcn_sched_barrier(0)
    Unit cur, nxt; int ui = 0;
    if (!S.next(0, cur)) return;
    f32x4 acc[2][2][4][2];
#pragma unroll
    for (int a = 0; a < 2; ++a)
#pragma unroll
        for (int b = 0; b < 2; ++b)
#pragma unroll
            for (int m = 0; m < 4; ++m)
#pragma unroll
                for (int n = 0; n < 2; ++n) acc[a][b][m][n] = (f32x4){0.f, 0.f, 0.f, 0.f};
    bf16x8 At[4][2], B0[2][2], B1[2][2];
    unsigned gc[2][2], gn[2][2];
    if constexpr (GATHER) {
#pragma unroll
        for (int h = 0; h < 2; ++h)
#pragma unroll
            for (int i = 0; i < 2; ++i) { gc[h][i] = (unsigned)(g.rowmap[cur.pm * BM + h * HALF + RA[i]] * K + CA[i]) * 2u; gn[h][i] = gc[h][i]; }
    } else { gc[0][0] = gc[0][1] = gc[1][0] = gc[1][1] = 0u; gn[0][0] = gn[0][1] = gn[1][0] = gn[1][1] = 0u; }
    const char* cA = GATHER ? (const char*)g.A : (const char*)g.A + (size_t)cur.pm * tstep; const char* cB = (const char*)g.Bt + (size_t)cur.pb * tstep;
    PG8_STAGE(PG8_SB(0, 0), cB, voffB); PG8_STAGE(PG8_SB(0, 1), cB + hstep, voffB); PG8_STAGEA(PG8_SA(0, 0), cA, 0, false); PG8_STAGEA(PG8_SA(0, 1), cA, 1, false);
    if (wr == 1) PG8_BAR;
    PG8_WAIT_V(2); PG8_BAR;
    PG8_STAGE(PG8_SB(1, 0), cB + kstep, voffB); PG8_STAGEA(PG8_SA(1, 0), cA + kstep, 0, false); PG8_STAGE(PG8_SB(1, 1), cB + hstep + kstep, voffB);
    PG8_WAIT_V(6); PG8_BAR;
    for (;;) {
        const bool has_next = S.next(ui + 1, nxt);
        if constexpr (GATHER) { if (has_next) {
#pragma unroll
            for (int h = 0; h < 2; ++h)
#pragma unroll
                for (int i = 0; i < 2; ++i) gn[h][i] = (unsigned)(g.rowmap[nxt.pm * BM + h * HALF + RA[i]] * K + CA[i]) * 2u; } }
        const char* nA = GATHER ? cA : (has_next ? (const char*)g.A + (size_t)nxt.pm * tstep : cA); const char* nB = has_next ? (const char*)g.Bt + (size_t)nxt.pb * tstep : cB;
        for (int t = 0; t < nt; t += 2) {
            const bool last = (t == nt - 2);
            const char* a1 = cA + (size_t)(t + 1) * kstep;
            const char* a2 = last ? nA : cA + (size_t)(t + 2) * kstep; const char* b2 = last ? nB : cB + (size_t)(t + 2) * kstep;
            const char* a3 = a2 + kstep; const char* b3 = b2 + kstep;
            PG8_LDB(B0, 0, 0); PG8_LDB(B1, 0, 1); PG8_SCHED; PG8_LDA(At, 0, 0); PG8_STAGEA(PG8_SA(1, 1), a1, 1, false);
            PG8_WAIT_V(8); PG8_WAIT_L(0); PG8_BAR; PG8_MMA(0, 0, At, B0); PG8_MMA(0, 1, At, B1); PG8_BAR; PG8_SCHED;
            PG8_LDA(At, 0, 1); PG8_STAGE(PG8_SB(0, 0), b2, voffB); PG8_STAGE(PG8_SB(0, 1), b2 + hstep, voffB); PG8_STAGEA(PG8_SA(0, 0), a2, 0, last);
            PG8_WAIT_V(8); PG8_WAIT_L(0); PG8_BAR; PG8_MMA(1, 0, At, B0); PG8_MMA(1, 1, At, B1); PG8_BAR; PG8_SCHED;
            PG8_LDB(B0, 1, 0); PG8_LDB(B1, 1, 1); PG8_SCHED; PG8_LDA(At, 1, 0); PG8_STAGEA(PG8_SA(0, 1), a2, 1, last);
            PG8_WAIT_V(8); PG8_WAIT_L(0); PG8_BAR; PG8_MMA(0, 0, At, B0); PG8_MMA(0, 1, At, B1); PG8_BAR; PG8_SCHED;
            PG8_LDA(At, 1, 1); PG8_STAGE(PG8_SB(1, 0), b3, voffB); PG8_STAGE(PG8_SB(1, 1), b3 + hstep, voffB); PG8_STAGEA(PG8_SA(1, 0), a3, 0, last);
            PG8_WAIT_V(8); PG8_WAIT_L(0); PG8_BAR; PG8_MMA(1, 0, At, B0); PG8_MMA(1, 1, At, B1); PG8_BAR; PG8_SCHED;
        }
        if (wr == 0) PG8_BAR;
        E(acc, cur, wr, wc, fr, fq);
        if (!has_next) break;
#pragma unroll
        for (int a = 0; a < 2; ++a)
#pragma unroll
            for (int b = 0; b < 2; ++b)
#pragma unroll
                for (int m = 0; m < 4; ++m)
#pragma unroll
                    for (int n = 0; n < 2; ++n) acc[a][b][m][n] = (f32x4){0.f, 0.f, 0.f, 0.f};
        cur = nxt; cA = nA; cB = nB; ++ui;
        if constexpr (GATHER) {
#pragma unroll
            for (int h = 0; h < 2; ++h)
#pragma unroll
                for (int i = 0; i < 2; ++i) gc[h][i] = gn[h][i]; }
        if (wr == 1) PG8_BAR;
    }
    PG8_WAIT_V(0);
    PG8_BAR;
#undef PG8_SA
#undef PG8_SB
#undef PG8_STAGE
#undef PG8_STAGEA
#undef PG8_LDA
#undef PG8_LDB
#undef PG8_MMA
#undef PG8_WAIT_V
#undef PG8_WAIT_L
#undef PG8_BAR
#undef PG8_SCHED
}
}
constexpr int DM = 1024, NB = 8, SEQ = 4096, NTOK = NB * SEQ, NLAYER = 2;
constexpr int NPROJ = 3072;
constexpr int D_IN = 3078;
constexpr int NEXP = 32, TOPK = 4;
constexpr int NSLOT_MAX = NTOK * TOPK + NEXP * 256;
constexpr int NTILE_MAX = NSLOT_MAX / 256;
constexpr int COL_CB = 0, COL_CC = 256, COL_CU = 512, COL_SQ = 768, COL_SK = 1152, COL_SV = 1536, COL_FQ = 1920, COL_FK = 2304, COL_FV = 2688;
constexpr float EPS = 1e-6f;
constexpr float LOG2E = 1.4426950408889634f;
constexpr float QSCALE = 0.125f * LOG2E;

namespace pg8 {
struct StaticOrder {
    int nM, nN, nwg, G, c;
    __device__ __forceinline__ void init(int M, int N, int G_, int c_) { nM = M / BM; nN = N / BM; nwg = nM * nN; G = G_; c = c_; }
    __device__ __forceinline__ bool next(int i, Unit& u) const {
        const long L = (long)i * G + c; if (L >= nwg) return false;
        int wgid = (int)L; { const int q = nwg / NXCD, r = nwg % NXCD, xcd = wgid % NXCD, off = wgid / NXCD; wgid = (xcd < r ? xcd * (q + 1) : r * (q + 1) + (xcd - r) * q) + off; }
        const int nig = WGM * nN, gid = wgid / nig, fm = gid * WGM, gsz = (nM - fm) < WGM ? (nM - fm) : WGM;
        u.pm = fm + ((wgid % nig) % gsz); u.pn = (wgid % nig) / gsz; u.pb = u.pn; return true;
    }
};
struct MoeOrder {
    int nM, nN, nwg, G, c; const LAS int* tb;
    __device__ __forceinline__ void init(const LAS int* tb_, int nN_, int G_, int c_) { tb = tb_; nM = tb_[NEXP]; nN = nN_; nwg = nM * nN; G = G_; c = c_; }
    __device__ __forceinline__ bool next(int i, Unit& u) const {
        const long L = (long)i * G + c; if (L >= nwg) return false;
        int wgid = (int)L; { const int q = nwg / NXCD, r = nwg % NXCD, xcd = wgid % NXCD, off = wgid / NXCD; wgid = (xcd < r ? xcd * (q + 1) : r * (q + 1) + (xcd - r) * q) + off; }
        const int nig = WGM * nN, gid = wgid / nig, fm = gid * WGM, gsz = (nM - fm) < WGM ? (nM - fm) : WGM;
        u.pm = fm + ((wgid % nig) % gsz); u.pn = (wgid % nig) / gsz;
        int e = 0;
#pragma unroll 1
        for (int j = 1; j < NEXP; ++j) e += (tb[j] <= u.pm) ? 1 : 0;
        u.pb = e * nN + u.pn; return true;
    }
};

struct EpiProj {
    static constexpr bool PERM = true;
    bf16* O; int ldc;
    __device__ __forceinline__ void operator()(const f32x4 (&acc)[2][2][4][2], const Unit& u, int wr, int wc, int fr, int fq) const {
        const int row0 = u.pm * BM + wr * 64 + fr, col0 = u.pn * BM + wc * 32 + 8 * fq;
#pragma unroll
        for (int ai = 0; ai < 2; ++ai)
#pragma unroll
            for (int m = 0; m < 4; ++m) { bf16* rowp = O + (size_t)(row0 + ai * HALF + m * 16) * ldc + col0;
#pragma unroll
                for (int bj = 0; bj < 2; ++bj) { const f32x4 v0 = acc[ai][bj][m][0], v1 = acc[ai][bj][m][1];
                    v4u w; w.x = cvt_pk_bf16(v0[0], v0[1]); w.y = cvt_pk_bf16(v0[2], v0[3]); w.z = cvt_pk_bf16(v1[0], v1[1]); w.w = cvt_pk_bf16(v1[2], v1[3]);
                    *(v4u*)(rowp + bj * HALF) = w; } }
    }
};
struct EpiResGate {
    static constexpr bool PERM = false;
    const float* base; float* out; const float* gbias; const float* gpart;
    __device__ __forceinline__ void operator()(const f32x4 (&acc)[2][2][4][2], const Unit& u, int wr, int wc, int fr, int fq) const {
        const int row0 = u.pm * BM + wr * 64 + fr, col0 = u.pn * BM + wc * 32 + 4 * fq; const int b = (u.pm * BM) / SEQ;
        f32x4 gv[2][2];
#pragma unroll
        for (int bj = 0; bj < 2; ++bj)
#pragma unroll
            for (int n = 0; n < 2; ++n) { const int c = col0 + bj * HALF + n * 16; f32x4 s = *(const f32x4*)(gbias + c);
#pragma unroll
                for (int ks = 0; ks < 4; ++ks) s += *(const f32x4*)(gpart + (size_t)(ks * NB + b) * 6144 + c);
                gv[bj][n] = s; }
#pragma unroll
        for (int ai = 0; ai < 2; ++ai)
#pragma unroll
            for (int m = 0; m < 4; ++m) { const size_t off = (size_t)(row0 + ai * HALF + m * 16) * DM + col0;
#pragma unroll
                for (int bj = 0; bj < 2; ++bj)
#pragma unroll
                    for (int n = 0; n < 2; ++n) { const f32x4 bs = *(const f32x4*)(base + off + bj * HALF + n * 16);
                        *(f32x4*)(out + off + bj * HALF + n * 16) = bs + gv[bj][n] * acc[ai][bj][m][n]; } }
    }
};
struct EpiSwiglu {
    static constexpr bool PERM = true;
    bf16* O; const float* b1;
    __device__ __forceinline__ void operator()(const f32x4 (&acc)[2][2][4][2], const Unit& u, int wr, int wc, int fr, int fq) const {
        const int row0 = u.pm * BM + wr * 64 + fr; const int e = u.pb >> 3; const int j0 = u.pn * 128 + wc * 32 + 8 * fq;
        const float* bp = b1 + (size_t)e * 2048 + 2 * j0;
        f32x4 bb[4];
#pragma unroll
        for (int q = 0; q < 4; ++q) bb[q] = *(const f32x4*)(bp + 4 * q);
        float bg[8], bl[8];
#pragma unroll
        for (int q = 0; q < 4; ++q) { bg[2 * q] = bb[q][0]; bl[2 * q] = bb[q][1]; bg[2 * q + 1] = bb[q][2]; bl[2 * q + 1] = bb[q][3]; }
#pragma unroll
        for (int ai = 0; ai < 2; ++ai)
#pragma unroll
            for (int m = 0; m < 4; ++m) { bf16* rowp = O + (size_t)(row0 + ai * HALF + m * 16) * DM + j0;
                float a[8];
#pragma unroll
                for (int n = 0; n < 2; ++n)
#pragma unroll
                    for (int i = 0; i < 4; ++i) { float gl = acc[ai][0][m][n][i] + bg[4 * n + i], li = acc[ai][1][m][n][i] + bl[4 * n + i];
                        gl = fminf(gl, 7.0f); li = fminf(fmaxf(li, -7.0f), 7.0f);
                        const float sg = __builtin_amdgcn_rcpf(1.0f + __builtin_amdgcn_exp2f(-1.702f * LOG2E * gl));
                        a[4 * n + i] = gl * sg * (li + 1.0f); }
                v4u w; w.x = cvt_pk_bf16(a[0], a[1]); w.y = cvt_pk_bf16(a[2], a[3]); w.z = cvt_pk_bf16(a[4], a[5]); w.w = cvt_pk_bf16(a[6], a[7]);
                *(v4u*)rowp = w; }
    }
};
struct EpiY {
    static constexpr bool PERM = true;
    bf16* O; const float* b2;
    __device__ __forceinline__ void operator()(const f32x4 (&acc)[2][2][4][2], const Unit& u, int wr, int wc, int fr, int fq) const {
        const int row0 = u.pm * BM + wr * 64 + fr; const int e = u.pb >> 2; const int col0 = u.pn * BM + wc * 32 + 8 * fq;
        f32x4 bv[2][2];
#pragma unroll
        for (int bj = 0; bj < 2; ++bj)
#pragma unroll
            for (int n = 0; n < 2; ++n) bv[bj][n] = *(const f32x4*)(b2 + (size_t)e * DM + col0 + bj * HALF + 4 * n);
#pragma unroll
        for (int ai = 0; ai < 2; ++ai)
#pragma unroll
            for (int m = 0; m < 4; ++m) { bf16* rowp = O + (size_t)(row0 + ai * HALF + m * 16) * DM + col0;
#pragma unroll
                for (int bj = 0; bj < 2; ++bj) { const f32x4 v0 = acc[ai][bj][m][0] + bv[bj][0], v1 = acc[ai][bj][m][1] + bv[bj][1];
                    v4u w; w.x = cvt_pk_bf16(v0[0], v0[1]); w.y = cvt_pk_bf16(v0[2], v0[3]); w.z = cvt_pk_bf16(v1[0], v1[1]); w.w = cvt_pk_bf16(v1[2], v1[3]);
                    *(v4u*)(rowp + bj * HALF) = w; } }
    }
};
}
namespace att {
constexpr int KROW = 144;
constexpr int TILE_B = 64 * KROW;
constexpr int OFF_K = 0, OFF_V = 2 * TILE_B, OFF_F = 4 * TILE_B, LDS_BYTES = OFF_F + 2 * 256;
__device__ __forceinline__ int pim(int m) { const int a = m >> 3, h = (m >> 2) & 1, b = m & 3; return 16 * (a >> 1) + 8 * h + 4 * (a & 1) + b; }
__device__ __forceinline__ unsigned pk_bf16(float lo, float hi) { unsigned r; asm volatile("v_cvt_pk_bf16_f32 %0, %1, %2" : "=v"(r) : "v"(lo), "v"(hi)); return r; }
__device__ __forceinline__ unsigned pk_f16(float lo, float hi) { return __builtin_bit_cast(unsigned, __builtin_amdgcn_cvt_pkrtz(lo, hi)); }

struct Tensors {
    const bf16* proj;
    const bf16* vt;
    const float* fcum;
    bf16* ymix;
    const float* ong;
    int colq, colk, coly;
};

template <int KIND>
__device__ __forceinline__ void unit(const Tensors& T, int b, int h, int qb, LAS unsigned char* lds) {
    int tid_ = threadIdx.x; asm volatile("" : "+v"(tid_));
    const int tid = tid_, lane = tid & 63, r32 = lane & 31, hi = lane >> 5; const int wid = __builtin_amdgcn_readfirstlane(tid >> 6);
    const int q0 = qb * 256, qw0 = q0 + wid * 32, qabs = qw0 + r32;
    const size_t rowbase = (size_t)b * SEQ;
    const int ktd = qw0 >> 6;
    const int kt_hi = (q0 + 255) >> 6;
    const int srow = tid >> 3, spc = tid & 7;
    const bf16* kg = T.proj + (rowbase + srow) * NPROJ + T.colk + h * 64 + spc * 8;
    const bf16* vg = T.vt + ((size_t)(b * 6 + h) * 64 + srow) * SEQ + spc * 8;
    const float* fg = T.fcum + (size_t)(b * 6 + h) * SEQ;
    const int sdst = srow * KROW + spc * 16;
    bf16x8 qf[4];
    { const bf16* qp = T.proj + (rowbase + qabs) * NPROJ + T.colq + h * 64 + hi * 8;
#pragma unroll
      for (int d0 = 0; d0 < 4; ++d0) qf[d0] = *(const bf16x8*)(qp + d0 * 16); }
    const int pm = pim(r32);
    const int koff = pm * KROW + hi * 16;
    f16x8 mtri0, mtri1, mones;
#pragma unroll
    for (int i = 0; i < 8; ++i) { mtri0[i] = (_Float16)((8 * hi + i > pm) ? 1.0f : 0.0f); mtri1[i] = (_Float16)((16 + 8 * hi + i > pm) ? 1.0f : 0.0f); mones[i] = (_Float16)1.0f; }
    f32x16 o0, o1;
#pragma unroll
    for (int r = 0; r < 16; ++r) { o0[r] = 0.f; o1[r] = 0.f; }
    float carry = (KIND == 1) ? -1e30f : 0.f;
    float lsum = 0.f;

    v4u kreg = *(const v4u*)(kg + (size_t)kt_hi * 64 * NPROJ), vreg = *(const v4u*)(vg + kt_hi * 64);
    float freg = 0.f; if (KIND == 1 && tid < 64) freg = fg[kt_hi * 64 + tid];
    *(LAS v4u*)(lds + OFF_K + sdst) = kreg; *(LAS v4u*)(lds + OFF_V + sdst) = vreg; if (KIND == 1 && tid < 64) *(LAS float*)(lds + OFF_F + tid * 4) = freg;
    __syncthreads();
    int buf = 0;
    for (int kt = kt_hi; kt >= 0; --kt) {
        if (kt > 0) { kreg = *(const v4u*)(kg + (size_t)(kt - 1) * 64 * NPROJ); vreg = *(const v4u*)(vg + (kt - 1) * 64); if (KIND == 1 && tid < 64) freg = fg[(kt - 1) * 64 + tid]; }
        if (kt <= ktd) {
            const LAS unsigned char* Kb = lds + OFF_K + buf * TILE_B; const LAS unsigned char* Vb = lds + OFF_V + buf * TILE_B;
            f32x16 p0, p1;
#pragma unroll
            for (int r = 0; r < 16; ++r) { p0[r] = 0.f; p1[r] = 0.f; }
#pragma unroll
            for (int d0 = 0; d0 < 4; ++d0) { const bf16x8 ka = *(const LAS bf16x8*)(Kb + koff + d0 * 32), kb2 = *(const LAS bf16x8*)(Kb + 32 * KROW + koff + d0 * 32);
                p0 = __builtin_amdgcn_mfma_f32_32x32x16_bf16(ka, qf[d0], p0, 0, 0, 0); p1 = __builtin_amdgcn_mfma_f32_32x32x16_bf16(kb2, qf[d0], p1, 0, 0, 0); }
            const bool diag = (kt == ktd);
            const int kbase = kt * 64 + 8 * hi;
            v4u wf0, wf1, wf2, wf3;
            if (KIND == 0) {
                float ls = 0.f; f32x16 l0, l1;
#pragma unroll
                for (int r = 0; r < 16; ++r) {
                    const int key = kbase + 16 * (r >> 3) + (r & 7);
                    float a = -__builtin_amdgcn_logf(1.0f + __builtin_amdgcn_exp2f(p0[r])); if (diag && !(key < qabs)) a = 0.f;
                    float c = -__builtin_amdgcn_logf(1.0f + __builtin_amdgcn_exp2f(p1[r])); if (diag && !(key + 32 < qabs)) c = 0.f;
                    ls += a + c; l0[r] = a; l1[r] = c; p0[r] += a; p1[r] += c; }
                v4u lf0, lf1, lf2, lf3;
#pragma unroll
                for (int j = 0; j < 4; ++j) { lf0[j] = pk_f16(l0[2 * j], l0[2 * j + 1]); lf1[j] = pk_f16(l0[8 + 2 * j], l0[9 + 2 * j]); lf2[j] = pk_f16(l1[2 * j], l1[2 * j + 1]); lf3[j] = pk_f16(l1[8 + 2 * j], l1[9 + 2 * j]); }
                f32x16 r0, r1;
#pragma unroll
                for (int r = 0; r < 16; ++r) { r0[r] = carry; r1[r] = carry; }
                r0 = __builtin_amdgcn_mfma_f32_32x32x16_f16(mtri0, __builtin_bit_cast(f16x8, lf0), r0, 0, 0, 0);
                r0 = __builtin_amdgcn_mfma_f32_32x32x16_f16(mtri1, __builtin_bit_cast(f16x8, lf1), r0, 0, 0, 0);
                r0 = __builtin_amdgcn_mfma_f32_32x32x16_f16(mones, __builtin_bit_cast(f16x8, lf2), r0, 0, 0, 0);
                r0 = __builtin_amdgcn_mfma_f32_32x32x16_f16(mones, __builtin_bit_cast(f16x8, lf3), r0, 0, 0, 0);
                r1 = __builtin_amdgcn_mfma_f32_32x32x16_f16(mtri0, __builtin_bit_cast(f16x8, lf2), r1, 0, 0, 0);
                r1 = __builtin_amdgcn_mfma_f32_32x32x16_f16(mtri1, __builtin_bit_cast(f16x8, lf3), r1, 0, 0, 0);
#pragma unroll
                for (int r = 0; r < 16; ++r) {
                    const int key = kbase + 16 * (r >> 3) + (r & 7);
                    float a = __builtin_amdgcn_exp2f(p0[r] + r0[r]); if (diag && !(key < qabs)) a = 0.f;
                    float c = __builtin_amdgcn_exp2f(p1[r] + r1[r]); if (diag && !(key + 32 < qabs)) c = 0.f;
                    p0[r] = a; p1[r] = c; }
                ls += __shfl_xor(ls, 32);
                carry += ls;
            } else {
                const LAS float* Fb = (const LAS float*)(lds + OFF_F + buf * 256) + 8 * hi;
                float mx = -1e30f;
#pragma unroll
                for (int g = 0; g < 2; ++g) {
                    const f32x4 fa = *(const LAS f32x4*)(Fb + 16 * g), fb = *(const LAS f32x4*)(Fb + 16 * g + 4), fc = *(const LAS f32x4*)(Fb + 32 + 16 * g), fd = *(const LAS f32x4*)(Fb + 32 + 16 * g + 4);
#pragma unroll
                    for (int i = 0; i < 8; ++i) { const int r = 8 * g + i; const int key = kbase + 16 * g + i;
                        float a = p0[r] - (i < 4 ? fa[i & 3] : fb[i & 3]); if (diag && key > qabs) a = -1e30f;
                        float c = p1[r] - (i < 4 ? fc[i & 3] : fd[i & 3]); if (diag && key + 32 > qabs) c = -1e30f;
                        p0[r] = a; p1[r] = c; mx = fmaxf(mx, fmaxf(a, c)); } }
                mx = fmaxf(mx, __shfl_xor(mx, 32));
                const float mnew = fmaxf(carry, mx), alpha = __builtin_amdgcn_exp2f(carry - mnew); carry = mnew;
                float ps = 0.f;
#pragma unroll
                for (int r = 0; r < 16; ++r) { const float a = __builtin_amdgcn_exp2f(p0[r] - mnew), c = __builtin_amdgcn_exp2f(p1[r] - mnew); ps += a + c; p0[r] = a; p1[r] = c; }
                ps += __shfl_xor(ps, 32);
                lsum = lsum * alpha + ps;
#pragma unroll
                for (int r = 0; r < 16; ++r) { o0[r] *= alpha; o1[r] *= alpha; }
            }
#pragma unroll
            for (int j = 0; j < 4; ++j) { wf0[j] = pk_bf16(p0[2 * j], p0[2 * j + 1]); wf1[j] = pk_bf16(p0[8 + 2 * j], p0[9 + 2 * j]); wf2[j] = pk_bf16(p1[2 * j], p1[2 * j + 1]); wf3[j] = pk_bf16(p1[8 + 2 * j], p1[9 + 2 * j]); }
#pragma unroll
            for (int c = 0; c < 4; ++c) {
                const bf16x8 va = *(const LAS bf16x8*)(Vb + koff + c * 32), vb2 = *(const LAS bf16x8*)(Vb + 32 * KROW + koff + c * 32);
                const bf16x8 wb = __builtin_bit_cast(bf16x8, c == 0 ? wf0 : c == 1 ? wf1 : c == 2 ? wf2 : wf3);
                o0 = __builtin_amdgcn_mfma_f32_32x32x16_bf16(va, wb, o0, 0, 0, 0); o1 = __builtin_amdgcn_mfma_f32_32x32x16_bf16(vb2, wb, o1, 0, 0, 0); }
        }
        if (kt > 0) { const int nb = (buf ^ 1) * TILE_B; *(LAS v4u*)(lds + OFF_K + nb + sdst) = kreg; *(LAS v4u*)(lds + OFF_V + nb + sdst) = vreg;
            if (KIND == 1 && tid < 64) *(LAS float*)(lds + OFF_F + (buf ^ 1) * 256 + tid * 4) = freg; }
        __syncthreads();
        buf ^= 1;
    }
    if (KIND == 1) { const float inv = 1.0f / lsum;
#pragma unroll
        for (int r = 0; r < 16; ++r) { o0[r] *= inv; o1[r] *= inv; } }
    float ss = 0.f;
#pragma unroll
    for (int r = 0; r < 16; ++r) ss += o0[r] * o0[r] + o1[r] * o1[r];
    ss += __shfl_xor(ss, 32);
    const float rinv = 1.0f / sqrtf(ss * (1.0f / 64.0f) + EPS);
    const float* gp = T.ong + T.coly + h * 64 + 8 * hi;
    bf16* yp = T.ymix + (rowbase + qabs) * DM + T.coly + h * 64 + 8 * hi;
#pragma unroll
    for (int d0 = 0; d0 < 2; ++d0)
#pragma unroll
        for (int g = 0; g < 2; ++g) { const f32x4 ga = *(const f32x4*)(gp + 32 * d0 + 16 * g), gb = *(const f32x4*)(gp + 32 * d0 + 16 * g + 4);
            float v[8];
#pragma unroll
            for (int i = 0; i < 8; ++i) v[i] = (d0 == 0 ? o0[8 * g + i] : o1[8 * g + i]) * rinv * (i < 4 ? ga[i & 3] : gb[i & 3]);
            v4u w; w.x = pk_bf16(v[0], v[1]); w.y = pk_bf16(v[2], v[3]); w.z = pk_bf16(v[4], v[5]); w.w = pk_bf16(v[6], v[7]);
            *(v4u*)(yp + 32 * d0 + 16 * g) = w; }
}
}
constexpr size_t MiB = 1u << 20;
constexpr size_t WS_CTL = 0, CTL_ZERO_BYTES = 1 * MiB;
constexpr size_t WS_MODP = 1 * MiB;
constexpr size_t WS_TOPW = 3 * MiB;
constexpr size_t WS_ROUTE = WS_TOPW + 512 * 1024;
constexpr size_t WS_TOKSLOT = WS_ROUTE + 512 * 1024;
constexpr size_t WS_SLOTTOK = WS_TOKSLOT + 512 * 1024;
constexpr size_t WS_HIST = WS_SLOTTOK + 576 * 1024;
constexpr size_t WS_MOETAB = WS_HIST + 32 * 1024;
constexpr size_t WS_LOGF = 6 * MiB;
constexpr size_t WS_FCUM = 7 * MiB;
constexpr size_t WS_WIN = 8 * MiB, WS_WOUT = 20 * MiB, WS_W1 = 24 * MiB, WS_W2 = 280 * MiB;
constexpr size_t WS_H = 408 * MiB;
constexpr size_t WS_PROJ = 472 * MiB;
constexpr size_t WS_VT = 664 * MiB;
constexpr size_t WS_YMIX = 712 * MiB;
constexpr size_t WS_XA = 776 * MiB, WS_XB = 904 * MiB;
constexpr size_t WS_ACT = 1032 * MiB, WS_Y = 1304 * MiB, WS_END = 1576 * MiB;
static_assert(WS_MOETAB + 256 <= WS_LOGF && (size_t)NSLOT_MAX * 4 <= 576 * 1024 && (size_t)NSLOT_MAX * DM * 2 <= 272 * MiB, "ws map");
constexpr int CW_BAR = 4096;

constexpr int RING_BYTES = 131072;
constexpr int MISC_OFF = RING_BYTES;
constexpr int LDS_BYTES = 147456;

#define RLX_AGENT __ATOMIC_RELAXED, __HIP_MEMORY_SCOPE_AGENT
__device__ __forceinline__ unsigned f2bf(float f) { unsigned u = __builtin_bit_cast(unsigned, f); return (u + 0x7fffu + ((u >> 16) & 1u)) >> 16; }
__device__ __forceinline__ unsigned pk2(float lo, float hi) { return f2bf(lo) | (f2bf(hi) << 16); }
__device__ __forceinline__ float bflo(unsigned u) { return __builtin_bit_cast(float, u << 16); }
__device__ __forceinline__ float bfhi(unsigned u) { return __builtin_bit_cast(float, u & 0xffff0000u); }
__device__ __forceinline__ float wave_sum(float v) {
#pragma unroll
    for (int o = 1; o < 64; o <<= 1) v += __shfl_xor(v, o);
    return v;
}

#define XB_TMO      128
#define XB_XCNT(j)  (256  + 64 * (j))
#define XB_XSUB(j)  (1280 + 64 * (j))
#define XB_XGEN(j)  (2304 + 64 * (j))
#define XB_TOP      3328
#define XB_TOPGEN   3392
#define XCD_BAR_WORDS 3456
#define XB_SPIN_CAP (1u << 18)
__device__ __forceinline__ unsigned xb_ld(unsigned* p)              { return __hip_atomic_load(p, __ATOMIC_RELAXED, __HIP_MEMORY_SCOPE_AGENT); }
__device__ __forceinline__ unsigned xb_add(unsigned* p, unsigned v) { return __hip_atomic_fetch_add(p, v, __ATOMIC_RELAXED, __HIP_MEMORY_SCOPE_AGENT); }
__device__ __forceinline__ unsigned xb_xcc_id() { return (unsigned)__builtin_amdgcn_s_getreg((3 << 11) | 20) & 0xFu; }
#define XB_SPIN(cond, bar) do { unsigned _sp = 0; while (cond) { __builtin_amdgcn_s_sleep(1); \
    if ((++_sp & 255u) == 0u) { if (xb_ld(&(bar)[XB_TMO])) break; if (_sp > XB_SPIN_CAP) { atomicAdd(&(bar)[XB_TMO], 1u); break; } } } } while (0)
struct XcdBarrier { unsigned* bar; unsigned x; volatile LAS unsigned* st; };
__device__ __forceinline__ XcdBarrier xcd_barrier_post(unsigned* bar, volatile LAS unsigned* st) {
    XcdBarrier b; b.bar = bar; b.x = xb_xcc_id(); b.st = st;
    if (threadIdx.x == 0) (void)xb_add(&bar[XB_XCNT(b.x)], 1u);
    return b;
}
__device__ __forceinline__ void xcd_barrier_complete(unsigned* bar, unsigned x, unsigned& nloc, unsigned& nx) {
    const unsigned G = gridDim.x * gridDim.y * gridDim.z;
    unsigned sum, cnt, mine, sp = 0u;
    for (;;) {
        sum = 0u; cnt = 0u; mine = 0u;
#pragma unroll
        for (unsigned j = 0; j < 16; ++j) { const unsigned c = xb_ld(&bar[XB_XCNT(j)]); sum += c; cnt += (c > 0u) ? 1u : 0u; mine = (j == x) ? c : mine; }
        if (sum == G) break;
        __builtin_amdgcn_s_sleep(1);
        if ((++sp & 255u) == 0u) { if (xb_ld(&bar[XB_TMO])) break; if (sp > XB_SPIN_CAP) { atomicAdd(&bar[XB_TMO], 1u); break; } }
    }
    nloc = mine > 0u ? mine : 1u; nx = cnt > 0u ? cnt : 1u;
}
__device__ __forceinline__ void xcd_barrier(const XcdBarrier& b) {
    asm volatile("s_waitcnt vmcnt(0)" ::: "memory");
    __syncthreads();
    if (threadIdx.x == 0) {
        unsigned* bar = b.bar;
        __builtin_amdgcn_s_waitcnt(0);
        unsigned nloc = b.st[0], nx = b.st[1];
        if (nloc == 0u) { xcd_barrier_complete(bar, b.x, nloc, nx); b.st[0] = nloc; b.st[1] = nx; }
        const unsigned old = xb_add(&bar[XB_XSUB(b.x)], 1u);
        const unsigned gen = old / nloc;
        if (old + 1u == (gen + 1u) * nloc) {
            __builtin_amdgcn_fence(__ATOMIC_RELEASE, "agent");
            asm volatile("s_waitcnt vmcnt(0)" ::: "memory");
            const unsigned og = xb_add(&bar[XB_TOP], 1u);
            const unsigned tg = og / nx;
            if (og + 1u == (tg + 1u) * nx) xb_add(&bar[XB_TOPGEN], 1u);
            else XB_SPIN(xb_ld(&bar[XB_TOPGEN]) == tg, bar);
            __builtin_amdgcn_fence(__ATOMIC_ACQUIRE, "agent");
            xb_add(&bar[XB_XGEN(b.x)], 1u);
            asm volatile("s_waitcnt vmcnt(0)" ::: "memory");
        } else {
            XB_SPIN(xb_ld(&bar[XB_XGEN(b.x)]) == gen, bar);
            __builtin_amdgcn_fence(__ATOMIC_ACQUIRE, "agent");
            asm volatile("s_waitcnt vmcnt(0)" ::: "memory");
        }
    }
    __syncthreads();
}

struct Frame {
    LAS unsigned char* lds;
    int tid, lane, wave, blk, G;
    const float* in[21];
    float* out; unsigned char* ws;
};
enum { I_X = 0, I_C, I_N1G, I_WADA, I_BADA, I_WIN, I_CONVW, I_SBQG, I_SBKG, I_FXQG, I_FXKG, I_FXFB, I_ONG, I_WOUT, I_N2G, I_RW, I_RB, I_W1, I_B1, I_W2, I_B2 };

template <int MAP>
__device__ __forceinline__ void p0_transpose_item(const float* W, int ldw, bf16* WT, LAS float* scr, int k0, int n0, int lane) {
#pragma unroll 8
    for (int i = 0; i < 32; ++i) { const int kk = 2 * i + (lane >> 5); scr[kk * 33 + (lane & 31)] = W[(size_t)(k0 + kk) * ldw + n0 + (lane & 31)]; }
    asm volatile("s_waitcnt lgkmcnt(0)" ::: "memory");
    const int c = lane & 7;
#pragma unroll
    for (int j = 0; j < 4; ++j) { const int n = (lane >> 3) + 8 * j; const LAS float* s = scr + (8 * c) * 33 + n;
        v4u o; o.x = pk2(s[0 * 33], s[1 * 33]); o.y = pk2(s[2 * 33], s[3 * 33]); o.z = pk2(s[4 * 33], s[5 * 33]); o.w = pk2(s[6 * 33], s[7 * 33]);
        const int cn = n0 + n; int row = cn;
        if (MAP == 1) { const int jj = cn >> 1, t = cn & 1; row = 256 * (jj >> 7) + 128 * t + (jj & 127); }
        *(v4u*)(WT + (size_t)row * 1024 + k0 + 8 * c) = o; }
    asm volatile("s_waitcnt lgkmcnt(0)" ::: "memory");
}
__device__ __forceinline__ void p0_prologue(Frame& F) {
    LAS float* scr = (LAS float*)(F.lds + F.wave * 16384);
    const int gw = F.blk * 8 + F.wave, NGW = F.G * 8;
    for (int it = gw; it < NLAYER * 4 * 24; it += NGW) {
        const int l = it / 96, ks = (it / 24) & 3, nc = it % 24;
        const float* W = F.in[I_WADA] + (size_t)l * DM * 6144 + nc * 256 + F.lane * 4;
        const float* c = F.in[I_C];
        f32x4 acc[NB];
#pragma unroll
        for (int b = 0; b < NB; ++b) acc[b] = (f32x4){0.f, 0.f, 0.f, 0.f};
#pragma unroll 4
        for (int k = ks * 256; k < ks * 256 + 256; ++k) {
            const f32x4 w = *(const f32x4*)(W + (size_t)k * 6144);
#pragma unroll
            for (int b = 0; b < NB; ++b) { const float cv = c[b * DM + k]; const float s = cv / (1.0f + __expf(-cv)); acc[b] += w * s; }
        }
        float* dst = (float*)(F.ws + WS_MODP) + ((size_t)(l * 4 + ks) * NB) * 6144 + nc * 256 + F.lane * 4;
#pragma unroll
        for (int b = 0; b < NB; ++b) *(f32x4*)(dst + (size_t)b * 6144) = acc[b];
    }
    constexpr int I_IN = 16 * 96, I_OUT = 16 * 32, I_1 = 16 * 64, I_2 = 16 * 32;
    constexpr int N_IN = NLAYER * I_IN, N_OUT = NLAYER * I_OUT, N_1 = NLAYER * NEXP * I_1, N_2 = NLAYER * NEXP * I_2;
    for (int it = gw; it < N_IN + N_OUT + N_1 + N_2; it += NGW) {
        int r = it;
        if (r < N_IN) { const int l = r / I_IN, q = r % I_IN, kb = q / 96, nb = q % 96;
            p0_transpose_item<0>(F.in[I_WIN] + (size_t)l * DM * D_IN, D_IN, (bf16*)(F.ws + WS_WIN) + (size_t)l * NPROJ * DM, scr, 64 * kb, 32 * nb, F.lane); continue; }
        r -= N_IN;
        if (r < N_OUT) { const int l = r / I_OUT, q = r % I_OUT, kb = q / 32, nb = q % 32;
            p0_transpose_item<0>(F.in[I_WOUT] + (size_t)l * DM * DM, DM, (bf16*)(F.ws + WS_WOUT) + (size_t)l * DM * DM, scr, 64 * kb, 32 * nb, F.lane); continue; }
        r -= N_OUT;
        if (r < N_1) { const int le = r / I_1, q = r % I_1, kb = q / 64, nb = q % 64;
            p0_transpose_item<1>(F.in[I_W1] + (size_t)le * DM * 2048, 2048, (bf16*)(F.ws + WS_W1) + (size_t)le * 2048 * DM, scr, 64 * kb, 32 * nb, F.lane); continue; }
        r -= N_1;
        { const int le = r / I_2, q = r % I_2, kb = q / 32, nb = q % 32;
            p0_transpose_item<0>(F.in[I_W2] + (size_t)le * DM * DM, DM, (bf16*)(F.ws + WS_W2) + (size_t)le * DM * DM, scr, 64 * kb, 32 * nb, F.lane); }
    }
}

__device__ __forceinline__ f32x4 mod4(const Frame& F, int l, int b, int which, int c) {
    const int n = which * DM + c;
    f32x4 s = *(const f32x4*)(F.in[I_BADA] + (size_t)l * 6144 + n);
    const float* p = (const float*)(F.ws + WS_MODP) + ((size_t)(l * 4) * NB + b) * 6144 + n;
#pragma unroll
    for (int ks = 0; ks < 4; ++ks) s += *(const f32x4*)(p + (size_t)ks * NB * 6144);
    return s;
}

template <bool COMBINE, bool NORM>
__device__ __forceinline__ void row_phase(Frame& F, int l, const float* xsrc, float* xdst) {
    const float* topw = (const float*)(F.ws + WS_TOPW); const int* tokslot = (const int*)(F.ws + WS_TOKSLOT); const bf16* Y = (const bf16*)(F.ws + WS_Y);
    bf16* H = (bf16*)(F.ws + WS_H); float* logf = (float*)(F.ws + WS_LOGF);
    LAS float* wl = (LAS float*)F.lds;
    if (NORM) { for (int i = F.tid; i < DM * 6; i += 512) { const int k = i / 6, q = i % 6; wl[k * 8 + q] = F.in[I_WIN][(size_t)l * DM * D_IN + (size_t)k * D_IN + NPROJ + q]; }
        __syncthreads(); }
    for (int chunk = F.blk; chunk < NTOK / 128; chunk += F.G) {
        const int b = chunk / (SEQ / 128);
        f32x4 g2[4], A[4], Bv[4];
#pragma unroll
        for (int j = 0; j < 4; ++j) { const int c = 256 * j + 4 * F.lane;
            if (COMBINE) g2[j] = mod4(F, l - 1, b, 5, c);
            if (NORM) { const f32x4 g = *(const f32x4*)(F.in[I_N1G] + (size_t)l * DM + c); A[j] = g * (mod4(F, l, b, 1, c) + 1.0f); Bv[j] = mod4(F, l, b, 0, c); } }
#pragma unroll 1
        for (int rr = 0; rr < 16; ++rr) {
            const int row = chunk * 128 + F.wave + 8 * rr;
            f32x4 v[4];
#pragma unroll
            for (int j = 0; j < 4; ++j) v[j] = *(const f32x4*)(xsrc + (size_t)row * DM + 256 * j + 4 * F.lane);
            if (COMBINE) {
                f32x4 s[4];
#pragma unroll
                for (int j = 0; j < 4; ++j) s[j] = (f32x4){0.f, 0.f, 0.f, 0.f};
#pragma unroll
                for (int k = 0; k < TOPK; ++k) { const float w = topw[row * 4 + k]; const int slot = tokslot[row * 4 + k];
#pragma unroll
                    for (int j = 0; j < 4; ++j) { const v2u yv = *(const v2u*)(Y + (size_t)slot * DM + 256 * j + 4 * F.lane);
                        s[j] += (f32x4){bflo(yv.x), bfhi(yv.x), bflo(yv.y), bfhi(yv.y)} * w; } }
#pragma unroll
                for (int j = 0; j < 4; ++j) { v[j] += g2[j] * s[j]; *(f32x4*)(xdst + (size_t)row * DM + 256 * j + 4 * F.lane) = v[j]; }
            }
            if (NORM) {
                float ss = 0.f;
#pragma unroll
                for (int j = 0; j < 4; ++j) ss += (v[j].x * v[j].x + v[j].y * v[j].y) + (v[j].z * v[j].z + v[j].w * v[j].w);
                const float rstd = 1.0f / sqrtf(wave_sum(ss) * (1.0f / DM) + EPS);
                float fl[6] = {0.f, 0.f, 0.f, 0.f, 0.f, 0.f};
                int woff = 4 * F.lane; asm volatile("" : "+v"(woff));
#pragma unroll
                for (int j = 0; j < 4; ++j) { const f32x4 hv = v[j] * rstd * A[j] + Bv[j];
                    v2u o; o.x = pk2(hv.x, hv.y); o.y = pk2(hv.z, hv.w); *(v2u*)(H + (size_t)row * DM + 256 * j + 4 * F.lane) = o;
#pragma unroll
                    for (int i = 0; i < 4; ++i) { const LAS float* wp = wl + (256 * j + woff + i) * 8; const f32x4 wa = *(const LAS f32x4*)wp; const f32x2 wb = *(const LAS f32x2*)(wp + 4); const float hx = hv[i];
                        fl[0] += hx * wa.x; fl[1] += hx * wa.y; fl[2] += hx * wa.z; fl[3] += hx * wa.w; fl[4] += hx * wb.x; fl[5] += hx * wb.y; } }
#pragma unroll
                for (int q = 0; q < 6; ++q) fl[q] = wave_sum(fl[q]);
                if (F.lane < 6) { float z = fl[0];
#pragma unroll
                    for (int q = 1; q < 6; ++q) z = (F.lane == q) ? fl[q] : z;
                    z += F.in[I_FXFB][l * 6 + F.lane];
                    logf[(size_t)row * 6 + F.lane] = fminf(z, 0.f) - __logf(1.0f + __expf(-fabsf(z))); }
            }
        }
    }
    __syncthreads();
}
__device__ __forceinline__ void p3_postproj(Frame& F, int l) {
    bf16* proj = (bf16*)(F.ws + WS_PROJ); bf16* ymix = (bf16*)(F.ws + WS_YMIX);
    const float* ong = F.in[I_ONG] + (size_t)l * DM;
    const int c4 = 4 * F.lane;
    f32x4 cw[3];
#pragma unroll
    for (int w = 0; w < 3; ++w) cw[w] = *(const f32x4*)(F.in[I_CONVW] + (size_t)(l * 3 + w) * 256 + c4);
    const f32x4 cg = *(const f32x4*)(ong + c4);
    const int e0 = 8 * (F.lane & 7);
    float gq[3][8]; int colv[3];
#pragma unroll
    for (int i = 0; i < 3; ++i) { const int vi = 8 * i + (F.lane >> 3); const int ty = vi / 6;
        colv[i] = (vi < 12 ? COL_SQ + 64 * vi : COL_FQ + 64 * (vi - 12)) + e0;
        const float* gp = (ty == 0 ? F.in[I_SBQG] : ty == 1 ? F.in[I_SBKG] : ty == 2 ? F.in[I_FXQG] : F.in[I_FXKG]) + (size_t)l * 64 + e0; const float sc = (ty == 0 || ty == 2) ? QSCALE : 1.0f;
#pragma unroll
        for (int q = 0; q < 8; ++q) gq[i][q] = gp[q] * sc; }
    LAS unsigned char* scr = F.lds + F.wave * (64 * 144);
    for (int tile = F.blk; tile < NTOK / 64; tile += F.G) {
        const int b = tile / (SEQ / 64), s0 = (tile % (SEQ / 64)) * 64; const size_t row0 = (size_t)b * SEQ + s0;
        for (int tt = 0; tt < 8; ++tt) {
            const int s = s0 + F.wave * 8 + tt; const size_t row = (size_t)b * SEQ + s; bf16* pr = proj + row * NPROJ;
            f32x4 vv[3];
#pragma unroll
            for (int w = 0; w < 3; ++w) { const int sw = s - 2 + w;
                if (sw >= 0) { const bf16* pw = proj + ((size_t)b * SEQ + sw) * NPROJ; const v2u cc = *(const v2u*)(pw + COL_CC + c4), cu = *(const v2u*)(pw + COL_CU + c4);
                    vv[w] = (f32x4){bflo(cc.x) * bflo(cu.x), bfhi(cc.x) * bfhi(cu.x), bflo(cc.y) * bflo(cu.y), bfhi(cc.y) * bfhi(cu.y)}; }
                else vv[w] = (f32x4){0.f, 0.f, 0.f, 0.f}; }
            const v2u cb = *(const v2u*)(pr + COL_CB + c4);
            f32x4 y = cw[0] * vv[0] + cw[1] * vv[1] + cw[2] * vv[2];
            y = y * (f32x4){bflo(cb.x), bfhi(cb.x), bflo(cb.y), bfhi(cb.y)};
            float ss = (y.x * y.x + y.y * y.y) + (y.z * y.z + y.w * y.w);
            ss += __shfl_xor(ss, 1); ss += __shfl_xor(ss, 2); ss += __shfl_xor(ss, 4); ss += __shfl_xor(ss, 8);
            const float rinv = 1.0f / sqrtf(ss * (1.0f / 64.0f) + EPS);
            y = y * rinv * cg;
            v2u o; o.x = pk2(y.x, y.y); o.y = pk2(y.z, y.w); *(v2u*)(ymix + row * DM + c4) = o;
#pragma unroll
            for (int i = 0; i < 3; ++i) { const v4u x = *(const v4u*)(pr + colv[i]);
                float f[8] = {bflo(x.x), bfhi(x.x), bflo(x.y), bfhi(x.y), bflo(x.z), bfhi(x.z), bflo(x.w), bfhi(x.w)};
                float q2 = 0.f;
#pragma unroll
                for (int q = 0; q < 8; ++q) q2 += f[q] * f[q];
                q2 += __shfl_xor(q2, 1); q2 += __shfl_xor(q2, 2); q2 += __shfl_xor(q2, 4);
                const float ri = 1.0f / sqrtf(q2 * (1.0f / 64.0f) + EPS);
                v4u w; w.x = pk2(f[0] * ri * gq[i][0], f[1] * ri * gq[i][1]); w.y = pk2(f[2] * ri * gq[i][2], f[3] * ri * gq[i][3]);
                w.z = pk2(f[4] * ri * gq[i][4], f[5] * ri * gq[i][5]); w.w = pk2(f[6] * ri * gq[i][6], f[7] * ri * gq[i][7]);
                *(v4u*)(pr + colv[i]) = w; }
        }
        for (int t = F.wave; t < 12; t += 8) {
            const int kind = t / 6, h = t % 6; const int col = (kind ? COL_FV : COL_SV) + 64 * h;
            const bf16* src = proj + (row0 + F.lane) * NPROJ + col;
#pragma unroll
            for (int pc = 0; pc < 8; ++pc) { const v4u x = *(const v4u*)(src + 8 * pc);
                const unsigned xs[4] = {x.x, x.y, x.z, x.w};
#pragma unroll
                for (int q = 0; q < 4; ++q) { *(LAS unsigned short*)(scr + (8 * pc + 2 * q) * 144 + 2 * F.lane) = (unsigned short)(xs[q] & 0xffffu);
                                              *(LAS unsigned short*)(scr + (8 * pc + 2 * q + 1) * 144 + 2 * F.lane) = (unsigned short)(xs[q] >> 16); } }
            asm volatile("s_waitcnt lgkmcnt(0)" ::: "memory");
            bf16* dst = (bf16*)(F.ws + WS_VT) + (size_t)kind * (48 * 64 * SEQ) + ((size_t)(b * 6 + h) * 64 + F.lane) * SEQ + s0;
#pragma unroll
            for (int pc = 0; pc < 8; ++pc) *(v4u*)(dst + 8 * pc) = *(const LAS v4u*)(scr + F.lane * 144 + 16 * pc);
            asm volatile("s_waitcnt lgkmcnt(0)" ::: "memory");
        }
    }
    for (int sq = F.blk * 8 + F.wave; sq < NB * 6; sq += F.G * 8) {
        const int b = sq / 6, h = sq % 6; const float* lf = (const float*)(F.ws + WS_LOGF) + ((size_t)b * SEQ + 64 * F.lane) * 6 + h;
        float tot = 0.f;
        for (int i = 0; i < 64; ++i) tot += lf[(size_t)i * 6];
        float inc = tot;
#pragma unroll
        for (int o = 1; o < 64; o <<= 1) { const float t = __shfl_up(inc, o); if (F.lane >= o) inc += t; }
        float run = inc - tot; float* fo = (float*)(F.ws + WS_FCUM) + (size_t)sq * SEQ + 64 * F.lane;
        for (int i = 0; i < 64; ++i) { run += lf[(size_t)i * 6]; fo[i] = run * LOG2E; }
    }
}

__device__ __forceinline__ void p4_attention(Frame& F, int l) {
    att::Tensors Ts, Tf;
    Ts.proj = (const bf16*)(F.ws + WS_PROJ); Ts.vt = (const bf16*)(F.ws + WS_VT); Ts.fcum = (const float*)(F.ws + WS_FCUM); Ts.ymix = (bf16*)(F.ws + WS_YMIX); Ts.ong = F.in[I_ONG] + (size_t)l * DM;
    Ts.colq = COL_SQ; Ts.colk = COL_SK; Ts.coly = 256;
    Tf = Ts; Tf.vt = Ts.vt + (size_t)48 * 64 * SEQ; Tf.colq = COL_FQ; Tf.colk = COL_FK; Tf.coly = 640;
    const int NU = 2 * 48 * 16;
    for (int i = 0;; ++i) {
        const int L = (i & 1) ? (i + 1) * F.G - 1 - F.blk : i * F.G + F.blk;
        if (i * F.G >= NU) break;
        if (L >= NU) continue;
        const int qb = 15 - L / 96, j = L % 96, kind = j / 48, bh = j % 48;
        if (kind == 0) att::unit<0>(Ts, bh / 6, bh % 6, qb, F.lds); else att::unit<1>(Tf, bh / 6, bh % 6, qb, F.lds);
    }
}

__device__ __forceinline__ void p6_norm_router(Frame& F, int l, const float* x1) {
    bf16* H = (bf16*)(F.ws + WS_H); float* topw = (float*)(F.ws + WS_TOPW); int* route = (int*)(F.ws + WS_ROUTE); int* hist = (int*)(F.ws + WS_HIST);
    const float* rw = F.in[I_RW] + (size_t)l * DM * NEXP; const float* rb = F.in[I_RB] + (size_t)l * NEXP;
    LAS float* hs = (LAS float*)(F.lds + F.wave * 16384);
    LAS int* cnt = (LAS int*)(F.lds + MISC_OFF + 256);
    const int e = F.lane & 31, half = F.lane >> 5;
    for (int chunk = F.blk; chunk < NTOK / 128; chunk += F.G) {
        const int b = chunk / (SEQ / 128);
        if (F.tid < 32) cnt[F.tid] = 0;
        __syncthreads();
        f32x4 A[4], Bv[4];
#pragma unroll
        for (int j = 0; j < 4; ++j) { const int c = 256 * j + 4 * F.lane; const f32x4 g = *(const f32x4*)(F.in[I_N2G] + (size_t)l * DM + c); A[j] = g * (mod4(F, l, b, 4, c) + 1.0f); Bv[j] = mod4(F, l, b, 3, c); }
        const float rbias = rb[e];
        for (int rg = 0; rg < 4; ++rg) {
            const int rbase = chunk * 128 + F.wave * 16 + 4 * rg;
#pragma unroll
            for (int r = 0; r < 4; ++r) { const int row = rbase + r;
                f32x4 v[4]; float ss = 0.f;
#pragma unroll
                for (int j = 0; j < 4; ++j) { v[j] = *(const f32x4*)(x1 + (size_t)row * DM + 256 * j + 4 * F.lane); ss += (v[j].x * v[j].x + v[j].y * v[j].y) + (v[j].z * v[j].z + v[j].w * v[j].w); }
                const float rstd = 1.0f / sqrtf(wave_sum(ss) * (1.0f / DM) + EPS);
#pragma unroll
                for (int j = 0; j < 4; ++j) { const f32x4 hv = v[j] * rstd * A[j] + Bv[j];
                    v2u o; o.x = pk2(hv.x, hv.y); o.y = pk2(hv.z, hv.w); *(v2u*)(H + (size_t)row * DM + 256 * j + 4 * F.lane) = o;
                    const int k = 256 * j + 4 * F.lane;
                    hs[(k + 0) * 4 + r] = hv.x; hs[(k + 1) * 4 + r] = hv.y; hs[(k + 2) * 4 + r] = hv.z; hs[(k + 3) * 4 + r] = hv.w; } }
            asm volatile("s_waitcnt lgkmcnt(0)" ::: "memory");
            f32x4 acc = (f32x4){0.f, 0.f, 0.f, 0.f};
            const float* rwp = rw + (size_t)(512 * half) * NEXP + e; const LAS f32x4* hp = (const LAS f32x4*)hs + 512 * half;
#pragma unroll 8
            for (int k = 0; k < 512; ++k) acc += hp[k] * rwp[(size_t)k * NEXP];
            asm volatile("s_waitcnt lgkmcnt(0)" ::: "memory");
#pragma unroll
            for (int r = 0; r < 4; ++r) { acc[r] += __shfl_xor(acc[r], 32); acc[r] += rbias; }
#pragma unroll
            for (int r = 0; r < 4; ++r) {
                float val = acc[r]; float tv[4]; int ti[4];
#pragma unroll
                for (int k = 0; k < TOPK; ++k) {
                    float bv = val; int bi = e;
#pragma unroll
                    for (int o = 1; o < 32; o <<= 1) { const float ov = __shfl_xor(bv, o); const int oi = __shfl_xor(bi, o); if (ov > bv || (ov == bv && oi < bi)) { bv = ov; bi = oi; } }
                    tv[k] = bv; ti[k] = bi; if (e == bi) val = -INFINITY;
                }
                const float e1 = __expf(tv[1] - tv[0]), e2 = __expf(tv[2] - tv[0]), e3 = __expf(tv[3] - tv[0]); const float inv = 1.0f / (1.0f + e1 + e2 + e3);
                if (F.lane < 4) { const int row = rbase + r; const int k = F.lane;
                    const float w = (k == 0 ? 1.0f : k == 1 ? e1 : k == 2 ? e2 : e3) * inv; const int ex = (k == 0 ? ti[0] : k == 1 ? ti[1] : k == 2 ? ti[2] : ti[3]);
                    const int pos = __hip_atomic_fetch_add(cnt + ex, 1, __ATOMIC_RELAXED, __HIP_MEMORY_SCOPE_WORKGROUP);
                    topw[row * 4 + k] = w; route[row * 4 + k] = ex + 32 * pos; }
            }
        }
        __syncthreads();
        if (F.tid < 32) hist[chunk * 32 + F.tid] = cnt[F.tid];
        __syncthreads();
    }
}

__device__ __forceinline__ void p7_scatter(Frame& F) {
    const int* hist = (const int*)(F.ws + WS_HIST); const int* route = (const int*)(F.ws + WS_ROUTE);
    int* tokslot = (int*)(F.ws + WS_TOKSLOT); int* slottok = (int*)(F.ws + WS_SLOTTOK); int* moetab = (int*)(F.ws + WS_MOETAB);
    LAS int* pre = (LAS int*)F.lds;
    LAS int* base = (LAS int*)(F.lds + 32768);
    for (int i = F.tid; i < 256 * 32; i += 512) pre[i] = hist[i];
    __syncthreads();
    if (F.tid < 32) { int run = 0;
        for (int c = 0; c < 256; ++c) { const int v = pre[c * 32 + F.tid]; pre[c * 32 + F.tid] = run; run += v; }
        base[64 + F.tid] = run; }
    __syncthreads();
    if (F.tid == 0) { int run = 0; for (int ex = 0; ex < NEXP; ++ex) { base[ex] = run; run += (base[64 + ex] + 255) & ~255; } base[NEXP] = run; }
    __syncthreads();
    if (F.blk == 0 && F.tid <= NEXP) moetab[F.tid] = base[F.tid] >> 8;
    for (int chunk = F.blk; chunk < NTOK / 128; chunk += F.G) {
        const int t = chunk * 128 + (F.tid >> 2), k = F.tid & 3; const int rt = route[t * 4 + k]; const int ex = rt & 31, pos = rt >> 5;
        const int slot = base[ex] + pre[chunk * 32 + ex] + pos;
        tokslot[t * 4 + k] = slot; slottok[slot] = t;
    }
    for (int ex = F.blk; ex < NEXP; ex += F.G) { const int lo = base[ex] + base[64 + ex], hi = base[ex + 1]; for (int s = lo + F.tid; s < hi; s += 512) slottok[s] = 0; }
    __syncthreads();
}

__device__ __forceinline__ void launder(Frame& F) { int t = threadIdx.x; asm volatile("" : "+v"(t)); F.tid = t; F.lane = t & 63; F.wave = __builtin_amdgcn_readfirstlane(t >> 6); }
struct Args { const float* in[21]; float* out; unsigned char* ws; int ph_lo, ph_hi; };
constexpr int N_PHASES = 1 + 9 * NLAYER + 1;

__global__ void __launch_bounds__(512, 2) fwd_kernel(Args args) {
    extern __shared__ __attribute__((aligned(16))) unsigned char lds_raw[];
    Frame F;
    F.lds = (LAS unsigned char*)lds_raw;
    F.tid = threadIdx.x; F.lane = F.tid & 63; F.wave = __builtin_amdgcn_readfirstlane(F.tid >> 6); F.blk = blockIdx.x; F.G = gridDim.x;
#pragma unroll
    for (int i = 0; i < 21; ++i) F.in[i] = args.in[i];
    F.out = args.out; F.ws = args.ws;
    volatile LAS unsigned* MISC = (volatile LAS unsigned*)(F.lds + MISC_OFF);
    if (F.tid < 16) MISC[F.tid] = 0u;
    __syncthreads();
    const int lo = args.ph_lo, hi = args.ph_hi;
    const bool multi = (hi - lo) > 1;
    XcdBarrier bar; bar.bar = (unsigned*)(F.ws + WS_CTL) + CW_BAR; bar.x = 0; bar.st = MISC;
    if (multi) bar = xcd_barrier_post((unsigned*)(F.ws + WS_CTL) + CW_BAR, MISC);
#ifndef PH_MASK
#define PH_MASK 0x7ff
#endif
#define PK(j) ((PH_MASK >> (j)) & 1)
#define IN(k) (lo <= (k) && (k) < hi)
#define SEAM(k) do { if (IN((k) + 1)) xcd_barrier(bar); } while (0)

    if (PK(0) && IN(0)) { launder(F); p0_prologue(F); SEAM(0); }
    for (int l = 0; l < NLAYER; ++l) {
        const int p = 1 + 9 * l;
        const float* xin = (l == 0) ? F.in[I_X] : (const float*)(F.ws + WS_XB);
        float* xa = (float*)(F.ws + WS_XA);
        if (PK(1) && IN(p + 0)) { launder(F);
            if (l == 0) row_phase<false, true>(F, 0, F.in[I_X], nullptr);
            else row_phase<true, true>(F, l, xa, (float*)(F.ws + WS_XB));
            SEAM(p + 0);
        }
        if (PK(2) && IN(p + 1)) { launder(F);
            pg8::Gemm g{(const bf16*)(F.ws + WS_H), (const bf16*)(F.ws + WS_WIN) + (size_t)l * NPROJ * DM, nullptr, DM};
            pg8::StaticOrder S; S.init(NTOK, NPROJ, F.G, F.blk);
            pg8::EpiProj E{(bf16*)(F.ws + WS_PROJ), NPROJ};
            pg8::gemm_phase<pg8::EpiProj, pg8::StaticOrder, false>(F.lds, g, S, E);
            SEAM(p + 1);
        }
        if (PK(3) && IN(p + 2)) { launder(F); p3_postproj(F, l); SEAM(p + 2); }
        if (PK(4) && IN(p + 3)) { launder(F); p4_attention(F, l); SEAM(p + 3); }
        if (PK(5) && IN(p + 4)) { launder(F);
            pg8::Gemm g{(const bf16*)(F.ws + WS_YMIX), (const bf16*)(F.ws + WS_WOUT) + (size_t)l * DM * DM, nullptr, DM};
            pg8::StaticOrder S; S.init(NTOK, DM, F.G, F.blk);
            pg8::EpiResGate E{xin, xa, F.in[I_BADA] + (size_t)l * 6144 + 2 * DM, (const float*)(F.ws + WS_MODP) + (size_t)l * 4 * NB * 6144 + 2 * DM};
            pg8::gemm_phase<pg8::EpiResGate, pg8::StaticOrder, false>(F.lds, g, S, E);
            SEAM(p + 4);
        }
        if (PK(6) && IN(p + 5)) { launder(F); p6_norm_router(F, l, xa); SEAM(p + 5); }
        if (PK(7) && IN(p + 6)) { launder(F); p7_scatter(F); SEAM(p + 6); }
        if (IN(p + 7) || IN(p + 8)) {
            LAS int* tb = (LAS int*)(F.lds + MISC_OFF + 64);
            if (F.tid <= NEXP) tb[F.tid] = ((const int*)(F.ws + WS_MOETAB))[F.tid];
            __syncthreads();
            if (PK(8) && IN(p + 7)) { launder(F);
                pg8::Gemm g{(const bf16*)(F.ws + WS_H), (const bf16*)(F.ws + WS_W1) + (size_t)l * NEXP * 2048 * DM, (const int*)(F.ws + WS_SLOTTOK), DM};
                pg8::MoeOrder S; S.init(tb, 8, F.G, F.blk);
                pg8::EpiSwiglu E{(bf16*)(F.ws + WS_ACT), F.in[I_B1] + (size_t)l * NEXP * 2048};
                pg8::gemm_phase<pg8::EpiSwiglu, pg8::MoeOrder, true>(F.lds, g, S, E);
                SEAM(p + 7);
            }
            if (PK(9) && IN(p + 8)) { launder(F);
                pg8::Gemm g{(const bf16*)(F.ws + WS_ACT), (const bf16*)(F.ws + WS_W2) + (size_t)l * NEXP * DM * DM, nullptr, DM};
                pg8::MoeOrder S; S.init(tb, 4, F.G, F.blk);
                pg8::EpiY E{(bf16*)(F.ws + WS_Y), F.in[I_B2] + (size_t)l * NEXP * DM};
                pg8::gemm_phase<pg8::EpiY, pg8::MoeOrder, false>(F.lds, g, S, E);
                SEAM(p + 8);
            }
        }
    }
    if (PK(10) && IN(N_PHASES - 1)) { launder(F); } if (PK(10) && IN(N_PHASES - 1)) row_phase<true, false>(F, NLAYER, (const float*)(F.ws + WS_XA), F.out);
#undef IN
#undef SEAM
}

#ifndef MK_SPLIT
#define MK_SPLIT 1
#endif
extern "C" void kernel_launch(void* const* d_in, const int* in_sizes, int n_in, void* d_out, int out_size, void* d_ws, size_t ws_size, hipStream_t stream) {
    static int grid = 0;
    if (grid == 0) {
        if (n_in != 21 || in_sizes[0] != NTOK * DM || out_size != NTOK * DM || ws_size < WS_END) {
            fprintf(stderr, "kernel_launch: unexpected shapes: n_in %d in0 %d out %d ws %zu (need %zu)\n", n_in, n_in > 0 ? in_sizes[0] : -1, out_size, ws_size, (size_t)WS_END); grid = -1; return; }
        int dev = 0, cus = 0, per_cu = 0;
        if (hipGetDevice(&dev) != hipSuccess || hipDeviceGetAttribute(&cus, hipDeviceAttributeMultiprocessorCount, dev) != hipSuccess) { fprintf(stderr, "kernel_launch: device query failed\n"); grid = -1; return; }
        if (hipFuncSetAttribute((const void*)fwd_kernel, hipFuncAttributeMaxDynamicSharedMemorySize, LDS_BYTES) != hipSuccess) { fprintf(stderr, "kernel_launch: hipFuncSetAttribute failed\n"); grid = -1; return; }
        if (hipOccupancyMaxActiveBlocksPerMultiprocessor(&per_cu, (const void*)fwd_kernel, 512, LDS_BYTES) != hipSuccess || per_cu < 1) fprintf(stderr, "kernel_launch: note: occupancy query says %d\n", per_cu);
        (void)hipGetLastError();
        grid = cus;
    }
    if (grid < 0) return;
    (void)hipMemsetAsync((char*)d_ws + WS_CTL, 0, CTL_ZERO_BYTES, stream);
    Args a{};
    for (int i = 0; i < 21; ++i) a.in[i] = (const float*)d_in[i];
    a.out = (float*)d_out; a.ws = (unsigned char*)d_ws;
#if MK_SPLIT
    for (int ph = 0; ph < N_PHASES; ++ph) { a.ph_lo = ph; a.ph_hi = ph + 1; hipLaunchKernelGGL(fwd_kernel, dim3(grid), dim3(512), LDS_BYTES, stream, a); }
#else
    a.ph_lo = 0; a.ph_hi = N_PHASES; hipLaunchKernelGGL(fwd_kernel, dim3(grid), dim3(512), LDS_BYTES, stream, a);
#endif
}
```

```cpp
#include <hip/hip_runtime.h>
#include <cstdio>
#include <cstdint>

#define GAS __attribute__((address_space(1)))
#define LAS __attribute__((address_space(3)))
typedef unsigned short bf16;
typedef unsigned v4u __attribute__((ext_vector_type(4)));
typedef unsigned v2u __attribute__((ext_vector_type(2)));
typedef float f32x4 __attribute__((ext_vector_type(4)));
typedef float f32x2 __attribute__((ext_vector_type(2)));
typedef float f32x16 __attribute__((ext_vector_type(16)));
typedef short bf16x8 __attribute__((ext_vector_type(8)));
typedef _Float16 f16x8 __attribute__((ext_vector_type(8)));
typedef _Float16 f16x2 __attribute__((ext_vector_type(2)));

namespace pg8 {
constexpr int BM = 256, BK = 64, HALF = 128, HTB = HALF * BK * 2  , STAGE_BYTES = 8 * HTB, NXCD = 8, WGM = 8;

__host__ __device__ __forceinline__ int lds_byte(int r, int c) { const int st = (r >> 4) * 2 + (c >> 5), rr = r & 15, cc = c & 31, ob = rr * 64 + cc * 2; return st * 1024 + (ob ^ (((ob >> 9) & 1) << 5)); }
__host__ __device__ __forceinline__ void stage_rc(int b, int& R, int& C) { const int st = b / 1024, sb = b % 1024, swz = sb ^ (((sb >> 9) & 1) << 5); R = (st >> 1) * 16 + swz / 64; C = (st & 1) * 32 + (swz % 64) / 2; }
__host__ __device__ __forceinline__ int perm32(int rho) { const int n = rho >> 4, i = rho & 15; return 8 * (i >> 2) + 4 * n + (i & 3); }

struct Unit { int pm, pn, pb; };
struct Gemm { const bf16* A; const bf16* Bt; const int* rowmap; int K; };

__device__ __forceinline__ unsigned cvt_pk_bf16(float lo, float hi) { unsigned r; asm volatile("v_cvt_pk_bf16_f32 %0, %1, %2" : "=v"(r) : "v"(lo), "v"(hi)); return r; }

template <class Epi, class Sched, bool GATHER>
__device__ __forceinline__ void gemm_phase(LAS unsigned char* lds, const Gemm g, const Sched& S, const Epi& E) {
    int tid_ = threadIdx.x; asm volatile("" : "+v"(tid_));
    const int tid = tid_, wid = __builtin_amdgcn_readfirstlane(tid >> 6), lane = tid & 63, wr = wid >> 2, wc = wid & 3, fr = lane & 15, fq = lane >> 4;
    const int K = g.K, nt = K / BK;
    unsigned voffA[2], voffB[2]; int RA[2], CA[2];
#pragma unroll
    for (int i = 0; i < 2; ++i) { int R, C; stage_rc(tid * 16 + i * 8192, R, C); const int Rb = Epi::PERM ? ((R & ~31) + perm32(R & 31)) : R; RA[i] = R; CA[i] = C;
        voffA[i] = (unsigned)(R * K + C) * 2u; voffB[i] = (unsigned)(Rb * K + C) * 2u; }
    const size_t kstep = (size_t)(BK * 2);
    const size_t hstep = (size_t)HALF * K * 2;
    const size_t tstep = 2 * hstep;
    const unsigned ldsw = (unsigned)wid * 1024u;
    const int aoff = lds_byte(wr * 64 + fr, fq * 8), boff = lds_byte(wc * 32 + fr, fq * 8);
#define PG8_SA(b, h) (((b) * 2 + (h)) * HTB)
#define PG8_SB(b, h) ((4 + (b) * 2 + (h)) * HTB)
#define PG8_STAGE(bufoff, gbase, voff) do { _Pragma("unroll") for (int _i = 0; _i < 2; ++_i) \
        __builtin_amdgcn_global_load_lds((const unsigned*)((const char*)(gbase) + (voff)[_i]), (LAS unsigned*)(lds + (bufoff) + ldsw + _i * 8192), 16, 0, 0); } while (0)
#define PG8_STAGEA(bufoff, pbase, h, nx) do { if constexpr (GATHER) { _Pragma("unroll") for (int _i = 0; _i < 2; ++_i) \
        __builtin_amdgcn_global_load_lds((const unsigned*)((const char*)(pbase) + ((nx) ? gn[h][_i] : gc[h][_i])), (LAS unsigned*)(lds + (bufoff) + ldsw + _i * 8192), 16, 0, 0); } \
        else { PG8_STAGE(bufoff, (const char*)(pbase) + (h) * hstep, voffA); } } while (0)
#define PG8_LDA(dst, b, h) do { _Pragma("unroll") for (int m = 0; m < 4; ++m) _Pragma("unroll") for (int k = 0; k < 2; ++k) dst[m][k] = *(const LAS bf16x8*)(lds + PG8_SA(b, h) + aoff + m * 2048 + k * 1024); } while (0)
#define PG8_LDB(dst, b, h) do { _Pragma("unroll") for (int n = 0; n < 2; ++n) _Pragma("unroll") for (int k = 0; k < 2; ++k) dst[n][k] = *(const LAS bf16x8*)(lds + PG8_SB(b, h) + boff + n * 2048 + k * 1024); } while (0)
#define PG8_MMA(ai, bj, At, Bt) do { __builtin_amdgcn_s_setprio(1); _Pragma("unroll") for (int m = 0; m < 4; ++m) _Pragma("unroll") for (int n = 0; n < 2; ++n) _Pragma("unroll") for (int k = 0; k < 2; ++k) \
        acc[ai][bj][m][n] = __builtin_amdgcn_mfma_f32_16x16x32_bf16(Bt[n][k], At[m][k], acc[ai][bj][m][n], 0, 0, 0); __builtin_amdgcn_s_setprio(0); } while (0)
#define PG8_WAIT_V(n) asm volatile("s_waitcnt vmcnt(" #n ")" ::: "memory")
#define PG8_WAIT_L(n) asm volatile("s_waitcnt lgkmcnt(" #n ")" ::: "memory")
#define PG8_BAR __builtin_amdgcn_s_barrier()
#define PG8_SCHED __builtin_amdgcn_sched_barrier(0)
    Unit cur, nxt; int ui = 0;
    if (!S.next(0, cur)) return;
    f32x4 acc[2][2][4][2];
#pragma unroll
    for (int a = 0; a < 2; ++a)
#pragma unroll
        for (int b = 0; b < 2; ++b)
#pragma unroll
            for (int m = 0; m < 4; ++m)
#pragma unroll
                for (int n = 0; n < 2; ++n) acc[a][b][m][n] = (f32x4){0.f, 0.f, 0.f, 0.f};
    bf16x8 At[4][2], B0[2][2], B1[2][2];
    unsigned gc[2][2], gn[2][2];
    if constexpr (GATHER) {
#pragma unroll
        for (int h = 0; h < 2; ++h)
#pragma unroll
            for (int i = 0; i < 2; ++i) { gc[h][i] = (unsigned)(g.rowmap[cur.pm * BM + h * HALF + RA[i]] * K + CA[i]) * 2u; gn[h][i] = gc[h][i]; }
    } else { gc[0][0] = gc[0][1] = gc[1][0] = gc[1][1] = 0u; gn[0][0] = gn[0][1] = gn[1][0] = gn[1][1] = 0u; }
    const char* cA = GATHER ? (const char*)g.A : (const char*)g.A + (size_t)cur.pm * tstep; const char* cB = (const char*)g.Bt + (size_t)cur.pb * tstep;
    PG8_STAGE(PG8_SB(0, 0), cB, voffB); PG8_STAGE(PG8_SB(0, 1), cB + hstep, voffB); PG8_STAGEA(PG8_SA(0, 0), cA, 0, false); PG8_STAGEA(PG8_SA(0, 1), cA, 1, false);
    if (wr == 1) PG8_BAR;
    PG8_WAIT_V(2); PG8_BAR;
    PG8_STAGE(PG8_SB(1, 0), cB + kstep, voffB); PG8_STAGEA(PG8_SA(1, 0), cA + kstep, 0, false); PG8_STAGE(PG8_SB(1, 1), cB + hstep + kstep, voffB);
    PG8_WAIT_V(6); PG8_BAR;
    for (;;) {
        const bool has_next = S.next(ui + 1, nxt);
        if constexpr (GATHER) { if (has_next) {
#pragma unroll
            for (int h = 0; h < 2; ++h)
#pragma unroll
                for (int i = 0; i < 2; ++i) gn[h][i] = (unsigned)(g.rowmap[nxt.pm * BM + h * HALF + RA[i]] * K + CA[i]) * 2u; } }
        const char* nA = GATHER ? cA : (has_next ? (const char*)g.A + (size_t)nxt.pm * tstep : cA); const char* nB = has_next ? (const char*)g.Bt + (size_t)nxt.pb * tstep : cB;
        for (int t = 0; t < nt; t += 2) {
            const bool last = (t == nt - 2);
            const char* a1 = cA + (size_t)(t + 1) * kstep;
            const char* a2 = last ? nA : cA + (size_t)(t + 2) * kstep; const char* b2 = last ? nB : cB + (size_t)(t + 2) * kstep;
            const char* a3 = a2 + kstep; const char* b3 = b2 + kstep;
            PG8_LDB(B0, 0, 0); PG8_LDB(B1, 0, 1); PG8_SCHED; PG8_LDA(At, 0, 0); PG8_STAGEA(PG8_SA(1, 1), a1, 1, false);
            PG8_WAIT_V(8); PG8_WAIT_L(0); PG8_BAR; PG8_MMA(0, 0, At, B0); PG8_MMA(0, 1, At, B1); PG8_BAR; PG8_SCHED;
            PG8_LDA(At, 0, 1); PG8_STAGE(PG8_SB(0, 0), b2, voffB); PG8_STAGE(PG8_SB(0, 1), b2 + hstep, voffB); PG8_STAGEA(PG8_SA(0, 0), a2, 0, last);
            PG8_WAIT_V(8); PG8_WAIT_L(0); PG8_BAR; PG8_MMA(1, 0, At, B0); PG8_MMA(1, 1, At, B1); PG8_BAR; PG8_SCHED;
            PG8_LDB(B0, 1, 0); PG8_LDB(B1, 1, 1); PG8_SCHED; PG8_LDA(At, 1, 0); PG8_STAGEA(PG8_SA(0, 1), a2, 1, last);
            PG8_WAIT_V(8); PG8_WAIT_L(0); PG8_BAR; PG8_MMA(0, 0, At, B0); PG8_MMA(0, 1, At, B1); PG8_BAR; PG8_SCHED;
            PG8_LDA(At, 1, 1); PG8_STAGE(PG8_SB(1, 0), b3, voffB); PG8_STAGE(PG8_SB(1, 1), b3 + hstep, voffB); PG8_STAGEA(PG8_SA(1, 0), a3, 0, last);
            PG8_WAIT_V(8); PG8_WAIT_L(0); PG8_BAR; PG8_MMA(1, 0, At, B0); PG8_MMA(1, 1, At, B1); PG8_BAR; PG8_SCHED;
        }
        if (wr == 0) PG8_BAR;
        E(acc, cur, wr, wc, fr, fq);
        if (!has_next) break;
#pragma unroll
        for (int a = 0; a < 2; ++a)
#pragma unroll
            for (int b = 0; b < 2; ++b)
#pragma unroll
                for (int m = 0; m < 4; ++m)
#pragma unroll
                    for (int n = 0; n < 2; ++n) acc[a][b][m][n] = (f32x4){0.f, 0.f, 0.f, 0.f};
        cur = nxt; cA = nA; cB = nB; ++ui;
        if constexpr (GATHER) {
#pragma unroll
            for (int h = 0; h < 2; ++h)
#pragma unroll
                for (int i = 0; i < 2; ++i) gc[h][i] = gn[h][i]; }
        if (wr == 1) PG8_BAR;
    }
    PG8_WAIT_V(0);
    PG8_BAR;
#undef PG8_SA
#undef PG8_SB
#undef PG8_STAGE
#undef PG8_STAGEA
#undef PG8_LDA
#undef PG8_LDB
#undef PG8_MMA
#undef PG8_WAIT_V
#undef PG8_WAIT_L
#undef PG8_BAR
#undef PG8_SCHED
}
}
constexpr int DM = 1024, NB = 8, SEQ = 4096, NTOK = NB * SEQ, NLAYER = 2;
constexpr int NPROJ = 3072;
constexpr int D_IN = 3078;
constexpr int NEXP = 32, TOPK = 4;
constexpr int NSLOT_MAX = NTOK * TOPK + NEXP * 256;
constexpr int NTILE_MAX = NSLOT_MAX / 256;
constexpr int COL_CB = 0, COL_CC = 256, COL_CU = 512, COL_SQ = 768, COL_SK = 1152, COL_SV = 1536, COL_FQ = 1920, COL_FK = 2304, COL_FV = 2688;
constexpr float EPS = 1e-6f;
constexpr float LOG2E = 1.4426950408889634f;
constexpr float QSCALE = 0.125f * LOG2E;

namespace pg8 {
struct StaticOrder {
    int nM, nN, nwg, G, c;
    __device__ __forceinline__ void init(int M, int N, int G_, int c_) { nM = M / BM; nN = N / BM; nwg = nM * nN; G = G_; c = c_; }
    __device__ __forceinline__ bool next(int i, Unit& u) const {
        const long L = (long)i * G + c; if (L >= nwg) return false;
        int wgid = (int)L; { const int q = nwg / NXCD, r = nwg % NXCD, xcd = wgid % NXCD, off = wgid / NXCD; wgid = (xcd < r ? xcd * (q + 1) : r * (q + 1) + (xcd - r) * q) + off; }
        const int nig = WGM * nN, gid = wgid / nig, fm = gid * WGM, gsz = (nM - fm) < WGM ? (nM - fm) : WGM;
        u.pm = fm + ((wgid % nig) % gsz); u.pn = (wgid % nig) / gsz; u.pb = u.pn; return true;
    }
};
struct MoeOrder {
    int nM, nN, nwg, G, c; const LAS int* tb;
    __device__ __forceinline__ void init(const LAS int* tb_, int nN_, int G_, int c_) { tb = tb_; nM = tb_[NEXP]; nN = nN_; nwg = nM * nN; G = G_; c = c_; }
    __device__ __forceinline__ bool next(int i, Unit& u) const {
        const long L = (long)i * G + c; if (L >= nwg) return false;
        int wgid = (int)L; { const int q = nwg / NXCD, r = nwg % NXCD, xcd = wgid % NXCD, off = wgid / NXCD; wgid = (xcd < r ? xcd * (q + 1) : r * (q + 1) + (xcd - r) * q) + off; }
        const int nig = WGM * nN, gid = wgid / nig, fm = gid * WGM, gsz = (nM - fm) < WGM ? (nM - fm) : WGM;
        u.pm = fm + ((wgid % nig) % gsz); u.pn = (wgid % nig) / gsz;
        int e = 0;
#pragma unroll 1
        for (int j = 1; j < NEXP; ++j) e += (tb[j] <= u.pm) ? 1 : 0;
        u.pb = e * nN + u.pn; return true;
    }
};

struct EpiProj {
    static constexpr bool PERM = true;
    bf16* O; int ldc;
    __device__ __forceinline__ void operator()(const f32x4 (&acc)[2][2][4][2], const Unit& u, int wr, int wc, int fr, int fq) const {
        const int row0 = u.pm * BM + wr * 64 + fr, col0 = u.pn * BM + wc * 32 + 8 * fq;
#pragma unroll
        for (int ai = 0; ai < 2; ++ai)
#pragma unroll
            for (int m = 0; m < 4; ++m) { bf16* rowp = O + (size_t)(row0 + ai * HALF + m * 16) * ldc + col0;
#pragma unroll
                for (int bj = 0; bj < 2; ++bj) { const f32x4 v0 = acc[ai][bj][m][0], v1 = acc[ai][bj][m][1];
                    v4u w; w.x = cvt_pk_bf16(v0[0], v0[1]); w.y = cvt_pk_bf16(v0[2], v0[3]); w.z = cvt_pk_bf16(v1[0], v1[1]); w.w = cvt_pk_bf16(v1[2], v1[3]);
                    *(v4u*)(rowp + bj * HALF) = w; } }
    }
};
struct EpiResGate {
    static constexpr bool PERM = false;
    const float* base; float* out; const float* gbias; const float* gpart;
    __device__ __forceinline__ void operator()(const f32x4 (&acc)[2][2][4][2], const Unit& u, int wr, int wc, int fr, int fq) const {
        const int row0 = u.pm * BM + wr * 64 + fr, col0 = u.pn * BM + wc * 32 + 4 * fq; const int b = (u.pm * BM) / SEQ;
        f32x4 gv[2][2];
#pragma unroll
        for (int bj = 0; bj < 2; ++bj)
#pragma unroll
            for (int n = 0; n < 2; ++n) { const int c = col0 + bj * HALF + n * 16; f32x4 s = *(const f32x4*)(gbias + c);
#pragma unroll
                for (int ks = 0; ks < 4; ++ks) s += *(const f32x4*)(gpart + (size_t)(ks * NB + b) * 6144 + c);
                gv[bj][n] = s; }
#pragma unroll
        for (int ai = 0; ai < 2; ++ai)
#pragma unroll
            for (int m = 0; m < 4; ++m) { const size_t off = (size_t)(row0 + ai * HALF + m * 16) * DM + col0;
#pragma unroll
                for (int bj = 0; bj < 2; ++bj)
#pragma unroll
                    for (int n = 0; n < 2; ++n) { const f32x4 bs = *(const f32x4*)(base + off + bj * HALF + n * 16);
                        *(f32x4*)(out + off + bj * HALF + n * 16) = bs + gv[bj][n] * acc[ai][bj][m][n]; } }
    }
};
struct EpiSwiglu {
    static constexpr bool PERM = true;
    bf16* O; const float* b1;
    __device__ __forceinline__ void operator()(const f32x4 (&acc)[2][2][4][2], const Unit& u, int wr, int wc, int fr, int fq) const {
        const int row0 = u.pm * BM + wr * 64 + fr; const int e = u.pb >> 3; const int j0 = u.pn * 128 + wc * 32 + 8 * fq;
        const float* bp = b1 + (size_t)e * 2048 + 2 * j0;
        f32x4 bb[4];
#pragma unroll
        for (int q = 0; q < 4; ++q) bb[q] = *(const f32x4*)(bp + 4 * q);
        float bg[8], bl[8];
#pragma unroll
        for (int q = 0; q < 4; ++q) { bg[2 * q] = bb[q][0]; bl[2 * q] = bb[q][1]; bg[2 * q + 1] = bb[q][2]; bl[2 * q + 1] = bb[q][3]; }
#pragma unroll
        for (int ai = 0; ai < 2; ++ai)
#pragma unroll
            for (int m = 0; m < 4; ++m) { bf16* rowp = O + (size_t)(row0 + ai * HALF + m * 16) * DM + j0;
                float a[8];
#pragma unroll
                for (int n = 0; n < 2; ++n)
#pragma unroll
                    for (int i = 0; i < 4; ++i) { float gl = acc[ai][0][m][n][i] + bg[4 * n + i], li = acc[ai][1][m][n][i] + bl[4 * n + i];
                        gl = fminf(gl, 7.0f); li = fminf(fmaxf(li, -7.0f), 7.0f);
                        const float sg = __builtin_amdgcn_rcpf(1.0f + __builtin_amdgcn_exp2f(-1.702f * LOG2E * gl));
                        a[4 * n + i] = gl * sg * (li + 1.0f); }
                v4u w; w.x = cvt_pk_bf16(a[0], a[1]); w.y = cvt_pk_bf16(a[2], a[3]); w.z = cvt_pk_bf16(a[4], a[5]); w.w = cvt_pk_bf16(a[6], a[7]);
                *(v4u*)rowp = w; }
    }
};
struct EpiY {
    static constexpr bool PERM = true;
    bf16* O; const float* b2;
    __device__ __forceinline__ void operator()(const f32x4 (&acc)[2][2][4][2], const Unit& u, int wr, int wc, int fr, int fq) const {
        const int row0 = u.pm * BM + wr * 64 + fr; const int e = u.pb >> 2; const int col0 = u.pn * BM + wc * 32 + 8 * fq;
        f32x4 bv[2][2];
#pragma unroll
        for (int bj = 0; bj < 2; ++bj)
#pragma unroll
            for (int n = 0; n < 2; ++n) bv[bj][n] = *(const f32x4*)(b2 + (size_t)e * DM + col0 + bj * HALF + 4 * n);
#pragma unroll
        for (int ai = 0; ai < 2; ++ai)
#pragma unroll
            for (int m = 0; m < 4; ++m) { bf16* rowp = O + (size_t)(row0 + ai * HALF + m * 16) * DM + col0;
#pragma unroll
                for (int bj = 0; bj < 2; ++bj) { const f32x4 v0 = acc[ai][bj][m][0] + bv[bj][0], v1 = acc[ai][bj][m][1] + bv[bj][1];
                    v4u w; w.x = cvt_pk_bf16(v0[0], v0[1]); w.y = cvt_pk_bf16(v0[2], v0[3]); w.z = cvt_pk_bf16(v1[0], v1[1]); w.w = cvt_pk_bf16(v1[2], v1[3]);
                    *(v4u*)(rowp + bj * HALF) = w; } }
    }
};
}
namespace att {
constexpr int KROW = 144;
constexpr int TILE_B = 64 * KROW;
constexpr int OFF_K = 0, OFF_V = 2 * TILE_B, OFF_F = 4 * TILE_B, LDS_BYTES = OFF_F + 2 * 256;
__device__ __forceinline__ int pim(int m) { const int a = m >> 3, h = (m >> 2) & 1, b = m & 3; return 16 * (a >> 1) + 8 * h + 4 * (a & 1) + b; }
__device__ __forceinline__ unsigned pk_bf16(float lo, float hi) { unsigned r; asm volatile("v_cvt_pk_bf16_f32 %0, %1, %2" : "=v"(r) : "v"(lo), "v"(hi)); return r; }
__device__ __forceinline__ unsigned pk_f16(float lo, float hi) { return __builtin_bit_cast(unsigned, __builtin_amdgcn_cvt_pkrtz(lo, hi)); }

struct Tensors {
    const bf16* proj;
    const bf16* vt;
    const float* fcum;
    bf16* ymix;
    const float* ong;
    int colq, colk, coly;
};

template <int KIND>
__device__ __forceinline__ void unit(const Tensors& T, int b, int h, int qb, LAS unsigned char* lds) {
    int tid_ = threadIdx.x; asm volatile("" : "+v"(tid_));
    const int tid = tid_, lane = tid & 63, r32 = lane & 31, hi = lane >> 5; const int wid = __builtin_amdgcn_readfirstlane(tid >> 6);
    const int q0 = qb * 256, qw0 = q0 + wid * 32, qabs = qw0 + r32;
    const size_t rowbase = (size_t)b * SEQ;
    const int ktd = qw0 >> 6;
    const int kt_hi = (q0 + 255) >> 6;
    const int srow = tid >> 3, spc = tid & 7;
    const bf16* kg = T.proj + (rowbase + srow) * NPROJ + T.colk + h * 64 + spc * 8;
    const bf16* vg = T.vt + ((size_t)(b * 6 + h) * 64 + srow) * SEQ + spc * 8;
    const float* fg = T.fcum + (size_t)(b * 6 + h) * SEQ;
    const int sdst = srow * KROW + spc * 16;
    bf16x8 qf[4];
    { const bf16* qp = T.proj + (rowbase + qabs) * NPROJ + T.colq + h * 64 + hi * 8;
#pragma unroll
      for (int d0 = 0; d0 < 4; ++d0) qf[d0] = *(const bf16x8*)(qp + d0 * 16); }
    const int pm = pim(r32);
    const int koff = pm * KROW + hi * 16;
    f16x8 mtri0, mtri1, mones;
#pragma unroll
    for (int i = 0; i < 8; ++i) { mtri0[i] = (_Float16)((8 * hi + i > pm) ? 1.0f : 0.0f); mtri1[i] = (_Float16)((16 + 8 * hi + i > pm) ? 1.0f : 0.0f); mones[i] = (_Float16)1.0f; }
    f32x16 o0, o1;
#pragma unroll
    for (int r = 0; r < 16; ++r) { o0[r] = 0.f; o1[r] = 0.f; }
    float carry = (KIND == 1) ? -1e30f : 0.f;
    float lsum = 0.f;

    v4u kreg = *(const v4u*)(kg + (size_t)kt_hi * 64 * NPROJ), vreg = *(const v4u*)(vg + kt_hi * 64);
    float freg = 0.f; if (KIND == 1 && tid < 64) freg = fg[kt_hi * 64 + tid];
    *(LAS v4u*)(lds + OFF_K + sdst) = kreg; *(LAS v4u*)(lds + OFF_V + sdst) = vreg; if (KIND == 1 && tid < 64) *(LAS float*)(lds + OFF_F + tid * 4) = freg;
    __syncthreads();
    int buf = 0;
    for (int kt = kt_hi; kt >= 0; --kt) {
        if (kt > 0) { kreg = *(const v4u*)(kg + (size_t)(kt - 1) * 64 * NPROJ); vreg = *(const v4u*)(vg + (kt - 1) * 64); if (KIND == 1 && tid < 64) freg = fg[(kt - 1) * 64 + tid]; }
        if (kt <= ktd) {
            const LAS unsigned char* Kb = lds + OFF_K + buf * TILE_B; const LAS unsigned char* Vb = lds + OFF_V + buf * TILE_B;
            f32x16 p0, p1;
#pragma unroll
            for (int r = 0; r < 16; ++r) { p0[r] = 0.f; p1[r] = 0.f; }
#pragma unroll
            for (int d0 = 0; d0 < 4; ++d0) { const bf16x8 ka = *(const LAS bf16x8*)(Kb + koff + d0 * 32), kb2 = *(const LAS bf16x8*)(Kb + 32 * KROW + koff + d0 * 32);
                p0 = __builtin_amdgcn_mfma_f32_32x32x16_bf16(ka, qf[d0], p0, 0, 0, 0); p1 = __builtin_amdgcn_mfma_f32_32x32x16_bf16(kb2, qf[d0], p1, 0, 0, 0); }
            const bool diag = (kt == ktd);
            const int kbase = kt * 64 + 8 * hi;
            v4u wf0, wf1, wf2, wf3;
            if (KIND == 0) {
                float ls = 0.f; f32x16 l0, l1;
#pragma unroll
                for (int r = 0; r < 16; ++r) {
                    const int key = kbase + 16 * (r >> 3) + (r & 7);
                    float a = -__builtin_amdgcn_logf(1.0f + __builtin_amdgcn_exp2f(p0[r])); if (diag && !(key < qabs)) a = 0.f;
                    float c = -__builtin_amdgcn_logf(1.0f + __builtin_amdgcn_exp2f(p1[r])); if (diag && !(key + 32 < qabs)) c = 0.f;
                    ls += a + c; l0[r] = a; l1[r] = c; p0[r] += a; p1[r] += c; }
                v4u lf0, lf1, lf2, lf3;
#pragma unroll
                for (int j = 0; j < 4; ++j) { lf0[j] = pk_f16(l0[2 * j], l0[2 * j + 1]); lf1[j] = pk_f16(l0[8 + 2 * j], l0[9 + 2 * j]); lf2[j] = pk_f16(l1[2 * j], l1[2 * j + 1]); lf3[j] = pk_f16(l1[8 + 2 * j], l1[9 + 2 * j]); }
                f32x16 r0, r1;
#pragma unroll
                for (int r = 0; r < 16; ++r) { r0[r] = carry; r1[r] = carry; }
                r0 = __builtin_amdgcn_mfma_f32_32x32x16_f16(mtri0, __builtin_bit_cast(f16x8, lf0), r0, 0, 0, 0);
                r0 = __builtin_amdgcn_mfma_f32_32x32x16_f16(mtri1, __builtin_bit_cast(f16x8, lf1), r0, 0, 0, 0);
                r0 = __builtin_amdgcn_mfma_f32_32x32x16_f16(mones, __builtin_bit_cast(f16x8, lf2), r0, 0, 0, 0);
                r0 = __builtin_amdgcn_mfma_f32_32x32x16_f16(mones, __builtin_bit_cast(f16x8, lf3), r0, 0, 0, 0);
                r1 = __builtin_amdgcn_mfma_f32_32x32x16_f16(mtri0, __builtin_bit_cast(f16x8, lf2), r1, 0, 0, 0);
                r1 = __builtin_amdgcn_mfma_f32_32x32x16_f16(mtri1, __builtin_bit_cast(f16x8, lf3), r1, 0, 0, 0);
#pragma unroll
                for (int r = 0; r < 16; ++r) {
                    const int key = kbase + 16 * (r >> 3) + (r & 7);
                    float a = __builtin_amdgcn_exp2f(p0[r] + r0[r]); if (diag && !(key < qabs)) a = 0.f;
                    float c = __builtin_amdgcn_exp2f(p1[r] + r1[r]); if (diag && !(key + 32 < qabs)) c = 0.f;
                    p0[r] = a; p1[r] = c; }
                ls += __shfl_xor(ls, 32);
                carry += ls;
            } else {
                const LAS float* Fb = (const LAS float*)(lds + OFF_F + buf * 256) + 8 * hi;
                float mx = -1e30f;
#pragma unroll
                for (int g = 0; g < 2; ++g) {
                    const f32x4 fa = *(const LAS f32x4*)(Fb + 16 * g), fb = *(const LAS f32x4*)(Fb + 16 * g + 4), fc = *(const LAS f32x4*)(Fb + 32 + 16 * g), fd = *(const LAS f32x4*)(Fb + 32 + 16 * g + 4);
#pragma unroll
                    for (int i = 0; i < 8; ++i) { const int r = 8 * g + i; const int key = kbase + 16 * g + i;
                        float a = p0[r] - (i < 4 ? fa[i & 3] : fb[i & 3]); if (diag && key > qabs) a = -1e30f;
                        float c = p1[r] - (i < 4 ? fc[i & 3] : fd[i & 3]); if (diag && key + 32 > qabs) c = -1e30f;
                        p0[r] = a; p1[r] = c; mx = fmaxf(mx, fmaxf(a, c)); } }
                mx = fmaxf(mx, __shfl_xor(mx, 32));
                const float mnew = fmaxf(carry, mx), alpha = __builtin_amdgcn_exp2f(carry - mnew); carry = mnew;
                float ps = 0.f;
#pragma unroll
                for (int r = 0; r < 16; ++r) { const float a = __builtin_amdgcn_exp2f(p0[r] - mnew), c = __builtin_amdgcn_exp2f(p1[r] - mnew); ps += a + c; p0[r] = a; p1[r] = c; }
                ps += __shfl_xor(ps, 32);
                lsum = lsum * alpha + ps;
#pragma unroll
                for (int r = 0; r < 16; ++r) { o0[r] *= alpha; o1[r] *= alpha; }
            }
#pragma unroll
            for (int j = 0; j < 4; ++j) { wf0[j] = pk_bf16(p0[2 * j], p0[2 * j + 1]); wf1[j] = pk_bf16(p0[8 + 2 * j], p0[9 + 2 * j]); wf2[j] = pk_bf16(p1[2 * j], p1[2 * j + 1]); wf3[j] = pk_bf16(p1[8 + 2 * j], p1[9 + 2 * j]); }
#pragma unroll
            for (int c = 0; c < 4; ++c) {
                const bf16x8 va = *(const LAS bf16x8*)(Vb + koff + c * 32), vb2 = *(const LAS bf16x8*)(Vb + 32 * KROW + koff + c * 32);
                const bf16x8 wb = __builtin_bit_cast(bf16x8, c == 0 ? wf0 : c == 1 ? wf1 : c == 2 ? wf2 : wf3);
                o0 = __builtin_amdgcn_mfma_f32_32x32x16_bf16(va, wb, o0, 0, 0, 0); o1 = __builtin_amdgcn_mfma_f32_32x32x16_bf16(vb2, wb, o1, 0, 0, 0); }
        }
        if (kt > 0) { const int nb = (buf ^ 1) * TILE_B; *(LAS v4u*)(lds + OFF_K + nb + sdst) = kreg; *(LAS v4u*)(lds + OFF_V + nb + sdst) = vreg;
            if (KIND == 1 && tid < 64) *(LAS float*)(lds + OFF_F + (buf ^ 1) * 256 + tid * 4) = freg; }
        __syncthreads();
        buf ^= 1;
    }
    if (KIND == 1) { const float inv = 1.0f / lsum;
#pragma unroll
        for (int r = 0; r < 16; ++r) { o0[r] *= inv; o1[r] *= inv; } }
    float ss = 0.f;
#pragma unroll
    for (int r = 0; r < 16; ++r) ss += o0[r] * o0[r] + o1[r] * o1[r];
    ss += __shfl_xor(ss, 32);
    const float rinv = 1.0f / sqrtf(ss * (1.0f / 64.0f) + EPS);
    const float* gp = T.ong + T.coly + h * 64 + 8 * hi;
    bf16* yp = T.ymix + (rowbase + qabs) * DM + T.coly + h * 64 + 8 * hi;
#pragma unroll
    for (int d0 = 0; d0 < 2; ++d0)
#pragma unroll
        for (int g = 0; g < 2; ++g) { const f32x4 ga = *(const f32x4*)(gp + 32 * d0 + 16 * g), gb = *(const f32x4*)(gp + 32 * d0 + 16 * g + 4);
            float v[8];
#pragma unroll
            for (int i = 0; i < 8; ++i) v[i] = (d0 == 0 ? o0[8 * g + i] : o1[8 * g + i]) * rinv * (i < 4 ? ga[i & 3] : gb[i & 3]);
            v4u w; w.x = pk_bf16(v[0], v[1]); w.y = pk_bf16(v[2], v[3]); w.z = pk_bf16(v[4], v[5]); w.w = pk_bf16(v[6], v[7]);
            *(v4u*)(yp + 32 * d0 + 16 * g) = w; }
}
}
constexpr size_t MiB = 1u << 20;
constexpr size_t WS_CTL = 0, CTL_ZERO_BYTES = 1 * MiB;
constexpr size_t WS_MODP = 1 * MiB;
constexpr size_t WS_TOPW = 3 * MiB;
constexpr size_t WS_ROUTE = WS_TOPW + 512 * 1024;
constexpr size_t WS_TOKSLOT = WS_ROUTE + 512 * 1024;
constexpr size_t WS_SLOTTOK = WS_TOKSLOT + 512 * 1024;
constexpr size_t WS_HIST = WS_SLOTTOK + 576 * 1024;
constexpr size_t WS_MOETAB = WS_HIST + 32 * 1024;
constexpr size_t WS_LOGF = 6 * MiB;
constexpr size_t WS_FCUM = 7 * MiB;
constexpr size_t WS_WIN = 8 * MiB, WS_WOUT = 20 * MiB, WS_W1 = 24 * MiB, WS_W2 = 280 * MiB;
constexpr size_t WS_H = 408 * MiB;
constexpr size_t WS_PROJ = 472 * MiB;
constexpr size_t WS_VT = 664 * MiB;
constexpr size_t WS_YMIX = 712 * MiB;
constexpr size_t WS_XA = 776 * MiB, WS_XB = 904 * MiB;
constexpr size_t WS_ACT = 1032 * MiB, WS_Y = 1304 * MiB, WS_END = 1576 * MiB;
static_assert(WS_MOETAB + 256 <= WS_LOGF && (size_t)NSLOT_MAX * 4 <= 576 * 1024 && (size_t)NSLOT_MAX * DM * 2 <= 272 * MiB, "ws map");
constexpr int CW_BAR = 4096;

constexpr int RING_BYTES = 131072;
constexpr int MISC_OFF = RING_BYTES;
constexpr int LDS_BYTES = 147456;

#define RLX_AGENT __ATOMIC_RELAXED, __HIP_MEMORY_SCOPE_AGENT
__device__ __forceinline__ unsigned f2bf(float f) { unsigned u = __builtin_bit_cast(unsigned, f); return (u + 0x7fffu + ((u >> 16) & 1u)) >> 16; }
__device__ __forceinline__ unsigned pk2(float lo, float hi) { return f2bf(lo) | (f2bf(hi) << 16); }
__device__ __forceinline__ float bflo(unsigned u) { return __builtin_bit_cast(float, u << 16); }
__device__ __forceinline__ float bfhi(unsigned u) { return __builtin_bit_cast(float, u & 0xffff0000u); }
__device__ __forceinline__ float wave_sum(float v) {
#pragma unroll
    for (int o = 1; o < 64; o <<= 1) v += __shfl_xor(v, o);
    return v;
}

#define XB_TMO      128
#define XB_XCNT(j)  (256  + 64 * (j))
#define XB_XSUB(j)  (1280 + 64 * (j))
#define XB_XGEN(j)  (2304 + 64 * (j))
#define XB_TOP      3328
#define XB_TOPGEN   3392
#define XCD_BAR_WORDS 3456
#define XB_SPIN_CAP (1u << 18)
__device__ __forceinline__ unsigned xb_ld(unsigned* p)              { return __hip_atomic_load(p, __ATOMIC_RELAXED, __HIP_MEMORY_SCOPE_AGENT); }
__device__ __forceinline__ unsigned xb_add(unsigned* p, unsigned v) { return __hip_atomic_fetch_add(p, v, __ATOMIC_RELAXED, __HIP_MEMORY_SCOPE_AGENT); }
__device__ __forceinline__ unsigned xb_xcc_id() { return (unsigned)__builtin_amdgcn_s_getreg((3 << 11) | 20) & 0xFu; }
#define XB_SPIN(cond, bar) do { unsigned _sp = 0; while (cond) { __builtin_amdgcn_s_sleep(1); \
    if ((++_sp & 255u) == 0u) { if (xb_ld(&(bar)[XB_TMO])) break; if (_sp > XB_SPIN_CAP) { atomicAdd(&(bar)[XB_TMO], 1u); break; } } } } while (0)
struct XcdBarrier { unsigned* bar; unsigned x; volatile LAS unsigned* st; };
__device__ __forceinline__ XcdBarrier xcd_barrier_post(unsigned* bar, volatile LAS unsigned* st) {
    XcdBarrier b; b.bar = bar; b.x = xb_xcc_id(); b.st = st;
    if (threadIdx.x == 0) (void)xb_add(&bar[XB_XCNT(b.x)], 1u);
    return b;
}
__device__ __forceinline__ void xcd_barrier_complete(unsigned* bar, unsigned x, unsigned& nloc, unsigned& nx) {
    const unsigned G = gridDim.x * gridDim.y * gridDim.z;
    unsigned sum, cnt, mine, sp = 0u;
    for (;;) {
        sum = 0u; cnt = 0u; mine = 0u;
#pragma unroll
        for (unsigned j = 0; j < 16; ++j) { const unsigned c = xb_ld(&bar[XB_XCNT(j)]); sum += c; cnt += (c > 0u) ? 1u : 0u; mine = (j == x) ? c : mine; }
        if (sum == G) break;
        __builtin_amdgcn_s_sleep(1);
        if ((++sp & 255u) == 0u) { if (xb_ld(&bar[XB_TMO])) break; if (sp > XB_SPIN_CAP) { atomicAdd(&bar[XB_TMO], 1u); break; } }
    }
    nloc = mine > 0u ? mine : 1u; nx = cnt > 0u ? cnt : 1u;
}
__device__ __forceinline__ void xcd_barrier(const XcdBarrier& b) {
    asm volatile("s_waitcnt vmcnt(0)" ::: "memory");
    __syncthreads();
    if (threadIdx.x == 0) {
        unsigned* bar = b.bar;
        __builtin_amdgcn_s_waitcnt(0);
        unsigned nloc = b.st[0], nx = b.st[1];
        if (nloc == 0u) { xcd_barrier_complete(bar, b.x, nloc, nx); b.st[0] = nloc; b.st[1] = nx; }
        const unsigned old = xb_add(&bar[XB_XSUB(b.x)], 1u);
        const unsigned gen = old / nloc;
        if (old + 1u == (gen + 1u) * nloc) {
            __builtin_amdgcn_fence(__ATOMIC_RELEASE, "agent");
            asm volatile("s_waitcnt vmcnt(0)" ::: "memory");
            const unsigned og = xb_add(&bar[XB_TOP], 1u);
            const unsigned tg = og / nx;
            if (og + 1u == (tg + 1u) * nx) xb_add(&bar[XB_TOPGEN], 1u);
            else XB_SPIN(xb_ld(&bar[XB_TOPGEN]) == tg, bar);
            __builtin_amdgcn_fence(__ATOMIC_ACQUIRE, "agent");
            xb_add(&bar[XB_XGEN(b.x)], 1u);
            asm volatile("s_waitcnt vmcnt(0)" ::: "memory");
        } else {
            XB_SPIN(xb_ld(&bar[XB_XGEN(b.x)]) == gen, bar);
            __builtin_amdgcn_fence(__ATOMIC_ACQUIRE, "agent");
            asm volatile("s_waitcnt vmcnt(0)" ::: "memory");
        }
    }
    __syncthreads();
}

struct Frame {
    LAS unsigned char* lds;
    int tid, lane, wave, blk, G;
    const float* in[21];
    float* out; unsigned char* ws;
};
enum { I_X = 0, I_C, I_N1G, I_WADA, I_BADA, I_WIN, I_CONVW, I_SBQG, I_SBKG, I_FXQG, I_FXKG, I_FXFB, I_ONG, I_WOUT, I_N2G, I_RW, I_RB, I_W1, I_B1, I_W2, I_B2 };

template <int MAP>
__device__ __forceinline__ void p0_transpose_item(const float* W, int ldw, bf16* WT, LAS float* scr, int k0, int n0, int lane) {
#pragma unroll 8
    for (int i = 0; i < 32; ++i) { const int kk = 2 * i + (lane >> 5); scr[kk * 33 + (lane & 31)] = W[(size_t)(k0 + kk) * ldw + n0 + (lane & 31)]; }
    asm volatile("s_waitcnt lgkmcnt(0)" ::: "memory");
    const int c = lane & 7;
#pragma unroll
    for (int j = 0; j < 4; ++j) { const int n = (lane >> 3) + 8 * j; const LAS float* s = scr + (8 * c) * 33 + n;
        v4u o; o.x = pk2(s[0 * 33], s[1 * 33]); o.y = pk2(s[2 * 33], s[3 * 33]); o.z = pk2(s[4 * 33], s[5 * 33]); o.w = pk2(s[6 * 33], s[7 * 33]);
        const int cn = n0 + n; int row = cn;
        if (MAP == 1) { const int jj = cn >> 1, t = cn & 1; row = 256 * (jj >> 7) + 128 * t + (jj & 127); }
        *(v4u*)(WT + (size_t)row * 1024 + k0 + 8 * c) = o; }
    asm volatile("s_waitcnt lgkmcnt(0)" ::: "memory");
}
__device__ __forceinline__ void p0_prologue(Frame& F) {
    LAS float* scr = (LAS float*)(F.lds + F.wave * 16384);
    const int gw = F.blk * 8 + F.wave, NGW = F.G * 8;
    for (int it = gw; it < NLAYER * 4 * 24; it += NGW) {
        const int l = it / 96, ks = (it / 24) & 3, nc = it % 24;
        const float* W = F.in[I_WADA] + (size_t)l * DM * 6144 + nc * 256 + F.lane * 4;
        const float* c = F.in[I_C];
        f32x4 acc[NB];
#pragma unroll
        for (int b = 0; b < NB; ++b) acc[b] = (f32x4){0.f, 0.f, 0.f, 0.f};
#pragma unroll 4
        for (int k = ks * 256; k < ks * 256 + 256; ++k) {
            const f32x4 w = *(const f32x4*)(W + (size_t)k * 6144);
#pragma unroll
            for (int b = 0; b < NB; ++b) { const float cv = c[b * DM + k]; const float s = cv / (1.0f + __expf(-cv)); acc[b] += w * s; }
        }
        float* dst = (float*)(F.ws + WS_MODP) + ((size_t)(l * 4 + ks) * NB) * 6144 + nc * 256 + F.lane * 4;
#pragma unroll
        for (int b = 0; b < NB; ++b) *(f32x4*)(dst + (size_t)b * 6144) = acc[b];
    }
    constexpr int I_IN = 16 * 96, I_OUT = 16 * 32, I_1 = 16 * 64, I_2 = 16 * 32;
    constexpr int N_IN = NLAYER * I_IN, N_OUT = NLAYER * I_OUT, N_1 = NLAYER * NEXP * I_1, N_2 = NLAYER * NEXP * I_2;
    for (int it = gw; it < N_IN + N_OUT + N_1 + N_2; it += NGW) {
        int r = it;
        if (r < N_IN) { const int l = r / I_IN, q = r % I_IN, kb = q / 96, nb = q % 96;
            p0_transpose_item<0>(F.in[I_WIN] + (size_t)l * DM * D_IN, D_IN, (bf16*)(F.ws + WS_WIN) + (size_t)l * NPROJ * DM, scr, 64 * kb, 32 * nb, F.lane); continue; }
        r -= N_IN;
        if (r < N_OUT) { const int l = r / I_OUT, q = r % I_OUT, kb = q / 32, nb = q % 32;
            p0_transpose_item<0>(F.in[I_WOUT] + (size_t)l * DM * DM, DM, (bf16*)(F.ws + WS_WOUT) + (size_t)l * DM * DM, scr, 64 * kb, 32 * nb, F.lane); continue; }
        r -= N_OUT;
        if (r < N_1) { const int le = r / I_1, q = r % I_1, kb = q / 64, nb = q % 64;
            p0_transpose_item<1>(F.in[I_W1] + (size_t)le * DM * 2048, 2048, (bf16*)(F.ws + WS_W1) + (size_t)le * 2048 * DM, scr, 64 * kb, 32 * nb, F.lane); continue; }
        r -= N_1;
        { const int le = r / I_2, q = r % I_2, kb = q / 32, nb = q % 32;
            p0_transpose_item<0>(F.in[I_W2] + (size_t)le * DM * DM, DM, (bf16*)(F.ws + WS_W2) + (size_t)le * DM * DM, scr, 64 * kb, 32 * nb, F.lane); }
    }
}

__device__ __forceinline__ f32x4 mod4(const Frame& F, int l, int b, int which, int c) {
    const int n = which * DM + c;
    f32x4 s = *(const f32x4*)(F.in[I_BADA] + (size_t)l * 6144 + n);
    const float* p = (const float*)(F.ws + WS_MODP) + ((size_t)(l * 4) * NB + b) * 6144 + n;
#pragma unroll
    for (int ks = 0; ks < 4; ++ks) s += *(const f32x4*)(p + (size_t)ks * NB * 6144);
    return s;
}

template <bool COMBINE, bool NORM>
__device__ __forceinline__ void row_phase(Frame& F, int l, const float* xsrc, float* xdst) {
    const float* topw = (const float*)(F.ws + WS_TOPW); const int* tokslot = (const int*)(F.ws + WS_TOKSLOT); const bf16* Y = (const bf16*)(F.ws + WS_Y);
    bf16* H = (bf16*)(F.ws + WS_H); float* logf = (float*)(F.ws + WS_LOGF);
    LAS float* wl = (LAS float*)F.lds;
    if (NORM) { for (int i = F.tid; i < DM * 6; i += 512) { const int k = i / 6, q = i % 6; wl[k * 8 + q] = F.in[I_WIN][(size_t)l * DM * D_IN + (size_t)k * D_IN + NPROJ + q]; }
        __syncthreads(); }
    for (int chunk = F.blk; chunk < NTOK / 128; chunk += F.G) {
        const int b = chunk / (SEQ / 128);
        f32x4 g2[4], A[4], Bv[4];
#pragma unroll
        for (int j = 0; j < 4; ++j) { const int c = 256 * j + 4 * F.lane;
            if (COMBINE) g2[j] = mod4(F, l - 1, b, 5, c);
            if (NORM) { const f32x4 g = *(const f32x4*)(F.in[I_N1G] + (size_t)l * DM + c); A[j] = g * (mod4(F, l, b, 1, c) + 1.0f); Bv[j] = mod4(F, l, b, 0, c); } }
#pragma unroll 1
        for (int rr = 0; rr < 16; ++rr) {
            const int row = chunk * 128 + F.wave + 8 * rr;
            f32x4 v[4];
#pragma unroll
            for (int j = 0; j < 4; ++j) v[j] = *(const f32x4*)(xsrc + (size_t)row * DM + 256 * j + 4 * F.lane);
            if (COMBINE) {
                f32x4 s[4];
#pragma unroll
                for (int j = 0; j < 4; ++j) s[j] = (f32x4){0.f, 0.f, 0.f, 0.f};
#pragma unroll
                for (int k = 0; k < TOPK; ++k) { const float w = topw[row * 4 + k]; const int slot = tokslot[row * 4 + k];
#pragma unroll
                    for (int j = 0; j < 4; ++j) { const v2u yv = *(const v2u*)(Y + (size_t)slot * DM + 256 * j + 4 * F.lane);
                        s[j] += (f32x4){bflo(yv.x), bfhi(yv.x), bflo(yv.y), bfhi(yv.y)} * w; } }
#pragma unroll
                for (int j = 0; j < 4; ++j) { v[j] += g2[j] * s[j]; *(f32x4*)(xdst + (size_t)row * DM + 256 * j + 4 * F.lane) = v[j]; }
            }
            if (NORM) {
                float ss = 0.f;
#pragma unroll
                for (int j = 0; j < 4; ++j) ss += (v[j].x * v[j].x + v[j].y * v[j].y) + (v[j].z * v[j].z + v[j].w * v[j].w);
                const float rstd = 1.0f / sqrtf(wave_sum(ss) * (1.0f / DM) + EPS);
                float fl[6] = {0.f, 0.f, 0.f, 0.f, 0.f, 0.f};
                int woff = 4 * F.lane; asm volatile("" : "+v"(woff));
#pragma unroll
                for (int j = 0; j < 4; ++j) { const f32x4 hv = v[j] * rstd * A[j] + Bv[j];
                    v2u o; o.x = pk2(hv.x, hv.y); o.y = pk2(hv.z, hv.w); *(v2u*)(H + (size_t)row * DM + 256 * j + 4 * F.lane) = o;
#pragma unroll
                    for (int i = 0; i < 4; ++i) { const LAS float* wp = wl + (256 * j + woff + i) * 8; const f32x4 wa = *(const LAS f32x4*)wp; const f32x2 wb = *(const LAS f32x2*)(wp + 4); const float hx = hv[i];
                        fl[0] += hx * wa.x; fl[1] += hx * wa.y; fl[2] += hx * wa.z; fl[3] += hx * wa.w; fl[4] += hx * wb.x; fl[5] += hx * wb.y; } }
#pragma unroll
                for (int q = 0; q < 6; ++q) fl[q] = wave_sum(fl[q]);
                if (F.lane < 6) { float z = fl[0];
#pragma unroll
                    for (int q = 1; q < 6; ++q) z = (F.lane == q) ? fl[q] : z;
                    z += F.in[I_FXFB][l * 6 + F.lane];
                    logf[(size_t)row * 6 + F.lane] = fminf(z, 0.f) - __logf(1.0f + __expf(-fabsf(z))); }
            }
        }
    }
    __syncthreads();
}
__device__ __forceinline__ void p3_postproj(Frame& F, int l) {
    bf16* proj = (bf16*)(F.ws + WS_PROJ); bf16* ymix = (bf16*)(F.ws + WS_YMIX);
    const float* ong = F.in[I_ONG] + (size_t)l * DM;
    const int c4 = 4 * F.lane;
    f32x4 cw[3];
#pragma unroll
    for (int w = 0; w < 3; ++w) cw[w] = *(const f32x4*)(F.in[I_CONVW] + (size_t)(l * 3 + w) * 256 + c4);
    const f32x4 cg = *(const f32x4*)(ong + c4);
    const int e0 = 8 * (F.lane & 7);
    float gq[3][8]; int colv[3];
#pragma unroll
    for (int i = 0; i < 3; ++i) { const int vi = 8 * i + (F.lane >> 3); const int ty = vi / 6;
        colv[i] = (vi < 12 ? COL_SQ + 64 * vi : COL_FQ + 64 * (vi - 12)) + e0;
        const float* gp = (ty == 0 ? F.in[I_SBQG] : ty == 1 ? F.in[I_SBKG] : ty == 2 ? F.in[I_FXQG] : F.in[I_FXKG]) + (size_t)l * 64 + e0; const float sc = (ty == 0 || ty == 2) ? QSCALE : 1.0f;
#pragma unroll
        for (int q = 0; q < 8; ++q) gq[i][q] = gp[q] * sc; }
    LAS unsigned char* scr = F.lds + F.wave * (64 * 144);
    for (int tile = F.blk; tile < NTOK / 64; tile += F.G) {
        const int b = tile / (SEQ / 64), s0 = (tile % (SEQ / 64)) * 64; const size_t row0 = (size_t)b * SEQ + s0;
        for (int tt = 0; tt < 8; ++tt) {
            const int s = s0 + F.wave * 8 + tt; const size_t row = (size_t)b * SEQ + s; bf16* pr = proj + row * NPROJ;
            f32x4 vv[3];
#pragma unroll
            for (int w = 0; w < 3; ++w) { const int sw = s - 2 + w;
                if (sw >= 0) { const bf16* pw = proj + ((size_t)b * SEQ + sw) * NPROJ; const v2u cc = *(const v2u*)(pw + COL_CC + c4), cu = *(const v2u*)(pw + COL_CU + c4);
                    vv[w] = (f32x4){bflo(cc.x) * bflo(cu.x), bfhi(cc.x) * bfhi(cu.x), bflo(cc.y) * bflo(cu.y), bfhi(cc.y) * bfhi(cu.y)}; }
                else vv[w] = (f32x4){0.f, 0.f, 0.f, 0.f}; }
            const v2u cb = *(const v2u*)(pr + COL_CB + c4);
            f32x4 y = cw[0] * vv[0] + cw[1] * vv[1] + cw[2] * vv[2];
            y = y * (f32x4){bflo(cb.x), bfhi(cb.x), bflo(cb.y), bfhi(cb.y)};
            float ss = (y.x * y.x + y.y * y.y) + (y.z * y.z + y.w * y.w);
            ss += __shfl_xor(ss, 1); ss += __shfl_xor(ss, 2); ss += __shfl_xor(ss, 4); ss += __shfl_xor(ss, 8);
            const float rinv = 1.0f / sqrtf(ss * (1.0f / 64.0f) + EPS);
            y = y * rinv * cg;
            v2u o; o.x = pk2(y.x, y.y); o.y = pk2(y.z, y.w); *(v2u*)(ymix + row * DM + c4) = o;
#pragma unroll
            for (int i = 0; i < 3; ++i) { const v4u x = *(const v4u*)(pr + colv[i]);
                float f[8] = {bflo(x.x), bfhi(x.x), bflo(x.y), bfhi(x.y), bflo(x.z), bfhi(x.z), bflo(x.w), bfhi(x.w)};
                float q2 = 0.f;
#pragma unroll
                for (int q = 0; q < 8; ++q) q2 += f[q] * f[q];
                q2 += __shfl_xor(q2, 1); q2 += __shfl_xor(q2, 2); q2 += __shfl_xor(q2, 4);
                const float ri = 1.0f / sqrtf(q2 * (1.0f / 64.0f) + EPS);
                v4u w; w.x = pk2(f[0] * ri * gq[i][0], f[1] * ri * gq[i][1]); w.y = pk2(f[2] * ri * gq[i][2], f[3] * ri * gq[i][3]);
                w.z = pk2(f[4] * ri * gq[i][4], f[5] * ri * gq[i][5]); w.w = pk2(f[6] * ri * gq[i][6], f[7] * ri * gq[i][7]);
                *(v4u*)(pr + colv[i]) = w; }
        }
        for (int t = F.wave; t < 12; t += 8) {
            const int kind = t / 6, h = t % 6; const int col = (kind ? COL_FV : COL_SV) + 64 * h;
            const bf16* src = proj + (row0 + F.lane) * NPROJ + col;
#pragma unroll
            for (int pc = 0; pc < 8; ++pc) { const v4u x = *(const v4u*)(src + 8 * pc);
                const unsigned xs[4] = {x.x, x.y, x.z, x.w};
#pragma unroll
                for (int q = 0; q < 4; ++q) { *(LAS unsigned short*)(scr + (8 * pc + 2 * q) * 144 + 2 * F.lane) = (unsigned short)(xs[q] & 0xffffu);
                                              *(LAS unsigned short*)(scr + (8 * pc + 2 * q + 1) * 144 + 2 * F.lane) = (unsigned short)(xs[q] >> 16); } }
            asm volatile("s_waitcnt lgkmcnt(0)" ::: "memory");
            bf16* dst = (bf16*)(F.ws + WS_VT) + (size_t)kind * (48 * 64 * SEQ) + ((size_t)(b * 6 + h) * 64 + F.lane) * SEQ + s0;
#pragma unroll
            for (int pc = 0; pc < 8; ++pc) *(v4u*)(dst + 8 * pc) = *(const LAS v4u*)(scr + F.lane * 144 + 16 * pc);
            asm volatile("s_waitcnt lgkmcnt(0)" ::: "memory");
        }
    }
    for (int sq = F.blk * 8 + F.wave; sq < NB * 6; sq += F.G * 8) {
        const int b = sq / 6, h = sq % 6; const float* lf = (const float*)(F.ws + WS_LOGF) + ((size_t)b * SEQ + 64 * F.lane) * 6 + h;
        float tot = 0.f;
        for (int i = 0; i < 64; ++i) tot += lf[(size_t)i * 6];
        float inc = tot;
#pragma unroll
        for (int o = 1; o < 64; o <<= 1) { const float t = __shfl_up(inc, o); if (F.lane >= o) inc += t; }
        float run = inc - tot; float* fo = (float*)(F.ws + WS_FCUM) + (size_t)sq * SEQ + 64 * F.lane;
        for (int i = 0; i < 64; ++i) { run += lf[(size_t)i * 6]; fo[i] = run * LOG2E; }
    }
}

__device__ __forceinline__ void p4_attention(Frame& F, int l) {
    att::Tensors Ts, Tf;
    Ts.proj = (const bf16*)(F.ws + WS_PROJ); Ts.vt = (const bf16*)(F.ws + WS_VT); Ts.fcum = (const float*)(F.ws + WS_FCUM); Ts.ymix = (bf16*)(F.ws + WS_YMIX); Ts.ong = F.in[I_ONG] + (size_t)l * DM;
    Ts.colq = COL_SQ; Ts.colk = COL_SK; Ts.coly = 256;
    Tf = Ts; Tf.vt = Ts.vt + (size_t)48 * 64 * SEQ; Tf.colq = COL_FQ; Tf.colk = COL_FK; Tf.coly = 640;
    const int NU = 2 * 48 * 16;
    for (int i = 0;; ++i) {
        const int L = (i & 1) ? (i + 1) * F.G - 1 - F.blk : i * F.G + F.blk;
        if (i * F.G >= NU) break;
        if (L >= NU) continue;
        const int qb = 15 - L / 96, j = L % 96, kind = j / 48, bh = j % 48;
        if (kind == 0) att::unit<0>(Ts, bh / 6, bh % 6, qb, F.lds); else att::unit<1>(Tf, bh / 6, bh % 6, qb, F.lds);
    }
}

__device__ __forceinline__ void p6_norm_router(Frame& F, int l, const float* x1) {
    bf16* H = (bf16*)(F.ws + WS_H); float* topw = (float*)(F.ws + WS_TOPW); int* route = (int*)(F.ws + WS_ROUTE); int* hist = (int*)(F.ws + WS_HIST);
    const float* rw = F.in[I_RW] + (size_t)l * DM * NEXP; const float* rb = F.in[I_RB] + (size_t)l * NEXP;
    LAS float* hs = (LAS float*)(F.lds + F.wave * 16384);
    LAS int* cnt = (LAS int*)(F.lds + MISC_OFF + 256);
    const int e = F.lane & 31, half = F.lane >> 5;
    for (int chunk = F.blk; chunk < NTOK / 128; chunk += F.G) {
        const int b = chunk / (SEQ / 128);
        if (F.tid < 32) cnt[F.tid] = 0;
        __syncthreads();
        f32x4 A[4], Bv[4];
#pragma unroll
        for (int j = 0; j < 4; ++j) { const int c = 256 * j + 4 * F.lane; const f32x4 g = *(const f32x4*)(F.in[I_N2G] + (size_t)l * DM + c); A[j] = g * (mod4(F, l, b, 4, c) + 1.0f); Bv[j] = mod4(F, l, b, 3, c); }
        const float rbias = rb[e];
        for (int rg = 0; rg < 4; ++rg) {
            const int rbase = chunk * 128 + F.wave * 16 + 4 * rg;
#pragma unroll
            for (int r = 0; r < 4; ++r) { const int row = rbase + r;
                f32x4 v[4]; float ss = 0.f;
#pragma unroll
                for (int j = 0; j < 4; ++j) { v[j] = *(const f32x4*)(x1 + (size_t)row * DM + 256 * j + 4 * F.lane); ss += (v[j].x * v[j].x + v[j].y * v[j].y) + (v[j].z * v[j].z + v[j].w * v[j].w); }
                const float rstd = 1.0f / sqrtf(wave_sum(ss) * (1.0f / DM) + EPS);
#pragma unroll
                for (int j = 0; j < 4; ++j) { const f32x4 hv = v[j] * rstd * A[j] + Bv[j];
                    v2u o; o.x = pk2(hv.x, hv.y); o.y = pk2(hv.z, hv.w); *(v2u*)(H + (size_t)row * DM + 256 * j + 4 * F.lane) = o;
                    const int k = 256 * j + 4 * F.lane;
                    hs[(k + 0) * 4 + r] = hv.x; hs[(k + 1) * 4 + r] = hv.y; hs[(k + 2) * 4 + r] = hv.z; hs[(k + 3) * 4 + r] = hv.w; } }
            asm volatile("s_waitcnt lgkmcnt(0)" ::: "memory");
            f32x4 acc = (f32x4){0.f, 0.f, 0.f, 0.f};
            const float* rwp = rw + (size_t)(512 * half) * NEXP + e; const LAS f32x4* hp = (const LAS f32x4*)hs + 512 * half;
#pragma unroll 8
            for (int k = 0; k < 512; ++k) acc += hp[k] * rwp[(size_t)k * NEXP];
            asm volatile("s_waitcnt lgkmcnt(0)" ::: "memory");
#pragma unroll
            for (int r = 0; r < 4; ++r) { acc[r] += __shfl_xor(acc[r], 32); acc[r] += rbias; }
#pragma unroll
            for (int r = 0; r < 4; ++r) {
                float val = acc[r]; float tv[4]; int ti[4];
#pragma unroll
                for (int k = 0; k < TOPK; ++k) {
                    float bv = val; int bi = e;
#pragma unroll
                    for (int o = 1; o < 32; o <<= 1) { const float ov = __shfl_xor(bv, o); const int oi = __shfl_xor(bi, o); if (ov > bv || (ov == bv && oi < bi)) { bv = ov; bi = oi; } }
                    tv[k] = bv; ti[k] = bi; if (e == bi) val = -INFINITY;
                }
                const float e1 = __expf(tv[1] - tv[0]), e2 = __expf(tv[2] - tv[0]), e3 = __expf(tv[3] - tv[0]); const float inv = 1.0f / (1.0f + e1 + e2 + e3);
                if (F.lane < 4) { const int row = rbase + r; const int k = F.lane;
                    const float w = (k == 0 ? 1.0f : k == 1 ? e1 : k == 2 ? e2 : e3) * inv; const int ex = (k == 0 ? ti[0] : k == 1 ? ti[1] : k == 2 ? ti[2] : ti[3]);
                    const int pos = __hip_atomic_fetch_add(cnt + ex, 1, __ATOMIC_RELAXED, __HIP_MEMORY_SCOPE_WORKGROUP);
                    topw[row * 4 + k] = w; route[row * 4 + k] = ex + 32 * pos; }
            }
        }
        __syncthreads();
        if (F.tid < 32) hist[chunk * 32 + F.tid] = cnt[F.tid];
        __syncthreads();
    }
}

__device__ __forceinline__ void p7_scatter(Frame& F) {
    const int* hist = (const int*)(F.ws + WS_HIST); const int* route = (const int*)(F.ws + WS_ROUTE);
    int* tokslot = (int*)(F.ws + WS_TOKSLOT); int* slottok = (int*)(F.ws + WS_SLOTTOK); int* moetab = (int*)(F.ws + WS_MOETAB);
    LAS int* pre = (LAS int*)F.lds;
    LAS int* base = (LAS int*)(F.lds + 32768);
    for (int i = F.tid; i < 256 * 32; i += 512) pre[i] = hist[i];
    __syncthreads();
    if (F.tid < 32) { int run = 0;
        for (int c = 0; c < 256; ++c) { const int v = pre[c * 32 + F.tid]; pre[c * 32 + F.tid] = run; run += v; }
        base[64 + F.tid] = run; }
    __syncthreads();
    if (F.tid == 0) { int run = 0; for (int ex = 0; ex < NEXP; ++ex) { base[ex] = run; run += (base[64 + ex] + 255) & ~255; } base[NEXP] = run; }
    __syncthreads();
    if (F.blk == 0 && F.tid <= NEXP) moetab[F.tid] = base[F.tid] >> 8;
    for (int chunk = F.blk; chunk < NTOK / 128; chunk += F.G) {
        const int t = chunk * 128 + (F.tid >> 2), k = F.tid & 3; const int rt = route[t * 4 + k]; const int ex = rt & 31, pos = rt >> 5;
        const int slot = base[ex] + pre[chunk * 32 + ex] + pos;
        tokslot[t * 4 + k] = slot; slottok[slot] = t;
    }
    for (int ex = F.blk; ex < NEXP; ex += F.G) { const int lo = base[ex] + base[64 + ex], hi = base[ex + 1]; for (int s = lo + F.tid; s < hi; s += 512) slottok[s] = 0; }
    __syncthreads();
}

__device__ __forceinline__ void launder(Frame& F) { int t = threadIdx.x; asm volatile("" : "+v"(t)); F.tid = t; F.lane = t & 63; F.wave = __builtin_amdgcn_readfirstlane(t >> 6); }
struct Args { const float* in[21]; float* out; unsigned char* ws; int ph_lo, ph_hi; };
constexpr int N_PHASES = 1 + 9 * NLAYER + 1;

__global__ void __launch_bounds__(512, 2) fwd_kernel(Args args) {
    extern __shared__ __attribute__((aligned(16))) unsigned char lds_raw[];
    Frame F;
    F.lds = (LAS unsigned char*)lds_raw;
    F.tid = threadIdx.x; F.lane = F.tid & 63; F.wave = __builtin_amdgcn_readfirstlane(F.tid >> 6); F.blk = blockIdx.x; F.G = gridDim.x;
#pragma unroll
    for (int i = 0; i < 21; ++i) F.in[i] = args.in[i];
    F.out = args.out; F.ws = args.ws;
    volatile LAS unsigned* MISC = (volatile LAS unsigned*)(F.lds + MISC_OFF);
    if (F.tid < 16) MISC[F.tid] = 0u;
    __syncthreads();
    const int lo = args.ph_lo, hi = args.ph_hi;
    const bool multi = (hi - lo) > 1;
    XcdBarrier bar; bar.bar = (unsigned*)(F.ws + WS_CTL) + CW_BAR; bar.x = 0; bar.st = MISC;
    if (multi) bar = xcd_barrier_post((unsigned*)(F.ws + WS_CTL) + CW_BAR, MISC);
#ifndef PH_MASK
#define PH_MASK 0x7ff
#endif
#define PK(j) ((PH_MASK >> (j)) & 1)
#define IN(k) (lo <= (k) && (k) < hi)
#define SEAM(k) do { if (IN((k) + 1)) xcd_barrier(bar); } while (0)

    if (PK(0) && IN(0)) { launder(F); p0_prologue(F); SEAM(0); }
    for (int l = 0; l < NLAYER; ++l) {
        const int p = 1 + 9 * l;
        const float* xin = (l == 0) ? F.in[I_X] : (const float*)(F.ws + WS_XB);
        float* xa = (float*)(F.ws + WS_XA);
        if (PK(1) && IN(p + 0)) { launder(F);
            if (l == 0) row_phase<false, true>(F, 0, F.in[I_X], nullptr);
            else row_phase<true, true>(F, l, xa, (float*)(F.ws + WS_XB));
            SEAM(p + 0);
        }
        if (PK(2) && IN(p + 1)) { launder(F);
            pg8::Gemm g{(const bf16*)(F.ws + WS_H), (const bf16*)(F.ws + WS_WIN) + (size_t)l * NPROJ * DM, nullptr, DM};
            pg8::StaticOrder S; S.init(NTOK, NPROJ, F.G, F.blk);
            pg8::EpiProj E{(bf16*)(F.ws + WS_PROJ), NPROJ};
            pg8::gemm_phase<pg8::EpiProj, pg8::StaticOrder, false>(F.lds, g, S, E);
            SEAM(p + 1);
        }
        if (PK(3) && IN(p + 2)) { launder(F); p3_postproj(F, l); SEAM(p + 2); }
        if (PK(4) && IN(p + 3)) { launder(F); p4_attention(F, l); SEAM(p + 3); }
        if (PK(5) && IN(p + 4)) { launder(F);
            pg8::Gemm g{(const bf16*)(F.ws + WS_YMIX), (const bf16*)(F.ws + WS_WOUT) + (size_t)l * DM * DM, nullptr, DM};
            pg8::StaticOrder S; S.init(NTOK, DM, F.G, F.blk);
            pg8::EpiResGate E{xin, xa, F.in[I_BADA] + (size_t)l * 6144 + 2 * DM, (const float*)(F.ws + WS_MODP) + (size_t)l * 4 * NB * 6144 + 2 * DM};
            pg8::gemm_phase<pg8::EpiResGate, pg8::StaticOrder, false>(F.lds, g, S, E);
            SEAM(p + 4);
        }
        if (PK(6) && IN(p + 5)) { launder(F); p6_norm_router(F, l, xa); SEAM(p + 5); }
        if (PK(7) && IN(p + 6)) { launder(F); p7_scatter(F); SEAM(p + 6); }
        if (IN(p + 7) || IN(p + 8)) {
            LAS int* tb = (LAS int*)(F.lds + MISC_OFF + 64);
            if (F.tid <= NEXP) tb[F.tid] = ((const int*)(F.ws + WS_MOETAB))[F.tid];
            __syncthreads();
            if (PK(8) && IN(p + 7)) { launder(F);
                pg8::Gemm g{(const bf16*)(F.ws + WS_H), (const bf16*)(F.ws + WS_W1) + (size_t)l * NEXP * 2048 * DM, (const int*)(F.ws + WS_SLOTTOK), DM};
                pg8::MoeOrder S; S.init(tb, 8, F.G, F.blk);
                pg8::EpiSwiglu E{(bf16*)(F.ws + WS_ACT), F.in[I_B1] + (size_t)l * NEXP * 2048};
                pg8::gemm_phase<pg8::EpiSwiglu, pg8::MoeOrder, true>(F.lds, g, S, E);
                SEAM(p + 7);
            }
            if (PK(9) && IN(p + 8)) { launder(F);
                pg8::Gemm g{(const bf16*)(F.ws + WS_ACT), (const bf16*)(F.ws + WS_W2) + (size_t)l * NEXP * DM * DM, nullptr, DM};
                pg8::MoeOrder S; S.init(tb, 4, F.G, F.blk);
                pg8::EpiY E{(bf16*)(F.ws + WS_Y), F.in[I_B2] + (size_t)l * NEXP * DM};
                pg8::gemm_phase<pg8::EpiY, pg8::MoeOrder, false>(F.lds, g, S, E);
                SEAM(p + 8);
            }
        }
    }
    if (PK(10) && IN(N_PHASES - 1)) { launder(F); } if (PK(10) && IN(N_PHASES - 1)) row_phase<true, false>(F, NLAYER, (const float*)(F.ws + WS_XA), F.out);
#undef IN
#undef SEAM
}

#ifndef MK_SPLIT
#define MK_SPLIT 0
#endif
extern "C" void kernel_launch(void* const* d_in, const int* in_sizes, int n_in, void* d_out, int out_size, void* d_ws, size_t ws_size, hipStream_t stream) {
    static int grid = 0;
    if (grid == 0) {
        if (n_in != 21 || in_sizes[0] != NTOK * DM || out_size != NTOK * DM || ws_size < WS_END) {
            fprintf(stderr, "kernel_launch: unexpected shapes: n_in %d in0 %d out %d ws %zu (need %zu)\n", n_in, n_in > 0 ? in_sizes[0] : -1, out_size, ws_size, (size_t)WS_END); grid = -1; return; }
        int dev = 0, cus = 0, per_cu = 0;
        if (hipGetDevice(&dev) != hipSuccess || hipDeviceGetAttribute(&cus, hipDeviceAttributeMultiprocessorCount, dev) != hipSuccess) { fprintf(stderr, "kernel_launch: device query failed\n"); grid = -1; return; }
        if (hipFuncSetAttribute((const void*)fwd_kernel, hipFuncAttributeMaxDynamicSharedMemorySize, LDS_BYTES) != hipSuccess) { fprintf(stderr, "kernel_launch: hipFuncSetAttribute failed\n"); grid = -1; return; }
        if (hipOccupancyMaxActiveBlocksPerMultiprocessor(&per_cu, (const void*)fwd_kernel, 512, LDS_BYTES) != hipSuccess || per_cu < 1) fprintf(stderr, "kernel_launch: note: occupancy query says %d\n", per_cu);
        (void)hipGetLastError();
        grid = cus;
    }
    if (grid < 0) return;
    (void)hipMemsetAsync((char*)d_ws + WS_CTL, 0, CTL_ZERO_BYTES, stream);
    Args a{};
    for (int i = 0; i < 21; ++i) a.in[i] = (const float*)d_in[i];
    a.out = (float*)d_out; a.ws = (unsigned char*)d_ws;
#if MK_SPLIT
    for (int ph = 0; ph < N_PHASES; ++ph) { a.ph_lo = ph; a.ph_hi = ph + 1; hipLaunchKernelGGL(fwd_kernel, dim3(grid), dim3(512), LDS_BYTES, stream, a); }
#else
    a.ph_lo = 0; a.ph_hi = N_PHASES; hipLaunchKernelGGL(fwd_kernel, dim3(grid), dim3(512), LDS_BYTES, stream, a);
#endif
}
```

```cpp
#include <hip/hip_runtime.h>
#include <cstdio>
#include <cstdint>

#define GAS __attribute__((address_space(1)))
#define LAS __attribute__((address_space(3)))
typedef unsigned short bf16;
typedef unsigned v4u __attribute__((ext_vector_type(4)));
typedef unsigned v2u __attribute__((ext_vector_type(2)));
typedef float f32x4 __attribute__((ext_vector_type(4)));
typedef float f32x2 __attribute__((ext_vector_type(2)));
typedef float f32x16 __attribute__((ext_vector_type(16)));
typedef short bf16x8 __attribute__((ext_vector_type(8)));
typedef _Float16 f16x8 __attribute__((ext_vector_type(8)));
typedef _Float16 f16x2 __attribute__((ext_vector_type(2)));

namespace pg8 {
constexpr int BM = 256, BK = 64, HALF = 128, HTB = HALF * BK * 2  , STAGE_BYTES = 8 * HTB, NXCD = 8, WGM = 8;

__host__ __device__ __forceinline__ int lds_byte(int r, int c) { const int st = (r >> 4) * 2 + (c >> 5), rr = r & 15, cc = c & 31, ob = rr * 64 + cc * 2; return st * 1024 + (ob ^ (((ob >> 9) & 1) << 5)); }
__host__ __device__ __forceinline__ void stage_rc(int b, int& R, int& C) { const int st = b / 1024, sb = b % 1024, swz = sb ^ (((sb >> 9) & 1) << 5); R = (st >> 1) * 16 + swz / 64; C = (st & 1) * 32 + (swz % 64) / 2; }
__host__ __device__ __forceinline__ int perm32(int rho) { const int n = rho >> 4, i = rho & 15; return 8 * (i >> 2) + 4 * n + (i & 3); }

struct Unit { int pm, pn, pb; };
struct Gemm { const bf16* A; const bf16* Bt; const int* rowmap; int K; };

__device__ __forceinline__ unsigned cvt_pk_bf16(float lo, float hi) { unsigned r; asm volatile("v_cvt_pk_bf16_f32 %0, %1, %2" : "=v"(r) : "v"(lo), "v"(hi)); return r; }

template <class Epi, class Sched, bool GATHER>
__device__ __forceinline__ void gemm_phase(LAS unsigned char* lds, const Gemm g, const Sched& S, const Epi& E) {
    int tid_ = threadIdx.x; asm volatile("" : "+v"(tid_));
    const int tid = tid_, wid = __builtin_amdgcn_readfirstlane(tid >> 6), lane = tid & 63, wr = wid >> 2, wc = wid & 3, fr = lane & 15, fq = lane >> 4;
    const int K = g.K, nt = K / BK;
    unsigned voffA[2], voffB[2]; int RA[2], CA[2];
#pragma unroll
    for (int i = 0; i < 2; ++i) { int R, C; stage_rc(tid * 16 + i * 8192, R, C); const int Rb = Epi::PERM ? ((R & ~31) + perm32(R & 31)) : R; RA[i] = R; CA[i] = C;
        voffA[i] = (unsigned)(R * K + C) * 2u; voffB[i] = (unsigned)(Rb * K + C) * 2u; }
    const size_t kstep = (size_t)(BK * 2);
    const size_t hstep = (size_t)HALF * K * 2;
    const size_t tstep = 2 * hstep;
    const unsigned ldsw = (unsigned)wid * 1024u;
    const int aoff = lds_byte(wr * 64 + fr, fq * 8), boff = lds_byte(wc * 32 + fr, fq * 8);
#define PG8_SA(b, h) (((b) * 2 + (h)) * HTB)
#define PG8_SB(b, h) ((4 + (b) * 2 + (h)) * HTB)
#define PG8_STAGE(bufoff, gbase, voff) do { _Pragma("unroll") for (int _i = 0; _i < 2; ++_i) \
        __builtin_amdgcn_global_load_lds((const unsigned*)((const char*)(gbase) + (voff)[_i]), (LAS unsigned*)(lds + (bufoff) + ldsw + _i * 8192), 16, 0, 0); } while (0)
#define PG8_STAGEA(bufoff, pbase, h, nx) do { if constexpr (GATHER) { _Pragma("unroll") for (int _i = 0; _i < 2; ++_i) \
        __builtin_amdgcn_global_load_lds((const unsigned*)((const char*)(pbase) + ((nx) ? gn[h][_i] : gc[h][_i])), (LAS unsigned*)(lds + (bufoff) + ldsw + _i * 8192), 16, 0, 0); } \
        else { PG8_STAGE(bufoff, (const char*)(pbase) + (h) * hstep, voffA); } } while (0)
#define PG8_LDA(dst, b, h) do { _Pragma("unroll") for (int m = 0; m < 4; ++m) _Pragma("unroll") for (int k = 0; k < 2; ++k) dst[m][k] = *(const LAS bf16x8*)(lds + PG8_SA(b, h) + aoff + m * 2048 + k * 1024); } while (0)
#define PG8_LDB(dst, b, h) do { _Pragma("unroll") for (int n = 0; n < 2; ++n) _Pragma("unroll") for (int k = 0; k < 2; ++k) dst[n][k] = *(const LAS bf16x8*)(lds + PG8_SB(b, h) + boff + n * 2048 + k * 1024); } while (0)
#define PG8_MMA(ai, bj, At, Bt) do { __builtin_amdgcn_s_setprio(1); _Pragma("unroll") for (int m = 0; m < 4; ++m) _Pragma("unroll") for (int n = 0; n < 2; ++n) _Pragma("unroll") for (int k = 0; k < 2; ++k) \
        acc[ai][bj][m][n] = __builtin_amdgcn_mfma_f32_16x16x32_bf16(Bt[n][k], At[m][k], acc[ai][bj][m][n], 0, 0, 0); __builtin_amdgcn_s_setprio(0); } while (0)
#define PG8_WAIT_V(n) asm volatile("s_waitcnt vmcnt(" #n ")" ::: "memory")
#define PG8_WAIT_L(n) asm volatile("s_waitcnt lgkmcnt(" #n ")" ::: "memory")
#define PG8_BAR __builtin_amdgcn_s_barrier()
#define PG8_SCHED __builtin_amdgcn_sched_barrier(0)
    Unit cur, nxt; int ui = 0;
    if (!S.next(0, cur)) return;
    f32x4 acc[2][2][4][2];
#pragma unroll
    for (int a = 0; a < 2; ++a)
#pragma unroll
        for (int b = 0; b < 2; ++b)
#pragma unroll
            for (int m = 0; m < 4; ++m)
#pragma unroll
                for (int n = 0; n < 2; ++n) acc[a][b][m][n] = (f32x4){0.f, 0.f, 0.f, 0.f};
    bf16x8 At[4][2], B0[2][2], B1[2][2];
    unsigned gc[2][2], gn[2][2];
    if constexpr (GATHER) {
#pragma unroll
        for (int h = 0; h < 2; ++h)
#pragma unroll
            for (int i = 0; i < 2; ++i) { gc[h][i] = (unsigned)(g.rowmap[cur.pm * BM + h * HALF + RA[i]] * K + CA[i]) * 2u; gn[h][i] = gc[h][i]; }
    } else { gc[0][0] = gc[0][1] = gc[1][0] = gc[1][1] = 0u; gn[0][0] = gn[0][1] = gn[1][0] = gn[1][1] = 0u; }
    const char* cA = GATHER ? (const char*)g.A : (const char*)g.A + (size_t)cur.pm * tstep; const char* cB = (const char*)g.Bt + (size_t)cur.pb * tstep;
    PG8_STAGE(PG8_SB(0, 0), cB, voffB); PG8_STAGE(PG8_SB(0, 1), cB + hstep, voffB); PG8_STAGEA(PG8_SA(0, 0), cA, 0, false); PG8_STAGEA(PG8_SA(0, 1), cA, 1, false);
    if (wr == 1) PG8_BAR;
    PG8_WAIT_V(2); PG8_BAR;
    PG8_STAGE(PG8_SB(1, 0), cB + kstep, voffB); PG8_STAGEA(PG8_SA(1, 0), cA + kstep, 0, false); PG8_STAGE(PG8_SB(1, 1), cB + hstep + kstep, voffB);
    PG8_WAIT_V(6); PG8_BAR;
    for (;;) {
        const bool has_next = S.next(ui + 1, nxt);
        if constexpr (GATHER) { if (has_next) {
#pragma unroll
            for (int h = 0; h < 2; ++h)
#pragma unroll
                for (int i = 0; i < 2; ++i) gn[h][i] = (unsigned)(g.rowmap[nxt.pm * BM + h * HALF + RA[i]] * K + CA[i]) * 2u; } }
        const char* nA = GATHER ? cA : (has_next ? (const char*)g.A + (size_t)nxt.pm * tstep : cA); const char* nB = has_next ? (const char*)g.Bt + (size_t)nxt.pb * tstep : cB;
        for (int t = 0; t < nt; t += 2) {
            const bool last = (t == nt - 2);
            const char* a1 = cA + (size_t)(t + 1) * kstep;
            const char* a2 = last ? nA : cA + (size_t)(t + 2) * kstep; const char* b2 = last ? nB : cB + (size_t)(t + 2) * kstep;
            const char* a3 = a2 + kstep; const char* b3 = b2 + kstep;
            PG8_LDB(B0, 0, 0); PG8_LDB(B1, 0, 1); PG8_SCHED; PG8_LDA(At, 0, 0); PG8_STAGEA(PG8_SA(1, 1), a1, 1, false);
            PG8_WAIT_V(8); PG8_WAIT_L(0); PG8_BAR; PG8_MMA(0, 0, At, B0); PG8_MMA(0, 1, At, B1); PG8_BAR; PG8_SCHED;
            PG8_LDA(At, 0, 1); PG8_STAGE(PG8_SB(0, 0), b2, voffB); PG8_STAGE(PG8_SB(0, 1), b2 + hstep, voffB); PG8_STAGEA(PG8_SA(0, 0), a2, 0, last);
            PG8_WAIT_V(8); PG8_WAIT_L(0); PG8_BAR; PG8_MMA(1, 0, At, B0); PG8_MMA(1, 1, At, B1); PG8_BAR; PG8_SCHED;
            PG8_LDB(B0, 1, 0); PG8_LDB(B1, 1, 1); PG8_SCHED; PG8_LDA(At, 1, 0); PG8_STAGEA(PG8_SA(0, 1), a2, 1, last);
            PG8_WAIT_V(8); PG8_WAIT_L(0); PG8_BAR; PG8_MMA(0, 0, At, B0); PG8_MMA(0, 1, At, B1); PG8_BAR; PG8_SCHED;
            PG8_LDA(At, 1, 1); PG8_STAGE(PG8_SB(1, 0), b3, voffB); PG8_STAGE(PG8_SB(1, 1), b3 + hstep, voffB); PG8_STAGEA(PG8_SA(1, 0), a3, 0, last);
            PG8_WAIT_V(8); PG8_WAIT_L(0); PG8_BAR; PG8_MMA(1, 0, At, B0); PG8_MMA(1, 1, At, B1); PG8_BAR; PG8_SCHED;
        }
        if (wr == 0) PG8_BAR;
        E(acc, cur, wr, wc, fr, fq);
        if (!has_next) break;
#pragma unroll
        for (int a = 0; a < 2; ++a)
#pragma unroll
            for (int b = 0; b < 2; ++b)
#pragma unroll
                for (int m = 0; m < 4; ++m)
#pragma unroll
                    for (int n = 0; n < 2; ++n) acc[a][b][m][n] = (f32x4){0.f, 0.f, 0.f, 0.f};
        cur = nxt; cA = nA; cB = nB; ++ui;
        if constexpr (GATHER) {
#pragma unroll
            for (int h = 0; h < 2; ++h)
#pragma unroll
                for (int i = 0; i < 2; ++i) gc[h][i] = gn[h][i]; }
        if (wr == 1) PG8_BAR;
    }
    PG8_WAIT_V(0);
    PG8_BAR;
#undef PG8_SA
#undef PG8_SB
#undef PG8_STAGE
#undef PG8_STAGEA
#undef PG8_LDA
#undef PG8_LDB
#undef PG8_MMA
#undef PG8_WAIT_V
#undef PG8_WAIT_L
#undef PG8_BAR
#undef PG8_SCHED
}
}
constexpr int DM = 1024, NB = 8, SEQ = 4096, NTOK = NB * SEQ, NLAYER = 2;
constexpr int NPROJ = 3072;
constexpr int D_IN = 3078;
constexpr int NEXP = 32, TOPK = 4;
constexpr int NSLOT_MAX = NTOK * TOPK + NEXP * 256;
constexpr int NTILE_MAX = NSLOT_MAX / 256;
constexpr int COL_CB = 0, COL_CC = 256, COL_CU = 512, COL_SQ = 768, COL_SK = 1152, COL_SV = 1536, COL_FQ = 1920, COL_FK = 2304, COL_FV = 2688;
constexpr float EPS = 1e-6f;
constexpr float LOG2E = 1.4426950408889634f;
constexpr float QSCALE = 0.125f * LOG2E;

namespace pg8 {
struct StaticOrder {
    int nM, nN, nwg, G, c;
    __device__ __forceinline__ void init(int M, int N, int G_, int c_) { nM = M / BM; nN = N / BM; nwg = nM * nN; G = G_; c = c_; }
    __device__ __forceinline__ bool next(int i, Unit& u) const {
        const long L = (long)i * G + c; if (L >= nwg) return false;
        int wgid = (int)L; { const int q = nwg / NXCD, r = nwg % NXCD, xcd = wgid % NXCD, off = wgid / NXCD; wgid = (xcd < r ? xcd * (q + 1) : r * (q + 1) + (xcd - r) * q) + off; }
        const int nig = WGM * nN, gid = wgid / nig, fm = gid * WGM, gsz = (nM - fm) < WGM ? (nM - fm) : WGM;
        u.pm = fm + ((wgid % nig) % gsz); u.pn = (wgid % nig) / gsz; u.pb = u.pn; return true;
    }
};
struct MoeOrder {
    int nM, nN, nwg, G, c; const LAS int* tb;
    __device__ __forceinline__ void init(const LAS int* tb_, int nN_, int G_, int c_) { tb = tb_; nM = tb_[NEXP]; nN = nN_; nwg = nM * nN; G = G_; c = c_; }
    __device__ __forceinline__ bool next(int i, Unit& u) const {
        const long L = (long)i * G + c; if (L >= nwg) return false;
        int wgid = (int)L; { const int q = nwg / NXCD, r = nwg % NXCD, xcd = wgid % NXCD, off = wgid / NXCD; wgid = (xcd < r ? xcd * (q + 1) : r * (q + 1) + (xcd - r) * q) + off; }
        const int nig = WGM * nN, gid = wgid / nig, fm = gid * WGM, gsz = (nM - fm) < WGM ? (nM - fm) : WGM;
        u.pm = fm + ((wgid % nig) % gsz); u.pn = (wgid % nig) / gsz;
        int e = 0;
#pragma unroll 1
        for (int j = 1; j < NEXP; ++j) e += (tb[j] <= u.pm) ? 1 : 0;
        u.pb = e * nN + u.pn; return true;
    }
};

struct EpiProj {
    static constexpr bool PERM = true;
    bf16* O; int ldc;
    __device__ __forceinline__ void operator()(const f32x4 (&acc)[2][2][4][2], const Unit& u, int wr, int wc, int fr, int fq) const {
        const int row0 = u.pm * BM + wr * 64 + fr, col0 = u.pn * BM + wc * 32 + 8 * fq;
#pragma unroll
        for (int ai = 0; ai < 2; ++ai)
#pragma unroll
            for (int m = 0; m < 4; ++m) { bf16* rowp = O + (size_t)(row0 + ai * HALF + m * 16) * ldc + col0;
#pragma unroll
                for (int bj = 0; bj < 2; ++bj) { const f32x4 v0 = acc[ai][bj][m][0], v1 = acc[ai][bj][m][1];
                    v4u w; w.x = cvt_pk_bf16(v0[0], v0[1]); w.y = cvt_pk_bf16(v0[2], v0[3]); w.z = cvt_pk_bf16(v1[0], v1[1]); w.w = cvt_pk_bf16(v1[2], v1[3]);
                    *(v4u*)(rowp + bj * HALF) = w; } }
    }
};
struct EpiResGate {
    static constexpr bool PERM = false;
    const float* base; float* out; const float* gbias; const float* gpart;
    __device__ __forceinline__ void operator()(const f32x4 (&acc)[2][2][4][2], const Unit& u, int wr, int wc, int fr, int fq) const {
        const int row0 = u.pm * BM + wr * 64 + fr, col0 = u.pn * BM + wc * 32 + 4 * fq; const int b = (u.pm * BM) / SEQ;
#pragma unroll
        for (int bj = 0; bj < 2; ++bj)
#pragma unroll
            for (int n = 0; n < 2; ++n) { const int c = col0 + bj * HALF + n * 16; f32x4 gv = *(const f32x4*)(gbias + c);
#pragma unroll
                for (int ks = 0; ks < 4; ++ks) gv += *(const f32x4*)(gpart + (size_t)(ks * NB + b) * 6144 + c);
#pragma unroll
                for (int ai = 0; ai < 2; ++ai)
#pragma unroll
                    for (int m = 0; m < 4; ++m) { const size_t off = (size_t)(row0 + ai * HALF + m * 16) * DM + c;
                        *(f32x4*)(out + off) = *(const f32x4*)(base + off) + gv * acc[ai][bj][m][n]; } }
    }
};
struct EpiSwiglu {
    static constexpr bool PERM = true;
    bf16* O; const float* b1;
    __device__ __forceinline__ void operator()(const f32x4 (&acc)[2][2][4][2], const Unit& u, int wr, int wc, int fr, int fq) const {
        const int row0 = u.pm * BM + wr * 64 + fr; const int e = u.pb >> 3; const int j0 = u.pn * 128 + wc * 32 + 8 * fq;
        const float* bp = b1 + (size_t)e * 2048 + 2 * j0;
        f32x4 bb[4];
#pragma unroll
        for (int q = 0; q < 4; ++q) bb[q] = *(const f32x4*)(bp + 4 * q);
        float bg[8], bl[8];
#pragma unroll
        for (int q = 0; q < 4; ++q) { bg[2 * q] = bb[q][0]; bl[2 * q] = bb[q][1]; bg[2 * q + 1] = bb[q][2]; bl[2 * q + 1] = bb[q][3]; }
#pragma unroll
        for (int ai = 0; ai < 2; ++ai)
#pragma unroll
            for (int m = 0; m < 4; ++m) { bf16* rowp = O + (size_t)(row0 + ai * HALF + m * 16) * DM + j0;
                float a[8];
#pragma unroll
                for (int n = 0; n < 2; ++n)
#pragma unroll
                    for (int i = 0; i < 4; ++i) { float gl = acc[ai][0][m][n][i] + bg[4 * n + i], li = acc[ai][1][m][n][i] + bl[4 * n + i];
                        gl = fminf(gl, 7.0f); li = fminf(fmaxf(li, -7.0f), 7.0f);
                        const float sg = __builtin_amdgcn_rcpf(1.0f + __builtin_amdgcn_exp2f(-1.702f * LOG2E * gl));
                        a[4 * n + i] = gl * sg * (li + 1.0f); }
                v4u w; w.x = cvt_pk_bf16(a[0], a[1]); w.y = cvt_pk_bf16(a[2], a[3]); w.z = cvt_pk_bf16(a[4], a[5]); w.w = cvt_pk_bf16(a[6], a[7]);
                *(v4u*)rowp = w; }
    }
};
struct EpiY {
    static constexpr bool PERM = true;
    bf16* O; const float* b2;
    __device__ __forceinline__ void operator()(const f32x4 (&acc)[2][2][4][2], const Unit& u, int wr, int wc, int fr, int fq) const {
        const int row0 = u.pm * BM + wr * 64 + fr; const int e = u.pb >> 2; const int col0 = u.pn * BM + wc * 32 + 8 * fq;
        f32x4 bv[2][2];
#pragma unroll
        for (int bj = 0; bj < 2; ++bj)
#pragma unroll
            for (int n = 0; n < 2; ++n) bv[bj][n] = *(const f32x4*)(b2 + (size_t)e * DM + col0 + bj * HALF + 4 * n);
#pragma unroll
        for (int ai = 0; ai < 2; ++ai)
#pragma unroll
            for (int m = 0; m < 4; ++m) { bf16* rowp = O + (size_t)(row0 + ai * HALF + m * 16) * DM + col0;
#pragma unroll
                for (int bj = 0; bj < 2; ++bj) { const f32x4 v0 = acc[ai][bj][m][0] + bv[bj][0], v1 = acc[ai][bj][m][1] + bv[bj][1];
                    v4u w; w.x = cvt_pk_bf16(v0[0], v0[1]); w.y = cvt_pk_bf16(v0[2], v0[3]); w.z = cvt_pk_bf16(v1[0], v1[1]); w.w = cvt_pk_bf16(v1[2], v1[3]);
                    *(v4u*)(rowp + bj * HALF) = w; } }
    }
};
}
namespace att {
constexpr int KROW = 144;
constexpr int TILE_B = 64 * KROW;
constexpr int OFF_K = 0, OFF_V = 2 * TILE_B, OFF_F = 4 * TILE_B, LDS_BYTES = OFF_F + 2 * 256;
__device__ __forceinline__ int pim(int m) { const int a = m >> 3, h = (m >> 2) & 1, b = m & 3; return 16 * (a >> 1) + 8 * h + 4 * (a & 1) + b; }
__device__ __forceinline__ unsigned pk_bf16(float lo, float hi) { unsigned r; asm volatile("v_cvt_pk_bf16_f32 %0, %1, %2" : "=v"(r) : "v"(lo), "v"(hi)); return r; }
__device__ __forceinline__ unsigned pk_f16(float lo, float hi) { return __builtin_bit_cast(unsigned, __builtin_amdgcn_cvt_pkrtz(lo, hi)); }

struct Tensors {
    const bf16* proj;
    const bf16* vt;
    const float* fcum;
    bf16* ymix;
    const float* ong;
    int colq, colk, coly;
};

template <int KIND>
__device__ __forceinline__ void unit(const Tensors& T, int b, int h, int qb, LAS unsigned char* lds) {
    int tid_ = threadIdx.x; asm volatile("" : "+v"(tid_));
    const int tid = tid_, lane = tid & 63, r32 = lane & 31, hi = lane >> 5; const int wid = __builtin_amdgcn_readfirstlane(tid >> 6);
    const int q0 = qb * 256, qw0 = q0 + wid * 32, qabs = qw0 + r32;
    const size_t rowbase = (size_t)b * SEQ;
    const int ktd = qw0 >> 6;
    const int kt_hi = (q0 + 255) >> 6;
    const int srow = tid >> 3, spc = tid & 7;
    const bf16* kg = T.proj + (rowbase + srow) * NPROJ + T.colk + h * 64 + spc * 8;
    const bf16* vg = T.vt + ((size_t)(b * 6 + h) * 64 + srow) * SEQ + spc * 8;
    const float* fg = T.fcum + (size_t)(b * 6 + h) * SEQ;
    const int sdst = srow * KROW + spc * 16;
    bf16x8 qf[4];
    { const bf16* qp = T.proj + (rowbase + qabs) * NPROJ + T.colq + h * 64 + hi * 8;
#pragma unroll
      for (int d0 = 0; d0 < 4; ++d0) qf[d0] = *(const bf16x8*)(qp + d0 * 16); }
    const int pm = pim(r32);
    const int koff = pm * KROW + hi * 16;
    f16x8 mtri0, mtri1, mones;
#pragma unroll
    for (int i = 0; i < 8; ++i) { mtri0[i] = (_Float16)((8 * hi + i > pm) ? 1.0f : 0.0f); mtri1[i] = (_Float16)((16 + 8 * hi + i > pm) ? 1.0f : 0.0f); mones[i] = (_Float16)1.0f; }
    f32x16 o0, o1;
#pragma unroll
    for (int r = 0; r < 16; ++r) { o0[r] = 0.f; o1[r] = 0.f; }
    float carry = (KIND == 1) ? -1e30f : 0.f;
    float lsum = 0.f;

    v4u kreg = *(const v4u*)(kg + (size_t)kt_hi * 64 * NPROJ), vreg = *(const v4u*)(vg + kt_hi * 64);
    float freg = 0.f; if (KIND == 1 && tid < 64) freg = fg[kt_hi * 64 + tid];
    *(LAS v4u*)(lds + OFF_K + sdst) = kreg; *(LAS v4u*)(lds + OFF_V + sdst) = vreg; if (KIND == 1 && tid < 64) *(LAS float*)(lds + OFF_F + tid * 4) = freg;
    __syncthreads();
    int buf = 0;
    for (int kt = kt_hi; kt >= 0; --kt) {
        if (kt > 0) { kreg = *(const v4u*)(kg + (size_t)(kt - 1) * 64 * NPROJ); vreg = *(const v4u*)(vg + (kt - 1) * 64); if (KIND == 1 && tid < 64) freg = fg[(kt - 1) * 64 + tid]; }
        if (kt <= ktd) {
            const LAS unsigned char* Kb = lds + OFF_K + buf * TILE_B; const LAS unsigned char* Vb = lds + OFF_V + buf * TILE_B;
            f32x16 p0, p1;
#pragma unroll
            for (int r = 0; r < 16; ++r) { p0[r] = 0.f; p1[r] = 0.f; }
#pragma unroll
            for (int d0 = 0; d0 < 4; ++d0) { const bf16x8 ka = *(const LAS bf16x8*)(Kb + koff + d0 * 32), kb2 = *(const LAS bf16x8*)(Kb + 32 * KROW + koff + d0 * 32);
                p0 = __builtin_amdgcn_mfma_f32_32x32x16_bf16(ka, qf[d0], p0, 0, 0, 0); p1 = __builtin_amdgcn_mfma_f32_32x32x16_bf16(kb2, qf[d0], p1, 0, 0, 0); }
            const bool diag = (kt == ktd);
            const int kbase = kt * 64 + 8 * hi;
            v4u wf0, wf1, wf2, wf3;
            if (KIND == 0) {
                float ls = 0.f; f32x16 l0, l1;
#pragma unroll
                for (int r = 0; r < 16; ++r) {
                    const int key = kbase + 16 * (r >> 3) + (r & 7);
                    float a = -__builtin_amdgcn_logf(1.0f + __builtin_amdgcn_exp2f(p0[r])); if (diag && !(key < qabs)) a = 0.f;
                    float c = -__builtin_amdgcn_logf(1.0f + __builtin_amdgcn_exp2f(p1[r])); if (diag && !(key + 32 < qabs)) c = 0.f;
                    ls += a + c; l0[r] = a; l1[r] = c; p0[r] += a; p1[r] += c; }
                v4u lf0, lf1, lf2, lf3;
#pragma unroll
                for (int j = 0; j < 4; ++j) { lf0[j] = pk_f16(l0[2 * j], l0[2 * j + 1]); lf1[j] = pk_f16(l0[8 + 2 * j], l0[9 + 2 * j]); lf2[j] = pk_f16(l1[2 * j], l1[2 * j + 1]); lf3[j] = pk_f16(l1[8 + 2 * j], l1[9 + 2 * j]); }
                f32x16 r0, r1;
#pragma unroll
                for (int r = 0; r < 16; ++r) { r0[r] = carry; r1[r] = carry; }
                r0 = __builtin_amdgcn_mfma_f32_32x32x16_f16(mtri0, __builtin_bit_cast(f16x8, lf0), r0, 0, 0, 0);
                r0 = __builtin_amdgcn_mfma_f32_32x32x16_f16(mtri1, __builtin_bit_cast(f16x8, lf1), r0, 0, 0, 0);
                r0 = __builtin_amdgcn_mfma_f32_32x32x16_f16(mones, __builtin_bit_cast(f16x8, lf2), r0, 0, 0, 0);
                r0 = __builtin_amdgcn_mfma_f32_32x32x16_f16(mones, __builtin_bit_cast(f16x8, lf3), r0, 0, 0, 0);
                r1 = __builtin_amdgcn_mfma_f32_32x32x16_f16(mtri0, __builtin_bit_cast(f16x8, lf2), r1, 0, 0, 0);
                r1 = __builtin_amdgcn_mfma_f32_32x32x16_f16(mtri1, __builtin_bit_cast(f16x8, lf3), r1, 0, 0, 0);
#pragma unroll
                for (int r = 0; r < 16; ++r) {
                    const int key = kbase + 16 * (r >> 3) + (r & 7);
                    float a = __builtin_amdgcn_exp2f(p0[r] + r0[r]); if (diag && !(key < qabs)) a = 0.f;
                    float c = __builtin_amdgcn_exp2f(p1[r] + r1[r]); if (diag && !(key + 32 < qabs)) c = 0.f;
                    p0[r] = a; p1[r] = c; }
                ls += __shfl_xor(ls, 32);
                carry += ls;
            } else {
                const LAS float* Fb = (const LAS float*)(lds + OFF_F + buf * 256) + 8 * hi;
                float mx = -1e30f;
#pragma unroll
                for (int g = 0; g < 2; ++g) {
                    const f32x4 fa = *(const LAS f32x4*)(Fb + 16 * g), fb = *(const LAS f32x4*)(Fb + 16 * g + 4), fc = *(const LAS f32x4*)(Fb + 32 + 16 * g), fd = *(const LAS f32x4*)(Fb + 32 + 16 * g + 4);
#pragma unroll
                    for (int i = 0; i < 8; ++i) { const int r = 8 * g + i; const int key = kbase + 16 * g + i;
                        float a = p0[r] - (i < 4 ? fa[i & 3] : fb[i & 3]); if (diag && key > qabs) a = -1e30f;
                        float c = p1[r] - (i < 4 ? fc[i & 3] : fd[i & 3]); if (diag && key + 32 > qabs) c = -1e30f;
                        p0[r] = a; p1[r] = c; mx = fmaxf(mx, fmaxf(a, c)); } }
                mx = fmaxf(mx, __shfl_xor(mx, 32));
                const float mnew = fmaxf(carry, mx), alpha = __builtin_amdgcn_exp2f(carry - mnew); carry = mnew;
                float ps = 0.f;
#pragma unroll
                for (int r = 0; r < 16; ++r) { const float a = __builtin_amdgcn_exp2f(p0[r] - mnew), c = __builtin_amdgcn_exp2f(p1[r] - mnew); ps += a + c; p0[r] = a; p1[r] = c; }
                ps += __shfl_xor(ps, 32);
                lsum = lsum * alpha + ps;
#pragma unroll
                for (int r = 0; r < 16; ++r) { o0[r] *= alpha; o1[r] *= alpha; }
            }
#pragma unroll
            for (int j = 0; j < 4; ++j) { wf0[j] = pk_bf16(p0[2 * j], p0[2 * j + 1]); wf1[j] = pk_bf16(p0[8 + 2 * j], p0[9 + 2 * j]); wf2[j] = pk_bf16(p1[2 * j], p1[2 * j + 1]); wf3[j] = pk_bf16(p1[8 + 2 * j], p1[9 + 2 * j]); }
#pragma unroll
            for (int c = 0; c < 4; ++c) {
                const bf16x8 va = *(const LAS bf16x8*)(Vb + koff + c * 32), vb2 = *(const LAS bf16x8*)(Vb + 32 * KROW + koff + c * 32);
                const bf16x8 wb = __builtin_bit_cast(bf16x8, c == 0 ? wf0 : c == 1 ? wf1 : c == 2 ? wf2 : wf3);
                o0 = __builtin_amdgcn_mfma_f32_32x32x16_bf16(va, wb, o0, 0, 0, 0); o1 = __builtin_amdgcn_mfma_f32_32x32x16_bf16(vb2, wb, o1, 0, 0, 0); }
        }
        if (kt > 0) { const int nb = (buf ^ 1) * TILE_B; *(LAS v4u*)(lds + OFF_K + nb + sdst) = kreg; *(LAS v4u*)(lds + OFF_V + nb + sdst) = vreg;
            if (KIND == 1 && tid < 64) *(LAS float*)(lds + OFF_F + (buf ^ 1) * 256 + tid * 4) = freg; }
        __syncthreads();
        buf ^= 1;
    }
    if (KIND == 1) { const float inv = 1.0f / lsum;
#pragma unroll
        for (int r = 0; r < 16; ++r) { o0[r] *= inv; o1[r] *= inv; } }
    float ss = 0.f;
#pragma unroll
    for (int r = 0; r < 16; ++r) ss += o0[r] * o0[r] + o1[r] * o1[r];
    ss += __shfl_xor(ss, 32);
    const float rinv = 1.0f / sqrtf(ss * (1.0f / 64.0f) + EPS);
    const float* gp = T.ong + T.coly + h * 64 + 8 * hi;
    bf16* yp = T.ymix + (rowbase + qabs) * DM + T.coly + h * 64 + 8 * hi;
#pragma unroll
    for (int d0 = 0; d0 < 2; ++d0)
#pragma unroll
        for (int g = 0; g < 2; ++g) { const f32x4 ga = *(const f32x4*)(gp + 32 * d0 + 16 * g), gb = *(const f32x4*)(gp + 32 * d0 + 16 * g + 4);
            float v[8];
#pragma unroll
            for (int i = 0; i < 8; ++i) v[i] = (d0 == 0 ? o0[8 * g + i] : o1[8 * g + i]) * rinv * (i < 4 ? ga[i & 3] : gb[i & 3]);
            v4u w; w.x = pk_bf16(v[0], v[1]); w.y = pk_bf16(v[2], v[3]); w.z = pk_bf16(v[4], v[5]); w.w = pk_bf16(v[6], v[7]);
            *(v4u*)(yp + 32 * d0 + 16 * g) = w; }
}
}
constexpr size_t MiB = 1u << 20;
constexpr size_t WS_CTL = 0, CTL_ZERO_BYTES = 1 * MiB;
constexpr size_t WS_MODP = 1 * MiB;
constexpr size_t WS_TOPW = 3 * MiB;
constexpr size_t WS_ROUTE = WS_TOPW + 512 * 1024;
constexpr size_t WS_TOKSLOT = WS_ROUTE + 512 * 1024;
constexpr size_t WS_SLOTTOK = WS_TOKSLOT + 512 * 1024;
constexpr size_t WS_HIST = WS_SLOTTOK + 576 * 1024;
constexpr size_t WS_MOETAB = WS_HIST + 32 * 1024;
constexpr size_t WS_LOGF = 6 * MiB;
constexpr size_t WS_FCUM = 7 * MiB;
constexpr size_t WS_WIN = 8 * MiB, WS_WOUT = 20 * MiB, WS_W1 = 24 * MiB, WS_W2 = 280 * MiB;
constexpr size_t WS_H = 408 * MiB;
constexpr size_t WS_PROJ = 472 * MiB;
constexpr size_t WS_VT = 664 * MiB;
constexpr size_t WS_YMIX = 712 * MiB;
constexpr size_t WS_XA = 776 * MiB, WS_XB = 904 * MiB;
constexpr size_t WS_ACT = 1032 * MiB, WS_Y = 1304 * MiB, WS_END = 1576 * MiB;
static_assert(WS_MOETAB + 256 <= WS_LOGF && (size_t)NSLOT_MAX * 4 <= 576 * 1024 && (size_t)NSLOT_MAX * DM * 2 <= 272 * MiB, "ws map");
constexpr int CW_BAR = 4096;

constexpr int RING_BYTES = 131072;
constexpr int MISC_OFF = RING_BYTES;
constexpr int LDS_BYTES = 147456;

#define RLX_AGENT __ATOMIC_RELAXED, __HIP_MEMORY_SCOPE_AGENT
__device__ __forceinline__ unsigned f2bf(float f) { unsigned u = __builtin_bit_cast(unsigned, f); return (u + 0x7fffu + ((u >> 16) & 1u)) >> 16; }
__device__ __forceinline__ unsigned pk2(float lo, float hi) { return f2bf(lo) | (f2bf(hi) << 16); }
__device__ __forceinline__ float bflo(unsigned u) { return __builtin_bit_cast(float, u << 16); }
__device__ __forceinline__ float bfhi(unsigned u) { return __builtin_bit_cast(float, u & 0xffff0000u); }
__device__ __forceinline__ float wave_sum(float v) {
#pragma unroll
    for (int o = 1; o < 64; o <<= 1) v += __shfl_xor(v, o);
    return v;
}

#define XB_TMO      128
#define XB_XCNT(j)  (256  + 64 * (j))
#define XB_XSUB(j)  (1280 + 64 * (j))
#define XB_XGEN(j)  (2304 + 64 * (j))
#define XB_TOP      3328
#define XB_TOPGEN   3392
#define XCD_BAR_WORDS 3456
#define XB_SPIN_CAP (1u << 18)
__device__ __forceinline__ unsigned xb_ld(unsigned* p)              { return __hip_atomic_load(p, __ATOMIC_RELAXED, __HIP_MEMORY_SCOPE_AGENT); }
__device__ __forceinline__ unsigned xb_add(unsigned* p, unsigned v) { return __hip_atomic_fetch_add(p, v, __ATOMIC_RELAXED, __HIP_MEMORY_SCOPE_AGENT); }
__device__ __forceinline__ unsigned xb_xcc_id() { return (unsigned)__builtin_amdgcn_s_getreg((3 << 11) | 20) & 0xFu; }
#define XB_SPIN(cond, bar) do { unsigned _sp = 0; while (cond) { __builtin_amdgcn_s_sleep(1); \
    if ((++_sp & 255u) == 0u) { if (xb_ld(&(bar)[XB_TMO])) break; if (_sp > XB_SPIN_CAP) { atomicAdd(&(bar)[XB_TMO], 1u); break; } } } } while (0)
struct XcdBarrier { unsigned* bar; unsigned x; volatile LAS unsigned* st; };
__device__ __forceinline__ XcdBarrier xcd_barrier_post(unsigned* bar, volatile LAS unsigned* st) {
    XcdBarrier b; b.bar = bar; b.x = xb_xcc_id(); b.st = st;
    if (threadIdx.x == 0) (void)xb_add(&bar[XB_XCNT(b.x)], 1u);
    return b;
}
__device__ __forceinline__ void xcd_barrier_complete(unsigned* bar, unsigned x, unsigned& nloc, unsigned& nx) {
    const unsigned G = gridDim.x * gridDim.y * gridDim.z;
    unsigned sum, cnt, mine, sp = 0u;
    for (;;) {
        sum = 0u; cnt = 0u; mine = 0u;
#pragma unroll
        for (unsigned j = 0; j < 16; ++j) { const unsigned c = xb_ld(&bar[XB_XCNT(j)]); sum += c; cnt += (c > 0u) ? 1u : 0u; mine = (j == x) ? c : mine; }
        if (sum == G) break;
        __builtin_amdgcn_s_sleep(1);
        if ((++sp & 255u) == 0u) { if (xb_ld(&bar[XB_TMO])) break; if (sp > XB_SPIN_CAP) { atomicAdd(&bar[XB_TMO], 1u); break; } }
    }
    nloc = mine > 0u ? mine : 1u; nx = cnt > 0u ? cnt : 1u;
}
__device__ __forceinline__ void xcd_barrier(const XcdBarrier& b) {
    asm volatile("s_waitcnt vmcnt(0)" ::: "memory");
    __syncthreads();
    if (threadIdx.x == 0) {
        unsigned* bar = b.bar;
        __builtin_amdgcn_s_waitcnt(0);
        unsigned nloc = b.st[0], nx = b.st[1];
        if (nloc == 0u) { xcd_barrier_complete(bar, b.x, nloc, nx); b.st[0] = nloc; b.st[1] = nx; }
        const unsigned old = xb_add(&bar[XB_XSUB(b.x)], 1u);
        const unsigned gen = old / nloc;
        if (old + 1u == (gen + 1u) * nloc) {
            __builtin_amdgcn_fence(__ATOMIC_RELEASE, "agent");
            asm volatile("s_waitcnt vmcnt(0)" ::: "memory");
            const unsigned og = xb_add(&bar[XB_TOP], 1u);
            const unsigned tg = og / nx;
            if (og + 1u == (tg + 1u) * nx) xb_add(&bar[XB_TOPGEN], 1u);
            else XB_SPIN(xb_ld(&bar[XB_TOPGEN]) == tg, bar);
            __builtin_amdgcn_fence(__ATOMIC_ACQUIRE, "agent");
            xb_add(&bar[XB_XGEN(b.x)], 1u);
            asm volatile("s_waitcnt vmcnt(0)" ::: "memory");
        } else {
            XB_SPIN(xb_ld(&bar[XB_XGEN(b.x)]) == gen, bar);
            __builtin_amdgcn_fence(__ATOMIC_ACQUIRE, "agent");
            asm volatile("s_waitcnt vmcnt(0)" ::: "memory");
        }
    }
    __syncthreads();
}

struct Frame {
    LAS unsigned char* lds;
    int tid, lane, wave, blk, G;
    const float* in[21];
    float* out; unsigned char* ws;
};
enum { I_X = 0, I_C, I_N1G, I_WADA, I_BADA, I_WIN, I_CONVW, I_SBQG, I_SBKG, I_FXQG, I_FXKG, I_FXFB, I_ONG, I_WOUT, I_N2G, I_RW, I_RB, I_W1, I_B1, I_W2, I_B2 };

template <int MAP>
__device__ __forceinline__ void p0_transpose_item(const float* W, int ldw, bf16* WT, LAS float* scr, int k0, int n0, int lane) {
#pragma unroll 8
    for (int i = 0; i < 32; ++i) { const int kk = 2 * i + (lane >> 5); scr[kk * 33 + (lane & 31)] = W[(size_t)(k0 + kk) * ldw + n0 + (lane & 31)]; }
    asm volatile("s_waitcnt lgkmcnt(0)" ::: "memory");
    const int c = lane & 7;
#pragma unroll
    for (int j = 0; j < 4; ++j) { const int n = (lane >> 3) + 8 * j; const LAS float* s = scr + (8 * c) * 33 + n;
        v4u o; o.x = pk2(s[0 * 33], s[1 * 33]); o.y = pk2(s[2 * 33], s[3 * 33]); o.z = pk2(s[4 * 33], s[5 * 33]); o.w = pk2(s[6 * 33], s[7 * 33]);
        const int cn = n0 + n; int row = cn;
        if (MAP == 1) { const int jj = cn >> 1, t = cn & 1; row = 256 * (jj >> 7) + 128 * t + (jj & 127); }
        *(v4u*)(WT + (size_t)row * 1024 + k0 + 8 * c) = o; }
    asm volatile("s_waitcnt lgkmcnt(0)" ::: "memory");
}
__device__ __forceinline__ void p0_prologue(Frame& F) {
    LAS float* scr = (LAS float*)(F.lds + F.wave * 16384);
    const int gw = F.blk * 8 + F.wave, NGW = F.G * 8;
    for (int it = gw; it < NLAYER * 4 * 24; it += NGW) {
        const int l = it / 96, ks = (it / 24) & 3, nc = it % 24;
        const float* W = F.in[I_WADA] + (size_t)l * DM * 6144 + nc * 256 + F.lane * 4;
        const float* c = F.in[I_C];
        f32x4 acc[NB];
#pragma unroll
        for (int b = 0; b < NB; ++b) acc[b] = (f32x4){0.f, 0.f, 0.f, 0.f};
#pragma unroll 4
        for (int k = ks * 256; k < ks * 256 + 256; ++k) {
            const f32x4 w = *(const f32x4*)(W + (size_t)k * 6144);
#pragma unroll
            for (int b = 0; b < NB; ++b) { const float cv = c[b * DM + k]; const float s = cv / (1.0f + __expf(-cv)); acc[b] += w * s; }
        }
        float* dst = (float*)(F.ws + WS_MODP) + ((size_t)(l * 4 + ks) * NB) * 6144 + nc * 256 + F.lane * 4;
#pragma unroll
        for (int b = 0; b < NB; ++b) *(f32x4*)(dst + (size_t)b * 6144) = acc[b];
    }
    constexpr int I_IN = 16 * 96, I_OUT = 16 * 32, I_1 = 16 * 64, I_2 = 16 * 32;
    constexpr int N_IN = NLAYER * I_IN, N_OUT = NLAYER * I_OUT, N_1 = NLAYER * NEXP * I_1, N_2 = NLAYER * NEXP * I_2;
    for (int it = gw; it < N_IN + N_OUT + N_1 + N_2; it += NGW) {
        int r = it;
        if (r < N_IN) { const int l = r / I_IN, q = r % I_IN, kb = q / 96, nb = q % 96;
            p0_transpose_item<0>(F.in[I_WIN] + (size_t)l * DM * D_IN, D_IN, (bf16*)(F.ws + WS_WIN) + (size_t)l * NPROJ * DM, scr, 64 * kb, 32 * nb, F.lane); continue; }
        r -= N_IN;
        if (r < N_OUT) { const int l = r / I_OUT, q = r % I_OUT, kb = q / 32, nb = q % 32;
            p0_transpose_item<0>(F.in[I_WOUT] + (size_t)l * DM * DM, DM, (bf16*)(F.ws + WS_WOUT) + (size_t)l * DM * DM, scr, 64 * kb, 32 * nb, F.lane); continue; }
        r -= N_OUT;
        if (r < N_1) { const int le = r / I_1, q = r % I_1, kb = q / 64, nb = q % 64;
            p0_transpose_item<1>(F.in[I_W1] + (size_t)le * DM * 2048, 2048, (bf16*)(F.ws + WS_W1) + (size_t)le * 2048 * DM, scr, 64 * kb, 32 * nb, F.lane); continue; }
        r -= N_1;
        { const int le = r / I_2, q = r % I_2, kb = q / 32, nb = q % 32;
            p0_transpose_item<0>(F.in[I_W2] + (size_t)le * DM * DM, DM, (bf16*)(F.ws + WS_W2) + (size_t)le * DM * DM, scr, 64 * kb, 32 * nb, F.lane); }
    }
}

__device__ __forceinline__ f32x4 mod4(const Frame& F, int l, int b, int which, int c) {
    const int n = which * DM + c;
    f32x4 s = *(const f32x4*)(F.in[I_BADA] + (size_t)l * 6144 + n);
    const float* p = (const float*)(F.ws + WS_MODP) + ((size_t)(l * 4) * NB + b) * 6144 + n;
#pragma unroll
    for (int ks = 0; ks < 4; ++ks) s += *(const f32x4*)(p + (size_t)ks * NB * 6144);
    return s;
}

template <bool COMBINE, bool NORM>
__device__ __forceinline__ void row_phase(Frame& F, int l, const float* xsrc, float* xdst) {
    const float* topw = (const float*)(F.ws + WS_TOPW); const int* tokslot = (const int*)(F.ws + WS_TOKSLOT); const bf16* Y = (const bf16*)(F.ws + WS_Y);
    bf16* H = (bf16*)(F.ws + WS_H); float* logf = (float*)(F.ws + WS_LOGF);
    LAS float* wl = (LAS float*)F.lds;
    if (NORM) { for (int i = F.tid; i < DM * 6; i += 512) { const int k = i / 6, q = i % 6; wl[k * 8 + q] = F.in[I_WIN][(size_t)l * DM * D_IN + (size_t)k * D_IN + NPROJ + q]; }
        __syncthreads(); }
    for (int chunk = F.blk; chunk < NTOK / 128; chunk += F.G) {
        const int b = chunk / (SEQ / 128);
        f32x4 g2[4], A[4], Bv[4];
#pragma unroll
        for (int j = 0; j < 4; ++j) { const int c = 256 * j + 4 * F.lane;
            if (COMBINE) g2[j] = mod4(F, l - 1, b, 5, c);
            if (NORM) { const f32x4 g = *(const f32x4*)(F.in[I_N1G] + (size_t)l * DM + c); A[j] = g * (mod4(F, l, b, 1, c) + 1.0f); Bv[j] = mod4(F, l, b, 0, c); } }
#pragma unroll 1
        for (int rr = 0; rr < 16; ++rr) {
            const int row = chunk * 128 + F.wave + 8 * rr;
            f32x4 v[4];
#pragma unroll
            for (int j = 0; j < 4; ++j) v[j] = *(const f32x4*)(xsrc + (size_t)row * DM + 256 * j + 4 * F.lane);
            if (COMBINE) {
                f32x4 s[4];
#pragma unroll
                for (int j = 0; j < 4; ++j) s[j] = (f32x4){0.f, 0.f, 0.f, 0.f};
#pragma unroll
                for (int k = 0; k < TOPK; ++k) { const float w = topw[row * 4 + k]; const int slot = tokslot[row * 4 + k];
#pragma unroll
                    for (int j = 0; j < 4; ++j) { const v2u yv = *(const v2u*)(Y + (size_t)slot * DM + 256 * j + 4 * F.lane);
                        s[j] += (f32x4){bflo(yv.x), bfhi(yv.x), bflo(yv.y), bfhi(yv.y)} * w; } }
#pragma unroll
                for (int j = 0; j < 4; ++j) { v[j] += g2[j] * s[j]; *(f32x4*)(xdst + (size_t)row * DM + 256 * j + 4 * F.lane) = v[j]; }
            }
            if (NORM) {
                float ss = 0.f;
#pragma unroll
                for (int j = 0; j < 4; ++j) ss += (v[j].x * v[j].x + v[j].y * v[j].y) + (v[j].z * v[j].z + v[j].w * v[j].w);
                const float rstd = 1.0f / sqrtf(wave_sum(ss) * (1.0f / DM) + EPS);
                float fl[6] = {0.f, 0.f, 0.f, 0.f, 0.f, 0.f};
                int woff = 4 * F.lane; asm volatile("" : "+v"(woff));
#pragma unroll
                for (int j = 0; j < 4; ++j) { const f32x4 hv = v[j] * rstd * A[j] + Bv[j];
                    v2u o; o.x = pk2(hv.x, hv.y); o.y = pk2(hv.z, hv.w); *(v2u*)(H + (size_t)row * DM + 256 * j + 4 * F.lane) = o;
#pragma unroll
                    for (int i = 0; i < 4; ++i) { const LAS float* wp = wl + (256 * j + woff + i) * 8; const f32x4 wa = *(const LAS f32x4*)wp; const f32x2 wb = *(const LAS f32x2*)(wp + 4); const float hx = hv[i];
                        fl[0] += hx * wa.x; fl[1] += hx * wa.y; fl[2] += hx * wa.z; fl[3] += hx * wa.w; fl[4] += hx * wb.x; fl[5] += hx * wb.y; } }
#pragma unroll
                for (int q = 0; q < 6; ++q) fl[q] = wave_sum(fl[q]);
                if (F.lane < 6) { float z = fl[0];
#pragma unroll
                    for (int q = 1; q < 6; ++q) z = (F.lane == q) ? fl[q] : z;
                    z += F.in[I_FXFB][l * 6 + F.lane];
                    logf[(size_t)row * 6 + F.lane] = fminf(z, 0.f) - __logf(1.0f + __expf(-fabsf(z))); }
            }
        }
    }
    __syncthreads();
}
__device__ __forceinline__ void p3_postproj(Frame& F, int l) {
    bf16* proj = (bf16*)(F.ws + WS_PROJ); bf16* ymix = (bf16*)(F.ws + WS_YMIX);
    const float* ong = F.in[I_ONG] + (size_t)l * DM;
    const int c4 = 4 * F.lane;
    f32x4 cw[3];
#pragma unroll
    for (int w = 0; w < 3; ++w) cw[w] = *(const f32x4*)(F.in[I_CONVW] + (size_t)(l * 3 + w) * 256 + c4);
    const f32x4 cg = *(const f32x4*)(ong + c4);
    const int e0 = 8 * (F.lane & 7);
    float gq[3][8]; int colv[3];
#pragma unroll
    for (int i = 0; i < 3; ++i) { const int vi = 8 * i + (F.lane >> 3); const int ty = vi / 6;
        colv[i] = (vi < 12 ? COL_SQ + 64 * vi : COL_FQ + 64 * (vi - 12)) + e0;
        const float* gp = (ty == 0 ? F.in[I_SBQG] : ty == 1 ? F.in[I_SBKG] : ty == 2 ? F.in[I_FXQG] : F.in[I_FXKG]) + (size_t)l * 64 + e0; const float sc = (ty == 0 || ty == 2) ? QSCALE : 1.0f;
#pragma unroll
        for (int q = 0; q < 8; ++q) gq[i][q] = gp[q] * sc; }
    LAS unsigned char* scr = F.lds + F.wave * (64 * 144);
    for (int tile = F.blk; tile < NTOK / 64; tile += F.G) {
        const int b = tile / (SEQ / 64), s0 = (tile % (SEQ / 64)) * 64; const size_t row0 = (size_t)b * SEQ + s0;
        for (int tt = 0; tt < 8; ++tt) {
            const int s = s0 + F.wave * 8 + tt; const size_t row = (size_t)b * SEQ + s; bf16* pr = proj + row * NPROJ;
            f32x4 vv[3];
#pragma unroll
            for (int w = 0; w < 3; ++w) { const int sw = s - 2 + w;
                if (sw >= 0) { const bf16* pw = proj + ((size_t)b * SEQ + sw) * NPROJ; const v2u cc = *(const v2u*)(pw + COL_CC + c4), cu = *(const v2u*)(pw + COL_CU + c4);
                    vv[w] = (f32x4){bflo(cc.x) * bflo(cu.x), bfhi(cc.x) * bfhi(cu.x), bflo(cc.y) * bflo(cu.y), bfhi(cc.y) * bfhi(cu.y)}; }
                else vv[w] = (f32x4){0.f, 0.f, 0.f, 0.f}; }
            const v2u cb = *(const v2u*)(pr + COL_CB + c4);
            f32x4 y = cw[0] * vv[0] + cw[1] * vv[1] + cw[2] * vv[2];
            y = y * (f32x4){bflo(cb.x), bfhi(cb.x), bflo(cb.y), bfhi(cb.y)};
            float ss = (y.x * y.x + y.y * y.y) + (y.z * y.z + y.w * y.w);
            ss += __shfl_xor(ss, 1); ss += __shfl_xor(ss, 2); ss += __shfl_xor(ss, 4); ss += __shfl_xor(ss, 8);
            const float rinv = 1.0f / sqrtf(ss * (1.0f / 64.0f) + EPS);
            y = y * rinv * cg;
            v2u o; o.x = pk2(y.x, y.y); o.y = pk2(y.z, y.w); *(v2u*)(ymix + row * DM + c4) = o;
#pragma unroll
            for (int i = 0; i < 3; ++i) { const v4u x = *(const v4u*)(pr + colv[i]);
                float f[8] = {bflo(x.x), bfhi(x.x), bflo(x.y), bfhi(x.y), bflo(x.z), bfhi(x.z), bflo(x.w), bfhi(x.w)};
                float q2 = 0.f;
#pragma unroll
                for (int q = 0; q < 8; ++q) q2 += f[q] * f[q];
                q2 += __shfl_xor(q2, 1); q2 += __shfl_xor(q2, 2); q2 += __shfl_xor(q2, 4);
                const float ri = 1.0f / sqrtf(q2 * (1.0f / 64.0f) + EPS);
                v4u w; w.x = pk2(f[0] * ri * gq[i][0], f[1] * ri * gq[i][1]); w.y = pk2(f[2] * ri * gq[i][2], f[3] * ri * gq[i][3]);
                w.z = pk2(f[4] * ri * gq[i][4], f[5] * ri * gq[i][5]); w.w = pk2(f[6] * ri * gq[i][6], f[7] * ri * gq[i][7]);
                *(v4u*)(pr + colv[i]) = w; }
        }
        for (int t = F.wave; t < 12; t += 8) {
            const int kind = t / 6, h = t % 6; const int col = (kind ? COL_FV : COL_SV) + 64 * h;
            const bf16* src = proj + (row0 + F.lane) * NPROJ + col;
#pragma unroll
            for (int pc = 0; pc < 8; ++pc) { const v4u x = *(const v4u*)(src + 8 * pc);
                const unsigned xs[4] = {x.x, x.y, x.z, x.w};
#pragma unroll
                for (int q = 0; q < 4; ++q) { *(LAS unsigned short*)(scr + (8 * pc + 2 * q) * 144 + 2 * F.lane) = (unsigned short)(xs[q] & 0xffffu);
                                              *(LAS unsigned short*)(scr + (8 * pc + 2 * q + 1) * 144 + 2 * F.lane) = (unsigned short)(xs[q] >> 16); } }
            asm volatile("s_waitcnt lgkmcnt(0)" ::: "memory");
            bf16* dst = (bf16*)(F.ws + WS_VT) + (size_t)kind * (48 * 64 * SEQ) + ((size_t)(b * 6 + h) * 64 + F.lane) * SEQ + s0;
#pragma unroll
            for (int pc = 0; pc < 8; ++pc) *(v4u*)(dst + 8 * pc) = *(const LAS v4u*)(scr + F.lane * 144 + 16 * pc);
            asm volatile("s_waitcnt lgkmcnt(0)" ::: "memory");
        }
    }
    for (int sq = F.blk * 8 + F.wave; sq < NB * 6; sq += F.G * 8) {
        const int b = sq / 6, h = sq % 6; const float* lf = (const float*)(F.ws + WS_LOGF) + ((size_t)b * SEQ + 64 * F.lane) * 6 + h;
        float tot = 0.f;
        for (int i = 0; i < 64; ++i) tot += lf[(size_t)i * 6];
        float inc = tot;
#pragma unroll
        for (int o = 1; o < 64; o <<= 1) { const float t = __shfl_up(inc, o); if (F.lane >= o) inc += t; }
        float run = inc - tot; float* fo = (float*)(F.ws + WS_FCUM) + (size_t)sq * SEQ + 64 * F.lane;
        for (int i = 0; i < 64; ++i) { run += lf[(size_t)i * 6]; fo[i] = run * LOG2E; }
    }
}

__device__ __forceinline__ void p4_attention(Frame& F, int l) {
    att::Tensors Ts, Tf;
    Ts.proj = (const bf16*)(F.ws + WS_PROJ); Ts.vt = (const bf16*)(F.ws + WS_VT); Ts.fcum = (const float*)(F.ws + WS_FCUM); Ts.ymix = (bf16*)(F.ws + WS_YMIX); Ts.ong = F.in[I_ONG] + (size_t)l * DM;
    Ts.colq = COL_SQ; Ts.colk = COL_SK; Ts.coly = 256;
    Tf = Ts; Tf.vt = Ts.vt + (size_t)48 * 64 * SEQ; Tf.colq = COL_FQ; Tf.colk = COL_FK; Tf.coly = 640;
    const int NU = 2 * 48 * 16;
    for (int i = 0;; ++i) {
        const int L = (i & 1) ? (i + 1) * F.G - 1 - F.blk : i * F.G + F.blk;
        if (i * F.G >= NU) break;
        if (L >= NU) continue;
        const int qb = 15 - L / 96, j = L % 96, kind = j / 48, bh = j % 48;
        if (kind == 0) att::unit<0>(Ts, bh / 6, bh % 6, qb, F.lds); else att::unit<1>(Tf, bh / 6, bh % 6, qb, F.lds);
    }
}

__device__ __forceinline__ void top4of8(const float (&v)[8], const int (&ix)[8], float (&tv)[4], int (&ti)[4]) {
    float w[8];
#pragma unroll
    for (int j = 0; j < 8; ++j) w[j] = v[j];
#pragma unroll
    for (int k = 0; k < 4; ++k) { float bv = w[0]; int bi = ix[0];
#pragma unroll
        for (int j = 1; j < 8; ++j) { const bool t = (w[j] > bv) || (w[j] == bv && ix[j] < bi); bv = t ? w[j] : bv; bi = t ? ix[j] : bi; }
        tv[k] = bv; ti[k] = bi;
#pragma unroll
        for (int j = 0; j < 8; ++j) w[j] = (ix[j] == bi) ? -INFINITY : w[j]; }
}
__device__ __forceinline__ void p6_norm_router(Frame& F, int l, const float* x1) {
    bf16* H = (bf16*)(F.ws + WS_H); float* topw = (float*)(F.ws + WS_TOPW); int* route = (int*)(F.ws + WS_ROUTE); int* hist = (int*)(F.ws + WS_HIST);
    const float* rw = F.in[I_RW] + (size_t)l * DM * NEXP; const float* rb = F.in[I_RB] + (size_t)l * NEXP;
    constexpr int RWP = 2064;
    LAS unsigned char* rwt = F.lds;
    LAS int* cnt = (LAS int*)(F.lds + MISC_OFF + 256);
    for (int idx = F.tid; idx < DM * NEXP; idx += 512) { const int k = idx >> 5, ex = idx & 31; *(LAS unsigned short*)(rwt + ex * RWP + k * 2) = (unsigned short)f2bf(rw[idx]); }
    __syncthreads();
    const int fr = F.lane & 15, fq = F.lane >> 4;
    float rbv[8]; int eix[8];
#pragma unroll
    for (int i = 0; i < 4; ++i) { eix[i] = 4 * fq + i; eix[4 + i] = 16 + 4 * fq + i; rbv[i] = rb[4 * fq + i]; rbv[4 + i] = rb[16 + 4 * fq + i]; }
    for (int chunk = F.blk; chunk < NTOK / 128; chunk += F.G) {
        const int b = chunk / (SEQ / 128);
        if (F.tid < 32) cnt[F.tid] = 0;
        __syncthreads();
        f32x4 A[4], Bv[4];
#pragma unroll
        for (int j = 0; j < 4; ++j) { const int c = 256 * j + 4 * F.lane; const f32x4 g = *(const f32x4*)(F.in[I_N2G] + (size_t)l * DM + c); A[j] = g * (mod4(F, l, b, 4, c) + 1.0f); Bv[j] = mod4(F, l, b, 3, c); }
        const int row0 = chunk * 128 + F.wave * 16;
#pragma unroll 1
        for (int rr = 0; rr < 16; rr += 2) {
            f32x4 v[2][4]; float ss[2];
#pragma unroll
            for (int u = 0; u < 2; ++u)
#pragma unroll
                for (int j = 0; j < 4; ++j) v[u][j] = *(const f32x4*)(x1 + (size_t)(row0 + rr + u) * DM + 256 * j + 4 * F.lane);
#pragma unroll
            for (int u = 0; u < 2; ++u) { float s = 0.f;
#pragma unroll
                for (int j = 0; j < 4; ++j) s += (v[u][j].x * v[u][j].x + v[u][j].y * v[u][j].y) + (v[u][j].z * v[u][j].z + v[u][j].w * v[u][j].w);
                ss[u] = s; }
#pragma unroll
            for (int o = 1; o < 64; o <<= 1) { ss[0] += __shfl_xor(ss[0], o); ss[1] += __shfl_xor(ss[1], o); }
#pragma unroll
            for (int u = 0; u < 2; ++u) { const float rstd = 1.0f / sqrtf(ss[u] * (1.0f / DM) + EPS);
#pragma unroll
                for (int j = 0; j < 4; ++j) { const f32x4 hv = v[u][j] * rstd * A[j] + Bv[j];
                    v2u o; o.x = pk2(hv.x, hv.y); o.y = pk2(hv.z, hv.w); *(v2u*)(H + (size_t)(row0 + rr + u) * DM + 256 * j + 4 * F.lane) = o; } }
        }
        asm volatile("s_waitcnt vmcnt(0)" ::: "memory");
        f32x4 acc0 = (f32x4){0.f, 0.f, 0.f, 0.f}, acc1 = (f32x4){0.f, 0.f, 0.f, 0.f};
        { const bf16* hp = H + (size_t)(row0 + fr) * DM + 8 * fq; const LAS unsigned char* wp = rwt + fr * RWP + 16 * fq;
#pragma unroll 8
          for (int s = 0; s < 32; ++s) { const v4u hb = __builtin_nontemporal_load((const v4u*)(hp + 32 * s));
              const bf16x8 a0 = *(const LAS bf16x8*)(wp + 64 * s), a1 = *(const LAS bf16x8*)(wp + 16 * RWP + 64 * s);
              acc0 = __builtin_amdgcn_mfma_f32_16x16x32_bf16(a0, __builtin_bit_cast(bf16x8, hb), acc0, 0, 0, 0);
              acc1 = __builtin_amdgcn_mfma_f32_16x16x32_bf16(a1, __builtin_bit_cast(bf16x8, hb), acc1, 0, 0, 0); } }
        float cv[8], tv[4], ov[8]; int ti[4], oi[8];
#pragma unroll
        for (int i = 0; i < 4; ++i) { cv[i] = acc0[i] + rbv[i]; cv[4 + i] = acc1[i] + rbv[4 + i]; }
        top4of8(cv, eix, tv, ti);
#pragma unroll
        for (int st = 16; st <= 32; st <<= 1) {
#pragma unroll
            for (int k = 0; k < 4; ++k) { ov[k] = tv[k]; oi[k] = ti[k]; ov[4 + k] = __shfl_xor(tv[k], st); oi[4 + k] = __shfl_xor(ti[k], st); }
            top4of8(ov, oi, tv, ti); }
        const float e1 = __expf(tv[1] - tv[0]), e2 = __expf(tv[2] - tv[0]), e3 = __expf(tv[3] - tv[0]); const float inv = 1.0f / (1.0f + e1 + e2 + e3);
        { const int row = row0 + fr, k = fq;
          const float w = (k == 0 ? 1.0f : k == 1 ? e1 : k == 2 ? e2 : e3) * inv; const int ex = (k == 0 ? ti[0] : k == 1 ? ti[1] : k == 2 ? ti[2] : ti[3]);
          const int pos = __hip_atomic_fetch_add(cnt + ex, 1, __ATOMIC_RELAXED, __HIP_MEMORY_SCOPE_WORKGROUP);
          topw[row * 4 + k] = w; route[row * 4 + k] = ex + 32 * pos; }
        __syncthreads();
        if (F.tid < 32) hist[chunk * 32 + F.tid] = cnt[F.tid];
        __syncthreads();
    }
}

__device__ __forceinline__ void p7_scatter(Frame& F) {
    const int* hist = (const int*)(F.ws + WS_HIST); const int* route = (const int*)(F.ws + WS_ROUTE);
    int* tokslot = (int*)(F.ws + WS_TOKSLOT); int* slottok = (int*)(F.ws + WS_SLOTTOK); int* moetab = (int*)(F.ws + WS_MOETAB);
    LAS int* pre = (LAS int*)F.lds;
    LAS int* base = (LAS int*)(F.lds + 32768);
    for (int i = F.tid; i < 256 * 32; i += 512) pre[i] = hist[i];
    __syncthreads();
    if (F.tid < 32) { int run = 0;
        for (int c = 0; c < 256; ++c) { const int v = pre[c * 32 + F.tid]; pre[c * 32 + F.tid] = run; run += v; }
        base[64 + F.tid] = run; }
    __syncthreads();
    if (F.tid == 0) { int run = 0; for (int ex = 0; ex < NEXP; ++ex) { base[ex] = run; run += (base[64 + ex] + 255) & ~255; } base[NEXP] = run; }
    __syncthreads();
    if (F.blk == 0 && F.tid <= NEXP) moetab[F.tid] = base[F.tid] >> 8;
    for (int chunk = F.blk; chunk < NTOK / 128; chunk += F.G) {
        const int t = chunk * 128 + (F.tid >> 2), k = F.tid & 3; const int rt = route[t * 4 + k]; const int ex = rt & 31, pos = rt >> 5;
        const int slot = base[ex] + pre[chunk * 32 + ex] + pos;
        tokslot[t * 4 + k] = slot; slottok[slot] = t;
    }
    for (int ex = F.blk; ex < NEXP; ex += F.G) { const int lo = base[ex] + base[64 + ex], hi = base[ex + 1]; for (int s = lo + F.tid; s < hi; s += 512) slottok[s] = 0; }
    __syncthreads();
}

struct Args { const float* in[21]; float* out; unsigned char* ws; int ph_lo, ph_hi; };
__device__ __forceinline__ void launder(Frame& F) { int t = threadIdx.x; asm volatile("" : "+v"(t)); F.tid = t; F.lane = t & 63; F.wave = __builtin_amdgcn_readfirstlane(t >> 6);
    const __attribute__((address_space(4))) Args* ap = (const __attribute__((address_space(4))) Args*)__builtin_amdgcn_kernarg_segment_ptr(); asm volatile("" : "+s"(ap));
#pragma unroll
    for (int i = 0; i < 21; ++i) F.in[i] = ap->in[i];
    F.out = ap->out; F.ws = ap->ws; }
constexpr int N_PHASES = 1 + 9 * NLAYER + 1;

#define PHASE_FN __device__ __forceinline__
__device__ __forceinline__ void make_frame(Frame& F, LAS unsigned char* lds) { F.lds = lds; F.blk = blockIdx.x; F.G = gridDim.x; launder(F); }
PHASE_FN void ph_prologue(LAS unsigned char* lds) { Frame F; make_frame(F, lds); p0_prologue(F); }
PHASE_FN void ph_norm1(LAS unsigned char* lds, int l) { Frame F; make_frame(F, lds);
    if (l == 0) row_phase<false, true>(F, 0, F.in[I_X], nullptr); else row_phase<true, true>(F, l, (const float*)(F.ws + WS_XA), (float*)(F.ws + WS_XB)); }
PHASE_FN void ph_proj(LAS unsigned char* lds, int l) { Frame F; make_frame(F, lds);
    pg8::Gemm g{(const bf16*)(F.ws + WS_H), (const bf16*)(F.ws + WS_WIN) + (size_t)l * NPROJ * DM, nullptr, DM};
    pg8::StaticOrder S; S.init(NTOK, NPROJ, F.G, F.blk);
    pg8::EpiProj E{(bf16*)(F.ws + WS_PROJ), NPROJ};
    pg8::gemm_phase<pg8::EpiProj, pg8::StaticOrder, false>(F.lds, g, S, E); }
PHASE_FN void ph_postproj(LAS unsigned char* lds, int l) { Frame F; make_frame(F, lds); p3_postproj(F, l); }
PHASE_FN void ph_attn(LAS unsigned char* lds, int l) { Frame F; make_frame(F, lds); p4_attention(F, l); }
PHASE_FN void ph_out(LAS unsigned char* lds, int l) { Frame F; make_frame(F, lds);
    const float* xin = (l == 0) ? F.in[I_X] : (const float*)(F.ws + WS_XB);
    pg8::Gemm g{(const bf16*)(F.ws + WS_YMIX), (const bf16*)(F.ws + WS_WOUT) + (size_t)l * DM * DM, nullptr, DM};
    pg8::StaticOrder S; S.init(NTOK, DM, F.G, F.blk);
    pg8::EpiResGate E{xin, (float*)(F.ws + WS_XA), F.in[I_BADA] + (size_t)l * 6144 + 2 * DM, (const float*)(F.ws + WS_MODP) + (size_t)l * 4 * NB * 6144 + 2 * DM};
    pg8::gemm_phase<pg8::EpiResGate, pg8::StaticOrder, false>(F.lds, g, S, E); }
PHASE_FN void ph_router(LAS unsigned char* lds, int l) { Frame F; make_frame(F, lds); p6_norm_router(F, l, (const float*)(F.ws + WS_XA)); }
PHASE_FN void ph_scatter(LAS unsigned char* lds) { Frame F; make_frame(F, lds); p7_scatter(F); }
__device__ __forceinline__ LAS int* moe_table(Frame& F) { LAS int* tb = (LAS int*)(F.lds + MISC_OFF + 64);
    if (F.tid <= NEXP) tb[F.tid] = ((const int*)(F.ws + WS_MOETAB))[F.tid];
    __syncthreads(); return tb; }
PHASE_FN void ph_moe_up(LAS unsigned char* lds, int l) { Frame F; make_frame(F, lds); LAS int* tb = moe_table(F);
    pg8::Gemm g{(const bf16*)(F.ws + WS_H), (const bf16*)(F.ws + WS_W1) + (size_t)l * NEXP * 2048 * DM, (const int*)(F.ws + WS_SLOTTOK), DM};
    pg8::MoeOrder S; S.init(tb, 8, F.G, F.blk);
    pg8::EpiSwiglu E{(bf16*)(F.ws + WS_ACT), F.in[I_B1] + (size_t)l * NEXP * 2048};
    pg8::gemm_phase<pg8::EpiSwiglu, pg8::MoeOrder, true>(F.lds, g, S, E); }
PHASE_FN void ph_moe_down(LAS unsigned char* lds, int l) { Frame F; make_frame(F, lds); LAS int* tb = moe_table(F);
    pg8::Gemm g{(const bf16*)(F.ws + WS_ACT), (const bf16*)(F.ws + WS_W2) + (size_t)l * NEXP * DM * DM, nullptr, DM};
    pg8::MoeOrder S; S.init(tb, 4, F.G, F.blk);
    pg8::EpiY E{(bf16*)(F.ws + WS_Y), F.in[I_B2] + (size_t)l * NEXP * DM};
    pg8::gemm_phase<pg8::EpiY, pg8::MoeOrder, false>(F.lds, g, S, E); }
PHASE_FN void ph_final(LAS unsigned char* lds) { Frame F; make_frame(F, lds); row_phase<true, false>(F, NLAYER, (const float*)(F.ws + WS_XA), F.out); }

#ifndef REP_MASK
#define REP_MASK 0
#endif
__global__ void __launch_bounds__(512, 2) fwd_kernel(Args args) {
    extern __shared__ __attribute__((aligned(16))) unsigned char lds_raw[];
    LAS unsigned char* lds = (LAS unsigned char*)lds_raw;
    volatile LAS unsigned* MISC = (volatile LAS unsigned*)(lds + MISC_OFF);
    if (threadIdx.x < 16) MISC[threadIdx.x] = 0u;
    __syncthreads();
    const int lo = args.ph_lo, hi = args.ph_hi;
    const bool multi = (hi - lo) > 1;
    XcdBarrier bar; bar.bar = (unsigned*)(args.ws + WS_CTL) + CW_BAR; bar.x = 0; bar.st = MISC;
    if (multi) bar = xcd_barrier_post((unsigned*)(args.ws + WS_CTL) + CW_BAR, MISC);
#define IN(k) (lo <= (k) && (k) < hi)
#define SEAM(k) do { if (IN((k) + 1)) xcd_barrier(bar); } while (0)
#define REPS(j) for (int rep_ = 0; rep_ < (((REP_MASK >> (j)) & 1) ? 2 : 1); ++rep_)
    if (IN(0)) { REPS(0) { ph_prologue(lds); SEAM(0); } }
    for (int l = 0; l < NLAYER; ++l) {
        const int p = 1 + 9 * l;
        if (IN(p + 0)) { REPS(1) { ph_norm1(lds, l); SEAM(p + 0); } }
        if (IN(p + 1)) { REPS(2) { ph_proj(lds, l); SEAM(p + 1); } }
        if (IN(p + 2)) { ph_postproj(lds, l); SEAM(p + 2); }
        if (IN(p + 3)) { REPS(4) { ph_attn(lds, l); SEAM(p + 3); } }
        if (IN(p + 4)) { REPS(5) { ph_out(lds, l); SEAM(p + 4); } }
        if (IN(p + 5)) { REPS(6) { ph_router(lds, l); SEAM(p + 5); } }
        if (IN(p + 6)) { REPS(7) { ph_scatter(lds); SEAM(p + 6); } }
        if (IN(p + 7)) { REPS(8) { ph_moe_up(lds, l); SEAM(p + 7); } }
        if (IN(p + 8)) { REPS(9) { ph_moe_down(lds, l); SEAM(p + 8); } }
    }
    if (IN(N_PHASES - 1)) { REPS(10) { ph_final(lds); } }
#undef IN
#undef SEAM
#undef REPS
}

#ifndef MK_SPLIT
#define MK_SPLIT 0
#endif
extern "C" void kernel_launch(void* const* d_in, const int* in_sizes, int n_in, void* d_out, int out_size, void* d_ws, size_t ws_size, hipStream_t stream) {
    static int grid = 0;
    if (grid == 0) {
        if (n_in != 21 || in_sizes[0] != NTOK * DM || out_size != NTOK * DM || ws_size < WS_END) {
            fprintf(stderr, "kernel_launch: unexpected shapes: n_in %d in0 %d out %d ws %zu (need %zu)\n", n_in, n_in > 0 ? in_sizes[0] : -1, out_size, ws_size, (size_t)WS_END); grid = -1; return; }
        int dev = 0, cus = 0, per_cu = 0;
        if (hipGetDevice(&dev) != hipSuccess || hipDeviceGetAttribute(&cus, hipDeviceAttributeMultiprocessorCount, dev) != hipSuccess) { fprintf(stderr, "kernel_launch: device query failed\n"); grid = -1; return; }
        if (hipFuncSetAttribute((const void*)fwd_kernel, hipFuncAttributeMaxDynamicSharedMemorySize, LDS_BYTES) != hipSuccess) { fprintf(stderr, "kernel_launch: hipFuncSetAttribute failed\n"); grid = -1; return; }
        if (hipOccupancyMaxActiveBlocksPerMultiprocessor(&per_cu, (const void*)fwd_kernel, 512, LDS_BYTES) != hipSuccess || per_cu < 1) fprintf(stderr, "kernel_launch: note: occupancy query says %d\n", per_cu);
        (void)hipGetLastError();
        grid = cus;
    }
    if (grid < 0) return;
    (void)hipMemsetAsync((char*)d_ws + WS_CTL, 0, CTL_ZERO_BYTES, stream);
    Args a{};
    for (int i = 0; i < 21; ++i) a.in[i] = (const float*)d_in[i];
    a.out = (float*)d_out; a.ws = (unsigned char*)d_ws;
#if MK_SPLIT
    for (int ph = 0; ph < N_PHASES; ++ph) { a.ph_lo = ph; a.ph_hi = ph + 1; hipLaunchKernelGGL(fwd_kernel, dim3(grid), dim3(512), LDS_BYTES, stream, a); }
#else
    a.ph_lo = 0; a.ph_hi = N_PHASES; hipLaunchKernelGGL(fwd_kernel, dim3(grid), dim3(512), LDS_BYTES, stream, a);
#endif
}
```

```cpp
#include <hip/hip_runtime.h>
#include <cstdio>
#include <cstdint>

#define GAS __attribute__((address_space(1)))
#define LAS __attribute__((address_space(3)))
typedef unsigned short bf16;
typedef unsigned v4u __attribute__((ext_vector_type(4)));
typedef unsigned v2u __attribute__((ext_vector_type(2)));
typedef float f32x4 __attribute__((ext_vector_type(4)));
typedef float f32x2 __attribute__((ext_vector_type(2)));
typedef float f32x16 __attribute__((ext_vector_type(16)));
typedef short bf16x8 __attribute__((ext_vector_type(8)));
typedef _Float16 f16x8 __attribute__((ext_vector_type(8)));
typedef _Float16 f16x2 __attribute__((ext_vector_type(2)));

namespace pg8 {
constexpr int BM = 256, BK = 64, HALF = 128, HTB = HALF * BK * 2  , STAGE_BYTES = 8 * HTB, NXCD = 8, WGM = 8;

__host__ __device__ __forceinline__ int lds_byte(int r, int c) { const int st = (r >> 4) * 2 + (c >> 5), rr = r & 15, cc = c & 31, ob = rr * 64 + cc * 2; return st * 1024 + (ob ^ (((ob >> 9) & 1) << 5)); }
__host__ __device__ __forceinline__ void stage_rc(int b, int& R, int& C) { const int st = b / 1024, sb = b % 1024, swz = sb ^ (((sb >> 9) & 1) << 5); R = (st >> 1) * 16 + swz / 64; C = (st & 1) * 32 + (swz % 64) / 2; }
__host__ __device__ __forceinline__ int perm32(int rho) { const int n = rho >> 4, i = rho & 15; return 8 * (i >> 2) + 4 * n + (i & 3); }

struct Unit { int pm, pn, pb; };
struct Gemm { const bf16* A; const bf16* Bt; const int* rowmap; int K; };

__device__ __forceinline__ unsigned cvt_pk_bf16(float lo, float hi) { unsigned r; asm volatile("v_cvt_pk_bf16_f32 %0, %1, %2" : "=v"(r) : "v"(lo), "v"(hi)); return r; }

template <class Epi, class Sched, bool GATHER>
__device__ __forceinline__ void gemm_phase(LAS unsigned char* lds, const Gemm g, const Sched& S, const Epi& E) {
    int tid_ = threadIdx.x; asm volatile("" : "+v"(tid_));
    const int tid = tid_, wid = __builtin_amdgcn_readfirstlane(tid >> 6), lane = tid & 63, wr = wid >> 2, wc = wid & 3, fr = lane & 15, fq = lane >> 4;
    const int K = g.K, nt = K / BK;
    unsigned voffA[2], voffB[2]; int RA[2], CA[2];
#pragma unroll
    for (int i = 0; i < 2; ++i) { int R, C; stage_rc(tid * 16 + i * 8192, R, C); const int Rb = Epi::PERM ? ((R & ~31) + perm32(R & 31)) : R; RA[i] = R; CA[i] = C;
        voffA[i] = (unsigned)(R * K + C) * 2u; voffB[i] = (unsigned)(Rb * K + C) * 2u; }
    const size_t kstep = (size_t)(BK * 2);
    const size_t hstep = (size_t)HALF * K * 2;
    const size_t tstep = 2 * hstep;
    const unsigned ldsw = (unsigned)wid * 1024u;
    const int aoff = lds_byte(wr * 64 + fr, fq * 8), boff = lds_byte(wc * 32 + fr, fq * 8);
#define PG8_SA(b, h) (((b) * 2 + (h)) * HTB)
#define PG8_SB(b, h) ((4 + (b) * 2 + (h)) * HTB)
#define PG8_STAGE(bufoff, gbase, voff) do { _Pragma("unroll") for (int _i = 0; _i < 2; ++_i) \
        __builtin_amdgcn_global_load_lds((const unsigned*)((const char*)(gbase) + (voff)[_i]), (LAS unsigned*)(lds + (bufoff) + ldsw + _i * 8192), 16, 0, 0); } while (0)
#define PG8_STAGEA(bufoff, pbase, h, nx) do { if constexpr (GATHER) { _Pragma("unroll") for (int _i = 0; _i < 2; ++_i) \
        __builtin_amdgcn_global_load_lds((const unsigned*)((const char*)(pbase) + ((nx) ? gn[h][_i] : gc[h][_i])), (LAS unsigned*)(lds + (bufoff) + ldsw + _i * 8192), 16, 0, 0); } \
        else { PG8_STAGE(bufoff, (const char*)(pbase) + (h) * hstep, voffA); } } while (0)
#define PG8_LDA(dst, b, h) do { _Pragma("unroll") for (int m = 0; m < 4; ++m) _Pragma("unroll") for (int k = 0; k < 2; ++k) dst[m][k] = *(const LAS bf16x8*)(lds + PG8_SA(b, h) + aoff + m * 2048 + k * 1024); } while (0)
#define PG8_LDB(dst, b, h) do { _Pragma("unroll") for (int n = 0; n < 2; ++n) _Pragma("unroll") for (int k = 0; k < 2; ++k) dst[n][k] = *(const LAS bf16x8*)(lds + PG8_SB(b, h) + boff + n * 2048 + k * 1024); } while (0)
#define PG8_MMA(ai, bj, At, Bt) do { __builtin_amdgcn_s_setprio(1); _Pragma("unroll") for (int m = 0; m < 4; ++m) _Pragma("unroll") for (int n = 0; n < 2; ++n) _Pragma("unroll") for (int k = 0; k < 2; ++k) \
        acc[ai][bj][m][n] = __builtin_amdgcn_mfma_f32_16x16x32_bf16(Bt[n][k], At[m][k], acc[ai][bj][m][n], 0, 0, 0); __builtin_amdgcn_s_setprio(0); } while (0)
#define PG8_WAIT_V(n) asm volatile("s_waitcnt vmcnt(" #n ")" ::: "memory")
#define PG8_WAIT_L(n) asm volatile("s_waitcnt lgkmcnt(" #n ")" ::: "memory")
#define PG8_BAR __builtin_amdgcn_s_barrier()
#define PG8_SCHED __builtin_amdgcn_sched_barrier(0)
    Unit cur, nxt; int ui = 0;
    if (!S.next(0, cur)) return;
    f32x4 acc[2][2][4][2];
#pragma unroll
    for (int a = 0; a < 2; ++a)
#pragma unroll
        for (int b = 0; b < 2; ++b)
#pragma unroll
            for (int m = 0; m < 4; ++m)
#pragma unroll
                for (int n = 0; n < 2; ++n) acc[a][b][m][n] = (f32x4){0.f, 0.f, 0.f, 0.f};
    bf16x8 At[4][2], B0[2][2], B1[2][2];
    unsigned gc[2][2], gn[2][2];
    if constexpr (GATHER) {
#pragma unroll
        for (int h = 0; h < 2; ++h)
#pragma unroll
            for (int i = 0; i < 2; ++i) { gc[h][i] = (unsigned)(g.rowmap[cur.pm * BM + h * HALF + RA[i]] * K + CA[i]) * 2u; gn[h][i] = gc[h][i]; }
    } else { gc[0][0] = gc[0][1] = gc[1][0] = gc[1][1] = 0u; gn[0][0] = gn[0][1] = gn[1][0] = gn[1][1] = 0u; }
    const char* cA = GATHER ? (const char*)g.A : (const char*)g.A + (size_t)cur.pm * tstep; const char* cB = (const char*)g.Bt + (size_t)cur.pb * tstep;
    PG8_STAGE(PG8_SB(0, 0), cB, voffB); PG8_STAGE(PG8_SB(0, 1), cB + hstep, voffB); PG8_STAGEA(PG8_SA(0, 0), cA, 0, false); PG8_STAGEA(PG8_SA(0, 1), cA, 1, false);
    if (wr == 1) PG8_BAR;
    PG8_WAIT_V(2); PG8_BAR;
    PG8_STAGE(PG8_SB(1, 0), cB + kstep, voffB); PG8_STAGEA(PG8_SA(1, 0), cA + kstep, 0, false); PG8_STAGE(PG8_SB(1, 1), cB + hstep + kstep, voffB);
    PG8_WAIT_V(6); PG8_BAR;
    for (;;) {
        const bool has_next = S.next(ui + 1, nxt);
        if constexpr (GATHER) { if (has_next) {
#pragma unroll
            for (int h = 0; h < 2; ++h)
#pragma unroll
                for (int i = 0; i < 2; ++i) gn[h][i] = (unsigned)(g.rowmap[nxt.pm * BM + h * HALF + RA[i]] * K + CA[i]) * 2u; } }
        const char* nA = GATHER ? cA : (has_next ? (const char*)g.A + (size_t)nxt.pm * tstep : cA); const char* nB = has_next ? (const char*)g.Bt + (size_t)nxt.pb * tstep : cB;
        for (int t = 0; t < nt; t += 2) {
            const bool last = (t == nt - 2);
            const char* a1 = cA + (size_t)(t + 1) * kstep;
            const char* a2 = last ? nA : cA + (size_t)(t + 2) * kstep; const char* b2 = last ? nB : cB + (size_t)(t + 2) * kstep;
            const char* a3 = a2 + kstep; const char* b3 = b2 + kstep;
            PG8_LDB(B0, 0, 0); PG8_LDB(B1, 0, 1); PG8_SCHED; PG8_LDA(At, 0, 0); PG8_STAGEA(PG8_SA(1, 1), a1, 1, false);
            PG8_WAIT_V(8); PG8_WAIT_L(0); PG8_BAR; PG8_MMA(0, 0, At, B0); PG8_MMA(0, 1, At, B1); PG8_BAR; PG8_SCHED;
            PG8_LDA(At, 0, 1); PG8_STAGE(PG8_SB(0, 0), b2, voffB); PG8_STAGE(PG8_SB(0, 1), b2 + hstep, voffB); PG8_STAGEA(PG8_SA(0, 0), a2, 0, last);
            PG8_WAIT_V(8); PG8_WAIT_L(0); PG8_BAR; PG8_MMA(1, 0, At, B0); PG8_MMA(1, 1, At, B1); PG8_BAR; PG8_SCHED;
            PG8_LDB(B0, 1, 0); PG8_LDB(B1, 1, 1); PG8_SCHED; PG8_LDA(At, 1, 0); PG8_STAGEA(PG8_SA(0, 1), a2, 1, last);
            PG8_WAIT_V(8); PG8_WAIT_L(0); PG8_BAR; PG8_MMA(0, 0, At, B0); PG8_MMA(0, 1, At, B1); PG8_BAR; PG8_SCHED;
            PG8_LDA(At, 1, 1); PG8_STAGE(PG8_SB(1, 0), b3, voffB); PG8_STAGE(PG8_SB(1, 1), b3 + hstep, voffB); PG8_STAGEA(PG8_SA(1, 0), a3, 0, last);
            PG8_WAIT_V(8); PG8_WAIT_L(0); PG8_BAR; PG8_MMA(1, 0, At, B0); PG8_MMA(1, 1, At, B1); PG8_BAR; PG8_SCHED;
        }
        if (wr == 0) PG8_BAR;
        E(acc, cur, wr, wc, fr, fq);
        if (!has_next) break;
#pragma unroll
        for (int a = 0; a < 2; ++a)
#pragma unroll
            for (int b = 0; b < 2; ++b)
#pragma unroll
                for (int m = 0; m < 4; ++m)
#pragma unroll
                    for (int n = 0; n < 2; ++n) acc[a][b][m][n] = (f32x4){0.f, 0.f, 0.f, 0.f};
        cur = nxt; cA = nA; cB = nB; ++ui;
        if constexpr (GATHER) {
#pragma unroll
            for (int h = 0; h < 2; ++h)
#pragma unroll
                for (int i = 0; i < 2; ++i) gc[h][i] = gn[h][i]; }
        if (wr == 1) PG8_BAR;
    }
    PG8_WAIT_V(0);
    PG8_BAR;
#undef PG8_SA
#undef PG8_SB
#undef PG8_STAGE
#undef PG8_STAGEA
#undef PG8_LDA
#undef PG8_LDB
#undef PG8_MMA
#undef PG8_WAIT_V
#undef PG8_WAIT_L
#undef PG8_BAR
#undef PG8_SCHED
}
}
constexpr int DM = 1024, NB = 8, SEQ = 4096, NTOK = NB * SEQ, NLAYER = 2;
constexpr int NPROJ = 3072;
constexpr int D_IN = 3078;
constexpr int NEXP = 32, TOPK = 4;
constexpr int NSLOT_MAX = NTOK * TOPK + NEXP * 256;
constexpr int NTILE_MAX = NSLOT_MAX / 256;
constexpr int COL_CB = 0, COL_CC = 256, COL_CU = 512, COL_SQ = 768, COL_SK = 1152, COL_SV = 1536, COL_FQ = 1920, COL_FK = 2304, COL_FV = 2688;
constexpr float EPS = 1e-6f;
constexpr float LOG2E = 1.4426950408889634f;
constexpr float QSCALE = 0.125f * LOG2E;

namespace pg8 {
struct StaticOrder {
    int nM, nN, nwg, G, c;
    __device__ __forceinline__ void init(int M, int N, int G_, int c_) { nM = M / BM; nN = N / BM; nwg = nM * nN; G = G_; c = c_; }
    __device__ __forceinline__ bool next(int i, Unit& u) const {
        const long L = (long)i * G + c; if (L >= nwg) return false;
        int wgid = (int)L; { const int q = nwg / NXCD, r = nwg % NXCD, xcd = wgid % NXCD, off = wgid / NXCD; wgid = (xcd < r ? xcd * (q + 1) : r * (q + 1) + (xcd - r) * q) + off; }
        const int nig = WGM * nN, gid = wgid / nig, fm = gid * WGM, gsz = (nM - fm) < WGM ? (nM - fm) : WGM;
        u.pm = fm + ((wgid % nig) % gsz); u.pn = (wgid % nig) / gsz; u.pb = u.pn; return true;
    }
};
struct MoeOrder {
    int nM, nN, nwg, G, c; const LAS int* tb;
    __device__ __forceinline__ void init(const LAS int* tb_, int nN_, int G_, int c_) { tb = tb_; nM = tb_[NEXP]; nN = nN_; nwg = nM * nN; G = G_; c = c_; }
    __device__ __forceinline__ bool next(int i, Unit& u) const {
        const long L = (long)i * G + c; if (L >= nwg) return false;
        int wgid = (int)L; { const int q = nwg / NXCD, r = nwg % NXCD, xcd = wgid % NXCD, off = wgid / NXCD; wgid = (xcd < r ? xcd * (q + 1) : r * (q + 1) + (xcd - r) * q) + off; }
        const int nig = WGM * nN, gid = wgid / nig, fm = gid * WGM, gsz = (nM - fm) < WGM ? (nM - fm) : WGM;
        u.pm = fm + ((wgid % nig) % gsz); u.pn = (wgid % nig) / gsz;
        int e = 0;
#pragma unroll 1
        for (int j = 1; j < NEXP; ++j) e += (tb[j] <= u.pm) ? 1 : 0;
        u.pb = e * nN + u.pn; return true;
    }
};

struct EpiProj {
    static constexpr bool PERM = true;
    bf16* O; int ldc;
    __device__ __forceinline__ void operator()(const f32x4 (&acc)[2][2][4][2], const Unit& u, int wr, int wc, int fr, int fq) const {
        const int row0 = u.pm * BM + wr * 64 + fr, col0 = u.pn * BM + wc * 32 + 8 * fq;
#pragma unroll
        for (int ai = 0; ai < 2; ++ai)
#pragma unroll
            for (int m = 0; m < 4; ++m) { bf16* rowp = O + (size_t)(row0 + ai * HALF + m * 16) * ldc + col0;
#pragma unroll
                for (int bj = 0; bj < 2; ++bj) { const f32x4 v0 = acc[ai][bj][m][0], v1 = acc[ai][bj][m][1];
                    v4u w; w.x = cvt_pk_bf16(v0[0], v0[1]); w.y = cvt_pk_bf16(v0[2], v0[3]); w.z = cvt_pk_bf16(v1[0], v1[1]); w.w = cvt_pk_bf16(v1[2], v1[3]);
                    *(v4u*)(rowp + bj * HALF) = w; } }
    }
};
struct EpiResGate {
    static constexpr bool PERM = false;
    const float* base; float* out; const float* gbias; const float* gpart;
    __device__ __forceinline__ void operator()(const f32x4 (&acc)[2][2][4][2], const Unit& u, int wr, int wc, int fr, int fq) const {
        const int row0 = u.pm * BM + wr * 64 + fr, col0 = u.pn * BM + wc * 32 + 4 * fq; const int b = (u.pm * BM) / SEQ;
#pragma unroll
        for (int bj = 0; bj < 2; ++bj)
#pragma unroll
            for (int n = 0; n < 2; ++n) { const int c = col0 + bj * HALF + n * 16; f32x4 gv = *(const f32x4*)(gbias + c);
#pragma unroll
                for (int ks = 0; ks < 4; ++ks) gv += *(const f32x4*)(gpart + (size_t)(ks * NB + b) * 6144 + c);
#pragma unroll
                for (int ai = 0; ai < 2; ++ai)
#pragma unroll
                    for (int m = 0; m < 4; ++m) { const size_t off = (size_t)(row0 + ai * HALF + m * 16) * DM + c;
                        *(f32x4*)(out + off) = *(const f32x4*)(base + off) + gv * acc[ai][bj][m][n]; } }
    }
};
struct EpiSwiglu {
    static constexpr bool PERM = true;
    bf16* O; const float* b1;
    __device__ __forceinline__ void operator()(const f32x4 (&acc)[2][2][4][2], const Unit& u, int wr, int wc, int fr, int fq) const {
        const int row0 = u.pm * BM + wr * 64 + fr; const int e = u.pb >> 3; const int j0 = u.pn * 128 + wc * 32 + 8 * fq;
        const float* bp = b1 + (size_t)e * 2048 + 2 * j0;
        f32x4 bb[4];
#pragma unroll
        for (int q = 0; q < 4; ++q) bb[q] = *(const f32x4*)(bp + 4 * q);
        float bg[8], bl[8];
#pragma unroll
        for (int q = 0; q < 4; ++q) { bg[2 * q] = bb[q][0]; bl[2 * q] = bb[q][1]; bg[2 * q + 1] = bb[q][2]; bl[2 * q + 1] = bb[q][3]; }
#pragma unroll
        for (int ai = 0; ai < 2; ++ai)
#pragma unroll
            for (int m = 0; m < 4; ++m) { bf16* rowp = O + (size_t)(row0 + ai * HALF + m * 16) * DM + j0;
                float a[8];
#pragma unroll
                for (int n = 0; n < 2; ++n)
#pragma unroll
                    for (int i = 0; i < 4; ++i) { float gl = acc[ai][0][m][n][i] + bg[4 * n + i], li = acc[ai][1][m][n][i] + bl[4 * n + i];
                        gl = fminf(gl, 7.0f); li = fminf(fmaxf(li, -7.0f), 7.0f);
                        const float sg = __builtin_amdgcn_rcpf(1.0f + __builtin_amdgcn_exp2f(-1.702f * LOG2E * gl));
                        a[4 * n + i] = gl * sg * (li + 1.0f); }
                v4u w; w.x = cvt_pk_bf16(a[0], a[1]); w.y = cvt_pk_bf16(a[2], a[3]); w.z = cvt_pk_bf16(a[4], a[5]); w.w = cvt_pk_bf16(a[6], a[7]);
                *(v4u*)rowp = w; }
    }
};
struct EpiY {
    static constexpr bool PERM = true;
    bf16* O; const float* b2;
    __device__ __forceinline__ void operator()(const f32x4 (&acc)[2][2][4][2], const Unit& u, int wr, int wc, int fr, int fq) const {
        const int row0 = u.pm * BM + wr * 64 + fr; const int e = u.pb >> 2; const int col0 = u.pn * BM + wc * 32 + 8 * fq;
        f32x4 bv[2][2];
#pragma unroll
        for (int bj = 0; bj < 2; ++bj)
#pragma unroll
            for (int n = 0; n < 2; ++n) bv[bj][n] = *(const f32x4*)(b2 + (size_t)e * DM + col0 + bj * HALF + 4 * n);
#pragma unroll
        for (int ai = 0; ai < 2; ++ai)
#pragma unroll
            for (int m = 0; m < 4; ++m) { bf16* rowp = O + (size_t)(row0 + ai * HALF + m * 16) * DM + col0;
#pragma unroll
                for (int bj = 0; bj < 2; ++bj) { const f32x4 v0 = acc[ai][bj][m][0] + bv[bj][0], v1 = acc[ai][bj][m][1] + bv[bj][1];
                    v4u w; w.x = cvt_pk_bf16(v0[0], v0[1]); w.y = cvt_pk_bf16(v0[2], v0[3]); w.z = cvt_pk_bf16(v1[0], v1[1]); w.w = cvt_pk_bf16(v1[2], v1[3]);
                    *(v4u*)(rowp + bj * HALF) = w; } }
    }
};
}
namespace att {
constexpr int KROW = 144;
constexpr int TILE_B = 64 * KROW;
constexpr int OFF_K = 0, OFF_V = 2 * TILE_B, OFF_F = 4 * TILE_B, LDS_BYTES = OFF_F + 2 * 256;
__device__ __forceinline__ int pim(int m) { const int a = m >> 3, h = (m >> 2) & 1, b = m & 3; return 16 * (a >> 1) + 8 * h + 4 * (a & 1) + b; }
__device__ __forceinline__ unsigned pk_bf16(float lo, float hi) { unsigned r; asm volatile("v_cvt_pk_bf16_f32 %0, %1, %2" : "=v"(r) : "v"(lo), "v"(hi)); return r; }
__device__ __forceinline__ unsigned pk_f16(float lo, float hi) { return __builtin_bit_cast(unsigned, __builtin_amdgcn_cvt_pkrtz(lo, hi)); }

struct Tensors {
    const bf16* proj;
    const bf16* vt;
    const float* fcum;
    bf16* ymix;
    const float* ong;
    int colq, colk, coly;
};

template <int KIND>
__device__ __forceinline__ void unit(const Tensors& T, int b, int h, int qb, LAS unsigned char* lds) {
    int tid_ = threadIdx.x; asm volatile("" : "+v"(tid_));
    const int tid = tid_, lane = tid & 63, r32 = lane & 31, hi = lane >> 5; const int wid = __builtin_amdgcn_readfirstlane(tid >> 6);
    const int q0 = qb * 256, qw0 = q0 + wid * 32, qabs = qw0 + r32;
    const size_t rowbase = (size_t)b * SEQ;
    const int ktd = qw0 >> 6;
    const int kt_hi = (q0 + 255) >> 6;
    const int srow = tid >> 3, spc = tid & 7;
    const bf16* kg = T.proj + (rowbase + srow) * NPROJ + T.colk + h * 64 + spc * 8;
    const bf16* vg = T.vt + ((size_t)(b * 6 + h) * 64 + srow) * SEQ + spc * 8;
    const float* fg = T.fcum + (size_t)(b * 6 + h) * SEQ;
    const int sdst = srow * KROW + spc * 16;
    bf16x8 qf[4];
    { const bf16* qp = T.proj + (rowbase + qabs) * NPROJ + T.colq + h * 64 + hi * 8;
#pragma unroll
      for (int d0 = 0; d0 < 4; ++d0) qf[d0] = *(const bf16x8*)(qp + d0 * 16); }
    const int pm = pim(r32);
    const int koff = pm * KROW + hi * 16;
    f16x8 mtri0, mtri1, mones;
#pragma unroll
    for (int i = 0; i < 8; ++i) { mtri0[i] = (_Float16)((8 * hi + i > pm) ? 1.0f : 0.0f); mtri1[i] = (_Float16)((16 + 8 * hi + i > pm) ? 1.0f : 0.0f); mones[i] = (_Float16)1.0f; }
    f32x16 o0, o1;
#pragma unroll
    for (int r = 0; r < 16; ++r) { o0[r] = 0.f; o1[r] = 0.f; }
    float carry = (KIND == 1) ? -1e30f : 0.f;
    float lsum = 0.f;

    v4u kreg = *(const v4u*)(kg + (size_t)kt_hi * 64 * NPROJ), vreg = *(const v4u*)(vg + kt_hi * 64);
    float freg = 0.f; if (KIND == 1 && tid < 64) freg = fg[kt_hi * 64 + tid];
    *(LAS v4u*)(lds + OFF_K + sdst) = kreg; *(LAS v4u*)(lds + OFF_V + sdst) = vreg; if (KIND == 1 && tid < 64) *(LAS float*)(lds + OFF_F + tid * 4) = freg;
    __syncthreads();
    int buf = 0;
    for (int kt = kt_hi; kt >= 0; --kt) {
        if (kt > 0) { kreg = *(const v4u*)(kg + (size_t)(kt - 1) * 64 * NPROJ); vreg = *(const v4u*)(vg + (kt - 1) * 64); if (KIND == 1 && tid < 64) freg = fg[(kt - 1) * 64 + tid]; }
        if (kt <= ktd) {
            const LAS unsigned char* Kb = lds + OFF_K + buf * TILE_B; const LAS unsigned char* Vb = lds + OFF_V + buf * TILE_B;
            f32x16 p0, p1;
#pragma unroll
            for (int r = 0; r < 16; ++r) { p0[r] = 0.f; p1[r] = 0.f; }
#pragma unroll
            for (int d0 = 0; d0 < 4; ++d0) { const bf16x8 ka = *(const LAS bf16x8*)(Kb + koff + d0 * 32), kb2 = *(const LAS bf16x8*)(Kb + 32 * KROW + koff + d0 * 32);
                p0 = __builtin_amdgcn_mfma_f32_32x32x16_bf16(ka, qf[d0], p0, 0, 0, 0); p1 = __builtin_amdgcn_mfma_f32_32x32x16_bf16(kb2, qf[d0], p1, 0, 0, 0); }
            const bool diag = (kt == ktd);
            const int kbase = kt * 64 + 8 * hi;
            v4u wf0, wf1, wf2, wf3;
            if (KIND == 0) {
                float ls = 0.f; f32x16 l0, l1;
#pragma unroll
                for (int r = 0; r < 16; ++r) {
                    const int key = kbase + 16 * (r >> 3) + (r & 7);
                    float a = -__builtin_amdgcn_logf(1.0f + __builtin_amdgcn_exp2f(p0[r])); if (diag && !(key < qabs)) a = 0.f;
                    float c = -__builtin_amdgcn_logf(1.0f + __builtin_amdgcn_exp2f(p1[r])); if (diag && !(key + 32 < qabs)) c = 0.f;
                    ls += a + c; l0[r] = a; l1[r] = c; p0[r] += a; p1[r] += c; }
                v4u lf0, lf1, lf2, lf3;
#pragma unroll
                for (int j = 0; j < 4; ++j) { lf0[j] = pk_f16(l0[2 * j], l0[2 * j + 1]); lf1[j] = pk_f16(l0[8 + 2 * j], l0[9 + 2 * j]); lf2[j] = pk_f16(l1[2 * j], l1[2 * j + 1]); lf3[j] = pk_f16(l1[8 + 2 * j], l1[9 + 2 * j]); }
                f32x16 r0, r1;
#pragma unroll
                for (int r = 0; r < 16; ++r) { r0[r] = carry; r1[r] = carry; }
                r0 = __builtin_amdgcn_mfma_f32_32x32x16_f16(mtri0, __builtin_bit_cast(f16x8, lf0), r0, 0, 0, 0);
                r0 = __builtin_amdgcn_mfma_f32_32x32x16_f16(mtri1, __builtin_bit_cast(f16x8, lf1), r0, 0, 0, 0);
                r0 = __builtin_amdgcn_mfma_f32_32x32x16_f16(mones, __builtin_bit_cast(f16x8, lf2), r0, 0, 0, 0);
                r0 = __builtin_amdgcn_mfma_f32_32x32x16_f16(mones, __builtin_bit_cast(f16x8, lf3), r0, 0, 0, 0);
                r1 = __builtin_amdgcn_mfma_f32_32x32x16_f16(mtri0, __builtin_bit_cast(f16x8, lf2), r1, 0, 0, 0);
                r1 = __builtin_amdgcn_mfma_f32_32x32x16_f16(mtri1, __builtin_bit_cast(f16x8, lf3), r1, 0, 0, 0);
#pragma unroll
                for (int r = 0; r < 16; ++r) {
                    const int key = kbase + 16 * (r >> 3) + (r & 7);
                    float a = __builtin_amdgcn_exp2f(p0[r] + r0[r]); if (diag && !(key < qabs)) a = 0.f;
                    float c = __builtin_amdgcn_exp2f(p1[r] + r1[r]); if (diag && !(key + 32 < qabs)) c = 0.f;
                    p0[r] = a; p1[r] = c; }
                ls += __shfl_xor(ls, 32);
                carry += ls;
            } else {
                const LAS float* Fb = (const LAS float*)(lds + OFF_F + buf * 256) + 8 * hi;
                float mx = -1e30f;
#pragma unroll
                for (int g = 0; g < 2; ++g) {
                    const f32x4 fa = *(const LAS f32x4*)(Fb + 16 * g), fb = *(const LAS f32x4*)(Fb + 16 * g + 4), fc = *(const LAS f32x4*)(Fb + 32 + 16 * g), fd = *(const LAS f32x4*)(Fb + 32 + 16 * g + 4);
#pragma unroll
                    for (int i = 0; i < 8; ++i) { const int r = 8 * g + i; const int key = kbase + 16 * g + i;
                        float a = p0[r] - (i < 4 ? fa[i & 3] : fb[i & 3]); if (diag && key > qabs) a = -1e30f;
                        float c = p1[r] - (i < 4 ? fc[i & 3] : fd[i & 3]); if (diag && key + 32 > qabs) c = -1e30f;
                        p0[r] = a; p1[r] = c; mx = fmaxf(mx, fmaxf(a, c)); } }
                mx = fmaxf(mx, __shfl_xor(mx, 32));
                const float mnew = fmaxf(carry, mx), alpha = __builtin_amdgcn_exp2f(carry - mnew); carry = mnew;
                float ps = 0.f;
#pragma unroll
                for (int r = 0; r < 16; ++r) { const float a = __builtin_amdgcn_exp2f(p0[r] - mnew), c = __builtin_amdgcn_exp2f(p1[r] - mnew); ps += a + c; p0[r] = a; p1[r] = c; }
                ps += __shfl_xor(ps, 32);
                lsum = lsum * alpha + ps;
#pragma unroll
                for (int r = 0; r < 16; ++r) { o0[r] *= alpha; o1[r] *= alpha; }
            }
#pragma unroll
            for (int j = 0; j < 4; ++j) { wf0[j] = pk_bf16(p0[2 * j], p0[2 * j + 1]); wf1[j] = pk_bf16(p0[8 + 2 * j], p0[9 + 2 * j]); wf2[j] = pk_bf16(p1[2 * j], p1[2 * j + 1]); wf3[j] = pk_bf16(p1[8 + 2 * j], p1[9 + 2 * j]); }
#pragma unroll
            for (int c = 0; c < 4; ++c) {
                const bf16x8 va = *(const LAS bf16x8*)(Vb + koff + c * 32), vb2 = *(const LAS bf16x8*)(Vb + 32 * KROW + koff + c * 32);
                const bf16x8 wb = __builtin_bit_cast(bf16x8, c == 0 ? wf0 : c == 1 ? wf1 : c == 2 ? wf2 : wf3);
                o0 = __builtin_amdgcn_mfma_f32_32x32x16_bf16(va, wb, o0, 0, 0, 0); o1 = __builtin_amdgcn_mfma_f32_32x32x16_bf16(vb2, wb, o1, 0, 0, 0); }
        }
        if (kt > 0) { const int nb = (buf ^ 1) * TILE_B; *(LAS v4u*)(lds + OFF_K + nb + sdst) = kreg; *(LAS v4u*)(lds + OFF_V + nb + sdst) = vreg;
            if (KIND == 1 && tid < 64) *(LAS float*)(lds + OFF_F + (buf ^ 1) * 256 + tid * 4) = freg; }
        __syncthreads();
        buf ^= 1;
    }
    if (KIND == 1) { const float inv = 1.0f / lsum;
#pragma unroll
        for (int r = 0; r < 16; ++r) { o0[r] *= inv; o1[r] *= inv; } }
    float ss = 0.f;
#pragma unroll
    for (int r = 0; r < 16; ++r) ss += o0[r] * o0[r] + o1[r] * o1[r];
    ss += __shfl_xor(ss, 32);
    const float rinv = 1.0f / sqrtf(ss * (1.0f / 64.0f) + EPS);
    const float* gp = T.ong + T.coly + h * 64 + 8 * hi;
    bf16* yp = T.ymix + (rowbase + qabs) * DM + T.coly + h * 64 + 8 * hi;
#pragma unroll
    for (int d0 = 0; d0 < 2; ++d0)
#pragma unroll
        for (int g = 0; g < 2; ++g) { const f32x4 ga = *(const f32x4*)(gp + 32 * d0 + 16 * g), gb = *(const f32x4*)(gp + 32 * d0 + 16 * g + 4);
            float v[8];
#pragma unroll
            for (int i = 0; i < 8; ++i) v[i] = (d0 == 0 ? o0[8 * g + i] : o1[8 * g + i]) * rinv * (i < 4 ? ga[i & 3] : gb[i & 3]);
            v4u w; w.x = pk_bf16(v[0], v[1]); w.y = pk_bf16(v[2], v[3]); w.z = pk_bf16(v[4], v[5]); w.w = pk_bf16(v[6], v[7]);
            *(v4u*)(yp + 32 * d0 + 16 * g) = w; }
}
}
constexpr size_t MiB = 1u << 20;
constexpr size_t WS_CTL = 0, CTL_ZERO_BYTES = 1 * MiB;
constexpr size_t WS_MODP = 1 * MiB;
constexpr size_t WS_TOPW = 3 * MiB;
constexpr size_t WS_ROUTE = WS_TOPW + 512 * 1024;
constexpr size_t WS_TOKSLOT = WS_ROUTE + 512 * 1024;
constexpr size_t WS_SLOTTOK = WS_TOKSLOT + 512 * 1024;
constexpr size_t WS_HIST = WS_SLOTTOK + 576 * 1024;
constexpr size_t WS_MOETAB = WS_HIST + 32 * 1024;
constexpr size_t WS_LOGF = 6 * MiB;
constexpr size_t WS_FCUM = 7 * MiB;
constexpr size_t WS_WIN = 8 * MiB, WS_WOUT = 20 * MiB, WS_W1 = 24 * MiB, WS_W2 = 280 * MiB;
constexpr size_t WS_H = 408 * MiB;
constexpr size_t WS_PROJ = 472 * MiB;
constexpr size_t WS_VT = 664 * MiB;
constexpr size_t WS_YMIX = 712 * MiB;
constexpr size_t WS_XA = 776 * MiB, WS_XB = 904 * MiB;
constexpr size_t WS_ACT = 1032 * MiB, WS_Y = 1304 * MiB, WS_END = 1576 * MiB;
static_assert(WS_MOETAB + 256 <= WS_LOGF && (size_t)NSLOT_MAX * 4 <= 576 * 1024 && (size_t)NSLOT_MAX * DM * 2 <= 272 * MiB, "ws map");
constexpr int CW_BAR = 4096;

constexpr int RING_BYTES = 131072;
constexpr int MISC_OFF = RING_BYTES;
constexpr int LDS_BYTES = 147456;

#define RLX_AGENT __ATOMIC_RELAXED, __HIP_MEMORY_SCOPE_AGENT
__device__ __forceinline__ unsigned f2bf(float f) { unsigned u = __builtin_bit_cast(unsigned, f); return (u + 0x7fffu + ((u >> 16) & 1u)) >> 16; }
__device__ __forceinline__ unsigned pk2(float lo, float hi) { return f2bf(lo) | (f2bf(hi) << 16); }
__device__ __forceinline__ float bflo(unsigned u) { return __builtin_bit_cast(float, u << 16); }
__device__ __forceinline__ float bfhi(unsigned u) { return __builtin_bit_cast(float, u & 0xffff0000u); }
__device__ __forceinline__ float wave_sum(float v) {
#pragma unroll
    for (int o = 1; o < 64; o <<= 1) v += __shfl_xor(v, o);
    return v;
}

#define XB_TMO      128
#define XB_XCNT(j)  (256  + 64 * (j))
#define XB_XSUB(j)  (1280 + 64 * (j))
#define XB_XGEN(j)  (2304 + 64 * (j))
#define XB_TOP      3328
#define XB_TOPGEN   3392
#define XCD_BAR_WORDS 3456
#define XB_SPIN_CAP (1u << 18)
__device__ __forceinline__ unsigned xb_ld(unsigned* p)              { return __hip_atomic_load(p, __ATOMIC_RELAXED, __HIP_MEMORY_SCOPE_AGENT); }
__device__ __forceinline__ unsigned xb_add(unsigned* p, unsigned v) { return __hip_atomic_fetch_add(p, v, __ATOMIC_RELAXED, __HIP_MEMORY_SCOPE_AGENT); }
__device__ __forceinline__ unsigned xb_xcc_id() { return (unsigned)__builtin_amdgcn_s_getreg((3 << 11) | 20) & 0xFu; }
#define XB_SPIN(cond, bar) do { unsigned _sp = 0; while (cond) { __builtin_amdgcn_s_sleep(1); \
    if ((++_sp & 255u) == 0u) { if (xb_ld(&(bar)[XB_TMO])) break; if (_sp > XB_SPIN_CAP) { atomicAdd(&(bar)[XB_TMO], 1u); break; } } } } while (0)
struct XcdBarrier { unsigned* bar; unsigned x; volatile LAS unsigned* st; };
__device__ __forceinline__ XcdBarrier xcd_barrier_post(unsigned* bar, volatile LAS unsigned* st) {
    XcdBarrier b; b.bar = bar; b.x = xb_xcc_id(); b.st = st;
    if (threadIdx.x == 0) (void)xb_add(&bar[XB_XCNT(b.x)], 1u);
    return b;
}
__device__ __forceinline__ void xcd_barrier_complete(unsigned* bar, unsigned x, unsigned& nloc, unsigned& nx) {
    const unsigned G = gridDim.x * gridDim.y * gridDim.z;
    unsigned sum, cnt, mine, sp = 0u;
    for (;;) {
        sum = 0u; cnt = 0u; mine = 0u;
#pragma unroll
        for (unsigned j = 0; j < 16; ++j) { const unsigned c = xb_ld(&bar[XB_XCNT(j)]); sum += c; cnt += (c > 0u) ? 1u : 0u; mine = (j == x) ? c : mine; }
        if (sum == G) break;
        __builtin_amdgcn_s_sleep(1);
        if ((++sp & 255u) == 0u) { if (xb_ld(&bar[XB_TMO])) break; if (sp > XB_SPIN_CAP) { atomicAdd(&bar[XB_TMO], 1u); break; } }
    }
    nloc = mine > 0u ? mine : 1u; nx = cnt > 0u ? cnt : 1u;
}
__device__ __forceinline__ void xcd_barrier(const XcdBarrier& b) {
    asm volatile("s_waitcnt vmcnt(0)" ::: "memory");
    __syncthreads();
    if (threadIdx.x == 0) {
        unsigned* bar = b.bar;
        __builtin_amdgcn_s_waitcnt(0);
        unsigned nloc = b.st[0], nx = b.st[1];
        if (nloc == 0u) { xcd_barrier_complete(bar, b.x, nloc, nx); b.st[0] = nloc; b.st[1] = nx; }
        const unsigned old = xb_add(&bar[XB_XSUB(b.x)], 1u);
        const unsigned gen = old / nloc;
        if (old + 1u == (gen + 1u) * nloc) {
            __builtin_amdgcn_fence(__ATOMIC_RELEASE, "agent");
            asm volatile("s_waitcnt vmcnt(0)" ::: "memory");
            const unsigned og = xb_add(&bar[XB_TOP], 1u);
            const unsigned tg = og / nx;
            if (og + 1u == (tg + 1u) * nx) xb_add(&bar[XB_TOPGEN], 1u);
            else XB_SPIN(xb_ld(&bar[XB_TOPGEN]) == tg, bar);
            __builtin_amdgcn_fence(__ATOMIC_ACQUIRE, "agent");
            xb_add(&bar[XB_XGEN(b.x)], 1u);
            asm volatile("s_waitcnt vmcnt(0)" ::: "memory");
        } else {
            XB_SPIN(xb_ld(&bar[XB_XGEN(b.x)]) == gen, bar);
            __builtin_amdgcn_fence(__ATOMIC_ACQUIRE, "agent");
            asm volatile("s_waitcnt vmcnt(0)" ::: "memory");
        }
    }
    __syncthreads();
}

struct Frame {
    LAS unsigned char* lds;
    int tid, lane, wave, blk, G;
    const float* in[21];
    float* out; unsigned char* ws;
};
enum { I_X = 0, I_C, I_N1G, I_WADA, I_BADA, I_WIN, I_CONVW, I_SBQG, I_SBKG, I_FXQG, I_FXKG, I_FXFB, I_ONG, I_WOUT, I_N2G, I_RW, I_RB, I_W1, I_B1, I_W2, I_B2 };

template <int MAP, bool WIDE>
__device__ __forceinline__ void p0_transpose_item(const float* W, int ldw, bf16* WT, LAS float* scr, int k0, int n0, int lane) {
    if (WIDE) {
        f32x4 t[8];
#pragma unroll
        for (int i = 0; i < 8; ++i) t[i] = __builtin_nontemporal_load((const f32x4*)(W + (size_t)(k0 + 8 * i + (lane >> 3)) * ldw + n0 + 4 * (lane & 7)));
#pragma unroll
        for (int i = 0; i < 8; ++i) { LAS float* d = scr + (8 * i + (lane >> 3)) * 33 + 4 * (lane & 7); d[0] = t[i].x; d[1] = t[i].y; d[2] = t[i].z; d[3] = t[i].w; }
    } else {
#pragma unroll 8
        for (int i = 0; i < 32; ++i) { const int kk = 2 * i + (lane >> 5); scr[kk * 33 + (lane & 31)] = W[(size_t)(k0 + kk) * ldw + n0 + (lane & 31)]; }
    }
    asm volatile("s_waitcnt lgkmcnt(0)" ::: "memory");
    const int c = lane & 7;
#pragma unroll
    for (int j = 0; j < 4; ++j) { const int n = (lane >> 3) + 8 * j; const LAS float* s = scr + (8 * c) * 33 + n;
        v4u o; o.x = pk2(s[0 * 33], s[1 * 33]); o.y = pk2(s[2 * 33], s[3 * 33]); o.z = pk2(s[4 * 33], s[5 * 33]); o.w = pk2(s[6 * 33], s[7 * 33]);
        const int cn = n0 + n; int row = cn;
        if (MAP == 1) { const int jj = cn >> 1, t = cn & 1; row = 256 * (jj >> 7) + 128 * t + (jj & 127); }
        *(v4u*)(WT + (size_t)row * 1024 + k0 + 8 * c) = o; }
    asm volatile("s_waitcnt lgkmcnt(0)" ::: "memory");
}
__device__ __forceinline__ void p0_prologue(Frame& F) {
    LAS float* scr = (LAS float*)(F.lds + F.wave * 16384);
    const int gw = F.blk * 8 + F.wave, NGW = F.G * 8;
    for (int it = gw; it < NLAYER * 4 * 24; it += NGW) {
        const int l = it / 96, ks = (it / 24) & 3, nc = it % 24;
        const float* W = F.in[I_WADA] + (size_t)l * DM * 6144 + nc * 256 + F.lane * 4;
        const float* c = F.in[I_C];
        f32x4 acc[NB];
#pragma unroll
        for (int b = 0; b < NB; ++b) acc[b] = (f32x4){0.f, 0.f, 0.f, 0.f};
#pragma unroll 4
        for (int k = ks * 256; k < ks * 256 + 256; ++k) {
            const f32x4 w = *(const f32x4*)(W + (size_t)k * 6144);
#pragma unroll
            for (int b = 0; b < NB; ++b) { const float cv = c[b * DM + k]; const float s = cv / (1.0f + __expf(-cv)); acc[b] += w * s; }
        }
        float* dst = (float*)(F.ws + WS_MODP) + ((size_t)(l * 4 + ks) * NB) * 6144 + nc * 256 + F.lane * 4;
#pragma unroll
        for (int b = 0; b < NB; ++b) *(f32x4*)(dst + (size_t)b * 6144) = acc[b];
    }
    constexpr int I_IN = 16 * 96, I_OUT = 16 * 32, I_1 = 16 * 64, I_2 = 16 * 32;
    constexpr int N_IN = NLAYER * I_IN, N_OUT = NLAYER * I_OUT, N_1 = NLAYER * NEXP * I_1, N_2 = NLAYER * NEXP * I_2;
    for (int it = gw; it < N_IN + N_OUT + N_1 + N_2; it += NGW) {
        int r = it;
        if (r < N_IN) { const int l = r / I_IN, q = r % I_IN, kb = q / 96, nb = q % 96;
            p0_transpose_item<0, false>(F.in[I_WIN] + (size_t)l * DM * D_IN, D_IN, (bf16*)(F.ws + WS_WIN) + (size_t)l * NPROJ * DM, scr, 64 * kb, 32 * nb, F.lane); continue; }
        r -= N_IN;
        if (r < N_OUT) { const int l = r / I_OUT, q = r % I_OUT, kb = q / 32, nb = q % 32;
            p0_transpose_item<0, true>(F.in[I_WOUT] + (size_t)l * DM * DM, DM, (bf16*)(F.ws + WS_WOUT) + (size_t)l * DM * DM, scr, 64 * kb, 32 * nb, F.lane); continue; }
        r -= N_OUT;
        if (r < N_1) { const int le = r / I_1, q = r % I_1, kb = q / 64, nb = q % 64;
            p0_transpose_item<1, true>(F.in[I_W1] + (size_t)le * DM * 2048, 2048, (bf16*)(F.ws + WS_W1) + (size_t)le * 2048 * DM, scr, 64 * kb, 32 * nb, F.lane); continue; }
        r -= N_1;
        { const int le = r / I_2, q = r % I_2, kb = q / 32, nb = q % 32;
            p0_transpose_item<0, true>(F.in[I_W2] + (size_t)le * DM * DM, DM, (bf16*)(F.ws + WS_W2) + (size_t)le * DM * DM, scr, 64 * kb, 32 * nb, F.lane); }
    }
}

__device__ __forceinline__ f32x4 mod4(const Frame& F, int l, int b, int which, int c) {
    const int n = which * DM + c;
    f32x4 s = *(const f32x4*)(F.in[I_BADA] + (size_t)l * 6144 + n);
    const float* p = (const float*)(F.ws + WS_MODP) + ((size_t)(l * 4) * NB + b) * 6144 + n;
#pragma unroll
    for (int ks = 0; ks < 4; ++ks) s += *(const f32x4*)(p + (size_t)ks * NB * 6144);
    return s;
}

constexpr size_t WS_GSUM = WS_FCUM + 800 * 1024;
static_assert(WS_GSUM + 16384 <= WS_WIN, "ws map");
template <bool COMBINE, bool NORM>
__device__ __forceinline__ void row_phase(Frame& F, int l, const float* xsrc, float* xdst) {
    const float* topw = (const float*)(F.ws + WS_TOPW); const int* tokslot = (const int*)(F.ws + WS_TOKSLOT); const bf16* Y = (const bf16*)(F.ws + WS_Y);
    bf16* H = (bf16*)(F.ws + WS_H); float* logf = (float*)(F.ws + WS_LOGF); float* gsum = (float*)(F.ws + WS_GSUM);
    LAS f32x4* wl4 = (LAS f32x4*)F.lds; LAS f32x2* wl2 = (LAS f32x2*)(F.lds + 16384); LAS float* part = (LAS float*)(F.lds + 16384 + 8192);
    if (NORM) { for (int k = F.tid; k < DM; k += 512) { const float* wp = F.in[I_WIN] + (size_t)l * DM * D_IN + (size_t)k * D_IN + NPROJ; const int idx = (4 * (k >> 8) + (k & 3)) * 64 + ((k >> 2) & 63);
            wl4[idx] = (f32x4){wp[0], wp[1], wp[2], wp[3]}; wl2[idx] = (f32x2){wp[4], wp[5]}; }
        __syncthreads(); }
    for (int chunk = F.blk; chunk < NTOK / 128; chunk += F.G) {
        const int b = chunk / (SEQ / 128);
        LAS f32x4* mv = (LAS f32x4*)(F.lds + 32768);
        __syncthreads();
        if (F.wave == 0) {
#pragma unroll
            for (int j = 0; j < 4; ++j) { const int c = 256 * j + 4 * F.lane;
                if (COMBINE) mv[(0 * 4 + j) * 64 + F.lane] = mod4(F, l - 1, b, 5, c);
                if (NORM) { const f32x4 g = *(const f32x4*)(F.in[I_N1G] + (size_t)l * DM + c); mv[(1 * 4 + j) * 64 + F.lane] = g * (mod4(F, l, b, 1, c) + 1.0f); mv[(2 * 4 + j) * 64 + F.lane] = mod4(F, l, b, 0, c); } } }
        __syncthreads();
        float lacc = 0.f;
#pragma unroll 1
        for (int rr = 0; rr < 16; rr += 2) {
            const int row = chunk * 128 + F.wave * 16 + rr;
            f32x4 v[2][4];
#pragma unroll
            for (int u = 0; u < 2; ++u)
#pragma unroll
                for (int j = 0; j < 4; ++j) v[u][j] = *(const f32x4*)(xsrc + (size_t)(row + u) * DM + 256 * j + 4 * F.lane);
            int mofs = F.lane; asm volatile("" : "+v"(mofs));
            if (COMBINE) {
#pragma unroll
                for (int u = 0; u < 2; ++u) {
                    f32x4 s[4];
#pragma unroll
                    for (int j = 0; j < 4; ++j) s[j] = (f32x4){0.f, 0.f, 0.f, 0.f};
#pragma unroll
                    for (int k = 0; k < TOPK; ++k) { const float w = topw[(row + u) * 4 + k]; const int slot = tokslot[(row + u) * 4 + k];
#pragma unroll
                        for (int j = 0; j < 4; ++j) { const v2u yv = *(const v2u*)(Y + (size_t)slot * DM + 256 * j + 4 * F.lane);
                            s[j] += (f32x4){bflo(yv.x), bfhi(yv.x), bflo(yv.y), bfhi(yv.y)} * w; } }
#pragma unroll
                    for (int j = 0; j < 4; ++j) { v[u][j] += mv[(0 * 4 + j) * 64 + mofs] * s[j]; *(f32x4*)(xdst + (size_t)(row + u) * DM + 256 * j + 4 * F.lane) = v[u][j]; }
                }
            }
            if (NORM) {
                float ss[2];
#pragma unroll
                for (int u = 0; u < 2; ++u) { float s = 0.f;
#pragma unroll
                    for (int j = 0; j < 4; ++j) s += (v[u][j].x * v[u][j].x + v[u][j].y * v[u][j].y) + (v[u][j].z * v[u][j].z + v[u][j].w * v[u][j].w);
                    ss[u] = s; }
#pragma unroll
                for (int o = 1; o < 64; o <<= 1) { ss[0] += __shfl_xor(ss[0], o); ss[1] += __shfl_xor(ss[1], o); }
                float fl[2][6];
                int lofs = F.lane; asm volatile("" : "+v"(lofs));
#pragma unroll
                for (int u = 0; u < 2; ++u) { const float rstd = 1.0f / sqrtf(ss[u] * (1.0f / DM) + EPS);
#pragma unroll
                    for (int q = 0; q < 6; ++q) fl[u][q] = 0.f;
#pragma unroll
                    for (int j = 0; j < 4; ++j) { const f32x4 hv = v[u][j] * rstd * mv[(1 * 4 + j) * 64 + mofs] + mv[(2 * 4 + j) * 64 + mofs];
                        v2u o; o.x = pk2(hv.x, hv.y); o.y = pk2(hv.z, hv.w); *(v2u*)(H + (size_t)(row + u) * DM + 256 * j + 4 * F.lane) = o;
#pragma unroll
                        for (int i = 0; i < 4; ++i) { const f32x4 wa = wl4[(4 * j + i) * 64 + lofs]; const f32x2 wb = wl2[(4 * j + i) * 64 + lofs]; const float hx = hv[i];
                            fl[u][0] += hx * wa.x; fl[u][1] += hx * wa.y; fl[u][2] += hx * wa.z; fl[u][3] += hx * wa.w; fl[u][4] += hx * wb.x; fl[u][5] += hx * wb.y; } } }
#pragma unroll
                for (int o = 1; o < 64; o <<= 1)
#pragma unroll
                    for (int u = 0; u < 2; ++u)
#pragma unroll
                        for (int q = 0; q < 6; ++q) fl[u][q] += __shfl_xor(fl[u][q], o);
                if (F.lane < 6) {
#pragma unroll
                    for (int u = 0; u < 2; ++u) { float z = fl[u][0];
#pragma unroll
                        for (int q = 1; q < 6; ++q) z = (F.lane == q) ? fl[u][q] : z;
                        z += F.in[I_FXFB][l * 6 + F.lane];
                        const float lg = fminf(z, 0.f) - __logf(1.0f + __expf(-fabsf(z)));
                        logf[(size_t)(row + u) * 6 + F.lane] = lg; lacc += lg; } }
            }
        }
        if (NORM) {
            if (F.lane < 6) part[F.wave * 8 + F.lane] = lacc;
            __syncthreads();
            if (F.tid < 12) { const int g = F.tid / 6, h = F.tid % 6; gsum[(size_t)(chunk * 2 + g) * 6 + h] = (part[(4 * g) * 8 + h] + part[(4 * g + 1) * 8 + h]) + (part[(4 * g + 2) * 8 + h] + part[(4 * g + 3) * 8 + h]); }
            __syncthreads();
        }
    }
    __syncthreads();
}
__device__ __forceinline__ void p3_postproj(Frame& F, int l) {
    bf16* proj = (bf16*)(F.ws + WS_PROJ); bf16* ymix = (bf16*)(F.ws + WS_YMIX);
    const float* ong = F.in[I_ONG] + (size_t)l * DM;
    const int c4 = 4 * F.lane;
    f32x4 cw[3];
#pragma unroll
    for (int w = 0; w < 3; ++w) cw[w] = *(const f32x4*)(F.in[I_CONVW] + (size_t)(l * 3 + w) * 256 + c4);
    const f32x4 cg = *(const f32x4*)(ong + c4);
    const int e0 = 8 * (F.lane & 7);
    float gq[3][8]; int colv[3];
#pragma unroll
    for (int i = 0; i < 3; ++i) { const int vi = 8 * i + (F.lane >> 3); const int ty = vi / 6;
        colv[i] = (vi < 12 ? COL_SQ + 64 * vi : COL_FQ + 64 * (vi - 12)) + e0;
        const float* gp = (ty == 0 ? F.in[I_SBQG] : ty == 1 ? F.in[I_SBKG] : ty == 2 ? F.in[I_FXQG] : F.in[I_FXKG]) + (size_t)l * 64 + e0; const float sc = (ty == 0 || ty == 2) ? QSCALE : 1.0f;
#pragma unroll
        for (int q = 0; q < 8; ++q) gq[i][q] = gp[q] * sc; }
    LAS unsigned char* scr = F.lds + F.wave * (64 * 144);
    for (int tile = F.blk; tile < NTOK / 64; tile += F.G) {
        const int b = tile / (SEQ / 64), s0 = (tile % (SEQ / 64)) * 64; const size_t row0 = (size_t)b * SEQ + s0;
        {
            const int sw0 = s0 + F.wave * 8;
            f32x4 vm2 = (f32x4){0.f, 0.f, 0.f, 0.f}, vm1 = vm2;
            if (sw0 >= 2) {
                const bf16* p2 = proj + ((size_t)b * SEQ + sw0 - 2) * NPROJ; const bf16* p1 = p2 + NPROJ;
                const v2u c2 = *(const v2u*)(p2 + COL_CC + c4), u2 = *(const v2u*)(p2 + COL_CU + c4), c1 = *(const v2u*)(p1 + COL_CC + c4), u1 = *(const v2u*)(p1 + COL_CU + c4);
                vm2 = (f32x4){bflo(c2.x) * bflo(u2.x), bfhi(c2.x) * bfhi(u2.x), bflo(c2.y) * bflo(u2.y), bfhi(c2.y) * bfhi(u2.y)};
                vm1 = (f32x4){bflo(c1.x) * bflo(u1.x), bfhi(c1.x) * bfhi(u1.x), bflo(c1.y) * bflo(u1.y), bfhi(c1.y) * bfhi(u1.y)}; }
#pragma unroll 1
            for (int tt = 0; tt < 8; tt += 2) {
                bf16* pr[2]; v2u cb[2], cc[2], cu[2]; v4u xq[2][3];
#pragma unroll
                for (int u = 0; u < 2; ++u) { pr[u] = proj + ((size_t)b * SEQ + sw0 + tt + u) * NPROJ;
                    cb[u] = *(const v2u*)(pr[u] + COL_CB + c4); cc[u] = *(const v2u*)(pr[u] + COL_CC + c4); cu[u] = *(const v2u*)(pr[u] + COL_CU + c4);
#pragma unroll
                    for (int i = 0; i < 3; ++i) xq[u][i] = *(const v4u*)(pr[u] + colv[i]); }
                f32x4 y[2]; float ss[2], q2[2][3];
#pragma unroll
                for (int u = 0; u < 2; ++u) {
                    const f32x4 v0 = (f32x4){bflo(cc[u].x) * bflo(cu[u].x), bfhi(cc[u].x) * bfhi(cu[u].x), bflo(cc[u].y) * bflo(cu[u].y), bfhi(cc[u].y) * bfhi(cu[u].y)};
                    y[u] = cw[0] * vm2 + cw[1] * vm1 + cw[2] * v0; vm2 = vm1; vm1 = v0;
                    y[u] = y[u] * (f32x4){bflo(cb[u].x), bfhi(cb[u].x), bflo(cb[u].y), bfhi(cb[u].y)};
                    ss[u] = (y[u].x * y[u].x + y[u].y * y[u].y) + (y[u].z * y[u].z + y[u].w * y[u].w);
#pragma unroll
                    for (int i = 0; i < 3; ++i) { const v4u x = xq[u][i]; const float f[8] = {bflo(x.x), bfhi(x.x), bflo(x.y), bfhi(x.y), bflo(x.z), bfhi(x.z), bflo(x.w), bfhi(x.w)};
                        float a = 0.f;
#pragma unroll
                        for (int k = 0; k < 8; ++k) a += f[k] * f[k];
                        q2[u][i] = a; } }
#pragma unroll
                for (int o = 1; o < 16; o <<= 1)
#pragma unroll
                    for (int u = 0; u < 2; ++u) { ss[u] += __shfl_xor(ss[u], o);
                        if (o < 8) {
#pragma unroll
                            for (int i = 0; i < 3; ++i) q2[u][i] += __shfl_xor(q2[u][i], o); } }
#pragma unroll
                for (int u = 0; u < 2; ++u) {
                    const float rinv = 1.0f / sqrtf(ss[u] * (1.0f / 64.0f) + EPS);
                    const f32x4 yo = y[u] * rinv * cg;
                    v2u o; o.x = pk2(yo.x, yo.y); o.y = pk2(yo.z, yo.w); *(v2u*)(ymix + ((size_t)b * SEQ + sw0 + tt + u) * DM + c4) = o;
#pragma unroll
                    for (int i = 0; i < 3; ++i) { const v4u x = xq[u][i]; const float f[8] = {bflo(x.x), bfhi(x.x), bflo(x.y), bfhi(x.y), bflo(x.z), bfhi(x.z), bflo(x.w), bfhi(x.w)};
                        const float ri = 1.0f / sqrtf(q2[u][i] * (1.0f / 64.0f) + EPS);
                        v4u w; w.x = pk2(f[0] * ri * gq[i][0], f[1] * ri * gq[i][1]); w.y = pk2(f[2] * ri * gq[i][2], f[3] * ri * gq[i][3]);
                        w.z = pk2(f[4] * ri * gq[i][4], f[5] * ri * gq[i][5]); w.w = pk2(f[6] * ri * gq[i][6], f[7] * ri * gq[i][7]);
                        *(v4u*)(pr[u] + colv[i]) = w; } }
            }
        }
        for (int t = F.wave; t < 12; t += 8) {
            const int kind = t / 6, h = t % 6; const int col = (kind ? COL_FV : COL_SV) + 64 * h;
            const bf16* src = proj + (row0 + F.lane) * NPROJ + col;
#pragma unroll
            for (int pc = 0; pc < 8; ++pc) { const v4u x = *(const v4u*)(src + 8 * pc);
                const unsigned xs[4] = {x.x, x.y, x.z, x.w};
#pragma unroll
                for (int q = 0; q < 4; ++q) { *(LAS unsigned short*)(scr + (8 * pc + 2 * q) * 144 + 2 * F.lane) = (unsigned short)(xs[q] & 0xffffu);
                                              *(LAS unsigned short*)(scr + (8 * pc + 2 * q + 1) * 144 + 2 * F.lane) = (unsigned short)(xs[q] >> 16); } }
            asm volatile("s_waitcnt lgkmcnt(0)" ::: "memory");
            bf16* dst = (bf16*)(F.ws + WS_VT) + (size_t)kind * (48 * 64 * SEQ) + ((size_t)(b * 6 + h) * 64 + F.lane) * SEQ + s0;
#pragma unroll
            for (int pc = 0; pc < 8; ++pc) *(v4u*)(dst + 8 * pc) = *(const LAS v4u*)(scr + F.lane * 144 + 16 * pc);
            asm volatile("s_waitcnt lgkmcnt(0)" ::: "memory");
        }
        if (F.wave == 7) { const int gt = tile % (SEQ / 64); const float* gs = (const float*)(F.ws + WS_GSUM) + (size_t)(b * (SEQ / 64)) * 6; const float* lf = (const float*)(F.ws + WS_LOGF) + (row0 + F.lane) * 6;
            float* fo = (float*)(F.ws + WS_FCUM) + (size_t)(b * 6) * SEQ + s0 + F.lane;
#pragma unroll
            for (int h = 0; h < 6; ++h) { float base = (F.lane < gt) ? gs[F.lane * 6 + h] : 0.f; base = wave_sum(base);
                float inc = lf[h];
#pragma unroll
                for (int o = 1; o < 64; o <<= 1) { const float t = __shfl_up(inc, o); if (F.lane >= o) inc += t; }
                fo[(size_t)h * SEQ] = (base + inc) * LOG2E; } }
    }
}

__device__ __forceinline__ void p4_attention(Frame& F, int l) {
    att::Tensors Ts, Tf;
    Ts.proj = (const bf16*)(F.ws + WS_PROJ); Ts.vt = (const bf16*)(F.ws + WS_VT); Ts.fcum = (const float*)(F.ws + WS_FCUM); Ts.ymix = (bf16*)(F.ws + WS_YMIX); Ts.ong = F.in[I_ONG] + (size_t)l * DM;
    Ts.colq = COL_SQ; Ts.colk = COL_SK; Ts.coly = 256;
    Tf = Ts; Tf.vt = Ts.vt + (size_t)48 * 64 * SEQ; Tf.colq = COL_FQ; Tf.colk = COL_FK; Tf.coly = 640;
    const int NU = 2 * 48 * 16;
    for (int i = 0;; ++i) {
        const int L = (i & 1) ? (i + 1) * F.G - 1 - F.blk : i * F.G + F.blk;
        if (i * F.G >= NU) break;
        if (L >= NU) continue;
        const int qb = 15 - L / 96, j = L % 96, kind = j / 48, bh = j % 48;
        if (kind == 0) att::unit<0>(Ts, bh / 6, bh % 6, qb, F.lds); else att::unit<1>(Tf, bh / 6, bh % 6, qb, F.lds);
    }
}

__device__ __forceinline__ void top4of8(const float (&v)[8], const int (&ix)[8], float (&tv)[4], int (&ti)[4]) {
    float w[8];
#pragma unroll
    for (int j = 0; j < 8; ++j) w[j] = v[j];
#pragma unroll
    for (int k = 0; k < 4; ++k) { float bv = w[0]; int bi = ix[0];
#pragma unroll
        for (int j = 1; j < 8; ++j) { const bool t = (w[j] > bv) || (w[j] == bv && ix[j] < bi); bv = t ? w[j] : bv; bi = t ? ix[j] : bi; }
        tv[k] = bv; ti[k] = bi;
#pragma unroll
        for (int j = 0; j < 8; ++j) w[j] = (ix[j] == bi) ? -INFINITY : w[j]; }
}
__device__ __forceinline__ void p6_norm_router(Frame& F, int l, const float* x1) {
    bf16* H = (bf16*)(F.ws + WS_H); float* topw = (float*)(F.ws + WS_TOPW); int* route = (int*)(F.ws + WS_ROUTE); int* hist = (int*)(F.ws + WS_HIST);
    const float* rw = F.in[I_RW] + (size_t)l * DM * NEXP; const float* rb = F.in[I_RB] + (size_t)l * NEXP;
    constexpr int RWP = 2064;
    LAS unsigned char* rwt = F.lds;
    LAS int* cnt = (LAS int*)(F.lds + MISC_OFF + 256);
    for (int idx = F.tid; idx < DM * NEXP; idx += 512) { const int k = idx >> 5, ex = idx & 31; *(LAS unsigned short*)(rwt + ex * RWP + k * 2) = (unsigned short)f2bf(rw[idx]); }
    __syncthreads();
    const int fr = F.lane & 15, fq = F.lane >> 4;
    float rbv[8]; int eix[8];
#pragma unroll
    for (int i = 0; i < 4; ++i) { eix[i] = 4 * fq + i; eix[4 + i] = 16 + 4 * fq + i; rbv[i] = rb[4 * fq + i]; rbv[4 + i] = rb[16 + 4 * fq + i]; }
    for (int chunk = F.blk; chunk < NTOK / 128; chunk += F.G) {
        const int b = chunk / (SEQ / 128);
        if (F.tid < 32) cnt[F.tid] = 0;
        __syncthreads();
        f32x4 A[4], Bv[4];
#pragma unroll
        for (int j = 0; j < 4; ++j) { const int c = 256 * j + 4 * F.lane; const f32x4 g = *(const f32x4*)(F.in[I_N2G] + (size_t)l * DM + c); A[j] = g * (mod4(F, l, b, 4, c) + 1.0f); Bv[j] = mod4(F, l, b, 3, c); }
        const int row0 = chunk * 128 + F.wave * 16;
#pragma unroll 1
        for (int rr = 0; rr < 16; rr += 2) {
            f32x4 v[2][4]; float ss[2];
#pragma unroll
            for (int u = 0; u < 2; ++u)
#pragma unroll
                for (int j = 0; j < 4; ++j) v[u][j] = *(const f32x4*)(x1 + (size_t)(row0 + rr + u) * DM + 256 * j + 4 * F.lane);
#pragma unroll
            for (int u = 0; u < 2; ++u) { float s = 0.f;
#pragma unroll
                for (int j = 0; j < 4; ++j) s += (v[u][j].x * v[u][j].x + v[u][j].y * v[u][j].y) + (v[u][j].z * v[u][j].z + v[u][j].w * v[u][j].w);
                ss[u] = s; }
#pragma unroll
            for (int o = 1; o < 64; o <<= 1) { ss[0] += __shfl_xor(ss[0], o); ss[1] += __shfl_xor(ss[1], o); }
#pragma unroll
            for (int u = 0; u < 2; ++u) { const float rstd = 1.0f / sqrtf(ss[u] * (1.0f / DM) + EPS);
#pragma unroll
                for (int j = 0; j < 4; ++j) { const f32x4 hv = v[u][j] * rstd * A[j] + Bv[j];
                    v2u o; o.x = pk2(hv.x, hv.y); o.y = pk2(hv.z, hv.w); *(v2u*)(H + (size_t)(row0 + rr + u) * DM + 256 * j + 4 * F.lane) = o; } }
        }
        asm volatile("s_waitcnt vmcnt(0)" ::: "memory");
        f32x4 acc0 = (f32x4){0.f, 0.f, 0.f, 0.f}, acc1 = (f32x4){0.f, 0.f, 0.f, 0.f};
        { const bf16* hp = H + (size_t)(row0 + fr) * DM + 8 * fq; const LAS unsigned char* wp = rwt + fr * RWP + 16 * fq;
#pragma unroll 8
          for (int s = 0; s < 32; ++s) { const v4u hb = __builtin_nontemporal_load((const v4u*)(hp + 32 * s));
              const bf16x8 a0 = *(const LAS bf16x8*)(wp + 64 * s), a1 = *(const LAS bf16x8*)(wp + 16 * RWP + 64 * s);
              acc0 = __builtin_amdgcn_mfma_f32_16x16x32_bf16(a0, __builtin_bit_cast(bf16x8, hb), acc0, 0, 0, 0);
              acc1 = __builtin_amdgcn_mfma_f32_16x16x32_bf16(a1, __builtin_bit_cast(bf16x8, hb), acc1, 0, 0, 0); } }
        float cv[8], tv[4], ov[8]; int ti[4], oi[8];
#pragma unroll
        for (int i = 0; i < 4; ++i) { cv[i] = acc0[i] + rbv[i]; cv[4 + i] = acc1[i] + rbv[4 + i]; }
        top4of8(cv, eix, tv, ti);
#pragma unroll
        for (int st = 16; st <= 32; st <<= 1) {
#pragma unroll
            for (int k = 0; k < 4; ++k) { ov[k] = tv[k]; oi[k] = ti[k]; ov[4 + k] = __shfl_xor(tv[k], st); oi[4 + k] = __shfl_xor(ti[k], st); }
            top4of8(ov, oi, tv, ti); }
        const float e1 = __expf(tv[1] - tv[0]), e2 = __expf(tv[2] - tv[0]), e3 = __expf(tv[3] - tv[0]); const float inv = 1.0f / (1.0f + e1 + e2 + e3);
        { const int row = row0 + fr, k = fq;
          const float w = (k == 0 ? 1.0f : k == 1 ? e1 : k == 2 ? e2 : e3) * inv; const int ex = (k == 0 ? ti[0] : k == 1 ? ti[1] : k == 2 ? ti[2] : ti[3]);
          const int pos = __hip_atomic_fetch_add(cnt + ex, 1, __ATOMIC_RELAXED, __HIP_MEMORY_SCOPE_WORKGROUP);
          topw[row * 4 + k] = w; route[row * 4 + k] = ex + 32 * pos; }
        __syncthreads();
        if (F.tid < 32) hist[chunk * 32 + F.tid] = cnt[F.tid];
        __syncthreads();
    }
}

__device__ __forceinline__ void p7_scatter(Frame& F) {
    const int* hist = (const int*)(F.ws + WS_HIST); const int* route = (const int*)(F.ws + WS_ROUTE);
    int* tokslot = (int*)(F.ws + WS_TOKSLOT); int* slottok = (int*)(F.ws + WS_SLOTTOK); int* moetab = (int*)(F.ws + WS_MOETAB);
    LAS int* pre = (LAS int*)F.lds;
    LAS int* base = (LAS int*)(F.lds + 32768);
    for (int i = F.tid; i < 256 * 32; i += 512) pre[i] = hist[i];
    __syncthreads();
    if (F.tid < 32) { int run = 0;
        for (int c = 0; c < 256; ++c) { const int v = pre[c * 32 + F.tid]; pre[c * 32 + F.tid] = run; run += v; }
        base[64 + F.tid] = run; }
    __syncthreads();
    if (F.tid == 0) { int run = 0; for (int ex = 0; ex < NEXP; ++ex) { base[ex] = run; run += (base[64 + ex] + 255) & ~255; } base[NEXP] = run; }
    __syncthreads();
    if (F.blk == 0 && F.tid <= NEXP) moetab[F.tid] = base[F.tid] >> 8;
    for (int chunk = F.blk; chunk < NTOK / 128; chunk += F.G) {
        const int t = chunk * 128 + (F.tid >> 2), k = F.tid & 3; const int rt = route[t * 4 + k]; const int ex = rt & 31, pos = rt >> 5;
        const int slot = base[ex] + pre[chunk * 32 + ex] + pos;
        tokslot[t * 4 + k] = slot; slottok[slot] = t;
    }
    for (int ex = F.blk; ex < NEXP; ex += F.G) { const int lo = base[ex] + base[64 + ex], hi = base[ex + 1]; for (int s = lo + F.tid; s < hi; s += 512) slottok[s] = 0; }
    __syncthreads();
}

struct Args { const float* in[21]; float* out; unsigned char* ws; int ph_lo, ph_hi; };
__device__ __forceinline__ void launder(Frame& F) { int t = threadIdx.x; asm volatile("" : "+v"(t)); F.tid = t; F.lane = t & 63; F.wave = __builtin_amdgcn_readfirstlane(t >> 6);
    const __attribute__((address_space(4))) Args* ap = (const __attribute__((address_space(4))) Args*)__builtin_amdgcn_kernarg_segment_ptr(); asm volatile("" : "+s"(ap));
#pragma unroll
    for (int i = 0; i < 21; ++i) F.in[i] = ap->in[i];
    F.out = ap->out; F.ws = ap->ws; }
constexpr int N_PHASES = 1 + 9 * NLAYER + 1;

#define PHASE_FN __device__ __forceinline__
__device__ __forceinline__ void make_frame(Frame& F, LAS unsigned char* lds) { F.lds = lds; F.blk = blockIdx.x; F.G = gridDim.x; launder(F); }
PHASE_FN void ph_prologue(LAS unsigned char* lds) { Frame F; make_frame(F, lds); p0_prologue(F); }
PHASE_FN void ph_norm1(LAS unsigned char* lds, int l) { Frame F; make_frame(F, lds);
    if (l == 0) row_phase<false, true>(F, 0, F.in[I_X], nullptr); else row_phase<true, true>(F, l, (const float*)(F.ws + WS_XA), (float*)(F.ws + WS_XB)); }
PHASE_FN void ph_proj(LAS unsigned char* lds, int l) { Frame F; make_frame(F, lds);
    pg8::Gemm g{(const bf16*)(F.ws + WS_H), (const bf16*)(F.ws + WS_WIN) + (size_t)l * NPROJ * DM, nullptr, DM};
    pg8::StaticOrder S; S.init(NTOK, NPROJ, F.G, F.blk);
    pg8::EpiProj E{(bf16*)(F.ws + WS_PROJ), NPROJ};
    pg8::gemm_phase<pg8::EpiProj, pg8::StaticOrder, false>(F.lds, g, S, E); }
PHASE_FN void ph_postproj(LAS unsigned char* lds, int l) { Frame F; make_frame(F, lds); p3_postproj(F, l); }
PHASE_FN void ph_attn(LAS unsigned char* lds, int l) { Frame F; make_frame(F, lds); p4_attention(F, l); }
PHASE_FN void ph_out(LAS unsigned char* lds, int l) { Frame F; make_frame(F, lds);
    const float* xin = (l == 0) ? F.in[I_X] : (const float*)(F.ws + WS_XB);
    pg8::Gemm g{(const bf16*)(F.ws + WS_YMIX), (const bf16*)(F.ws + WS_WOUT) + (size_t)l * DM * DM, nullptr, DM};
    pg8::StaticOrder S; S.init(NTOK, DM, F.G, F.blk);
    pg8::EpiResGate E{xin, (float*)(F.ws + WS_XA), F.in[I_BADA] + (size_t)l * 6144 + 2 * DM, (const float*)(F.ws + WS_MODP) + (size_t)l * 4 * NB * 6144 + 2 * DM};
    pg8::gemm_phase<pg8::EpiResGate, pg8::StaticOrder, false>(F.lds, g, S, E); }
PHASE_FN void ph_router(LAS unsigned char* lds, int l) { Frame F; make_frame(F, lds); p6_norm_router(F, l, (const float*)(F.ws + WS_XA)); }
PHASE_FN void ph_scatter(LAS unsigned char* lds) { Frame F; make_frame(F, lds); p7_scatter(F); }
__device__ __forceinline__ LAS int* moe_table(Frame& F) { LAS int* tb = (LAS int*)(F.lds + MISC_OFF + 64);
    if (F.tid <= NEXP) tb[F.tid] = ((const int*)(F.ws + WS_MOETAB))[F.tid];
    __syncthreads(); return tb; }
PHASE_FN void ph_moe_up(LAS unsigned char* lds, int l) { Frame F; make_frame(F, lds); LAS int* tb = moe_table(F);
    pg8::Gemm g{(const bf16*)(F.ws + WS_H), (const bf16*)(F.ws + WS_W1) + (size_t)l * NEXP * 2048 * DM, (const int*)(F.ws + WS_SLOTTOK), DM};
    pg8::MoeOrder S; S.init(tb, 8, F.G, F.blk);
    pg8::EpiSwiglu E{(bf16*)(F.ws + WS_ACT), F.in[I_B1] + (size_t)l * NEXP * 2048};
    pg8::gemm_phase<pg8::EpiSwiglu, pg8::MoeOrder, true>(F.lds, g, S, E); }
PHASE_FN void ph_moe_down(LAS unsigned char* lds, int l) { Frame F; make_frame(F, lds); LAS int* tb = moe_table(F);
    pg8::Gemm g{(const bf16*)(F.ws + WS_ACT), (const bf16*)(F.ws + WS_W2) + (size_t)l * NEXP * DM * DM, nullptr, DM};
    pg8::MoeOrder S; S.init(tb, 4, F.G, F.blk);
    pg8::EpiY E{(bf16*)(F.ws + WS_Y), F.in[I_B2] + (size_t)l * NEXP * DM};
    pg8::gemm_phase<pg8::EpiY, pg8::MoeOrder, false>(F.lds, g, S, E); }
PHASE_FN void ph_final(LAS unsigned char* lds) { Frame F; make_frame(F, lds); row_phase<true, false>(F, NLAYER, (const float*)(F.ws + WS_XA), F.out); }

#ifndef REP_MASK
#define REP_MASK 0
#endif
__global__ void __launch_bounds__(512, 2) fwd_kernel(Args args) {
    extern __shared__ __attribute__((aligned(16))) unsigned char lds_raw[];
    LAS unsigned char* lds = (LAS unsigned char*)lds_raw;
    volatile LAS unsigned* MISC = (volatile LAS unsigned*)(lds + MISC_OFF);
    if (threadIdx.x < 16) MISC[threadIdx.x] = 0u;
    __syncthreads();
    const int lo = args.ph_lo, hi = args.ph_hi;
    const bool multi = (hi - lo) > 1;
    XcdBarrier bar; bar.bar = (unsigned*)(args.ws + WS_CTL) + CW_BAR; bar.x = 0; bar.st = MISC;
    if (multi) bar = xcd_barrier_post((unsigned*)(args.ws + WS_CTL) + CW_BAR, MISC);
#define IN(k) (lo <= (k) && (k) < hi)
#define SEAM(k) do { if (IN((k) + 1)) xcd_barrier(bar); } while (0)
#define REPS(j) for (int rep_ = 0; rep_ < (((REP_MASK >> (j)) & 1) ? 2 : 1); ++rep_)
    if (IN(0)) { REPS(0) { ph_prologue(lds); SEAM(0); } }
    for (int l = 0; l < NLAYER; ++l) {
        const int p = 1 + 9 * l;
        if (IN(p + 0)) { REPS(1) { ph_norm1(lds, l); SEAM(p + 0); } }
        if (IN(p + 1)) { REPS(2) { ph_proj(lds, l); SEAM(p + 1); } }
        if (IN(p + 2)) { ph_postproj(lds, l); SEAM(p + 2); }
        if (IN(p + 3)) { REPS(4) { ph_attn(lds, l); SEAM(p + 3); } }
        if (IN(p + 4)) { REPS(5) { ph_out(lds, l); SEAM(p + 4); } }
        if (IN(p + 5)) { REPS(6) { ph_router(lds, l); SEAM(p + 5); } }
        if (IN(p + 6)) { REPS(7) { ph_scatter(lds); SEAM(p + 6); } }
        if (IN(p + 7)) { REPS(8) { ph_moe_up(lds, l); SEAM(p + 7); } }
        if (IN(p + 8)) { REPS(9) { ph_moe_down(lds, l); SEAM(p + 8); } }
    }
    if (IN(N_PHASES - 1)) { REPS(10) { ph_final(lds); } }
#undef IN
#undef SEAM
#undef REPS
}

template <int KIND> __global__ void __launch_bounds__(512, 2) phase_kernel(Args args, int l) {
    extern __shared__ __attribute__((aligned(16))) unsigned char lds_raw[];
    LAS unsigned char* lds = (LAS unsigned char*)lds_raw;
    if (KIND == 0) ph_prologue(lds); if (KIND == 1) ph_norm1(lds, l); if (KIND == 2) ph_proj(lds, l); if (KIND == 3) ph_postproj(lds, l); if (KIND == 4) ph_attn(lds, l);
    if (KIND == 5) ph_out(lds, l); if (KIND == 6) ph_router(lds, l); if (KIND == 7) ph_scatter(lds); if (KIND == 8) ph_moe_up(lds, l); if (KIND == 9) ph_moe_down(lds, l); if (KIND == 10) ph_final(lds);
}
template <int KIND> static void launch_phase(const Args& a, int l, int grid, hipStream_t stream) {
    static bool attr = false;
    if (!attr) { (void)hipFuncSetAttribute((const void*)phase_kernel<KIND>, hipFuncAttributeMaxDynamicSharedMemorySize, LDS_BYTES); attr = true; }
    for (int rep = 0; rep < (((REP_MASK >> KIND) & 1) ? 2 : 1); ++rep) hipLaunchKernelGGL(phase_kernel<KIND>, dim3(grid), dim3(512), LDS_BYTES, stream, a, l);
}
#ifndef MK_SPLIT
#define MK_SPLIT 0
#endif
extern "C" void kernel_launch(void* const* d_in, const int* in_sizes, int n_in, void* d_out, int out_size, void* d_ws, size_t ws_size, hipStream_t stream) {
    static int grid = 0;
    if (grid == 0) {
        if (n_in != 21 || in_sizes[0] != NTOK * DM || out_size != NTOK * DM || ws_size < WS_END) {
            fprintf(stderr, "kernel_launch: unexpected shapes: n_in %d in0 %d out %d ws %zu (need %zu)\n", n_in, n_in > 0 ? in_sizes[0] : -1, out_size, ws_size, (size_t)WS_END); grid = -1; return; }
        int dev = 0, cus = 0, per_cu = 0;
        if (hipGetDevice(&dev) != hipSuccess || hipDeviceGetAttribute(&cus, hipDeviceAttributeMultiprocessorCount, dev) != hipSuccess) { fprintf(stderr, "kernel_launch: device query failed\n"); grid = -1; return; }
        if (hipFuncSetAttribute((const void*)fwd_kernel, hipFuncAttributeMaxDynamicSharedMemorySize, LDS_BYTES) != hipSuccess) { fprintf(stderr, "kernel_launch: hipFuncSetAttribute failed\n"); grid = -1; return; }
        if (hipOccupancyMaxActiveBlocksPerMultiprocessor(&per_cu, (const void*)fwd_kernel, 512, LDS_BYTES) != hipSuccess || per_cu < 1) fprintf(stderr, "kernel_launch: note: occupancy query says %d\n", per_cu);
        (void)hipGetLastError();
        grid = cus;
    }
    if (grid < 0) return;
    (void)hipMemsetAsync((char*)d_ws + WS_CTL, 0, CTL_ZERO_BYTES, stream);
    Args a{};
    for (int i = 0; i < 21; ++i) a.in[i] = (const float*)d_in[i];
    a.out = (float*)d_out; a.ws = (unsigned char*)d_ws;
#if MK_SPLIT
    a.ph_lo = 0; a.ph_hi = 0;
    launch_phase<0>(a, 0, grid, stream);
    for (int l = 0; l < NLAYER; ++l) { launch_phase<1>(a, l, grid, stream); launch_phase<2>(a, l, grid, stream); launch_phase<3>(a, l, grid, stream); launch_phase<4>(a, l, grid, stream); launch_phase<5>(a, l, grid, stream);
        launch_phase<6>(a, l, grid, stream); launch_phase<7>(a, l, grid, stream); launch_phase<8>(a, l, grid, stream); launch_phase<9>(a, l, grid, stream); }
    launch_phase<10>(a, 0, grid, stream);
#else
    a.ph_lo = 0; a.ph_hi = N_PHASES; hipLaunchKernelGGL(fwd_kernel, dim3(grid), dim3(512), LDS_BYTES, stream, a);
#endif
}
```

```cpp
#include <hip/hip_runtime.h>
#include <cstdio>
#include <cstdint>

#define GAS __attribute__((address_space(1)))
#define LAS __attribute__((address_space(3)))
typedef unsigned short bf16;
typedef unsigned v4u __attribute__((ext_vector_type(4)));
typedef unsigned v2u __attribute__((ext_vector_type(2)));
typedef float f32x4 __attribute__((ext_vector_type(4)));
typedef float f32x2 __attribute__((ext_vector_type(2)));
typedef float f32x16 __attribute__((ext_vector_type(16)));
typedef short bf16x8 __attribute__((ext_vector_type(8)));
typedef _Float16 f16x8 __attribute__((ext_vector_type(8)));
typedef _Float16 f16x2 __attribute__((ext_vector_type(2)));

namespace pg8 {
constexpr int BM = 256, BK = 64, HALF = 128, HTB = HALF * BK * 2  , STAGE_BYTES = 8 * HTB, NXCD = 8, WGM = 8;

__host__ __device__ __forceinline__ int lds_byte(int r, int c) { const int st = (r >> 4) * 2 + (c >> 5), rr = r & 15, cc = c & 31, ob = rr * 64 + cc * 2; return st * 1024 + (ob ^ (((ob >> 9) & 1) << 5)); }
__host__ __device__ __forceinline__ void stage_rc(int b, int& R, int& C) { const int st = b / 1024, sb = b % 1024, swz = sb ^ (((sb >> 9) & 1) << 5); R = (st >> 1) * 16 + swz / 64; C = (st & 1) * 32 + (swz % 64) / 2; }
__host__ __device__ __forceinline__ int perm32(int rho) { const int n = rho >> 4, i = rho & 15; return 8 * (i >> 2) + 4 * n + (i & 3); }

struct Unit { int pm, pn, pb; };
struct Gemm { const bf16* A; const bf16* Bt; const int* rowmap; int K; };

__device__ __forceinline__ unsigned cvt_pk_bf16(float lo, float hi) { unsigned r; asm volatile("v_cvt_pk_bf16_f32 %0, %1, %2" : "=v"(r) : "v"(lo), "v"(hi)); return r; }

template <class Epi, class Sched, bool GATHER>
__device__ __forceinline__ void gemm_phase(LAS unsigned char* lds, const Gemm g, const Sched& S, const Epi& E) {
    int tid_ = threadIdx.x; asm volatile("" : "+v"(tid_));
    const int tid = tid_, wid = __builtin_amdgcn_readfirstlane(tid >> 6), lane = tid & 63, wr = wid >> 2, wc = wid & 3, fr = lane & 15, fq = lane >> 4;
    const int K = g.K, nt = K / BK;
    unsigned voffA[2], voffB[2]; int RA[2], CA[2];
#pragma unroll
    for (int i = 0; i < 2; ++i) { int R, C; stage_rc(tid * 16 + i * 8192, R, C); const int Rb = Epi::PERM ? ((R & ~31) + perm32(R & 31)) : R; RA[i] = R; CA[i] = C;
        voffA[i] = (unsigned)(R * K + C) * 2u; voffB[i] = (unsigned)(Rb * K + C) * 2u; }
    const size_t kstep = (size_t)(BK * 2);
    const size_t hstep = (size_t)HALF * K * 2;
    const size_t tstep = 2 * hstep;
    const unsigned ldsw = (unsigned)wid * 1024u;
    const int aoff = lds_byte(wr * 64 + fr, fq * 8), boff = lds_byte(wc * 32 + fr, fq * 8);
#define PG8_SA(b, h) (((b) * 2 + (h)) * HTB)
#define PG8_SB(b, h) ((4 + (b) * 2 + (h)) * HTB)
#define PG8_STAGE(bufoff, gbase, voff) do { _Pragma("unroll") for (int _i = 0; _i < 2; ++_i) \
        __builtin_amdgcn_global_load_lds((const unsigned*)((const char*)(gbase) + (voff)[_i]), (LAS unsigned*)(lds + (bufoff) + ldsw + _i * 8192), 16, 0, 0); } while (0)
#define PG8_STAGEA(bufoff, pbase, h, nx) do { if constexpr (GATHER) { _Pragma("unroll") for (int _i = 0; _i < 2; ++_i) \
        __builtin_amdgcn_global_load_lds((const unsigned*)((const char*)(pbase) + ((nx) ? gn[h][_i] : gc[h][_i])), (LAS unsigned*)(lds + (bufoff) + ldsw + _i * 8192), 16, 0, 0); } \
        else { PG8_STAGE(bufoff, (const char*)(pbase) + (h) * hstep, voffA); } } while (0)
#define PG8_LDA(dst, b, h) do { _Pragma("unroll") for (int m = 0; m < 4; ++m) _Pragma("unroll") for (int k = 0; k < 2; ++k) dst[m][k] = *(const LAS bf16x8*)(lds + PG8_SA(b, h) + aoff + m * 2048 + k * 1024); } while (0)
#define PG8_LDB(dst, b, h) do { _Pragma("unroll") for (int n = 0; n < 2; ++n) _Pragma("unroll") for (int k = 0; k < 2; ++k) dst[n][k] = *(const LAS bf16x8*)(lds + PG8_SB(b, h) + boff + n * 2048 + k * 1024); } while (0)
#define PG8_MMA(ai, bj, At, Bt) do { __builtin_amdgcn_s_setprio(1); _Pragma("unroll") for (int m = 0; m < 4; ++m) _Pragma("unroll") for (int n = 0; n < 2; ++n) _Pragma("unroll") for (int k = 0; k < 2; ++k) \
        acc[ai][bj][m][n] = __builtin_amdgcn_mfma_f32_16x16x32_bf16(Bt[n][k], At[m][k], acc[ai][bj][m][n], 0, 0, 0); __builtin_amdgcn_s_setprio(0); } while (0)
#define PG8_WAIT_V(n) asm volatile("s_waitcnt vmcnt(" #n ")" ::: "memory")
#define PG8_WAIT_L(n) asm volatile("s_waitcnt lgkmcnt(" #n ")" ::: "memory")
#define PG8_BAR __builtin_amdgcn_s_barrier()
#define PG8_SCHED __builtin_amdgcn_sched_barrier(0)
    Unit cur, nxt; int ui = 0;
    if (!S.next(0, cur)) return;
    f32x4 acc[2][2][4][2];
#pragma unroll
    for (int a = 0; a < 2; ++a)
#pragma unroll
        for (int b = 0; b < 2; ++b)
#pragma unroll
            for (int m = 0; m < 4; ++m)
#pragma unroll
                for (int n = 0; n < 2; ++n) acc[a][b][m][n] = (f32x4){0.f, 0.f, 0.f, 0.f};
    bf16x8 At[4][2], B0[2][2], B1[2][2];
    unsigned gc[2][2], gn[2][2];
    if constexpr (GATHER) {
#pragma unroll
        for (int h = 0; h < 2; ++h)
#pragma unroll
            for (int i = 0; i < 2; ++i) { gc[h][i] = (unsigned)(g.rowmap[cur.pm * BM + h * HALF + RA[i]] * K + CA[i]) * 2u; gn[h][i] = gc[h][i]; }
    } else { gc[0][0] = gc[0][1] = gc[1][0] = gc[1][1] = 0u; gn[0][0] = gn[0][1] = gn[1][0] = gn[1][1] = 0u; }
    const char* cA = GATHER ? (const char*)g.A : (const char*)g.A + (size_t)cur.pm * tstep; const char* cB = (const char*)g.Bt + (size_t)cur.pb * tstep;
    PG8_STAGE(PG8_SB(0, 0), cB, voffB); PG8_STAGE(PG8_SB(0, 1), cB + hstep, voffB); PG8_STAGEA(PG8_SA(0, 0), cA, 0, false); PG8_STAGEA(PG8_SA(0, 1), cA, 1, false);
    if (wr == 1) PG8_BAR;
    PG8_WAIT_V(2); PG8_BAR;
    PG8_STAGE(PG8_SB(1, 0), cB + kstep, voffB); PG8_STAGEA(PG8_SA(1, 0), cA + kstep, 0, false); PG8_STAGE(PG8_SB(1, 1), cB + hstep + kstep, voffB);
    PG8_WAIT_V(6); PG8_BAR;
    for (;;) {
        const bool has_next = S.next(ui + 1, nxt);
        if constexpr (GATHER) { if (has_next) {
#pragma unroll
            for (int h = 0; h < 2; ++h)
#pragma unroll
                for (int i = 0; i < 2; ++i) gn[h][i] = (unsigned)(g.rowmap[nxt.pm * BM + h * HALF + RA[i]] * K + CA[i]) * 2u; } }
        const char* nA = GATHER ? cA : (has_next ? (const char*)g.A + (size_t)nxt.pm * tstep : cA); const char* nB = has_next ? (const char*)g.Bt + (size_t)nxt.pb * tstep : cB;
        for (int t = 0; t < nt; t += 2) {
            const bool last = (t == nt - 2);
            const char* a1 = cA + (size_t)(t + 1) * kstep;
            const char* a2 = last ? nA : cA + (size_t)(t + 2) * kstep; const char* b2 = last ? nB : cB + (size_t)(t + 2) * kstep;
            const char* a3 = a2 + kstep; const char* b3 = b2 + kstep;
            PG8_LDB(B0, 0, 0); PG8_LDB(B1, 0, 1); PG8_SCHED; PG8_LDA(At, 0, 0); PG8_STAGEA(PG8_SA(1, 1), a1, 1, false);
            PG8_WAIT_V(8); PG8_WAIT_L(0); PG8_BAR; PG8_MMA(0, 0, At, B0); PG8_MMA(0, 1, At, B1); PG8_BAR; PG8_SCHED;
            PG8_LDA(At, 0, 1); PG8_STAGE(PG8_SB(0, 0), b2, voffB); PG8_STAGE(PG8_SB(0, 1), b2 + hstep, voffB); PG8_STAGEA(PG8_SA(0, 0), a2, 0, last);
            PG8_WAIT_V(8); PG8_WAIT_L(0); PG8_BAR; PG8_MMA(1, 0, At, B0); PG8_MMA(1, 1, At, B1); PG8_BAR; PG8_SCHED;
            PG8_LDB(B0, 1, 0); PG8_LDB(B1, 1, 1); PG8_SCHED; PG8_LDA(At, 1, 0); PG8_STAGEA(PG8_SA(0, 1), a2, 1, last);
            PG8_WAIT_V(8); PG8_WAIT_L(0); PG8_BAR; PG8_MMA(0, 0, At, B0); PG8_MMA(0, 1, At, B1); PG8_BAR; PG8_SCHED;
            PG8_LDA(At, 1, 1); PG8_STAGE(PG8_SB(1, 0), b3, voffB); PG8_STAGE(PG8_SB(1, 1), b3 + hstep, voffB); PG8_STAGEA(PG8_SA(1, 0), a3, 0, last);
            PG8_WAIT_V(8); PG8_WAIT_L(0); PG8_BAR; PG8_MMA(1, 0, At, B0); PG8_MMA(1, 1, At, B1); PG8_BAR; PG8_SCHED;
        }
        if (wr == 0) PG8_BAR;
        E(acc, cur, wr, wc, fr, fq);
        if (!has_next) break;
#pragma unroll
        for (int a = 0; a < 2; ++a)
#pragma unroll
            for (int b = 0; b < 2; ++b)
#pragma unroll
                for (int m = 0; m < 4; ++m)
#pragma unroll
                    for (int n = 0; n < 2; ++n) acc[a][b][m][n] = (f32x4){0.f, 0.f, 0.f, 0.f};
        cur = nxt; cA = nA; cB = nB; ++ui;
        if constexpr (GATHER) {
#pragma unroll
            for (int h = 0; h < 2; ++h)
#pragma unroll
                for (int i = 0; i < 2; ++i) gc[h][i] = gn[h][i]; }
        if (wr == 1) PG8_BAR;
    }
    PG8_WAIT_V(0);
    PG8_BAR;
#undef PG8_SA
#undef PG8_SB
#undef PG8_STAGE
#undef PG8_STAGEA
#undef PG8_LDA
#undef PG8_LDB
#undef PG8_MMA
#undef PG8_WAIT_V
#undef PG8_WAIT_L
#undef PG8_BAR
#undef PG8_SCHED
}
}
constexpr int DM = 1024, NB = 8, SEQ = 4096, NTOK = NB * SEQ, NLAYER = 2;
constexpr int NPROJ = 3072;
constexpr int D_IN = 3078;
constexpr int NEXP = 32, TOPK = 4;
constexpr int NSLOT_MAX = NTOK * TOPK + NEXP * 256;
constexpr int NTILE_MAX = NSLOT_MAX / 256;
constexpr int COL_CB = 0, COL_CC = 256, COL_CU = 512, COL_SQ = 768, COL_SK = 1152, COL_SV = 1536, COL_FQ = 1920, COL_FK = 2304, COL_FV = 2688;
constexpr float EPS = 1e-6f;
constexpr float LOG2E = 1.4426950408889634f;
constexpr float QSCALE = 0.125f * LOG2E;

namespace pg8 {
struct StaticOrder {
    int nM, nN, nwg, G, c;
    __device__ __forceinline__ void init(int M, int N, int G_, int c_) { nM = M / BM; nN = N / BM; nwg = nM * nN; G = G_; c = c_; }
    __device__ __forceinline__ bool next(int i, Unit& u) const {
        const long L = (long)i * G + c; if (L >= nwg) return false;
        int wgid = (int)L; { const int q = nwg / NXCD, r = nwg % NXCD, xcd = wgid % NXCD, off = wgid / NXCD; wgid = (xcd < r ? xcd * (q + 1) : r * (q + 1) + (xcd - r) * q) + off; }
        const int nig = WGM * nN, gid = wgid / nig, fm = gid * WGM, gsz = (nM - fm) < WGM ? (nM - fm) : WGM;
        u.pm = fm + ((wgid % nig) % gsz); u.pn = (wgid % nig) / gsz; u.pb = u.pn; return true;
    }
};
struct MoeOrder {
    int nM, nN, nwg, G, c; const LAS int* tb;
    __device__ __forceinline__ void init(const LAS int* tb_, int nN_, int G_, int c_) { tb = tb_; nM = tb_[NEXP]; nN = nN_; nwg = nM * nN; G = G_; c = c_; }
    __device__ __forceinline__ bool next(int i, Unit& u) const {
        const long L = (long)i * G + c; if (L >= nwg) return false;
        int wgid = (int)L; { const int q = nwg / NXCD, r = nwg % NXCD, xcd = wgid % NXCD, off = wgid / NXCD; wgid = (xcd < r ? xcd * (q + 1) : r * (q + 1) + (xcd - r) * q) + off; }
        const int nig = WGM * nN, gid = wgid / nig, fm = gid * WGM, gsz = (nM - fm) < WGM ? (nM - fm) : WGM;
        u.pm = fm + ((wgid % nig) % gsz); u.pn = (wgid % nig) / gsz;
        int e = 0;
#pragma unroll 1
        for (int j = 1; j < NEXP; ++j) e += (tb[j] <= u.pm) ? 1 : 0;
        u.pb = e * nN + u.pn; return true;
    }
};

struct EpiProj {
    static constexpr bool PERM = true;
    bf16* O; int ldc;
    __device__ __forceinline__ void operator()(const f32x4 (&acc)[2][2][4][2], const Unit& u, int wr, int wc, int fr, int fq) const {
        const int row0 = u.pm * BM + wr * 64 + fr, col0 = u.pn * BM + wc * 32 + 8 * fq;
#pragma unroll
        for (int ai = 0; ai < 2; ++ai)
#pragma unroll
            for (int m = 0; m < 4; ++m) { bf16* rowp = O + (size_t)(row0 + ai * HALF + m * 16) * ldc + col0;
#pragma unroll
                for (int bj = 0; bj < 2; ++bj) { const f32x4 v0 = acc[ai][bj][m][0], v1 = acc[ai][bj][m][1];
                    v4u w; w.x = cvt_pk_bf16(v0[0], v0[1]); w.y = cvt_pk_bf16(v0[2], v0[3]); w.z = cvt_pk_bf16(v1[0], v1[1]); w.w = cvt_pk_bf16(v1[2], v1[3]);
                    *(v4u*)(rowp + bj * HALF) = w; } }
    }
};
struct EpiResGate {
    static constexpr bool PERM = false;
    const float* base; float* out; const float* gbias; const float* gpart;
    __device__ __forceinline__ void operator()(const f32x4 (&acc)[2][2][4][2], const Unit& u, int wr, int wc, int fr, int fq) const {
        const int row0 = u.pm * BM + wr * 64 + fr, col0 = u.pn * BM + wc * 32 + 4 * fq; const int b = (u.pm * BM) / SEQ;
#pragma unroll
        for (int bj = 0; bj < 2; ++bj)
#pragma unroll
            for (int n = 0; n < 2; ++n) { const int c = col0 + bj * HALF + n * 16; f32x4 gv = *(const f32x4*)(gbias + c);
#pragma unroll
                for (int ks = 0; ks < 4; ++ks) gv += *(const f32x4*)(gpart + (size_t)(ks * NB + b) * 6144 + c);
#pragma unroll
                for (int ai = 0; ai < 2; ++ai)
#pragma unroll
                    for (int m = 0; m < 4; ++m) { const size_t off = (size_t)(row0 + ai * HALF + m * 16) * DM + c;
                        *(f32x4*)(out + off) = *(const f32x4*)(base + off) + gv * acc[ai][bj][m][n]; } }
    }
};
struct EpiSwiglu {
    static constexpr bool PERM = true;
    bf16* O; const float* b1;
    __device__ __forceinline__ void operator()(const f32x4 (&acc)[2][2][4][2], const Unit& u, int wr, int wc, int fr, int fq) const {
        const int row0 = u.pm * BM + wr * 64 + fr; const int e = u.pb >> 3; const int j0 = u.pn * 128 + wc * 32 + 8 * fq;
        const float* bp = b1 + (size_t)e * 2048 + 2 * j0;
        f32x4 bb[4];
#pragma unroll
        for (int q = 0; q < 4; ++q) bb[q] = *(const f32x4*)(bp + 4 * q);
        float bg[8], bl[8];
#pragma unroll
        for (int q = 0; q < 4; ++q) { bg[2 * q] = bb[q][0]; bl[2 * q] = bb[q][1]; bg[2 * q + 1] = bb[q][2]; bl[2 * q + 1] = bb[q][3]; }
#pragma unroll
        for (int ai = 0; ai < 2; ++ai)
#pragma unroll
            for (int m = 0; m < 4; ++m) { bf16* rowp = O + (size_t)(row0 + ai * HALF + m * 16) * DM + j0;
                float a[8];
#pragma unroll
                for (int n = 0; n < 2; ++n)
#pragma unroll
                    for (int i = 0; i < 4; ++i) { float gl = acc[ai][0][m][n][i] + bg[4 * n + i], li = acc[ai][1][m][n][i] + bl[4 * n + i];
                        gl = fminf(gl, 7.0f); li = fminf(fmaxf(li, -7.0f), 7.0f);
                        const float sg = __builtin_amdgcn_rcpf(1.0f + __builtin_amdgcn_exp2f(-1.702f * LOG2E * gl));
                        a[4 * n + i] = gl * sg * (li + 1.0f); }
                v4u w; w.x = cvt_pk_bf16(a[0], a[1]); w.y = cvt_pk_bf16(a[2], a[3]); w.z = cvt_pk_bf16(a[4], a[5]); w.w = cvt_pk_bf16(a[6], a[7]);
                *(v4u*)rowp = w; }
    }
};
struct EpiY {
    static constexpr bool PERM = true;
    bf16* O; const float* b2;
    __device__ __forceinline__ void operator()(const f32x4 (&acc)[2][2][4][2], const Unit& u, int wr, int wc, int fr, int fq) const {
        const int row0 = u.pm * BM + wr * 64 + fr; const int e = u.pb >> 2; const int col0 = u.pn * BM + wc * 32 + 8 * fq;
        f32x4 bv[2][2];
#pragma unroll
        for (int bj = 0; bj < 2; ++bj)
#pragma unroll
            for (int n = 0; n < 2; ++n) bv[bj][n] = *(const f32x4*)(b2 + (size_t)e * DM + col0 + bj * HALF + 4 * n);
#pragma unroll
        for (int ai = 0; ai < 2; ++ai)
#pragma unroll
            for (int m = 0; m < 4; ++m) { bf16* rowp = O + (size_t)(row0 + ai * HALF + m * 16) * DM + col0;
#pragma unroll
                for (int bj = 0; bj < 2; ++bj) { const f32x4 v0 = acc[ai][bj][m][0] + bv[bj][0], v1 = acc[ai][bj][m][1] + bv[bj][1];
                    v4u w; w.x = cvt_pk_bf16(v0[0], v0[1]); w.y = cvt_pk_bf16(v0[2], v0[3]); w.z = cvt_pk_bf16(v1[0], v1[1]); w.w = cvt_pk_bf16(v1[2], v1[3]);
                    *(v4u*)(rowp + bj * HALF) = w; } }
    }
};
}
namespace att {
constexpr int KROW = 128;
constexpr int TILE_B = 64 * KROW;
constexpr int OFF_K = 0, OFF_V = 2 * TILE_B, OFF_F = 4 * TILE_B, OFF_Q = OFF_F + 512, LDS_BYTES = OFF_Q + 8 * 4608;
__device__ __forceinline__ int pim(int m) { const int a = m >> 3, h = (m >> 2) & 1, b = m & 3; return 16 * (a >> 1) + 8 * h + 4 * (a & 1) + b; }
__device__ __forceinline__ unsigned pk_bf16(float lo, float hi) { unsigned r; asm volatile("v_cvt_pk_bf16_f32 %0, %1, %2" : "=v"(r) : "v"(lo), "v"(hi)); return r; }
__device__ __forceinline__ unsigned pk_f16(float lo, float hi) { return __builtin_bit_cast(unsigned, __builtin_amdgcn_cvt_pkrtz(lo, hi)); }
__device__ __forceinline__ float half_sum(float v) { auto rr = __builtin_amdgcn_permlane32_swap(__float_as_uint(v), __float_as_uint(v), false, false); return __uint_as_float(rr[0]) + __uint_as_float(rr[1]); }
__device__ __forceinline__ float half_max(float v) { auto rr = __builtin_amdgcn_permlane32_swap(__float_as_uint(v), __float_as_uint(v), false, false); return fmaxf(__uint_as_float(rr[0]), __uint_as_float(rr[1])); }
#define ATT_SB() __builtin_amdgcn_sched_barrier(0)
#define ATT_MFMA(a, b, c) __builtin_amdgcn_mfma_f32_32x32x16_bf16((a), (b), (c), 0, 0, 0)
#define ATT_MFMAH(a, b, c) __builtin_amdgcn_mfma_f32_32x32x16_f16((a), (b), (c), 0, 0, 0)

struct Tensors {
    const bf16* proj;
    const bf16* vt;
    const float* fcum;
    bf16* ymix;
    const float* ong;
    int colq, colk, coly;
};
struct WaveCtx { int r32, hi, qabs; int ko[4]; const LAS unsigned char* qb; f16x8 mtri0, mtri1, mones; };

__device__ __forceinline__ void qk_only(f32x16& p0, f32x16& p1, const LAS unsigned char* Kb, const WaveCtx& W) {
#pragma unroll
    for (int r = 0; r < 16; ++r) { p0[r] = 0.f; p1[r] = 0.f; }
#pragma unroll
    for (int d0 = 0; d0 < 4; ++d0) { const bf16x8 ka = *(const LAS bf16x8*)(Kb + W.ko[d0]), kb2 = *(const LAS bf16x8*)(Kb + 32 * KROW + W.ko[d0]);
        const bf16x8 qv = *(const LAS bf16x8*)(W.qb + 32 * d0);
        p0 = ATT_MFMA(ka, qv, p0); p1 = ATT_MFMA(kb2, qv, p1); }
}

template <int KIND, bool DIAG>
__device__ __forceinline__ void tile(f32x16& p0, f32x16& p1, f32x16& o0, f32x16& o1, float& carry, float& lsum, const LAS unsigned char* Kn, const LAS unsigned char* Vb, const LAS float* Fb, int kt, const WaveCtx& W) {
    const int kbase = kt * 64 + 8 * W.hi;
#define ATT_KF(i) (*(const LAS bf16x8*)(Kn + ((i) & 1) * 32 * KROW + W.ko[(i) >> 1]))
#define ATT_VF(i) (*(const LAS bf16x8*)(Vb + ((i) & 1) * 32 * KROW + W.ko[(i) >> 1]))
#define ATT_QF(d0) (*(const LAS bf16x8*)(W.qb + 32 * (d0)))
    bf16x8 kcur = ATT_KF(0), knxt = kcur, qcur = ATT_QF(0), qnxt = qcur;
    f32x16 n0, n1;
#pragma unroll
    for (int r = 0; r < 16; ++r) { n0[r] = 0.f; n1[r] = 0.f; }
    v4u wf[4];
    if (KIND == 0) {
        v4u lf[4]; float lfirst = 0.f, pz0 = 0.f;
#pragma unroll
        for (int i = 0; i < 8; ++i) {
            if (i < 7) { knxt = ATT_KF(i + 1); if (i & 1) qnxt = ATT_QF((i + 1) >> 1); }
#pragma unroll
            for (int jj = 0; jj < 2; ++jj) { const int r = (4 * i + 2 * jj) & 15; float lg[2];
#pragma unroll
                for (int e = 0; e < 2; ++e) { const float z = (i < 4) ? p0[r + e] : p1[r + e]; float g = __builtin_amdgcn_logf(1.0f + __builtin_amdgcn_exp2f(z));
                    if (i < 4) p0[r + e] = z - g; else p1[r + e] = z - g;
                    if (DIAG) { const int key = kbase + (i < 4 ? 0 : 32) + 16 * ((r + e) >> 3) + ((r + e) & 7); g = (key < W.qabs) ? g : 0.f; }
                    lg[e] = g; }
                if (i == 0 && jj == 0) { lfirst = -lg[0]; pz0 = p0[0]; }
                lf[2 * (i >> 2) + (r >> 3)][(r & 7) >> 1] = pk_f16(-lg[0], -lg[1]); }
            if (i & 1) { n1 = ATT_MFMA(kcur, qcur, n1); qcur = qnxt; } else n0 = ATT_MFMA(kcur, qcur, n0);
            kcur = knxt;
            ATT_SB();
        }
        bf16x8 va = ATT_VF(0), vb = ATT_VF(1), vna = va, vnb = vb;
#pragma unroll
        for (int r = 0; r < 16; ++r) { p0[r] += carry; p1[r] += carry; }
        p0 = ATT_MFMAH(W.mtri0, __builtin_bit_cast(f16x8, lf[0]), p0); p1 = ATT_MFMAH(W.mtri0, __builtin_bit_cast(f16x8, lf[2]), p1);
        p0 = ATT_MFMAH(W.mtri1, __builtin_bit_cast(f16x8, lf[1]), p0); p1 = ATT_MFMAH(W.mtri1, __builtin_bit_cast(f16x8, lf[3]), p1);
        p0 = ATT_MFMAH(W.mones, __builtin_bit_cast(f16x8, lf[2]), p0);
        p0 = ATT_MFMAH(W.mones, __builtin_bit_cast(f16x8, lf[3]), p0);
        ATT_SB();
        const float t00 = p0[0];
#pragma unroll
        for (int c = 0; c < 4; ++c) {
            if (c < 3) { vna = ATT_VF(2 * c + 2); vnb = ATT_VF(2 * c + 3); }
#pragma unroll
            for (int j = 0; j < 4; ++j) { const int r = 8 * (c & 1) + 2 * j; float w[2];
#pragma unroll
                for (int e = 0; e < 2; ++e) { const float t = (c < 2) ? p0[r + e] : p1[r + e]; float x = __builtin_amdgcn_exp2f(t);
                    if (DIAG) { const int key = kbase + (c < 2 ? 0 : 32) + 16 * ((r + e) >> 3) + ((r + e) & 7); x = (key < W.qabs) ? x : 0.f; }
                    w[e] = x; }
                wf[c][j] = pk_bf16(w[0], w[1]); }
            o0 = ATT_MFMA(va, __builtin_bit_cast(bf16x8, wf[c]), o0); o1 = ATT_MFMA(vb, __builtin_bit_cast(bf16x8, wf[c]), o1);
            va = vna; vb = vnb;
            ATT_SB();
        }
        carry = half_sum(W.hi == 0 ? (t00 - pz0) + lfirst : 0.f);
    } else {
#define ATT_FBV(i) (*(const LAS f32x4*)(Fb + 8 * W.hi + 32 * ((i) >> 2) + 16 * (((i) >> 1) & 1) + 4 * ((i) & 1)))
        f32x4 fcur = ATT_FBV(0), fnxt = fcur;
        float mx = -1e30f;
#pragma unroll
        for (int i = 0; i < 8; ++i) {
            if (i < 7) { knxt = ATT_KF(i + 1); fnxt = ATT_FBV(i + 1); if (i & 1) qnxt = ATT_QF((i + 1) >> 1); }
#pragma unroll
            for (int e = 0; e < 4; ++e) { const int r = (4 * i + e) & 15; float s = ((i < 4) ? p0[r] : p1[r]) - fcur[e];
                if (DIAG) { const int key = kbase + (i < 4 ? 0 : 32) + 16 * (r >> 3) + (r & 7); s = (key > W.qabs) ? -1e30f : s; }
                if (i < 4) p0[r] = s; else p1[r] = s; mx = fmaxf(mx, s); }
            if (i & 1) { n1 = ATT_MFMA(kcur, qcur, n1); qcur = qnxt; } else n0 = ATT_MFMA(kcur, qcur, n0);
            kcur = knxt; fcur = fnxt;
            ATT_SB();
        }
        bf16x8 va = ATT_VF(0), vb = ATT_VF(1), vna = va, vnb = vb;
        mx = half_max(mx);
        if (__any(mx > carry)) {
            const float mnew = fmaxf(carry, mx), alpha = __builtin_amdgcn_exp2f(carry - mnew); carry = mnew; lsum *= alpha;
#pragma unroll
            for (int r = 0; r < 16; ++r) { o0[r] *= alpha; o1[r] *= alpha; }
        }
        ATT_SB();
        float ps = 0.f;
#pragma unroll
        for (int c = 0; c < 4; ++c) {
            if (c < 3) { vna = ATT_VF(2 * c + 2); vnb = ATT_VF(2 * c + 3); }
#pragma unroll
            for (int j = 0; j < 4; ++j) { const int r = 8 * (c & 1) + 2 * j;
                const float a = __builtin_amdgcn_exp2f(((c < 2) ? p0[r] : p1[r]) - carry), d = __builtin_amdgcn_exp2f(((c < 2) ? p0[r + 1] : p1[r + 1]) - carry);
                ps += a + d; wf[c][j] = pk_bf16(a, d); }
            o0 = ATT_MFMA(va, __builtin_bit_cast(bf16x8, wf[c]), o0); o1 = ATT_MFMA(vb, __builtin_bit_cast(bf16x8, wf[c]), o1);
            va = vna; vb = vnb;
            ATT_SB();
        }
        lsum += half_sum(ps);
    }
    p0 = n0; p1 = n1;
#undef ATT_KF
#undef ATT_QF
#undef ATT_VF
#undef ATT_FBV
}

template <int KIND>
__device__ __forceinline__ void unit(const Tensors& T, int b, int h, int qb, LAS unsigned char* lds) {
    int tid_ = threadIdx.x; asm volatile("" : "+v"(tid_));
    const int tid = tid_, lane = tid & 63; const int wid = __builtin_amdgcn_readfirstlane(tid >> 6);
    WaveCtx W; W.r32 = lane & 31; W.hi = lane >> 5;
    const int q0 = qb * 256, qw0 = q0 + wid * 32; W.qabs = qw0 + W.r32;
    const size_t rowbase = (size_t)b * SEQ;
    const int ktd = qw0 >> 6;
    const int kt_hi = (q0 + 255) >> 6;
    const int srow = tid >> 3, cg = (tid & 7) ^ ((srow >> 1) & 7);
    const bf16* kg = T.proj + (rowbase + srow) * NPROJ + T.colk + h * 64 + cg * 8;
    const bf16* vg = T.vt + ((size_t)(b * 6 + h) * 64 + srow) * SEQ + cg * 8;
    const float* fg = T.fcum + (size_t)(b * 6 + h) * SEQ;
    LAS unsigned char* qlds = lds + OFF_Q + wid * 4608;
    W.qb = qlds + W.r32 * 144 + W.hi * 16;
    { const bf16* qp = T.proj + (rowbase + W.qabs) * NPROJ + T.colq + h * 64 + W.hi * 8;
      v4u qt[4];
#pragma unroll
      for (int d0 = 0; d0 < 4; ++d0) qt[d0] = *(const v4u*)(qp + d0 * 16);
#pragma unroll
      for (int d0 = 0; d0 < 4; ++d0) *(LAS v4u*)(qlds + W.r32 * 144 + W.hi * 16 + 32 * d0) = qt[d0]; }
    const int pm = pim(W.r32);
#pragma unroll
    for (int j = 0; j < 4; ++j) W.ko[j] = pm * KROW + (((2 * j + W.hi) ^ ((pm >> 1) & 7)) << 4);
#pragma unroll
    for (int i = 0; i < 8; ++i) { W.mtri0[i] = (_Float16)((8 * W.hi + i > pm) ? 1.0f : 0.0f); W.mtri1[i] = (_Float16)((16 + 8 * W.hi + i > pm) ? 1.0f : 0.0f); W.mones[i] = (_Float16)1.0f; }
    f32x16 o0, o1, p0, p1;
#pragma unroll
    for (int r = 0; r < 16; ++r) { o0[r] = 0.f; o1[r] = 0.f; p0[r] = 0.f; p1[r] = 0.f; }
    float carry = (KIND == 1) ? -1e30f : 0.f, lsum = 0.f;
#define ATT_KB(t) (lds + OFF_K + ((t) & 1) * TILE_B)
#define ATT_VB(t) (lds + OFF_V + ((t) & 1) * TILE_B)
#define ATT_FB(t) ((LAS float*)(lds + OFF_F + ((t) & 1) * 256))
#define ATT_DMA(gsrc, ldst) __builtin_amdgcn_global_load_lds((const unsigned*)(gsrc), (LAS unsigned*)((ldst) + wid * 1024), 16, 0, 0)
    ATT_DMA(kg + (size_t)kt_hi * 64 * NPROJ, ATT_KB(kt_hi)); ATT_DMA(vg + kt_hi * 64, ATT_VB(kt_hi)); ATT_DMA(kg + (size_t)(kt_hi - 1) * 64 * NPROJ, ATT_KB(kt_hi - 1));
    if (KIND == 1 && tid < 64) ATT_FB(kt_hi)[tid] = fg[kt_hi * 64 + tid];
    __syncthreads();
    if (ktd == kt_hi) qk_only(p0, p1, ATT_KB(kt_hi), W);
    __syncthreads();
    for (int kt = kt_hi; kt >= 0; --kt) {
        float freg = 0.f;
        if (kt >= 2) ATT_DMA(kg + (size_t)(kt - 2) * 64 * NPROJ, ATT_KB(kt - 2));
        if (kt >= 1) { ATT_DMA(vg + (kt - 1) * 64, ATT_VB(kt - 1)); if (KIND == 1 && tid < 64) freg = fg[(kt - 1) * 64 + tid]; }
        if (kt <= ktd) {
            if (kt == ktd) tile<KIND, true>(p0, p1, o0, o1, carry, lsum, ATT_KB(kt - 1), ATT_VB(kt), ATT_FB(kt), kt, W);
            else tile<KIND, false>(p0, p1, o0, o1, carry, lsum, ATT_KB(kt - 1), ATT_VB(kt), ATT_FB(kt), kt, W);
        } else if (kt - 1 == ktd) qk_only(p0, p1, ATT_KB(kt - 1), W);
        if (KIND == 1 && kt >= 1 && tid < 64) ATT_FB(kt - 1)[tid] = freg;
        __syncthreads();
    }
#undef ATT_KB
#undef ATT_VB
#undef ATT_FB
#undef ATT_DMA
    if (KIND == 1) { const float inv = 1.0f / lsum;
#pragma unroll
        for (int r = 0; r < 16; ++r) { o0[r] *= inv; o1[r] *= inv; } }
    float ss = 0.f;
#pragma unroll
    for (int r = 0; r < 16; ++r) ss += o0[r] * o0[r] + o1[r] * o1[r];
    ss = half_sum(ss);
    const float rinv = 1.0f / sqrtf(ss * (1.0f / 64.0f) + EPS);
    const float* gp = T.ong + T.coly + h * 64 + 8 * W.hi;
    bf16* yp = T.ymix + (rowbase + W.qabs) * DM + T.coly + h * 64 + 8 * W.hi;
#pragma unroll
    for (int d0 = 0; d0 < 2; ++d0)
#pragma unroll
        for (int g = 0; g < 2; ++g) { const f32x4 ga = *(const f32x4*)(gp + 32 * d0 + 16 * g), gb = *(const f32x4*)(gp + 32 * d0 + 16 * g + 4);
            float v[8];
#pragma unroll
            for (int i = 0; i < 8; ++i) v[i] = (d0 == 0 ? o0[8 * g + i] : o1[8 * g + i]) * rinv * (i < 4 ? ga[i & 3] : gb[i & 3]);
            v4u w; w.x = pk_bf16(v[0], v[1]); w.y = pk_bf16(v[2], v[3]); w.z = pk_bf16(v[4], v[5]); w.w = pk_bf16(v[6], v[7]);
            *(v4u*)(yp + 32 * d0 + 16 * g) = w; }
}
}
constexpr size_t MiB = 1u << 20;
constexpr size_t WS_CTL = 0, CTL_ZERO_BYTES = 1 * MiB;
constexpr size_t WS_MODP = 1 * MiB;
constexpr size_t WS_TOPW = 3 * MiB;
constexpr size_t WS_ROUTE = WS_TOPW + 512 * 1024;
constexpr size_t WS_TOKSLOT = WS_ROUTE + 512 * 1024;
constexpr size_t WS_SLOTTOK = WS_TOKSLOT + 512 * 1024;
constexpr size_t WS_HIST = WS_SLOTTOK + 576 * 1024;
constexpr size_t WS_MOETAB = WS_HIST + 32 * 1024;
constexpr size_t WS_LOGF = 6 * MiB;
constexpr size_t WS_FCUM = 7 * MiB;
constexpr size_t WS_WIN = 8 * MiB, WS_WOUT = 20 * MiB, WS_W1 = 24 * MiB, WS_W2 = 280 * MiB;
constexpr size_t WS_H = 408 * MiB;
constexpr size_t WS_PROJ = 472 * MiB;
constexpr size_t WS_VT = 664 * MiB;
constexpr size_t WS_YMIX = 712 * MiB;
constexpr size_t WS_XA = 776 * MiB, WS_XB = 904 * MiB;
constexpr size_t WS_ACT = 1032 * MiB, WS_Y = 1304 * MiB, WS_END = 1576 * MiB;
static_assert(WS_MOETAB + 256 <= WS_LOGF && (size_t)NSLOT_MAX * 4 <= 576 * 1024 && (size_t)NSLOT_MAX * DM * 2 <= 272 * MiB, "ws map");
constexpr int CW_BAR = 4096;

constexpr int RING_BYTES = 131072;
constexpr int MISC_OFF = RING_BYTES;
constexpr int LDS_BYTES = 147456;

#define RLX_AGENT __ATOMIC_RELAXED, __HIP_MEMORY_SCOPE_AGENT
__device__ __forceinline__ unsigned f2bf(float f) { unsigned u = __builtin_bit_cast(unsigned, f); return (u + 0x7fffu + ((u >> 16) & 1u)) >> 16; }
__device__ __forceinline__ unsigned pk2(float lo, float hi) { return f2bf(lo) | (f2bf(hi) << 16); }
__device__ __forceinline__ float bflo(unsigned u) { return __builtin_bit_cast(float, u << 16); }
__device__ __forceinline__ float bfhi(unsigned u) { return __builtin_bit_cast(float, u & 0xffff0000u); }
__device__ __forceinline__ float wave_sum(float v) {
#pragma unroll
    for (int o = 1; o < 64; o <<= 1) v += __shfl_xor(v, o);
    return v;
}

#define XB_TMO      128
#define XB_XCNT(j)  (256  + 64 * (j))
#define XB_XSUB(j)  (1280 + 64 * (j))
#define XB_XGEN(j)  (2304 + 64 * (j))
#define XB_TOP      3328
#define XB_TOPGEN   3392
#define XCD_BAR_WORDS 3456
#define XB_SPIN_CAP (1u << 18)
__device__ __forceinline__ unsigned xb_ld(unsigned* p)              { return __hip_atomic_load(p, __ATOMIC_RELAXED, __HIP_MEMORY_SCOPE_AGENT); }
__device__ __forceinline__ unsigned xb_add(unsigned* p, unsigned v) { return __hip_atomic_fetch_add(p, v, __ATOMIC_RELAXED, __HIP_MEMORY_SCOPE_AGENT); }
__device__ __forceinline__ unsigned xb_xcc_id() { return (unsigned)__builtin_amdgcn_s_getreg((3 << 11) | 20) & 0xFu; }
#define XB_SPIN(cond, bar) do { unsigned _sp = 0; while (cond) { __builtin_amdgcn_s_sleep(1); \
    if ((++_sp & 255u) == 0u) { if (xb_ld(&(bar)[XB_TMO])) break; if (_sp > XB_SPIN_CAP) { atomicAdd(&(bar)[XB_TMO], 1u); break; } } } } while (0)
struct XcdBarrier { unsigned* bar; unsigned x; volatile LAS unsigned* st; };
__device__ __forceinline__ XcdBarrier xcd_barrier_post(unsigned* bar, volatile LAS unsigned* st) {
    XcdBarrier b; b.bar = bar; b.x = xb_xcc_id(); b.st = st;
    if (threadIdx.x == 0) (void)xb_add(&bar[XB_XCNT(b.x)], 1u);
    return b;
}
__device__ __forceinline__ void xcd_barrier_complete(unsigned* bar, unsigned x, unsigned& nloc, unsigned& nx) {
    const unsigned G = gridDim.x * gridDim.y * gridDim.z;
    unsigned sum, cnt, mine, sp = 0u;
    for (;;) {
        sum = 0u; cnt = 0u; mine = 0u;
#pragma unroll
        for (unsigned j = 0; j < 16; ++j) { const unsigned c = xb_ld(&bar[XB_XCNT(j)]); sum += c; cnt += (c > 0u) ? 1u : 0u; mine = (j == x) ? c : mine; }
        if (sum == G) break;
        __builtin_amdgcn_s_sleep(1);
        if ((++sp & 255u) == 0u) { if (xb_ld(&bar[XB_TMO])) break; if (sp > XB_SPIN_CAP) { atomicAdd(&bar[XB_TMO], 1u); break; } }
    }
    nloc = mine > 0u ? mine : 1u; nx = cnt > 0u ? cnt : 1u;
}
__device__ __forceinline__ void xcd_barrier(const XcdBarrier& b) {
    asm volatile("s_waitcnt vmcnt(0)" ::: "memory");
    __syncthreads();
    if (threadIdx.x == 0) {
        unsigned* bar = b.bar;
        __builtin_amdgcn_s_waitcnt(0);
        unsigned nloc = b.st[0], nx = b.st[1];
        if (nloc == 0u) { xcd_barrier_complete(bar, b.x, nloc, nx); b.st[0] = nloc; b.st[1] = nx; }
        const unsigned old = xb_add(&bar[XB_XSUB(b.x)], 1u);
        const unsigned gen = old / nloc;
        if (old + 1u == (gen + 1u) * nloc) {
            __builtin_amdgcn_fence(__ATOMIC_RELEASE, "agent");
            asm volatile("s_waitcnt vmcnt(0)" ::: "memory");
            const unsigned og = xb_add(&bar[XB_TOP], 1u);
            const unsigned tg = og / nx;
            if (og + 1u == (tg + 1u) * nx) xb_add(&bar[XB_TOPGEN], 1u);
            else XB_SPIN(xb_ld(&bar[XB_TOPGEN]) == tg, bar);
            __builtin_amdgcn_fence(__ATOMIC_ACQUIRE, "agent");
            xb_add(&bar[XB_XGEN(b.x)], 1u);
            asm volatile("s_waitcnt vmcnt(0)" ::: "memory");
        } else {
            XB_SPIN(xb_ld(&bar[XB_XGEN(b.x)]) == gen, bar);
            __builtin_amdgcn_fence(__ATOMIC_ACQUIRE, "agent");
            asm volatile("s_waitcnt vmcnt(0)" ::: "memory");
        }
    }
    __syncthreads();
}

struct Frame {
    LAS unsigned char* lds;
    int tid, lane, wave, blk, G;
    const float* in[21];
    float* out; unsigned char* ws;
};
enum { I_X = 0, I_C, I_N1G, I_WADA, I_BADA, I_WIN, I_CONVW, I_SBQG, I_SBKG, I_FXQG, I_FXKG, I_FXFB, I_ONG, I_WOUT, I_N2G, I_RW, I_RB, I_W1, I_B1, I_W2, I_B2 };

template <int MAP, bool WIDE>
__device__ __forceinline__ void p0_transpose_item(const float* W, int ldw, bf16* WT, LAS float* scr, int k0, int n0, int lane) {
    if (WIDE) {
        f32x4 t[8];
#pragma unroll
        for (int i = 0; i < 8; ++i) t[i] = __builtin_nontemporal_load((const f32x4*)(W + (size_t)(k0 + 8 * i + (lane >> 3)) * ldw + n0 + 4 * (lane & 7)));
#pragma unroll
        for (int i = 0; i < 8; ++i) { LAS float* d = scr + (8 * i + (lane >> 3)) * 33 + 4 * (lane & 7); d[0] = t[i].x; d[1] = t[i].y; d[2] = t[i].z; d[3] = t[i].w; }
    } else {
#pragma unroll 8
        for (int i = 0; i < 32; ++i) { const int kk = 2 * i + (lane >> 5); scr[kk * 33 + (lane & 31)] = W[(size_t)(k0 + kk) * ldw + n0 + (lane & 31)]; }
    }
    asm volatile("s_waitcnt lgkmcnt(0)" ::: "memory");
    const int c = lane & 7;
#pragma unroll
    for (int j = 0; j < 4; ++j) { const int n = (lane >> 3) + 8 * j; const LAS float* s = scr + (8 * c) * 33 + n;
        v4u o; o.x = pk2(s[0 * 33], s[1 * 33]); o.y = pk2(s[2 * 33], s[3 * 33]); o.z = pk2(s[4 * 33], s[5 * 33]); o.w = pk2(s[6 * 33], s[7 * 33]);
        const int cn = n0 + n; int row = cn;
        if (MAP == 1) { const int jj = cn >> 1, t = cn & 1; row = 256 * (jj >> 7) + 128 * t + (jj & 127); }
        *(v4u*)(WT + (size_t)row * 1024 + k0 + 8 * c) = o; }
    asm volatile("s_waitcnt lgkmcnt(0)" ::: "memory");
}
__device__ __forceinline__ void p0_prologue(Frame& F) {
    LAS float* scr = (LAS float*)(F.lds + F.wave * 16384);
    const int gw = F.blk * 8 + F.wave, NGW = F.G * 8;
    for (int it = gw; it < NLAYER * 4 * 24; it += NGW) {
        const int l = it / 96, ks = (it / 24) & 3, nc = it % 24;
        const float* W = F.in[I_WADA] + (size_t)l * DM * 6144 + nc * 256 + F.lane * 4;
        const float* c = F.in[I_C];
        f32x4 acc[NB];
#pragma unroll
        for (int b = 0; b < NB; ++b) acc[b] = (f32x4){0.f, 0.f, 0.f, 0.f};
#pragma unroll 4
        for (int k = ks * 256; k < ks * 256 + 256; ++k) {
            const f32x4 w = *(const f32x4*)(W + (size_t)k * 6144);
#pragma unroll
            for (int b = 0; b < NB; ++b) { const float cv = c[b * DM + k]; const float s = cv / (1.0f + __expf(-cv)); acc[b] += w * s; }
        }
        float* dst = (float*)(F.ws + WS_MODP) + ((size_t)(l * 4 + ks) * NB) * 6144 + nc * 256 + F.lane * 4;
#pragma unroll
        for (int b = 0; b < NB; ++b) *(f32x4*)(dst + (size_t)b * 6144) = acc[b];
    }
    constexpr int I_IN = 16 * 96, I_OUT = 16 * 32, I_1 = 16 * 64, I_2 = 16 * 32;
    constexpr int N_IN = NLAYER * I_IN, N_OUT = NLAYER * I_OUT, N_1 = NLAYER * NEXP * I_1, N_2 = NLAYER * NEXP * I_2;
    for (int it = gw; it < N_IN + N_OUT + N_1 + N_2; it += NGW) {
        int r = it;
        if (r < N_IN) { const int l = r / I_IN, q = r % I_IN, kb = q / 96, nb = q % 96;
            p0_transpose_item<0, false>(F.in[I_WIN] + (size_t)l * DM * D_IN, D_IN, (bf16*)(F.ws + WS_WIN) + (size_t)l * NPROJ * DM, scr, 64 * kb, 32 * nb, F.lane); continue; }
        r -= N_IN;
        if (r < N_OUT) { const int l = r / I_OUT, q = r % I_OUT, kb = q / 32, nb = q % 32;
            p0_transpose_item<0, true>(F.in[I_WOUT] + (size_t)l * DM * DM, DM, (bf16*)(F.ws + WS_WOUT) + (size_t)l * DM * DM, scr, 64 * kb, 32 * nb, F.lane); continue; }
        r -= N_OUT;
        if (r < N_1) { const int le = r / I_1, q = r % I_1, kb = q / 64, nb = q % 64;
            p0_transpose_item<1, true>(F.in[I_W1] + (size_t)le * DM * 2048, 2048, (bf16*)(F.ws + WS_W1) + (size_t)le * 2048 * DM, scr, 64 * kb, 32 * nb, F.lane); continue; }
        r -= N_1;
        { const int le = r / I_2, q = r % I_2, kb = q / 32, nb = q % 32;
            p0_transpose_item<0, true>(F.in[I_W2] + (size_t)le * DM * DM, DM, (bf16*)(F.ws + WS_W2) + (size_t)le * DM * DM, scr, 64 * kb, 32 * nb, F.lane); }
    }
}

__device__ __forceinline__ f32x4 mod4(const Frame& F, int l, int b, int which, int c) {
    const int n = which * DM + c;
    f32x4 s = *(const f32x4*)(F.in[I_BADA] + (size_t)l * 6144 + n);
    const float* p = (const float*)(F.ws + WS_MODP) + ((size_t)(l * 4) * NB + b) * 6144 + n;
#pragma unroll
    for (int ks = 0; ks < 4; ++ks) s += *(const f32x4*)(p + (size_t)ks * NB * 6144);
    return s;
}

constexpr size_t WS_GSUM = WS_FCUM + 800 * 1024;
static_assert(WS_GSUM + 16384 <= WS_WIN, "ws map");
template <bool COMBINE, bool NORM>
__device__ __forceinline__ void row_phase(Frame& F, int l, const float* xsrc, float* xdst) {
    const float* topw = (const float*)(F.ws + WS_TOPW); const int* tokslot = (const int*)(F.ws + WS_TOKSLOT); const bf16* Y = (const bf16*)(F.ws + WS_Y);
    bf16* H = (bf16*)(F.ws + WS_H); float* logf = (float*)(F.ws + WS_LOGF); float* gsum = (float*)(F.ws + WS_GSUM);
    LAS f32x4* wl4 = (LAS f32x4*)F.lds; LAS f32x2* wl2 = (LAS f32x2*)(F.lds + 16384); LAS float* part = (LAS float*)(F.lds + 16384 + 8192);
    if (NORM) { for (int k = F.tid; k < DM; k += 512) { const float* wp = F.in[I_WIN] + (size_t)l * DM * D_IN + (size_t)k * D_IN + NPROJ; const int idx = (4 * (k >> 8) + (k & 3)) * 64 + ((k >> 2) & 63);
            wl4[idx] = (f32x4){wp[0], wp[1], wp[2], wp[3]}; wl2[idx] = (f32x2){wp[4], wp[5]}; }
        __syncthreads(); }
    for (int chunk = F.blk; chunk < NTOK / 128; chunk += F.G) {
        const int b = chunk / (SEQ / 128);
        LAS f32x4* mv = (LAS f32x4*)(F.lds + 32768);
        __syncthreads();
        if (F.wave == 0) {
#pragma unroll
            for (int j = 0; j < 4; ++j) { const int c = 256 * j + 4 * F.lane;
                if (COMBINE) mv[(0 * 4 + j) * 64 + F.lane] = mod4(F, l - 1, b, 5, c);
                if (NORM) { const f32x4 g = *(const f32x4*)(F.in[I_N1G] + (size_t)l * DM + c); mv[(1 * 4 + j) * 64 + F.lane] = g * (mod4(F, l, b, 1, c) + 1.0f); mv[(2 * 4 + j) * 64 + F.lane] = mod4(F, l, b, 0, c); } } }
        __syncthreads();
        float lacc = 0.f;
#pragma unroll 1
        for (int rr = 0; rr < 16; rr += 2) {
            const int row = chunk * 128 + F.wave * 16 + rr;
            f32x4 v[2][4];
#pragma unroll
            for (int u = 0; u < 2; ++u)
#pragma unroll
                for (int j = 0; j < 4; ++j) v[u][j] = *(const f32x4*)(xsrc + (size_t)(row + u) * DM + 256 * j + 4 * F.lane);
            int mofs = F.lane; asm volatile("" : "+v"(mofs));
            if (COMBINE) {
#pragma unroll
                for (int u = 0; u < 2; ++u) {
                    f32x4 s[4];
#pragma unroll
                    for (int j = 0; j < 4; ++j) s[j] = (f32x4){0.f, 0.f, 0.f, 0.f};
#pragma unroll
                    for (int k = 0; k < TOPK; ++k) { const float w = topw[(row + u) * 4 + k]; const int slot = tokslot[(row + u) * 4 + k];
#pragma unroll
                        for (int j = 0; j < 4; ++j) { const v2u yv = *(const v2u*)(Y + (size_t)slot * DM + 256 * j + 4 * F.lane);
                            s[j] += (f32x4){bflo(yv.x), bfhi(yv.x), bflo(yv.y), bfhi(yv.y)} * w; } }
#pragma unroll
                    for (int j = 0; j < 4; ++j) { v[u][j] += mv[(0 * 4 + j) * 64 + mofs] * s[j]; *(f32x4*)(xdst + (size_t)(row + u) * DM + 256 * j + 4 * F.lane) = v[u][j]; }
                }
            }
            if (NORM) {
                float ss[2];
#pragma unroll
                for (int u = 0; u < 2; ++u) { float s = 0.f;
#pragma unroll
                    for (int j = 0; j < 4; ++j) s += (v[u][j].x * v[u][j].x + v[u][j].y * v[u][j].y) + (v[u][j].z * v[u][j].z + v[u][j].w * v[u][j].w);
                    ss[u] = s; }
#pragma unroll
                for (int o = 1; o < 64; o <<= 1) { ss[0] += __shfl_xor(ss[0], o); ss[1] += __shfl_xor(ss[1], o); }
                float fl[2][6];
                int lofs = F.lane; asm volatile("" : "+v"(lofs));
#pragma unroll
                for (int u = 0; u < 2; ++u) { const float rstd = 1.0f / sqrtf(ss[u] * (1.0f / DM) + EPS);
#pragma unroll
                    for (int q = 0; q < 6; ++q) fl[u][q] = 0.f;
#pragma unroll
                    for (int j = 0; j < 4; ++j) { const f32x4 hv = v[u][j] * rstd * mv[(1 * 4 + j) * 64 + mofs] + mv[(2 * 4 + j) * 64 + mofs];
                        v2u o; o.x = pk2(hv.x, hv.y); o.y = pk2(hv.z, hv.w); *(v2u*)(H + (size_t)(row + u) * DM + 256 * j + 4 * F.lane) = o;
#pragma unroll
                        for (int i = 0; i < 4; ++i) { const f32x4 wa = wl4[(4 * j + i) * 64 + lofs]; const f32x2 wb = wl2[(4 * j + i) * 64 + lofs]; const float hx = hv[i];
                            fl[u][0] += hx * wa.x; fl[u][1] += hx * wa.y; fl[u][2] += hx * wa.z; fl[u][3] += hx * wa.w; fl[u][4] += hx * wb.x; fl[u][5] += hx * wb.y; } } }
#pragma unroll
                for (int o = 1; o < 64; o <<= 1)
#pragma unroll
                    for (int u = 0; u < 2; ++u)
#pragma unroll
                        for (int q = 0; q < 6; ++q) fl[u][q] += __shfl_xor(fl[u][q], o);
                if (F.lane < 6) {
#pragma unroll
                    for (int u = 0; u < 2; ++u) { float z = fl[u][0];
#pragma unroll
                        for (int q = 1; q < 6; ++q) z = (F.lane == q) ? fl[u][q] : z;
                        z += F.in[I_FXFB][l * 6 + F.lane];
                        const float lg = fminf(z, 0.f) - __logf(1.0f + __expf(-fabsf(z)));
                        logf[(size_t)(row + u) * 6 + F.lane] = lg; lacc += lg; } }
            }
        }
        if (NORM) {
            if (F.lane < 6) part[F.wave * 8 + F.lane] = lacc;
            __syncthreads();
            if (F.tid < 12) { const int g = F.tid / 6, h = F.tid % 6; gsum[(size_t)(chunk * 2 + g) * 6 + h] = (part[(4 * g) * 8 + h] + part[(4 * g + 1) * 8 + h]) + (part[(4 * g + 2) * 8 + h] + part[(4 * g + 3) * 8 + h]); }
            __syncthreads();
        }
    }
    __syncthreads();
}
__device__ __forceinline__ void p3_postproj(Frame& F, int l) {
    bf16* proj = (bf16*)(F.ws + WS_PROJ); bf16* ymix = (bf16*)(F.ws + WS_YMIX);
    const float* ong = F.in[I_ONG] + (size_t)l * DM;
    const int c4 = 4 * F.lane;
    f32x4 cw[3];
#pragma unroll
    for (int w = 0; w < 3; ++w) cw[w] = *(const f32x4*)(F.in[I_CONVW] + (size_t)(l * 3 + w) * 256 + c4);
    const f32x4 cg = *(const f32x4*)(ong + c4);
    const int e0 = 8 * (F.lane & 7);
    float gq[3][8]; int colv[3];
#pragma unroll
    for (int i = 0; i < 3; ++i) { const int vi = 8 * i + (F.lane >> 3); const int ty = vi / 6;
        colv[i] = (vi < 12 ? COL_SQ + 64 * vi : COL_FQ + 64 * (vi - 12)) + e0;
        const float* gp = (ty == 0 ? F.in[I_SBQG] : ty == 1 ? F.in[I_SBKG] : ty == 2 ? F.in[I_FXQG] : F.in[I_FXKG]) + (size_t)l * 64 + e0; const float sc = (ty == 0 || ty == 2) ? QSCALE : 1.0f;
#pragma unroll
        for (int q = 0; q < 8; ++q) gq[i][q] = gp[q] * sc; }
    LAS unsigned char* scr = F.lds + F.wave * (64 * 144);
    for (int tile = F.blk; tile < NTOK / 64; tile += F.G) {
        const int b = tile / (SEQ / 64), s0 = (tile % (SEQ / 64)) * 64; const size_t row0 = (size_t)b * SEQ + s0;
        {
            const int sw0 = s0 + F.wave * 8;
            f32x4 vm2 = (f32x4){0.f, 0.f, 0.f, 0.f}, vm1 = vm2;
            if (sw0 >= 2) {
                const bf16* p2 = proj + ((size_t)b * SEQ + sw0 - 2) * NPROJ; const bf16* p1 = p2 + NPROJ;
                const v2u c2 = *(const v2u*)(p2 + COL_CC + c4), u2 = *(const v2u*)(p2 + COL_CU + c4), c1 = *(const v2u*)(p1 + COL_CC + c4), u1 = *(const v2u*)(p1 + COL_CU + c4);
                vm2 = (f32x4){bflo(c2.x) * bflo(u2.x), bfhi(c2.x) * bfhi(u2.x), bflo(c2.y) * bflo(u2.y), bfhi(c2.y) * bfhi(u2.y)};
                vm1 = (f32x4){bflo(c1.x) * bflo(u1.x), bfhi(c1.x) * bfhi(u1.x), bflo(c1.y) * bflo(u1.y), bfhi(c1.y) * bfhi(u1.y)}; }
#pragma unroll 1
            for (int tt = 0; tt < 8; tt += 2) {
                bf16* pr[2]; v2u cb[2], cc[2], cu[2]; v4u xq[2][3];
#pragma unroll
                for (int u = 0; u < 2; ++u) { pr[u] = proj + ((size_t)b * SEQ + sw0 + tt + u) * NPROJ;
                    cb[u] = *(const v2u*)(pr[u] + COL_CB + c4); cc[u] = *(const v2u*)(pr[u] + COL_CC + c4); cu[u] = *(const v2u*)(pr[u] + COL_CU + c4);
#pragma unroll
                    for (int i = 0; i < 3; ++i) xq[u][i] = *(const v4u*)(pr[u] + colv[i]); }
                f32x4 y[2]; float ss[2], q2[2][3];
#pragma unroll
                for (int u = 0; u < 2; ++u) {
                    const f32x4 v0 = (f32x4){bflo(cc[u].x) * bflo(cu[u].x), bfhi(cc[u].x) * bfhi(cu[u].x), bflo(cc[u].y) * bflo(cu[u].y), bfhi(cc[u].y) * bfhi(cu[u].y)};
                    y[u] = cw[0] * vm2 + cw[1] * vm1 + cw[2] * v0; vm2 = vm1; vm1 = v0;
                    y[u] = y[u] * (f32x4){bflo(cb[u].x), bfhi(cb[u].x), bflo(cb[u].y), bfhi(cb[u].y)};
                    ss[u] = (y[u].x * y[u].x + y[u].y * y[u].y) + (y[u].z * y[u].z + y[u].w * y[u].w);
#pragma unroll
                    for (int i = 0; i < 3; ++i) { const v4u x = xq[u][i]; const float f[8] = {bflo(x.x), bfhi(x.x), bflo(x.y), bfhi(x.y), bflo(x.z), bfhi(x.z), bflo(x.w), bfhi(x.w)};
                        float a = 0.f;
#pragma unroll
                        for (int k = 0; k < 8; ++k) a += f[k] * f[k];
                        q2[u][i] = a; } }
#pragma unroll
                for (int o = 1; o < 16; o <<= 1)
#pragma unroll
                    for (int u = 0; u < 2; ++u) { ss[u] += __shfl_xor(ss[u], o);
                        if (o < 8) {
#pragma unroll
                            for (int i = 0; i < 3; ++i) q2[u][i] += __shfl_xor(q2[u][i], o); } }
#pragma unroll
                for (int u = 0; u < 2; ++u) {
                    const float rinv = 1.0f / sqrtf(ss[u] * (1.0f / 64.0f) + EPS);
                    const f32x4 yo = y[u] * rinv * cg;
                    v2u o; o.x = pk2(yo.x, yo.y); o.y = pk2(yo.z, yo.w); *(v2u*)(ymix + ((size_t)b * SEQ + sw0 + tt + u) * DM + c4) = o;
#pragma unroll
                    for (int i = 0; i < 3; ++i) { const v4u x = xq[u][i]; const float f[8] = {bflo(x.x), bfhi(x.x), bflo(x.y), bfhi(x.y), bflo(x.z), bfhi(x.z), bflo(x.w), bfhi(x.w)};
                        const float ri = 1.0f / sqrtf(q2[u][i] * (1.0f / 64.0f) + EPS);
                        v4u w; w.x = pk2(f[0] * ri * gq[i][0], f[1] * ri * gq[i][1]); w.y = pk2(f[2] * ri * gq[i][2], f[3] * ri * gq[i][3]);
                        w.z = pk2(f[4] * ri * gq[i][4], f[5] * ri * gq[i][5]); w.w = pk2(f[6] * ri * gq[i][6], f[7] * ri * gq[i][7]);
                        *(v4u*)(pr[u] + colv[i]) = w; } }
            }
        }
        for (int t = F.wave; t < 12; t += 8) {
            const int kind = t / 6, h = t % 6; const int col = (kind ? COL_FV : COL_SV) + 64 * h;
            const bf16* src = proj + (row0 + F.lane) * NPROJ + col;
#pragma unroll
            for (int pc = 0; pc < 8; ++pc) { const v4u x = *(const v4u*)(src + 8 * pc);
                const unsigned xs[4] = {x.x, x.y, x.z, x.w};
#pragma unroll
                for (int q = 0; q < 4; ++q) { *(LAS unsigned short*)(scr + (8 * pc + 2 * q) * 144 + 2 * F.lane) = (unsigned short)(xs[q] & 0xffffu);
                                              *(LAS unsigned short*)(scr + (8 * pc + 2 * q + 1) * 144 + 2 * F.lane) = (unsigned short)(xs[q] >> 16); } }
            asm volatile("s_waitcnt lgkmcnt(0)" ::: "memory");
            bf16* dst = (bf16*)(F.ws + WS_VT) + (size_t)kind * (48 * 64 * SEQ) + ((size_t)(b * 6 + h) * 64 + F.lane) * SEQ + s0;
#pragma unroll
            for (int pc = 0; pc < 8; ++pc) *(v4u*)(dst + 8 * pc) = *(const LAS v4u*)(scr + F.lane * 144 + 16 * pc);
            asm volatile("s_waitcnt lgkmcnt(0)" ::: "memory");
        }
        if (F.wave == 7) { const int gt = tile % (SEQ / 64); const float* gs = (const float*)(F.ws + WS_GSUM) + (size_t)(b * (SEQ / 64)) * 6; const float* lf = (const float*)(F.ws + WS_LOGF) + (row0 + F.lane) * 6;
            float* fo = (float*)(F.ws + WS_FCUM) + (size_t)(b * 6) * SEQ + s0 + F.lane;
#pragma unroll
            for (int h = 0; h < 6; ++h) { float base = (F.lane < gt) ? gs[F.lane * 6 + h] : 0.f; base = wave_sum(base);
                float inc = lf[h];
#pragma unroll
                for (int o = 1; o < 64; o <<= 1) { const float t = __shfl_up(inc, o); if (F.lane >= o) inc += t; }
                fo[(size_t)h * SEQ] = (base + inc) * LOG2E; } }
    }
}

__device__ __forceinline__ void p4_attention(Frame& F, int l) {
    att::Tensors Ts, Tf;
    Ts.proj = (const bf16*)(F.ws + WS_PROJ); Ts.vt = (const bf16*)(F.ws + WS_VT); Ts.fcum = (const float*)(F.ws + WS_FCUM); Ts.ymix = (bf16*)(F.ws + WS_YMIX); Ts.ong = F.in[I_ONG] + (size_t)l * DM;
    Ts.colq = COL_SQ; Ts.colk = COL_SK; Ts.coly = 256;
    Tf = Ts; Tf.vt = Ts.vt + (size_t)48 * 64 * SEQ; Tf.colq = COL_FQ; Tf.colk = COL_FK; Tf.coly = 640;
    const int NU = 48 * 16;
    for (int i = 0; i * F.G < NU; ++i) {
        const int L = (i & 1) ? (i + 1) * F.G - 1 - F.blk : i * F.G + F.blk;
        if (L >= NU) continue;
        const int qb = 15 - L / 48, bh = L % 48;
        att::unit<0>(Ts, bh / 6, bh % 6, qb, F.lds);
    }
    for (int i = 0; i * F.G < NU; ++i) {
        const int L = (i & 1) ? (i + 1) * F.G - 1 - F.blk : i * F.G + F.blk;
        if (L >= NU) continue;
        const int qb = 15 - L / 48, bh = L % 48;
        att::unit<1>(Tf, bh / 6, bh % 6, qb, F.lds);
    }
}

__device__ __forceinline__ void top4of8(const float (&v)[8], const int (&ix)[8], float (&tv)[4], int (&ti)[4]) {
    float w[8];
#pragma unroll
    for (int j = 0; j < 8; ++j) w[j] = v[j];
#pragma unroll
    for (int k = 0; k < 4; ++k) { float bv = w[0]; int bi = ix[0];
#pragma unroll
        for (int j = 1; j < 8; ++j) { const bool t = (w[j] > bv) || (w[j] == bv && ix[j] < bi); bv = t ? w[j] : bv; bi = t ? ix[j] : bi; }
        tv[k] = bv; ti[k] = bi;
#pragma unroll
        for (int j = 0; j < 8; ++j) w[j] = (ix[j] == bi) ? -INFINITY : w[j]; }
}
__device__ __forceinline__ void p6_norm_router(Frame& F, int l, const float* x1) {
    bf16* H = (bf16*)(F.ws + WS_H); float* topw = (float*)(F.ws + WS_TOPW); int* route = (int*)(F.ws + WS_ROUTE); int* hist = (int*)(F.ws + WS_HIST);
    const float* rw = F.in[I_RW] + (size_t)l * DM * NEXP; const float* rb = F.in[I_RB] + (size_t)l * NEXP;
    constexpr int RWP = 2064;
    LAS unsigned char* rwt = F.lds;
    LAS int* cnt = (LAS int*)(F.lds + MISC_OFF + 256);
    for (int idx = F.tid; idx < DM * NEXP; idx += 512) { const int k = idx >> 5, ex = idx & 31; *(LAS unsigned short*)(rwt + ex * RWP + k * 2) = (unsigned short)f2bf(rw[idx]); }
    __syncthreads();
    const int fr = F.lane & 15, fq = F.lane >> 4;
    float rbv[8]; int eix[8];
#pragma unroll
    for (int i = 0; i < 4; ++i) { eix[i] = 4 * fq + i; eix[4 + i] = 16 + 4 * fq + i; rbv[i] = rb[4 * fq + i]; rbv[4 + i] = rb[16 + 4 * fq + i]; }
    for (int chunk = F.blk; chunk < NTOK / 128; chunk += F.G) {
        const int b = chunk / (SEQ / 128);
        if (F.tid < 32) cnt[F.tid] = 0;
        __syncthreads();
        f32x4 A[4], Bv[4];
#pragma unroll
        for (int j = 0; j < 4; ++j) { const int c = 256 * j + 4 * F.lane; const f32x4 g = *(const f32x4*)(F.in[I_N2G] + (size_t)l * DM + c); A[j] = g * (mod4(F, l, b, 4, c) + 1.0f); Bv[j] = mod4(F, l, b, 3, c); }
        const int row0 = chunk * 128 + F.wave * 16;
#pragma unroll 1
        for (int rr = 0; rr < 16; rr += 2) {
            f32x4 v[2][4]; float ss[2];
#pragma unroll
            for (int u = 0; u < 2; ++u)
#pragma unroll
                for (int j = 0; j < 4; ++j) v[u][j] = *(const f32x4*)(x1 + (size_t)(row0 + rr + u) * DM + 256 * j + 4 * F.lane);
#pragma unroll
            for (int u = 0; u < 2; ++u) { float s = 0.f;
#pragma unroll
                for (int j = 0; j < 4; ++j) s += (v[u][j].x * v[u][j].x + v[u][j].y * v[u][j].y) + (v[u][j].z * v[u][j].z + v[u][j].w * v[u][j].w);
                ss[u] = s; }
#pragma unroll
            for (int o = 1; o < 64; o <<= 1) { ss[0] += __shfl_xor(ss[0], o); ss[1] += __shfl_xor(ss[1], o); }
#pragma unroll
            for (int u = 0; u < 2; ++u) { const float rstd = 1.0f / sqrtf(ss[u] * (1.0f / DM) + EPS);
#pragma unroll
                for (int j = 0; j < 4; ++j) { const f32x4 hv = v[u][j] * rstd * A[j] + Bv[j];
                    v2u o; o.x = pk2(hv.x, hv.y); o.y = pk2(hv.z, hv.w); *(v2u*)(H + (size_t)(row0 + rr + u) * DM + 256 * j + 4 * F.lane) = o; } }
        }
        asm volatile("s_waitcnt vmcnt(0)" ::: "memory");
        f32x4 acc0 = (f32x4){0.f, 0.f, 0.f, 0.f}, acc1 = (f32x4){0.f, 0.f, 0.f, 0.f};
        { const bf16* hp = H + (size_t)(row0 + fr) * DM + 8 * fq; const LAS unsigned char* wp = rwt + fr * RWP + 16 * fq;
#pragma unroll 8
          for (int s = 0; s < 32; ++s) { const v4u hb = __builtin_nontemporal_load((const v4u*)(hp + 32 * s));
              const bf16x8 a0 = *(const LAS bf16x8*)(wp + 64 * s), a1 = *(const LAS bf16x8*)(wp + 16 * RWP + 64 * s);
              acc0 = __builtin_amdgcn_mfma_f32_16x16x32_bf16(a0, __builtin_bit_cast(bf16x8, hb), acc0, 0, 0, 0);
              acc1 = __builtin_amdgcn_mfma_f32_16x16x32_bf16(a1, __builtin_bit_cast(bf16x8, hb), acc1, 0, 0, 0); } }
        float cv[8], tv[4], ov[8]; int ti[4], oi[8];
#pragma unroll
        for (int i = 0; i < 4; ++i) { cv[i] = acc0[i] + rbv[i]; cv[4 + i] = acc1[i] + rbv[4 + i]; }
        top4of8(cv, eix, tv, ti);
#pragma unroll
        for (int st = 16; st <= 32; st <<= 1) {
#pragma unroll
            for (int k = 0; k < 4; ++k) { ov[k] = tv[k]; oi[k] = ti[k]; ov[4 + k] = __shfl_xor(tv[k], st); oi[4 + k] = __shfl_xor(ti[k], st); }
            top4of8(ov, oi, tv, ti); }
        const float e1 = __expf(tv[1] - tv[0]), e2 = __expf(tv[2] - tv[0]), e3 = __expf(tv[3] - tv[0]); const float inv = 1.0f / (1.0f + e1 + e2 + e3);
        { const int row = row0 + fr, k = fq;
          const float w = (k == 0 ? 1.0f : k == 1 ? e1 : k == 2 ? e2 : e3) * inv; const int ex = (k == 0 ? ti[0] : k == 1 ? ti[1] : k == 2 ? ti[2] : ti[3]);
          const int pos = __hip_atomic_fetch_add(cnt + ex, 1, __ATOMIC_RELAXED, __HIP_MEMORY_SCOPE_WORKGROUP);
          topw[row * 4 + k] = w; route[row * 4 + k] = ex + 32 * pos; }
        __syncthreads();
        if (F.tid < 32) hist[chunk * 32 + F.tid] = cnt[F.tid];
        __syncthreads();
    }
}

__device__ __forceinline__ void p7_scatter(Frame& F) {
    const int* hist = (const int*)(F.ws + WS_HIST); const int* route = (const int*)(F.ws + WS_ROUTE);
    int* tokslot = (int*)(F.ws + WS_TOKSLOT); int* slottok = (int*)(F.ws + WS_SLOTTOK); int* moetab = (int*)(F.ws + WS_MOETAB);
    LAS int* pre = (LAS int*)F.lds;
    LAS int* base = (LAS int*)(F.lds + 32768);
    for (int i = F.tid; i < 256 * 32; i += 512) pre[i] = hist[i];
    __syncthreads();
    if (F.tid < 32) { int run = 0;
        for (int c = 0; c < 256; ++c) { const int v = pre[c * 32 + F.tid]; pre[c * 32 + F.tid] = run; run += v; }
        base[64 + F.tid] = run; }
    __syncthreads();
    if (F.tid == 0) { int run = 0; for (int ex = 0; ex < NEXP; ++ex) { base[ex] = run; run += (base[64 + ex] + 255) & ~255; } base[NEXP] = run; }
    __syncthreads();
    if (F.blk == 0 && F.tid <= NEXP) moetab[F.tid] = base[F.tid] >> 8;
    for (int chunk = F.blk; chunk < NTOK / 128; chunk += F.G) {
        const int t = chunk * 128 + (F.tid >> 2), k = F.tid & 3; const int rt = route[t * 4 + k]; const int ex = rt & 31, pos = rt >> 5;
        const int slot = base[ex] + pre[chunk * 32 + ex] + pos;
        tokslot[t * 4 + k] = slot; slottok[slot] = t;
    }
    for (int ex = F.blk; ex < NEXP; ex += F.G) { const int lo = base[ex] + base[64 + ex], hi = base[ex + 1]; for (int s = lo + F.tid; s < hi; s += 512) slottok[s] = 0; }
    __syncthreads();
}

struct Args { const float* in[21]; float* out; unsigned char* ws; int ph_lo, ph_hi; };
__device__ __forceinline__ void launder(Frame& F) { int t = threadIdx.x; asm volatile("" : "+v"(t)); F.tid = t; F.lane = t & 63; F.wave = __builtin_amdgcn_readfirstlane(t >> 6);
    const __attribute__((address_space(4))) Args* ap = (const __attribute__((address_space(4))) Args*)__builtin_amdgcn_kernarg_segment_ptr(); asm volatile("" : "+s"(ap));
#pragma unroll
    for (int i = 0; i < 21; ++i) F.in[i] = ap->in[i];
    F.out = ap->out; F.ws = ap->ws; }
constexpr int N_PHASES = 1 + 9 * NLAYER + 1;

#define PHASE_FN __device__ __forceinline__
__device__ __forceinline__ void make_frame(Frame& F, LAS unsigned char* lds) { F.lds = lds; F.blk = blockIdx.x; F.G = gridDim.x; launder(F); }
PHASE_FN void ph_prologue(LAS unsigned char* lds) { Frame F; make_frame(F, lds); p0_prologue(F); }
PHASE_FN void ph_norm1(LAS unsigned char* lds, int l) { Frame F; make_frame(F, lds);
    if (l == 0) row_phase<false, true>(F, 0, F.in[I_X], nullptr); else row_phase<true, true>(F, l, (const float*)(F.ws + WS_XA), (float*)(F.ws + WS_XB)); }
PHASE_FN void ph_proj(LAS unsigned char* lds, int l) { Frame F; make_frame(F, lds);
    pg8::Gemm g{(const bf16*)(F.ws + WS_H), (const bf16*)(F.ws + WS_WIN) + (size_t)l * NPROJ * DM, nullptr, DM};
    pg8::StaticOrder S; S.init(NTOK, NPROJ, F.G, F.blk);
    pg8::EpiProj E{(bf16*)(F.ws + WS_PROJ), NPROJ};
    pg8::gemm_phase<pg8::EpiProj, pg8::StaticOrder, false>(F.lds, g, S, E); }
PHASE_FN void ph_postproj(LAS unsigned char* lds, int l) { Frame F; make_frame(F, lds); p3_postproj(F, l); }
PHASE_FN void ph_attn(LAS unsigned char* lds, int l) { Frame F; make_frame(F, lds); p4_attention(F, l); }
PHASE_FN void ph_out(LAS unsigned char* lds, int l) { Frame F; make_frame(F, lds);
    const float* xin = (l == 0) ? F.in[I_X] : (const float*)(F.ws + WS_XB);
    pg8::Gemm g{(const bf16*)(F.ws + WS_YMIX), (const bf16*)(F.ws + WS_WOUT) + (size_t)l * DM * DM, nullptr, DM};
    pg8::StaticOrder S; S.init(NTOK, DM, F.G, F.blk);
    pg8::EpiResGate E{xin, (float*)(F.ws + WS_XA), F.in[I_BADA] + (size_t)l * 6144 + 2 * DM, (const float*)(F.ws + WS_MODP) + (size_t)l * 4 * NB * 6144 + 2 * DM};
    pg8::gemm_phase<pg8::EpiResGate, pg8::StaticOrder, false>(F.lds, g, S, E); }
PHASE_FN void ph_router(LAS unsigned char* lds, int l) { Frame F; make_frame(F, lds); p6_norm_router(F, l, (const float*)(F.ws + WS_XA)); }
PHASE_FN void ph_scatter(LAS unsigned char* lds) { Frame F; make_frame(F, lds); p7_scatter(F); }
__device__ __forceinline__ LAS int* moe_table(Frame& F) { LAS int* tb = (LAS int*)(F.lds + MISC_OFF + 64);
    if (F.tid <= NEXP) tb[F.tid] = ((const int*)(F.ws + WS_MOETAB))[F.tid];
    __syncthreads(); return tb; }
PHASE_FN void ph_moe_up(LAS unsigned char* lds, int l) { Frame F; make_frame(F, lds); LAS int* tb = moe_table(F);
    pg8::Gemm g{(const bf16*)(F.ws + WS_H), (const bf16*)(F.ws + WS_W1) + (size_t)l * NEXP * 2048 * DM, (const int*)(F.ws + WS_SLOTTOK), DM};
    pg8::MoeOrder S; S.init(tb, 8, F.G, F.blk);
    pg8::EpiSwiglu E{(bf16*)(F.ws + WS_ACT), F.in[I_B1] + (size_t)l * NEXP * 2048};
    pg8::gemm_phase<pg8::EpiSwiglu, pg8::MoeOrder, true>(F.lds, g, S, E); }
PHASE_FN void ph_moe_down(LAS unsigned char* lds, int l) { Frame F; make_frame(F, lds); LAS int* tb = moe_table(F);
    pg8::Gemm g{(const bf16*)(F.ws + WS_ACT), (const bf16*)(F.ws + WS_W2) + (size_t)l * NEXP * DM * DM, nullptr, DM};
    pg8::MoeOrder S; S.init(tb, 4, F.G, F.blk);
    pg8::EpiY E{(bf16*)(F.ws + WS_Y), F.in[I_B2] + (size_t)l * NEXP * DM};
    pg8::gemm_phase<pg8::EpiY, pg8::MoeOrder, false>(F.lds, g, S, E); }
PHASE_FN void ph_final(LAS unsigned char* lds) { Frame F; make_frame(F, lds); row_phase<true, false>(F, NLAYER, (const float*)(F.ws + WS_XA), F.out); }

#ifndef REP_MASK
#define REP_MASK 0
#endif
__global__ void __launch_bounds__(512, 2) fwd_kernel(Args args) {
    extern __shared__ __attribute__((aligned(16))) unsigned char lds_raw[];
    LAS unsigned char* lds = (LAS unsigned char*)lds_raw;
    volatile LAS unsigned* MISC = (volatile LAS unsigned*)(lds + MISC_OFF);
    if (threadIdx.x < 16) MISC[threadIdx.x] = 0u;
    __syncthreads();
    const int lo = args.ph_lo, hi = args.ph_hi;
    const bool multi = (hi - lo) > 1;
    XcdBarrier bar; bar.bar = (unsigned*)(args.ws + WS_CTL) + CW_BAR; bar.x = 0; bar.st = MISC;
    if (multi) bar = xcd_barrier_post((unsigned*)(args.ws + WS_CTL) + CW_BAR, MISC);
#define IN(k) (lo <= (k) && (k) < hi)
#define SEAM(k) do { if (IN((k) + 1)) xcd_barrier(bar); } while (0)
#define REPS(j) for (int rep_ = 0; rep_ < (((REP_MASK >> (j)) & 1) ? 2 : 1); ++rep_)
    if (IN(0)) { REPS(0) { ph_prologue(lds); SEAM(0); } }
    for (int l = 0; l < NLAYER; ++l) {
        const int p = 1 + 9 * l;
        if (IN(p + 0)) { REPS(1) { ph_norm1(lds, l); SEAM(p + 0); } }
        if (IN(p + 1)) { REPS(2) { ph_proj(lds, l); SEAM(p + 1); } }
        if (IN(p + 2)) { ph_postproj(lds, l); SEAM(p + 2); }
        if (IN(p + 3)) { REPS(4) { ph_attn(lds, l); SEAM(p + 3); } }
        if (IN(p + 4)) { REPS(5) { ph_out(lds, l); SEAM(p + 4); } }
        if (IN(p + 5)) { REPS(6) { ph_router(lds, l); SEAM(p + 5); } }
        if (IN(p + 6)) { REPS(7) { ph_scatter(lds); SEAM(p + 6); } }
        if (IN(p + 7)) { REPS(8) { ph_moe_up(lds, l); SEAM(p + 7); } }
        if (IN(p + 8)) { REPS(9) { ph_moe_down(lds, l); SEAM(p + 8); } }
    }
    if (IN(N_PHASES - 1)) { REPS(10) { ph_final(lds); } }
#undef IN
#undef SEAM
#undef REPS
}

template <int KIND> __global__ void __launch_bounds__(512, 2) phase_kernel(Args args, int l) {
    extern __shared__ __attribute__((aligned(16))) unsigned char lds_raw[];
    LAS unsigned char* lds = (LAS unsigned char*)lds_raw;
    if (KIND == 0) ph_prologue(lds); if (KIND == 1) ph_norm1(lds, l); if (KIND == 2) ph_proj(lds, l); if (KIND == 3) ph_postproj(lds, l); if (KIND == 4) ph_attn(lds, l);
    if (KIND == 5) ph_out(lds, l); if (KIND == 6) ph_router(lds, l); if (KIND == 7) ph_scatter(lds); if (KIND == 8) ph_moe_up(lds, l); if (KIND == 9) ph_moe_down(lds, l); if (KIND == 10) ph_final(lds);
}
template <int KIND> static void launch_phase(const Args& a, int l, int grid, hipStream_t stream) {
    static bool attr = false;
    if (!attr) { (void)hipFuncSetAttribute((const void*)phase_kernel<KIND>, hipFuncAttributeMaxDynamicSharedMemorySize, LDS_BYTES); attr = true; }
    for (int rep = 0; rep < (((REP_MASK >> KIND) & 1) ? 2 : 1); ++rep) hipLaunchKernelGGL(phase_kernel<KIND>, dim3(grid), dim3(512), LDS_BYTES, stream, a, l);
}
#ifndef MK_SPLIT
#define MK_SPLIT 0
#endif
extern "C" void kernel_launch(void* const* d_in, const int* in_sizes, int n_in, void* d_out, int out_size, void* d_ws, size_t ws_size, hipStream_t stream) {
    static int grid = 0;
    if (grid == 0) {
        if (n_in != 21 || in_sizes[0] != NTOK * DM || out_size != NTOK * DM || ws_size < WS_END) {
            fprintf(stderr, "kernel_launch: unexpected shapes: n_in %d in0 %d out %d ws %zu (need %zu)\n", n_in, n_in > 0 ? in_sizes[0] : -1, out_size, ws_size, (size_t)WS_END); grid = -1; return; }
        int dev = 0, cus = 0, per_cu = 0;
        if (hipGetDevice(&dev) != hipSuccess || hipDeviceGetAttribute(&cus, hipDeviceAttributeMultiprocessorCount, dev) != hipSuccess) { fprintf(stderr, "kernel_launch: device query failed\n"); grid = -1; return; }
        if (hipFuncSetAttribute((const void*)fwd_kernel, hipFuncAttributeMaxDynamicSharedMemorySize, LDS_BYTES) != hipSuccess) { fprintf(stderr, "kernel_launch: hipFuncSetAttribute failed\n"); grid = -1; return; }
        if (hipOccupancyMaxActiveBlocksPerMultiprocessor(&per_cu, (const void*)fwd_kernel, 512, LDS_BYTES) != hipSuccess || per_cu < 1) fprintf(stderr, "kernel_launch: note: occupancy query says %d\n", per_cu);
        (void)hipGetLastError();
        grid = cus;
    }
    if (grid < 0) return;
    (void)hipMemsetAsync((char*)d_ws + WS_CTL, 0, CTL_ZERO_BYTES, stream);
    Args a{};
    for (int i = 0; i < 21; ++i) a.in[i] = (const float*)d_in[i];
    a.out = (float*)d_out; a.ws = (unsigned char*)d_ws;
#if MK_SPLIT
    a.ph_lo = 0; a.ph_hi = 0;
    launch_phase<0>(a, 0, grid, stream);
    for (int l = 0; l < NLAYER; ++l) { launch_phase<1>(a, l, grid, stream); launch_phase<2>(a, l, grid, stream); launch_phase<3>(a, l, grid, stream); launch_phase<4>(a, l, grid, stream); launch_phase<5>(a, l, grid, stream);
        launch_phase<6>(a, l, grid, stream); launch_phase<7>(a, l, grid, stream); launch_phase<8>(a, l, grid, stream); launch_phase<9>(a, l, grid, stream); }
    launch_phase<10>(a, 0, grid, stream);
#else
    a.ph_lo = 0; a.ph_hi = N_PHASES; hipLaunchKernelGGL(fwd_kernel, dim3(grid), dim3(512), LDS_BYTES, stream, a);
#endif
}
```

```cpp
#include <hip/hip_runtime.h>
#include <cstdio>
#include <cstdint>

#define GAS __attribute__((address_space(1)))
#define LAS __attribute__((address_space(3)))
typedef unsigned short bf16;
typedef unsigned v4u __attribute__((ext_vector_type(4)));
typedef unsigned v2u __attribute__((ext_vector_type(2)));
typedef float f32x4 __attribute__((ext_vector_type(4)));
typedef float f32x2 __attribute__((ext_vector_type(2)));
typedef float f32x16 __attribute__((ext_vector_type(16)));
typedef short bf16x8 __attribute__((ext_vector_type(8)));
typedef _Float16 f16x8 __attribute__((ext_vector_type(8)));
typedef _Float16 f16x2 __attribute__((ext_vector_type(2)));
typedef int v4i __attribute__((ext_vector_type(4)));
typedef int v8i __attribute__((ext_vector_type(8)));

namespace pg8 {
constexpr int BM = 256, BK = 64, HALF = 128, HTB = HALF * BK * 2  , STAGE_BYTES = 8 * HTB, NXCD = 8, WGM = 8;

__host__ __device__ __forceinline__ int lds_byte(int r, int c) { const int st = (r >> 4) * 2 + (c >> 5), rr = r & 15, cc = c & 31, ob = rr * 64 + cc * 2; return st * 1024 + (ob ^ (((ob >> 9) & 1) << 5)); }
__host__ __device__ __forceinline__ void stage_rc(int b, int& R, int& C) { const int st = b / 1024, sb = b % 1024, swz = sb ^ (((sb >> 9) & 1) << 5); R = (st >> 1) * 16 + swz / 64; C = (st & 1) * 32 + (swz % 64) / 2; }
__host__ __device__ __forceinline__ int perm32(int rho) { const int n = rho >> 4, i = rho & 15; return 8 * (i >> 2) + 4 * n + (i & 3); }

struct Unit { int pm, pn, pb; };
struct Gemm { const bf16* A; const bf16* Bt; const int* rowmap; int K; };

__device__ __forceinline__ unsigned cvt_pk_bf16(float lo, float hi) { unsigned r; asm volatile("v_cvt_pk_bf16_f32 %0, %1, %2" : "=v"(r) : "v"(lo), "v"(hi)); return r; }

template <class Epi, class Sched, bool GATHER, bool FP8 = false>
__device__ __forceinline__ void gemm_phase(LAS unsigned char* lds, const Gemm g, const Sched& S, const Epi& E) {
    int tid_ = threadIdx.x; asm volatile("" : "+v"(tid_));
    const int tid = tid_, wid = __builtin_amdgcn_readfirstlane(tid >> 6), lane = tid & 63, wr = wid >> 2, wc = wid & 3, fr = lane & 15, fq = lane >> 4;
    const int K = g.K, nt = K / BK;
    unsigned voffA[2], voffB[2]; int RA[2], CA[2];
#pragma unroll
    for (int i = 0; i < 2; ++i) { int R, C; stage_rc(tid * 16 + i * 8192, R, C); const int Rb = Epi::PERM ? ((R & ~31) + perm32(R & 31)) : R; RA[i] = R; CA[i] = C;
        voffA[i] = (unsigned)(R * K + C) * 2u; voffB[i] = (unsigned)(Rb * K + C) * 2u; }
    const size_t kstep = (size_t)(BK * 2);
    const size_t hstep = (size_t)HALF * K * 2;
    const size_t tstep = 2 * hstep;
    const unsigned ldsw = (unsigned)wid * 1024u;
    const int aoff = lds_byte(wr * 64 + fr, fq * 8), boff = lds_byte(wc * 32 + fr, fq * 8);
#define PG8_SA(b, h) (((b) * 2 + (h)) * HTB)
#define PG8_SB(b, h) ((4 + (b) * 2 + (h)) * HTB)
#define PG8_STAGE(bufoff, gbase, voff) do { _Pragma("unroll") for (int _i = 0; _i < 2; ++_i) \
        __builtin_amdgcn_global_load_lds((const unsigned*)((const char*)(gbase) + (voff)[_i]), (LAS unsigned*)(lds + (bufoff) + ldsw + _i * 8192), 16, 0, 0); } while (0)
#define PG8_STAGEA(bufoff, pbase, h, nx) do { if constexpr (GATHER) { _Pragma("unroll") for (int _i = 0; _i < 2; ++_i) \
        __builtin_amdgcn_global_load_lds((const unsigned*)((const char*)(pbase) + ((nx) ? gn[h][_i] : gc[h][_i])), (LAS unsigned*)(lds + (bufoff) + ldsw + _i * 8192), 16, 0, 0); } \
        else { PG8_STAGE(bufoff, (const char*)(pbase) + (h) * hstep, voffA); } } while (0)
#define PG8_LDA(dst, b, h) do { if constexpr (FP8) { _Pragma("unroll") for (int m = 0; m < 4; ++m) dst##8[m] = __builtin_shufflevector(*(const LAS v4i*)(lds + PG8_SA(b, h) + aoff + m * 2048), *(const LAS v4i*)(lds + PG8_SA(b, h) + aoff + m * 2048 + 1024), 0, 1, 2, 3, 4, 5, 6, 7); } \
        else { _Pragma("unroll") for (int m = 0; m < 4; ++m) _Pragma("unroll") for (int k = 0; k < 2; ++k) dst[m][k] = *(const LAS bf16x8*)(lds + PG8_SA(b, h) + aoff + m * 2048 + k * 1024); } } while (0)
#define PG8_LDB(dst, b, h) do { if constexpr (FP8) { _Pragma("unroll") for (int n = 0; n < 2; ++n) dst##8[n] = __builtin_shufflevector(*(const LAS v4i*)(lds + PG8_SB(b, h) + boff + n * 2048), *(const LAS v4i*)(lds + PG8_SB(b, h) + boff + n * 2048 + 1024), 0, 1, 2, 3, 4, 5, 6, 7); } \
        else { _Pragma("unroll") for (int n = 0; n < 2; ++n) _Pragma("unroll") for (int k = 0; k < 2; ++k) dst[n][k] = *(const LAS bf16x8*)(lds + PG8_SB(b, h) + boff + n * 2048 + k * 1024); } } while (0)
#define PG8_MMA(ai, bj, At, Bt) do { __builtin_amdgcn_s_setprio(1); if constexpr (FP8) { _Pragma("unroll") for (int m = 0; m < 4; ++m) _Pragma("unroll") for (int n = 0; n < 2; ++n) \
        asm volatile("v_mfma_scale_f32_16x16x128_f8f6f4 %0, %1, %2, %0, %3, %4 op_sel_hi:[0,0,0]" : "+v"(acc[ai][bj][m][n]) : "v"(Bt##8[n]), "v"(At##8[m]), "v"(sclw), "v"(scla)); } \
        else { _Pragma("unroll") for (int m = 0; m < 4; ++m) _Pragma("unroll") for (int n = 0; n < 2; ++n) _Pragma("unroll") for (int k = 0; k < 2; ++k) \
        acc[ai][bj][m][n] = __builtin_amdgcn_mfma_f32_16x16x32_bf16(Bt[n][k], At[m][k], acc[ai][bj][m][n], 0, 0, 0); } __builtin_amdgcn_s_setprio(0); } while (0)
#define PG8_WAIT_V(n) asm volatile("s_waitcnt vmcnt(" #n ")" ::: "memory")
#define PG8_WAIT_L(n) asm volatile("s_waitcnt lgkmcnt(" #n ")" ::: "memory")
#define PG8_BAR __builtin_amdgcn_s_barrier()
#define PG8_SCHED __builtin_amdgcn_sched_barrier(0)
    Unit cur, nxt; int ui = 0;
    if (!S.next(0, cur)) return;
    f32x4 acc[2][2][4][2];
#pragma unroll
    for (int a = 0; a < 2; ++a)
#pragma unroll
        for (int b = 0; b < 2; ++b)
#pragma unroll
            for (int m = 0; m < 4; ++m)
#pragma unroll
                for (int n = 0; n < 2; ++n) acc[a][b][m][n] = (f32x4){0.f, 0.f, 0.f, 0.f};
    bf16x8 At[4][2], B0[2][2], B1[2][2]; v8i At8[4], B08[2], B18[2];
    const int sclw = 0x7A7A7A7A, scla = 0x7F7F7F7F;
    unsigned gc[2][2], gn[2][2];
    if constexpr (GATHER) {
#pragma unroll
        for (int h = 0; h < 2; ++h)
#pragma unroll
            for (int i = 0; i < 2; ++i) { gc[h][i] = (unsigned)(g.rowmap[cur.pm * BM + h * HALF + RA[i]] * K + CA[i]) * 2u; gn[h][i] = gc[h][i]; }
    } else { gc[0][0] = gc[0][1] = gc[1][0] = gc[1][1] = 0u; gn[0][0] = gn[0][1] = gn[1][0] = gn[1][1] = 0u; }
    const char* cA = GATHER ? (const char*)g.A : (const char*)g.A + (size_t)cur.pm * tstep; const char* cB = (const char*)g.Bt + (size_t)cur.pb * tstep;
    PG8_STAGE(PG8_SB(0, 0), cB, voffB); PG8_STAGE(PG8_SB(0, 1), cB + hstep, voffB); PG8_STAGEA(PG8_SA(0, 0), cA, 0, false); PG8_STAGEA(PG8_SA(0, 1), cA, 1, false);
    if (wr == 1) PG8_BAR;
    PG8_WAIT_V(2); PG8_BAR;
    PG8_STAGE(PG8_SB(1, 0), cB + kstep, voffB); PG8_STAGEA(PG8_SA(1, 0), cA + kstep, 0, false); PG8_STAGE(PG8_SB(1, 1), cB + hstep + kstep, voffB);
    PG8_WAIT_V(6); PG8_BAR;
    for (;;) {
        const bool has_next = S.next(ui + 1, nxt);
        if constexpr (GATHER) { if (has_next) {
#pragma unroll
            for (int h = 0; h < 2; ++h)
#pragma unroll
                for (int i = 0; i < 2; ++i) gn[h][i] = (unsigned)(g.rowmap[nxt.pm * BM + h * HALF + RA[i]] * K + CA[i]) * 2u; } }
        const char* nA = GATHER ? cA : (has_next ? (const char*)g.A + (size_t)nxt.pm * tstep : cA); const char* nB = has_next ? (const char*)g.Bt + (size_t)nxt.pb * tstep : cB;
        for (int t = 0; t < nt; t += 2) {
            const bool last = (t == nt - 2);
            const char* a1 = cA + (size_t)(t + 1) * kstep;
            const char* a2 = last ? nA : cA + (size_t)(t + 2) * kstep; const char* b2 = last ? nB : cB + (size_t)(t + 2) * kstep;
            const char* a3 = a2 + kstep; const char* b3 = b2 + kstep;
            PG8_LDB(B0, 0, 0); PG8_LDB(B1, 0, 1); PG8_SCHED; PG8_LDA(At, 0, 0); PG8_STAGEA(PG8_SA(1, 1), a1, 1, false);
            PG8_WAIT_V(8); PG8_WAIT_L(0); PG8_BAR; PG8_MMA(0, 0, At, B0); PG8_MMA(0, 1, At, B1); PG8_BAR; PG8_SCHED;
            PG8_LDA(At, 0, 1); PG8_STAGE(PG8_SB(0, 0), b2, voffB); PG8_STAGE(PG8_SB(0, 1), b2 + hstep, voffB); PG8_STAGEA(PG8_SA(0, 0), a2, 0, last);
            PG8_WAIT_V(8); PG8_WAIT_L(0); PG8_BAR; PG8_MMA(1, 0, At, B0); PG8_MMA(1, 1, At, B1); PG8_BAR; PG8_SCHED;
            PG8_LDB(B0, 1, 0); PG8_LDB(B1, 1, 1); PG8_SCHED; PG8_LDA(At, 1, 0); PG8_STAGEA(PG8_SA(0, 1), a2, 1, last);
            PG8_WAIT_V(8); PG8_WAIT_L(0); PG8_BAR; PG8_MMA(0, 0, At, B0); PG8_MMA(0, 1, At, B1); PG8_BAR; PG8_SCHED;
            PG8_LDA(At, 1, 1); PG8_STAGE(PG8_SB(1, 0), b3, voffB); PG8_STAGE(PG8_SB(1, 1), b3 + hstep, voffB); PG8_STAGEA(PG8_SA(1, 0), a3, 0, last);
            PG8_WAIT_V(8); PG8_WAIT_L(0); PG8_BAR; PG8_MMA(1, 0, At, B0); PG8_MMA(1, 1, At, B1); PG8_BAR; PG8_SCHED;
        }
        if (wr == 0) PG8_BAR;
        if constexpr (FP8) asm volatile("s_nop 15\n\ts_nop 7" ::: "memory");
        E(acc, cur, wr, wc, fr, fq);
        if (!has_next) break;
#pragma unroll
        for (int a = 0; a < 2; ++a)
#pragma unroll
            for (int b = 0; b < 2; ++b)
#pragma unroll
                for (int m = 0; m < 4; ++m)
#pragma unroll
                    for (int n = 0; n < 2; ++n) acc[a][b][m][n] = (f32x4){0.f, 0.f, 0.f, 0.f};
        cur = nxt; cA = nA; cB = nB; ++ui;
        if constexpr (GATHER) {
#pragma unroll
            for (int h = 0; h < 2; ++h)
#pragma unroll
                for (int i = 0; i < 2; ++i) gc[h][i] = gn[h][i]; }
        if (wr == 1) PG8_BAR;
    }
    PG8_WAIT_V(0);
    PG8_BAR;
#undef PG8_SA
#undef PG8_SB
#undef PG8_STAGE
#undef PG8_STAGEA
#undef PG8_LDA
#undef PG8_LDB
#undef PG8_MMA
#undef PG8_WAIT_V
#undef PG8_WAIT_L
#undef PG8_BAR
#undef PG8_SCHED
}
}
constexpr int DM = 1024, NB = 8, SEQ = 4096, NTOK = NB * SEQ, NLAYER = 2;
constexpr int NPROJ = 3072;
constexpr int D_IN = 3078;
constexpr int NEXP = 32, TOPK = 4;
constexpr int NSLOT_MAX = NTOK * TOPK + NEXP * 256;
constexpr int NTILE_MAX = NSLOT_MAX / 256;
constexpr int COL_CB = 0, COL_CC = 256, COL_CU = 512, COL_SQ = 768, COL_SK = 1152, COL_SV = 1536, COL_FQ = 1920, COL_FK = 2304, COL_FV = 2688;
constexpr float EPS = 1e-6f;
constexpr float LOG2E = 1.4426950408889634f;
constexpr float QSCALE = 0.125f * LOG2E;

namespace pg8 {
struct StaticOrder {
    int nM, nN, nwg, G, c;
    __device__ __forceinline__ void init(int M, int N, int G_, int c_) { nM = M / BM; nN = N / BM; nwg = nM * nN; G = G_; c = c_; }
    __device__ __forceinline__ bool next(int i, Unit& u) const {
        const long L = (long)i * G + c; if (L >= nwg) return false;
        int wgid = (int)L; { const int q = nwg / NXCD, r = nwg % NXCD, xcd = wgid % NXCD, off = wgid / NXCD; wgid = (xcd < r ? xcd * (q + 1) : r * (q + 1) + (xcd - r) * q) + off; }
        const int nig = WGM * nN, gid = wgid / nig, fm = gid * WGM, gsz = (nM - fm) < WGM ? (nM - fm) : WGM;
        u.pm = fm + ((wgid % nig) % gsz); u.pn = (wgid % nig) / gsz; u.pb = u.pn; return true;
    }
};
struct MoeOrder {
    int nM, nN, nwg, G, c; const LAS int* tb;
    __device__ __forceinline__ void init(const LAS int* tb_, int nN_, int G_, int c_) { tb = tb_; nM = tb_[NEXP]; nN = nN_; nwg = nM * nN; G = G_; c = c_; }
    __device__ __forceinline__ bool next(int i, Unit& u) const {
        const long L = (long)i * G + c; if (L >= nwg) return false;
        int wgid = (int)L; { const int q = nwg / NXCD, r = nwg % NXCD, xcd = wgid % NXCD, off = wgid / NXCD; wgid = (xcd < r ? xcd * (q + 1) : r * (q + 1) + (xcd - r) * q) + off; }
        const int nig = WGM * nN, gid = wgid / nig, fm = gid * WGM, gsz = (nM - fm) < WGM ? (nM - fm) : WGM;
        u.pm = fm + ((wgid % nig) % gsz); u.pn = (wgid % nig) / gsz;
        int e = 0;
#pragma unroll 1
        for (int j = 1; j < NEXP; ++j) e += (tb[j] <= u.pm) ? 1 : 0;
        u.pb = e * nN + u.pn; return true;
    }
};

struct EpiProj {
    static constexpr bool PERM = true;
    bf16* O; int ldc;
    __device__ __forceinline__ void operator()(const f32x4 (&acc)[2][2][4][2], const Unit& u, int wr, int wc, int fr, int fq) const {
        const int row0 = u.pm * BM + wr * 64 + fr, col0 = u.pn * BM + wc * 32 + 8 * fq;
#pragma unroll
        for (int ai = 0; ai < 2; ++ai)
#pragma unroll
            for (int m = 0; m < 4; ++m) { bf16* rowp = O + (size_t)(row0 + ai * HALF + m * 16) * ldc + col0;
#pragma unroll
                for (int bj = 0; bj < 2; ++bj) { const f32x4 v0 = acc[ai][bj][m][0], v1 = acc[ai][bj][m][1];
                    v4u w; w.x = cvt_pk_bf16(v0[0], v0[1]); w.y = cvt_pk_bf16(v0[2], v0[3]); w.z = cvt_pk_bf16(v1[0], v1[1]); w.w = cvt_pk_bf16(v1[2], v1[3]);
                    *(v4u*)(rowp + bj * HALF) = w; } }
    }
};
struct EpiResGate {
    static constexpr bool PERM = false;
    const float* base; float* out; const float* gbias; const float* gpart;
    __device__ __forceinline__ void operator()(const f32x4 (&acc)[2][2][4][2], const Unit& u, int wr, int wc, int fr, int fq) const {
        const int row0 = u.pm * BM + wr * 64 + fr, col0 = u.pn * BM + wc * 32 + 4 * fq; const int b = (u.pm * BM) / SEQ;
#pragma unroll
        for (int bj = 0; bj < 2; ++bj)
#pragma unroll
            for (int n = 0; n < 2; ++n) { const int c = col0 + bj * HALF + n * 16; f32x4 gv = *(const f32x4*)(gbias + c);
#pragma unroll
                for (int ks = 0; ks < 4; ++ks) gv += *(const f32x4*)(gpart + (size_t)(ks * NB + b) * 6144 + c);
#pragma unroll
                for (int ai = 0; ai < 2; ++ai)
#pragma unroll
                    for (int m = 0; m < 4; ++m) { const size_t off = (size_t)(row0 + ai * HALF + m * 16) * DM + c;
                        *(f32x4*)(out + off) = *(const f32x4*)(base + off) + gv * acc[ai][bj][m][n]; } }
    }
};
struct EpiSwiglu {
    static constexpr bool PERM = true;
    bf16* O; const float* b1;
    __device__ __forceinline__ void operator()(const f32x4 (&acc)[2][2][4][2], const Unit& u, int wr, int wc, int fr, int fq) const {
        const int row0 = u.pm * BM + wr * 64 + fr; const int e = u.pb >> 3; const int j0 = u.pn * 128 + wc * 32 + 8 * fq;
        const float* bp = b1 + (size_t)e * 2048 + 2 * j0;
        f32x4 bb[4];
#pragma unroll
        for (int q = 0; q < 4; ++q) bb[q] = *(const f32x4*)(bp + 4 * q);
        float bg[8], bl[8];
#pragma unroll
        for (int q = 0; q < 4; ++q) { bg[2 * q] = bb[q][0]; bl[2 * q] = bb[q][1]; bg[2 * q + 1] = bb[q][2]; bl[2 * q + 1] = bb[q][3]; }
#pragma unroll
        for (int ai = 0; ai < 2; ++ai)
#pragma unroll
            for (int m = 0; m < 4; ++m) { bf16* rowp = O + (size_t)(row0 + ai * HALF + m * 16) * DM + j0;
                float a[8];
#pragma unroll
                for (int n = 0; n < 2; ++n)
#pragma unroll
                    for (int i = 0; i < 4; ++i) { float gl = acc[ai][0][m][n][i] + bg[4 * n + i], li = acc[ai][1][m][n][i] + bl[4 * n + i];
                        gl = fminf(gl, 7.0f); li = fminf(fmaxf(li, -7.0f), 7.0f);
                        const float sg = __builtin_amdgcn_rcpf(1.0f + __builtin_amdgcn_exp2f(-1.702f * LOG2E * gl));
                        a[4 * n + i] = gl * sg * (li + 1.0f); }
                v4u w; w.x = cvt_pk_bf16(a[0], a[1]); w.y = cvt_pk_bf16(a[2], a[3]); w.z = cvt_pk_bf16(a[4], a[5]); w.w = cvt_pk_bf16(a[6], a[7]);
                *(v4u*)rowp = w; }
    }
};
__device__ __forceinline__ float clamp448(float v) { return __builtin_amdgcn_fmed3f(v, -448.0f, 448.0f); }
__device__ __forceinline__ unsigned pk4_fp8(float a, float b, float c, float d) { unsigned r = 0; r = __builtin_amdgcn_cvt_pk_fp8_f32(clamp448(a), clamp448(b), r, false); r = __builtin_amdgcn_cvt_pk_fp8_f32(clamp448(c), clamp448(d), r, true); return r; }
struct EpiSwiglu8 {
    static constexpr bool PERM = true;
    unsigned char* O; const float* b1;
    __device__ __forceinline__ void operator()(const f32x4 (&acc)[2][2][4][2], const Unit& u, int wr, int wc, int fr, int fq) const {
        const int row0 = u.pm * BM + wr * 64 + fr; const int e = u.pb >> 3; const int j0 = u.pn * 128 + wc * 32 + 8 * fq;
        const float* bp = b1 + (size_t)e * 2048 + 2 * j0;
        f32x4 bb[4];
#pragma unroll
        for (int q = 0; q < 4; ++q) bb[q] = *(const f32x4*)(bp + 4 * q);
        float bg[8], bl[8];
#pragma unroll
        for (int q = 0; q < 4; ++q) { bg[2 * q] = bb[q][0]; bl[2 * q] = bb[q][1]; bg[2 * q + 1] = bb[q][2]; bl[2 * q + 1] = bb[q][3]; }
#pragma unroll
        for (int ai = 0; ai < 2; ++ai)
#pragma unroll
            for (int m = 0; m < 4; ++m) { unsigned char* rowp = O + (size_t)(row0 + ai * HALF + m * 16) * DM + j0;
                float a[8];
#pragma unroll
                for (int n = 0; n < 2; ++n)
#pragma unroll
                    for (int i = 0; i < 4; ++i) { float gl = acc[ai][0][m][n][i] + bg[4 * n + i], li = acc[ai][1][m][n][i] + bl[4 * n + i];
                        gl = fminf(gl, 7.0f); li = fminf(fmaxf(li, -7.0f), 7.0f);
                        const float sg = __builtin_amdgcn_rcpf(1.0f + __builtin_amdgcn_exp2f(-1.702f * LOG2E * gl));
                        a[4 * n + i] = gl * sg * (li + 1.0f); }
                v2u w; w.x = pk4_fp8(a[0], a[1], a[2], a[3]); w.y = pk4_fp8(a[4], a[5], a[6], a[7]);
                *(v2u*)rowp = w; }
    }
};
struct EpiY {
    static constexpr bool PERM = true;
    bf16* O; const float* b2;
    __device__ __forceinline__ void operator()(const f32x4 (&acc)[2][2][4][2], const Unit& u, int wr, int wc, int fr, int fq) const {
        const int row0 = u.pm * BM + wr * 64 + fr; const int e = u.pb >> 2; const int col0 = u.pn * BM + wc * 32 + 8 * fq;
        f32x4 bv[2][2];
#pragma unroll
        for (int bj = 0; bj < 2; ++bj)
#pragma unroll
            for (int n = 0; n < 2; ++n) bv[bj][n] = *(const f32x4*)(b2 + (size_t)e * DM + col0 + bj * HALF + 4 * n);
#pragma unroll
        for (int ai = 0; ai < 2; ++ai)
#pragma unroll
            for (int m = 0; m < 4; ++m) { bf16* rowp = O + (size_t)(row0 + ai * HALF + m * 16) * DM + col0;
#pragma unroll
                for (int bj = 0; bj < 2; ++bj) { const f32x4 v0 = acc[ai][bj][m][0] + bv[bj][0], v1 = acc[ai][bj][m][1] + bv[bj][1];
                    v4u w; w.x = cvt_pk_bf16(v0[0], v0[1]); w.y = cvt_pk_bf16(v0[2], v0[3]); w.z = cvt_pk_bf16(v1[0], v1[1]); w.w = cvt_pk_bf16(v1[2], v1[3]);
                    *(v4u*)(rowp + bj * HALF) = w; } }
    }
};
}
namespace att {
constexpr int KROW = 128;
constexpr int TILE_B = 64 * KROW;
constexpr int OFF_K = 0, OFF_V = 2 * TILE_B, OFF_F = 4 * TILE_B, OFF_Q = OFF_F + 512, LDS_BYTES = OFF_Q + 8 * 4608;
__device__ __forceinline__ int pim(int m) { const int a = m >> 3, h = (m >> 2) & 1, b = m & 3; return 16 * (a >> 1) + 8 * h + 4 * (a & 1) + b; }
__device__ __forceinline__ unsigned pk_bf16(float lo, float hi) { unsigned r; asm volatile("v_cvt_pk_bf16_f32 %0, %1, %2" : "=v"(r) : "v"(lo), "v"(hi)); return r; }
__device__ __forceinline__ unsigned pk_f16(float lo, float hi) { return __builtin_bit_cast(unsigned, __builtin_amdgcn_cvt_pkrtz(lo, hi)); }
__device__ __forceinline__ float half_sum(float v) { auto rr = __builtin_amdgcn_permlane32_swap(__float_as_uint(v), __float_as_uint(v), false, false); return __uint_as_float(rr[0]) + __uint_as_float(rr[1]); }
__device__ __forceinline__ float half_max(float v) { auto rr = __builtin_amdgcn_permlane32_swap(__float_as_uint(v), __float_as_uint(v), false, false); return fmaxf(__uint_as_float(rr[0]), __uint_as_float(rr[1])); }
#define ATT_SB() __builtin_amdgcn_sched_barrier(0)
#define ATT_MFMA(a, b, c) __builtin_amdgcn_mfma_f32_32x32x16_bf16((a), (b), (c), 0, 0, 0)
#define ATT_MFMAH(a, b, c) __builtin_amdgcn_mfma_f32_32x32x16_f16((a), (b), (c), 0, 0, 0)

struct Tensors {
    const bf16* proj;
    const bf16* vt;
    const float* fcum;
    bf16* ymix;
    const float* ong;
    int colq, colk, coly;
};
struct WaveCtx { int r32, hi, qabs; int ko[4]; const LAS unsigned char* qb; f16x8 mtri0, mtri1, mones; };

__device__ __forceinline__ void qk_only(f32x16& p0, f32x16& p1, const LAS unsigned char* Kb, const WaveCtx& W) {
#pragma unroll
    for (int r = 0; r < 16; ++r) { p0[r] = 0.f; p1[r] = 0.f; }
#pragma unroll
    for (int d0 = 0; d0 < 4; ++d0) { const bf16x8 ka = *(const LAS bf16x8*)(Kb + W.ko[d0]), kb2 = *(const LAS bf16x8*)(Kb + 32 * KROW + W.ko[d0]);
        const bf16x8 qv = *(const LAS bf16x8*)(W.qb + 32 * d0);
        p0 = ATT_MFMA(ka, qv, p0); p1 = ATT_MFMA(kb2, qv, p1); }
}

template <int KIND, bool DIAG>
__device__ __forceinline__ void tile(f32x16& p0, f32x16& p1, f32x16& o0, f32x16& o1, float& carry, float& lsum, const LAS unsigned char* Kn, const LAS unsigned char* Vb, const LAS float* Fb, int kt, const WaveCtx& W) {
    const int kbase = kt * 64 + 8 * W.hi;
#define ATT_KF(i) (*(const LAS bf16x8*)(Kn + ((i) & 1) * 32 * KROW + W.ko[(i) >> 1]))
#define ATT_VF(i) (*(const LAS bf16x8*)(Vb + ((i) & 1) * 32 * KROW + W.ko[(i) >> 1]))
#define ATT_QF(d0) (*(const LAS bf16x8*)(W.qb + 32 * (d0)))
    bf16x8 kcur = ATT_KF(0), knxt = kcur, qcur = ATT_QF(0), qnxt = qcur;
    f32x16 n0, n1;
#pragma unroll
    for (int r = 0; r < 16; ++r) { n0[r] = 0.f; n1[r] = 0.f; }
    v4u wf[4];
    if (KIND == 0) {
        v4u lf[4]; float lfirst = 0.f, pz0 = 0.f;
#pragma unroll
        for (int i = 0; i < 8; ++i) {
            if (i < 7) { knxt = ATT_KF(i + 1); if (i & 1) qnxt = ATT_QF((i + 1) >> 1); }
#pragma unroll
            for (int jj = 0; jj < 2; ++jj) { const int r = (4 * i + 2 * jj) & 15; float lg[2];
#pragma unroll
                for (int e = 0; e < 2; ++e) { const float z = (i < 4) ? p0[r + e] : p1[r + e]; float g = __builtin_amdgcn_logf(1.0f + __builtin_amdgcn_exp2f(z));
                    if (i < 4) p0[r + e] = z - g; else p1[r + e] = z - g;
                    if (DIAG) { const int key = kbase + (i < 4 ? 0 : 32) + 16 * ((r + e) >> 3) + ((r + e) & 7); g = (key < W.qabs) ? g : 0.f; }
                    lg[e] = g; }
                if (i == 0 && jj == 0) { lfirst = -lg[0]; pz0 = p0[0]; }
                lf[2 * (i >> 2) + (r >> 3)][(r & 7) >> 1] = pk_f16(-lg[0], -lg[1]); }
            if (i & 1) { n1 = ATT_MFMA(kcur, qcur, n1); qcur = qnxt; } else n0 = ATT_MFMA(kcur, qcur, n0);
            kcur = knxt;
            ATT_SB();
        }
        bf16x8 va = ATT_VF(0), vb = ATT_VF(1), vna = va, vnb = vb;
#pragma unroll
        for (int r = 0; r < 16; ++r) { p0[r] += carry; p1[r] += carry; }
        p0 = ATT_MFMAH(W.mtri0, __builtin_bit_cast(f16x8, lf[0]), p0); p1 = ATT_MFMAH(W.mtri0, __builtin_bit_cast(f16x8, lf[2]), p1);
        p0 = ATT_MFMAH(W.mtri1, __builtin_bit_cast(f16x8, lf[1]), p0); p1 = ATT_MFMAH(W.mtri1, __builtin_bit_cast(f16x8, lf[3]), p1);
        p0 = ATT_MFMAH(W.mones, __builtin_bit_cast(f16x8, lf[2]), p0);
        p0 = ATT_MFMAH(W.mones, __builtin_bit_cast(f16x8, lf[3]), p0);
        ATT_SB();
        const float t00 = p0[0];
#pragma unroll
        for (int c = 0; c < 4; ++c) {
            if (c < 3) { vna = ATT_VF(2 * c + 2); vnb = ATT_VF(2 * c + 3); }
#pragma unroll
            for (int j = 0; j < 4; ++j) { const int r = 8 * (c & 1) + 2 * j; float w[2];
#pragma unroll
                for (int e = 0; e < 2; ++e) { const float t = (c < 2) ? p0[r + e] : p1[r + e]; float x = __builtin_amdgcn_exp2f(t);
                    if (DIAG) { const int key = kbase + (c < 2 ? 0 : 32) + 16 * ((r + e) >> 3) + ((r + e) & 7); x = (key < W.qabs) ? x : 0.f; }
                    w[e] = x; }
                wf[c][j] = pk_bf16(w[0], w[1]); }
            o0 = ATT_MFMA(va, __builtin_bit_cast(bf16x8, wf[c]), o0); o1 = ATT_MFMA(vb, __builtin_bit_cast(bf16x8, wf[c]), o1);
            va = vna; vb = vnb;
            ATT_SB();
        }
        carry = half_sum(W.hi == 0 ? (t00 - pz0) + lfirst : 0.f);
    } else {
#define ATT_FBV(i) (*(const LAS f32x4*)(Fb + 8 * W.hi + 32 * ((i) >> 2) + 16 * (((i) >> 1) & 1) + 4 * ((i) & 1)))
        f32x4 fcur = ATT_FBV(0), fnxt = fcur;
        float mx = -1e30f;
#pragma unroll
        for (int i = 0; i < 8; ++i) {
            if (i < 7) { knxt = ATT_KF(i + 1); fnxt = ATT_FBV(i + 1); if (i & 1) qnxt = ATT_QF((i + 1) >> 1); }
#pragma unroll
            for (int e = 0; e < 4; ++e) { const int r = (4 * i + e) & 15; float s = ((i < 4) ? p0[r] : p1[r]) - fcur[e];
                if (DIAG) { const int key = kbase + (i < 4 ? 0 : 32) + 16 * (r >> 3) + (r & 7); s = (key > W.qabs) ? -1e30f : s; }
                if (i < 4) p0[r] = s; else p1[r] = s; mx = fmaxf(mx, s); }
            if (i & 1) { n1 = ATT_MFMA(kcur, qcur, n1); qcur = qnxt; } else n0 = ATT_MFMA(kcur, qcur, n0);
            kcur = knxt; fcur = fnxt;
            ATT_SB();
        }
        bf16x8 va = ATT_VF(0), vb = ATT_VF(1), vna = va, vnb = vb;
        mx = half_max(mx);
        if (__any(mx > carry)) {
            const float mnew = fmaxf(carry, mx), alpha = __builtin_amdgcn_exp2f(carry - mnew); carry = mnew; lsum *= alpha;
#pragma unroll
            for (int r = 0; r < 16; ++r) { o0[r] *= alpha; o1[r] *= alpha; }
        }
        ATT_SB();
        float ps = 0.f;
#pragma unroll
        for (int c = 0; c < 4; ++c) {
            if (c < 3) { vna = ATT_VF(2 * c + 2); vnb = ATT_VF(2 * c + 3); }
#pragma unroll
            for (int j = 0; j < 4; ++j) { const int r = 8 * (c & 1) + 2 * j;
                const float a = __builtin_amdgcn_exp2f(((c < 2) ? p0[r] : p1[r]) - carry), d = __builtin_amdgcn_exp2f(((c < 2) ? p0[r + 1] : p1[r + 1]) - carry);
                ps += a + d; wf[c][j] = pk_bf16(a, d); }
            o0 = ATT_MFMA(va, __builtin_bit_cast(bf16x8, wf[c]), o0); o1 = ATT_MFMA(vb, __builtin_bit_cast(bf16x8, wf[c]), o1);
            va = vna; vb = vnb;
            ATT_SB();
        }
        lsum += half_sum(ps);
    }
    p0 = n0; p1 = n1;
#undef ATT_KF
#undef ATT_QF
#undef ATT_VF
#undef ATT_FBV
}

template <int KIND>
__device__ __forceinline__ void unit(const Tensors& T, int b, int h, int qb, LAS unsigned char* lds) {
    int tid_ = threadIdx.x; asm volatile("" : "+v"(tid_));
    const int tid = tid_, lane = tid & 63; const int wid = __builtin_amdgcn_readfirstlane(tid >> 6);
    WaveCtx W; W.r32 = lane & 31; W.hi = lane >> 5;
    const int q0 = qb * 256, qw0 = q0 + wid * 32; W.qabs = qw0 + W.r32;
    const size_t rowbase = (size_t)b * SEQ;
    const int ktd = qw0 >> 6;
    const int kt_hi = (q0 + 255) >> 6;
    const int srow = tid >> 3, cg = (tid & 7) ^ ((srow >> 1) & 7);
    const bf16* kg = T.proj + (rowbase + srow) * NPROJ + T.colk + h * 64 + cg * 8;
    const bf16* vg = T.vt + ((size_t)(b * 6 + h) * 64 + srow) * SEQ + cg * 8;
    const float* fg = T.fcum + (size_t)(b * 6 + h) * SEQ;
    LAS unsigned char* qlds = lds + OFF_Q + wid * 4608;
    W.qb = qlds + W.r32 * 144 + W.hi * 16;
    { const bf16* qp = T.proj + (rowbase + W.qabs) * NPROJ + T.colq + h * 64 + W.hi * 8;
      v4u qt[4];
#pragma unroll
      for (int d0 = 0; d0 < 4; ++d0) qt[d0] = *(const v4u*)(qp + d0 * 16);
#pragma unroll
      for (int d0 = 0; d0 < 4; ++d0) *(LAS v4u*)(qlds + W.r32 * 144 + W.hi * 16 + 32 * d0) = qt[d0]; }
    const int pm = pim(W.r32);
#pragma unroll
    for (int j = 0; j < 4; ++j) W.ko[j] = pm * KROW + (((2 * j + W.hi) ^ ((pm >> 1) & 7)) << 4);
#pragma unroll
    for (int i = 0; i < 8; ++i) { W.mtri0[i] = (_Float16)((8 * W.hi + i > pm) ? 1.0f : 0.0f); W.mtri1[i] = (_Float16)((16 + 8 * W.hi + i > pm) ? 1.0f : 0.0f); W.mones[i] = (_Float16)1.0f; }
    f32x16 o0, o1, p0, p1;
#pragma unroll
    for (int r = 0; r < 16; ++r) { o0[r] = 0.f; o1[r] = 0.f; p0[r] = 0.f; p1[r] = 0.f; }
    float carry = (KIND == 1) ? -1e30f : 0.f, lsum = 0.f;
#define ATT_KB(t) (lds + OFF_K + ((t) & 1) * TILE_B)
#define ATT_VB(t) (lds + OFF_V + ((t) & 1) * TILE_B)
#define ATT_FB(t) ((LAS float*)(lds + OFF_F + ((t) & 1) * 256))
#define ATT_DMA(gsrc, ldst) __builtin_amdgcn_global_load_lds((const unsigned*)(gsrc), (LAS unsigned*)((ldst) + wid * 1024), 16, 0, 0)
    ATT_DMA(kg + (size_t)kt_hi * 64 * NPROJ, ATT_KB(kt_hi)); ATT_DMA(vg + kt_hi * 64, ATT_VB(kt_hi)); ATT_DMA(kg + (size_t)(kt_hi - 1) * 64 * NPROJ, ATT_KB(kt_hi - 1));
    if (KIND == 1 && tid < 64) ATT_FB(kt_hi)[tid] = fg[kt_hi * 64 + tid];
    __syncthreads();
    if (ktd == kt_hi) qk_only(p0, p1, ATT_KB(kt_hi), W);
    __syncthreads();
    for (int kt = kt_hi; kt >= 0; --kt) {
        float freg = 0.f;
        if (kt >= 2) ATT_DMA(kg + (size_t)(kt - 2) * 64 * NPROJ, ATT_KB(kt - 2));
        if (kt >= 1) { ATT_DMA(vg + (kt - 1) * 64, ATT_VB(kt - 1)); if (KIND == 1 && tid < 64) freg = fg[(kt - 1) * 64 + tid]; }
        if (kt <= ktd) {
            if (kt == ktd) tile<KIND, true>(p0, p1, o0, o1, carry, lsum, ATT_KB(kt - 1), ATT_VB(kt), ATT_FB(kt), kt, W);
            else tile<KIND, false>(p0, p1, o0, o1, carry, lsum, ATT_KB(kt - 1), ATT_VB(kt), ATT_FB(kt), kt, W);
        } else if (kt - 1 == ktd) qk_only(p0, p1, ATT_KB(kt - 1), W);
        if (KIND == 1 && kt >= 1 && tid < 64) ATT_FB(kt - 1)[tid] = freg;
        __syncthreads();
    }
#undef ATT_KB
#undef ATT_VB
#undef ATT_FB
#undef ATT_DMA
    if (KIND == 1) { const float inv = 1.0f / lsum;
#pragma unroll
        for (int r = 0; r < 16; ++r) { o0[r] *= inv; o1[r] *= inv; } }
    float ss = 0.f;
#pragma unroll
    for (int r = 0; r < 16; ++r) ss += o0[r] * o0[r] + o1[r] * o1[r];
    ss = half_sum(ss);
    const float rinv = 1.0f / sqrtf(ss * (1.0f / 64.0f) + EPS);
    const float* gp = T.ong + T.coly + h * 64 + 8 * W.hi;
    bf16* yp = T.ymix + (rowbase + W.qabs) * DM + T.coly + h * 64 + 8 * W.hi;
#pragma unroll
    for (int d0 = 0; d0 < 2; ++d0)
#pragma unroll
        for (int g = 0; g < 2; ++g) { const f32x4 ga = *(const f32x4*)(gp + 32 * d0 + 16 * g), gb = *(const f32x4*)(gp + 32 * d0 + 16 * g + 4);
            float v[8];
#pragma unroll
            for (int i = 0; i < 8; ++i) v[i] = (d0 == 0 ? o0[8 * g + i] : o1[8 * g + i]) * rinv * (i < 4 ? ga[i & 3] : gb[i & 3]);
            v4u w; w.x = pk_bf16(v[0], v[1]); w.y = pk_bf16(v[2], v[3]); w.z = pk_bf16(v[4], v[5]); w.w = pk_bf16(v[6], v[7]);
            *(v4u*)(yp + 32 * d0 + 16 * g) = w; }
}
}
constexpr size_t MiB = 1u << 20;
constexpr size_t WS_CTL = 0, CTL_ZERO_BYTES = 1 * MiB;
constexpr size_t WS_MODP = 1 * MiB;
constexpr size_t WS_TOPW = 3 * MiB;
constexpr size_t WS_ROUTE = WS_TOPW + 512 * 1024;
constexpr size_t WS_TOKSLOT = WS_ROUTE + 512 * 1024;
constexpr size_t WS_SLOTTOK = WS_TOKSLOT + 512 * 1024;
constexpr size_t WS_HIST = WS_SLOTTOK + 576 * 1024;
constexpr size_t WS_MOETAB = WS_HIST + 32 * 1024;
constexpr size_t WS_LOGF = 6 * MiB;
constexpr size_t WS_FCUM = 7 * MiB;
constexpr size_t WS_WIN = 8 * MiB, WS_WOUT = 20 * MiB, WS_W1 = 24 * MiB, WS_W2 = 280 * MiB;
constexpr size_t WS_H = 408 * MiB;
constexpr size_t WS_PROJ = 472 * MiB;
constexpr size_t WS_VT = 664 * MiB;
constexpr size_t WS_YMIX = 712 * MiB;
constexpr size_t WS_XA = 776 * MiB, WS_XB = 904 * MiB;
constexpr size_t WS_ACT = 1032 * MiB, WS_Y = 1304 * MiB, WS_H8 = 1576 * MiB, WS_END = 1608 * MiB;
static_assert(WS_MOETAB + 256 <= WS_LOGF && (size_t)NSLOT_MAX * 4 <= 576 * 1024 && (size_t)NSLOT_MAX * DM * 2 <= 272 * MiB, "ws map");
constexpr int CW_BAR = 4096;

constexpr int RING_BYTES = 131072;
constexpr int MISC_OFF = RING_BYTES;
constexpr int LDS_BYTES = 147456;

#define RLX_AGENT __ATOMIC_RELAXED, __HIP_MEMORY_SCOPE_AGENT
__device__ __forceinline__ unsigned f2bf(float f) { unsigned u = __builtin_bit_cast(unsigned, f); return (u + 0x7fffu + ((u >> 16) & 1u)) >> 16; }
__device__ __forceinline__ unsigned pk2(float lo, float hi) { return f2bf(lo) | (f2bf(hi) << 16); }
__device__ __forceinline__ float bflo(unsigned u) { return __builtin_bit_cast(float, u << 16); }
__device__ __forceinline__ float bfhi(unsigned u) { return __builtin_bit_cast(float, u & 0xffff0000u); }
__device__ __forceinline__ float wave_sum(float v) {
#pragma unroll
    for (int o = 1; o < 64; o <<= 1) v += __shfl_xor(v, o);
    return v;
}

#define XB_TMO      128
#define XB_XCNT(j)  (256  + 64 * (j))
#define XB_XSUB(j)  (1280 + 64 * (j))
#define XB_XGEN(j)  (2304 + 64 * (j))
#define XB_TOP      3328
#define XB_TOPGEN   3392
#define XCD_BAR_WORDS 3456
#define XB_SPIN_CAP (1u << 18)
__device__ __forceinline__ unsigned xb_ld(unsigned* p)              { return __hip_atomic_load(p, __ATOMIC_RELAXED, __HIP_MEMORY_SCOPE_AGENT); }
__device__ __forceinline__ unsigned xb_add(unsigned* p, unsigned v) { return __hip_atomic_fetch_add(p, v, __ATOMIC_RELAXED, __HIP_MEMORY_SCOPE_AGENT); }
__device__ __forceinline__ unsigned xb_xcc_id() { return (unsigned)__builtin_amdgcn_s_getreg((3 << 11) | 20) & 0xFu; }
#define XB_SPIN(cond, bar) do { unsigned _sp = 0; while (cond) { __builtin_amdgcn_s_sleep(1); \
    if ((++_sp & 255u) == 0u) { if (xb_ld(&(bar)[XB_TMO])) break; if (_sp > XB_SPIN_CAP) { atomicAdd(&(bar)[XB_TMO], 1u); break; } } } } while (0)
struct XcdBarrier { unsigned* bar; unsigned x; volatile LAS unsigned* st; };
__device__ __forceinline__ XcdBarrier xcd_barrier_post(unsigned* bar, volatile LAS unsigned* st) {
    XcdBarrier b; b.bar = bar; b.x = xb_xcc_id(); b.st = st;
    if (threadIdx.x == 0) (void)xb_add(&bar[XB_XCNT(b.x)], 1u);
    return b;
}
__device__ __forceinline__ void xcd_barrier_complete(unsigned* bar, unsigned x, unsigned& nloc, unsigned& nx) {
    const unsigned G = gridDim.x * gridDim.y * gridDim.z;
    unsigned sum, cnt, mine, sp = 0u;
    for (;;) {
        sum = 0u; cnt = 0u; mine = 0u;
#pragma unroll
        for (unsigned j = 0; j < 16; ++j) { const unsigned c = xb_ld(&bar[XB_XCNT(j)]); sum += c; cnt += (c > 0u) ? 1u : 0u; mine = (j == x) ? c : mine; }
        if (sum == G) break;
        __builtin_amdgcn_s_sleep(1);
        if ((++sp & 255u) == 0u) { if (xb_ld(&bar[XB_TMO])) break; if (sp > XB_SPIN_CAP) { atomicAdd(&bar[XB_TMO], 1u); break; } }
    }
    nloc = mine > 0u ? mine : 1u; nx = cnt > 0u ? cnt : 1u;
}
__device__ __forceinline__ void xcd_barrier(const XcdBarrier& b) {
    asm volatile("s_waitcnt vmcnt(0)" ::: "memory");
    __syncthreads();
    if (threadIdx.x == 0) {
        unsigned* bar = b.bar;
        __builtin_amdgcn_s_waitcnt(0);
        unsigned nloc = b.st[0], nx = b.st[1];
        if (nloc == 0u) { xcd_barrier_complete(bar, b.x, nloc, nx); b.st[0] = nloc; b.st[1] = nx; }
        const unsigned old = xb_add(&bar[XB_XSUB(b.x)], 1u);
        const unsigned gen = old / nloc;
        if (old + 1u == (gen + 1u) * nloc) {
            __builtin_amdgcn_fence(__ATOMIC_RELEASE, "agent");
            asm volatile("s_waitcnt vmcnt(0)" ::: "memory");
            const unsigned og = xb_add(&bar[XB_TOP], 1u);
            const unsigned tg = og / nx;
            if (og + 1u == (tg + 1u) * nx) xb_add(&bar[XB_TOPGEN], 1u);
            else XB_SPIN(xb_ld(&bar[XB_TOPGEN]) == tg, bar);
            __builtin_amdgcn_fence(__ATOMIC_ACQUIRE, "agent");
            xb_add(&bar[XB_XGEN(b.x)], 1u);
            asm volatile("s_waitcnt vmcnt(0)" ::: "memory");
        } else {
            XB_SPIN(xb_ld(&bar[XB_XGEN(b.x)]) == gen, bar);
            __builtin_amdgcn_fence(__ATOMIC_ACQUIRE, "agent");
            asm volatile("s_waitcnt vmcnt(0)" ::: "memory");
        }
    }
    __syncthreads();
}

struct Frame {
    LAS unsigned char* lds;
    int tid, lane, wave, blk, G;
    const float* in[21];
    float* out; unsigned char* ws;
};
enum { I_X = 0, I_C, I_N1G, I_WADA, I_BADA, I_WIN, I_CONVW, I_SBQG, I_SBKG, I_FXQG, I_FXKG, I_FXFB, I_ONG, I_WOUT, I_N2G, I_RW, I_RB, I_W1, I_B1, I_W2, I_B2 };

template <int MAP, bool WIDE, bool OUT8 = false>
__device__ __forceinline__ void p0_transpose_item(const float* W, int ldw, bf16* WT, LAS float* scr, int k0, int n0, int lane) {
    if (WIDE) {
        f32x4 t[8];
#pragma unroll
        for (int i = 0; i < 8; ++i) t[i] = __builtin_nontemporal_load((const f32x4*)(W + (size_t)(k0 + 8 * i + (lane >> 3)) * ldw + n0 + 4 * (lane & 7)));
#pragma unroll
        for (int i = 0; i < 8; ++i) { LAS float* d = scr + (8 * i + (lane >> 3)) * 33 + 4 * (lane & 7); d[0] = t[i].x; d[1] = t[i].y; d[2] = t[i].z; d[3] = t[i].w; }
    } else {
#pragma unroll 8
        for (int i = 0; i < 32; ++i) { const int kk = 2 * i + (lane >> 5); scr[kk * 33 + (lane & 31)] = W[(size_t)(k0 + kk) * ldw + n0 + (lane & 31)]; }
    }
    asm volatile("s_waitcnt lgkmcnt(0)" ::: "memory");
    const int c = lane & 7;
#pragma unroll
    for (int j = 0; j < 4; ++j) { const int n = (lane >> 3) + 8 * j; const LAS float* s = scr + (8 * c) * 33 + n;
        v4u o; o.x = pk2(s[0 * 33], s[1 * 33]); o.y = pk2(s[2 * 33], s[3 * 33]); o.z = pk2(s[4 * 33], s[5 * 33]); o.w = pk2(s[6 * 33], s[7 * 33]);
        const int cn = n0 + n; int row = cn;
        if (MAP == 1) { const int jj = cn >> 1, t = cn & 1; row = 256 * (jj >> 7) + 128 * t + (jj & 127); }
        if (OUT8) { v2u o8; o8.x = pg8::pk4_fp8(32.0f * s[0 * 33], 32.0f * s[1 * 33], 32.0f * s[2 * 33], 32.0f * s[3 * 33]); o8.y = pg8::pk4_fp8(32.0f * s[4 * 33], 32.0f * s[5 * 33], 32.0f * s[6 * 33], 32.0f * s[7 * 33]);
            *(v2u*)((unsigned char*)WT + (size_t)row * 1024 + k0 + 8 * c) = o8; }
        else *(v4u*)(WT + (size_t)row * 1024 + k0 + 8 * c) = o; }
    asm volatile("s_waitcnt lgkmcnt(0)" ::: "memory");
}
__device__ __forceinline__ void p0_prologue(Frame& F) {
    LAS float* scr = (LAS float*)(F.lds + F.wave * 16384);
    const int gw = F.blk * 8 + F.wave, NGW = F.G * 8;
    for (int it = gw; it < NLAYER * 4 * 24; it += NGW) {
        const int l = it / 96, ks = (it / 24) & 3, nc = it % 24;
        const float* W = F.in[I_WADA] + (size_t)l * DM * 6144 + nc * 256 + F.lane * 4;
        const float* c = F.in[I_C];
        f32x4 acc[NB];
#pragma unroll
        for (int b = 0; b < NB; ++b) acc[b] = (f32x4){0.f, 0.f, 0.f, 0.f};
#pragma unroll 4
        for (int k = ks * 256; k < ks * 256 + 256; ++k) {
            const f32x4 w = *(const f32x4*)(W + (size_t)k * 6144);
#pragma unroll
            for (int b = 0; b < NB; ++b) { const float cv = c[b * DM + k]; const float s = cv / (1.0f + __expf(-cv)); acc[b] += w * s; }
        }
        float* dst = (float*)(F.ws + WS_MODP) + ((size_t)(l * 4 + ks) * NB) * 6144 + nc * 256 + F.lane * 4;
#pragma unroll
        for (int b = 0; b < NB; ++b) *(f32x4*)(dst + (size_t)b * 6144) = acc[b];
    }
    constexpr int I_IN = 16 * 96, I_OUT = 16 * 32, I_1 = 16 * 64, I_2 = 16 * 32;
    constexpr int N_IN = NLAYER * I_IN, N_OUT = NLAYER * I_OUT, N_1 = NLAYER * NEXP * I_1, N_2 = NLAYER * NEXP * I_2;
    for (int it = gw; it < N_IN + N_OUT + N_1 + N_2; it += NGW) {
        int r = it;
        if (r < N_IN) { const int l = r / I_IN, q = r % I_IN, kb = q / 96, nb = q % 96;
            p0_transpose_item<0, false>(F.in[I_WIN] + (size_t)l * DM * D_IN, D_IN, (bf16*)(F.ws + WS_WIN) + (size_t)l * NPROJ * DM, scr, 64 * kb, 32 * nb, F.lane); continue; }
        r -= N_IN;
        if (r < N_OUT) { const int l = r / I_OUT, q = r % I_OUT, kb = q / 32, nb = q % 32;
            p0_transpose_item<0, true>(F.in[I_WOUT] + (size_t)l * DM * DM, DM, (bf16*)(F.ws + WS_WOUT) + (size_t)l * DM * DM, scr, 64 * kb, 32 * nb, F.lane); continue; }
        r -= N_OUT;
        if (r < N_1) { const int le = r / I_1, q = r % I_1, kb = q / 64, nb = q % 64;
            p0_transpose_item<1, true, true>(F.in[I_W1] + (size_t)le * DM * 2048, 2048, (bf16*)(F.ws + WS_W1 + (size_t)le * 2048 * DM), scr, 64 * kb, 32 * nb, F.lane); continue; }
        r -= N_1;
        { const int le = r / I_2, q = r % I_2, kb = q / 32, nb = q % 32;
            p0_transpose_item<0, true, true>(F.in[I_W2] + (size_t)le * DM * DM, DM, (bf16*)(F.ws + WS_W2 + (size_t)le * DM * DM), scr, 64 * kb, 32 * nb, F.lane); }
    }
}

__device__ __forceinline__ f32x4 mod4(const Frame& F, int l, int b, int which, int c) {
    const int n = which * DM + c;
    f32x4 s = *(const f32x4*)(F.in[I_BADA] + (size_t)l * 6144 + n);
    const float* p = (const float*)(F.ws + WS_MODP) + ((size_t)(l * 4) * NB + b) * 6144 + n;
#pragma unroll
    for (int ks = 0; ks < 4; ++ks) s += *(const f32x4*)(p + (size_t)ks * NB * 6144);
    return s;
}

constexpr size_t WS_GSUM = WS_FCUM + 800 * 1024;
static_assert(WS_GSUM + 16384 <= WS_WIN, "ws map");
template <bool COMBINE, bool NORM>
__device__ __forceinline__ void row_phase(Frame& F, int l, const float* xsrc, float* xdst) {
    const float* topw = (const float*)(F.ws + WS_TOPW); const int* tokslot = (const int*)(F.ws + WS_TOKSLOT); const bf16* Y = (const bf16*)(F.ws + WS_Y);
    bf16* H = (bf16*)(F.ws + WS_H); float* logf = (float*)(F.ws + WS_LOGF); float* gsum = (float*)(F.ws + WS_GSUM);
    LAS f32x4* wl4 = (LAS f32x4*)F.lds; LAS f32x2* wl2 = (LAS f32x2*)(F.lds + 16384); LAS float* part = (LAS float*)(F.lds + 16384 + 8192);
    if (NORM) { for (int k = F.tid; k < DM; k += 512) { const float* wp = F.in[I_WIN] + (size_t)l * DM * D_IN + (size_t)k * D_IN + NPROJ; const int idx = (4 * (k >> 8) + (k & 3)) * 64 + ((k >> 2) & 63);
            wl4[idx] = (f32x4){wp[0], wp[1], wp[2], wp[3]}; wl2[idx] = (f32x2){wp[4], wp[5]}; }
        __syncthreads(); }
    for (int chunk = F.blk; chunk < NTOK / 128; chunk += F.G) {
        const int b = chunk / (SEQ / 128);
        LAS f32x4* mv = (LAS f32x4*)(F.lds + 32768);
        __syncthreads();
        if (F.wave == 0) {
#pragma unroll
            for (int j = 0; j < 4; ++j) { const int c = 256 * j + 4 * F.lane;
                if (COMBINE) mv[(0 * 4 + j) * 64 + F.lane] = mod4(F, l - 1, b, 5, c);
                if (NORM) { const f32x4 g = *(const f32x4*)(F.in[I_N1G] + (size_t)l * DM + c); mv[(1 * 4 + j) * 64 + F.lane] = g * (mod4(F, l, b, 1, c) + 1.0f); mv[(2 * 4 + j) * 64 + F.lane] = mod4(F, l, b, 0, c); } } }
        __syncthreads();
        float lacc = 0.f;
#pragma unroll 1
        for (int rr = 0; rr < 16; rr += 2) {
            const int row = chunk * 128 + F.wave * 16 + rr;
            f32x4 v[2][4];
#pragma unroll
            for (int u = 0; u < 2; ++u)
#pragma unroll
                for (int j = 0; j < 4; ++j) v[u][j] = *(const f32x4*)(xsrc + (size_t)(row + u) * DM + 256 * j + 4 * F.lane);
            int mofs = F.lane; asm volatile("" : "+v"(mofs));
            if (COMBINE) {
#pragma unroll
                for (int u = 0; u < 2; ++u) {
                    f32x4 s[4];
#pragma unroll
                    for (int j = 0; j < 4; ++j) s[j] = (f32x4){0.f, 0.f, 0.f, 0.f};
#pragma unroll
                    for (int k = 0; k < TOPK; ++k) { const float w = topw[(row + u) * 4 + k]; const int slot = tokslot[(row + u) * 4 + k];
#pragma unroll
                        for (int j = 0; j < 4; ++j) { const v2u yv = *(const v2u*)(Y + (size_t)slot * DM + 256 * j + 4 * F.lane);
                            s[j] += (f32x4){bflo(yv.x), bfhi(yv.x), bflo(yv.y), bfhi(yv.y)} * w; } }
#pragma unroll
                    for (int j = 0; j < 4; ++j) { v[u][j] += mv[(0 * 4 + j) * 64 + mofs] * s[j]; *(f32x4*)(xdst + (size_t)(row + u) * DM + 256 * j + 4 * F.lane) = v[u][j]; }
                }
            }
            if (NORM) {
                float ss[2];
#pragma unroll
                for (int u = 0; u < 2; ++u) { float s = 0.f;
#pragma unroll
                    for (int j = 0; j < 4; ++j) s += (v[u][j].x * v[u][j].x + v[u][j].y * v[u][j].y) + (v[u][j].z * v[u][j].z + v[u][j].w * v[u][j].w);
                    ss[u] = s; }
#pragma unroll
                for (int o = 1; o < 64; o <<= 1) { ss[0] += __shfl_xor(ss[0], o); ss[1] += __shfl_xor(ss[1], o); }
                float fl[2][6];
                int lofs = F.lane; asm volatile("" : "+v"(lofs));
#pragma unroll
                for (int u = 0; u < 2; ++u) { const float rstd = 1.0f / sqrtf(ss[u] * (1.0f / DM) + EPS);
#pragma unroll
                    for (int q = 0; q < 6; ++q) fl[u][q] = 0.f;
#pragma unroll
                    for (int j = 0; j < 4; ++j) { const f32x4 hv = v[u][j] * rstd * mv[(1 * 4 + j) * 64 + mofs] + mv[(2 * 4 + j) * 64 + mofs];
                        v2u o; o.x = pk2(hv.x, hv.y); o.y = pk2(hv.z, hv.w); *(v2u*)(H + (size_t)(row + u) * DM + 256 * j + 4 * F.lane) = o;
#pragma unroll
                        for (int i = 0; i < 4; ++i) { const f32x4 wa = wl4[(4 * j + i) * 64 + lofs]; const f32x2 wb = wl2[(4 * j + i) * 64 + lofs]; const float hx = hv[i];
                            fl[u][0] += hx * wa.x; fl[u][1] += hx * wa.y; fl[u][2] += hx * wa.z; fl[u][3] += hx * wa.w; fl[u][4] += hx * wb.x; fl[u][5] += hx * wb.y; } } }
#pragma unroll
                for (int o = 1; o < 64; o <<= 1)
#pragma unroll
                    for (int u = 0; u < 2; ++u)
#pragma unroll
                        for (int q = 0; q < 6; ++q) fl[u][q] += __shfl_xor(fl[u][q], o);
                if (F.lane < 6) {
#pragma unroll
                    for (int u = 0; u < 2; ++u) { float z = fl[u][0];
#pragma unroll
                        for (int q = 1; q < 6; ++q) z = (F.lane == q) ? fl[u][q] : z;
                        z += F.in[I_FXFB][l * 6 + F.lane];
                        const float lg = fminf(z, 0.f) - __logf(1.0f + __expf(-fabsf(z)));
                        logf[(size_t)(row + u) * 6 + F.lane] = lg; lacc += lg; } }
            }
        }
        if (NORM) {
            if (F.lane < 6) part[F.wave * 8 + F.lane] = lacc;
            __syncthreads();
            if (F.tid < 12) { const int g = F.tid / 6, h = F.tid % 6; gsum[(size_t)(chunk * 2 + g) * 6 + h] = (part[(4 * g) * 8 + h] + part[(4 * g + 1) * 8 + h]) + (part[(4 * g + 2) * 8 + h] + part[(4 * g + 3) * 8 + h]); }
            __syncthreads();
        }
    }
    __syncthreads();
}
__device__ __forceinline__ void p3_postproj(Frame& F, int l) {
    bf16* proj = (bf16*)(F.ws + WS_PROJ); bf16* ymix = (bf16*)(F.ws + WS_YMIX);
    const float* ong = F.in[I_ONG] + (size_t)l * DM;
    const int c4 = 4 * F.lane;
    f32x4 cw[3];
#pragma unroll
    for (int w = 0; w < 3; ++w) cw[w] = *(const f32x4*)(F.in[I_CONVW] + (size_t)(l * 3 + w) * 256 + c4);
    const f32x4 cg = *(const f32x4*)(ong + c4);
    const int e0 = 8 * (F.lane & 7);
    float gq[3][8]; int colv[3];
#pragma unroll
    for (int i = 0; i < 3; ++i) { const int vi = 8 * i + (F.lane >> 3); const int ty = vi / 6;
        colv[i] = (vi < 12 ? COL_SQ + 64 * vi : COL_FQ + 64 * (vi - 12)) + e0;
        const float* gp = (ty == 0 ? F.in[I_SBQG] : ty == 1 ? F.in[I_SBKG] : ty == 2 ? F.in[I_FXQG] : F.in[I_FXKG]) + (size_t)l * 64 + e0; const float sc = (ty == 0 || ty == 2) ? QSCALE : 1.0f;
#pragma unroll
        for (int q = 0; q < 8; ++q) gq[i][q] = gp[q] * sc; }
    LAS unsigned char* scr = F.lds + F.wave * (64 * 144);
    for (int tile = F.blk; tile < NTOK / 64; tile += F.G) {
        const int b = tile / (SEQ / 64), s0 = (tile % (SEQ / 64)) * 64; const size_t row0 = (size_t)b * SEQ + s0;
        {
            const int sw0 = s0 + F.wave * 8;
            f32x4 vm2 = (f32x4){0.f, 0.f, 0.f, 0.f}, vm1 = vm2;
            if (sw0 >= 2) {
                const bf16* p2 = proj + ((size_t)b * SEQ + sw0 - 2) * NPROJ; const bf16* p1 = p2 + NPROJ;
                const v2u c2 = *(const v2u*)(p2 + COL_CC + c4), u2 = *(const v2u*)(p2 + COL_CU + c4), c1 = *(const v2u*)(p1 + COL_CC + c4), u1 = *(const v2u*)(p1 + COL_CU + c4);
                vm2 = (f32x4){bflo(c2.x) * bflo(u2.x), bfhi(c2.x) * bfhi(u2.x), bflo(c2.y) * bflo(u2.y), bfhi(c2.y) * bfhi(u2.y)};
                vm1 = (f32x4){bflo(c1.x) * bflo(u1.x), bfhi(c1.x) * bfhi(u1.x), bflo(c1.y) * bflo(u1.y), bfhi(c1.y) * bfhi(u1.y)}; }
#pragma unroll 1
            for (int tt = 0; tt < 8; tt += 2) {
                bf16* pr[2]; v2u cb[2], cc[2], cu[2]; v4u xq[2][3];
#pragma unroll
                for (int u = 0; u < 2; ++u) { pr[u] = proj + ((size_t)b * SEQ + sw0 + tt + u) * NPROJ;
                    cb[u] = *(const v2u*)(pr[u] + COL_CB + c4); cc[u] = *(const v2u*)(pr[u] + COL_CC + c4); cu[u] = *(const v2u*)(pr[u] + COL_CU + c4);
#pragma unroll
                    for (int i = 0; i < 3; ++i) xq[u][i] = *(const v4u*)(pr[u] + colv[i]); }
                f32x4 y[2]; float ss[2], q2[2][3];
#pragma unroll
                for (int u = 0; u < 2; ++u) {
                    const f32x4 v0 = (f32x4){bflo(cc[u].x) * bflo(cu[u].x), bfhi(cc[u].x) * bfhi(cu[u].x), bflo(cc[u].y) * bflo(cu[u].y), bfhi(cc[u].y) * bfhi(cu[u].y)};
                    y[u] = cw[0] * vm2 + cw[1] * vm1 + cw[2] * v0; vm2 = vm1; vm1 = v0;
                    y[u] = y[u] * (f32x4){bflo(cb[u].x), bfhi(cb[u].x), bflo(cb[u].y), bfhi(cb[u].y)};
                    ss[u] = (y[u].x * y[u].x + y[u].y * y[u].y) + (y[u].z * y[u].z + y[u].w * y[u].w);
#pragma unroll
                    for (int i = 0; i < 3; ++i) { const v4u x = xq[u][i]; const float f[8] = {bflo(x.x), bfhi(x.x), bflo(x.y), bfhi(x.y), bflo(x.z), bfhi(x.z), bflo(x.w), bfhi(x.w)};
                        float a = 0.f;
#pragma unroll
                        for (int k = 0; k < 8; ++k) a += f[k] * f[k];
                        q2[u][i] = a; } }
#pragma unroll
                for (int o = 1; o < 16; o <<= 1)
#pragma unroll
                    for (int u = 0; u < 2; ++u) { ss[u] += __shfl_xor(ss[u], o);
                        if (o < 8) {
#pragma unroll
                            for (int i = 0; i < 3; ++i) q2[u][i] += __shfl_xor(q2[u][i], o); } }
#pragma unroll
                for (int u = 0; u < 2; ++u) {
                    const float rinv = 1.0f / sqrtf(ss[u] * (1.0f / 64.0f) + EPS);
                    const f32x4 yo = y[u] * rinv * cg;
                    v2u o; o.x = pk2(yo.x, yo.y); o.y = pk2(yo.z, yo.w); *(v2u*)(ymix + ((size_t)b * SEQ + sw0 + tt + u) * DM + c4) = o;
#pragma unroll
                    for (int i = 0; i < 3; ++i) { const v4u x = xq[u][i]; const float f[8] = {bflo(x.x), bfhi(x.x), bflo(x.y), bfhi(x.y), bflo(x.z), bfhi(x.z), bflo(x.w), bfhi(x.w)};
                        const float ri = 1.0f / sqrtf(q2[u][i] * (1.0f / 64.0f) + EPS);
                        v4u w; w.x = pk2(f[0] * ri * gq[i][0], f[1] * ri * gq[i][1]); w.y = pk2(f[2] * ri * gq[i][2], f[3] * ri * gq[i][3]);
                        w.z = pk2(f[4] * ri * gq[i][4], f[5] * ri * gq[i][5]); w.w = pk2(f[6] * ri * gq[i][6], f[7] * ri * gq[i][7]);
                        *(v4u*)(pr[u] + colv[i]) = w; } }
            }
        }
        for (int t = F.wave; t < 12; t += 8) {
            const int kind = t / 6, h = t % 6; const int col = (kind ? COL_FV : COL_SV) + 64 * h;
            const bf16* src = proj + (row0 + F.lane) * NPROJ + col;
#pragma unroll
            for (int pc = 0; pc < 8; ++pc) { const v4u x = *(const v4u*)(src + 8 * pc);
                const unsigned xs[4] = {x.x, x.y, x.z, x.w};
#pragma unroll
                for (int q = 0; q < 4; ++q) { *(LAS unsigned short*)(scr + (8 * pc + 2 * q) * 144 + 2 * F.lane) = (unsigned short)(xs[q] & 0xffffu);
                                              *(LAS unsigned short*)(scr + (8 * pc + 2 * q + 1) * 144 + 2 * F.lane) = (unsigned short)(xs[q] >> 16); } }
            asm volatile("s_waitcnt lgkmcnt(0)" ::: "memory");
            bf16* dst = (bf16*)(F.ws + WS_VT) + (size_t)kind * (48 * 64 * SEQ) + ((size_t)(b * 6 + h) * 64 + F.lane) * SEQ + s0;
#pragma unroll
            for (int pc = 0; pc < 8; ++pc) *(v4u*)(dst + 8 * pc) = *(const LAS v4u*)(scr + F.lane * 144 + 16 * pc);
            asm volatile("s_waitcnt lgkmcnt(0)" ::: "memory");
        }
        if (F.wave == 7) { const int gt = tile % (SEQ / 64); const float* gs = (const float*)(F.ws + WS_GSUM) + (size_t)(b * (SEQ / 64)) * 6; const float* lf = (const float*)(F.ws + WS_LOGF) + (row0 + F.lane) * 6;
            float* fo = (float*)(F.ws + WS_FCUM) + (size_t)(b * 6) * SEQ + s0 + F.lane;
#pragma unroll
            for (int h = 0; h < 6; ++h) { float base = (F.lane < gt) ? gs[F.lane * 6 + h] : 0.f; base = wave_sum(base);
                float inc = lf[h];
#pragma unroll
                for (int o = 1; o < 64; o <<= 1) { const float t = __shfl_up(inc, o); if (F.lane >= o) inc += t; }
                fo[(size_t)h * SEQ] = (base + inc) * LOG2E; } }
    }
}

__device__ __forceinline__ void p4_attention(Frame& F, int l) {
    att::Tensors Ts, Tf;
    Ts.proj = (const bf16*)(F.ws + WS_PROJ); Ts.vt = (const bf16*)(F.ws + WS_VT); Ts.fcum = (const float*)(F.ws + WS_FCUM); Ts.ymix = (bf16*)(F.ws + WS_YMIX); Ts.ong = F.in[I_ONG] + (size_t)l * DM;
    Ts.colq = COL_SQ; Ts.colk = COL_SK; Ts.coly = 256;
    Tf = Ts; Tf.vt = Ts.vt + (size_t)48 * 64 * SEQ; Tf.colq = COL_FQ; Tf.colk = COL_FK; Tf.coly = 640;
    const int NU = 48 * 16;
    for (int i = 0; i * F.G < NU; ++i) {
        const int L = (i & 1) ? (i + 1) * F.G - 1 - F.blk : i * F.G + F.blk;
        if (L >= NU) continue;
        const int qb = 15 - L / 48, bh = L % 48;
        att::unit<0>(Ts, bh / 6, bh % 6, qb, F.lds);
    }
    for (int i = 0; i * F.G < NU; ++i) {
        const int L = (i & 1) ? (i + 1) * F.G - 1 - F.blk : i * F.G + F.blk;
        if (L >= NU) continue;
        const int qb = 15 - L / 48, bh = L % 48;
        att::unit<1>(Tf, bh / 6, bh % 6, qb, F.lds);
    }
}

__device__ __forceinline__ void top4of8(const float (&v)[8], const int (&ix)[8], float (&tv)[4], int (&ti)[4]) {
    float w[8];
#pragma unroll
    for (int j = 0; j < 8; ++j) w[j] = v[j];
#pragma unroll
    for (int k = 0; k < 4; ++k) { float bv = w[0]; int bi = ix[0];
#pragma unroll
        for (int j = 1; j < 8; ++j) { const bool t = (w[j] > bv) || (w[j] == bv && ix[j] < bi); bv = t ? w[j] : bv; bi = t ? ix[j] : bi; }
        tv[k] = bv; ti[k] = bi;
#pragma unroll
        for (int j = 0; j < 8; ++j) w[j] = (ix[j] == bi) ? -INFINITY : w[j]; }
}
__device__ __forceinline__ void p6_norm_router(Frame& F, int l, const float* x1) {
    bf16* H = (bf16*)(F.ws + WS_H); unsigned char* H8 = F.ws + WS_H8; float* topw = (float*)(F.ws + WS_TOPW); int* route = (int*)(F.ws + WS_ROUTE); int* hist = (int*)(F.ws + WS_HIST);
    const float* rw = F.in[I_RW] + (size_t)l * DM * NEXP; const float* rb = F.in[I_RB] + (size_t)l * NEXP;
    constexpr int RWP = 2064;
    LAS unsigned char* rwt = F.lds;
    LAS int* cnt = (LAS int*)(F.lds + MISC_OFF + 256);
    for (int idx = F.tid; idx < DM * NEXP; idx += 512) { const int k = idx >> 5, ex = idx & 31; *(LAS unsigned short*)(rwt + ex * RWP + k * 2) = (unsigned short)f2bf(rw[idx]); }
    __syncthreads();
    const int fr = F.lane & 15, fq = F.lane >> 4;
    float rbv[8]; int eix[8];
#pragma unroll
    for (int i = 0; i < 4; ++i) { eix[i] = 4 * fq + i; eix[4 + i] = 16 + 4 * fq + i; rbv[i] = rb[4 * fq + i]; rbv[4 + i] = rb[16 + 4 * fq + i]; }
    for (int chunk = F.blk; chunk < NTOK / 128; chunk += F.G) {
        const int b = chunk / (SEQ / 128);
        if (F.tid < 32) cnt[F.tid] = 0;
        __syncthreads();
        f32x4 A[4], Bv[4];
#pragma unroll
        for (int j = 0; j < 4; ++j) { const int c = 256 * j + 4 * F.lane; const f32x4 g = *(const f32x4*)(F.in[I_N2G] + (size_t)l * DM + c); A[j] = g * (mod4(F, l, b, 4, c) + 1.0f); Bv[j] = mod4(F, l, b, 3, c); }
        const int row0 = chunk * 128 + F.wave * 16;
#pragma unroll 1
        for (int rr = 0; rr < 16; rr += 2) {
            f32x4 v[2][4]; float ss[2];
#pragma unroll
            for (int u = 0; u < 2; ++u)
#pragma unroll
                for (int j = 0; j < 4; ++j) v[u][j] = *(const f32x4*)(x1 + (size_t)(row0 + rr + u) * DM + 256 * j + 4 * F.lane);
#pragma unroll
            for (int u = 0; u < 2; ++u) { float s = 0.f;
#pragma unroll
                for (int j = 0; j < 4; ++j) s += (v[u][j].x * v[u][j].x + v[u][j].y * v[u][j].y) + (v[u][j].z * v[u][j].z + v[u][j].w * v[u][j].w);
                ss[u] = s; }
#pragma unroll
            for (int o = 1; o < 64; o <<= 1) { ss[0] += __shfl_xor(ss[0], o); ss[1] += __shfl_xor(ss[1], o); }
#pragma unroll
            for (int u = 0; u < 2; ++u) { const float rstd = 1.0f / sqrtf(ss[u] * (1.0f / DM) + EPS);
#pragma unroll
                for (int j = 0; j < 4; ++j) { const f32x4 hv = v[u][j] * rstd * A[j] + Bv[j];
                    v2u o; o.x = pk2(hv.x, hv.y); o.y = pk2(hv.z, hv.w); *(v2u*)(H + (size_t)(row0 + rr + u) * DM + 256 * j + 4 * F.lane) = o;
                    *(unsigned*)(H8 + (size_t)(row0 + rr + u) * DM + 256 * j + 4 * F.lane) = pg8::pk4_fp8(hv.x, hv.y, hv.z, hv.w); } }
        }
        asm volatile("s_waitcnt vmcnt(0)" ::: "memory");
        f32x4 acc0 = (f32x4){0.f, 0.f, 0.f, 0.f}, acc1 = (f32x4){0.f, 0.f, 0.f, 0.f};
        { const bf16* hp = H + (size_t)(row0 + fr) * DM + 8 * fq; const LAS unsigned char* wp = rwt + fr * RWP + 16 * fq;
#pragma unroll 8
          for (int s = 0; s < 32; ++s) { const v4u hb = __builtin_nontemporal_load((const v4u*)(hp + 32 * s));
              const bf16x8 a0 = *(const LAS bf16x8*)(wp + 64 * s), a1 = *(const LAS bf16x8*)(wp + 16 * RWP + 64 * s);
              acc0 = __builtin_amdgcn_mfma_f32_16x16x32_bf16(a0, __builtin_bit_cast(bf16x8, hb), acc0, 0, 0, 0);
              acc1 = __builtin_amdgcn_mfma_f32_16x16x32_bf16(a1, __builtin_bit_cast(bf16x8, hb), acc1, 0, 0, 0); } }
        float cv[8], tv[4], ov[8]; int ti[4], oi[8];
#pragma unroll
        for (int i = 0; i < 4; ++i) { cv[i] = acc0[i] + rbv[i]; cv[4 + i] = acc1[i] + rbv[4 + i]; }
        top4of8(cv, eix, tv, ti);
#pragma unroll
        for (int st = 16; st <= 32; st <<= 1) {
#pragma unroll
            for (int k = 0; k < 4; ++k) { ov[k] = tv[k]; oi[k] = ti[k]; ov[4 + k] = __shfl_xor(tv[k], st); oi[4 + k] = __shfl_xor(ti[k], st); }
            top4of8(ov, oi, tv, ti); }
        const float e1 = __expf(tv[1] - tv[0]), e2 = __expf(tv[2] - tv[0]), e3 = __expf(tv[3] - tv[0]); const float inv = 1.0f / (1.0f + e1 + e2 + e3);
        { const int row = row0 + fr, k = fq;
          const float w = (k == 0 ? 1.0f : k == 1 ? e1 : k == 2 ? e2 : e3) * inv; const int ex = (k == 0 ? ti[0] : k == 1 ? ti[1] : k == 2 ? ti[2] : ti[3]);
          const int pos = __hip_atomic_fetch_add(cnt + ex, 1, __ATOMIC_RELAXED, __HIP_MEMORY_SCOPE_WORKGROUP);
          topw[row * 4 + k] = w; route[row * 4 + k] = ex + 32 * pos; }
        __syncthreads();
        if (F.tid < 32) hist[chunk * 32 + F.tid] = cnt[F.tid];
        __syncthreads();
    }
}

__device__ __forceinline__ void p7_scatter(Frame& F) {
    const int* hist = (const int*)(F.ws + WS_HIST); const int* route = (const int*)(F.ws + WS_ROUTE);
    int* tokslot = (int*)(F.ws + WS_TOKSLOT); int* slottok = (int*)(F.ws + WS_SLOTTOK); int* moetab = (int*)(F.ws + WS_MOETAB);
    LAS int* pre = (LAS int*)F.lds;
    LAS int* base = (LAS int*)(F.lds + 32768);
    for (int i = F.tid; i < 256 * 32; i += 512) pre[i] = hist[i];
    __syncthreads();
    if (F.tid < 32) { int run = 0;
        for (int c = 0; c < 256; ++c) { const int v = pre[c * 32 + F.tid]; pre[c * 32 + F.tid] = run; run += v; }
        base[64 + F.tid] = run; }
    __syncthreads();
    if (F.tid == 0) { int run = 0; for (int ex = 0; ex < NEXP; ++ex) { base[ex] = run; run += (base[64 + ex] + 255) & ~255; } base[NEXP] = run; }
    __syncthreads();
    if (F.blk == 0 && F.tid <= NEXP) moetab[F.tid] = base[F.tid] >> 8;
    for (int chunk = F.blk; chunk < NTOK / 128; chunk += F.G) {
        const int t = chunk * 128 + (F.tid >> 2), k = F.tid & 3; const int rt = route[t * 4 + k]; const int ex = rt & 31, pos = rt >> 5;
        const int slot = base[ex] + pre[chunk * 32 + ex] + pos;
        tokslot[t * 4 + k] = slot; slottok[slot] = t;
    }
    for (int ex = F.blk; ex < NEXP; ex += F.G) { const int lo = base[ex] + base[64 + ex], hi = base[ex + 1]; for (int s = lo + F.tid; s < hi; s += 512) slottok[s] = 0; }
    __syncthreads();
}

struct Args { const float* in[21]; float* out; unsigned char* ws; int ph_lo, ph_hi; };
__device__ __forceinline__ void launder(Frame& F) { int t = threadIdx.x; asm volatile("" : "+v"(t)); F.tid = t; F.lane = t & 63; F.wave = __builtin_amdgcn_readfirstlane(t >> 6);
    const __attribute__((address_space(4))) Args* ap = (const __attribute__((address_space(4))) Args*)__builtin_amdgcn_kernarg_segment_ptr(); asm volatile("" : "+s"(ap));
#pragma unroll
    for (int i = 0; i < 21; ++i) F.in[i] = ap->in[i];
    F.out = ap->out; F.ws = ap->ws; }
constexpr int N_PHASES = 1 + 9 * NLAYER + 1;

#define PHASE_FN __device__ __forceinline__
__device__ __forceinline__ void make_frame(Frame& F, LAS unsigned char* lds) { F.lds = lds; F.blk = blockIdx.x; F.G = gridDim.x; launder(F); }
PHASE_FN void ph_prologue(LAS unsigned char* lds) { Frame F; make_frame(F, lds); p0_prologue(F); }
PHASE_FN void ph_norm1(LAS unsigned char* lds, int l) { Frame F; make_frame(F, lds);
    if (l == 0) row_phase<false, true>(F, 0, F.in[I_X], nullptr); else row_phase<true, true>(F, l, (const float*)(F.ws + WS_XA), (float*)(F.ws + WS_XB)); }
PHASE_FN void ph_proj(LAS unsigned char* lds, int l) { Frame F; make_frame(F, lds);
    pg8::Gemm g{(const bf16*)(F.ws + WS_H), (const bf16*)(F.ws + WS_WIN) + (size_t)l * NPROJ * DM, nullptr, DM};
    pg8::StaticOrder S; S.init(NTOK, NPROJ, F.G, F.blk);
    pg8::EpiProj E{(bf16*)(F.ws + WS_PROJ), NPROJ};
    pg8::gemm_phase<pg8::EpiProj, pg8::StaticOrder, false>(F.lds, g, S, E); }
PHASE_FN void ph_postproj(LAS unsigned char* lds, int l) { Frame F; make_frame(F, lds); p3_postproj(F, l); }
PHASE_FN void ph_attn(LAS unsigned char* lds, int l) { Frame F; make_frame(F, lds); p4_attention(F, l); }
PHASE_FN void ph_out(LAS unsigned char* lds, int l) { Frame F; make_frame(F, lds);
    const float* xin = (l == 0) ? F.in[I_X] : (const float*)(F.ws + WS_XB);
    pg8::Gemm g{(const bf16*)(F.ws + WS_YMIX), (const bf16*)(F.ws + WS_WOUT) + (size_t)l * DM * DM, nullptr, DM};
    pg8::StaticOrder S; S.init(NTOK, DM, F.G, F.blk);
    pg8::EpiResGate E{xin, (float*)(F.ws + WS_XA), F.in[I_BADA] + (size_t)l * 6144 + 2 * DM, (const float*)(F.ws + WS_MODP) + (size_t)l * 4 * NB * 6144 + 2 * DM};
    pg8::gemm_phase<pg8::EpiResGate, pg8::StaticOrder, false>(F.lds, g, S, E); }
PHASE_FN void ph_router(LAS unsigned char* lds, int l) { Frame F; make_frame(F, lds); p6_norm_router(F, l, (const float*)(F.ws + WS_XA)); }
PHASE_FN void ph_scatter(LAS unsigned char* lds) { Frame F; make_frame(F, lds); p7_scatter(F); }
__device__ __forceinline__ LAS int* moe_table(Frame& F) { LAS int* tb = (LAS int*)(F.lds + MISC_OFF + 64);
    if (F.tid <= NEXP) tb[F.tid] = ((const int*)(F.ws + WS_MOETAB))[F.tid];
    __syncthreads(); return tb; }
PHASE_FN void ph_moe_up(LAS unsigned char* lds, int l) { Frame F; make_frame(F, lds); LAS int* tb = moe_table(F);
    pg8::Gemm g{(const bf16*)(F.ws + WS_H8), (const bf16*)(F.ws + WS_W1 + (size_t)l * NEXP * 2048 * DM), (const int*)(F.ws + WS_SLOTTOK), DM / 2};
    pg8::MoeOrder S; S.init(tb, 8, F.G, F.blk);
    pg8::EpiSwiglu8 E{F.ws + WS_ACT, F.in[I_B1] + (size_t)l * NEXP * 2048};
    pg8::gemm_phase<pg8::EpiSwiglu8, pg8::MoeOrder, true, true>(F.lds, g, S, E); }
PHASE_FN void ph_moe_down(LAS unsigned char* lds, int l) { Frame F; make_frame(F, lds); LAS int* tb = moe_table(F);
    pg8::Gemm g{(const bf16*)(F.ws + WS_ACT), (const bf16*)(F.ws + WS_W2 + (size_t)l * NEXP * DM * DM), nullptr, DM / 2};
    pg8::MoeOrder S; S.init(tb, 4, F.G, F.blk);
    pg8::EpiY E{(bf16*)(F.ws + WS_Y), F.in[I_B2] + (size_t)l * NEXP * DM};
    pg8::gemm_phase<pg8::EpiY, pg8::MoeOrder, false, true>(F.lds, g, S, E); }
PHASE_FN void ph_final(LAS unsigned char* lds) { Frame F; make_frame(F, lds); row_phase<true, false>(F, NLAYER, (const float*)(F.ws + WS_XA), F.out); }

#ifndef REP_MASK
#define REP_MASK 0
#endif
__global__ void __launch_bounds__(512, 2) fwd_kernel(Args args) {
    extern __shared__ __attribute__((aligned(16))) unsigned char lds_raw[];
    LAS unsigned char* lds = (LAS unsigned char*)lds_raw;
    volatile LAS unsigned* MISC = (volatile LAS unsigned*)(lds + MISC_OFF);
    if (threadIdx.x < 16) MISC[threadIdx.x] = 0u;
    __syncthreads();
    const int lo = args.ph_lo, hi = args.ph_hi;
    const bool multi = (hi - lo) > 1;
    XcdBarrier bar; bar.bar = (unsigned*)(args.ws + WS_CTL) + CW_BAR; bar.x = 0; bar.st = MISC;
    if (multi) bar = xcd_barrier_post((unsigned*)(args.ws + WS_CTL) + CW_BAR, MISC);
#define IN(k) (lo <= (k) && (k) < hi)
#define SEAM(k) do { if (IN((k) + 1)) xcd_barrier(bar); } while (0)
#define REPS(j) for (int rep_ = 0; rep_ < (((REP_MASK >> (j)) & 1) ? 2 : 1); ++rep_)
    if (IN(0)) { REPS(0) { ph_prologue(lds); SEAM(0); } }
    for (int l = 0; l < NLAYER; ++l) {
        const int p = 1 + 9 * l;
        if (IN(p + 0)) { REPS(1) { ph_norm1(lds, l); SEAM(p + 0); } }
        if (IN(p + 1)) { REPS(2) { ph_proj(lds, l); SEAM(p + 1); } }
        if (IN(p + 2)) { ph_postproj(lds, l); SEAM(p + 2); }
        if (IN(p + 3)) { REPS(4) { ph_attn(lds, l); SEAM(p + 3); } }
        if (IN(p + 4)) { REPS(5) { ph_out(lds, l); SEAM(p + 4); } }
        if (IN(p + 5)) { REPS(6) { ph_router(lds, l); SEAM(p + 5); } }
        if (IN(p + 6)) { REPS(7) { ph_scatter(lds); SEAM(p + 6); } }
        if (IN(p + 7)) { REPS(8) { ph_moe_up(lds, l); SEAM(p + 7); } }
        if (IN(p + 8)) { REPS(9) { ph_moe_down(lds, l); SEAM(p + 8); } }
    }
    if (IN(N_PHASES - 1)) { REPS(10) { ph_final(lds); } }
#undef IN
#undef SEAM
#undef REPS
}

template <int KIND> __global__ void __launch_bounds__(512, 2) phase_kernel(Args args, int l) {
    extern __shared__ __attribute__((aligned(16))) unsigned char lds_raw[];
    LAS unsigned char* lds = (LAS unsigned char*)lds_raw;
    if (KIND == 0) ph_prologue(lds); if (KIND == 1) ph_norm1(lds, l); if (KIND == 2) ph_proj(lds, l); if (KIND == 3) ph_postproj(lds, l); if (KIND == 4) ph_attn(lds, l);
    if (KIND == 5) ph_out(lds, l); if (KIND == 6) ph_router(lds, l); if (KIND == 7) ph_scatter(lds); if (KIND == 8) ph_moe_up(lds, l); if (KIND == 9) ph_moe_down(lds, l); if (KIND == 10) ph_final(lds);
}
template <int KIND> static void launch_phase(const Args& a, int l, int grid, hipStream_t stream) {
    static bool attr = false;
    if (!attr) { (void)hipFuncSetAttribute((const void*)phase_kernel<KIND>, hipFuncAttributeMaxDynamicSharedMemorySize, LDS_BYTES); attr = true; }
    for (int rep = 0; rep < (((REP_MASK >> KIND) & 1) ? 2 : 1); ++rep) hipLaunchKernelGGL(phase_kernel<KIND>, dim3(grid), dim3(512), LDS_BYTES, stream, a, l);
}
#ifndef MK_SPLIT
#define MK_SPLIT 0
#endif
extern "C" void kernel_launch(void* const* d_in, const int* in_sizes, int n_in, void* d_out, int out_size, void* d_ws, size_t ws_size, hipStream_t stream) {
    static int grid = 0;
    if (grid == 0) {
        if (n_in != 21 || in_sizes[0] != NTOK * DM || out_size != NTOK * DM || ws_size < WS_END) {
            fprintf(stderr, "kernel_launch: unexpected shapes: n_in %d in0 %d out %d ws %zu (need %zu)\n", n_in, n_in > 0 ? in_sizes[0] : -1, out_size, ws_size, (size_t)WS_END); grid = -1; return; }
        int dev = 0, cus = 0, per_cu = 0;
        if (hipGetDevice(&dev) != hipSuccess || hipDeviceGetAttribute(&cus, hipDeviceAttributeMultiprocessorCount, dev) != hipSuccess) { fprintf(stderr, "kernel_launch: device query failed\n"); grid = -1; return; }
        if (hipFuncSetAttribute((const void*)fwd_kernel, hipFuncAttributeMaxDynamicSharedMemorySize, LDS_BYTES) != hipSuccess) { fprintf(stderr, "kernel_launch: hipFuncSetAttribute failed\n"); grid = -1; return; }
        if (hipOccupancyMaxActiveBlocksPerMultiprocessor(&per_cu, (const void*)fwd_kernel, 512, LDS_BYTES) != hipSuccess || per_cu < 1) fprintf(stderr, "kernel_launch: note: occupancy query says %d\n", per_cu);
        (void)hipGetLastError();
        grid = cus;
    }
    if (grid < 0) return;
    (void)hipMemsetAsync((char*)d_ws + WS_CTL, 0, CTL_ZERO_BYTES, stream);
    Args a{};
    for (int i = 0; i < 21; ++i) a.in[i] = (const float*)d_in[i];
    a.out = (float*)d_out; a.ws = (unsigned char*)d_ws;
#if MK_SPLIT
    a.ph_lo = 0; a.ph_hi = 0;
    launch_phase<0>(a, 0, grid, stream);
    for (int l = 0; l < NLAYER; ++l) { launch_phase<1>(a, l, grid, stream); launch_phase<2>(a, l, grid, stream); launch_phase<3>(a, l, grid, stream); launch_phase<4>(a, l, grid, stream); launch_phase<5>(a, l, grid, stream);
        launch_phase<6>(a, l, grid, stream); launch_phase<7>(a, l, grid, stream); launch_phase<8>(a, l, grid, stream); launch_phase<9>(a, l, grid, stream); }
    launch_phase<10>(a, 0, grid, stream);
#else
    a.ph_lo = 0; a.ph_hi = N_PHASES; hipLaunchKernelGGL(fwd_kernel, dim3(grid), dim3(512), LDS_BYTES, stream, a);
#endif
}
```

```cpp
#include <hip/hip_runtime.h>
#include <cstdio>
#include <cstdint>

#define GAS __attribute__((address_space(1)))
#define LAS __attribute__((address_space(3)))
typedef unsigned short bf16;
typedef unsigned v4u __attribute__((ext_vector_type(4)));
typedef unsigned v2u __attribute__((ext_vector_type(2)));
typedef float f32x4 __attribute__((ext_vector_type(4)));
typedef float f32x2 __attribute__((ext_vector_type(2)));
typedef float f32x16 __attribute__((ext_vector_type(16)));
typedef short bf16x8 __attribute__((ext_vector_type(8)));
typedef _Float16 f16x8 __attribute__((ext_vector_type(8)));
typedef _Float16 f16x2 __attribute__((ext_vector_type(2)));
typedef int v4i __attribute__((ext_vector_type(4)));
typedef int v8i __attribute__((ext_vector_type(8)));

namespace pg8 {
constexpr int BM = 256, BK = 64, HALF = 128, HTB = HALF * BK * 2  , STAGE_BYTES = 8 * HTB, NXCD = 8, WGM = 8;

__host__ __device__ __forceinline__ int lds_byte(int r, int c) { const int st = (r >> 4) * 2 + (c >> 5), rr = r & 15, cc = c & 31, ob = rr * 64 + cc * 2; return st * 1024 + (ob ^ (((ob >> 9) & 1) << 5)); }
__host__ __device__ __forceinline__ void stage_rc(int b, int& R, int& C) { const int st = b / 1024, sb = b % 1024, swz = sb ^ (((sb >> 9) & 1) << 5); R = (st >> 1) * 16 + swz / 64; C = (st & 1) * 32 + (swz % 64) / 2; }
__host__ __device__ __forceinline__ int perm32(int rho) { const int n = rho >> 4, i = rho & 15; return 8 * (i >> 2) + 4 * n + (i & 3); }

struct Unit { int pm, pn, pb; };
struct Gemm { const bf16* A; const bf16* Bt; const int* rowmap; int K; void* tprobe = nullptr; };

__device__ __forceinline__ unsigned cvt_pk_bf16(float lo, float hi) { unsigned r; asm volatile("v_cvt_pk_bf16_f32 %0, %1, %2" : "=v"(r) : "v"(lo), "v"(hi)); return r; }

template <class Epi, class Sched, bool GATHER, bool FP8 = false>
__device__ __forceinline__ void gemm_phase(LAS unsigned char* lds, const Gemm g, const Sched& S, const Epi& E, int wave) {
    int lane_ = (int)__builtin_amdgcn_mbcnt_hi(~0u, __builtin_amdgcn_mbcnt_lo(~0u, 0u)); asm volatile("" : "+v"(lane_));
    const int wid = wave, lane = lane_, tid = wid * 64 + lane, wr = wid >> 2, wc = wid & 3, fr = lane & 15, fq = lane >> 4;
    const int K = g.K, nt = K / BK;
    unsigned voffA[2], voffB[2]; int RA[2], CA[2];
#pragma unroll
    for (int i = 0; i < 2; ++i) { int R, C; stage_rc(tid * 16 + i * 8192, R, C); const int Rb = Epi::PERM ? ((R & ~31) + perm32(R & 31)) : R; RA[i] = R; CA[i] = C;
        voffA[i] = (unsigned)(R * K + C) * 2u; voffB[i] = (unsigned)(Rb * K + C) * 2u; }
    const size_t kstep = (size_t)(BK * 2);
    const size_t hstep = (size_t)HALF * K * 2;
    const size_t tstep = 2 * hstep;
    const unsigned ldsw = (unsigned)wid * 1024u;
    const int aoff = lds_byte(wr * 64 + fr, fq * 8), boff = lds_byte(wc * 32 + fr, fq * 8);
#define PG8_SA(b, h) (((b) * 2 + (h)) * HTB)
#define PG8_SB(b, h) ((4 + (b) * 2 + (h)) * HTB)
#define PG8_STAGE(bufoff, gbase, voff) do { _Pragma("unroll") for (int _i = 0; _i < 2; ++_i) \
        __builtin_amdgcn_global_load_lds((const unsigned*)((const char*)(gbase) + (voff)[_i]), (LAS unsigned*)(lds + (bufoff) + ldsw + _i * 8192), 16, 0, 0); } while (0)
#define PG8_STAGEA(bufoff, pbase, h, nx) do { if constexpr (GATHER) { _Pragma("unroll") for (int _i = 0; _i < 2; ++_i) \
        __builtin_amdgcn_global_load_lds((const unsigned*)((const char*)(pbase) + ((nx) ? gn[h][_i] : gc[h][_i])), (LAS unsigned*)(lds + (bufoff) + ldsw + _i * 8192), 16, 0, 0); } \
        else { PG8_STAGE(bufoff, (const char*)(pbase) + (h) * hstep, voffA); } } while (0)
#define PG8_LDA(dst, b, h) do { if constexpr (FP8) { _Pragma("unroll") for (int m = 0; m < 4; ++m) dst##8[m] = __builtin_shufflevector(*(const LAS v4i*)(lds + PG8_SA(b, h) + aoff + m * 2048), *(const LAS v4i*)(lds + PG8_SA(b, h) + aoff + m * 2048 + 1024), 0, 1, 2, 3, 4, 5, 6, 7); } \
        else { _Pragma("unroll") for (int m = 0; m < 4; ++m) _Pragma("unroll") for (int k = 0; k < 2; ++k) dst[m][k] = *(const LAS bf16x8*)(lds + PG8_SA(b, h) + aoff + m * 2048 + k * 1024); } } while (0)
#define PG8_LDB(dst, b, h) do { if constexpr (FP8) { _Pragma("unroll") for (int n = 0; n < 2; ++n) dst##8[n] = __builtin_shufflevector(*(const LAS v4i*)(lds + PG8_SB(b, h) + boff + n * 2048), *(const LAS v4i*)(lds + PG8_SB(b, h) + boff + n * 2048 + 1024), 0, 1, 2, 3, 4, 5, 6, 7); } \
        else { _Pragma("unroll") for (int n = 0; n < 2; ++n) _Pragma("unroll") for (int k = 0; k < 2; ++k) dst[n][k] = *(const LAS bf16x8*)(lds + PG8_SB(b, h) + boff + n * 2048 + k * 1024); } } while (0)
#define PG8_MMA(ai, bj, At, Bt) do { __builtin_amdgcn_s_setprio(1); if constexpr (FP8) { _Pragma("unroll") for (int m = 0; m < 4; ++m) _Pragma("unroll") for (int n = 0; n < 2; ++n) \
        asm volatile("v_mfma_scale_f32_16x16x128_f8f6f4 %0, %1, %2, %0, %3, %4 op_sel_hi:[0,0,0]" : "+v"(acc[ai][bj][m][n]) : "v"(Bt##8[n]), "v"(At##8[m]), "v"(sclw), "v"(scla)); } \
        else { _Pragma("unroll") for (int m = 0; m < 4; ++m) _Pragma("unroll") for (int n = 0; n < 2; ++n) _Pragma("unroll") for (int k = 0; k < 2; ++k) \
        acc[ai][bj][m][n] = __builtin_amdgcn_mfma_f32_16x16x32_bf16(Bt[n][k], At[m][k], acc[ai][bj][m][n], 0, 0, 0); } __builtin_amdgcn_s_setprio(0); } while (0)
#define PG8_WAIT_V(n) asm volatile("s_waitcnt vmcnt(" #n ")" ::: "memory")
#define PG8_WAIT_L(n) asm volatile("s_waitcnt lgkmcnt(" #n ")" ::: "memory")
#define PG8_BAR __builtin_amdgcn_s_barrier()
#define PG8_SCHED __builtin_amdgcn_sched_barrier(0)
    Unit cur, nxt; int ui = 0;
    if (!S.next(0, cur)) return;
#ifdef GEMM_STAGGER
    {
        const unsigned long long t0 = __builtin_amdgcn_s_memrealtime(); const unsigned long long d = (unsigned long long)((blockIdx.x >> 3) & 3) * GEMM_STAGGER;
        while (__builtin_amdgcn_s_memrealtime() - t0 < d) __builtin_amdgcn_s_sleep(16);
    }
#endif
    f32x4 acc[2][2][4][2];
#pragma unroll
    for (int a = 0; a < 2; ++a)
#pragma unroll
        for (int b = 0; b < 2; ++b)
#pragma unroll
            for (int m = 0; m < 4; ++m)
#pragma unroll
                for (int n = 0; n < 2; ++n) acc[a][b][m][n] = (f32x4){0.f, 0.f, 0.f, 0.f};
    bf16x8 At[4][2], B0[2][2], B1[2][2]; v8i At8[4], B08[2], B18[2];
    const int sclw = 0x7A7A7A7A, scla = 0x7F7F7F7F;
    unsigned gc[2][2], gn[2][2];
    if constexpr (GATHER) {
#pragma unroll
        for (int h = 0; h < 2; ++h)
#pragma unroll
            for (int i = 0; i < 2; ++i) { gc[h][i] = (unsigned)(g.rowmap[cur.pm * BM + h * HALF + RA[i]] * K + CA[i]) * 2u; gn[h][i] = gc[h][i]; }
    } else { gc[0][0] = gc[0][1] = gc[1][0] = gc[1][1] = 0u; gn[0][0] = gn[0][1] = gn[1][0] = gn[1][1] = 0u; }
    const char* cA = GATHER ? (const char*)g.A : (const char*)g.A + (size_t)cur.pm * tstep; const char* cB = (const char*)g.Bt + (size_t)cur.pb * tstep;
    PG8_STAGE(PG8_SB(0, 0), cB, voffB); PG8_STAGE(PG8_SB(0, 1), cB + hstep, voffB); PG8_STAGEA(PG8_SA(0, 0), cA, 0, false); PG8_STAGEA(PG8_SA(0, 1), cA, 1, false);
    if (wr == 1) PG8_BAR;
    PG8_WAIT_V(2); PG8_BAR;
    PG8_STAGE(PG8_SB(1, 0), cB + kstep, voffB); PG8_STAGEA(PG8_SA(1, 0), cA + kstep, 0, false); PG8_STAGE(PG8_SB(1, 1), cB + hstep + kstep, voffB);
    PG8_WAIT_V(6); PG8_BAR;
    for (;;) {
        const bool has_next = S.next(ui + 1, nxt);
        if constexpr (GATHER) { if (has_next) {
#pragma unroll
            for (int h = 0; h < 2; ++h)
#pragma unroll
                for (int i = 0; i < 2; ++i) gn[h][i] = (unsigned)(g.rowmap[nxt.pm * BM + h * HALF + RA[i]] * K + CA[i]) * 2u; } }
        const char* nA = GATHER ? cA : (has_next ? (const char*)g.A + (size_t)nxt.pm * tstep : cA); const char* nB = has_next ? (const char*)g.Bt + (size_t)nxt.pb * tstep : cB;
#ifdef TPG
        const unsigned long long tg0 = __builtin_readcyclecounter();
#endif
        for (int t = 0; t < nt; t += 2) {
            const bool last = (t == nt - 2);
            const char* a1 = cA + (size_t)(t + 1) * kstep;
            const char* a2 = last ? nA : cA + (size_t)(t + 2) * kstep; const char* b2 = last ? nB : cB + (size_t)(t + 2) * kstep;
            const char* a3 = a2 + kstep; const char* b3 = b2 + kstep;
            PG8_LDB(B0, 0, 0); PG8_LDB(B1, 0, 1); PG8_SCHED; PG8_LDA(At, 0, 0); PG8_STAGEA(PG8_SA(1, 1), a1, 1, false);
            PG8_WAIT_V(8); PG8_WAIT_L(0); PG8_BAR; PG8_MMA(0, 0, At, B0); PG8_MMA(0, 1, At, B1); PG8_BAR; PG8_SCHED;
            PG8_LDA(At, 0, 1); PG8_STAGE(PG8_SB(0, 0), b2, voffB); PG8_STAGE(PG8_SB(0, 1), b2 + hstep, voffB); PG8_STAGEA(PG8_SA(0, 0), a2, 0, last);
            PG8_WAIT_V(8); PG8_WAIT_L(0); PG8_BAR; PG8_MMA(1, 0, At, B0); PG8_MMA(1, 1, At, B1); PG8_BAR; PG8_SCHED;
            PG8_LDB(B0, 1, 0); PG8_LDB(B1, 1, 1); PG8_SCHED; PG8_LDA(At, 1, 0); PG8_STAGEA(PG8_SA(0, 1), a2, 1, last);
            PG8_WAIT_V(8); PG8_WAIT_L(0); PG8_BAR; PG8_MMA(0, 0, At, B0); PG8_MMA(0, 1, At, B1); PG8_BAR; PG8_SCHED;
            PG8_LDA(At, 1, 1); PG8_STAGE(PG8_SB(1, 0), b3, voffB); PG8_STAGE(PG8_SB(1, 1), b3 + hstep, voffB); PG8_STAGEA(PG8_SA(1, 0), a3, 0, last);
            PG8_WAIT_V(8); PG8_WAIT_L(0); PG8_BAR; PG8_MMA(1, 0, At, B0); PG8_MMA(1, 1, At, B1); PG8_BAR; PG8_SCHED;
        }
#ifdef TPG
        { const unsigned long long tg1 = __builtin_readcyclecounter(); asm volatile("" :: "s"(tg0), "s"(tg1));
          if (FP8 && !GATHER && blockIdx.x == 3 && tid == 0) atomicAdd((unsigned long long*)g.tprobe, (TPG == 1) ? (tg1 - tg0) : 1ull); }
#endif
        if (wr == 0) PG8_BAR;
        if constexpr (FP8) asm volatile("s_nop 15\n\ts_nop 7" ::: "memory");
        E(acc, cur, wr, wc, fr, fq);
        if (!has_next) break;
#pragma unroll
        for (int a = 0; a < 2; ++a)
#pragma unroll
            for (int b = 0; b < 2; ++b)
#pragma unroll
                for (int m = 0; m < 4; ++m)
#pragma unroll
                    for (int n = 0; n < 2; ++n) acc[a][b][m][n] = (f32x4){0.f, 0.f, 0.f, 0.f};
        cur = nxt; cA = nA; cB = nB; ++ui;
        if constexpr (GATHER) {
#pragma unroll
            for (int h = 0; h < 2; ++h)
#pragma unroll
                for (int i = 0; i < 2; ++i) gc[h][i] = gn[h][i]; }
        if (wr == 1) PG8_BAR;
    }
    PG8_WAIT_V(0);
    PG8_BAR;
#undef PG8_SA
#undef PG8_SB
#undef PG8_STAGE
#undef PG8_STAGEA
#undef PG8_LDA
#undef PG8_LDB
#undef PG8_MMA
#undef PG8_WAIT_V
#undef PG8_WAIT_L
#undef PG8_BAR
#undef PG8_SCHED
}
}
constexpr int DM = 1024, NB = 8, SEQ = 4096, NTOK = NB * SEQ, NLAYER = 2;
constexpr int NPROJ = 3072;
constexpr int D_IN = 3078;
constexpr int NEXP = 32, TOPK = 4;
constexpr int NSLOT_MAX = NTOK * TOPK + NEXP * 256;
constexpr int NTILE_MAX = NSLOT_MAX / 256;
constexpr int COL_CB = 0, COL_CC = 256, COL_CU = 512, COL_SQ = 768, COL_SK = 1152, COL_SV = 1536, COL_FQ = 1920, COL_FK = 2304, COL_FV = 2688;
constexpr float EPS = 1e-6f;
constexpr float LOG2E = 1.4426950408889634f;
constexpr float QSCALE = 0.125f * LOG2E;

namespace pg8 {
struct StaticOrder {
    int nM, nN, nwg, G, c;
    __device__ __forceinline__ void init(int M, int N, int G_, int c_) { nM = M / BM; nN = N / BM; nwg = nM * nN; G = G_; c = c_; }
    __device__ __forceinline__ bool next(int i, Unit& u) const {
        const long L = (long)i * G + c; if (L >= nwg) return false;
        int wgid = (int)L; { const int q = nwg / NXCD, r = nwg % NXCD, xcd = wgid % NXCD, off = wgid / NXCD; wgid = (xcd < r ? xcd * (q + 1) : r * (q + 1) + (xcd - r) * q) + off; }
        const int nig = WGM * nN, gid = wgid / nig, fm = gid * WGM, gsz = (nM - fm) < WGM ? (nM - fm) : WGM;
        u.pm = fm + ((wgid % nig) % gsz); u.pn = (wgid % nig) / gsz; u.pb = u.pn; return true;
    }
};
struct MoeOrder {
    int nM, nN, nwg, G, c; const LAS int* tb;
    __device__ __forceinline__ void init(const LAS int* tb_, int nN_, int G_, int c_) { tb = tb_; nM = tb_[NEXP]; nN = nN_; nwg = nM * nN; G = G_; c = c_; }
    __device__ __forceinline__ bool next(int i, Unit& u) const {
        const long L = (long)i * G + c; if (L >= nwg) return false;
        int wgid = (int)L; { const int q = nwg / NXCD, r = nwg % NXCD, xcd = wgid % NXCD, off = wgid / NXCD; wgid = (xcd < r ? xcd * (q + 1) : r * (q + 1) + (xcd - r) * q) + off; }
        const int nig = WGM * nN, gid = wgid / nig, fm = gid * WGM, gsz = (nM - fm) < WGM ? (nM - fm) : WGM;
        u.pm = fm + ((wgid % nig) % gsz); u.pn = (wgid % nig) / gsz;
        int e = 0;
#pragma unroll 1
        for (int j = 1; j < NEXP; ++j) e += (tb[j] <= u.pm) ? 1 : 0;
        u.pb = e * nN + u.pn; return true;
    }
};

struct EpiProj {
    static constexpr bool PERM = true;
    bf16* O; int ldc;
    __device__ __forceinline__ void operator()(const f32x4 (&acc)[2][2][4][2], const Unit& u, int wr, int wc, int fr, int fq) const {
        const int row0 = u.pm * BM + wr * 64 + fr, col0 = u.pn * BM + wc * 32 + 8 * fq;
#pragma unroll
        for (int ai = 0; ai < 2; ++ai)
#pragma unroll
            for (int m = 0; m < 4; ++m) { bf16* rowp = O + (size_t)(row0 + ai * HALF + m * 16) * ldc + col0;
#pragma unroll
                for (int bj = 0; bj < 2; ++bj) { const f32x4 v0 = acc[ai][bj][m][0], v1 = acc[ai][bj][m][1];
                    v4u w; w.x = cvt_pk_bf16(v0[0], v0[1]); w.y = cvt_pk_bf16(v0[2], v0[3]); w.z = cvt_pk_bf16(v1[0], v1[1]); w.w = cvt_pk_bf16(v1[2], v1[3]);
                    *(v4u*)(rowp + bj * HALF) = w; } }
    }
};
template <bool BASE16> struct EpiResGate {
    static constexpr bool PERM = true;
    const void* base; bf16* out; const float* gbias; const float* gpart;
    __device__ __forceinline__ void operator()(const f32x4 (&acc)[2][2][4][2], const Unit& u, int wr, int wc, int fr, int fq) const {
        const int row0 = u.pm * BM + wr * 64 + fr, col0 = u.pn * BM + wc * 32 + 8 * fq; const int b = (u.pm * BM) / SEQ;
#pragma unroll
        for (int bj = 0; bj < 2; ++bj) { const int c = col0 + bj * HALF; f32x4 g0 = *(const f32x4*)(gbias + c), g1 = *(const f32x4*)(gbias + c + 4);
#pragma unroll
            for (int ks = 0; ks < 4; ++ks) { g0 += *(const f32x4*)(gpart + (size_t)(ks * NB + b) * 6144 + c); g1 += *(const f32x4*)(gpart + (size_t)(ks * NB + b) * 6144 + c + 4); }
#pragma unroll
            for (int ai = 0; ai < 2; ++ai)
#pragma unroll
                for (int m = 0; m < 4; ++m) { const size_t off = (size_t)(row0 + ai * HALF + m * 16) * DM + c; f32x4 b0, b1;
                    if (BASE16) { const v4u t = *(const v4u*)((const bf16*)base + off); b0 = (f32x4){__builtin_bit_cast(float, t.x << 16), __builtin_bit_cast(float, t.x & 0xffff0000u), __builtin_bit_cast(float, t.y << 16), __builtin_bit_cast(float, t.y & 0xffff0000u)};
                        b1 = (f32x4){__builtin_bit_cast(float, t.z << 16), __builtin_bit_cast(float, t.z & 0xffff0000u), __builtin_bit_cast(float, t.w << 16), __builtin_bit_cast(float, t.w & 0xffff0000u)}; }
                    else { b0 = *(const f32x4*)((const float*)base + off); b1 = *(const f32x4*)((const float*)base + off + 4); }
                    const f32x4 v0 = b0 + g0 * acc[ai][bj][m][0], v1 = b1 + g1 * acc[ai][bj][m][1];
                    v4u w; w.x = cvt_pk_bf16(v0[0], v0[1]); w.y = cvt_pk_bf16(v0[2], v0[3]); w.z = cvt_pk_bf16(v1[0], v1[1]); w.w = cvt_pk_bf16(v1[2], v1[3]);
                    *(v4u*)(out + off) = w; } }
    }
};
struct EpiSwiglu {
    static constexpr bool PERM = true;
    bf16* O; const float* b1;
    __device__ __forceinline__ void operator()(const f32x4 (&acc)[2][2][4][2], const Unit& u, int wr, int wc, int fr, int fq) const {
        const int row0 = u.pm * BM + wr * 64 + fr; const int e = u.pb >> 3; const int j0 = u.pn * 128 + wc * 32 + 8 * fq;
        const float* bp = b1 + (size_t)e * 2048 + 2 * j0;
        f32x4 bb[4];
#pragma unroll
        for (int q = 0; q < 4; ++q) bb[q] = *(const f32x4*)(bp + 4 * q);
        float bg[8], bl[8];
#pragma unroll
        for (int q = 0; q < 4; ++q) { bg[2 * q] = bb[q][0]; bl[2 * q] = bb[q][1]; bg[2 * q + 1] = bb[q][2]; bl[2 * q + 1] = bb[q][3]; }
#pragma unroll
        for (int ai = 0; ai < 2; ++ai)
#pragma unroll
            for (int m = 0; m < 4; ++m) { bf16* rowp = O + (size_t)(row0 + ai * HALF + m * 16) * DM + j0;
                float a[8];
#pragma unroll
                for (int n = 0; n < 2; ++n)
#pragma unroll
                    for (int i = 0; i < 4; ++i) { float gl = acc[ai][0][m][n][i] + bg[4 * n + i], li = acc[ai][1][m][n][i] + bl[4 * n + i];
                        gl = fminf(gl, 7.0f); li = fminf(fmaxf(li, -7.0f), 7.0f);
                        const float sg = __builtin_amdgcn_rcpf(1.0f + __builtin_amdgcn_exp2f(-1.702f * LOG2E * gl));
                        a[4 * n + i] = gl * sg * (li + 1.0f); }
                v4u w; w.x = cvt_pk_bf16(a[0], a[1]); w.y = cvt_pk_bf16(a[2], a[3]); w.z = cvt_pk_bf16(a[4], a[5]); w.w = cvt_pk_bf16(a[6], a[7]);
                *(v4u*)rowp = w; }
    }
};
__device__ __forceinline__ float clamp448(float v) { return __builtin_amdgcn_fmed3f(v, -448.0f, 448.0f); }
__device__ __forceinline__ unsigned pk4_fp8(float a, float b, float c, float d) { unsigned r = 0; r = __builtin_amdgcn_cvt_pk_fp8_f32(clamp448(a), clamp448(b), r, false); r = __builtin_amdgcn_cvt_pk_fp8_f32(clamp448(c), clamp448(d), r, true); return r; }
struct EpiSwiglu8 {
    static constexpr bool PERM = true;
    unsigned char* O; const float* b1;
    __device__ __forceinline__ void operator()(const f32x4 (&acc)[2][2][4][2], const Unit& u, int wr, int wc, int fr, int fq) const {
        const int row0 = u.pm * BM + wr * 64 + fr; const int e = u.pb >> 3; const int j0 = u.pn * 128 + wc * 32 + 8 * fq;
        const float* bp = b1 + (size_t)e * 2048 + 2 * j0;
        f32x4 bb[4];
#pragma unroll
        for (int q = 0; q < 4; ++q) bb[q] = *(const f32x4*)(bp + 4 * q);
        float bg[8], bl[8];
#pragma unroll
        for (int q = 0; q < 4; ++q) { bg[2 * q] = bb[q][0]; bl[2 * q] = bb[q][1]; bg[2 * q + 1] = bb[q][2]; bl[2 * q + 1] = bb[q][3]; }
#pragma unroll
        for (int ai = 0; ai < 2; ++ai)
#pragma unroll
            for (int m = 0; m < 4; ++m) { unsigned char* rowp = O + (size_t)(row0 + ai * HALF + m * 16) * DM + j0;
                float a[8];
#pragma unroll
                for (int n = 0; n < 2; ++n)
#pragma unroll
                    for (int i = 0; i < 4; ++i) { float gl = acc[ai][0][m][n][i] + bg[4 * n + i], li = acc[ai][1][m][n][i] + bl[4 * n + i];
                        gl = fminf(gl, 7.0f); li = fminf(fmaxf(li, -7.0f), 7.0f);
                        const float sg = __builtin_amdgcn_rcpf(1.0f + __builtin_amdgcn_exp2f(-1.702f * LOG2E * gl));
                        a[4 * n + i] = gl * sg * (li + 1.0f); }
                v2u w; w.x = pk4_fp8(a[0], a[1], a[2], a[3]); w.y = pk4_fp8(a[4], a[5], a[6], a[7]);
                *(v2u*)rowp = w; }
    }
};
struct EpiY {
    static constexpr bool PERM = true;
    unsigned char* O; const float* b2;
    __device__ __forceinline__ void operator()(const f32x4 (&acc)[2][2][4][2], const Unit& u, int wr, int wc, int fr, int fq) const {
        const int row0 = u.pm * BM + wr * 64 + fr; const int e = u.pb >> 2; const int col0 = u.pn * BM + wc * 32 + 8 * fq;
        f32x4 bv[2][2];
#pragma unroll
        for (int bj = 0; bj < 2; ++bj)
#pragma unroll
            for (int n = 0; n < 2; ++n) bv[bj][n] = b2 ? *(const f32x4*)(b2 + (size_t)e * DM + col0 + bj * HALF + 4 * n) : (f32x4){0.f, 0.f, 0.f, 0.f};
#pragma unroll
        for (int ai = 0; ai < 2; ++ai)
#pragma unroll
            for (int m = 0; m < 4; ++m) { unsigned char* rowp = O + (size_t)(row0 + ai * HALF + m * 16) * DM + col0;
#pragma unroll
                for (int bj = 0; bj < 2; ++bj) { const f32x4 v0 = acc[ai][bj][m][0] + bv[bj][0], v1 = acc[ai][bj][m][1] + bv[bj][1];
                    v2u w; w.x = pk4_fp8(v0[0], v0[1], v0[2], v0[3]); w.y = pk4_fp8(v1[0], v1[1], v1[2], v1[3]);
                    *(v2u*)(rowp + bj * HALF) = w; } }
    }
};
}
namespace att {
constexpr int KROW = 128;
constexpr int TILE_B = 64 * KROW;
constexpr int OFF_K = 0, OFF_V = 2 * TILE_B, OFF_F = 4 * TILE_B, OFF_Q = OFF_F + 512, LDS_BYTES = OFF_Q + 8 * 4608;
__device__ __forceinline__ int pim(int m) { const int a = m >> 3, h = (m >> 2) & 1, b = m & 3; return 16 * (a >> 1) + 8 * h + 4 * (a & 1) + b; }
typedef __bf16 bf16x2_t __attribute__((ext_vector_type(2)));
__device__ __forceinline__ unsigned pk_bf16(float lo, float hi) { const f32x2 v = {lo, hi}; const bf16x2_t b = __builtin_convertvector(v, bf16x2_t); return __builtin_bit_cast(unsigned, b); }
__device__ __forceinline__ unsigned pk_f16(float lo, float hi) { return __builtin_bit_cast(unsigned, __builtin_amdgcn_cvt_pkrtz(lo, hi)); }
__device__ __forceinline__ float half_sum(float v) { auto rr = __builtin_amdgcn_permlane32_swap(__float_as_uint(v), __float_as_uint(v), false, false); return __uint_as_float(rr[0]) + __uint_as_float(rr[1]); }
__device__ __forceinline__ float half_max(float v) { auto rr = __builtin_amdgcn_permlane32_swap(__float_as_uint(v), __float_as_uint(v), false, false); return fmaxf(__uint_as_float(rr[0]), __uint_as_float(rr[1])); }
__device__ __forceinline__ void glds16(const void* gsrc, unsigned lds_dst) { unsigned keep;
    asm volatile("s_mov_b32 %0, m0\n\ts_mov_b32 m0, %2\n\ts_nop 0\n\tglobal_load_lds_dwordx4 %1, off\n\ts_mov_b32 m0, %0" : "=&s"(keep) : "v"(gsrc), "s"(lds_dst) : "memory"); }
#define ATT_SB() __builtin_amdgcn_sched_barrier(0)
#define ATT_MFMA(a, b, c) __builtin_amdgcn_mfma_f32_32x32x16_bf16((a), (b), (c), 0, 0, 0)
#define ATT_MFMAH(a, b, c) __builtin_amdgcn_mfma_f32_32x32x16_f16((a), (b), (c), 0, 0, 0)

struct Tensors {
    const bf16* proj;
    const bf16* vt;
    const float* fcum;
    bf16* ymix;
    const float* ong;
    int colq, colk, coly;
    void* tprobe;
};
struct WaveCtx { int r32, hi, qabs; int ko[4]; const LAS unsigned char* qb; f16x8 mtri0, mtri1, mones; };

__device__ __forceinline__ void qk_only(f32x16& p0, f32x16& p1, const LAS unsigned char* Kb, const WaveCtx& W) {
#pragma unroll
    for (int r = 0; r < 16; ++r) { p0[r] = 0.f; p1[r] = 0.f; }
#pragma unroll
    for (int d0 = 0; d0 < 4; ++d0) { const bf16x8 ka = *(const LAS bf16x8*)(Kb + W.ko[d0]), kb2 = *(const LAS bf16x8*)(Kb + 32 * KROW + W.ko[d0]);
        const bf16x8 qv = *(const LAS bf16x8*)(W.qb + 32 * d0);
        p0 = ATT_MFMA(ka, qv, p0); p1 = ATT_MFMA(kb2, qv, p1); }
}

template <int KIND, bool DIAG>
__device__ __forceinline__ void tile(f32x16& p0, f32x16& p1, f32x16& o0, f32x16& o1, float& carry, float& lsum, const LAS unsigned char* Kn, const LAS unsigned char* Vb, const LAS float* Fb, int kt, const WaveCtx& W) {
    const int kbase = kt * 64 + 8 * W.hi;
#define ATT_KF(i) (*(const LAS bf16x8*)(Kn + ((i) & 1) * 32 * KROW + W.ko[(i) >> 1]))
#define ATT_VF(i) (*(const LAS bf16x8*)(Vb + ((i) & 1) * 32 * KROW + W.ko[(i) >> 1]))
#define ATT_QF(d0) (*(const LAS bf16x8*)(W.qb + 32 * (d0)))
    bf16x8 kcur = ATT_KF(0), knxt = kcur, qcur = ATT_QF(0), qnxt = qcur;
    f32x16 n0, n1;
#pragma unroll
    for (int r = 0; r < 16; ++r) { n0[r] = 0.f; n1[r] = 0.f; }
    v4u wf[4];
    if (KIND == 0) {
        v4u lf[4]; float lfirst = 0.f, pz0 = 0.f;
#pragma unroll
        for (int i = 0; i < 8; ++i) {
            if (i < 7) { knxt = ATT_KF(i + 1); if (i & 1) qnxt = ATT_QF((i + 1) >> 1); }
#pragma unroll
            for (int jj = 0; jj < 2; ++jj) { const int r = (4 * i + 2 * jj) & 15; float lg[2];
#pragma unroll
                for (int e = 0; e < 2; ++e) { const float z = (i < 4) ? p0[r + e] : p1[r + e]; float g = __builtin_amdgcn_logf(1.0f + __builtin_amdgcn_exp2f(z));
                    if (i < 4) p0[r + e] = z - g; else p1[r + e] = z - g;
                    if (DIAG) { const int key = kbase + (i < 4 ? 0 : 32) + 16 * ((r + e) >> 3) + ((r + e) & 7); g = (key < W.qabs) ? g : 0.f; }
                    lg[e] = g; }
                if (i == 0 && jj == 0) { lfirst = -lg[0]; pz0 = p0[0]; }
                lf[2 * (i >> 2) + (r >> 3)][(r & 7) >> 1] = pk_f16(-lg[0], -lg[1]); }
            if (i & 1) { n1 = ATT_MFMA(kcur, qcur, n1); qcur = qnxt; } else n0 = ATT_MFMA(kcur, qcur, n0);
            kcur = knxt;
            ATT_SB();
        }
        bf16x8 va = ATT_VF(0), vb = ATT_VF(1), vna = va, vnb = vb;
#pragma unroll
        for (int r = 0; r < 16; ++r) { p0[r] += carry; p1[r] += carry; }
        p0 = ATT_MFMAH(W.mtri0, __builtin_bit_cast(f16x8, lf[0]), p0); p1 = ATT_MFMAH(W.mtri0, __builtin_bit_cast(f16x8, lf[2]), p1);
        p0 = ATT_MFMAH(W.mtri1, __builtin_bit_cast(f16x8, lf[1]), p0); p1 = ATT_MFMAH(W.mtri1, __builtin_bit_cast(f16x8, lf[3]), p1);
        p0 = ATT_MFMAH(W.mones, __builtin_bit_cast(f16x8, lf[2]), p0);
        p0 = ATT_MFMAH(W.mones, __builtin_bit_cast(f16x8, lf[3]), p0);
        ATT_SB();
        const float t00 = p0[0];
#pragma unroll
        for (int c = 0; c < 4; ++c) {
            if (c < 3) { vna = ATT_VF(2 * c + 2); vnb = ATT_VF(2 * c + 3); }
#pragma unroll
            for (int j = 0; j < 4; ++j) { const int r = 8 * (c & 1) + 2 * j; float w[2];
#pragma unroll
                for (int e = 0; e < 2; ++e) { const float t = (c < 2) ? p0[r + e] : p1[r + e]; float x = __builtin_amdgcn_exp2f(t);
                    if (DIAG) { const int key = kbase + (c < 2 ? 0 : 32) + 16 * ((r + e) >> 3) + ((r + e) & 7); x = (key < W.qabs) ? x : 0.f; }
                    w[e] = x; }
                wf[c][j] = pk_bf16(w[0], w[1]); }
            o0 = ATT_MFMA(va, __builtin_bit_cast(bf16x8, wf[c]), o0); o1 = ATT_MFMA(vb, __builtin_bit_cast(bf16x8, wf[c]), o1);
            va = vna; vb = vnb;
            ATT_SB();
        }
        carry = half_sum(W.hi == 0 ? (t00 - pz0) + lfirst : 0.f);
    } else {
#define ATT_FBV(i) (*(const LAS f32x4*)(Fb + 8 * W.hi + 32 * ((i) >> 2) + 16 * (((i) >> 1) & 1) + 4 * ((i) & 1)))
        f32x4 fcur = ATT_FBV(0), fnxt = fcur;
        float mx = -1e30f;
#pragma unroll
        for (int i = 0; i < 8; ++i) {
            if (i < 7) { knxt = ATT_KF(i + 1); fnxt = ATT_FBV(i + 1); if (i & 1) qnxt = ATT_QF((i + 1) >> 1); }
#pragma unroll
            for (int e = 0; e < 4; ++e) { const int r = (4 * i + e) & 15; float s = ((i < 4) ? p0[r] : p1[r]) - fcur[e];
                if (DIAG) { const int key = kbase + (i < 4 ? 0 : 32) + 16 * (r >> 3) + (r & 7); s = (key > W.qabs) ? -1e30f : s; }
                if (i < 4) p0[r] = s; else p1[r] = s; mx = fmaxf(mx, s); }
            if (i & 1) { n1 = ATT_MFMA(kcur, qcur, n1); qcur = qnxt; } else n0 = ATT_MFMA(kcur, qcur, n0);
            kcur = knxt; fcur = fnxt;
            ATT_SB();
        }
        bf16x8 va = ATT_VF(0), vb = ATT_VF(1), vna = va, vnb = vb;
        mx = half_max(mx);
        if (__any(mx > carry)) {
            const float mnew = fmaxf(carry, mx), alpha = __builtin_amdgcn_exp2f(carry - mnew); carry = mnew; lsum *= alpha;
#pragma unroll
            for (int r = 0; r < 16; ++r) { o0[r] *= alpha; o1[r] *= alpha; }
        }
        ATT_SB();
        float ps = 0.f;
#pragma unroll
        for (int c = 0; c < 4; ++c) {
            if (c < 3) { vna = ATT_VF(2 * c + 2); vnb = ATT_VF(2 * c + 3); }
#pragma unroll
            for (int j = 0; j < 4; ++j) { const int r = 8 * (c & 1) + 2 * j;
                const float a = __builtin_amdgcn_exp2f(((c < 2) ? p0[r] : p1[r]) - carry), d = __builtin_amdgcn_exp2f(((c < 2) ? p0[r + 1] : p1[r + 1]) - carry);
                ps += a + d; wf[c][j] = pk_bf16(a, d); }
            o0 = ATT_MFMA(va, __builtin_bit_cast(bf16x8, wf[c]), o0); o1 = ATT_MFMA(vb, __builtin_bit_cast(bf16x8, wf[c]), o1);
            va = vna; vb = vnb;
            ATT_SB();
        }
        lsum += half_sum(ps);
    }
    p0 = n0; p1 = n1;
#undef ATT_KF
#undef ATT_QF
#undef ATT_VF
#undef ATT_FBV
}

template <int KIND>
__device__ __forceinline__ void unit(const Tensors& T, int b, int h, int qb, LAS unsigned char* lds, int wave) {
    int lane_ = (int)__builtin_amdgcn_mbcnt_hi(~0u, __builtin_amdgcn_mbcnt_lo(~0u, 0u)); asm volatile("" : "+v"(lane_));
    const int wid = wave, lane = lane_, tid = wid * 64 + lane;
    WaveCtx W; W.r32 = lane & 31; W.hi = lane >> 5;
    const int q0 = qb * 256, qw0 = q0 + wid * 32; W.qabs = qw0 + W.r32;
    const size_t rowbase = (size_t)b * SEQ;
    const int ktd = qw0 >> 6;
    const int kt_hi = (q0 + 255) >> 6;
    const int srow = tid >> 3, cg = (tid & 7) ^ ((srow >> 1) & 7);
    const bf16* kg = T.proj + (rowbase + srow) * NPROJ + T.colk + h * 64 + cg * 8;
    const bf16* vg = T.vt + ((size_t)(b * 6 + h) * 64 + srow) * SEQ + cg * 8;
    const float* fg = T.fcum + (size_t)(b * 6 + h) * SEQ;
    LAS unsigned char* qlds = lds + OFF_Q + wid * 4608;
    W.qb = qlds + W.r32 * 144 + W.hi * 16;
    { const bf16* qp = T.proj + (rowbase + W.qabs) * NPROJ + T.colq + h * 64 + W.hi * 8;
      v4u qt[4];
#pragma unroll
      for (int d0 = 0; d0 < 4; ++d0) qt[d0] = *(const v4u*)(qp + d0 * 16);
#pragma unroll
      for (int d0 = 0; d0 < 4; ++d0) *(LAS v4u*)(qlds + W.r32 * 144 + W.hi * 16 + 32 * d0) = qt[d0]; }
    const int pm = pim(W.r32);
#pragma unroll
    for (int j = 0; j < 4; ++j) W.ko[j] = pm * KROW + (((2 * j + W.hi) ^ ((pm >> 1) & 7)) << 4);
#pragma unroll
    for (int i = 0; i < 8; ++i) { W.mtri0[i] = (_Float16)((8 * W.hi + i > pm) ? 1.0f : 0.0f); W.mtri1[i] = (_Float16)((16 + 8 * W.hi + i > pm) ? 1.0f : 0.0f); W.mones[i] = (_Float16)1.0f; }
    f32x16 o0, o1, p0, p1;
#pragma unroll
    for (int r = 0; r < 16; ++r) { o0[r] = 0.f; o1[r] = 0.f; p0[r] = 0.f; p1[r] = 0.f; }
    float carry = (KIND == 1) ? -1e30f : 0.f, lsum = 0.f;
#define ATT_KB(t) (lds + OFF_K + ((t) & 1) * TILE_B)
#define ATT_VB(t) (lds + OFF_V + ((t) & 1) * TILE_B)
#define ATT_FB(t) ((LAS float*)(lds + OFF_F + ((t) & 1) * 256))
#define ATT_DMA(gsrc, ldst) glds16((gsrc), (unsigned)__builtin_amdgcn_readfirstlane((int)(uintptr_t)((ldst) + wid * 1024)))
    ATT_DMA(kg + (size_t)kt_hi * 64 * NPROJ, ATT_KB(kt_hi)); ATT_DMA(vg + kt_hi * 64, ATT_VB(kt_hi)); ATT_DMA(kg + (size_t)(kt_hi - 1) * 64 * NPROJ, ATT_KB(kt_hi - 1));
    if (KIND == 1 && tid < 64) ATT_FB(kt_hi)[tid] = fg[kt_hi * 64 + tid];
    asm volatile("s_waitcnt vmcnt(0)" ::: "memory");
    __syncthreads();
    if (ktd == kt_hi) qk_only(p0, p1, ATT_KB(kt_hi), W);
    __syncthreads();
#ifdef TPROBE
    unsigned long long tacc = 0ull;
#endif
    for (int kt = kt_hi; kt >= 0; --kt) {
        float freg = 0.f;
#ifdef TPROBE
        const unsigned long long tp0 = __builtin_readcyclecounter();
#endif
        if (kt >= 2) ATT_DMA(kg + (size_t)(kt - 2) * 64 * NPROJ, ATT_KB(kt - 2));
        if (kt >= 1) { ATT_DMA(vg + (kt - 1) * 64, ATT_VB(kt - 1)); if (KIND == 1 && tid < 64) freg = fg[(kt - 1) * 64 + tid]; }
#ifdef TPROBE
        const unsigned long long tp1 = __builtin_readcyclecounter();
#endif
        if (kt <= ktd) {
            if (kt == ktd) tile<KIND, true>(p0, p1, o0, o1, carry, lsum, ATT_KB(kt - 1), ATT_VB(kt), ATT_FB(kt), kt, W);
            else tile<KIND, false>(p0, p1, o0, o1, carry, lsum, ATT_KB(kt - 1), ATT_VB(kt), ATT_FB(kt), kt, W);
        } else if (kt - 1 == ktd) qk_only(p0, p1, ATT_KB(kt - 1), W);
        if (KIND == 1 && kt >= 1 && tid < 64) ATT_FB(kt - 1)[tid] = freg;
#ifdef TPROBE
        const unsigned long long tp2 = __builtin_readcyclecounter();
#endif
        asm volatile("s_waitcnt vmcnt(0)" ::: "memory");
#ifdef ATT_LDSFLUSH
        { unsigned dummy; asm volatile("ds_read_b32 %0, %1\n\ts_waitcnt lgkmcnt(0)" : "=v"(dummy) : "v"((unsigned)(uintptr_t)(lds + OFF_V + wid * 1024 + lane * 16)) : "memory"); }
#endif
        __syncthreads();
#ifdef TPROBE
        const unsigned long long tp3 = __builtin_readcyclecounter();
        tacc += (TPROBE == 1) ? (tp3 - tp2) : (TPROBE == 2) ? (tp3 - tp0) : (TPROBE == 3) ? (tp2 - tp1) : (tp1 - tp0);
        asm volatile("" :: "s"(tp0), "s"(tp1), "s"(tp2), "s"(tp3));
#endif
    }
#ifdef TPROBE
    if (blockIdx.x == TPROBE_BLK && tid == TPROBE_WAVE * 64) atomicAdd((unsigned long long*)T.tprobe, tacc);
#endif
#undef ATT_KB
#undef ATT_VB
#undef ATT_FB
#undef ATT_DMA
    if (KIND == 1) { const float inv = 1.0f / lsum;
#pragma unroll
        for (int r = 0; r < 16; ++r) { o0[r] *= inv; o1[r] *= inv; } }
    float ss = 0.f;
#pragma unroll
    for (int r = 0; r < 16; ++r) ss += o0[r] * o0[r] + o1[r] * o1[r];
    ss = half_sum(ss);
    const float rinv = 1.0f / sqrtf(ss * (1.0f / 64.0f) + EPS);
    const float* gp = T.ong + T.coly + h * 64 + 8 * W.hi;
    bf16* yp = T.ymix + (rowbase + W.qabs) * DM + T.coly + h * 64 + 8 * W.hi;
#pragma unroll
    for (int d0 = 0; d0 < 2; ++d0)
#pragma unroll
        for (int g = 0; g < 2; ++g) { const f32x4 ga = *(const f32x4*)(gp + 32 * d0 + 16 * g), gb = *(const f32x4*)(gp + 32 * d0 + 16 * g + 4);
            float v[8];
#pragma unroll
            for (int i = 0; i < 8; ++i) v[i] = (d0 == 0 ? o0[8 * g + i] : o1[8 * g + i]) * rinv * (i < 4 ? ga[i & 3] : gb[i & 3]);
            v4u w; w.x = pk_bf16(v[0], v[1]); w.y = pk_bf16(v[2], v[3]); w.z = pk_bf16(v[4], v[5]); w.w = pk_bf16(v[6], v[7]);
            *(v4u*)(yp + 32 * d0 + 16 * g) = w; }
}
}
constexpr size_t MiB = 1u << 20;
constexpr size_t WS_CTL = 0, CTL_ZERO_BYTES = 1 * MiB;
constexpr size_t WS_MODP = 1 * MiB;
constexpr size_t WS_TOPW = 3 * MiB;
constexpr size_t WS_ROUTE = WS_TOPW + 512 * 1024;
constexpr size_t WS_TOKSLOT = WS_ROUTE + 512 * 1024;
constexpr size_t WS_SLOTTOK = WS_TOKSLOT + 512 * 1024;
constexpr size_t WS_HIST = WS_SLOTTOK + 576 * 1024;
constexpr size_t WS_MOETAB = WS_HIST + 32 * 1024;
constexpr size_t WS_LOGF = 6 * MiB;
constexpr size_t WS_FCUM = 7 * MiB;
constexpr size_t WS_WIN = 8 * MiB, WS_WOUT = 20 * MiB, WS_W1 = 24 * MiB, WS_W2 = 280 * MiB;
constexpr size_t WS_H = 408 * MiB;
constexpr size_t WS_PROJ = 472 * MiB;
constexpr size_t WS_VT = 664 * MiB;
constexpr size_t WS_YMIX = 712 * MiB;
constexpr size_t WS_XA = 776 * MiB, WS_XB = 904 * MiB;
constexpr size_t WS_ACT = 1032 * MiB, WS_Y = 1304 * MiB, WS_H8 = 1576 * MiB, WS_END = 1608 * MiB;
static_assert(WS_MOETAB + 256 <= WS_LOGF && (size_t)NSLOT_MAX * 4 <= 576 * 1024 && (size_t)NSLOT_MAX * DM * 2 <= 272 * MiB, "ws map");
#ifndef P2_FP8
#define P2_FP8 0
#endif
constexpr int CW_BAR = 4096;

constexpr int RING_BYTES = 131072;
constexpr int MISC_OFF = RING_BYTES;
constexpr int LDS_BYTES = 147456;

#define RLX_AGENT __ATOMIC_RELAXED, __HIP_MEMORY_SCOPE_AGENT
__device__ __forceinline__ unsigned f2bf(float f) { unsigned u = __builtin_bit_cast(unsigned, f); return (u + 0x7fffu + ((u >> 16) & 1u)) >> 16; }
__device__ __forceinline__ unsigned pk2(float lo, float hi) { return f2bf(lo) | (f2bf(hi) << 16); }
__device__ __forceinline__ float bflo(unsigned u) { return __builtin_bit_cast(float, u << 16); }
__device__ __forceinline__ float bfhi(unsigned u) { return __builtin_bit_cast(float, u & 0xffff0000u); }
__device__ __forceinline__ int shxi(int v, int o, int lane) {
    if (o == 1) return __builtin_amdgcn_mov_dpp(v, 0xB1, 0xf, 0xf, true);
    if (o == 2) return __builtin_amdgcn_mov_dpp(v, 0x4E, 0xf, 0xf, true);
    if (o == 4) return __builtin_amdgcn_ds_swizzle(v, 0x101F);
    if (o == 8) return __builtin_amdgcn_ds_swizzle(v, 0x201F);
    if (o == 16) return __builtin_amdgcn_ds_swizzle(v, 0x401F);
    return __builtin_amdgcn_ds_bpermute((lane ^ o) << 2, v);
}
__device__ __forceinline__ float shx(float v, int o, int lane) { return __builtin_bit_cast(float, shxi(__builtin_bit_cast(int, v), o, lane)); }
__device__ __forceinline__ float shup(float v, int o, int lane) { return __builtin_bit_cast(float, __builtin_amdgcn_ds_bpermute(((lane - o) & 63) << 2, __builtin_bit_cast(int, v))); }
__device__ __forceinline__ float add_other_half(float v) { auto rr = __builtin_amdgcn_permlane32_swap(__float_as_uint(v), __float_as_uint(v), false, false); return __uint_as_float(rr[0]) + __uint_as_float(rr[1]); }
__device__ __forceinline__ float wave_sum(float v, int lane) {
    v += shx(v, 1, lane); v += shx(v, 2, lane); v += shx(v, 4, lane); v += shx(v, 8, lane); v += shx(v, 16, lane);
    return add_other_half(v);
}

#define XB_TMO      128
#define XB_XCNT(j)  (256  + 64 * (j))
#define XB_XSUB(j)  (1280 + 64 * (j))
#define XB_XGEN(j)  (2304 + 64 * (j))
#define XB_TOP      3328
#define XB_TOPGEN   3392
#define XCD_BAR_WORDS 3456
#define XB_SPIN_CAP (1u << 18)
__device__ __forceinline__ unsigned xb_ld(unsigned* p)              { return __hip_atomic_load(p, __ATOMIC_RELAXED, __HIP_MEMORY_SCOPE_AGENT); }
__device__ __forceinline__ unsigned xb_add(unsigned* p, unsigned v) { return __hip_atomic_fetch_add(p, v, __ATOMIC_RELAXED, __HIP_MEMORY_SCOPE_AGENT); }
__device__ __forceinline__ unsigned xb_xcc_id() { return (unsigned)__builtin_amdgcn_s_getreg((3 << 11) | 20) & 0xFu; }
#define XB_SPIN(cond, bar) do { unsigned _sp = 0; while (cond) { __builtin_amdgcn_s_sleep(1); \
    if ((++_sp & 255u) == 0u) { if (xb_ld(&(bar)[XB_TMO])) break; if (_sp > XB_SPIN_CAP) { atomicAdd(&(bar)[XB_TMO], 1u); break; } } } } while (0)
__device__ __forceinline__ int lane_id() { return (int)__builtin_amdgcn_mbcnt_hi(~0u, __builtin_amdgcn_mbcnt_lo(~0u, 0u)); }
struct XcdBarrier { unsigned* bar; unsigned x; volatile LAS unsigned* st; int wave; };
__device__ __forceinline__ XcdBarrier xcd_barrier_post(unsigned* bar, volatile LAS unsigned* st, int wave) {
    XcdBarrier b; b.bar = bar; b.x = (unsigned)__builtin_amdgcn_readfirstlane((int)xb_xcc_id()); b.st = st; b.wave = wave;
    if (wave == 0 && lane_id() == 0) (void)xb_add(&bar[XB_XCNT(b.x)], 1u);
    return b;
}
__device__ __forceinline__ void xcd_barrier_complete(unsigned* bar, unsigned x, unsigned& nloc, unsigned& nx) {
    const unsigned G = gridDim.x * gridDim.y * gridDim.z;
    unsigned sum, cnt, mine, sp = 0u;
    for (;;) {
        sum = 0u; cnt = 0u; mine = 0u;
#pragma unroll
        for (unsigned j = 0; j < 16; ++j) { const unsigned c = xb_ld(&bar[XB_XCNT(j)]); sum += c; cnt += (c > 0u) ? 1u : 0u; mine = (j == x) ? c : mine; }
        if (sum == G) break;
        __builtin_amdgcn_s_sleep(1);
        if ((++sp & 255u) == 0u) { if (xb_ld(&bar[XB_TMO])) break; if (sp > XB_SPIN_CAP) { atomicAdd(&bar[XB_TMO], 1u); break; } }
    }
    nloc = mine > 0u ? mine : 1u; nx = cnt > 0u ? cnt : 1u;
}
__device__ __forceinline__ void xcd_barrier(const XcdBarrier& b) {
    asm volatile("s_waitcnt vmcnt(0)" ::: "memory");
    __syncthreads();
    if (b.wave == 0 && lane_id() == 0) {
        unsigned* bar = b.bar; const unsigned bx = (unsigned)__builtin_amdgcn_readfirstlane((int)xb_xcc_id());
        __builtin_amdgcn_s_waitcnt(0);
        unsigned nloc = b.st[0], nx = b.st[1];
        if (nloc == 0u) { xcd_barrier_complete(bar, bx, nloc, nx); b.st[0] = nloc; b.st[1] = nx; }
        const unsigned old = xb_add(&bar[XB_XSUB(bx)], 1u);
        const unsigned gen = old / nloc;
        if (old + 1u == (gen + 1u) * nloc) {
            __builtin_amdgcn_fence(__ATOMIC_RELEASE, "agent");
            asm volatile("s_waitcnt vmcnt(0)" ::: "memory");
            const unsigned og = xb_add(&bar[XB_TOP], 1u);
            const unsigned tg = og / nx;
            if (og + 1u == (tg + 1u) * nx) xb_add(&bar[XB_TOPGEN], 1u);
            else XB_SPIN(xb_ld(&bar[XB_TOPGEN]) == tg, bar);
            __builtin_amdgcn_fence(__ATOMIC_ACQUIRE, "agent");
            xb_add(&bar[XB_XGEN(bx)], 1u);
            asm volatile("s_waitcnt vmcnt(0)" ::: "memory");
        } else {
            XB_SPIN(xb_ld(&bar[XB_XGEN(bx)]) == gen, bar);
            __builtin_amdgcn_fence(__ATOMIC_ACQUIRE, "agent");
            asm volatile("s_waitcnt vmcnt(0)" ::: "memory");
        }
    }
    __syncthreads();
}

struct Frame {
    LAS unsigned char* lds;
    int tid, lane, wave, blk, G;
    const float* in[21];
    float* out; unsigned char* ws;
};
enum { I_X = 0, I_C, I_N1G, I_WADA, I_BADA, I_WIN, I_CONVW, I_SBQG, I_SBKG, I_FXQG, I_FXKG, I_FXFB, I_ONG, I_WOUT, I_N2G, I_RW, I_RB, I_W1, I_B1, I_W2, I_B2 };

template <int MAP, bool WIDE, bool OUT8 = false>
__device__ __forceinline__ void p0_transpose_item(const float* W, int ldw, bf16* WT, LAS float* scr, int k0, int n0, int lane) {
    if (WIDE) {
        f32x4 t[8];
#pragma unroll
        for (int i = 0; i < 8; ++i) t[i] = __builtin_nontemporal_load((const f32x4*)(W + (size_t)(k0 + 8 * i + (lane >> 3)) * ldw + n0 + 4 * (lane & 7)));
#pragma unroll
        for (int i = 0; i < 8; ++i) { LAS float* d = scr + (8 * i + (lane >> 3)) * 33 + 4 * (lane & 7); d[0] = t[i].x; d[1] = t[i].y; d[2] = t[i].z; d[3] = t[i].w; }
    } else {
#pragma unroll 8
        for (int i = 0; i < 32; ++i) { const int kk = 2 * i + (lane >> 5); scr[kk * 33 + (lane & 31)] = W[(size_t)(k0 + kk) * ldw + n0 + (lane & 31)]; }
    }
    asm volatile("s_waitcnt lgkmcnt(0)" ::: "memory");
    const int c = lane & 7;
#pragma unroll
    for (int j = 0; j < 4; ++j) { const int n = (lane >> 3) + 8 * j; const LAS float* s = scr + (8 * c) * 33 + n;
        v4u o; o.x = pk2(s[0 * 33], s[1 * 33]); o.y = pk2(s[2 * 33], s[3 * 33]); o.z = pk2(s[4 * 33], s[5 * 33]); o.w = pk2(s[6 * 33], s[7 * 33]);
        const int cn = n0 + n; int row = cn;
        if (MAP == 1) { const int jj = cn >> 1, t = cn & 1; row = 256 * (jj >> 7) + 128 * t + (jj & 127); }
        if (OUT8) { v2u o8; o8.x = pg8::pk4_fp8(32.0f * s[0 * 33], 32.0f * s[1 * 33], 32.0f * s[2 * 33], 32.0f * s[3 * 33]); o8.y = pg8::pk4_fp8(32.0f * s[4 * 33], 32.0f * s[5 * 33], 32.0f * s[6 * 33], 32.0f * s[7 * 33]);
            *(v2u*)((unsigned char*)WT + (size_t)row * 1024 + k0 + 8 * c) = o8; }
        else *(v4u*)(WT + (size_t)row * 1024 + k0 + 8 * c) = o; }
    asm volatile("s_waitcnt lgkmcnt(0)" ::: "memory");
}
__device__ __forceinline__ void p0_prologue(Frame& F) {
    LAS float* scr = (LAS float*)(F.lds + F.wave * 16384);
    const int gw = F.blk * 8 + F.wave, NGW = F.G * 8;
    constexpr int N_ADA = NLAYER * 4 * 24;
    if (F.blk * 8 < N_ADA) {
        LAS float* sl = (LAS float*)(F.lds + 8 * 16384 - 32768);
        for (int i = F.tid; i < NB * DM; i += 512) { const float cv = F.in[I_C][i]; sl[i] = cv / (1.0f + __expf(-cv)); }
        __syncthreads();
        if (gw < N_ADA) {
            const int it = gw; const int l = it / 96, ks = (it / 24) & 3, nc = it % 24;
            const float* W = F.in[I_WADA] + (size_t)l * DM * 6144 + nc * 256 + F.lane * 4;
            f32x4 acc[NB];
#pragma unroll
            for (int b = 0; b < NB; ++b) acc[b] = (f32x4){0.f, 0.f, 0.f, 0.f};
#pragma unroll 8
            for (int k = ks * 256; k < ks * 256 + 256; ++k) {
                const f32x4 w = __builtin_nontemporal_load((const f32x4*)(W + (size_t)k * 6144));
#pragma unroll
                for (int b = 0; b < NB; ++b) acc[b] += w * sl[b * DM + k];
            }
            float* dst = (float*)(F.ws + WS_MODP) + ((size_t)(l * 4 + ks) * NB) * 6144 + nc * 256 + F.lane * 4;
#pragma unroll
            for (int b = 0; b < NB; ++b) *(f32x4*)(dst + (size_t)b * 6144) = acc[b];
        }
        __syncthreads();
    }
    constexpr int I_IN = 16 * 96, I_OUT = 16 * 32, I_1 = 16 * 64, I_2 = 16 * 32;
    constexpr int N_IN = NLAYER * I_IN, N_OUT = NLAYER * I_OUT, N_1 = NLAYER * NEXP * I_1, N_2 = NLAYER * NEXP * I_2;
#pragma unroll 1
    for (int it = gw; it < N_IN + N_OUT; it += NGW) {
        int r = it;
        if (r < N_IN) { const int l = r / I_IN, q = r % I_IN, kb = q / 96, nb = q % 96;
            p0_transpose_item<0, false, P2_FP8>(F.in[I_WIN] + (size_t)l * DM * D_IN, D_IN, (bf16*)(F.ws + WS_WIN + (size_t)l * NPROJ * DM * (P2_FP8 ? 1 : 2)), scr, 64 * kb, 32 * nb, F.lane); continue; }
        r -= N_IN;
        { const int l = r / I_OUT, q = r % I_OUT, kb = q / 32, nb = q % 32;
            p0_transpose_item<0, true>(F.in[I_WOUT] + (size_t)l * DM * DM, DM, (bf16*)(F.ws + WS_WOUT) + (size_t)l * DM * DM, scr, 64 * kb, 32 * nb, F.lane); }
    }
    constexpr int ADA_SKIP = 6, NE = N_1 + N_2;
    const bool adaw = gw < N_ADA; const int pool = adaw ? -1 : (gw - N_ADA < N_ADA * ADA_SKIP ? gw - N_ADA : -1);
    const int pool_it = (pool >= 0) ? (pool % N_ADA) + (pool / N_ADA) * NGW : -1;
    f32x4 cur[8], nxt[8];
#define P0_LOAD(dst, itx_) do { const int it_ = ((itx_) < 0) ? pool_it : (itx_); const float* s_; int ldw_; \
        if (it_ < N_1) { const int le = it_ / I_1, q = it_ % I_1, kb = q / 64, nb = q % 64; ldw_ = 2048; s_ = F.in[I_W1] + (size_t)le * DM * 2048 + (size_t)(64 * kb + (F.lane >> 3)) * 2048 + 32 * nb + 4 * (F.lane & 7); } \
        else { const int r_ = it_ - N_1; const int le = r_ / I_2, q = r_ % I_2, kb = q / 32, nb = q % 32; ldw_ = DM; s_ = F.in[I_W2] + (size_t)le * DM * DM + (size_t)(64 * kb + (F.lane >> 3)) * DM + 32 * nb + 4 * (F.lane & 7); } \
        _Pragma("unroll") for (int i = 0; i < 8; ++i) dst[i] = __builtin_nontemporal_load((const f32x4*)(s_ + (size_t)(8 * i) * ldw_)); } while (0)
    int itx = adaw ? gw + ADA_SKIP * NGW : (pool >= 0 ? gw - NGW : gw);
    if (itx < NE) P0_LOAD(cur, itx);
#pragma unroll 1
    for (; itx < NE; itx += NGW) {
        if (itx + NGW < NE) P0_LOAD(nxt, itx + NGW);
#pragma unroll
        for (int i = 0; i < 8; ++i) { LAS float* d = scr + (8 * i + (F.lane >> 3)) * 33 + 4 * (F.lane & 7); d[0] = cur[i].x; d[1] = cur[i].y; d[2] = cur[i].z; d[3] = cur[i].w; }
        asm volatile("s_waitcnt lgkmcnt(0)" ::: "memory");
        { const int it = (itx < 0) ? pool_it : itx; const bool isw1 = it < N_1; const int r = isw1 ? it : it - N_1;
          const int per = isw1 ? I_1 : I_2, nbn = isw1 ? 64 : 32; const int le = r / per, q = r % per, kb = q / nbn, nb = q % nbn;
          unsigned char* WT = isw1 ? F.ws + WS_W1 + (size_t)le * 2048 * DM : F.ws + WS_W2 + (size_t)le * DM * DM;
          const int c = F.lane & 7;
#pragma unroll
          for (int j = 0; j < 4; ++j) { const int n = (F.lane >> 3) + 8 * j; const LAS float* s = scr + (8 * c) * 33 + n;
              v2u o8; o8.x = pg8::pk4_fp8(32.0f * s[0 * 33], 32.0f * s[1 * 33], 32.0f * s[2 * 33], 32.0f * s[3 * 33]); o8.y = pg8::pk4_fp8(32.0f * s[4 * 33], 32.0f * s[5 * 33], 32.0f * s[6 * 33], 32.0f * s[7 * 33]);
              const int cn = 32 * nb + n; int row = cn;
              if (isw1) { const int jj = cn >> 1, t = cn & 1; row = 256 * (jj >> 7) + 128 * t + (jj & 127); }
              *(v2u*)(WT + (size_t)row * 1024 + 64 * kb + 8 * c) = o8; } }
        asm volatile("s_waitcnt lgkmcnt(0)" ::: "memory");
#pragma unroll
        for (int i = 0; i < 8; ++i) cur[i] = nxt[i];
    }
#undef P0_LOAD
}

__device__ __forceinline__ f32x4 mod4(const Frame& F, int l, int b, int which, int c) {
    const int n = which * DM + c;
    f32x4 s = *(const f32x4*)(F.in[I_BADA] + (size_t)l * 6144 + n);
    const float* p = (const float*)(F.ws + WS_MODP) + ((size_t)(l * 4) * NB + b) * 6144 + n;
#pragma unroll
    for (int ks = 0; ks < 4; ++ks) s += *(const f32x4*)(p + (size_t)ks * NB * 6144);
    return s;
}

constexpr size_t WS_GSUM = WS_FCUM + 800 * 1024;
static_assert(WS_GSUM + 16384 <= WS_WIN, "ws map");
template <bool S16> __device__ __forceinline__ f32x4 ld_row4(const void* base, size_t idx) {
    if (S16) { const v2u t = *(const v2u*)((const bf16*)base + idx); return (f32x4){bflo(t.x), bfhi(t.x), bflo(t.y), bfhi(t.y)}; }
    return *(const f32x4*)((const float*)base + idx); }
template <bool D16> __device__ __forceinline__ void st_row4(void* base, size_t idx, f32x4 v) {
    if (D16) { v2u o; o.x = pk2(v.x, v.y); o.y = pk2(v.z, v.w); *(v2u*)((bf16*)base + idx) = o; }
    else *(f32x4*)((float*)base + idx) = v; }
__device__ __forceinline__ f32x4 fp8x4_to_f32(unsigned w) { return (f32x4){__builtin_amdgcn_cvt_f32_fp8(w, 0), __builtin_amdgcn_cvt_f32_fp8(w, 1), __builtin_amdgcn_cvt_f32_fp8(w, 2), __builtin_amdgcn_cvt_f32_fp8(w, 3)}; }
template <bool COMBINE, bool NORM, bool S16, bool D16>
__device__ __forceinline__ void row_phase(Frame& F, int l, const void* xsrc, void* xdst) {
    const float* topw = (const float*)(F.ws + WS_TOPW); const int* tokslot = (const int*)(F.ws + WS_TOKSLOT); const unsigned char* Y = F.ws + WS_Y;
    bf16* H = (bf16*)(F.ws + WS_H); float* logf = (float*)(F.ws + WS_LOGF); float* gsum = (float*)(F.ws + WS_GSUM);
    LAS f32x4* wl4 = (LAS f32x4*)F.lds; LAS f32x2* wl2 = (LAS f32x2*)(F.lds + 16384); LAS float* part = (LAS float*)(F.lds + 16384 + 8192);
    if (NORM) { for (int k = F.tid; k < DM; k += 512) { const float* wp = F.in[I_WIN] + (size_t)l * DM * D_IN + (size_t)k * D_IN + NPROJ; const int idx = (4 * (k >> 8) + (k & 3)) * 64 + ((k >> 2) & 63);
            wl4[idx] = (f32x4){wp[0], wp[1], wp[2], wp[3]}; wl2[idx] = (f32x2){wp[4], wp[5]}; }
        __syncthreads(); }
    for (int chunk = F.blk; chunk < NTOK / 128; chunk += F.G) {
        const int b = chunk / (SEQ / 128);
        LAS f32x4* mv = (LAS f32x4*)(F.lds + 32768);
        __syncthreads();
        if (F.wave == 0) {
#pragma unroll
            for (int j = 0; j < 4; ++j) { const int c = 256 * j + 4 * F.lane;
                if (COMBINE) mv[(0 * 4 + j) * 64 + F.lane] = mod4(F, l - 1, b, 5, c);
                if (NORM) { const f32x4 g = *(const f32x4*)(F.in[I_N1G] + (size_t)l * DM + c); mv[(1 * 4 + j) * 64 + F.lane] = g * (mod4(F, l, b, 1, c) + 1.0f); mv[(2 * 4 + j) * 64 + F.lane] = mod4(F, l, b, 0, c); } } }
        __syncthreads();
        float lacc = 0.f;
#pragma unroll 1
        for (int rr = 0; rr < 16; rr += 2) {
            const int row = chunk * 128 + F.wave * 16 + rr;
            f32x4 v[2][4];
#pragma unroll
            for (int u = 0; u < 2; ++u)
#pragma unroll
                for (int j = 0; j < 4; ++j) v[u][j] = ld_row4<S16>(xsrc, (size_t)(row + u) * DM + 256 * j + 4 * F.lane);
            int mofs = F.lane; asm volatile("" : "+v"(mofs));
            if (COMBINE) {
#pragma unroll
                for (int u = 0; u < 2; ++u) {
                    f32x4 s[4];
#pragma unroll
                    for (int j = 0; j < 4; ++j) s[j] = (f32x4){0.f, 0.f, 0.f, 0.f};
#pragma unroll
                    for (int k = 0; k < TOPK; ++k) { const float w = topw[(row + u) * 4 + k]; const int slot = tokslot[(row + u) * 4 + k];
#pragma unroll
                        for (int j = 0; j < 4; ++j) s[j] += fp8x4_to_f32(*(const unsigned*)(Y + (size_t)slot * DM + 256 * j + 4 * F.lane)) * w; }
#pragma unroll
                    for (int j = 0; j < 4; ++j) { v[u][j] += mv[(0 * 4 + j) * 64 + mofs] * s[j]; st_row4<D16>(xdst, (size_t)(row + u) * DM + 256 * j + 4 * F.lane, v[u][j]); }
                }
            }
            if (NORM) {
                float ss[2];
#pragma unroll
                for (int u = 0; u < 2; ++u) { float s = 0.f;
#pragma unroll
                    for (int j = 0; j < 4; ++j) s += (v[u][j].x * v[u][j].x + v[u][j].y * v[u][j].y) + (v[u][j].z * v[u][j].z + v[u][j].w * v[u][j].w);
                    ss[u] = s; }
#pragma unroll
                for (int o = 1; o < 32; o <<= 1) { ss[0] += shx(ss[0], o, F.lane); ss[1] += shx(ss[1], o, F.lane); }
                ss[0] = add_other_half(ss[0]); ss[1] = add_other_half(ss[1]);
                float fl[2][6];
                int lofs = F.lane; asm volatile("" : "+v"(lofs));
#pragma unroll
                for (int u = 0; u < 2; ++u) { const float rstd = 1.0f / sqrtf(ss[u] * (1.0f / DM) + EPS);
#pragma unroll
                    for (int q = 0; q < 6; ++q) fl[u][q] = 0.f;
#pragma unroll
                    for (int j = 0; j < 4; ++j) { const f32x4 hv = v[u][j] * rstd * mv[(1 * 4 + j) * 64 + mofs] + mv[(2 * 4 + j) * 64 + mofs];
                        if (P2_FP8) *(unsigned*)((unsigned char*)H + (size_t)(row + u) * DM + 256 * j + 4 * F.lane) = pg8::pk4_fp8(hv.x, hv.y, hv.z, hv.w);
                        else { v2u o; o.x = pk2(hv.x, hv.y); o.y = pk2(hv.z, hv.w); *(v2u*)(H + (size_t)(row + u) * DM + 256 * j + 4 * F.lane) = o; }
#pragma unroll
                        for (int i = 0; i < 4; ++i) { const f32x4 wa = wl4[(4 * j + i) * 64 + lofs]; const f32x2 wb = wl2[(4 * j + i) * 64 + lofs]; const float hx = hv[i];
                            fl[u][0] += hx * wa.x; fl[u][1] += hx * wa.y; fl[u][2] += hx * wa.z; fl[u][3] += hx * wa.w; fl[u][4] += hx * wb.x; fl[u][5] += hx * wb.y; } } }
#pragma unroll
                for (int o = 1; o < 32; o <<= 1)
#pragma unroll
                    for (int u = 0; u < 2; ++u)
#pragma unroll
                        for (int q = 0; q < 6; ++q) fl[u][q] += shx(fl[u][q], o, F.lane);
#pragma unroll
                for (int u = 0; u < 2; ++u)
#pragma unroll
                    for (int q = 0; q < 6; ++q) fl[u][q] = add_other_half(fl[u][q]);
                if (F.lane < 6) {
#pragma unroll
                    for (int u = 0; u < 2; ++u) { float z = fl[u][0];
#pragma unroll
                        for (int q = 1; q < 6; ++q) z = (F.lane == q) ? fl[u][q] : z;
                        z += F.in[I_FXFB][l * 6 + F.lane];
                        const float lg = fminf(z, 0.f) - __logf(1.0f + __expf(-fabsf(z)));
                        logf[(size_t)(row + u) * 6 + F.lane] = lg; lacc += lg; } }
            }
        }
        if (NORM) {
            if (F.lane < 6) part[F.wave * 8 + F.lane] = lacc;
            __syncthreads();
            if (F.tid < 12) { const int g = F.tid / 6, h = F.tid % 6; gsum[(size_t)(chunk * 2 + g) * 6 + h] = (part[(4 * g) * 8 + h] + part[(4 * g + 1) * 8 + h]) + (part[(4 * g + 2) * 8 + h] + part[(4 * g + 3) * 8 + h]); }
            __syncthreads();
        }
    }
    __syncthreads();
}
__device__ __forceinline__ void p3_postproj(Frame& F, int l) {
    bf16* proj = (bf16*)(F.ws + WS_PROJ); bf16* ymix = (bf16*)(F.ws + WS_YMIX);
    const float* ong = F.in[I_ONG] + (size_t)l * DM;
    const int c4 = 4 * F.lane;
    f32x4 cw[3];
#pragma unroll
    for (int w = 0; w < 3; ++w) cw[w] = *(const f32x4*)(F.in[I_CONVW] + (size_t)(l * 3 + w) * 256 + c4);
    const f32x4 cg = *(const f32x4*)(ong + c4);
    const int e0 = 8 * (F.lane & 7);
    float gq[3][8]; int colv[3];
#pragma unroll
    for (int i = 0; i < 3; ++i) { const int vi = 8 * i + (F.lane >> 3); const int ty = vi / 6;
        colv[i] = (vi < 12 ? COL_SQ + 64 * vi : COL_FQ + 64 * (vi - 12)) + e0;
        const float* gp = (ty == 0 ? F.in[I_SBQG] : ty == 1 ? F.in[I_SBKG] : ty == 2 ? F.in[I_FXQG] : F.in[I_FXKG]) + (size_t)l * 64 + e0; const float sc = (ty == 0 || ty == 2) ? QSCALE : 1.0f;
#pragma unroll
        for (int q = 0; q < 8; ++q) gq[i][q] = gp[q] * sc; }
    LAS unsigned char* scr = F.lds + F.wave * (64 * 144);
    for (int tile = F.blk; tile < NTOK / 64; tile += F.G) {
        const int b = tile / (SEQ / 64), s0 = (tile % (SEQ / 64)) * 64; const size_t row0 = (size_t)b * SEQ + s0;
        {
            const int sw0 = s0 + F.wave * 8;
            f32x4 vm2 = (f32x4){0.f, 0.f, 0.f, 0.f}, vm1 = vm2;
            if (sw0 >= 2) {
                const bf16* p2 = proj + ((size_t)b * SEQ + sw0 - 2) * NPROJ; const bf16* p1 = p2 + NPROJ;
                const v2u c2 = *(const v2u*)(p2 + COL_CC + c4), u2 = *(const v2u*)(p2 + COL_CU + c4), c1 = *(const v2u*)(p1 + COL_CC + c4), u1 = *(const v2u*)(p1 + COL_CU + c4);
                vm2 = (f32x4){bflo(c2.x) * bflo(u2.x), bfhi(c2.x) * bfhi(u2.x), bflo(c2.y) * bflo(u2.y), bfhi(c2.y) * bfhi(u2.y)};
                vm1 = (f32x4){bflo(c1.x) * bflo(u1.x), bfhi(c1.x) * bfhi(u1.x), bflo(c1.y) * bflo(u1.y), bfhi(c1.y) * bfhi(u1.y)}; }
#pragma unroll 1
            for (int tt = 0; tt < 8; tt += 2) {
                bf16* pr[2]; v2u cb[2], cc[2], cu[2]; v4u xq[2][3];
#pragma unroll
                for (int u = 0; u < 2; ++u) { pr[u] = proj + ((size_t)b * SEQ + sw0 + tt + u) * NPROJ;
                    cb[u] = *(const v2u*)(pr[u] + COL_CB + c4); cc[u] = *(const v2u*)(pr[u] + COL_CC + c4); cu[u] = *(const v2u*)(pr[u] + COL_CU + c4);
#pragma unroll
                    for (int i = 0; i < 3; ++i) xq[u][i] = *(const v4u*)(pr[u] + colv[i]); }
                f32x4 y[2]; float ss[2], q2[2][3];
#pragma unroll
                for (int u = 0; u < 2; ++u) {
                    const f32x4 v0 = (f32x4){bflo(cc[u].x) * bflo(cu[u].x), bfhi(cc[u].x) * bfhi(cu[u].x), bflo(cc[u].y) * bflo(cu[u].y), bfhi(cc[u].y) * bfhi(cu[u].y)};
                    y[u] = cw[0] * vm2 + cw[1] * vm1 + cw[2] * v0; vm2 = vm1; vm1 = v0;
                    y[u] = y[u] * (f32x4){bflo(cb[u].x), bfhi(cb[u].x), bflo(cb[u].y), bfhi(cb[u].y)};
                    ss[u] = (y[u].x * y[u].x + y[u].y * y[u].y) + (y[u].z * y[u].z + y[u].w * y[u].w);
#pragma unroll
                    for (int i = 0; i < 3; ++i) { const v4u x = xq[u][i]; const float f[8] = {bflo(x.x), bfhi(x.x), bflo(x.y), bfhi(x.y), bflo(x.z), bfhi(x.z), bflo(x.w), bfhi(x.w)};
                        float a = 0.f;
#pragma unroll
                        for (int k = 0; k < 8; ++k) a += f[k] * f[k];
                        q2[u][i] = a; } }
#pragma unroll
                for (int o = 1; o < 16; o <<= 1)
#pragma unroll
                    for (int u = 0; u < 2; ++u) { ss[u] += shx(ss[u], o, F.lane);
                        if (o < 8) {
#pragma unroll
                            for (int i = 0; i < 3; ++i) q2[u][i] += shx(q2[u][i], o, F.lane); } }
#pragma unroll
                for (int u = 0; u < 2; ++u) {
                    const float rinv = 1.0f / sqrtf(ss[u] * (1.0f / 64.0f) + EPS);
                    const f32x4 yo = y[u] * rinv * cg;
                    v2u o; o.x = pk2(yo.x, yo.y); o.y = pk2(yo.z, yo.w); *(v2u*)(ymix + ((size_t)b * SEQ + sw0 + tt + u) * DM + c4) = o;
#pragma unroll
                    for (int i = 0; i < 3; ++i) { const v4u x = xq[u][i]; const float f[8] = {bflo(x.x), bfhi(x.x), bflo(x.y), bfhi(x.y), bflo(x.z), bfhi(x.z), bflo(x.w), bfhi(x.w)};
                        const float ri = 1.0f / sqrtf(q2[u][i] * (1.0f / 64.0f) + EPS);
                        v4u w; w.x = pk2(f[0] * ri * gq[i][0], f[1] * ri * gq[i][1]); w.y = pk2(f[2] * ri * gq[i][2], f[3] * ri * gq[i][3]);
                        w.z = pk2(f[4] * ri * gq[i][4], f[5] * ri * gq[i][5]); w.w = pk2(f[6] * ri * gq[i][6], f[7] * ri * gq[i][7]);
                        *(v4u*)(pr[u] + colv[i]) = w; } }
            }
        }
        for (int t = F.wave; t < 12; t += 8) {
            const int kind = t / 6, h = t % 6; const int col = (kind ? COL_FV : COL_SV) + 64 * h;
            const bf16* src = proj + (row0 + F.lane) * NPROJ + col;
#pragma unroll
            for (int pc = 0; pc < 8; ++pc) { const v4u x = *(const v4u*)(src + 8 * pc);
                const unsigned xs[4] = {x.x, x.y, x.z, x.w};
#pragma unroll
                for (int q = 0; q < 4; ++q) { *(LAS unsigned short*)(scr + (8 * pc + 2 * q) * 144 + 2 * F.lane) = (unsigned short)(xs[q] & 0xffffu);
                                              *(LAS unsigned short*)(scr + (8 * pc + 2 * q + 1) * 144 + 2 * F.lane) = (unsigned short)(xs[q] >> 16); } }
            asm volatile("s_waitcnt lgkmcnt(0)" ::: "memory");
            bf16* dst = (bf16*)(F.ws + WS_VT) + (size_t)kind * (48 * 64 * SEQ) + ((size_t)(b * 6 + h) * 64 + F.lane) * SEQ + s0;
#pragma unroll
            for (int pc = 0; pc < 8; ++pc) *(v4u*)(dst + 8 * pc) = *(const LAS v4u*)(scr + F.lane * 144 + 16 * pc);
            asm volatile("s_waitcnt lgkmcnt(0)" ::: "memory");
        }
        if (F.wave == 7) { const int gt = tile % (SEQ / 64); const float* gs = (const float*)(F.ws + WS_GSUM) + (size_t)(b * (SEQ / 64)) * 6; const float* lf = (const float*)(F.ws + WS_LOGF) + (row0 + F.lane) * 6;
            float* fo = (float*)(F.ws + WS_FCUM) + (size_t)(b * 6) * SEQ + s0 + F.lane;
#pragma unroll
            for (int h = 0; h < 6; ++h) { float base = (F.lane < gt) ? gs[F.lane * 6 + h] : 0.f; base = wave_sum(base, F.lane);
                float inc = lf[h];
#pragma unroll
                for (int o = 1; o < 64; o <<= 1) { const float t = shup(inc, o, F.lane); if (F.lane >= o) inc += t; }
                fo[(size_t)h * SEQ] = (base + inc) * LOG2E; } }
    }
}

__device__ __forceinline__ void p4_attention(Frame& F, int l) {
    att::Tensors Ts, Tf;
    Ts.proj = (const bf16*)(F.ws + WS_PROJ); Ts.vt = (const bf16*)(F.ws + WS_VT); Ts.fcum = (const float*)(F.ws + WS_FCUM); Ts.ymix = (bf16*)(F.ws + WS_YMIX); Ts.ong = F.in[I_ONG] + (size_t)l * DM;
    Ts.colq = COL_SQ; Ts.colk = COL_SK; Ts.coly = 256; Ts.tprobe = (void*)(F.ws + WS_CTL + 512);
    Tf = Ts; Tf.vt = Ts.vt + (size_t)48 * 64 * SEQ; Tf.colq = COL_FQ; Tf.colk = COL_FK; Tf.coly = 640;
    const int NU = 48 * 16;
    for (int i = 0; i * F.G < NU; ++i) {
        const int L = (i & 1) ? (i + 1) * F.G - 1 - F.blk : i * F.G + F.blk;
        if (L >= NU) continue;
        const int qb = 15 - L / 48, bh = L % 48;
#if defined(ATT_HYB) && (ATT_HYB & 1)
        { att_old::Tensors To; To.proj = Ts.proj; To.ymix = Ts.ymix; To.ong = Ts.ong; To.fcum = Ts.fcum; To.vt = Ts.vt; To.colq = Ts.colq; To.colk = Ts.colk; To.coly = Ts.coly; att_old::unit<0>(To, bh / 6, bh % 6, qb, F.lds, F.wave); }
#else
        att::unit<0>(Ts, bh / 6, bh % 6, qb, F.lds, F.wave);
#endif
    }
    for (int i = 0; i * F.G < NU; ++i) {
        const int L = (i & 1) ? (i + 1) * F.G - 1 - F.blk : i * F.G + F.blk;
        if (L >= NU) continue;
        const int qb = 15 - L / 48, bh = L % 48;
#if defined(ATT_HYB) && (ATT_HYB & 2)
        { att_old::Tensors To; To.proj = Tf.proj; To.ymix = Tf.ymix; To.ong = Tf.ong; To.fcum = Tf.fcum; To.vt = Tf.vt; To.colq = Tf.colq; To.colk = Tf.colk; To.coly = Tf.coly; att_old::unit<1>(To, bh / 6, bh % 6, qb, F.lds, F.wave); }
#else
        att::unit<1>(Tf, bh / 6, bh % 6, qb, F.lds, F.wave);
#endif
    }
}

__device__ __forceinline__ void top4of8(const float (&v)[8], const int (&ix)[8], float (&tv)[4], int (&ti)[4]) {
    float w[8];
#pragma unroll
    for (int j = 0; j < 8; ++j) w[j] = v[j];
#pragma unroll
    for (int k = 0; k < 4; ++k) { float bv = w[0]; int bi = ix[0];
#pragma unroll
        for (int j = 1; j < 8; ++j) { const bool t = (w[j] > bv) || (w[j] == bv && ix[j] < bi); bv = t ? w[j] : bv; bi = t ? ix[j] : bi; }
        tv[k] = bv; ti[k] = bi;
#pragma unroll
        for (int j = 0; j < 8; ++j) w[j] = (ix[j] == bi) ? -INFINITY : w[j]; }
}
__device__ __forceinline__ void p6_norm_router(Frame& F, int l, const bf16* x1) {
    bf16* H = (bf16*)(F.ws + WS_H); unsigned char* H8 = F.ws + WS_H8; float* topw = (float*)(F.ws + WS_TOPW); int* route = (int*)(F.ws + WS_ROUTE); int* hist = (int*)(F.ws + WS_HIST);
    const float* rw = F.in[I_RW] + (size_t)l * DM * NEXP; const float* rb = F.in[I_RB] + (size_t)l * NEXP;
    constexpr int RWP = 2064;
    LAS unsigned char* rwt = F.lds;
    LAS int* cnt = (LAS int*)(F.lds + MISC_OFF + 256);
    {
        f32x4 t[16];
#pragma unroll
        for (int i = 0; i < 16; ++i) t[i] = *(const f32x4*)(rw + (size_t)(2 * F.tid) * NEXP + 4 * i);
#pragma unroll
        for (int i = 0; i < 8; ++i)
#pragma unroll
            for (int c = 0; c < 4; ++c) *(LAS unsigned*)(rwt + (4 * i + c) * RWP + 4 * F.tid) = f2bf(t[i][c]) | (f2bf(t[8 + i][c]) << 16);
    }
    __syncthreads();
    const int fr = F.lane & 15, fq = F.lane >> 4;
    float rbv[8]; int eix[8];
#pragma unroll
    for (int i = 0; i < 4; ++i) { eix[i] = 4 * fq + i; eix[4 + i] = 16 + 4 * fq + i; rbv[i] = rb[4 * fq + i]; rbv[4 + i] = rb[16 + 4 * fq + i]; }
    for (int chunk = F.blk; chunk < NTOK / 128; chunk += F.G) {
        const int b = chunk / (SEQ / 128);
        if (F.tid < 32) cnt[F.tid] = 0;
        __syncthreads();
        f32x4 A[4], Bv[4];
#pragma unroll
        for (int j = 0; j < 4; ++j) { const int c = 256 * j + 4 * F.lane; const f32x4 g = *(const f32x4*)(F.in[I_N2G] + (size_t)l * DM + c); A[j] = g * (mod4(F, l, b, 4, c) + 1.0f); Bv[j] = mod4(F, l, b, 3, c); }
        const int row0 = chunk * 128 + F.wave * 16;
#pragma unroll 1
        for (int rr = 0; rr < 16; rr += 2) {
            f32x4 v[2][4]; float ss[2];
#pragma unroll
            for (int u = 0; u < 2; ++u)
#pragma unroll
                for (int j = 0; j < 4; ++j) v[u][j] = ld_row4<true>(x1, (size_t)(row0 + rr + u) * DM + 256 * j + 4 * F.lane);
#pragma unroll
            for (int u = 0; u < 2; ++u) { float s = 0.f;
#pragma unroll
                for (int j = 0; j < 4; ++j) s += (v[u][j].x * v[u][j].x + v[u][j].y * v[u][j].y) + (v[u][j].z * v[u][j].z + v[u][j].w * v[u][j].w);
                ss[u] = s; }
#pragma unroll
            for (int o = 1; o < 32; o <<= 1) { ss[0] += shx(ss[0], o, F.lane); ss[1] += shx(ss[1], o, F.lane); }
            ss[0] = add_other_half(ss[0]); ss[1] = add_other_half(ss[1]);
#pragma unroll
            for (int u = 0; u < 2; ++u) { const float rstd = 1.0f / sqrtf(ss[u] * (1.0f / DM) + EPS);
#pragma unroll
                for (int j = 0; j < 4; ++j) { const f32x4 hv = v[u][j] * rstd * A[j] + Bv[j];
                    v2u o; o.x = pk2(hv.x, hv.y); o.y = pk2(hv.z, hv.w); *(v2u*)(H + (size_t)(row0 + rr + u) * DM + 256 * j + 4 * F.lane) = o;
                    *(unsigned*)(H8 + (size_t)(row0 + rr + u) * DM + 256 * j + 4 * F.lane) = pg8::pk4_fp8(hv.x, hv.y, hv.z, hv.w); } }
        }
        asm volatile("s_waitcnt vmcnt(0)" ::: "memory");
        f32x4 acc0 = (f32x4){0.f, 0.f, 0.f, 0.f}, acc1 = (f32x4){0.f, 0.f, 0.f, 0.f};
        { const bf16* hp = H + (size_t)(row0 + fr) * DM + 8 * fq; const LAS unsigned char* wp = rwt + fr * RWP + 16 * fq;
#pragma unroll 8
          for (int s = 0; s < 32; ++s) { const v4u hb = __builtin_nontemporal_load((const v4u*)(hp + 32 * s));
              const bf16x8 a0 = *(const LAS bf16x8*)(wp + 64 * s), a1 = *(const LAS bf16x8*)(wp + 16 * RWP + 64 * s);
              acc0 = __builtin_amdgcn_mfma_f32_16x16x32_bf16(a0, __builtin_bit_cast(bf16x8, hb), acc0, 0, 0, 0);
              acc1 = __builtin_amdgcn_mfma_f32_16x16x32_bf16(a1, __builtin_bit_cast(bf16x8, hb), acc1, 0, 0, 0); } }
        float cv[8], tv[4], ov[8]; int ti[4], oi[8];
#pragma unroll
        for (int i = 0; i < 4; ++i) { cv[i] = acc0[i] + rbv[i]; cv[4 + i] = acc1[i] + rbv[4 + i]; }
        top4of8(cv, eix, tv, ti);
        {
#pragma unroll
            for (int k = 0; k < 4; ++k) { ov[k] = tv[k]; oi[k] = ti[k]; ov[4 + k] = shx(tv[k], 16, F.lane); oi[4 + k] = shxi(ti[k], 16, F.lane); }
            top4of8(ov, oi, tv, ti);
#pragma unroll
            for (int k = 0; k < 4; ++k) { auto rv = __builtin_amdgcn_permlane32_swap(__float_as_uint(tv[k]), __float_as_uint(tv[k]), false, false); auto ri = __builtin_amdgcn_permlane32_swap((unsigned)ti[k], (unsigned)ti[k], false, false);
                ov[k] = __uint_as_float(rv[0]); oi[k] = (int)ri[0]; ov[4 + k] = __uint_as_float(rv[1]); oi[4 + k] = (int)ri[1]; }
            top4of8(ov, oi, tv, ti); }
        const float e1 = __expf(tv[1] - tv[0]), e2 = __expf(tv[2] - tv[0]), e3 = __expf(tv[3] - tv[0]); const float inv = 1.0f / (1.0f + e1 + e2 + e3);
        { const int row = row0 + fr, k = fq;
          const float w = (k == 0 ? 1.0f : k == 1 ? e1 : k == 2 ? e2 : e3) * inv; const int ex = (k == 0 ? ti[0] : k == 1 ? ti[1] : k == 2 ? ti[2] : ti[3]);
          const int pos = __hip_atomic_fetch_add(cnt + ex, 1, __ATOMIC_RELAXED, __HIP_MEMORY_SCOPE_WORKGROUP);
          topw[row * 4 + k] = w; route[row * 4 + k] = ex + 32 * pos; }
        __syncthreads();
        if (F.tid < 32) hist[chunk * 32 + F.tid] = cnt[F.tid];
        __syncthreads();
    }
}

__device__ __forceinline__ void p7_scatter(Frame& F) {
    const int* hist = (const int*)(F.ws + WS_HIST); const int* route = (const int*)(F.ws + WS_ROUTE);
    int* tokslot = (int*)(F.ws + WS_TOKSLOT); int* slottok = (int*)(F.ws + WS_SLOTTOK); int* moetab = (int*)(F.ws + WS_MOETAB);
    LAS int* pre = (LAS int*)F.lds;
    LAS int* base = (LAS int*)(F.lds + 32768);
    for (int i = F.tid; i < 256 * 32; i += 512) pre[i] = hist[i];
    __syncthreads();
    if (F.tid < 32) { int run = 0;
        for (int c = 0; c < 256; ++c) { const int v = pre[c * 32 + F.tid]; pre[c * 32 + F.tid] = run; run += v; }
        base[64 + F.tid] = run; }
    __syncthreads();
    if (F.tid == 0) { int run = 0; for (int ex = 0; ex < NEXP; ++ex) { base[ex] = run; run += (base[64 + ex] + 255) & ~255; } base[NEXP] = run; }
    __syncthreads();
    if (F.blk == 0 && F.tid <= NEXP) moetab[F.tid] = base[F.tid] >> 8;
    for (int chunk = F.blk; chunk < NTOK / 128; chunk += F.G) {
        const int t = chunk * 128 + (F.tid >> 2), k = F.tid & 3; const int rt = route[t * 4 + k]; const int ex = rt & 31, pos = rt >> 5;
        const int slot = base[ex] + pre[chunk * 32 + ex] + pos;
        tokslot[t * 4 + k] = slot; slottok[slot] = t;
    }
    for (int ex = F.blk; ex < NEXP; ex += F.G) { const int lo = base[ex] + base[64 + ex], hi = base[ex + 1]; for (int s = lo + F.tid; s < hi; s += 512) slottok[s] = 0; }
    __syncthreads();
}

struct Args { const float* in[21]; float* out; unsigned char* ws; int ph_lo, ph_hi; };
__device__ __forceinline__ void launder(Frame& F, int wave) { int t = lane_id(); asm volatile("" : "+v"(t)); F.lane = t; F.wave = wave; F.tid = wave * 64 + t;
    const __attribute__((address_space(4))) Args* ap = (const __attribute__((address_space(4))) Args*)__builtin_amdgcn_kernarg_segment_ptr(); asm volatile("" : "+s"(ap));
#pragma unroll
    for (int i = 0; i < 21; ++i) F.in[i] = ap->in[i];
    F.out = ap->out; F.ws = ap->ws; }
constexpr int N_PHASES = 1 + 9 * NLAYER + 1;

#define PHASE_FN __device__ __forceinline__
__device__ __forceinline__ void make_frame(Frame& F, LAS unsigned char* lds, int wave) { F.lds = lds; int bk = blockIdx.x, gd = gridDim.x; asm volatile("" : "+s"(bk), "+s"(gd)); F.blk = bk; F.G = gd; launder(F, wave); }
PHASE_FN void ph_prologue(LAS unsigned char* lds, int wave) { Frame F; make_frame(F, lds, wave); p0_prologue(F); }
PHASE_FN void ph_norm1(LAS unsigned char* lds, int wave, int l) { Frame F; make_frame(F, lds, wave);
    if (l == 0) row_phase<false, true, false, false>(F, 0, F.in[I_X], nullptr); else row_phase<true, true, true, true>(F, l, F.ws + WS_XA, F.ws + WS_XB); }
PHASE_FN void ph_proj(LAS unsigned char* lds, int wave, int l) { Frame F; make_frame(F, lds, wave);
    pg8::Gemm g{(const bf16*)(F.ws + WS_H), (const bf16*)(F.ws + WS_WIN + (size_t)l * NPROJ * DM * (P2_FP8 ? 1 : 2)), nullptr, P2_FP8 ? DM / 2 : DM};
    pg8::StaticOrder S; S.init(NTOK, NPROJ, F.G, F.blk);
    pg8::EpiProj E{(bf16*)(F.ws + WS_PROJ), NPROJ};
    pg8::gemm_phase<pg8::EpiProj, pg8::StaticOrder, false, P2_FP8 != 0>(F.lds, g, S, E, F.wave); }
PHASE_FN void ph_postproj(LAS unsigned char* lds, int wave, int l) { Frame F; make_frame(F, lds, wave); p3_postproj(F, l); }
PHASE_FN void ph_attn(LAS unsigned char* lds, int wave, int l) { Frame F; make_frame(F, lds, wave); p4_attention(F, l); }
PHASE_FN void ph_out(LAS unsigned char* lds, int wave, int l) { Frame F; make_frame(F, lds, wave);
    pg8::Gemm g{(const bf16*)(F.ws + WS_YMIX), (const bf16*)(F.ws + WS_WOUT) + (size_t)l * DM * DM, nullptr, DM};
    pg8::StaticOrder S; S.init(NTOK, DM, F.G, F.blk);
    const float* gb = F.in[I_BADA] + (size_t)l * 6144 + 2 * DM; const float* gp = (const float*)(F.ws + WS_MODP) + (size_t)l * 4 * NB * 6144 + 2 * DM;
    if (l == 0) { pg8::EpiResGate<false> E{F.in[I_X], (bf16*)(F.ws + WS_XA), gb, gp}; pg8::gemm_phase<pg8::EpiResGate<false>, pg8::StaticOrder, false>(F.lds, g, S, E, F.wave); }
    else { pg8::EpiResGate<true> E{F.ws + WS_XB, (bf16*)(F.ws + WS_XA), gb, gp}; pg8::gemm_phase<pg8::EpiResGate<true>, pg8::StaticOrder, false>(F.lds, g, S, E, F.wave); } }
PHASE_FN void ph_router(LAS unsigned char* lds, int wave, int l) { Frame F; make_frame(F, lds, wave); p6_norm_router(F, l, (const bf16*)(F.ws + WS_XA)); }
PHASE_FN void ph_scatter(LAS unsigned char* lds, int wave) { Frame F; make_frame(F, lds, wave); p7_scatter(F); }
__device__ __forceinline__ LAS int* moe_table(Frame& F) { LAS int* tb = (LAS int*)(F.lds + MISC_OFF + 64);
    if (F.tid <= NEXP) tb[F.tid] = ((const int*)(F.ws + WS_MOETAB))[F.tid];
    __syncthreads(); return tb; }
PHASE_FN void ph_moe_up(LAS unsigned char* lds, int wave, int l) { Frame F; make_frame(F, lds, wave); LAS int* tb = moe_table(F);
    pg8::Gemm g{(const bf16*)(F.ws + WS_H8), (const bf16*)(F.ws + WS_W1 + (size_t)l * NEXP * 2048 * DM), (const int*)(F.ws + WS_SLOTTOK), DM / 2};
    pg8::MoeOrder S; S.init(tb, 8, F.G, F.blk);
    pg8::EpiSwiglu8 E{F.ws + WS_ACT, F.in[I_B1] + (size_t)l * NEXP * 2048};
    pg8::gemm_phase<pg8::EpiSwiglu8, pg8::MoeOrder, true, true>(F.lds, g, S, E, F.wave); }
struct EpiNull { static constexpr bool PERM = true; __device__ __forceinline__ void operator()(const f32x4 (&acc)[2][2][4][2], const pg8::Unit& u, int wr, int wc, int fr, int fq) const { float s = 0.f;
#pragma unroll
    for (int a = 0; a < 2; ++a)
#pragma unroll
        for (int b = 0; b < 2; ++b)
#pragma unroll
            for (int m = 0; m < 4; ++m)
#pragma unroll
                for (int n = 0; n < 2; ++n) s += acc[a][b][m][n][0] + acc[a][b][m][n][1] + acc[a][b][m][n][2] + acc[a][b][m][n][3];
    asm volatile("" :: "v"(s)); } };
PHASE_FN void ph_moe_down_nostore(LAS unsigned char* lds, int wave, int l) { Frame F; make_frame(F, lds, wave); LAS int* tb = moe_table(F);
    pg8::Gemm g{(const bf16*)(F.ws + WS_ACT), (const bf16*)(F.ws + WS_W2 + (size_t)l * NEXP * DM * DM), nullptr, DM / 2};
    pg8::MoeOrder S; S.init(tb, 4, F.G, F.blk);
#if EXP_NOSTORE == 2
    pg8::EpiY E{F.ws + WS_PROJ, nullptr};
    pg8::gemm_phase<pg8::EpiY, pg8::MoeOrder, false, true>(F.lds, g, S, E, F.wave); }
#else
    EpiNull E;
    pg8::gemm_phase<EpiNull, pg8::MoeOrder, false, true>(F.lds, g, S, E, F.wave); }
#endif
PHASE_FN void ph_moe_down(LAS unsigned char* lds, int wave, int l) { Frame F; make_frame(F, lds, wave); LAS int* tb = moe_table(F);
    pg8::Gemm g{(const bf16*)(F.ws + WS_ACT), (const bf16*)(F.ws + WS_W2 + (size_t)l * NEXP * DM * DM), nullptr, DM / 2, (void*)(F.ws + WS_CTL + 512)};
    pg8::MoeOrder S; S.init(tb, 4, F.G, F.blk);
    pg8::EpiY E{F.ws + WS_Y, F.in[I_B2] + (size_t)l * NEXP * DM};
    pg8::gemm_phase<pg8::EpiY, pg8::MoeOrder, false, true>(F.lds, g, S, E, F.wave); }
PHASE_FN void ph_final(LAS unsigned char* lds, int wave) { Frame F; make_frame(F, lds, wave); row_phase<true, false, true, false>(F, NLAYER, F.ws + WS_XA, F.out); }

#ifndef REP_MASK
#define REP_MASK 0
#endif
#ifndef MK_SPLIT
#define MK_SPLIT 0
#endif
#if !MK_SPLIT
__global__ void __launch_bounds__(512, 2) fwd_kernel(Args args) {
    extern __shared__ __attribute__((aligned(16))) unsigned char lds_raw[];
    LAS unsigned char* lds = (LAS unsigned char*)lds_raw;
    volatile LAS unsigned* MISC = (volatile LAS unsigned*)(lds + MISC_OFF);
    if (threadIdx.x < 16) MISC[threadIdx.x] = 0u;
    const int wave = __builtin_amdgcn_readfirstlane(threadIdx.x >> 6);
    __syncthreads();
    const XcdBarrier bar = xcd_barrier_post((unsigned*)(args.ws + WS_CTL) + CW_BAR, MISC, wave);
#define IN(k) true
#define SEAM(k) xcd_barrier(bar)
#define REPS(j) for (int rep_ = 0; rep_ < (((REP_MASK >> (j)) & 1) ? 2 : 1); ++rep_)
#ifdef PT_SEL
    unsigned long long pt_acc = 0ull, pt_t0 = 0ull;
#define PT_BEGIN(j) do { if ((j) == PT_SEL) pt_t0 = __builtin_amdgcn_s_memrealtime(); } while (0)
#define PT_END(j) do { if ((j) == PT_SEL) { const unsigned long long t1_ = __builtin_amdgcn_s_memrealtime(); pt_acc += t1_ - pt_t0; } } while (0)
#else
#define PT_BEGIN(j) do {} while (0)
#define PT_END(j) do {} while (0)
#endif
    if (IN(0)) { REPS(0) { PT_BEGIN(0); ph_prologue(lds, wave); SEAM(0); PT_END(0); } }
    for (int l = 0; l < NLAYER; ++l) {
        const int p = 1 + 9 * l;
        if (IN(p + 0)) { REPS(1) { PT_BEGIN(1); ph_norm1(lds, wave, l); SEAM(p + 0); PT_END(1); } }
        if (IN(p + 1)) { REPS(2) { PT_BEGIN(2); ph_proj(lds, wave, l); SEAM(p + 1); PT_END(2); } }
        if (IN(p + 2)) { PT_BEGIN(3); ph_postproj(lds, wave, l); SEAM(p + 2); PT_END(3); }
        if (IN(p + 3)) { REPS(4) { PT_BEGIN(4); ph_attn(lds, wave, l); SEAM(p + 3); PT_END(4); } }
        if (IN(p + 4)) { REPS(5) { PT_BEGIN(5); ph_out(lds, wave, l); SEAM(p + 4); PT_END(5); } }
        if (IN(p + 5)) { REPS(6) { PT_BEGIN(6); ph_router(lds, wave, l); SEAM(p + 5); PT_END(6); } }
        if (IN(p + 6)) { REPS(7) { PT_BEGIN(7); ph_scatter(lds, wave); SEAM(p + 6); PT_END(7); } }
        if (IN(p + 7)) { REPS(8) { PT_BEGIN(8); ph_moe_up(lds, wave, l); SEAM(p + 7); PT_END(8); } }
        if (IN(p + 8)) { REPS(9) { PT_BEGIN(9); ph_moe_down(lds, wave, l); SEAM(p + 8); PT_END(9); } }
    }
    if (IN(N_PHASES - 1)) { REPS(10) { PT_BEGIN(10); ph_final(lds, wave); PT_END(10); } }
#ifdef PT_SEL
    if (blockIdx.x == 0 && wave == 0 && lane_id() == 0) { const unsigned long long t0_ = __builtin_amdgcn_s_memrealtime(); while (__builtin_amdgcn_s_memrealtime() - t0_ < pt_acc * PT_K) __builtin_amdgcn_s_sleep(8); }
#endif
#ifdef TPG
    if (blockIdx.x == 3 && wave == 0 && lane_id() == 0) { __builtin_amdgcn_s_waitcnt(0);
        const unsigned long long acc = __hip_atomic_load((unsigned long long*)(args.ws + WS_CTL + 512), __ATOMIC_RELAXED, __HIP_MEMORY_SCOPE_AGENT) * ((TPG == 1) ? 1ull : 100000ull);
        const unsigned long long t0 = __builtin_readcyclecounter(); while (__builtin_readcyclecounter() - t0 < acc) __builtin_amdgcn_s_sleep(4); }
#endif
#ifdef TPROBE
    if (blockIdx.x == TPROBE_BLK && wave == 0 && lane_id() == 0) {
        __builtin_amdgcn_s_waitcnt(0);
        const unsigned long long acc = __hip_atomic_load((unsigned long long*)(args.ws + WS_CTL + 512), __ATOMIC_RELAXED, __HIP_MEMORY_SCOPE_AGENT) * TPROBE_K;
        const unsigned long long t0 = __builtin_readcyclecounter();
        while (__builtin_readcyclecounter() - t0 < acc) __builtin_amdgcn_s_sleep(4);
    }
#endif
#ifdef UBENCH
    {
        float v[32];
#pragma unroll
        for (int i = 0; i < 32; ++i) v[i] = (float)(lane_id() + i) * 1e-3f;
        for (int it = 0; it < UBENCH_ITERS; ++it) {
#pragma unroll
            for (int i = 0; i < 32; ++i) {
#if UBENCH == 1
                v[i] = __builtin_amdgcn_exp2f(v[i]);
#elif UBENCH == 2
                v[i] = v[i] * 1.0001f + 0.5f;
#elif UBENCH == 3
                v[i] = __builtin_amdgcn_logf(v[i]);
#endif
            }
            asm volatile("" ::: "memory");
        }
        float s = 0.f;
#pragma unroll
        for (int i = 0; i < 32; ++i) s += v[i];
        if (s == 123.456f) ((float*)(args.ws + WS_GSUM + 14000))[0] = s;
    }
#endif
#undef IN
#undef SEAM
#undef REPS
}

#endif
template <int KIND> __global__ void __launch_bounds__(512, 2) phase_kernel(Args args, int l) {
    extern __shared__ __attribute__((aligned(16))) unsigned char lds_raw[];
    LAS unsigned char* lds = (LAS unsigned char*)lds_raw; const int wave = __builtin_amdgcn_readfirstlane(threadIdx.x >> 6);
    if (KIND == 0) ph_prologue(lds, wave); if (KIND == 1) ph_norm1(lds, wave, l); if (KIND == 2) ph_proj(lds, wave, l); if (KIND == 3) ph_postproj(lds, wave, l); if (KIND == 4) ph_attn(lds, wave, l);
    if (KIND == 5) ph_out(lds, wave, l); if (KIND == 6) ph_router(lds, wave, l); if (KIND == 7) ph_scatter(lds, wave); if (KIND == 8) ph_moe_up(lds, wave, l); if (KIND == 9) ph_moe_down(lds, wave, l); if (KIND == 10) ph_final(lds, wave);
#ifdef EXP_NOSTORE
    if (KIND == 11) ph_moe_down_nostore(lds, wave, l);
#endif
}
template <int KIND> static void launch_phase(const Args& a, int l, int grid, hipStream_t stream) {
    static bool attr = false;
    if (!attr) { (void)hipFuncSetAttribute((const void*)phase_kernel<KIND>, hipFuncAttributeMaxDynamicSharedMemorySize, LDS_BYTES); attr = true; }
    for (int rep = 0; rep < (((REP_MASK >> KIND) & 1) ? 2 : 1); ++rep) hipLaunchKernelGGL(phase_kernel<KIND>, dim3(grid), dim3(512), LDS_BYTES, stream, a, l);
}

extern "C" void kernel_launch(void* const* d_in, const int* in_sizes, int n_in, void* d_out, int out_size, void* d_ws, size_t ws_size, hipStream_t stream) {
    static int grid = 0;
    if (grid == 0) {
        if (n_in != 21 || in_sizes[0] != NTOK * DM || out_size != NTOK * DM || ws_size < WS_END) {
            fprintf(stderr, "kernel_launch: unexpected shapes: n_in %d in0 %d out %d ws %zu (need %zu)\n", n_in, n_in > 0 ? in_sizes[0] : -1, out_size, ws_size, (size_t)WS_END); grid = -1; return; }
        int dev = 0, cus = 0, per_cu = 0;
        if (hipGetDevice(&dev) != hipSuccess || hipDeviceGetAttribute(&cus, hipDeviceAttributeMultiprocessorCount, dev) != hipSuccess) { fprintf(stderr, "kernel_launch: device query failed\n"); grid = -1; return; }
#if !MK_SPLIT
        if (hipFuncSetAttribute((const void*)fwd_kernel, hipFuncAttributeMaxDynamicSharedMemorySize, LDS_BYTES) != hipSuccess) { fprintf(stderr, "kernel_launch: hipFuncSetAttribute failed\n"); grid = -1; return; }
        if (hipOccupancyMaxActiveBlocksPerMultiprocessor(&per_cu, (const void*)fwd_kernel, 512, LDS_BYTES) != hipSuccess || per_cu < 1) fprintf(stderr, "kernel_launch: note: occupancy query says %d\n", per_cu);
        (void)hipGetLastError();
#endif
        grid = cus;
    }
    if (grid < 0) return;
    (void)hipMemsetAsync((char*)d_ws + WS_CTL, 0, CTL_ZERO_BYTES, stream);
    Args a{};
    for (int i = 0; i < 21; ++i) a.in[i] = (const float*)d_in[i];
    a.out = (float*)d_out; a.ws = (unsigned char*)d_ws;
#if MK_SPLIT
    a.ph_lo = 0; a.ph_hi = 0;
    launch_phase<0>(a, 0, grid, stream);
    for (int l = 0; l < NLAYER; ++l) { launch_phase<1>(a, l, grid, stream); launch_phase<2>(a, l, grid, stream); launch_phase<3>(a, l, grid, stream); launch_phase<4>(a, l, grid, stream); launch_phase<5>(a, l, grid, stream);
        launch_phase<6>(a, l, grid, stream); launch_phase<7>(a, l, grid, stream); launch_phase<8>(a, l, grid, stream);
#ifdef EXP_NOSTORE
        launch_phase<11>(a, l, grid, stream);
#endif
        launch_phase<9>(a, l, grid, stream); }
    launch_phase<10>(a, 0, grid, stream);
#else
    a.ph_lo = 0; a.ph_hi = N_PHASES; hipLaunchKernelGGL(fwd_kernel, dim3(grid), dim3(512), LDS_BYTES, stream, a);
#endif
}
```

```cpp
#include <hip/hip_runtime.h>
#include <cstdio>
#include <cstdint>

#define GAS __attribute__((address_space(1)))
#define LAS __attribute__((address_space(3)))
typedef unsigned short bf16;
typedef unsigned v4u __attribute__((ext_vector_type(4)));
typedef unsigned v2u __attribute__((ext_vector_type(2)));
typedef float f32x4 __attribute__((ext_vector_type(4)));
typedef float f32x2 __attribute__((ext_vector_type(2)));
typedef float f32x16 __attribute__((ext_vector_type(16)));
typedef short bf16x8 __attribute__((ext_vector_type(8)));
typedef _Float16 f16x8 __attribute__((ext_vector_type(8)));
typedef _Float16 f16x2 __attribute__((ext_vector_type(2)));
typedef int v4i __attribute__((ext_vector_type(4)));
typedef int v8i __attribute__((ext_vector_type(8)));

namespace pg8 {
constexpr int BM = 256, BK = 64, HALF = 128, HTB = HALF * BK * 2  , STAGE_BYTES = 8 * HTB, NXCD = 8, WGM = 8;

__host__ __device__ __forceinline__ int lds_byte(int r, int c) { const int st = (r >> 4) * 2 + (c >> 5), rr = r & 15, cc = c & 31, ob = rr * 64 + cc * 2; return st * 1024 + (ob ^ (((ob >> 9) & 1) << 5)); }
__host__ __device__ __forceinline__ void stage_rc(int b, int& R, int& C) { const int st = b / 1024, sb = b % 1024, swz = sb ^ (((sb >> 9) & 1) << 5); R = (st >> 1) * 16 + swz / 64; C = (st & 1) * 32 + (swz % 64) / 2; }
__host__ __device__ __forceinline__ int perm32(int rho) { const int n = rho >> 4, i = rho & 15; return 8 * (i >> 2) + 4 * n + (i & 3); }

struct Unit { int pm, pn, pb; };
struct Gemm { const bf16* A; const bf16* Bt; const int* rowmap; int K; void* tprobe = nullptr; };

__device__ __forceinline__ unsigned cvt_pk_bf16(float lo, float hi) { unsigned r; asm volatile("v_cvt_pk_bf16_f32 %0, %1, %2" : "=v"(r) : "v"(lo), "v"(hi)); return r; }

template <class Epi, class Sched, bool GATHER, bool FP8 = false>
__device__ __forceinline__ void gemm_phase(LAS unsigned char* lds, const Gemm g, const Sched& S, const Epi& E, int wave) {
    int lane_ = (int)__builtin_amdgcn_mbcnt_hi(~0u, __builtin_amdgcn_mbcnt_lo(~0u, 0u)); asm volatile("" : "+v"(lane_));
    const int wid = wave, lane = lane_, tid = wid * 64 + lane, wr = wid >> 2, wc = wid & 3, fr = lane & 15, fq = lane >> 4;
    const int K = g.K, nt = K / BK;
    unsigned voffA[2], voffB[2]; int RA[2], CA[2];
#pragma unroll
    for (int i = 0; i < 2; ++i) { int R, C; stage_rc(tid * 16 + i * 8192, R, C); const int Rb = Epi::PERM ? ((R & ~31) + perm32(R & 31)) : R; RA[i] = R; CA[i] = C;
        voffA[i] = (unsigned)(R * K + C) * 2u; voffB[i] = (unsigned)(Rb * K + C) * 2u; }
    const size_t kstep = (size_t)(BK * 2);
    const size_t hstep = (size_t)HALF * K * 2;
    const size_t tstep = 2 * hstep;
    const unsigned ldsw = (unsigned)wid * 1024u;
    const int aoff = lds_byte(wr * 64 + fr, fq * 8), boff = lds_byte(wc * 32 + fr, fq * 8);
#define PG8_SA(b, h) (((b) * 2 + (h)) * HTB)
#define PG8_SB(b, h) ((4 + (b) * 2 + (h)) * HTB)
#define PG8_STAGE(bufoff, gbase, voff) do { _Pragma("unroll") for (int _i = 0; _i < 2; ++_i) \
        __builtin_amdgcn_global_load_lds((const unsigned*)((const char*)(gbase) + (voff)[_i]), (LAS unsigned*)(lds + (bufoff) + ldsw + _i * 8192), 16, 0, 0); } while (0)
#define PG8_STAGEA(bufoff, pbase, h, nx) do { if constexpr (GATHER) { _Pragma("unroll") for (int _i = 0; _i < 2; ++_i) \
        __builtin_amdgcn_global_load_lds((const unsigned*)((const char*)(pbase) + ((nx) ? gn[h][_i] : gc[h][_i])), (LAS unsigned*)(lds + (bufoff) + ldsw + _i * 8192), 16, 0, 0); } \
        else { PG8_STAGE(bufoff, (const char*)(pbase) + (h) * hstep, voffA); } } while (0)
#define PG8_LDA(dst, b, h) do { if constexpr (FP8) { _Pragma("unroll") for (int m = 0; m < 4; ++m) dst##8[m] = __builtin_shufflevector(*(const LAS v4i*)(lds + PG8_SA(b, h) + aoff + m * 2048), *(const LAS v4i*)(lds + PG8_SA(b, h) + aoff + m * 2048 + 1024), 0, 1, 2, 3, 4, 5, 6, 7); } \
        else { _Pragma("unroll") for (int m = 0; m < 4; ++m) _Pragma("unroll") for (int k = 0; k < 2; ++k) dst[m][k] = *(const LAS bf16x8*)(lds + PG8_SA(b, h) + aoff + m * 2048 + k * 1024); } } while (0)
#define PG8_LDB(dst, b, h) do { if constexpr (FP8) { _Pragma("unroll") for (int n = 0; n < 2; ++n) dst##8[n] = __builtin_shufflevector(*(const LAS v4i*)(lds + PG8_SB(b, h) + boff + n * 2048), *(const LAS v4i*)(lds + PG8_SB(b, h) + boff + n * 2048 + 1024), 0, 1, 2, 3, 4, 5, 6, 7); } \
        else { _Pragma("unroll") for (int n = 0; n < 2; ++n) _Pragma("unroll") for (int k = 0; k < 2; ++k) dst[n][k] = *(const LAS bf16x8*)(lds + PG8_SB(b, h) + boff + n * 2048 + k * 1024); } } while (0)
#define PG8_MMA(ai, bj, At, Bt) do { __builtin_amdgcn_s_setprio(1); if constexpr (FP8) { _Pragma("unroll") for (int m = 0; m < 4; ++m) _Pragma("unroll") for (int n = 0; n < 2; ++n) \
        asm volatile("v_mfma_scale_f32_16x16x128_f8f6f4 %0, %1, %2, %0, %3, %4 op_sel_hi:[0,0,0]" : "+v"(acc[ai][bj][m][n]) : "v"(Bt##8[n]), "v"(At##8[m]), "v"(sclw), "v"(scla)); } \
        else { _Pragma("unroll") for (int m = 0; m < 4; ++m) _Pragma("unroll") for (int n = 0; n < 2; ++n) _Pragma("unroll") for (int k = 0; k < 2; ++k) \
        acc[ai][bj][m][n] = __builtin_amdgcn_mfma_f32_16x16x32_bf16(Bt[n][k], At[m][k], acc[ai][bj][m][n], 0, 0, 0); } __builtin_amdgcn_s_setprio(0); } while (0)
#define PG8_WAIT_V(n) asm volatile("s_waitcnt vmcnt(" #n ")" ::: "memory")
#define PG8_WAIT_L(n) asm volatile("s_waitcnt lgkmcnt(" #n ")" ::: "memory")
#define PG8_BAR __builtin_amdgcn_s_barrier()
#define PG8_SCHED __builtin_amdgcn_sched_barrier(0)
    Unit cur, nxt; int ui = 0;
    if (!S.next(0, cur)) return;
#ifdef GEMM_STAGGER
    {
        const unsigned long long t0 = __builtin_amdgcn_s_memrealtime(); const unsigned long long d = (unsigned long long)((blockIdx.x >> 3) & 3) * GEMM_STAGGER;
        while (__builtin_amdgcn_s_memrealtime() - t0 < d) __builtin_amdgcn_s_sleep(16);
    }
#endif
    f32x4 acc[2][2][4][2];
#pragma unroll
    for (int a = 0; a < 2; ++a)
#pragma unroll
        for (int b = 0; b < 2; ++b)
#pragma unroll
            for (int m = 0; m < 4; ++m)
#pragma unroll
                for (int n = 0; n < 2; ++n) acc[a][b][m][n] = (f32x4){0.f, 0.f, 0.f, 0.f};
    bf16x8 At[4][2], B0[2][2], B1[2][2]; v8i At8[4], B08[2], B18[2];
    const int sclw = 0x7A7A7A7A, scla = 0x7F7F7F7F;
    unsigned gc[2][2], gn[2][2];
    if constexpr (GATHER) {
#pragma unroll
        for (int h = 0; h < 2; ++h)
#pragma unroll
            for (int i = 0; i < 2; ++i) { gc[h][i] = (unsigned)(g.rowmap[cur.pm * BM + h * HALF + RA[i]] * K + CA[i]) * 2u; gn[h][i] = gc[h][i]; }
    } else { gc[0][0] = gc[0][1] = gc[1][0] = gc[1][1] = 0u; gn[0][0] = gn[0][1] = gn[1][0] = gn[1][1] = 0u; }
    const char* cA = GATHER ? (const char*)g.A : (const char*)g.A + (size_t)cur.pm * tstep; const char* cB = (const char*)g.Bt + (size_t)cur.pb * tstep;
    PG8_STAGE(PG8_SB(0, 0), cB, voffB); PG8_STAGE(PG8_SB(0, 1), cB + hstep, voffB); PG8_STAGEA(PG8_SA(0, 0), cA, 0, false); PG8_STAGEA(PG8_SA(0, 1), cA, 1, false);
    if (wr == 1) PG8_BAR;
    PG8_WAIT_V(2); PG8_BAR;
    PG8_STAGE(PG8_SB(1, 0), cB + kstep, voffB); PG8_STAGEA(PG8_SA(1, 0), cA + kstep, 0, false); PG8_STAGE(PG8_SB(1, 1), cB + hstep + kstep, voffB);
    PG8_WAIT_V(6); PG8_BAR;
    for (;;) {
        const bool has_next = S.next(ui + 1, nxt);
        if constexpr (GATHER) { if (has_next) {
#pragma unroll
            for (int h = 0; h < 2; ++h)
#pragma unroll
                for (int i = 0; i < 2; ++i) gn[h][i] = (unsigned)(g.rowmap[nxt.pm * BM + h * HALF + RA[i]] * K + CA[i]) * 2u; } }
        const char* nA = GATHER ? cA : (has_next ? (const char*)g.A + (size_t)nxt.pm * tstep : cA); const char* nB = has_next ? (const char*)g.Bt + (size_t)nxt.pb * tstep : cB;
#ifdef TPG
        const unsigned long long tg0 = __builtin_readcyclecounter();
#endif
        for (int t = 0; t < nt; t += 2) {
            const bool last = (t == nt - 2);
            const char* a1 = cA + (size_t)(t + 1) * kstep;
            const char* a2 = last ? nA : cA + (size_t)(t + 2) * kstep; const char* b2 = last ? nB : cB + (size_t)(t + 2) * kstep;
            const char* a3 = a2 + kstep; const char* b3 = b2 + kstep;
            PG8_LDB(B0, 0, 0); PG8_LDB(B1, 0, 1); PG8_SCHED; PG8_LDA(At, 0, 0); PG8_STAGEA(PG8_SA(1, 1), a1, 1, false);
            PG8_WAIT_V(8); PG8_WAIT_L(0); PG8_BAR; PG8_MMA(0, 0, At, B0); PG8_MMA(0, 1, At, B1); PG8_BAR; PG8_SCHED;
            PG8_LDA(At, 0, 1); PG8_STAGE(PG8_SB(0, 0), b2, voffB); PG8_STAGE(PG8_SB(0, 1), b2 + hstep, voffB); PG8_STAGEA(PG8_SA(0, 0), a2, 0, last);
            PG8_WAIT_V(8); PG8_WAIT_L(0); PG8_BAR; PG8_MMA(1, 0, At, B0); PG8_MMA(1, 1, At, B1); PG8_BAR; PG8_SCHED;
            PG8_LDB(B0, 1, 0); PG8_LDB(B1, 1, 1); PG8_SCHED; PG8_LDA(At, 1, 0); PG8_STAGEA(PG8_SA(0, 1), a2, 1, last);
            PG8_WAIT_V(8); PG8_WAIT_L(0); PG8_BAR; PG8_MMA(0, 0, At, B0); PG8_MMA(0, 1, At, B1); PG8_BAR; PG8_SCHED;
            PG8_LDA(At, 1, 1); PG8_STAGE(PG8_SB(1, 0), b3, voffB); PG8_STAGE(PG8_SB(1, 1), b3 + hstep, voffB); PG8_STAGEA(PG8_SA(1, 0), a3, 0, last);
            PG8_WAIT_V(8); PG8_WAIT_L(0); PG8_BAR; PG8_MMA(1, 0, At, B0); PG8_MMA(1, 1, At, B1); PG8_BAR; PG8_SCHED;
        }
#ifdef TPG
        { const unsigned long long tg1 = __builtin_readcyclecounter(); asm volatile("" :: "s"(tg0), "s"(tg1));
          if (FP8 && !GATHER && blockIdx.x == 3 && tid == 0) atomicAdd((unsigned long long*)g.tprobe, (TPG == 1) ? (tg1 - tg0) : 1ull); }
#endif
        if (wr == 0) PG8_BAR;
        if constexpr (FP8) asm volatile("s_nop 15\n\ts_nop 7" ::: "memory");
        E(acc, cur, wr, wc, fr, fq);
        if (!has_next) break;
#pragma unroll
        for (int a = 0; a < 2; ++a)
#pragma unroll
            for (int b = 0; b < 2; ++b)
#pragma unroll
                for (int m = 0; m < 4; ++m)
#pragma unroll
                    for (int n = 0; n < 2; ++n) acc[a][b][m][n] = (f32x4){0.f, 0.f, 0.f, 0.f};
        cur = nxt; cA = nA; cB = nB; ++ui;
        if constexpr (GATHER) {
#pragma unroll
            for (int h = 0; h < 2; ++h)
#pragma unroll
                for (int i = 0; i < 2; ++i) gc[h][i] = gn[h][i]; }
        if (wr == 1) PG8_BAR;
    }
    PG8_WAIT_V(0);
    PG8_BAR;
#undef PG8_SA
#undef PG8_SB
#undef PG8_STAGE
#undef PG8_STAGEA
#undef PG8_LDA
#undef PG8_LDB
#undef PG8_MMA
#undef PG8_WAIT_V
#undef PG8_WAIT_L
#undef PG8_BAR
#undef PG8_SCHED
}
}
constexpr int DM = 1024, NB = 8, SEQ = 4096, NTOK = NB * SEQ, NLAYER = 2;
constexpr int NPROJ = 3072;
constexpr int D_IN = 3078;
constexpr int NEXP = 32, TOPK = 4;
constexpr int NSLOT_MAX = NTOK * TOPK + NEXP * 256;
constexpr int NTILE_MAX = NSLOT_MAX / 256;
constexpr int COL_CB = 0, COL_CC = 256, COL_CU = 512, COL_SQ = 768, COL_SK = 1152, COL_SV = 1536, COL_FQ = 1920, COL_FK = 2304, COL_FV = 2688;
constexpr float EPS = 1e-6f;
constexpr float LOG2E = 1.4426950408889634f;
constexpr float QSCALE = 0.125f * LOG2E;

namespace pg8 {
struct StaticOrder {
    int nM, nN, nwg, G, c;
    __device__ __forceinline__ void init(int M, int N, int G_, int c_) { nM = M / BM; nN = N / BM; nwg = nM * nN; G = G_; c = c_; }
    __device__ __forceinline__ bool next(int i, Unit& u) const {
        const long L = (long)i * G + c; if (L >= nwg) return false;
        int wgid = (int)L; { const int q = nwg / NXCD, r = nwg % NXCD, xcd = wgid % NXCD, off = wgid / NXCD; wgid = (xcd < r ? xcd * (q + 1) : r * (q + 1) + (xcd - r) * q) + off; }
        const int nig = WGM * nN, gid = wgid / nig, fm = gid * WGM, gsz = (nM - fm) < WGM ? (nM - fm) : WGM;
        u.pm = fm + ((wgid % nig) % gsz); u.pn = (wgid % nig) / gsz; u.pb = u.pn; return true;
    }
};
struct MoeOrder {
    int nM, nN, nwg, G, c; const LAS int* tb;
    __device__ __forceinline__ void init(const LAS int* tb_, int nN_, int G_, int c_) { tb = tb_; nM = tb_[NEXP]; nN = nN_; nwg = nM * nN; G = G_; c = c_; }
    __device__ __forceinline__ bool next(int i, Unit& u) const {
        const long L = (long)i * G + c; if (L >= nwg) return false;
        int wgid = (int)L; { const int q = nwg / NXCD, r = nwg % NXCD, xcd = wgid % NXCD, off = wgid / NXCD; wgid = (xcd < r ? xcd * (q + 1) : r * (q + 1) + (xcd - r) * q) + off; }
        const int nig = WGM * nN, gid = wgid / nig, fm = gid * WGM, gsz = (nM - fm) < WGM ? (nM - fm) : WGM;
        u.pm = fm + ((wgid % nig) % gsz); u.pn = (wgid % nig) / gsz;
        int e = 0;
#pragma unroll 1
        for (int j = 1; j < NEXP; ++j) e += (tb[j] <= u.pm) ? 1 : 0;
        u.pb = e * nN + u.pn; return true;
    }
};

struct EpiProj {
    static constexpr bool PERM = true;
    bf16* O; int ldc;
    __device__ __forceinline__ void operator()(const f32x4 (&acc)[2][2][4][2], const Unit& u, int wr, int wc, int fr, int fq) const {
        const int row0 = u.pm * BM + wr * 64 + fr, col0 = u.pn * BM + wc * 32 + 8 * fq;
#pragma unroll
        for (int ai = 0; ai < 2; ++ai)
#pragma unroll
            for (int m = 0; m < 4; ++m) { bf16* rowp = O + (size_t)(row0 + ai * HALF + m * 16) * ldc + col0;
#pragma unroll
                for (int bj = 0; bj < 2; ++bj) { const f32x4 v0 = acc[ai][bj][m][0], v1 = acc[ai][bj][m][1];
                    v4u w; w.x = cvt_pk_bf16(v0[0], v0[1]); w.y = cvt_pk_bf16(v0[2], v0[3]); w.z = cvt_pk_bf16(v1[0], v1[1]); w.w = cvt_pk_bf16(v1[2], v1[3]);
                    *(v4u*)(rowp + bj * HALF) = w; } }
    }
};
template <bool BASE16> struct EpiResGate {
    static constexpr bool PERM = true;
    const void* base; bf16* out; const float* gbias; const float* gpart;
    __device__ __forceinline__ void operator()(const f32x4 (&acc)[2][2][4][2], const Unit& u, int wr, int wc, int fr, int fq) const {
        const int row0 = u.pm * BM + wr * 64 + fr, col0 = u.pn * BM + wc * 32 + 8 * fq; const int b = (u.pm * BM) / SEQ;
#pragma unroll
        for (int bj = 0; bj < 2; ++bj) { const int c = col0 + bj * HALF; f32x4 g0 = *(const f32x4*)(gbias + c), g1 = *(const f32x4*)(gbias + c + 4);
#pragma unroll
            for (int ks = 0; ks < 4; ++ks) { g0 += *(const f32x4*)(gpart + (size_t)(ks * NB + b) * 6144 + c); g1 += *(const f32x4*)(gpart + (size_t)(ks * NB + b) * 6144 + c + 4); }
#pragma unroll
            for (int ai = 0; ai < 2; ++ai)
#pragma unroll
                for (int m = 0; m < 4; ++m) { const size_t off = (size_t)(row0 + ai * HALF + m * 16) * DM + c; f32x4 b0, b1;
                    if (BASE16) { const v4u t = *(const v4u*)((const bf16*)base + off); b0 = (f32x4){__builtin_bit_cast(float, t.x << 16), __builtin_bit_cast(float, t.x & 0xffff0000u), __builtin_bit_cast(float, t.y << 16), __builtin_bit_cast(float, t.y & 0xffff0000u)};
                        b1 = (f32x4){__builtin_bit_cast(float, t.z << 16), __builtin_bit_cast(float, t.z & 0xffff0000u), __builtin_bit_cast(float, t.w << 16), __builtin_bit_cast(float, t.w & 0xffff0000u)}; }
                    else { b0 = *(const f32x4*)((const float*)base + off); b1 = *(const f32x4*)((const float*)base + off + 4); }
                    const f32x4 v0 = b0 + g0 * acc[ai][bj][m][0], v1 = b1 + g1 * acc[ai][bj][m][1];
                    v4u w; w.x = cvt_pk_bf16(v0[0], v0[1]); w.y = cvt_pk_bf16(v0[2], v0[3]); w.z = cvt_pk_bf16(v1[0], v1[1]); w.w = cvt_pk_bf16(v1[2], v1[3]);
                    *(v4u*)(out + off) = w; } }
    }
};
struct EpiSwiglu {
    static constexpr bool PERM = true;
    bf16* O; const float* b1;
    __device__ __forceinline__ void operator()(const f32x4 (&acc)[2][2][4][2], const Unit& u, int wr, int wc, int fr, int fq) const {
        const int row0 = u.pm * BM + wr * 64 + fr; const int e = u.pb >> 3; const int j0 = u.pn * 128 + wc * 32 + 8 * fq;
        const float* bp = b1 + (size_t)e * 2048 + 2 * j0;
        f32x4 bb[4];
#pragma unroll
        for (int q = 0; q < 4; ++q) bb[q] = *(const f32x4*)(bp + 4 * q);
        float bg[8], bl[8];
#pragma unroll
        for (int q = 0; q < 4; ++q) { bg[2 * q] = bb[q][0]; bl[2 * q] = bb[q][1]; bg[2 * q + 1] = bb[q][2]; bl[2 * q + 1] = bb[q][3]; }
#pragma unroll
        for (int ai = 0; ai < 2; ++ai)
#pragma unroll
            for (int m = 0; m < 4; ++m) { bf16* rowp = O + (size_t)(row0 + ai * HALF + m * 16) * DM + j0;
                float a[8];
#pragma unroll
                for (int n = 0; n < 2; ++n)
#pragma unroll
                    for (int i = 0; i < 4; ++i) { float gl = acc[ai][0][m][n][i] + bg[4 * n + i], li = acc[ai][1][m][n][i] + bl[4 * n + i];
                        gl = fminf(gl, 7.0f); li = fminf(fmaxf(li, -7.0f), 7.0f);
                        const float sg = __builtin_amdgcn_rcpf(1.0f + __builtin_amdgcn_exp2f(-1.702f * LOG2E * gl));
                        a[4 * n + i] = gl * sg * (li + 1.0f); }
                v4u w; w.x = cvt_pk_bf16(a[0], a[1]); w.y = cvt_pk_bf16(a[2], a[3]); w.z = cvt_pk_bf16(a[4], a[5]); w.w = cvt_pk_bf16(a[6], a[7]);
                *(v4u*)rowp = w; }
    }
};
__device__ __forceinline__ float clamp448(float v) { return __builtin_amdgcn_fmed3f(v, -448.0f, 448.0f); }
__device__ __forceinline__ unsigned pk4_fp8(float a, float b, float c, float d) { unsigned r = 0; r = __builtin_amdgcn_cvt_pk_fp8_f32(clamp448(a), clamp448(b), r, false); r = __builtin_amdgcn_cvt_pk_fp8_f32(clamp448(c), clamp448(d), r, true); return r; }
struct EpiSwiglu8 {
    static constexpr bool PERM = true;
    unsigned char* O; const float* b1;
    __device__ __forceinline__ void operator()(const f32x4 (&acc)[2][2][4][2], const Unit& u, int wr, int wc, int fr, int fq) const {
        const int row0 = u.pm * BM + wr * 64 + fr; const int e = u.pb >> 3; const int j0 = u.pn * 128 + wc * 32 + 8 * fq;
        const float* bp = b1 + (size_t)e * 2048 + 2 * j0;
        f32x4 bb[4];
#pragma unroll
        for (int q = 0; q < 4; ++q) bb[q] = *(const f32x4*)(bp + 4 * q);
        float bg[8], bl[8];
#pragma unroll
        for (int q = 0; q < 4; ++q) { bg[2 * q] = bb[q][0]; bl[2 * q] = bb[q][1]; bg[2 * q + 1] = bb[q][2]; bl[2 * q + 1] = bb[q][3]; }
#pragma unroll
        for (int ai = 0; ai < 2; ++ai)
#pragma unroll
            for (int m = 0; m < 4; ++m) { unsigned char* rowp = O + (size_t)(row0 + ai * HALF + m * 16) * DM + j0;
                float a[8];
#pragma unroll
                for (int n = 0; n < 2; ++n)
#pragma unroll
                    for (int i = 0; i < 4; ++i) { float gl = acc[ai][0][m][n][i] + bg[4 * n + i], li = acc[ai][1][m][n][i] + bl[4 * n + i];
                        gl = fminf(gl, 7.0f); li = fminf(fmaxf(li, -7.0f), 7.0f);
                        const float sg = __builtin_amdgcn_rcpf(1.0f + __builtin_amdgcn_exp2f(-1.702f * LOG2E * gl));
                        a[4 * n + i] = gl * sg * (li + 1.0f); }
                v2u w; w.x = pk4_fp8(a[0], a[1], a[2], a[3]); w.y = pk4_fp8(a[4], a[5], a[6], a[7]);
                *(v2u*)rowp = w; }
    }
};
struct EpiY {
    static constexpr bool PERM = true;
    unsigned char* O; const float* b2;
    __device__ __forceinline__ void operator()(const f32x4 (&acc)[2][2][4][2], const Unit& u, int wr, int wc, int fr, int fq) const {
        const int row0 = u.pm * BM + wr * 64 + fr; const int e = u.pb >> 2; const int col0 = u.pn * BM + wc * 32 + 8 * fq;
        f32x4 bv[2][2];
#pragma unroll
        for (int bj = 0; bj < 2; ++bj)
#pragma unroll
            for (int n = 0; n < 2; ++n) bv[bj][n] = b2 ? *(const f32x4*)(b2 + (size_t)e * DM + col0 + bj * HALF + 4 * n) : (f32x4){0.f, 0.f, 0.f, 0.f};
#pragma unroll
        for (int ai = 0; ai < 2; ++ai)
#pragma unroll
            for (int m = 0; m < 4; ++m) { unsigned char* rowp = O + (size_t)(row0 + ai * HALF + m * 16) * DM + col0;
#pragma unroll
                for (int bj = 0; bj < 2; ++bj) { const f32x4 v0 = acc[ai][bj][m][0] + bv[bj][0], v1 = acc[ai][bj][m][1] + bv[bj][1];
                    v2u w; w.x = pk4_fp8(v0[0], v0[1], v0[2], v0[3]); w.y = pk4_fp8(v1[0], v1[1], v1[2], v1[3]);
                    *(v2u*)(rowp + bj * HALF) = w; } }
    }
};
}
namespace att {
constexpr int KROW = 128;
constexpr int TILE_B = 64 * KROW;
constexpr int OFF_K = 0, OFF_V = 2 * TILE_B, OFF_F = 4 * TILE_B, OFF_Q = OFF_F + 512, LDS_BYTES = OFF_Q + 8 * 4608;
__device__ __forceinline__ int pim(int m) { const int a = m >> 3, h = (m >> 2) & 1, b = m & 3; return 16 * (a >> 1) + 8 * h + 4 * (a & 1) + b; }
typedef __bf16 bf16x2_t __attribute__((ext_vector_type(2)));
__device__ __forceinline__ unsigned pk_bf16(float lo, float hi) { const f32x2 v = {lo, hi}; const bf16x2_t b = __builtin_convertvector(v, bf16x2_t); return __builtin_bit_cast(unsigned, b); }
__device__ __forceinline__ unsigned pk_f16(float lo, float hi) { return __builtin_bit_cast(unsigned, __builtin_amdgcn_cvt_pkrtz(lo, hi)); }
__device__ __forceinline__ float half_sum(float v) { auto rr = __builtin_amdgcn_permlane32_swap(__float_as_uint(v), __float_as_uint(v), false, false); return __uint_as_float(rr[0]) + __uint_as_float(rr[1]); }
__device__ __forceinline__ float half_max(float v) { auto rr = __builtin_amdgcn_permlane32_swap(__float_as_uint(v), __float_as_uint(v), false, false); return fmaxf(__uint_as_float(rr[0]), __uint_as_float(rr[1])); }
__device__ __forceinline__ void glds16(const void* gsrc, unsigned lds_dst) { unsigned keep;
    asm volatile("s_mov_b32 %0, m0\n\ts_mov_b32 m0, %2\n\ts_nop 0\n\tglobal_load_lds_dwordx4 %1, off\n\ts_mov_b32 m0, %0" : "=&s"(keep) : "v"(gsrc), "s"(lds_dst) : "memory"); }
#define ATT_SB() __builtin_amdgcn_sched_barrier(0)
#define ATT_MFMA(a, b, c) __builtin_amdgcn_mfma_f32_32x32x16_bf16((a), (b), (c), 0, 0, 0)
#define ATT_MFMAH(a, b, c) __builtin_amdgcn_mfma_f32_32x32x16_f16((a), (b), (c), 0, 0, 0)

struct Tensors {
    const bf16* proj;
    const bf16* vt;
    const float* fcum;
    bf16* ymix;
    const float* ong;
    int colq, colk, coly;
    void* tprobe;
};
struct WaveCtx { int r32, hi, qabs; int ko[4]; const LAS unsigned char* qb; f16x8 mtri0, mtri1, mones; };

__device__ __forceinline__ void qk_only(f32x16& p0, f32x16& p1, const LAS unsigned char* Kb, const WaveCtx& W) {
#pragma unroll
    for (int r = 0; r < 16; ++r) { p0[r] = 0.f; p1[r] = 0.f; }
#pragma unroll
    for (int d0 = 0; d0 < 4; ++d0) { const bf16x8 ka = *(const LAS bf16x8*)(Kb + W.ko[d0]), kb2 = *(const LAS bf16x8*)(Kb + 32 * KROW + W.ko[d0]);
        const bf16x8 qv = *(const LAS bf16x8*)(W.qb + 32 * d0);
        p0 = ATT_MFMA(ka, qv, p0); p1 = ATT_MFMA(kb2, qv, p1); }
}

template <int KIND, bool DIAG>
__device__ __forceinline__ void tile(f32x16& p0, f32x16& p1, f32x16& o0, f32x16& o1, float& carry, float& lsum, const LAS unsigned char* Kn, const LAS unsigned char* Vb, const LAS float* Fb, int kt, const WaveCtx& W) {
    const int kbase = kt * 64 + 8 * W.hi;
#define ATT_KF(i) (*(const LAS bf16x8*)(Kn + ((i) & 1) * 32 * KROW + W.ko[(i) >> 1]))
#define ATT_VF(i) (*(const LAS bf16x8*)(Vb + ((i) & 1) * 32 * KROW + W.ko[(i) >> 1]))
#define ATT_QF(d0) (*(const LAS bf16x8*)(W.qb + 32 * (d0)))
    bf16x8 kcur = ATT_KF(0), knxt = kcur, qcur = ATT_QF(0), qnxt = qcur;
    f32x16 n0, n1;
#pragma unroll
    for (int r = 0; r < 16; ++r) { n0[r] = 0.f; n1[r] = 0.f; }
    v4u wf[4];
    if (KIND == 0) {
        v4u lf[4]; float lfirst = 0.f, pz0 = 0.f;
#pragma unroll
        for (int i = 0; i < 8; ++i) {
            if (i < 7) { knxt = ATT_KF(i + 1); if (i & 1) qnxt = ATT_QF((i + 1) >> 1); }
#pragma unroll
            for (int jj = 0; jj < 2; ++jj) { const int r = (4 * i + 2 * jj) & 15; float lg[2];
#pragma unroll
                for (int e = 0; e < 2; ++e) { const float z = (i < 4) ? p0[r + e] : p1[r + e]; float g = __builtin_amdgcn_logf(1.0f + __builtin_amdgcn_exp2f(z));
                    if (i < 4) p0[r + e] = z - g; else p1[r + e] = z - g;
                    if (DIAG) { const int key = kbase + (i < 4 ? 0 : 32) + 16 * ((r + e) >> 3) + ((r + e) & 7); g = (key < W.qabs) ? g : 0.f; }
                    lg[e] = g; }
                if (i == 0 && jj == 0) { lfirst = -lg[0]; pz0 = p0[0]; }
                lf[2 * (i >> 2) + (r >> 3)][(r & 7) >> 1] = pk_f16(-lg[0], -lg[1]); }
            if (i & 1) { n1 = ATT_MFMA(kcur, qcur, n1); qcur = qnxt; } else n0 = ATT_MFMA(kcur, qcur, n0);
            kcur = knxt;
            ATT_SB();
        }
        bf16x8 va = ATT_VF(0), vb = ATT_VF(1), vna = va, vnb = vb;
#pragma unroll
        for (int r = 0; r < 16; ++r) { p0[r] += carry; p1[r] += carry; }
        p0 = ATT_MFMAH(W.mtri0, __builtin_bit_cast(f16x8, lf[0]), p0); p1 = ATT_MFMAH(W.mtri0, __builtin_bit_cast(f16x8, lf[2]), p1);
        p0 = ATT_MFMAH(W.mtri1, __builtin_bit_cast(f16x8, lf[1]), p0); p1 = ATT_MFMAH(W.mtri1, __builtin_bit_cast(f16x8, lf[3]), p1);
        p0 = ATT_MFMAH(W.mones, __builtin_bit_cast(f16x8, lf[2]), p0);
        p0 = ATT_MFMAH(W.mones, __builtin_bit_cast(f16x8, lf[3]), p0);
        ATT_SB();
        const float t00 = p0[0];
#pragma unroll
        for (int c = 0; c < 4; ++c) {
            if (c < 3) { vna = ATT_VF(2 * c + 2); vnb = ATT_VF(2 * c + 3); }
#pragma unroll
            for (int j = 0; j < 4; ++j) { const int r = 8 * (c & 1) + 2 * j; float w[2];
#pragma unroll
                for (int e = 0; e < 2; ++e) { const float t = (c < 2) ? p0[r + e] : p1[r + e]; float x = __builtin_amdgcn_exp2f(t);
                    if (DIAG) { const int key = kbase + (c < 2 ? 0 : 32) + 16 * ((r + e) >> 3) + ((r + e) & 7); x = (key < W.qabs) ? x : 0.f; }
                    w[e] = x; }
                wf[c][j] = pk_bf16(w[0], w[1]); }
            o0 = ATT_MFMA(va, __builtin_bit_cast(bf16x8, wf[c]), o0); o1 = ATT_MFMA(vb, __builtin_bit_cast(bf16x8, wf[c]), o1);
            va = vna; vb = vnb;
            ATT_SB();
        }
        carry = half_sum(W.hi == 0 ? (t00 - pz0) + lfirst : 0.f);
    } else {
#define ATT_FBV(i) (*(const LAS f32x4*)(Fb + 8 * W.hi + 32 * ((i) >> 2) + 16 * (((i) >> 1) & 1) + 4 * ((i) & 1)))
        f32x4 fcur = ATT_FBV(0), fnxt = fcur;
        float mx = -1e30f;
#pragma unroll
        for (int i = 0; i < 8; ++i) {
            if (i < 7) { knxt = ATT_KF(i + 1); fnxt = ATT_FBV(i + 1); if (i & 1) qnxt = ATT_QF((i + 1) >> 1); }
#pragma unroll
            for (int e = 0; e < 4; ++e) { const int r = (4 * i + e) & 15; float s = ((i < 4) ? p0[r] : p1[r]) - fcur[e];
                if (DIAG) { const int key = kbase + (i < 4 ? 0 : 32) + 16 * (r >> 3) + (r & 7); s = (key > W.qabs) ? -1e30f : s; }
                if (i < 4) p0[r] = s; else p1[r] = s; mx = fmaxf(mx, s); }
            if (i & 1) { n1 = ATT_MFMA(kcur, qcur, n1); qcur = qnxt; } else n0 = ATT_MFMA(kcur, qcur, n0);
            kcur = knxt; fcur = fnxt;
            ATT_SB();
        }
        bf16x8 va = ATT_VF(0), vb = ATT_VF(1), vna = va, vnb = vb;
        mx = half_max(mx);
        if (__any(mx > carry)) {
            const float mnew = fmaxf(carry, mx), alpha = __builtin_amdgcn_exp2f(carry - mnew); carry = mnew; lsum *= alpha;
#pragma unroll
            for (int r = 0; r < 16; ++r) { o0[r] *= alpha; o1[r] *= alpha; }
        }
        ATT_SB();
        float ps = 0.f;
#pragma unroll
        for (int c = 0; c < 4; ++c) {
            if (c < 3) { vna = ATT_VF(2 * c + 2); vnb = ATT_VF(2 * c + 3); }
#pragma unroll
            for (int j = 0; j < 4; ++j) { const int r = 8 * (c & 1) + 2 * j;
                const float a = __builtin_amdgcn_exp2f(((c < 2) ? p0[r] : p1[r]) - carry), d = __builtin_amdgcn_exp2f(((c < 2) ? p0[r + 1] : p1[r + 1]) - carry);
                ps += a + d; wf[c][j] = pk_bf16(a, d); }
            o0 = ATT_MFMA(va, __builtin_bit_cast(bf16x8, wf[c]), o0); o1 = ATT_MFMA(vb, __builtin_bit_cast(bf16x8, wf[c]), o1);
            va = vna; vb = vnb;
            ATT_SB();
        }
        lsum += half_sum(ps);
    }
    p0 = n0; p1 = n1;
#undef ATT_KF
#undef ATT_QF
#undef ATT_VF
#undef ATT_FBV
}

template <int KIND>
__device__ __forceinline__ void unit(const Tensors& T, int b, int h, int qb, LAS unsigned char* lds, int wave) {
    int lane_ = (int)__builtin_amdgcn_mbcnt_hi(~0u, __builtin_amdgcn_mbcnt_lo(~0u, 0u)); asm volatile("" : "+v"(lane_));
    const int wid = wave, lane = lane_, tid = wid * 64 + lane;
    WaveCtx W; W.r32 = lane & 31; W.hi = lane >> 5;
    const int q0 = qb * 256, qw0 = q0 + wid * 32; W.qabs = qw0 + W.r32;
    const size_t rowbase = (size_t)b * SEQ;
    const int ktd = qw0 >> 6;
    const int kt_hi = (q0 + 255) >> 6;
    const int srow = tid >> 3, cg = (tid & 7) ^ ((srow >> 1) & 7);
    const bf16* kg = T.proj + (rowbase + srow) * NPROJ + T.colk + h * 64 + cg * 8;
    const bf16* vg = T.vt + ((size_t)(b * 6 + h) * 64 + srow) * SEQ + cg * 8;
    const float* fg = T.fcum + (size_t)(b * 6 + h) * SEQ;
    LAS unsigned char* qlds = lds + OFF_Q + wid * 4608;
    W.qb = qlds + W.r32 * 144 + W.hi * 16;
    { const bf16* qp = T.proj + (rowbase + W.qabs) * NPROJ + T.colq + h * 64 + W.hi * 8;
      v4u qt[4];
#pragma unroll
      for (int d0 = 0; d0 < 4; ++d0) qt[d0] = *(const v4u*)(qp + d0 * 16);
#pragma unroll
      for (int d0 = 0; d0 < 4; ++d0) *(LAS v4u*)(qlds + W.r32 * 144 + W.hi * 16 + 32 * d0) = qt[d0]; }
    const int pm = pim(W.r32);
#pragma unroll
    for (int j = 0; j < 4; ++j) W.ko[j] = pm * KROW + (((2 * j + W.hi) ^ ((pm >> 1) & 7)) << 4);
#pragma unroll
    for (int i = 0; i < 8; ++i) { W.mtri0[i] = (_Float16)((8 * W.hi + i > pm) ? 1.0f : 0.0f); W.mtri1[i] = (_Float16)((16 + 8 * W.hi + i > pm) ? 1.0f : 0.0f); W.mones[i] = (_Float16)1.0f; }
    f32x16 o0, o1, p0, p1;
#pragma unroll
    for (int r = 0; r < 16; ++r) { o0[r] = 0.f; o1[r] = 0.f; p0[r] = 0.f; p1[r] = 0.f; }
    float carry = (KIND == 1) ? -1e30f : 0.f, lsum = 0.f;
#define ATT_KB(t) (lds + OFF_K + ((t) & 1) * TILE_B)
#define ATT_VB(t) (lds + OFF_V + ((t) & 1) * TILE_B)
#define ATT_FB(t) ((LAS float*)(lds + OFF_F + ((t) & 1) * 256))
#define ATT_DMA(gsrc, ldst) glds16((gsrc), (unsigned)__builtin_amdgcn_readfirstlane((int)(uintptr_t)((ldst) + wid * 1024)))
    ATT_DMA(kg + (size_t)kt_hi * 64 * NPROJ, ATT_KB(kt_hi)); ATT_DMA(vg + kt_hi * 64, ATT_VB(kt_hi)); ATT_DMA(kg + (size_t)(kt_hi - 1) * 64 * NPROJ, ATT_KB(kt_hi - 1));
    if (KIND == 1 && tid < 64) ATT_FB(kt_hi)[tid] = fg[kt_hi * 64 + tid];
    asm volatile("s_waitcnt vmcnt(0)" ::: "memory");
    __syncthreads();
    if (ktd == kt_hi) qk_only(p0, p1, ATT_KB(kt_hi), W);
    __syncthreads();
#ifdef TPROBE
    unsigned long long tacc = 0ull;
#endif
    for (int kt = kt_hi; kt >= 0; --kt) {
        float freg = 0.f;
#ifdef TPROBE
        const unsigned long long tp0 = __builtin_readcyclecounter();
#endif
        if (kt >= 2) ATT_DMA(kg + (size_t)(kt - 2) * 64 * NPROJ, ATT_KB(kt - 2));
        if (kt >= 1) { ATT_DMA(vg + (kt - 1) * 64, ATT_VB(kt - 1)); if (KIND == 1 && tid < 64) freg = fg[(kt - 1) * 64 + tid]; }
#ifdef TPROBE
        const unsigned long long tp1 = __builtin_readcyclecounter();
#endif
        if (kt <= ktd) {
            if (kt == ktd) tile<KIND, true>(p0, p1, o0, o1, carry, lsum, ATT_KB(kt - 1), ATT_VB(kt), ATT_FB(kt), kt, W);
            else tile<KIND, false>(p0, p1, o0, o1, carry, lsum, ATT_KB(kt - 1), ATT_VB(kt), ATT_FB(kt), kt, W);
        } else if (kt - 1 == ktd) qk_only(p0, p1, ATT_KB(kt - 1), W);
        if (KIND == 1 && kt >= 1 && tid < 64) ATT_FB(kt - 1)[tid] = freg;
#ifdef TPROBE
        const unsigned long long tp2 = __builtin_readcyclecounter();
#endif
        asm volatile("s_waitcnt vmcnt(0)" ::: "memory");
#ifdef ATT_LDSFLUSH
        { unsigned dummy; asm volatile("ds_read_b32 %0, %1\n\ts_waitcnt lgkmcnt(0)" : "=v"(dummy) : "v"((unsigned)(uintptr_t)(lds + OFF_V + wid * 1024 + lane * 16)) : "memory"); }
#endif
        __syncthreads();
#ifdef TPROBE
        const unsigned long long tp3 = __builtin_readcyclecounter();
        tacc += (TPROBE == 1) ? (tp3 - tp2) : (TPROBE == 2) ? (tp3 - tp0) : (TPROBE == 3) ? (tp2 - tp1) : (tp1 - tp0);
        asm volatile("" :: "s"(tp0), "s"(tp1), "s"(tp2), "s"(tp3));
#endif
    }
#ifdef TPROBE
    if (blockIdx.x == TPROBE_BLK && tid == TPROBE_WAVE * 64) atomicAdd((unsigned long long*)T.tprobe, tacc);
#endif
#undef ATT_KB
#undef ATT_VB
#undef ATT_FB
#undef ATT_DMA
    if (KIND == 1) { const float inv = 1.0f / lsum;
#pragma unroll
        for (int r = 0; r < 16; ++r) { o0[r] *= inv; o1[r] *= inv; } }
    float ss = 0.f;
#pragma unroll
    for (int r = 0; r < 16; ++r) ss += o0[r] * o0[r] + o1[r] * o1[r];
    ss = half_sum(ss);
    const float rinv = 1.0f / sqrtf(ss * (1.0f / 64.0f) + EPS);
    const float* gp = T.ong + T.coly + h * 64 + 8 * W.hi;
    bf16* yp = T.ymix + (rowbase + W.qabs) * DM + T.coly + h * 64 + 8 * W.hi;
#pragma unroll
    for (int d0 = 0; d0 < 2; ++d0)
#pragma unroll
        for (int g = 0; g < 2; ++g) { const f32x4 ga = *(const f32x4*)(gp + 32 * d0 + 16 * g), gb = *(const f32x4*)(gp + 32 * d0 + 16 * g + 4);
            float v[8];
#pragma unroll
            for (int i = 0; i < 8; ++i) v[i] = (d0 == 0 ? o0[8 * g + i] : o1[8 * g + i]) * rinv * (i < 4 ? ga[i & 3] : gb[i & 3]);
            v4u w; w.x = pk_bf16(v[0], v[1]); w.y = pk_bf16(v[2], v[3]); w.z = pk_bf16(v[4], v[5]); w.w = pk_bf16(v[6], v[7]);
            *(v4u*)(yp + 32 * d0 + 16 * g) = w; }
}
}
constexpr size_t MiB = 1u << 20;
constexpr size_t WS_CTL = 0, CTL_ZERO_BYTES = 1 * MiB;
constexpr size_t WS_MODP = 1 * MiB;
constexpr size_t WS_TOPW = 3 * MiB;
constexpr size_t WS_ROUTE = WS_TOPW + 512 * 1024;
constexpr size_t WS_TOKSLOT = WS_ROUTE + 512 * 1024;
constexpr size_t WS_SLOTTOK = WS_TOKSLOT + 512 * 1024;
constexpr size_t WS_HIST = WS_SLOTTOK + 576 * 1024;
constexpr size_t WS_MOETAB = WS_HIST + 32 * 1024;
constexpr size_t WS_LOGF = 6 * MiB;
constexpr size_t WS_FCUM = 7 * MiB;
constexpr size_t WS_WIN = 8 * MiB, WS_WOUT = 20 * MiB, WS_W1 = 24 * MiB, WS_W2 = 280 * MiB;
constexpr size_t WS_H = 408 * MiB;
constexpr size_t WS_PROJ = 472 * MiB;
constexpr size_t WS_VT = 664 * MiB;
constexpr size_t WS_YMIX = 712 * MiB;
constexpr size_t WS_XA = 776 * MiB, WS_XB = 904 * MiB;
constexpr size_t WS_ACT = 1032 * MiB, WS_Y = 1304 * MiB, WS_H8 = 1576 * MiB, WS_END = 1608 * MiB;
static_assert(WS_MOETAB + 256 <= WS_LOGF && (size_t)NSLOT_MAX * 4 <= 576 * 1024 && (size_t)NSLOT_MAX * DM * 2 <= 272 * MiB, "ws map");
#ifndef P2_FP8
#define P2_FP8 0
#endif
constexpr int CW_BAR = 4096;

constexpr int RING_BYTES = 131072;
constexpr int MISC_OFF = RING_BYTES;
constexpr int LDS_BYTES = 147456;

#define RLX_AGENT __ATOMIC_RELAXED, __HIP_MEMORY_SCOPE_AGENT
__device__ __forceinline__ unsigned f2bf(float f) { unsigned u = __builtin_bit_cast(unsigned, f); return (u + 0x7fffu + ((u >> 16) & 1u)) >> 16; }
__device__ __forceinline__ unsigned pk2(float lo, float hi) { return f2bf(lo) | (f2bf(hi) << 16); }
__device__ __forceinline__ float bflo(unsigned u) { return __builtin_bit_cast(float, u << 16); }
__device__ __forceinline__ float bfhi(unsigned u) { return __builtin_bit_cast(float, u & 0xffff0000u); }
__device__ __forceinline__ int shxi(int v, int o, int lane) {
    if (o == 1) return __builtin_amdgcn_mov_dpp(v, 0xB1, 0xf, 0xf, true);
    if (o == 2) return __builtin_amdgcn_mov_dpp(v, 0x4E, 0xf, 0xf, true);
    if (o == 4) return __builtin_amdgcn_ds_swizzle(v, 0x101F);
    if (o == 8) return __builtin_amdgcn_ds_swizzle(v, 0x201F);
    if (o == 16) return __builtin_amdgcn_ds_swizzle(v, 0x401F);
    return __builtin_amdgcn_ds_bpermute((lane ^ o) << 2, v);
}
__device__ __forceinline__ float shx(float v, int o, int lane) { return __builtin_bit_cast(float, shxi(__builtin_bit_cast(int, v), o, lane)); }
__device__ __forceinline__ float shup(float v, int o, int lane) { return __builtin_bit_cast(float, __builtin_amdgcn_ds_bpermute(((lane - o) & 63) << 2, __builtin_bit_cast(int, v))); }
__device__ __forceinline__ float add_other_half(float v) { auto rr = __builtin_amdgcn_permlane32_swap(__float_as_uint(v), __float_as_uint(v), false, false); return __uint_as_float(rr[0]) + __uint_as_float(rr[1]); }
__device__ __forceinline__ float wave_sum(float v, int lane) {
    v += shx(v, 1, lane); v += shx(v, 2, lane); v += shx(v, 4, lane); v += shx(v, 8, lane); v += shx(v, 16, lane);
    return add_other_half(v);
}

#define XB_TMO      128
#define XB_XCNT(j)  (256  + 64 * (j))
#define XB_XSUB(j)  (1280 + 64 * (j))
#define XB_XGEN(j)  (2304 + 64 * (j))
#define XB_TOP      3328
#define XB_TOPGEN   3392
#define XCD_BAR_WORDS 3456
#define XB_SPIN_CAP (1u << 18)
__device__ __forceinline__ unsigned xb_ld(unsigned* p)              { return __hip_atomic_load(p, __ATOMIC_RELAXED, __HIP_MEMORY_SCOPE_AGENT); }
__device__ __forceinline__ unsigned xb_add(unsigned* p, unsigned v) { return __hip_atomic_fetch_add(p, v, __ATOMIC_RELAXED, __HIP_MEMORY_SCOPE_AGENT); }
__device__ __forceinline__ unsigned xb_xcc_id() { return (unsigned)__builtin_amdgcn_s_getreg((3 << 11) | 20) & 0xFu; }
#define XB_SPIN(cond, bar) do { unsigned _sp = 0; while (cond) { __builtin_amdgcn_s_sleep(1); \
    if ((++_sp & 255u) == 0u) { if (xb_ld(&(bar)[XB_TMO])) break; if (_sp > XB_SPIN_CAP) { atomicAdd(&(bar)[XB_TMO], 1u); break; } } } } while (0)
__device__ __forceinline__ int lane_id() { return (int)__builtin_amdgcn_mbcnt_hi(~0u, __builtin_amdgcn_mbcnt_lo(~0u, 0u)); }
struct XcdBarrier { unsigned* bar; unsigned x; volatile LAS unsigned* st; int wave; };
__device__ __forceinline__ XcdBarrier xcd_barrier_post(unsigned* bar, volatile LAS unsigned* st, int wave) {
    XcdBarrier b; b.bar = bar; b.x = (unsigned)__builtin_amdgcn_readfirstlane((int)xb_xcc_id()); b.st = st; b.wave = wave;
    if (wave == 0 && lane_id() == 0) (void)xb_add(&bar[XB_XCNT(b.x)], 1u);
    return b;
}
__device__ __forceinline__ void xcd_barrier_complete(unsigned* bar, unsigned x, unsigned& nloc, unsigned& nx) {
    const unsigned G = gridDim.x * gridDim.y * gridDim.z;
    unsigned sum, cnt, mine, sp = 0u;
    for (;;) {
        sum = 0u; cnt = 0u; mine = 0u;
#pragma unroll
        for (unsigned j = 0; j < 16; ++j) { const unsigned c = xb_ld(&bar[XB_XCNT(j)]); sum += c; cnt += (c > 0u) ? 1u : 0u; mine = (j == x) ? c : mine; }
        if (sum == G) break;
        __builtin_amdgcn_s_sleep(1);
        if ((++sp & 255u) == 0u) { if (xb_ld(&bar[XB_TMO])) break; if (sp > XB_SPIN_CAP) { atomicAdd(&bar[XB_TMO], 1u); break; } }
    }
    nloc = mine > 0u ? mine : 1u; nx = cnt > 0u ? cnt : 1u;
}
__device__ __forceinline__ void xcd_barrier(const XcdBarrier& b) {
    asm volatile("s_waitcnt vmcnt(0)" ::: "memory");
    __syncthreads();
    if (b.wave == 0 && lane_id() == 0) {
        unsigned* bar = b.bar; const unsigned bx = (unsigned)__builtin_amdgcn_readfirstlane((int)xb_xcc_id());
        __builtin_amdgcn_s_waitcnt(0);
        unsigned nloc = b.st[0], nx = b.st[1];
        if (nloc == 0u) { xcd_barrier_complete(bar, bx, nloc, nx); b.st[0] = nloc; b.st[1] = nx; }
        const unsigned old = xb_add(&bar[XB_XSUB(bx)], 1u);
        const unsigned gen = old / nloc;
        if (old + 1u == (gen + 1u) * nloc) {
            __builtin_amdgcn_fence(__ATOMIC_RELEASE, "agent");
            asm volatile("s_waitcnt vmcnt(0)" ::: "memory");
            const unsigned og = xb_add(&bar[XB_TOP], 1u);
            const unsigned tg = og / nx;
            if (og + 1u == (tg + 1u) * nx) xb_add(&bar[XB_TOPGEN], 1u);
            else XB_SPIN(xb_ld(&bar[XB_TOPGEN]) == tg, bar);
            __builtin_amdgcn_fence(__ATOMIC_ACQUIRE, "agent");
            xb_add(&bar[XB_XGEN(bx)], 1u);
            asm volatile("s_waitcnt vmcnt(0)" ::: "memory");
        } else {
            XB_SPIN(xb_ld(&bar[XB_XGEN(bx)]) == gen, bar);
            __builtin_amdgcn_fence(__ATOMIC_ACQUIRE, "agent");
            asm volatile("s_waitcnt vmcnt(0)" ::: "memory");
        }
    }
    __syncthreads();
}

struct Frame {
    LAS unsigned char* lds;
    int tid, lane, wave, blk, G;
    const float* in[21];
    float* out; unsigned char* ws;
};
enum { I_X = 0, I_C, I_N1G, I_WADA, I_BADA, I_WIN, I_CONVW, I_SBQG, I_SBKG, I_FXQG, I_FXKG, I_FXFB, I_ONG, I_WOUT, I_N2G, I_RW, I_RB, I_W1, I_B1, I_W2, I_B2 };

template <int MAP, bool WIDE, bool OUT8 = false>
__device__ __forceinline__ void p0_transpose_item(const float* W, int ldw, bf16* WT, LAS float* scr, int k0, int n0, int lane) {
    if (WIDE) {
        f32x4 t[8];
#pragma unroll
        for (int i = 0; i < 8; ++i) t[i] = __builtin_nontemporal_load((const f32x4*)(W + (size_t)(k0 + 8 * i + (lane >> 3)) * ldw + n0 + 4 * (lane & 7)));
#pragma unroll
        for (int i = 0; i < 8; ++i) { LAS float* d = scr + (8 * i + (lane >> 3)) * 33 + 4 * (lane & 7); d[0] = t[i].x; d[1] = t[i].y; d[2] = t[i].z; d[3] = t[i].w; }
    } else {
#pragma unroll 8
        for (int i = 0; i < 32; ++i) { const int kk = 2 * i + (lane >> 5); scr[kk * 33 + (lane & 31)] = W[(size_t)(k0 + kk) * ldw + n0 + (lane & 31)]; }
    }
    asm volatile("s_waitcnt lgkmcnt(0)" ::: "memory");
    const int c = lane & 7;
#pragma unroll
    for (int j = 0; j < 4; ++j) { const int n = (lane >> 3) + 8 * j; const LAS float* s = scr + (8 * c) * 33 + n;
        v4u o; o.x = pk2(s[0 * 33], s[1 * 33]); o.y = pk2(s[2 * 33], s[3 * 33]); o.z = pk2(s[4 * 33], s[5 * 33]); o.w = pk2(s[6 * 33], s[7 * 33]);
        const int cn = n0 + n; int row = cn;
        if (MAP == 1) { const int jj = cn >> 1, t = cn & 1; row = 256 * (jj >> 7) + 128 * t + (jj & 127); }
        if (OUT8) { v2u o8; o8.x = pg8::pk4_fp8(32.0f * s[0 * 33], 32.0f * s[1 * 33], 32.0f * s[2 * 33], 32.0f * s[3 * 33]); o8.y = pg8::pk4_fp8(32.0f * s[4 * 33], 32.0f * s[5 * 33], 32.0f * s[6 * 33], 32.0f * s[7 * 33]);
            *(v2u*)((unsigned char*)WT + (size_t)row * 1024 + k0 + 8 * c) = o8; }
        else *(v4u*)(WT + (size_t)row * 1024 + k0 + 8 * c) = o; }
    asm volatile("s_waitcnt lgkmcnt(0)" ::: "memory");
}
__device__ __forceinline__ void p0_prologue(Frame& F) {
    LAS float* scr = (LAS float*)(F.lds + F.wave * 16384);
    const int gw = F.blk * 8 + F.wave, NGW = F.G * 8;
    constexpr int N_ADA = NLAYER * 4 * 24;
    if (F.blk * 8 < N_ADA) {
        LAS float* sl = (LAS float*)(F.lds + 8 * 16384 - 32768);
        for (int i = F.tid; i < NB * DM; i += 512) { const float cv = F.in[I_C][i]; sl[i] = cv / (1.0f + __expf(-cv)); }
        __syncthreads();
        if (gw < N_ADA) {
            const int it = gw; const int l = it / 96, ks = (it / 24) & 3, nc = it % 24;
            const float* W = F.in[I_WADA] + (size_t)l * DM * 6144 + nc * 256 + F.lane * 4;
            f32x4 acc[NB];
#pragma unroll
            for (int b = 0; b < NB; ++b) acc[b] = (f32x4){0.f, 0.f, 0.f, 0.f};
#pragma unroll 8
            for (int k = ks * 256; k < ks * 256 + 256; ++k) {
                const f32x4 w = __builtin_nontemporal_load((const f32x4*)(W + (size_t)k * 6144));
#pragma unroll
                for (int b = 0; b < NB; ++b) acc[b] += w * sl[b * DM + k];
            }
            float* dst = (float*)(F.ws + WS_MODP) + ((size_t)(l * 4 + ks) * NB) * 6144 + nc * 256 + F.lane * 4;
#pragma unroll
            for (int b = 0; b < NB; ++b) *(f32x4*)(dst + (size_t)b * 6144) = acc[b];
        }
        __syncthreads();
    }
    constexpr int I_IN = 16 * 96, I_OUT = 16 * 32, I_1 = 16 * 64, I_2 = 16 * 32;
    constexpr int N_IN = NLAYER * I_IN, N_OUT = NLAYER * I_OUT, N_1 = NLAYER * NEXP * I_1, N_2 = NLAYER * NEXP * I_2;
#pragma unroll 1
    for (int it = gw; it < N_IN + N_OUT; it += NGW) {
        int r = it;
        if (r < N_IN) { const int l = r / I_IN, q = r % I_IN, kb = q / 96, nb = q % 96;
            p0_transpose_item<0, false, P2_FP8>(F.in[I_WIN] + (size_t)l * DM * D_IN, D_IN, (bf16*)(F.ws + WS_WIN + (size_t)l * NPROJ * DM * (P2_FP8 ? 1 : 2)), scr, 64 * kb, 32 * nb, F.lane); continue; }
        r -= N_IN;
        { const int l = r / I_OUT, q = r % I_OUT, kb = q / 32, nb = q % 32;
            p0_transpose_item<0, true>(F.in[I_WOUT] + (size_t)l * DM * DM, DM, (bf16*)(F.ws + WS_WOUT) + (size_t)l * DM * DM, scr, 64 * kb, 32 * nb, F.lane); }
    }
    constexpr int ADA_SKIP = 6, NE = N_1 + N_2;
    const bool adaw = gw < N_ADA; const int pool = adaw ? -1 : (gw - N_ADA < N_ADA * ADA_SKIP ? gw - N_ADA : -1);
    const int pool_it = (pool >= 0) ? (pool % N_ADA) + (pool / N_ADA) * NGW : -1;
    f32x4 cur[8], nxt[8];
#define P0_LOAD(dst, itx_) do { const int it_ = ((itx_) < 0) ? pool_it : (itx_); const float* s_; int ldw_; \
        if (it_ < N_1) { const int le = it_ / I_1, q = it_ % I_1, kb = q / 64, nb = q % 64; ldw_ = 2048; s_ = F.in[I_W1] + (size_t)le * DM * 2048 + (size_t)(64 * kb + (F.lane >> 3)) * 2048 + 32 * nb + 4 * (F.lane & 7); } \
        else { const int r_ = it_ - N_1; const int le = r_ / I_2, q = r_ % I_2, kb = q / 32, nb = q % 32; ldw_ = DM; s_ = F.in[I_W2] + (size_t)le * DM * DM + (size_t)(64 * kb + (F.lane >> 3)) * DM + 32 * nb + 4 * (F.lane & 7); } \
        _Pragma("unroll") for (int i = 0; i < 8; ++i) dst[i] = __builtin_nontemporal_load((const f32x4*)(s_ + (size_t)(8 * i) * ldw_)); } while (0)
    int itx = adaw ? gw + ADA_SKIP * NGW : (pool >= 0 ? gw - NGW : gw);
    if (itx < NE) P0_LOAD(cur, itx);
#pragma unroll 1
    for (; itx < NE; itx += NGW) {
        if (itx + NGW < NE) P0_LOAD(nxt, itx + NGW);
#pragma unroll
        for (int i = 0; i < 8; ++i) { LAS float* d = scr + (8 * i + (F.lane >> 3)) * 33 + 4 * (F.lane & 7); d[0] = cur[i].x; d[1] = cur[i].y; d[2] = cur[i].z; d[3] = cur[i].w; }
        asm volatile("s_waitcnt lgkmcnt(0)" ::: "memory");
        { const int it = (itx < 0) ? pool_it : itx; const bool isw1 = it < N_1; const int r = isw1 ? it : it - N_1;
          const int per = isw1 ? I_1 : I_2, nbn = isw1 ? 64 : 32; const int le = r / per, q = r % per, kb = q / nbn, nb = q % nbn;
          unsigned char* WT = isw1 ? F.ws + WS_W1 + (size_t)le * 2048 * DM : F.ws + WS_W2 + (size_t)le * DM * DM;
          const int c = F.lane & 7;
#pragma unroll
          for (int j = 0; j < 4; ++j) { const int n = (F.lane >> 3) + 8 * j; const LAS float* s = scr + (8 * c) * 33 + n;
              v2u o8; o8.x = pg8::pk4_fp8(32.0f * s[0 * 33], 32.0f * s[1 * 33], 32.0f * s[2 * 33], 32.0f * s[3 * 33]); o8.y = pg8::pk4_fp8(32.0f * s[4 * 33], 32.0f * s[5 * 33], 32.0f * s[6 * 33], 32.0f * s[7 * 33]);
              const int cn = 32 * nb + n; int row = cn;
              if (isw1) { const int jj = cn >> 1, t = cn & 1; row = 256 * (jj >> 7) + 128 * t + (jj & 127); }
              *(v2u*)(WT + (size_t)row * 1024 + 64 * kb + 8 * c) = o8; } }
        asm volatile("s_waitcnt lgkmcnt(0)" ::: "memory");
#pragma unroll
        for (int i = 0; i < 8; ++i) cur[i] = nxt[i];
    }
#undef P0_LOAD
}

__device__ __forceinline__ f32x4 mod4(const Frame& F, int l, int b, int which, int c) {
    const int n = which * DM + c;
    f32x4 s = *(const f32x4*)(F.in[I_BADA] + (size_t)l * 6144 + n);
    const float* p = (const float*)(F.ws + WS_MODP) + ((size_t)(l * 4) * NB + b) * 6144 + n;
#pragma unroll
    for (int ks = 0; ks < 4; ++ks) s += *(const f32x4*)(p + (size_t)ks * NB * 6144);
    return s;
}

constexpr size_t WS_GSUM = WS_FCUM + 800 * 1024;
static_assert(WS_GSUM + 16384 <= WS_WIN, "ws map");
template <bool S16> __device__ __forceinline__ f32x4 ld_row4(const void* base, size_t idx) {
    if (S16) { const v2u t = *(const v2u*)((const bf16*)base + idx); return (f32x4){bflo(t.x), bfhi(t.x), bflo(t.y), bfhi(t.y)}; }
    return *(const f32x4*)((const float*)base + idx); }
template <bool D16> __device__ __forceinline__ void st_row4(void* base, size_t idx, f32x4 v) {
    if (D16) { v2u o; o.x = pk2(v.x, v.y); o.y = pk2(v.z, v.w); *(v2u*)((bf16*)base + idx) = o; }
    else *(f32x4*)((float*)base + idx) = v; }
__device__ __forceinline__ f32x4 fp8x4_to_f32(unsigned w) { return (f32x4){__builtin_amdgcn_cvt_f32_fp8(w, 0), __builtin_amdgcn_cvt_f32_fp8(w, 1), __builtin_amdgcn_cvt_f32_fp8(w, 2), __builtin_amdgcn_cvt_f32_fp8(w, 3)}; }
template <bool COMBINE, bool NORM, bool S16, bool D16>
__device__ __forceinline__ void row_phase(Frame& F, int l, const void* xsrc, void* xdst) {
    const float* topw = (const float*)(F.ws + WS_TOPW); const int* tokslot = (const int*)(F.ws + WS_TOKSLOT); const unsigned char* Y = F.ws + WS_Y;
    bf16* H = (bf16*)(F.ws + WS_H); float* logf = (float*)(F.ws + WS_LOGF); float* gsum = (float*)(F.ws + WS_GSUM);
    LAS f32x4* wl4 = (LAS f32x4*)F.lds; LAS f32x2* wl2 = (LAS f32x2*)(F.lds + 16384); LAS float* part = (LAS float*)(F.lds + 16384 + 8192);
    if (NORM) { for (int k = F.tid; k < DM; k += 512) { const float* wp = F.in[I_WIN] + (size_t)l * DM * D_IN + (size_t)k * D_IN + NPROJ; const int idx = (4 * (k >> 8) + (k & 3)) * 64 + ((k >> 2) & 63);
            wl4[idx] = (f32x4){wp[0], wp[1], wp[2], wp[3]}; wl2[idx] = (f32x2){wp[4], wp[5]}; }
        __syncthreads(); }
    for (int chunk = F.blk; chunk < NTOK / 128; chunk += F.G) {
        const int b = chunk / (SEQ / 128);
        LAS f32x4* mv = (LAS f32x4*)(F.lds + 32768);
        __syncthreads();
        if (F.wave == 0) {
#pragma unroll
            for (int j = 0; j < 4; ++j) { const int c = 256 * j + 4 * F.lane;
                if (COMBINE) mv[(0 * 4 + j) * 64 + F.lane] = mod4(F, l - 1, b, 5, c);
                if (NORM) { const f32x4 g = *(const f32x4*)(F.in[I_N1G] + (size_t)l * DM + c); mv[(1 * 4 + j) * 64 + F.lane] = g * (mod4(F, l, b, 1, c) + 1.0f); mv[(2 * 4 + j) * 64 + F.lane] = mod4(F, l, b, 0, c); } } }
        __syncthreads();
        float lacc = 0.f;
#pragma unroll 1
        for (int rr = 0; rr < 16; rr += 2) {
            const int row = chunk * 128 + F.wave * 16 + rr;
            f32x4 v[2][4];
#pragma unroll
            for (int u = 0; u < 2; ++u)
#pragma unroll
                for (int j = 0; j < 4; ++j) v[u][j] = ld_row4<S16>(xsrc, (size_t)(row + u) * DM + 256 * j + 4 * F.lane);
            int mofs = F.lane; asm volatile("" : "+v"(mofs));
            if (COMBINE) {
#pragma unroll
                for (int u = 0; u < 2; ++u) {
                    f32x4 s[4];
#pragma unroll
                    for (int j = 0; j < 4; ++j) s[j] = (f32x4){0.f, 0.f, 0.f, 0.f};
#pragma unroll
                    for (int k = 0; k < TOPK; ++k) { const float w = topw[(row + u) * 4 + k]; const int slot = tokslot[(row + u) * 4 + k];
#pragma unroll
                        for (int j = 0; j < 4; ++j) s[j] += fp8x4_to_f32(*(const unsigned*)(Y + (size_t)slot * DM + 256 * j + 4 * F.lane)) * w; }
#pragma unroll
                    for (int j = 0; j < 4; ++j) { v[u][j] += mv[(0 * 4 + j) * 64 + mofs] * s[j]; st_row4<D16>(xdst, (size_t)(row + u) * DM + 256 * j + 4 * F.lane, v[u][j]); }
                }
            }
            if (NORM) {
                float ss[2];
#pragma unroll
                for (int u = 0; u < 2; ++u) { float s = 0.f;
#pragma unroll
                    for (int j = 0; j < 4; ++j) s += (v[u][j].x * v[u][j].x + v[u][j].y * v[u][j].y) + (v[u][j].z * v[u][j].z + v[u][j].w * v[u][j].w);
                    ss[u] = s; }
#pragma unroll
                for (int o = 1; o < 32; o <<= 1) { ss[0] += shx(ss[0], o, F.lane); ss[1] += shx(ss[1], o, F.lane); }
                ss[0] = add_other_half(ss[0]); ss[1] = add_other_half(ss[1]);
                float fl[2][6];
                int lofs = F.lane; asm volatile("" : "+v"(lofs));
#pragma unroll
                for (int u = 0; u < 2; ++u) { const float rstd = 1.0f / sqrtf(ss[u] * (1.0f / DM) + EPS);
#pragma unroll
                    for (int q = 0; q < 6; ++q) fl[u][q] = 0.f;
#pragma unroll
                    for (int j = 0; j < 4; ++j) { const f32x4 hv = v[u][j] * rstd * mv[(1 * 4 + j) * 64 + mofs] + mv[(2 * 4 + j) * 64 + mofs];
                        if (P2_FP8) *(unsigned*)((unsigned char*)H + (size_t)(row + u) * DM + 256 * j + 4 * F.lane) = pg8::pk4_fp8(hv.x, hv.y, hv.z, hv.w);
                        else { v2u o; o.x = pk2(hv.x, hv.y); o.y = pk2(hv.z, hv.w); *(v2u*)(H + (size_t)(row + u) * DM + 256 * j + 4 * F.lane) = o; }
#pragma unroll
                        for (int i = 0; i < 4; ++i) { const f32x4 wa = wl4[(4 * j + i) * 64 + lofs]; const f32x2 wb = wl2[(4 * j + i) * 64 + lofs]; const float hx = hv[i];
                            fl[u][0] += hx * wa.x; fl[u][1] += hx * wa.y; fl[u][2] += hx * wa.z; fl[u][3] += hx * wa.w; fl[u][4] += hx * wb.x; fl[u][5] += hx * wb.y; } } }
#pragma unroll
                for (int o = 1; o < 32; o <<= 1)
#pragma unroll
                    for (int u = 0; u < 2; ++u)
#pragma unroll
                        for (int q = 0; q < 6; ++q) fl[u][q] += shx(fl[u][q], o, F.lane);
#pragma unroll
                for (int u = 0; u < 2; ++u)
#pragma unroll
                    for (int q = 0; q < 6; ++q) fl[u][q] = add_other_half(fl[u][q]);
                if (F.lane < 6) {
#pragma unroll
                    for (int u = 0; u < 2; ++u) { float z = fl[u][0];
#pragma unroll
                        for (int q = 1; q < 6; ++q) z = (F.lane == q) ? fl[u][q] : z;
                        z += F.in[I_FXFB][l * 6 + F.lane];
                        const float lg = fminf(z, 0.f) - __logf(1.0f + __expf(-fabsf(z)));
                        logf[(size_t)(row + u) * 6 + F.lane] = lg; lacc += lg; } }
            }
        }
        if (NORM) {
            if (F.lane < 6) part[F.wave * 8 + F.lane] = lacc;
            __syncthreads();
            if (F.tid < 12) { const int g = F.tid / 6, h = F.tid % 6; gsum[(size_t)(chunk * 2 + g) * 6 + h] = (part[(4 * g) * 8 + h] + part[(4 * g + 1) * 8 + h]) + (part[(4 * g + 2) * 8 + h] + part[(4 * g + 3) * 8 + h]); }
            __syncthreads();
        }
    }
    __syncthreads();
}
__device__ __forceinline__ void p3_postproj(Frame& F, int l) {
    bf16* proj = (bf16*)(F.ws + WS_PROJ); bf16* ymix = (bf16*)(F.ws + WS_YMIX);
    const float* ong = F.in[I_ONG] + (size_t)l * DM;
    const int c4 = 4 * F.lane;
    f32x4 cw[3];
#pragma unroll
    for (int w = 0; w < 3; ++w) cw[w] = *(const f32x4*)(F.in[I_CONVW] + (size_t)(l * 3 + w) * 256 + c4);
    const f32x4 cg = *(const f32x4*)(ong + c4);
    const int e0 = 8 * (F.lane & 7);
    float gq[3][8]; int colv[3];
#pragma unroll
    for (int i = 0; i < 3; ++i) { const int vi = 8 * i + (F.lane >> 3); const int ty = vi / 6;
        colv[i] = (vi < 12 ? COL_SQ + 64 * vi : COL_FQ + 64 * (vi - 12)) + e0;
        const float* gp = (ty == 0 ? F.in[I_SBQG] : ty == 1 ? F.in[I_SBKG] : ty == 2 ? F.in[I_FXQG] : F.in[I_FXKG]) + (size_t)l * 64 + e0; const float sc = (ty == 0 || ty == 2) ? QSCALE : 1.0f;
#pragma unroll
        for (int q = 0; q < 8; ++q) gq[i][q] = gp[q] * sc; }
    LAS unsigned char* scr = F.lds + F.wave * (64 * 144);
    for (int tile = F.blk; tile < NTOK / 64; tile += F.G) {
        const int b = tile / (SEQ / 64), s0 = (tile % (SEQ / 64)) * 64; const size_t row0 = (size_t)b * SEQ + s0;
        {
            const int sw0 = s0 + F.wave * 8;
            f32x4 vm2 = (f32x4){0.f, 0.f, 0.f, 0.f}, vm1 = vm2;
            if (sw0 >= 2) {
                const bf16* p2 = proj + ((size_t)b * SEQ + sw0 - 2) * NPROJ; const bf16* p1 = p2 + NPROJ;
                const v2u c2 = *(const v2u*)(p2 + COL_CC + c4), u2 = *(const v2u*)(p2 + COL_CU + c4), c1 = *(const v2u*)(p1 + COL_CC + c4), u1 = *(const v2u*)(p1 + COL_CU + c4);
                vm2 = (f32x4){bflo(c2.x) * bflo(u2.x), bfhi(c2.x) * bfhi(u2.x), bflo(c2.y) * bflo(u2.y), bfhi(c2.y) * bfhi(u2.y)};
                vm1 = (f32x4){bflo(c1.x) * bflo(u1.x), bfhi(c1.x) * bfhi(u1.x), bflo(c1.y) * bflo(u1.y), bfhi(c1.y) * bfhi(u1.y)}; }
#pragma unroll 1
            for (int tt = 0; tt < 8; tt += 2) {
                bf16* pr[2]; v2u cb[2], cc[2], cu[2]; v4u xq[2][3];
#pragma unroll
                for (int u = 0; u < 2; ++u) { pr[u] = proj + ((size_t)b * SEQ + sw0 + tt + u) * NPROJ;
                    cb[u] = *(const v2u*)(pr[u] + COL_CB + c4); cc[u] = *(const v2u*)(pr[u] + COL_CC + c4); cu[u] = *(const v2u*)(pr[u] + COL_CU + c4);
#pragma unroll
                    for (int i = 0; i < 3; ++i) xq[u][i] = *(const v4u*)(pr[u] + colv[i]); }
                f32x4 y[2]; float ss[2], q2[2][3];
#pragma unroll
                for (int u = 0; u < 2; ++u) {
                    const f32x4 v0 = (f32x4){bflo(cc[u].x) * bflo(cu[u].x), bfhi(cc[u].x) * bfhi(cu[u].x), bflo(cc[u].y) * bflo(cu[u].y), bfhi(cc[u].y) * bfhi(cu[u].y)};
                    y[u] = cw[0] * vm2 + cw[1] * vm1 + cw[2] * v0; vm2 = vm1; vm1 = v0;
                    y[u] = y[u] * (f32x4){bflo(cb[u].x), bfhi(cb[u].x), bflo(cb[u].y), bfhi(cb[u].y)};
                    ss[u] = (y[u].x * y[u].x + y[u].y * y[u].y) + (y[u].z * y[u].z + y[u].w * y[u].w);
#pragma unroll
                    for (int i = 0; i < 3; ++i) { const v4u x = xq[u][i]; const float f[8] = {bflo(x.x), bfhi(x.x), bflo(x.y), bfhi(x.y), bflo(x.z), bfhi(x.z), bflo(x.w), bfhi(x.w)};
                        float a = 0.f;
#pragma unroll
                        for (int k = 0; k < 8; ++k) a += f[k] * f[k];
                        q2[u][i] = a; } }
#pragma unroll
                for (int o = 1; o < 16; o <<= 1)
#pragma unroll
                    for (int u = 0; u < 2; ++u) { ss[u] += shx(ss[u], o, F.lane);
                        if (o < 8) {
#pragma unroll
                            for (int i = 0; i < 3; ++i) q2[u][i] += shx(q2[u][i], o, F.lane); } }
#pragma unroll
                for (int u = 0; u < 2; ++u) {
                    const float rinv = 1.0f / sqrtf(ss[u] * (1.0f / 64.0f) + EPS);
                    const f32x4 yo = y[u] * rinv * cg;
                    v2u o; o.x = pk2(yo.x, yo.y); o.y = pk2(yo.z, yo.w); *(v2u*)(ymix + ((size_t)b * SEQ + sw0 + tt + u) * DM + c4) = o;
#pragma unroll
                    for (int i = 0; i < 3; ++i) { const v4u x = xq[u][i]; const float f[8] = {bflo(x.x), bfhi(x.x), bflo(x.y), bfhi(x.y), bflo(x.z), bfhi(x.z), bflo(x.w), bfhi(x.w)};
                        const float ri = 1.0f / sqrtf(q2[u][i] * (1.0f / 64.0f) + EPS);
                        v4u w; w.x = pk2(f[0] * ri * gq[i][0], f[1] * ri * gq[i][1]); w.y = pk2(f[2] * ri * gq[i][2], f[3] * ri * gq[i][3]);
                        w.z = pk2(f[4] * ri * gq[i][4], f[5] * ri * gq[i][5]); w.w = pk2(f[6] * ri * gq[i][6], f[7] * ri * gq[i][7]);
                        *(v4u*)(pr[u] + colv[i]) = w; } }
            }
        }
        for (int t = F.wave; t < 12; t += 8) {
            const int kind = t / 6, h = t % 6; const int col = (kind ? COL_FV : COL_SV) + 64 * h;
            const bf16* src = proj + (row0 + F.lane) * NPROJ + col;
#pragma unroll
            for (int pc = 0; pc < 8; ++pc) { const v4u x = *(const v4u*)(src + 8 * pc);
                const unsigned xs[4] = {x.x, x.y, x.z, x.w};
#pragma unroll
                for (int q = 0; q < 4; ++q) { *(LAS unsigned short*)(scr + (8 * pc + 2 * q) * 144 + 2 * F.lane) = (unsigned short)(xs[q] & 0xffffu);
                                              *(LAS unsigned short*)(scr + (8 * pc + 2 * q + 1) * 144 + 2 * F.lane) = (unsigned short)(xs[q] >> 16); } }
            asm volatile("s_waitcnt lgkmcnt(0)" ::: "memory");
            bf16* dst = (bf16*)(F.ws + WS_VT) + (size_t)kind * (48 * 64 * SEQ) + ((size_t)(b * 6 + h) * 64 + F.lane) * SEQ + s0;
#pragma unroll
            for (int pc = 0; pc < 8; ++pc) *(v4u*)(dst + 8 * pc) = *(const LAS v4u*)(scr + F.lane * 144 + 16 * pc);
            asm volatile("s_waitcnt lgkmcnt(0)" ::: "memory");
        }
        if (F.wave == 7) { const int gt = tile % (SEQ / 64); const float* gs = (const float*)(F.ws + WS_GSUM) + (size_t)(b * (SEQ / 64)) * 6; const float* lf = (const float*)(F.ws + WS_LOGF) + (row0 + F.lane) * 6;
            float* fo = (float*)(F.ws + WS_FCUM) + (size_t)(b * 6) * SEQ + s0 + F.lane;
#pragma unroll
            for (int h = 0; h < 6; ++h) { float base = (F.lane < gt) ? gs[F.lane * 6 + h] : 0.f; base = wave_sum(base, F.lane);
                float inc = lf[h];
#pragma unroll
                for (int o = 1; o < 64; o <<= 1) { const float t = shup(inc, o, F.lane); if (F.lane >= o) inc += t; }
                fo[(size_t)h * SEQ] = (base + inc) * LOG2E; } }
    }
}

__device__ __forceinline__ void p4_attention(Frame& F, int l) {
    att::Tensors Ts, Tf;
    Ts.proj = (const bf16*)(F.ws + WS_PROJ); Ts.vt = (const bf16*)(F.ws + WS_VT); Ts.fcum = (const float*)(F.ws + WS_FCUM); Ts.ymix = (bf16*)(F.ws + WS_YMIX); Ts.ong = F.in[I_ONG] + (size_t)l * DM;
    Ts.colq = COL_SQ; Ts.colk = COL_SK; Ts.coly = 256; Ts.tprobe = (void*)(F.ws + WS_CTL + 512);
    Tf = Ts; Tf.vt = Ts.vt + (size_t)48 * 64 * SEQ; Tf.colq = COL_FQ; Tf.colk = COL_FK; Tf.coly = 640;
    const int NU = 48 * 16;
    for (int i = 0; i * F.G < NU; ++i) {
        const int L = (i & 1) ? (i + 1) * F.G - 1 - F.blk : i * F.G + F.blk;
        if (L >= NU) continue;
        const int qb = 15 - L / 48, bh = L % 48;
#if defined(ATT_HYB) && (ATT_HYB & 1)
        { att_old::Tensors To; To.proj = Ts.proj; To.ymix = Ts.ymix; To.ong = Ts.ong; To.fcum = Ts.fcum; To.vt = Ts.vt; To.colq = Ts.colq; To.colk = Ts.colk; To.coly = Ts.coly; att_old::unit<0>(To, bh / 6, bh % 6, qb, F.lds, F.wave); }
#else
        att::unit<0>(Ts, bh / 6, bh % 6, qb, F.lds, F.wave);
#endif
    }
    for (int i = 0; i * F.G < NU; ++i) {
        const int L = (i & 1) ? (i + 1) * F.G - 1 - F.blk : i * F.G + F.blk;
        if (L >= NU) continue;
        const int qb = 15 - L / 48, bh = L % 48;
#if defined(ATT_HYB) && (ATT_HYB & 2)
        { att_old::Tensors To; To.proj = Tf.proj; To.ymix = Tf.ymix; To.ong = Tf.ong; To.fcum = Tf.fcum; To.vt = Tf.vt; To.colq = Tf.colq; To.colk = Tf.colk; To.coly = Tf.coly; att_old::unit<1>(To, bh / 6, bh % 6, qb, F.lds, F.wave); }
#else
        att::unit<1>(Tf, bh / 6, bh % 6, qb, F.lds, F.wave);
#endif
    }
}

__device__ __forceinline__ void top4of8(const float (&v)[8], const int (&ix)[8], float (&tv)[4], int (&ti)[4]) {
    float w[8];
#pragma unroll
    for (int j = 0; j < 8; ++j) w[j] = v[j];
#pragma unroll
    for (int k = 0; k < 4; ++k) { float bv = w[0]; int bi = ix[0];
#pragma unroll
        for (int j = 1; j < 8; ++j) { const bool t = (w[j] > bv) || (w[j] == bv && ix[j] < bi); bv = t ? w[j] : bv; bi = t ? ix[j] : bi; }
        tv[k] = bv; ti[k] = bi;
#pragma unroll
        for (int j = 0; j < 8; ++j) w[j] = (ix[j] == bi) ? -INFINITY : w[j]; }
}
__device__ __forceinline__ void p6_norm_router(Frame& F, int l, const bf16* x1) {
    bf16* H = (bf16*)(F.ws + WS_H); unsigned char* H8 = F.ws + WS_H8; float* topw = (float*)(F.ws + WS_TOPW); int* route = (int*)(F.ws + WS_ROUTE); int* hist = (int*)(F.ws + WS_HIST);
    const float* rw = F.in[I_RW] + (size_t)l * DM * NEXP; const float* rb = F.in[I_RB] + (size_t)l * NEXP;
    constexpr int RWP = 2064;
    LAS unsigned char* rwt = F.lds;
    LAS int* cnt = (LAS int*)(F.lds + MISC_OFF + 256);
    {
        f32x4 t[16];
#pragma unroll
        for (int i = 0; i < 16; ++i) t[i] = *(const f32x4*)(rw + (size_t)(2 * F.tid) * NEXP + 4 * i);
#pragma unroll
        for (int i = 0; i < 8; ++i)
#pragma unroll
            for (int c = 0; c < 4; ++c) *(LAS unsigned*)(rwt + (4 * i + c) * RWP + 4 * F.tid) = f2bf(t[i][c]) | (f2bf(t[8 + i][c]) << 16);
    }
    __syncthreads();
    const int fr = F.lane & 15, fq = F.lane >> 4;
    float rbv[8]; int eix[8];
#pragma unroll
    for (int i = 0; i < 4; ++i) { eix[i] = 4 * fq + i; eix[4 + i] = 16 + 4 * fq + i; rbv[i] = rb[4 * fq + i]; rbv[4 + i] = rb[16 + 4 * fq + i]; }
    for (int chunk = F.blk; chunk < NTOK / 128; chunk += F.G) {
        const int b = chunk / (SEQ / 128);
        if (F.tid < 32) cnt[F.tid] = 0;
        __syncthreads();
        f32x4 A[4], Bv[4];
#pragma unroll
        for (int j = 0; j < 4; ++j) { const int c = 256 * j + 4 * F.lane; const f32x4 g = *(const f32x4*)(F.in[I_N2G] + (size_t)l * DM + c); A[j] = g * (mod4(F, l, b, 4, c) + 1.0f); Bv[j] = mod4(F, l, b, 3, c); }
        const int row0 = chunk * 128 + F.wave * 16;
#pragma unroll 1
        for (int rr = 0; rr < 16; rr += 2) {
            f32x4 v[2][4]; float ss[2];
#pragma unroll
            for (int u = 0; u < 2; ++u)
#pragma unroll
                for (int j = 0; j < 4; ++j) v[u][j] = ld_row4<true>(x1, (size_t)(row0 + rr + u) * DM + 256 * j + 4 * F.lane);
#pragma unroll
            for (int u = 0; u < 2; ++u) { float s = 0.f;
#pragma unroll
                for (int j = 0; j < 4; ++j) s += (v[u][j].x * v[u][j].x + v[u][j].y * v[u][j].y) + (v[u][j].z * v[u][j].z + v[u][j].w * v[u][j].w);
                ss[u] = s; }
#pragma unroll
            for (int o = 1; o < 32; o <<= 1) { ss[0] += shx(ss[0], o, F.lane); ss[1] += shx(ss[1], o, F.lane); }
            ss[0] = add_other_half(ss[0]); ss[1] = add_other_half(ss[1]);
#pragma unroll
            for (int u = 0; u < 2; ++u) { const float rstd = 1.0f / sqrtf(ss[u] * (1.0f / DM) + EPS);
#pragma unroll
                for (int j = 0; j < 4; ++j) { const f32x4 hv = v[u][j] * rstd * A[j] + Bv[j];
                    v2u o; o.x = pk2(hv.x, hv.y); o.y = pk2(hv.z, hv.w); *(v2u*)(H + (size_t)(row0 + rr + u) * DM + 256 * j + 4 * F.lane) = o;
                    *(unsigned*)(H8 + (size_t)(row0 + rr + u) * DM + 256 * j + 4 * F.lane) = pg8::pk4_fp8(hv.x, hv.y, hv.z, hv.w); } }
        }
        asm volatile("s_waitcnt vmcnt(0)" ::: "memory");
        f32x4 acc0 = (f32x4){0.f, 0.f, 0.f, 0.f}, acc1 = (f32x4){0.f, 0.f, 0.f, 0.f};
        { const bf16* hp = H + (size_t)(row0 + fr) * DM + 8 * fq; const LAS unsigned char* wp = rwt + fr * RWP + 16 * fq;
#pragma unroll 8
          for (int s = 0; s < 32; ++s) { const v4u hb = __builtin_nontemporal_load((const v4u*)(hp + 32 * s));
              const bf16x8 a0 = *(const LAS bf16x8*)(wp + 64 * s), a1 = *(const LAS bf16x8*)(wp + 16 * RWP + 64 * s);
              acc0 = __builtin_amdgcn_mfma_f32_16x16x32_bf16(a0, __builtin_bit_cast(bf16x8, hb), acc0, 0, 0, 0);
              acc1 = __builtin_amdgcn_mfma_f32_16x16x32_bf16(a1, __builtin_bit_cast(bf16x8, hb), acc1, 0, 0, 0); } }
        float cv[8], tv[4], ov[8]; int ti[4], oi[8];
#pragma unroll
        for (int i = 0; i < 4; ++i) { cv[i] = acc0[i] + rbv[i]; cv[4 + i] = acc1[i] + rbv[4 + i]; }
        top4of8(cv, eix, tv, ti);
        {
#pragma unroll
            for (int k = 0; k < 4; ++k) { ov[k] = tv[k]; oi[k] = ti[k]; ov[4 + k] = shx(tv[k], 16, F.lane); oi[4 + k] = shxi(ti[k], 16, F.lane); }
            top4of8(ov, oi, tv, ti);
#pragma unroll
            for (int k = 0; k < 4; ++k) { auto rv = __builtin_amdgcn_permlane32_swap(__float_as_uint(tv[k]), __float_as_uint(tv[k]), false, false); auto ri = __builtin_amdgcn_permlane32_swap((unsigned)ti[k], (unsigned)ti[k], false, false);
                ov[k] = __uint_as_float(rv[0]); oi[k] = (int)ri[0]; ov[4 + k] = __uint_as_float(rv[1]); oi[4 + k] = (int)ri[1]; }
            top4of8(ov, oi, tv, ti); }
        const float e1 = __expf(tv[1] - tv[0]), e2 = __expf(tv[2] - tv[0]), e3 = __expf(tv[3] - tv[0]); const float inv = 1.0f / (1.0f + e1 + e2 + e3);
        { const int row = row0 + fr, k = fq;
          const float w = (k == 0 ? 1.0f : k == 1 ? e1 : k == 2 ? e2 : e3) * inv; const int ex = (k == 0 ? ti[0] : k == 1 ? ti[1] : k == 2 ? ti[2] : ti[3]);
          const int pos = __hip_atomic_fetch_add(cnt + ex, 1, __ATOMIC_RELAXED, __HIP_MEMORY_SCOPE_WORKGROUP);
          topw[row * 4 + k] = w; route[row * 4 + k] = ex + 32 * pos; }
        __syncthreads();
        if (F.tid < 32) hist[chunk * 32 + F.tid] = cnt[F.tid];
        __syncthreads();
    }
}

__device__ __forceinline__ void p7_scatter(Frame& F) {
    const int* hist = (const int*)(F.ws + WS_HIST); const int* route = (const int*)(F.ws + WS_ROUTE);
    int* tokslot = (int*)(F.ws + WS_TOKSLOT); int* slottok = (int*)(F.ws + WS_SLOTTOK); int* moetab = (int*)(F.ws + WS_MOETAB);
    LAS int* pre = (LAS int*)F.lds;
    LAS int* base = (LAS int*)(F.lds + 32768);
    for (int i = F.tid; i < 256 * 32; i += 512) pre[i] = hist[i];
    __syncthreads();
    if (F.tid < 32) { int run = 0;
        for (int c = 0; c < 256; ++c) { const int v = pre[c * 32 + F.tid]; pre[c * 32 + F.tid] = run; run += v; }
        base[64 + F.tid] = run; }
    __syncthreads();
    if (F.tid == 0) { int run = 0; for (int ex = 0; ex < NEXP; ++ex) { base[ex] = run; run += (base[64 + ex] + 255) & ~255; } base[NEXP] = run; }
    __syncthreads();
    if (F.blk == 0 && F.tid <= NEXP) moetab[F.tid] = base[F.tid] >> 8;
    for (int chunk = F.blk; chunk < NTOK / 128; chunk += F.G) {
        const int t = chunk * 128 + (F.tid >> 2), k = F.tid & 3; const int rt = route[t * 4 + k]; const int ex = rt & 31, pos = rt >> 5;
        const int slot = base[ex] + pre[chunk * 32 + ex] + pos;
        tokslot[t * 4 + k] = slot; slottok[slot] = t;
    }
    for (int ex = F.blk; ex < NEXP; ex += F.G) { const int lo = base[ex] + base[64 + ex], hi = base[ex + 1]; for (int s = lo + F.tid; s < hi; s += 512) slottok[s] = 0; }
    __syncthreads();
}

struct Args { const float* in[21]; float* out; unsigned char* ws; int ph_lo, ph_hi; };
__device__ __forceinline__ void launder(Frame& F, int wave) {
#if 1
    int t = threadIdx.x; asm volatile("" : "+v"(t)); F.tid = t; F.lane = t & 63; F.wave = __builtin_amdgcn_readfirstlane(t >> 6); (void)wave;
#else
    int t = lane_id(); asm volatile("" : "+v"(t)); F.lane = t; F.wave = wave; F.tid = wave * 64 + t;
#endif
    const __attribute__((address_space(4))) Args* ap = (const __attribute__((address_space(4))) Args*)__builtin_amdgcn_kernarg_segment_ptr(); asm volatile("" : "+s"(ap));
#pragma unroll
    for (int i = 0; i < 21; ++i) F.in[i] = ap->in[i];
    F.out = ap->out; F.ws = ap->ws; }
constexpr int N_PHASES = 1 + 9 * NLAYER + 1;

#define PHASE_FN __device__ __forceinline__
__device__ __forceinline__ void make_frame(Frame& F, LAS unsigned char* lds, int wave) { F.lds = lds; int bk = blockIdx.x, gd = gridDim.x; asm volatile("" : "+s"(bk), "+s"(gd)); F.blk = bk; F.G = gd; launder(F, wave); }
PHASE_FN void ph_prologue(LAS unsigned char* lds, int wave) { Frame F; make_frame(F, lds, wave); p0_prologue(F); }
PHASE_FN void ph_norm1(LAS unsigned char* lds, int wave, int l) { Frame F; make_frame(F, lds, wave);
    if (l == 0) row_phase<false, true, false, false>(F, 0, F.in[I_X], nullptr); else row_phase<true, true, true, true>(F, l, F.ws + WS_XA, F.ws + WS_XB); }
PHASE_FN void ph_proj(LAS unsigned char* lds, int wave, int l) { Frame F; make_frame(F, lds, wave);
    pg8::Gemm g{(const bf16*)(F.ws + WS_H), (const bf16*)(F.ws + WS_WIN + (size_t)l * NPROJ * DM * (P2_FP8 ? 1 : 2)), nullptr, P2_FP8 ? DM / 2 : DM};
    pg8::StaticOrder S; S.init(NTOK, NPROJ, F.G, F.blk);
    pg8::EpiProj E{(bf16*)(F.ws + WS_PROJ), NPROJ};
    pg8::gemm_phase<pg8::EpiProj, pg8::StaticOrder, false, P2_FP8 != 0>(F.lds, g, S, E, F.wave); }
PHASE_FN void ph_postproj(LAS unsigned char* lds, int wave, int l) { Frame F; make_frame(F, lds, wave); p3_postproj(F, l); }
PHASE_FN void ph_attn(LAS unsigned char* lds, int wave, int l) { Frame F; make_frame(F, lds, wave); p4_attention(F, l); }
PHASE_FN void ph_out(LAS unsigned char* lds, int wave, int l) { Frame F; make_frame(F, lds, wave);
    pg8::Gemm g{(const bf16*)(F.ws + WS_YMIX), (const bf16*)(F.ws + WS_WOUT) + (size_t)l * DM * DM, nullptr, DM};
    pg8::StaticOrder S; S.init(NTOK, DM, F.G, F.blk);
    const float* gb = F.in[I_BADA] + (size_t)l * 6144 + 2 * DM; const float* gp = (const float*)(F.ws + WS_MODP) + (size_t)l * 4 * NB * 6144 + 2 * DM;
    if (l == 0) { pg8::EpiResGate<false> E{F.in[I_X], (bf16*)(F.ws + WS_XA), gb, gp}; pg8::gemm_phase<pg8::EpiResGate<false>, pg8::StaticOrder, false>(F.lds, g, S, E, F.wave); }
    else { pg8::EpiResGate<true> E{F.ws + WS_XB, (bf16*)(F.ws + WS_XA), gb, gp}; pg8::gemm_phase<pg8::EpiResGate<true>, pg8::StaticOrder, false>(F.lds, g, S, E, F.wave); } }
PHASE_FN void ph_router(LAS unsigned char* lds, int wave, int l) { Frame F; make_frame(F, lds, wave); p6_norm_router(F, l, (const bf16*)(F.ws + WS_XA)); }
PHASE_FN void ph_scatter(LAS unsigned char* lds, int wave) { Frame F; make_frame(F, lds, wave); p7_scatter(F); }
__device__ __forceinline__ LAS int* moe_table(Frame& F) { LAS int* tb = (LAS int*)(F.lds + MISC_OFF + 64);
    if (F.tid <= NEXP) tb[F.tid] = ((const int*)(F.ws + WS_MOETAB))[F.tid];
    __syncthreads(); return tb; }
PHASE_FN void ph_moe_up(LAS unsigned char* lds, int wave, int l) { Frame F; make_frame(F, lds, wave); LAS int* tb = moe_table(F);
    pg8::Gemm g{(const bf16*)(F.ws + WS_H8), (const bf16*)(F.ws + WS_W1 + (size_t)l * NEXP * 2048 * DM), (const int*)(F.ws + WS_SLOTTOK), DM / 2};
    pg8::MoeOrder S; S.init(tb, 8, F.G, F.blk);
    pg8::EpiSwiglu8 E{F.ws + WS_ACT, F.in[I_B1] + (size_t)l * NEXP * 2048};
    pg8::gemm_phase<pg8::EpiSwiglu8, pg8::MoeOrder, true, true>(F.lds, g, S, E, F.wave); }
struct EpiNull { static constexpr bool PERM = true; __device__ __forceinline__ void operator()(const f32x4 (&acc)[2][2][4][2], const pg8::Unit& u, int wr, int wc, int fr, int fq) const { float s = 0.f;
#pragma unroll
    for (int a = 0; a < 2; ++a)
#pragma unroll
        for (int b = 0; b < 2; ++b)
#pragma unroll
            for (int m = 0; m < 4; ++m)
#pragma unroll
                for (int n = 0; n < 2; ++n) s += acc[a][b][m][n][0] + acc[a][b][m][n][1] + acc[a][b][m][n][2] + acc[a][b][m][n][3];
    asm volatile("" :: "v"(s)); } };
PHASE_FN void ph_moe_down_nostore(LAS unsigned char* lds, int wave, int l) { Frame F; make_frame(F, lds, wave); LAS int* tb = moe_table(F);
    pg8::Gemm g{(const bf16*)(F.ws + WS_ACT), (const bf16*)(F.ws + WS_W2 + (size_t)l * NEXP * DM * DM), nullptr, DM / 2};
    pg8::MoeOrder S; S.init(tb, 4, F.G, F.blk);
#if EXP_NOSTORE == 2
    pg8::EpiY E{F.ws + WS_PROJ, nullptr};
    pg8::gemm_phase<pg8::EpiY, pg8::MoeOrder, false, true>(F.lds, g, S, E, F.wave); }
#else
    EpiNull E;
    pg8::gemm_phase<EpiNull, pg8::MoeOrder, false, true>(F.lds, g, S, E, F.wave); }
#endif
PHASE_FN void ph_moe_down(LAS unsigned char* lds, int wave, int l) { Frame F; make_frame(F, lds, wave); LAS int* tb = moe_table(F);
    pg8::Gemm g{(const bf16*)(F.ws + WS_ACT), (const bf16*)(F.ws + WS_W2 + (size_t)l * NEXP * DM * DM), nullptr, DM / 2, (void*)(F.ws + WS_CTL + 512)};
    pg8::MoeOrder S; S.init(tb, 4, F.G, F.blk);
    pg8::EpiY E{F.ws + WS_Y, F.in[I_B2] + (size_t)l * NEXP * DM};
    pg8::gemm_phase<pg8::EpiY, pg8::MoeOrder, false, true>(F.lds, g, S, E, F.wave); }
PHASE_FN void ph_final(LAS unsigned char* lds, int wave) { Frame F; make_frame(F, lds, wave); row_phase<true, false, true, false>(F, NLAYER, F.ws + WS_XA, F.out); }

#ifndef REP_MASK
#define REP_MASK 0
#endif
#ifndef MK_SPLIT
#define MK_SPLIT 0
#endif
#if !MK_SPLIT
__global__ void __launch_bounds__(512, 2) fwd_kernel(Args args) {
    extern __shared__ __attribute__((aligned(16))) unsigned char lds_raw[];
    LAS unsigned char* lds = (LAS unsigned char*)lds_raw;
    volatile LAS unsigned* MISC = (volatile LAS unsigned*)(lds + MISC_OFF);
    if (threadIdx.x < 16) MISC[threadIdx.x] = 0u;
    const int wave = __builtin_amdgcn_readfirstlane(threadIdx.x >> 6);
    __syncthreads();
    const XcdBarrier bar = xcd_barrier_post((unsigned*)(args.ws + WS_CTL) + CW_BAR, MISC, wave);
#define IN(k) true
#define SEAM(k) xcd_barrier(bar)
#define REPS(j) for (int rep_ = 0; rep_ < (((REP_MASK >> (j)) & 1) ? 2 : 1); ++rep_)
#ifdef PT_SEL
    unsigned long long pt_acc = 0ull, pt_t0 = 0ull;
#define PT_BEGIN(j) do { if ((j) == PT_SEL) pt_t0 = __builtin_amdgcn_s_memrealtime(); } while (0)
#define PT_END(j) do { if ((j) == PT_SEL) { const unsigned long long t1_ = __builtin_amdgcn_s_memrealtime(); pt_acc += t1_ - pt_t0; } } while (0)
#else
#define PT_BEGIN(j) do {} while (0)
#define PT_END(j) do {} while (0)
#endif
    if (IN(0)) { REPS(0) { PT_BEGIN(0); ph_prologue(lds, wave); SEAM(0); PT_END(0); } }
    for (int l = 0; l < NLAYER; ++l) {
        const int p = 1 + 9 * l;
        if (IN(p + 0)) { REPS(1) { PT_BEGIN(1); ph_norm1(lds, wave, l); SEAM(p + 0); PT_END(1); } }
        if (IN(p + 1)) { REPS(2) { PT_BEGIN(2); ph_proj(lds, wave, l); SEAM(p + 1); PT_END(2); } }
        if (IN(p + 2)) { PT_BEGIN(3); ph_postproj(lds, wave, l); SEAM(p + 2); PT_END(3); }
        if (IN(p + 3)) { REPS(4) { PT_BEGIN(4); ph_attn(lds, wave, l); SEAM(p + 3); PT_END(4); } }
        if (IN(p + 4)) { REPS(5) { PT_BEGIN(5); ph_out(lds, wave, l); SEAM(p + 4); PT_END(5); } }
        if (IN(p + 5)) { REPS(6) { PT_BEGIN(6); ph_router(lds, wave, l); SEAM(p + 5); PT_END(6); } }
        if (IN(p + 6)) { REPS(7) { PT_BEGIN(7); ph_scatter(lds, wave); SEAM(p + 6); PT_END(7); } }
        if (IN(p + 7)) { REPS(8) { PT_BEGIN(8); ph_moe_up(lds, wave, l); SEAM(p + 7); PT_END(8); } }
        if (IN(p + 8)) { REPS(9) { PT_BEGIN(9); ph_moe_down(lds, wave, l); SEAM(p + 8); PT_END(9); } }
    }
    if (IN(N_PHASES - 1)) { REPS(10) { PT_BEGIN(10); ph_final(lds, wave); PT_END(10); } }
#ifdef PT_SEL
    if (blockIdx.x == 0 && wave == 0 && lane_id() == 0) { const unsigned long long t0_ = __builtin_amdgcn_s_memrealtime(); while (__builtin_amdgcn_s_memrealtime() - t0_ < pt_acc * PT_K) __builtin_amdgcn_s_sleep(8); }
#endif
#ifdef TPG
    if (blockIdx.x == 3 && wave == 0 && lane_id() == 0) { __builtin_amdgcn_s_waitcnt(0);
        const unsigned long long acc = __hip_atomic_load((unsigned long long*)(args.ws + WS_CTL + 512), __ATOMIC_RELAXED, __HIP_MEMORY_SCOPE_AGENT) * ((TPG == 1) ? 1ull : 100000ull);
        const unsigned long long t0 = __builtin_readcyclecounter(); while (__builtin_readcyclecounter() - t0 < acc) __builtin_amdgcn_s_sleep(4); }
#endif
#ifdef TPROBE
    if (blockIdx.x == TPROBE_BLK && wave == 0 && lane_id() == 0) {
        __builtin_amdgcn_s_waitcnt(0);
        const unsigned long long acc = __hip_atomic_load((unsigned long long*)(args.ws + WS_CTL + 512), __ATOMIC_RELAXED, __HIP_MEMORY_SCOPE_AGENT) * TPROBE_K;
        const unsigned long long t0 = __builtin_readcyclecounter();
        while (__builtin_readcyclecounter() - t0 < acc) __builtin_amdgcn_s_sleep(4);
    }
#endif
#ifdef UBENCH
    {
        float v[32];
#pragma unroll
        for (int i = 0; i < 32; ++i) v[i] = (float)(lane_id() + i) * 1e-3f;
        for (int it = 0; it < UBENCH_ITERS; ++it) {
#pragma unroll
            for (int i = 0; i < 32; ++i) {
#if UBENCH == 1
                v[i] = __builtin_amdgcn_exp2f(v[i]);
#elif UBENCH == 2
                v[i] = v[i] * 1.0001f + 0.5f;
#elif UBENCH == 3
                v[i] = __builtin_amdgcn_logf(v[i]);
#endif
            }
            asm volatile("" ::: "memory");
        }
        float s = 0.f;
#pragma unroll
        for (int i = 0; i < 32; ++i) s += v[i];
        if (s == 123.456f) ((float*)(args.ws + WS_GSUM + 14000))[0] = s;
    }
#endif
#undef IN
#undef SEAM
#undef REPS
}

#endif
template <int KIND> __global__ void __launch_bounds__(512, 2) phase_kernel(Args args, int l) {
    extern __shared__ __attribute__((aligned(16))) unsigned char lds_raw[];
    LAS unsigned char* lds = (LAS unsigned char*)lds_raw; const int wave = __builtin_amdgcn_readfirstlane(threadIdx.x >> 6);
    if (KIND == 0) ph_prologue(lds, wave); if (KIND == 1) ph_norm1(lds, wave, l); if (KIND == 2) ph_proj(lds, wave, l); if (KIND == 3) ph_postproj(lds, wave, l); if (KIND == 4) ph_attn(lds, wave, l);
    if (KIND == 5) ph_out(lds, wave, l); if (KIND == 6) ph_router(lds, wave, l); if (KIND == 7) ph_scatter(lds, wave); if (KIND == 8) ph_moe_up(lds, wave, l); if (KIND == 9) ph_moe_down(lds, wave, l); if (KIND == 10) ph_final(lds, wave);
#ifdef EXP_NOSTORE
    if (KIND == 11) ph_moe_down_nostore(lds, wave, l);
#endif
}
template <int KIND> static void launch_phase(const Args& a, int l, int grid, hipStream_t stream) {
    static bool attr = false;
    if (!attr) { (void)hipFuncSetAttribute((const void*)phase_kernel<KIND>, hipFuncAttributeMaxDynamicSharedMemorySize, LDS_BYTES); attr = true; }
    for (int rep = 0; rep < (((REP_MASK >> KIND) & 1) ? 2 : 1); ++rep) hipLaunchKernelGGL(phase_kernel<KIND>, dim3(grid), dim3(512), LDS_BYTES, stream, a, l);
}

extern "C" void kernel_launch(void* const* d_in, const int* in_sizes, int n_in, void* d_out, int out_size, void* d_ws, size_t ws_size, hipStream_t stream) {
    static int grid = 0;
    if (grid == 0) {
        if (n_in != 21 || in_sizes[0] != NTOK * DM || out_size != NTOK * DM || ws_size < WS_END) {
            fprintf(stderr, "kernel_launch: unexpected shapes: n_in %d in0 %d out %d ws %zu (need %zu)\n", n_in, n_in > 0 ? in_sizes[0] : -1, out_size, ws_size, (size_t)WS_END); grid = -1; return; }
        int dev = 0, cus = 0, per_cu = 0;
        if (hipGetDevice(&dev) != hipSuccess || hipDeviceGetAttribute(&cus, hipDeviceAttributeMultiprocessorCount, dev) != hipSuccess) { fprintf(stderr, "kernel_launch: device query failed\n"); grid = -1; return; }
#if !MK_SPLIT
        if (hipFuncSetAttribute((const void*)fwd_kernel, hipFuncAttributeMaxDynamicSharedMemorySize, LDS_BYTES) != hipSuccess) { fprintf(stderr, "kernel_launch: hipFuncSetAttribute failed\n"); grid = -1; return; }
        if (hipOccupancyMaxActiveBlocksPerMultiprocessor(&per_cu, (const void*)fwd_kernel, 512, LDS_BYTES) != hipSuccess || per_cu < 1) fprintf(stderr, "kernel_launch: note: occupancy query says %d\n", per_cu);
        (void)hipGetLastError();
#endif
        grid = cus;
    }
    if (grid < 0) return;
    (void)hipMemsetAsync((char*)d_ws + WS_CTL, 0, CTL_ZERO_BYTES, stream);
    Args a{};
    for (int i = 0; i < 21; ++i) a.in[i] = (const float*)d_in[i];
    a.out = (float*)d_out; a.ws = (unsigned char*)d_ws;
#if MK_SPLIT
    a.ph_lo = 0; a.ph_hi = 0;
    launch_phase<0>(a, 0, grid, stream);
    for (int l = 0; l < NLAYER; ++l) { launch_phase<1>(a, l, grid, stream); launch_phase<2>(a, l, grid, stream); launch_phase<3>(a, l, grid, stream); launch_phase<4>(a, l, grid, stream); launch_phase<5>(a, l, grid, stream);
        launch_phase<6>(a, l, grid, stream); launch_phase<7>(a, l, grid, stream); launch_phase<8>(a, l, grid, stream);
#ifdef EXP_NOSTORE
        launch_phase<11>(a, l, grid, stream);
#endif
        launch_phase<9>(a, l, grid, stream); }
    launch_phase<10>(a, 0, grid, stream);
#else
    a.ph_lo = 0; a.ph_hi = N_PHASES; hipLaunchKernelGGL(fwd_kernel, dim3(grid), dim3(512), LDS_BYTES, stream, a);
#endif
}
```

```cpp
#include <hip/hip_runtime.h>
#include <cstdio>
#include <cstdint>

#define GAS __attribute__((address_space(1)))
#define LAS __attribute__((address_space(3)))
typedef unsigned short bf16;
typedef unsigned v4u __attribute__((ext_vector_type(4)));
typedef unsigned v2u __attribute__((ext_vector_type(2)));
typedef float f32x4 __attribute__((ext_vector_type(4)));
typedef float f32x2 __attribute__((ext_vector_type(2)));
typedef float f32x16 __attribute__((ext_vector_type(16)));
typedef short bf16x8 __attribute__((ext_vector_type(8)));
typedef _Float16 f16x8 __attribute__((ext_vector_type(8)));
typedef _Float16 f16x2 __attribute__((ext_vector_type(2)));
typedef int v4i __attribute__((ext_vector_type(4)));
typedef int v8i __attribute__((ext_vector_type(8)));

namespace pg8 {
constexpr int BM = 256, BK = 64, HALF = 128, HTB = HALF * BK * 2  , STAGE_BYTES = 8 * HTB, NXCD = 8, WGM = 8;

__host__ __device__ __forceinline__ int lds_byte(int r, int c) { const int st = (r >> 4) * 2 + (c >> 5), rr = r & 15, cc = c & 31, ob = rr * 64 + cc * 2; return st * 1024 + (ob ^ (((ob >> 9) & 1) << 5)); }
__host__ __device__ __forceinline__ void stage_rc(int b, int& R, int& C) { const int st = b / 1024, sb = b % 1024, swz = sb ^ (((sb >> 9) & 1) << 5); R = (st >> 1) * 16 + swz / 64; C = (st & 1) * 32 + (swz % 64) / 2; }
__host__ __device__ __forceinline__ int perm32(int rho) { const int n = rho >> 4, i = rho & 15; return 8 * (i >> 2) + 4 * n + (i & 3); }

struct Unit { int pm, pn, pb; };
struct Gemm { const bf16* A; const bf16* Bt; const int* rowmap; int K; void* tprobe = nullptr; };

__device__ __forceinline__ unsigned cvt_pk_bf16(float lo, float hi) { unsigned r; asm volatile("v_cvt_pk_bf16_f32 %0, %1, %2" : "=v"(r) : "v"(lo), "v"(hi)); return r; }

template <class Epi, class Sched, bool GATHER, bool FP8 = false>
__device__ __forceinline__ void gemm_phase(LAS unsigned char* lds, const Gemm g, const Sched& S, const Epi& E, int wave) {
    int lane_ = (int)__builtin_amdgcn_mbcnt_hi(~0u, __builtin_amdgcn_mbcnt_lo(~0u, 0u)); asm volatile("" : "+v"(lane_));
    const int wid = wave, lane = lane_, tid = wid * 64 + lane, wr = wid >> 2, wc = wid & 3, fr = lane & 15, fq = lane >> 4;
    const int K = g.K, nt = K / BK;
    unsigned voffA[2], voffB[2]; int RA[2], CA[2];
#pragma unroll
    for (int i = 0; i < 2; ++i) { int R, C; stage_rc(tid * 16 + i * 8192, R, C); const int Rb = Epi::PERM ? ((R & ~31) + perm32(R & 31)) : R; RA[i] = R; CA[i] = C;
        voffA[i] = (unsigned)(R * K + C) * 2u; voffB[i] = (unsigned)(Rb * K + C) * 2u; }
    const size_t kstep = (size_t)(BK * 2);
    const size_t hstep = (size_t)HALF * K * 2;
    const size_t tstep = 2 * hstep;
    const unsigned ldsw = (unsigned)wid * 1024u;
    const int aoff = lds_byte(wr * 64 + fr, fq * 8), boff = lds_byte(wc * 32 + fr, fq * 8);
#define PG8_SA(b, h) (((b) * 2 + (h)) * HTB)
#define PG8_SB(b, h) ((4 + (b) * 2 + (h)) * HTB)
#define PG8_STAGE(bufoff, gbase, voff) do { _Pragma("unroll") for (int _i = 0; _i < 2; ++_i) \
        __builtin_amdgcn_global_load_lds((const unsigned*)((const char*)(gbase) + (voff)[_i]), (LAS unsigned*)(lds + (bufoff) + ldsw + _i * 8192), 16, 0, 0); } while (0)
#define PG8_STAGEA(bufoff, pbase, h, nx) do { if constexpr (GATHER) { _Pragma("unroll") for (int _i = 0; _i < 2; ++_i) \
        __builtin_amdgcn_global_load_lds((const unsigned*)((const char*)(pbase) + ((nx) ? gn[h][_i] : gc[h][_i])), (LAS unsigned*)(lds + (bufoff) + ldsw + _i * 8192), 16, 0, 0); } \
        else { PG8_STAGE(bufoff, (const char*)(pbase) + (h) * hstep, voffA); } } while (0)
#define PG8_LDA(dst, b, h) do { if constexpr (FP8) { _Pragma("unroll") for (int m = 0; m < 4; ++m) dst##8[m] = __builtin_shufflevector(*(const LAS v4i*)(lds + PG8_SA(b, h) + aoff + m * 2048), *(const LAS v4i*)(lds + PG8_SA(b, h) + aoff + m * 2048 + 1024), 0, 1, 2, 3, 4, 5, 6, 7); } \
        else { _Pragma("unroll") for (int m = 0; m < 4; ++m) _Pragma("unroll") for (int k = 0; k < 2; ++k) dst[m][k] = *(const LAS bf16x8*)(lds + PG8_SA(b, h) + aoff + m * 2048 + k * 1024); } } while (0)
#define PG8_LDB(dst, b, h) do { if constexpr (FP8) { _Pragma("unroll") for (int n = 0; n < 2; ++n) dst##8[n] = __builtin_shufflevector(*(const LAS v4i*)(lds + PG8_SB(b, h) + boff + n * 2048), *(const LAS v4i*)(lds + PG8_SB(b, h) + boff + n * 2048 + 1024), 0, 1, 2, 3, 4, 5, 6, 7); } \
        else { _Pragma("unroll") for (int n = 0; n < 2; ++n) _Pragma("unroll") for (int k = 0; k < 2; ++k) dst[n][k] = *(const LAS bf16x8*)(lds + PG8_SB(b, h) + boff + n * 2048 + k * 1024); } } while (0)
#define PG8_MMA(ai, bj, At, Bt) do { __builtin_amdgcn_s_setprio(1); if constexpr (FP8) { _Pragma("unroll") for (int m = 0; m < 4; ++m) _Pragma("unroll") for (int n = 0; n < 2; ++n) \
        asm volatile("v_mfma_scale_f32_16x16x128_f8f6f4 %0, %1, %2, %0, %3, %4 op_sel_hi:[0,0,0]" : "+v"(acc[ai][bj][m][n]) : "v"(Bt##8[n]), "v"(At##8[m]), "v"(sclw), "v"(scla)); } \
        else { _Pragma("unroll") for (int m = 0; m < 4; ++m) _Pragma("unroll") for (int n = 0; n < 2; ++n) _Pragma("unroll") for (int k = 0; k < 2; ++k) \
        acc[ai][bj][m][n] = __builtin_amdgcn_mfma_f32_16x16x32_bf16(Bt[n][k], At[m][k], acc[ai][bj][m][n], 0, 0, 0); } __builtin_amdgcn_s_setprio(0); } while (0)
#define PG8_WAIT_V(n) asm volatile("s_waitcnt vmcnt(" #n ")" ::: "memory")
#define PG8_WAIT_L(n) asm volatile("s_waitcnt lgkmcnt(" #n ")" ::: "memory")
#define PG8_BAR __builtin_amdgcn_s_barrier()
#define PG8_SCHED __builtin_amdgcn_sched_barrier(0)
    Unit cur, nxt; int ui = 0;
    if (!S.next(0, cur)) return;
#ifdef GEMM_STAGGER
    {
        const unsigned long long t0 = __builtin_amdgcn_s_memrealtime(); const unsigned long long d = (unsigned long long)((blockIdx.x >> 3) & 3) * GEMM_STAGGER;
        while (__builtin_amdgcn_s_memrealtime() - t0 < d) __builtin_amdgcn_s_sleep(16);
    }
#endif
    f32x4 acc[2][2][4][2];
#pragma unroll
    for (int a = 0; a < 2; ++a)
#pragma unroll
        for (int b = 0; b < 2; ++b)
#pragma unroll
            for (int m = 0; m < 4; ++m)
#pragma unroll
                for (int n = 0; n < 2; ++n) acc[a][b][m][n] = (f32x4){0.f, 0.f, 0.f, 0.f};
    bf16x8 At[4][2], B0[2][2], B1[2][2]; v8i At8[4], B08[2], B18[2];
    const int sclw = 0x7A7A7A7A, scla = 0x7F7F7F7F;
    unsigned gc[2][2], gn[2][2];
    if constexpr (GATHER) {
#pragma unroll
        for (int h = 0; h < 2; ++h)
#pragma unroll
            for (int i = 0; i < 2; ++i) { gc[h][i] = (unsigned)(g.rowmap[cur.pm * BM + h * HALF + RA[i]] * K + CA[i]) * 2u; gn[h][i] = gc[h][i]; }
    } else { gc[0][0] = gc[0][1] = gc[1][0] = gc[1][1] = 0u; gn[0][0] = gn[0][1] = gn[1][0] = gn[1][1] = 0u; }
    const char* cA = GATHER ? (const char*)g.A : (const char*)g.A + (size_t)cur.pm * tstep; const char* cB = (const char*)g.Bt + (size_t)cur.pb * tstep;
    PG8_STAGE(PG8_SB(0, 0), cB, voffB); PG8_STAGE(PG8_SB(0, 1), cB + hstep, voffB); PG8_STAGEA(PG8_SA(0, 0), cA, 0, false); PG8_STAGEA(PG8_SA(0, 1), cA, 1, false);
    if (wr == 1) PG8_BAR;
    PG8_WAIT_V(2); PG8_BAR;
    PG8_STAGE(PG8_SB(1, 0), cB + kstep, voffB); PG8_STAGEA(PG8_SA(1, 0), cA + kstep, 0, false); PG8_STAGE(PG8_SB(1, 1), cB + hstep + kstep, voffB);
    PG8_WAIT_V(6); PG8_BAR;
    for (;;) {
        const bool has_next = S.next(ui + 1, nxt);
        if constexpr (GATHER) { if (has_next) {
#pragma unroll
            for (int h = 0; h < 2; ++h)
#pragma unroll
                for (int i = 0; i < 2; ++i) gn[h][i] = (unsigned)(g.rowmap[nxt.pm * BM + h * HALF + RA[i]] * K + CA[i]) * 2u; } }
        const char* nA = GATHER ? cA : (has_next ? (const char*)g.A + (size_t)nxt.pm * tstep : cA); const char* nB = has_next ? (const char*)g.Bt + (size_t)nxt.pb * tstep : cB;
#ifdef TPG
        const unsigned long long tg0 = __builtin_readcyclecounter();
#endif
        for (int t = 0; t < nt; t += 2) {
            const bool last = (t == nt - 2);
            const char* a1 = cA + (size_t)(t + 1) * kstep;
            const char* a2 = last ? nA : cA + (size_t)(t + 2) * kstep; const char* b2 = last ? nB : cB + (size_t)(t + 2) * kstep;
            const char* a3 = a2 + kstep; const char* b3 = b2 + kstep;
            PG8_LDB(B0, 0, 0); PG8_LDB(B1, 0, 1); PG8_SCHED; PG8_LDA(At, 0, 0); PG8_STAGEA(PG8_SA(1, 1), a1, 1, false);
            PG8_WAIT_V(8); PG8_WAIT_L(0); PG8_BAR; PG8_MMA(0, 0, At, B0); PG8_MMA(0, 1, At, B1); PG8_BAR; PG8_SCHED;
            PG8_LDA(At, 0, 1); PG8_STAGE(PG8_SB(0, 0), b2, voffB); PG8_STAGE(PG8_SB(0, 1), b2 + hstep, voffB); PG8_STAGEA(PG8_SA(0, 0), a2, 0, last);
            PG8_WAIT_V(8); PG8_WAIT_L(0); PG8_BAR; PG8_MMA(1, 0, At, B0); PG8_MMA(1, 1, At, B1); PG8_BAR; PG8_SCHED;
            PG8_LDB(B0, 1, 0); PG8_LDB(B1, 1, 1); PG8_SCHED; PG8_LDA(At, 1, 0); PG8_STAGEA(PG8_SA(0, 1), a2, 1, last);
            PG8_WAIT_V(8); PG8_WAIT_L(0); PG8_BAR; PG8_MMA(0, 0, At, B0); PG8_MMA(0, 1, At, B1); PG8_BAR; PG8_SCHED;
            PG8_LDA(At, 1, 1); PG8_STAGE(PG8_SB(1, 0), b3, voffB); PG8_STAGE(PG8_SB(1, 1), b3 + hstep, voffB); PG8_STAGEA(PG8_SA(1, 0), a3, 0, last);
            PG8_WAIT_V(8); PG8_WAIT_L(0); PG8_BAR; PG8_MMA(1, 0, At, B0); PG8_MMA(1, 1, At, B1); PG8_BAR; PG8_SCHED;
        }
#ifdef TPG
        { const unsigned long long tg1 = __builtin_readcyclecounter(); asm volatile("" :: "s"(tg0), "s"(tg1));
          if (FP8 && !GATHER && blockIdx.x == 3 && tid == 0) atomicAdd((unsigned long long*)g.tprobe, (TPG == 1) ? (tg1 - tg0) : 1ull); }
#endif
        if (wr == 0) PG8_BAR;
        if constexpr (FP8) asm volatile("s_nop 15\n\ts_nop 7" ::: "memory");
        E(acc, cur, wr, wc, fr, fq);
        if (!has_next) break;
#pragma unroll
        for (int a = 0; a < 2; ++a)
#pragma unroll
            for (int b = 0; b < 2; ++b)
#pragma unroll
                for (int m = 0; m < 4; ++m)
#pragma unroll
                    for (int n = 0; n < 2; ++n) acc[a][b][m][n] = (f32x4){0.f, 0.f, 0.f, 0.f};
        cur = nxt; cA = nA; cB = nB; ++ui;
        if constexpr (GATHER) {
#pragma unroll
            for (int h = 0; h < 2; ++h)
#pragma unroll
                for (int i = 0; i < 2; ++i) gc[h][i] = gn[h][i]; }
        if (wr == 1) PG8_BAR;
    }
    PG8_WAIT_V(0);
    PG8_BAR;
#undef PG8_SA
#undef PG8_SB
#undef PG8_STAGE
#undef PG8_STAGEA
#undef PG8_LDA
#undef PG8_LDB
#undef PG8_MMA
#undef PG8_WAIT_V
#undef PG8_WAIT_L
#undef PG8_BAR
#undef PG8_SCHED
}
}
constexpr int DM = 1024, NB = 8, SEQ = 4096, NTOK = NB * SEQ, NLAYER = 2;
constexpr int NPROJ = 3072;
constexpr int D_IN = 3078;
constexpr int NEXP = 32, TOPK = 4;
constexpr int NSLOT_MAX = NTOK * TOPK + NEXP * 256;
constexpr int NTILE_MAX = NSLOT_MAX / 256;
constexpr int COL_CB = 0, COL_CC = 256, COL_CU = 512, COL_SQ = 768, COL_SK = 1152, COL_SV = 1536, COL_FQ = 1920, COL_FK = 2304, COL_FV = 2688;
constexpr float EPS = 1e-6f;
constexpr float LOG2E = 1.4426950408889634f;
constexpr float QSCALE = 0.125f * LOG2E;

namespace pg8 {
struct StaticOrder {
    int nM, nN, nwg, G, c;
    __device__ __forceinline__ void init(int M, int N, int G_, int c_) { nM = M / BM; nN = N / BM; nwg = nM * nN; G = G_; c = c_; }
    __device__ __forceinline__ bool next(int i, Unit& u) const {
        const long L = (long)i * G + c; if (L >= nwg) return false;
        int wgid = (int)L; { const int q = nwg / NXCD, r = nwg % NXCD, xcd = wgid % NXCD, off = wgid / NXCD; wgid = (xcd < r ? xcd * (q + 1) : r * (q + 1) + (xcd - r) * q) + off; }
        const int nig = WGM * nN, gid = wgid / nig, fm = gid * WGM, gsz = (nM - fm) < WGM ? (nM - fm) : WGM;
        u.pm = fm + ((wgid % nig) % gsz); u.pn = (wgid % nig) / gsz; u.pb = u.pn; return true;
    }
};
struct MoeOrder {
    int nM, nN, nwg, G, c; const LAS int* tb;
    __device__ __forceinline__ void init(const LAS int* tb_, int nN_, int G_, int c_) { tb = tb_; nM = tb_[NEXP]; nN = nN_; nwg = nM * nN; G = G_; c = c_; }
    __device__ __forceinline__ bool next(int i, Unit& u) const {
        const long L = (long)i * G + c; if (L >= nwg) return false;
        int wgid = (int)L; { const int q = nwg / NXCD, r = nwg % NXCD, xcd = wgid % NXCD, off = wgid / NXCD; wgid = (xcd < r ? xcd * (q + 1) : r * (q + 1) + (xcd - r) * q) + off; }
        const int nig = WGM * nN, gid = wgid / nig, fm = gid * WGM, gsz = (nM - fm) < WGM ? (nM - fm) : WGM;
        u.pm = fm + ((wgid % nig) % gsz); u.pn = (wgid % nig) / gsz;
        int e = 0;
#pragma unroll 1
        for (int j = 1; j < NEXP; ++j) e += (tb[j] <= u.pm) ? 1 : 0;
        u.pb = e * nN + u.pn; return true;
    }
};

struct EpiProj {
    static constexpr bool PERM = true;
    bf16* O; int ldc;
    __device__ __forceinline__ void operator()(const f32x4 (&acc)[2][2][4][2], const Unit& u, int wr, int wc, int fr, int fq) const {
        const int row0 = u.pm * BM + wr * 64 + fr, col0 = u.pn * BM + wc * 32 + 8 * fq;
#pragma unroll
        for (int ai = 0; ai < 2; ++ai)
#pragma unroll
            for (int m = 0; m < 4; ++m) { bf16* rowp = O + (size_t)(row0 + ai * HALF + m * 16) * ldc + col0;
#pragma unroll
                for (int bj = 0; bj < 2; ++bj) { const f32x4 v0 = acc[ai][bj][m][0], v1 = acc[ai][bj][m][1];
                    v4u w; w.x = cvt_pk_bf16(v0[0], v0[1]); w.y = cvt_pk_bf16(v0[2], v0[3]); w.z = cvt_pk_bf16(v1[0], v1[1]); w.w = cvt_pk_bf16(v1[2], v1[3]);
                    *(v4u*)(rowp + bj * HALF) = w; } }
    }
};
template <bool BASE16> struct EpiResGate {
    static constexpr bool PERM = true;
    const void* base; bf16* out; const float* gbias; const float* gpart;
    __device__ __forceinline__ void operator()(const f32x4 (&acc)[2][2][4][2], const Unit& u, int wr, int wc, int fr, int fq) const {
        const int row0 = u.pm * BM + wr * 64 + fr, col0 = u.pn * BM + wc * 32 + 8 * fq; const int b = (u.pm * BM) / SEQ;
#pragma unroll
        for (int bj = 0; bj < 2; ++bj) { const int c = col0 + bj * HALF; f32x4 g0 = *(const f32x4*)(gbias + c), g1 = *(const f32x4*)(gbias + c + 4);
#pragma unroll
            for (int ks = 0; ks < 4; ++ks) { g0 += *(const f32x4*)(gpart + (size_t)(ks * NB + b) * 6144 + c); g1 += *(const f32x4*)(gpart + (size_t)(ks * NB + b) * 6144 + c + 4); }
#pragma unroll
            for (int ai = 0; ai < 2; ++ai)
#pragma unroll
                for (int m = 0; m < 4; ++m) { const size_t off = (size_t)(row0 + ai * HALF + m * 16) * DM + c; f32x4 b0, b1;
                    if (BASE16) { const v4u t = *(const v4u*)((const bf16*)base + off); b0 = (f32x4){__builtin_bit_cast(float, t.x << 16), __builtin_bit_cast(float, t.x & 0xffff0000u), __builtin_bit_cast(float, t.y << 16), __builtin_bit_cast(float, t.y & 0xffff0000u)};
                        b1 = (f32x4){__builtin_bit_cast(float, t.z << 16), __builtin_bit_cast(float, t.z & 0xffff0000u), __builtin_bit_cast(float, t.w << 16), __builtin_bit_cast(float, t.w & 0xffff0000u)}; }
                    else { b0 = *(const f32x4*)((const float*)base + off); b1 = *(const f32x4*)((const float*)base + off + 4); }
                    const f32x4 v0 = b0 + g0 * acc[ai][bj][m][0], v1 = b1 + g1 * acc[ai][bj][m][1];
                    v4u w; w.x = cvt_pk_bf16(v0[0], v0[1]); w.y = cvt_pk_bf16(v0[2], v0[3]); w.z = cvt_pk_bf16(v1[0], v1[1]); w.w = cvt_pk_bf16(v1[2], v1[3]);
                    *(v4u*)(out + off) = w; } }
    }
};
struct EpiSwiglu {
    static constexpr bool PERM = true;
    bf16* O; const float* b1;
    __device__ __forceinline__ void operator()(const f32x4 (&acc)[2][2][4][2], const Unit& u, int wr, int wc, int fr, int fq) const {
        const int row0 = u.pm * BM + wr * 64 + fr; const int e = u.pb >> 3; const int j0 = u.pn * 128 + wc * 32 + 8 * fq;
        const float* bp = b1 + (size_t)e * 2048 + 2 * j0;
        f32x4 bb[4];
#pragma unroll
        for (int q = 0; q < 4; ++q) bb[q] = *(const f32x4*)(bp + 4 * q);
        float bg[8], bl[8];
#pragma unroll
        for (int q = 0; q < 4; ++q) { bg[2 * q] = bb[q][0]; bl[2 * q] = bb[q][1]; bg[2 * q + 1] = bb[q][2]; bl[2 * q + 1] = bb[q][3]; }
#pragma unroll
        for (int ai = 0; ai < 2; ++ai)
#pragma unroll
            for (int m = 0; m < 4; ++m) { bf16* rowp = O + (size_t)(row0 + ai * HALF + m * 16) * DM + j0;
                float a[8];
#pragma unroll
                for (int n = 0; n < 2; ++n)
#pragma unroll
                    for (int i = 0; i < 4; ++i) { float gl = acc[ai][0][m][n][i] + bg[4 * n + i], li = acc[ai][1][m][n][i] + bl[4 * n + i];
                        gl = fminf(gl, 7.0f); li = fminf(fmaxf(li, -7.0f), 7.0f);
                        const float sg = __builtin_amdgcn_rcpf(1.0f + __builtin_amdgcn_exp2f(-1.702f * LOG2E * gl));
                        a[4 * n + i] = gl * sg * (li + 1.0f); }
                v4u w; w.x = cvt_pk_bf16(a[0], a[1]); w.y = cvt_pk_bf16(a[2], a[3]); w.z = cvt_pk_bf16(a[4], a[5]); w.w = cvt_pk_bf16(a[6], a[7]);
                *(v4u*)rowp = w; }
    }
};
__device__ __forceinline__ float clamp448(float v) { return __builtin_amdgcn_fmed3f(v, -448.0f, 448.0f); }
__device__ __forceinline__ unsigned pk4_fp8(float a, float b, float c, float d) { unsigned r = 0; r = __builtin_amdgcn_cvt_pk_fp8_f32(clamp448(a), clamp448(b), r, false); r = __builtin_amdgcn_cvt_pk_fp8_f32(clamp448(c), clamp448(d), r, true); return r; }
struct EpiSwiglu8 {
    static constexpr bool PERM = true;
    unsigned char* O; const float* b1;
    __device__ __forceinline__ void operator()(const f32x4 (&acc)[2][2][4][2], const Unit& u, int wr, int wc, int fr, int fq) const {
        const int row0 = u.pm * BM + wr * 64 + fr; const int e = u.pb >> 3; const int j0 = u.pn * 128 + wc * 32 + 8 * fq;
        const float* bp = b1 + (size_t)e * 2048 + 2 * j0;
        f32x4 bb[4];
#pragma unroll
        for (int q = 0; q < 4; ++q) bb[q] = *(const f32x4*)(bp + 4 * q);
        float bg[8], bl[8];
#pragma unroll
        for (int q = 0; q < 4; ++q) { bg[2 * q] = bb[q][0]; bl[2 * q] = bb[q][1]; bg[2 * q + 1] = bb[q][2]; bl[2 * q + 1] = bb[q][3]; }
#pragma unroll
        for (int ai = 0; ai < 2; ++ai)
#pragma unroll
            for (int m = 0; m < 4; ++m) { unsigned char* rowp = O + (size_t)(row0 + ai * HALF + m * 16) * DM + j0;
                float a[8];
#pragma unroll
                for (int n = 0; n < 2; ++n)
#pragma unroll
                    for (int i = 0; i < 4; ++i) { float gl = acc[ai][0][m][n][i] + bg[4 * n + i], li = acc[ai][1][m][n][i] + bl[4 * n + i];
                        gl = fminf(gl, 7.0f); li = fminf(fmaxf(li, -7.0f), 7.0f);
                        const float sg = __builtin_amdgcn_rcpf(1.0f + __builtin_amdgcn_exp2f(-1.702f * LOG2E * gl));
                        a[4 * n + i] = gl * sg * (li + 1.0f); }
                v2u w; w.x = pk4_fp8(a[0], a[1], a[2], a[3]); w.y = pk4_fp8(a[4], a[5], a[6], a[7]);
                *(v2u*)rowp = w; }
    }
};
struct EpiY {
    static constexpr bool PERM = true;
    unsigned char* O; const float* b2;
    __device__ __forceinline__ void operator()(const f32x4 (&acc)[2][2][4][2], const Unit& u, int wr, int wc, int fr, int fq) const {
        const int row0 = u.pm * BM + wr * 64 + fr; const int e = u.pb >> 2; const int col0 = u.pn * BM + wc * 32 + 8 * fq;
        f32x4 bv[2][2];
#pragma unroll
        for (int bj = 0; bj < 2; ++bj)
#pragma unroll
            for (int n = 0; n < 2; ++n) bv[bj][n] = b2 ? *(const f32x4*)(b2 + (size_t)e * DM + col0 + bj * HALF + 4 * n) : (f32x4){0.f, 0.f, 0.f, 0.f};
#pragma unroll
        for (int ai = 0; ai < 2; ++ai)
#pragma unroll
            for (int m = 0; m < 4; ++m) { unsigned char* rowp = O + (size_t)(row0 + ai * HALF + m * 16) * DM + col0;
#pragma unroll
                for (int bj = 0; bj < 2; ++bj) { const f32x4 v0 = acc[ai][bj][m][0] + bv[bj][0], v1 = acc[ai][bj][m][1] + bv[bj][1];
                    v2u w; w.x = pk4_fp8(v0[0], v0[1], v0[2], v0[3]); w.y = pk4_fp8(v1[0], v1[1], v1[2], v1[3]);
                    *(v2u*)(rowp + bj * HALF) = w; } }
    }
};
}
namespace att {
constexpr int KROW = 128;
constexpr int TILE_B = 64 * KROW;
constexpr int OFF_K = 0, OFF_V = 2 * TILE_B, OFF_F = 4 * TILE_B, OFF_Q = OFF_F + 512, OFF_FLAG = OFF_Q + 8 * 4608, LDS_BYTES = OFF_FLAG + 64;
__device__ __forceinline__ int pim(int m) { const int a = m >> 3, h = (m >> 2) & 1, b = m & 3; return 16 * (a >> 1) + 8 * h + 4 * (a & 1) + b; }
typedef __bf16 bf16x2_t __attribute__((ext_vector_type(2)));
__device__ __forceinline__ unsigned pk_bf16(float lo, float hi) { const f32x2 v = {lo, hi}; const bf16x2_t b = __builtin_convertvector(v, bf16x2_t); return __builtin_bit_cast(unsigned, b); }
__device__ __forceinline__ unsigned pk_f16(float lo, float hi) { return __builtin_bit_cast(unsigned, __builtin_amdgcn_cvt_pkrtz(lo, hi)); }
__device__ __forceinline__ float half_sum(float v) { auto rr = __builtin_amdgcn_permlane32_swap(__float_as_uint(v), __float_as_uint(v), false, false); return __uint_as_float(rr[0]) + __uint_as_float(rr[1]); }
__device__ __forceinline__ float half_max(float v) { auto rr = __builtin_amdgcn_permlane32_swap(__float_as_uint(v), __float_as_uint(v), false, false); return fmaxf(__uint_as_float(rr[0]), __uint_as_float(rr[1])); }
__device__ __forceinline__ void glds16(const void* gsrc, unsigned lds_dst) { unsigned keep;
    asm volatile("s_mov_b32 %0, m0\n\ts_mov_b32 m0, %2\n\ts_nop 0\n\tglobal_load_lds_dwordx4 %1, off\n\ts_mov_b32 m0, %0" : "=&s"(keep) : "v"(gsrc), "s"(lds_dst) : "memory"); }
#define ATT_SB() __builtin_amdgcn_sched_barrier(0)
#define ATT_MFMA(a, b, c) __builtin_amdgcn_mfma_f32_32x32x16_bf16((a), (b), (c), 0, 0, 0)
#define ATT_MFMAH(a, b, c) __builtin_amdgcn_mfma_f32_32x32x16_f16((a), (b), (c), 0, 0, 0)

struct Tensors {
    const bf16* proj;
    const bf16* vt;
    const float* fcum;
    bf16* ymix;
    const float* ong;
    int colq, colk, coly;
    void* tprobe;
    float z2max;
};
struct WaveCtx { int r32, hi, qabs; int ko[4]; const LAS unsigned char* qb; f16x8 mtri0, mtri1, mones; };

__device__ __forceinline__ void qk_only(f32x16& p0, f32x16& p1, const LAS unsigned char* Kb, const WaveCtx& W) {
#pragma unroll
    for (int r = 0; r < 16; ++r) { p0[r] = 0.f; p1[r] = 0.f; }
#pragma unroll
    for (int d0 = 0; d0 < 4; ++d0) { const bf16x8 ka = *(const LAS bf16x8*)(Kb + W.ko[d0]), kb2 = *(const LAS bf16x8*)(Kb + 32 * KROW + W.ko[d0]);
        const bf16x8 qv = *(const LAS bf16x8*)(W.qb + 32 * d0);
        p0 = ATT_MFMA(ka, qv, p0); p1 = ATT_MFMA(kb2, qv, p1); }
}

template <int KIND, bool DIAG>
__device__ __forceinline__ void tile(f32x16& p0, f32x16& p1, f32x16& o0, f32x16& o1, float& carry, float& lsum, const LAS unsigned char* Kn, const LAS unsigned char* Vb, const LAS float* Fb, int kt, const WaveCtx& W) {
    const int kbase = kt * 64 + 8 * W.hi;
#define ATT_KF(i) (*(const LAS bf16x8*)(Kn + ((i) & 1) * 32 * KROW + W.ko[(i) >> 1]))
#define ATT_VF(i) (*(const LAS bf16x8*)(Vb + ((i) & 1) * 32 * KROW + W.ko[(i) >> 1]))
#define ATT_QF(d0) (*(const LAS bf16x8*)(W.qb + 32 * (d0)))
    bf16x8 kcur = ATT_KF(0), knxt = kcur, qcur = ATT_QF(0), qnxt = qcur;
    f32x16 n0, n1;
#pragma unroll
    for (int r = 0; r < 16; ++r) { n0[r] = 0.f; n1[r] = 0.f; }
    v4u wf[4];
    if (KIND == 0) {
        v4u lf[4]; float lfirst = 0.f, pz0 = 0.f;
#pragma unroll
        for (int i = 0; i < 8; ++i) {
            if (i < 7) { knxt = ATT_KF(i + 1); if (i & 1) qnxt = ATT_QF((i + 1) >> 1); }
#pragma unroll
            for (int jj = 0; jj < 2; ++jj) { const int r = (4 * i + 2 * jj) & 15; float lg[2];
#pragma unroll
                for (int e = 0; e < 2; ++e) { const float z = (i < 4) ? p0[r + e] : p1[r + e]; float g = __builtin_amdgcn_logf(1.0f + __builtin_amdgcn_exp2f(z));
                    if (i < 4) p0[r + e] = z - g; else p1[r + e] = z - g;
                    if (DIAG) { const int key = kbase + (i < 4 ? 0 : 32) + 16 * ((r + e) >> 3) + ((r + e) & 7); g = (key < W.qabs) ? g : 0.f; }
                    lg[e] = g; }
                if (i == 0 && jj == 0) { lfirst = -lg[0]; pz0 = p0[0]; }
                lf[2 * (i >> 2) + (r >> 3)][(r & 7) >> 1] = pk_f16(-lg[0], -lg[1]);
                if (jj == 1) asm volatile("" : "+v"(kcur) : "v"(lf[2 * (i >> 2) + (r >> 3)][(r & 7) >> 1])); }
            if (i & 1) { n1 = ATT_MFMA(kcur, qcur, n1); qcur = qnxt; } else n0 = ATT_MFMA(kcur, qcur, n0);
            kcur = knxt;
            ATT_SB();
        }
        bf16x8 va = ATT_VF(0), vb = ATT_VF(1), vna = va, vnb = vb;
#pragma unroll
        for (int r = 0; r < 16; ++r) { p0[r] += carry; p1[r] += carry; }
        p0 = ATT_MFMAH(W.mtri0, __builtin_bit_cast(f16x8, lf[0]), p0); p1 = ATT_MFMAH(W.mtri0, __builtin_bit_cast(f16x8, lf[2]), p1);
        p0 = ATT_MFMAH(W.mtri1, __builtin_bit_cast(f16x8, lf[1]), p0); p1 = ATT_MFMAH(W.mtri1, __builtin_bit_cast(f16x8, lf[3]), p1);
        p0 = ATT_MFMAH(W.mones, __builtin_bit_cast(f16x8, lf[2]), p0);
        p0 = ATT_MFMAH(W.mones, __builtin_bit_cast(f16x8, lf[3]), p0);
        ATT_SB();
        const float t00 = p0[0];
#pragma unroll
        for (int c = 0; c < 4; ++c) {
            if (c < 3) { vna = ATT_VF(2 * c + 2); vnb = ATT_VF(2 * c + 3); }
#pragma unroll
            for (int j = 0; j < 4; ++j) { const int r = 8 * (c & 1) + 2 * j; float w[2];
#pragma unroll
                for (int e = 0; e < 2; ++e) { const float t = (c < 2) ? p0[r + e] : p1[r + e]; float x = __builtin_amdgcn_exp2f(t);
                    if (DIAG) { const int key = kbase + (c < 2 ? 0 : 32) + 16 * ((r + e) >> 3) + ((r + e) & 7); x = (key < W.qabs) ? x : 0.f; }
                    w[e] = x; }
                wf[c][j] = pk_bf16(w[0], w[1]); }
            o0 = ATT_MFMA(va, __builtin_bit_cast(bf16x8, wf[c]), o0); o1 = ATT_MFMA(vb, __builtin_bit_cast(bf16x8, wf[c]), o1);
            va = vna; vb = vnb;
            ATT_SB();
        }
        carry = half_sum(W.hi == 0 ? (t00 - pz0) + lfirst : 0.f);
    } else {
#define ATT_FBV(i) (*(const LAS f32x4*)(Fb + 8 * W.hi + 32 * ((i) >> 2) + 16 * (((i) >> 1) & 1) + 4 * ((i) & 1)))
        f32x4 fcur = ATT_FBV(0), fnxt = fcur;
        float mx = -1e30f;
#pragma unroll
        for (int i = 0; i < 8; ++i) {
            if (i < 7) { knxt = ATT_KF(i + 1); fnxt = ATT_FBV(i + 1); if (i & 1) qnxt = ATT_QF((i + 1) >> 1); }
#pragma unroll
            for (int e = 0; e < 4; ++e) { const int r = (4 * i + e) & 15; float s = ((i < 4) ? p0[r] : p1[r]) - fcur[e];
                if (DIAG) { const int key = kbase + (i < 4 ? 0 : 32) + 16 * (r >> 3) + (r & 7); s = (key > W.qabs) ? -1e30f : s; }
                if (i < 4) p0[r] = s; else p1[r] = s; mx = fmaxf(mx, s); }
            asm volatile("" : "+v"(kcur) : "v"(mx));
            if (i & 1) { n1 = ATT_MFMA(kcur, qcur, n1); qcur = qnxt; } else n0 = ATT_MFMA(kcur, qcur, n0);
            kcur = knxt; fcur = fnxt;
            ATT_SB();
        }
        bf16x8 va = ATT_VF(0), vb = ATT_VF(1), vna = va, vnb = vb;
        mx = half_max(mx);
        if (__any(mx > carry)) {
            const float mnew = fmaxf(carry, mx), alpha = __builtin_amdgcn_exp2f(carry - mnew); carry = mnew; lsum *= alpha;
#pragma unroll
            for (int r = 0; r < 16; ++r) { o0[r] *= alpha; o1[r] *= alpha; }
        }
        ATT_SB();
        float ps = 0.f;
#pragma unroll
        for (int c = 0; c < 4; ++c) {
            if (c < 3) { vna = ATT_VF(2 * c + 2); vnb = ATT_VF(2 * c + 3); }
#pragma unroll
            for (int j = 0; j < 4; ++j) { const int r = 8 * (c & 1) + 2 * j;
                const float a = __builtin_amdgcn_exp2f(((c < 2) ? p0[r] : p1[r]) - carry), d = __builtin_amdgcn_exp2f(((c < 2) ? p0[r + 1] : p1[r + 1]) - carry);
                ps += a + d; wf[c][j] = pk_bf16(a, d); }
            o0 = ATT_MFMA(va, __builtin_bit_cast(bf16x8, wf[c]), o0); o1 = ATT_MFMA(vb, __builtin_bit_cast(bf16x8, wf[c]), o1);
            va = vna; vb = vnb;
            ATT_SB();
        }
        lsum += half_sum(ps);
    }
    p0 = n0; p1 = n1;
#undef ATT_KF
#undef ATT_QF
#undef ATT_VF
#undef ATT_FBV
}

template <int KIND>
__device__ __forceinline__ void unit(const Tensors& T, int b, int h, int qb, LAS unsigned char* lds, int wave) {
    int lane_ = (int)__builtin_amdgcn_mbcnt_hi(~0u, __builtin_amdgcn_mbcnt_lo(~0u, 0u)); asm volatile("" : "+v"(lane_));
    const int wid = wave, lane = lane_, tid = wid * 64 + lane;
    WaveCtx W; W.r32 = lane & 31; W.hi = lane >> 5;
    const int q0 = qb * 256, qw0 = q0 + wid * 32; W.qabs = qw0 + W.r32;
    const size_t rowbase = (size_t)b * SEQ;
    const int ktd = qw0 >> 6;
    const int kt_hi = (q0 + 255) >> 6;
    const int srow = tid >> 3, cg = (tid & 7) ^ ((srow >> 1) & 7);
    const bf16* kg = T.proj + (rowbase + srow) * NPROJ + T.colk + h * 64 + cg * 8;
    const bf16* vg = T.vt + ((size_t)(b * 6 + h) * 64 + srow) * SEQ + cg * 8;
    const float* fg = T.fcum + (size_t)(b * 6 + h) * SEQ;
    LAS unsigned char* qlds = lds + OFF_Q + wid * 4608;
    W.qb = qlds + W.r32 * 144 + W.hi * 16;
    { const bf16* qp = T.proj + (rowbase + W.qabs) * NPROJ + T.colq + h * 64 + W.hi * 8;
      v4u qt[4];
#pragma unroll
      for (int d0 = 0; d0 < 4; ++d0) qt[d0] = *(const v4u*)(qp + d0 * 16);
#pragma unroll
      for (int d0 = 0; d0 < 4; ++d0) *(LAS v4u*)(qlds + W.r32 * 144 + W.hi * 16 + 32 * d0) = qt[d0]; }
    const int pm = pim(W.r32);
#pragma unroll
    for (int j = 0; j < 4; ++j) W.ko[j] = pm * KROW + (((2 * j + W.hi) ^ ((pm >> 1) & 7)) << 4);
#pragma unroll
    for (int i = 0; i < 8; ++i) { W.mtri0[i] = (_Float16)((8 * W.hi + i > pm) ? 1.0f : 0.0f); W.mtri1[i] = (_Float16)((16 + 8 * W.hi + i > pm) ? 1.0f : 0.0f); W.mones[i] = (_Float16)1.0f; }
    f32x16 o0, o1, p0, p1;
#pragma unroll
    for (int r = 0; r < 16; ++r) { o0[r] = 0.f; o1[r] = 0.f; p0[r] = 0.f; p1[r] = 0.f; }
    float carry = (KIND == 1) ? -1e30f : 0.f, lsum = 0.f;
#define ATT_KB(t) (lds + OFF_K + ((t) & 1) * TILE_B)
#define ATT_VB(t) (lds + OFF_V + ((t) & 1) * TILE_B)
#define ATT_FB(t) ((LAS float*)(lds + OFF_F + ((t) & 1) * 256))
#define ATT_DMA(gsrc, ldst) glds16((gsrc), (unsigned)__builtin_amdgcn_readfirstlane((int)(uintptr_t)((ldst) + wid * 1024)))
    ATT_DMA(kg + (size_t)kt_hi * 64 * NPROJ, ATT_KB(kt_hi)); ATT_DMA(vg + kt_hi * 64, ATT_VB(kt_hi)); ATT_DMA(kg + (size_t)(kt_hi - 1) * 64 * NPROJ, ATT_KB(kt_hi - 1));
    if (KIND == 1 && tid < 64) ATT_FB(kt_hi)[tid] = fg[kt_hi * 64 + tid];
    asm volatile("s_waitcnt vmcnt(0)" ::: "memory");
    __syncthreads();
    if (ktd == kt_hi) qk_only(p0, p1, ATT_KB(kt_hi), W);
    __syncthreads();
#ifdef TPROBE
    unsigned long long tacc = 0ull;
#endif
    constexpr float EXIT_LOG2 = -64.0f;
    LAS int* flags = (LAS int*)(lds + OFF_FLAG);
    bool wdone = false;
    for (int kt = kt_hi; kt >= 0; --kt) {
        float freg = 0.f, fnx = 0.f;
        if (KIND == 1 && kt >= 1) fnx = fg[kt * 64 - 1];
#ifdef TPROBE
        const unsigned long long tp0 = __builtin_readcyclecounter();
#endif
        if (kt >= 2) ATT_DMA(kg + (size_t)(kt - 2) * 64 * NPROJ, ATT_KB(kt - 2));
        if (kt >= 1) { ATT_DMA(vg + (kt - 1) * 64, ATT_VB(kt - 1)); if (KIND == 1 && tid < 64) freg = fg[(kt - 1) * 64 + tid]; }
#ifdef TPROBE
        const unsigned long long tp1 = __builtin_readcyclecounter();
#endif
        if (kt <= ktd) {
            if (!wdone) {
                if (kt == ktd) tile<KIND, true>(p0, p1, o0, o1, carry, lsum, ATT_KB(kt - 1), ATT_VB(kt), ATT_FB(kt), kt, W);
                else tile<KIND, false>(p0, p1, o0, o1, carry, lsum, ATT_KB(kt - 1), ATT_VB(kt), ATT_FB(kt), kt, W);
                const float slack = (KIND == 0) ? carry : (T.z2max - fnx) - carry;
                wdone = !__any(!(slack < EXIT_LOG2));
            }
        } else if (kt - 1 == ktd) qk_only(p0, p1, ATT_KB(kt - 1), W);
        if (lane == 0) flags[(kt & 1) * 8 + wid] = wdone ? 1 : 0;
        if (KIND == 1 && kt >= 1 && tid < 64) ATT_FB(kt - 1)[tid] = freg;
#ifdef TPROBE
        const unsigned long long tp2 = __builtin_readcyclecounter();
#endif
        asm volatile("s_waitcnt vmcnt(0)" ::: "memory");
#ifdef ATT_LDSFLUSH
        { unsigned dummy; asm volatile("ds_read_b32 %0, %1\n\ts_waitcnt lgkmcnt(0)" : "=v"(dummy) : "v"((unsigned)(uintptr_t)(lds + OFF_V + wid * 1024 + lane * 16)) : "memory"); }
#endif
        __syncthreads();
        if (__all(flags[(kt & 1) * 8 + (lane & 7)] != 0)) break;
#ifdef TPROBE
        const unsigned long long tp3 = __builtin_readcyclecounter();
        tacc += (TPROBE == 1) ? (tp3 - tp2) : (TPROBE == 2) ? (tp3 - tp0) : (TPROBE == 3) ? (tp2 - tp1) : (tp1 - tp0);
        asm volatile("" :: "s"(tp0), "s"(tp1), "s"(tp2), "s"(tp3));
#endif
    }
#ifdef TPROBE
    if (blockIdx.x == TPROBE_BLK && tid == TPROBE_WAVE * 64) atomicAdd((unsigned long long*)T.tprobe, tacc);
#endif
#undef ATT_KB
#undef ATT_VB
#undef ATT_FB
#undef ATT_DMA
    if (KIND == 1) { const float inv = 1.0f / lsum;
#pragma unroll
        for (int r = 0; r < 16; ++r) { o0[r] *= inv; o1[r] *= inv; } }
    float ss = 0.f;
#pragma unroll
    for (int r = 0; r < 16; ++r) ss += o0[r] * o0[r] + o1[r] * o1[r];
    ss = half_sum(ss);
    const float rinv = 1.0f / sqrtf(ss * (1.0f / 64.0f) + EPS);
    const float* gp = T.ong + T.coly + h * 64 + 8 * W.hi;
    bf16* yp = T.ymix + (rowbase + W.qabs) * DM + T.coly + h * 64 + 8 * W.hi;
#pragma unroll
    for (int d0 = 0; d0 < 2; ++d0)
#pragma unroll
        for (int g = 0; g < 2; ++g) { const f32x4 ga = *(const f32x4*)(gp + 32 * d0 + 16 * g), gb = *(const f32x4*)(gp + 32 * d0 + 16 * g + 4);
            float v[8];
#pragma unroll
            for (int i = 0; i < 8; ++i) v[i] = (d0 == 0 ? o0[8 * g + i] : o1[8 * g + i]) * rinv * (i < 4 ? ga[i & 3] : gb[i & 3]);
            v4u w; w.x = pk_bf16(v[0], v[1]); w.y = pk_bf16(v[2], v[3]); w.z = pk_bf16(v[4], v[5]); w.w = pk_bf16(v[6], v[7]);
            *(v4u*)(yp + 32 * d0 + 16 * g) = w; }
}
}
constexpr size_t MiB = 1u << 20;
constexpr size_t WS_CTL = 0, CTL_ZERO_BYTES = 1 * MiB;
constexpr size_t WS_MODP = 1 * MiB;
constexpr size_t WS_TOPW = 3 * MiB;
constexpr size_t WS_ROUTE = WS_TOPW + 512 * 1024;
constexpr size_t WS_TOKSLOT = WS_ROUTE + 512 * 1024;
constexpr size_t WS_SLOTTOK = WS_TOKSLOT + 512 * 1024;
constexpr size_t WS_HIST = WS_SLOTTOK + 576 * 1024;
constexpr size_t WS_MOETAB = WS_HIST + 32 * 1024;
constexpr size_t WS_LOGF = 6 * MiB;
constexpr size_t WS_FCUM = 7 * MiB;
constexpr size_t WS_WIN = 8 * MiB, WS_WOUT = 20 * MiB, WS_W1 = 24 * MiB, WS_W2 = 280 * MiB;
constexpr size_t WS_H = 408 * MiB;
constexpr size_t WS_PROJ = 472 * MiB;
constexpr size_t WS_VT = 664 * MiB;
constexpr size_t WS_YMIX = 712 * MiB;
constexpr size_t WS_XA = 776 * MiB, WS_XB = 904 * MiB;
constexpr size_t WS_ACT = 1032 * MiB, WS_Y = 1304 * MiB, WS_H8 = 1576 * MiB, WS_END = 1608 * MiB;
static_assert(WS_MOETAB + 256 <= WS_LOGF && (size_t)NSLOT_MAX * 4 <= 576 * 1024 && (size_t)NSLOT_MAX * DM * 2 <= 272 * MiB, "ws map");
#ifndef P2_FP8
#define P2_FP8 0
#endif
constexpr int CW_BAR = 4096;

constexpr int RING_BYTES = 131072;
constexpr int MISC_OFF = RING_BYTES;
constexpr int LDS_BYTES = 147456;

#define RLX_AGENT __ATOMIC_RELAXED, __HIP_MEMORY_SCOPE_AGENT
__device__ __forceinline__ unsigned f2bf(float f) { unsigned u = __builtin_bit_cast(unsigned, f); return (u + 0x7fffu + ((u >> 16) & 1u)) >> 16; }
__device__ __forceinline__ unsigned pk2(float lo, float hi) { return f2bf(lo) | (f2bf(hi) << 16); }
__device__ __forceinline__ float bflo(unsigned u) { return __builtin_bit_cast(float, u << 16); }
__device__ __forceinline__ float bfhi(unsigned u) { return __builtin_bit_cast(float, u & 0xffff0000u); }
__device__ __forceinline__ int shxi(int v, int o, int lane) {
    if (o == 1) return __builtin_amdgcn_mov_dpp(v, 0xB1, 0xf, 0xf, true);
    if (o == 2) return __builtin_amdgcn_mov_dpp(v, 0x4E, 0xf, 0xf, true);
    if (o == 4) return __builtin_amdgcn_ds_swizzle(v, 0x101F);
    if (o == 8) return __builtin_amdgcn_ds_swizzle(v, 0x201F);
    if (o == 16) return __builtin_amdgcn_ds_swizzle(v, 0x401F);
    return __builtin_amdgcn_ds_bpermute((lane ^ o) << 2, v);
}
__device__ __forceinline__ float shx(float v, int o, int lane) { return __builtin_bit_cast(float, shxi(__builtin_bit_cast(int, v), o, lane)); }
__device__ __forceinline__ float shup(float v, int o, int lane) { return __builtin_bit_cast(float, __builtin_amdgcn_ds_bpermute(((lane - o) & 63) << 2, __builtin_bit_cast(int, v))); }
__device__ __forceinline__ float add_other_half(float v) { auto rr = __builtin_amdgcn_permlane32_swap(__float_as_uint(v), __float_as_uint(v), false, false); return __uint_as_float(rr[0]) + __uint_as_float(rr[1]); }
__device__ __forceinline__ float wave_sum(float v, int lane) {
    v += shx(v, 1, lane); v += shx(v, 2, lane); v += shx(v, 4, lane); v += shx(v, 8, lane); v += shx(v, 16, lane);
    return add_other_half(v);
}

#define XB_TMO      128
#define XB_XCNT(j)  (256  + 64 * (j))
#define XB_XSUB(j)  (1280 + 64 * (j))
#define XB_XGEN(j)  (2304 + 64 * (j))
#define XB_TOP      3328
#define XB_TOPGEN   3392
#define XCD_BAR_WORDS 3456
#define XB_SPIN_CAP (1u << 18)
__device__ __forceinline__ unsigned xb_ld(unsigned* p)              { return __hip_atomic_load(p, __ATOMIC_RELAXED, __HIP_MEMORY_SCOPE_AGENT); }
__device__ __forceinline__ unsigned xb_add(unsigned* p, unsigned v) { return __hip_atomic_fetch_add(p, v, __ATOMIC_RELAXED, __HIP_MEMORY_SCOPE_AGENT); }
__device__ __forceinline__ unsigned xb_xcc_id() { return (unsigned)__builtin_amdgcn_s_getreg((3 << 11) | 20) & 0xFu; }
#define XB_SPIN(cond, bar) do { unsigned _sp = 0; while (cond) { __builtin_amdgcn_s_sleep(1); \
    if ((++_sp & 255u) == 0u) { if (xb_ld(&(bar)[XB_TMO])) break; if (_sp > XB_SPIN_CAP) { atomicAdd(&(bar)[XB_TMO], 1u); break; } } } } while (0)
__device__ __forceinline__ int lane_id() { return (int)__builtin_amdgcn_mbcnt_hi(~0u, __builtin_amdgcn_mbcnt_lo(~0u, 0u)); }
struct XcdBarrier { unsigned* bar; unsigned x; volatile LAS unsigned* st; int wave; };
__device__ __forceinline__ XcdBarrier xcd_barrier_post(unsigned* bar, volatile LAS unsigned* st, int wave) {
    XcdBarrier b; b.bar = bar; b.x = (unsigned)__builtin_amdgcn_readfirstlane((int)xb_xcc_id()); b.st = st; b.wave = wave;
    if (wave == 0 && lane_id() == 0) (void)xb_add(&bar[XB_XCNT(b.x)], 1u);
    return b;
}
__device__ __forceinline__ void xcd_barrier_complete(unsigned* bar, unsigned x, unsigned& nloc, unsigned& nx) {
    const unsigned G = gridDim.x * gridDim.y * gridDim.z;
    unsigned sum, cnt, mine, sp = 0u;
    for (;;) {
        sum = 0u; cnt = 0u; mine = 0u;
#pragma unroll
        for (unsigned j = 0; j < 16; ++j) { const unsigned c = xb_ld(&bar[XB_XCNT(j)]); sum += c; cnt += (c > 0u) ? 1u : 0u; mine = (j == x) ? c : mine; }
        if (sum == G) break;
        __builtin_amdgcn_s_sleep(1);
        if ((++sp & 255u) == 0u) { if (xb_ld(&bar[XB_TMO])) break; if (sp > XB_SPIN_CAP) { atomicAdd(&bar[XB_TMO], 1u); break; } }
    }
    nloc = mine > 0u ? mine : 1u; nx = cnt > 0u ? cnt : 1u;
}
__device__ __forceinline__ void xcd_barrier(const XcdBarrier& b) {
    asm volatile("s_waitcnt vmcnt(0)" ::: "memory");
    __syncthreads();
    if (b.wave == 0 && lane_id() == 0) {
        unsigned* bar = b.bar; const unsigned bx = (unsigned)__builtin_amdgcn_readfirstlane((int)xb_xcc_id());
        __builtin_amdgcn_s_waitcnt(0);
        unsigned nloc = b.st[0], nx = b.st[1];
        if (nloc == 0u) { xcd_barrier_complete(bar, bx, nloc, nx); b.st[0] = nloc; b.st[1] = nx; }
        const unsigned old = xb_add(&bar[XB_XSUB(bx)], 1u);
        const unsigned gen = old / nloc;
        if (old + 1u == (gen + 1u) * nloc) {
            __builtin_amdgcn_fence(__ATOMIC_RELEASE, "agent");
            asm volatile("s_waitcnt vmcnt(0)" ::: "memory");
            const unsigned og = xb_add(&bar[XB_TOP], 1u);
            const unsigned tg = og / nx;
            if (og + 1u == (tg + 1u) * nx) xb_add(&bar[XB_TOPGEN], 1u);
            else XB_SPIN(xb_ld(&bar[XB_TOPGEN]) == tg, bar);
            __builtin_amdgcn_fence(__ATOMIC_ACQUIRE, "agent");
            xb_add(&bar[XB_XGEN(bx)], 1u);
            asm volatile("s_waitcnt vmcnt(0)" ::: "memory");
        } else {
            XB_SPIN(xb_ld(&bar[XB_XGEN(bx)]) == gen, bar);
            __builtin_amdgcn_fence(__ATOMIC_ACQUIRE, "agent");
            asm volatile("s_waitcnt vmcnt(0)" ::: "memory");
        }
    }
    __syncthreads();
}

struct Frame {
    LAS unsigned char* lds;
    int tid, lane, wave, blk, G;
    const float* in[21];
    float* out; unsigned char* ws;
};
enum { I_X = 0, I_C, I_N1G, I_WADA, I_BADA, I_WIN, I_CONVW, I_SBQG, I_SBKG, I_FXQG, I_FXKG, I_FXFB, I_ONG, I_WOUT, I_N2G, I_RW, I_RB, I_W1, I_B1, I_W2, I_B2 };

template <int MAP, bool WIDE, bool OUT8 = false>
__device__ __forceinline__ void p0_transpose_item(const float* W, int ldw, bf16* WT, LAS float* scr, int k0, int n0, int lane) {
    if (WIDE) {
        f32x4 t[8];
#pragma unroll
        for (int i = 0; i < 8; ++i) t[i] = __builtin_nontemporal_load((const f32x4*)(W + (size_t)(k0 + 8 * i + (lane >> 3)) * ldw + n0 + 4 * (lane & 7)));
#pragma unroll
        for (int i = 0; i < 8; ++i) { LAS float* d = scr + (8 * i + (lane >> 3)) * 33 + 4 * (lane & 7); d[0] = t[i].x; d[1] = t[i].y; d[2] = t[i].z; d[3] = t[i].w; }
    } else {
#pragma unroll 8
        for (int i = 0; i < 32; ++i) { const int kk = 2 * i + (lane >> 5); scr[kk * 33 + (lane & 31)] = W[(size_t)(k0 + kk) * ldw + n0 + (lane & 31)]; }
    }
    asm volatile("s_waitcnt lgkmcnt(0)" ::: "memory");
    const int c = lane & 7;
#pragma unroll
    for (int j = 0; j < 4; ++j) { const int n = (lane >> 3) + 8 * j; const LAS float* s = scr + (8 * c) * 33 + n;
        v4u o; o.x = pk2(s[0 * 33], s[1 * 33]); o.y = pk2(s[2 * 33], s[3 * 33]); o.z = pk2(s[4 * 33], s[5 * 33]); o.w = pk2(s[6 * 33], s[7 * 33]);
        const int cn = n0 + n; int row = cn;
        if (MAP == 1) { const int jj = cn >> 1, t = cn & 1; row = 256 * (jj >> 7) + 128 * t + (jj & 127); }
        if (OUT8) { v2u o8; o8.x = pg8::pk4_fp8(32.0f * s[0 * 33], 32.0f * s[1 * 33], 32.0f * s[2 * 33], 32.0f * s[3 * 33]); o8.y = pg8::pk4_fp8(32.0f * s[4 * 33], 32.0f * s[5 * 33], 32.0f * s[6 * 33], 32.0f * s[7 * 33]);
            *(v2u*)((unsigned char*)WT + (size_t)row * 1024 + k0 + 8 * c) = o8; }
        else *(v4u*)(WT + (size_t)row * 1024 + k0 + 8 * c) = o; }
    asm volatile("s_waitcnt lgkmcnt(0)" ::: "memory");
}
__device__ __forceinline__ void p0_prologue(Frame& F) {
    LAS float* scr = (LAS float*)(F.lds + F.wave * 16384);
    const int gw = F.blk * 8 + F.wave, NGW = F.G * 8;
    constexpr int N_ADA = NLAYER * 4 * 24;
    if (F.blk * 8 < N_ADA) {
        LAS float* sl = (LAS float*)(F.lds + 8 * 16384 - 32768);
        for (int i = F.tid; i < NB * DM; i += 512) { const float cv = F.in[I_C][i]; sl[i] = cv / (1.0f + __expf(-cv)); }
        __syncthreads();
        if (gw < N_ADA) {
            const int it = gw; const int l = it / 96, ks = (it / 24) & 3, nc = it % 24;
            const float* W = F.in[I_WADA] + (size_t)l * DM * 6144 + nc * 256 + F.lane * 4;
            f32x4 acc[NB];
#pragma unroll
            for (int b = 0; b < NB; ++b) acc[b] = (f32x4){0.f, 0.f, 0.f, 0.f};
#pragma unroll 8
            for (int k = ks * 256; k < ks * 256 + 256; ++k) {
                const f32x4 w = __builtin_nontemporal_load((const f32x4*)(W + (size_t)k * 6144));
#pragma unroll
                for (int b = 0; b < NB; ++b) acc[b] += w * sl[b * DM + k];
            }
            float* dst = (float*)(F.ws + WS_MODP) + ((size_t)(l * 4 + ks) * NB) * 6144 + nc * 256 + F.lane * 4;
#pragma unroll
            for (int b = 0; b < NB; ++b) *(f32x4*)(dst + (size_t)b * 6144) = acc[b];
        }
        __syncthreads();
    }
    constexpr int I_IN = 16 * 96, I_OUT = 16 * 32, I_1 = 16 * 64, I_2 = 16 * 32;
    constexpr int N_IN = NLAYER * I_IN, N_OUT = NLAYER * I_OUT, N_1 = NLAYER * NEXP * I_1, N_2 = NLAYER * NEXP * I_2;
#pragma unroll 1
    for (int it = gw; it < N_IN + N_OUT; it += NGW) {
        int r = it;
        if (r < N_IN) { const int l = r / I_IN, q = r % I_IN, kb = q / 96, nb = q % 96;
            p0_transpose_item<0, false, P2_FP8>(F.in[I_WIN] + (size_t)l * DM * D_IN, D_IN, (bf16*)(F.ws + WS_WIN + (size_t)l * NPROJ * DM * (P2_FP8 ? 1 : 2)), scr, 64 * kb, 32 * nb, F.lane); continue; }
        r -= N_IN;
        { const int l = r / I_OUT, q = r % I_OUT, kb = q / 32, nb = q % 32;
            p0_transpose_item<0, true>(F.in[I_WOUT] + (size_t)l * DM * DM, DM, (bf16*)(F.ws + WS_WOUT) + (size_t)l * DM * DM, scr, 64 * kb, 32 * nb, F.lane); }
    }
    constexpr int ADA_SKIP = 6, NE = N_1 + N_2;
    const bool adaw = gw < N_ADA; const int pool = adaw ? -1 : (gw - N_ADA < N_ADA * ADA_SKIP ? gw - N_ADA : -1);
    const int pool_it = (pool >= 0) ? (pool % N_ADA) + (pool / N_ADA) * NGW : -1;
    f32x4 cur[8], nxt[8];
#define P0_LOAD(dst, itx_) do { const int it_ = ((itx_) < 0) ? pool_it : (itx_); const float* s_; int ldw_; \
        if (it_ < N_1) { const int le = it_ / I_1, q = it_ % I_1, kb = q / 64, nb = q % 64; ldw_ = 2048; s_ = F.in[I_W1] + (size_t)le * DM * 2048 + (size_t)(64 * kb + (F.lane >> 3)) * 2048 + 32 * nb + 4 * (F.lane & 7); } \
        else { const int r_ = it_ - N_1; const int le = r_ / I_2, q = r_ % I_2, kb = q / 32, nb = q % 32; ldw_ = DM; s_ = F.in[I_W2] + (size_t)le * DM * DM + (size_t)(64 * kb + (F.lane >> 3)) * DM + 32 * nb + 4 * (F.lane & 7); } \
        _Pragma("unroll") for (int i = 0; i < 8; ++i) dst[i] = __builtin_nontemporal_load((const f32x4*)(s_ + (size_t)(8 * i) * ldw_)); } while (0)
    int itx = adaw ? gw + ADA_SKIP * NGW : (pool >= 0 ? gw - NGW : gw);
    if (itx < NE) P0_LOAD(cur, itx);
#pragma unroll 1
    for (; itx < NE; itx += NGW) {
        if (itx + NGW < NE) P0_LOAD(nxt, itx + NGW);
#pragma unroll
        for (int i = 0; i < 8; ++i) { LAS float* d = scr + (8 * i + (F.lane >> 3)) * 33 + 4 * (F.lane & 7); d[0] = cur[i].x; d[1] = cur[i].y; d[2] = cur[i].z; d[3] = cur[i].w; }
        asm volatile("s_waitcnt lgkmcnt(0)" ::: "memory");
        { const int it = (itx < 0) ? pool_it : itx; const bool isw1 = it < N_1; const int r = isw1 ? it : it - N_1;
          const int per = isw1 ? I_1 : I_2, nbn = isw1 ? 64 : 32; const int le = r / per, q = r % per, kb = q / nbn, nb = q % nbn;
          unsigned char* WT = isw1 ? F.ws + WS_W1 + (size_t)le * 2048 * DM : F.ws + WS_W2 + (size_t)le * DM * DM;
          const int c = F.lane & 7;
#pragma unroll
          for (int j = 0; j < 4; ++j) { const int n = (F.lane >> 3) + 8 * j; const LAS float* s = scr + (8 * c) * 33 + n;
              v2u o8; o8.x = pg8::pk4_fp8(32.0f * s[0 * 33], 32.0f * s[1 * 33], 32.0f * s[2 * 33], 32.0f * s[3 * 33]); o8.y = pg8::pk4_fp8(32.0f * s[4 * 33], 32.0f * s[5 * 33], 32.0f * s[6 * 33], 32.0f * s[7 * 33]);
              const int cn = 32 * nb + n; int row = cn;
              if (isw1) { const int jj = cn >> 1, t = cn & 1; row = 256 * (jj >> 7) + 128 * t + (jj & 127); }
              *(v2u*)(WT + (size_t)row * 1024 + 64 * kb + 8 * c) = o8; } }
        asm volatile("s_waitcnt lgkmcnt(0)" ::: "memory");
#pragma unroll
        for (int i = 0; i < 8; ++i) cur[i] = nxt[i];
    }
#undef P0_LOAD
}

__device__ __forceinline__ f32x4 mod4(const Frame& F, int l, int b, int which, int c) {
    const int n = which * DM + c;
    f32x4 s = *(const f32x4*)(F.in[I_BADA] + (size_t)l * 6144 + n);
    const float* p = (const float*)(F.ws + WS_MODP) + ((size_t)(l * 4) * NB + b) * 6144 + n;
#pragma unroll
    for (int ks = 0; ks < 4; ++ks) s += *(const f32x4*)(p + (size_t)ks * NB * 6144);
    return s;
}

constexpr size_t WS_GSUM = WS_FCUM + 800 * 1024;
static_assert(WS_GSUM + 16384 <= WS_WIN, "ws map");
template <bool S16> __device__ __forceinline__ f32x4 ld_row4(const void* base, size_t idx) {
    if (S16) { const v2u t = *(const v2u*)((const bf16*)base + idx); return (f32x4){bflo(t.x), bfhi(t.x), bflo(t.y), bfhi(t.y)}; }
    return *(const f32x4*)((const float*)base + idx); }
template <bool D16> __device__ __forceinline__ void st_row4(void* base, size_t idx, f32x4 v) {
    if (D16) { v2u o; o.x = pk2(v.x, v.y); o.y = pk2(v.z, v.w); *(v2u*)((bf16*)base + idx) = o; }
    else *(f32x4*)((float*)base + idx) = v; }
__device__ __forceinline__ f32x4 fp8x4_to_f32(unsigned w) { return (f32x4){__builtin_amdgcn_cvt_f32_fp8(w, 0), __builtin_amdgcn_cvt_f32_fp8(w, 1), __builtin_amdgcn_cvt_f32_fp8(w, 2), __builtin_amdgcn_cvt_f32_fp8(w, 3)}; }
template <bool COMBINE, bool NORM, bool S16, bool D16>
__device__ __forceinline__ void row_phase(Frame& F, int l, const void* xsrc, void* xdst) {
    const float* topw = (const float*)(F.ws + WS_TOPW); const int* tokslot = (const int*)(F.ws + WS_TOKSLOT); const unsigned char* Y = F.ws + WS_Y;
    bf16* H = (bf16*)(F.ws + WS_H); float* logf = (float*)(F.ws + WS_LOGF); float* gsum = (float*)(F.ws + WS_GSUM);
    LAS f32x4* wl4 = (LAS f32x4*)F.lds; LAS f32x2* wl2 = (LAS f32x2*)(F.lds + 16384); LAS float* part = (LAS float*)(F.lds + 16384 + 8192);
    if (NORM) { for (int k = F.tid; k < DM; k += 512) { const float* wp = F.in[I_WIN] + (size_t)l * DM * D_IN + (size_t)k * D_IN + NPROJ; const int idx = (4 * (k >> 8) + (k & 3)) * 64 + ((k >> 2) & 63);
            wl4[idx] = (f32x4){wp[0], wp[1], wp[2], wp[3]}; wl2[idx] = (f32x2){wp[4], wp[5]}; }
        __syncthreads(); }
    for (int chunk = F.blk; chunk < NTOK / 128; chunk += F.G) {
        const int b = chunk / (SEQ / 128);
        LAS f32x4* mv = (LAS f32x4*)(F.lds + 32768);
        __syncthreads();
        if (F.wave == 0) {
#pragma unroll
            for (int j = 0; j < 4; ++j) { const int c = 256 * j + 4 * F.lane;
                if (COMBINE) mv[(0 * 4 + j) * 64 + F.lane] = mod4(F, l - 1, b, 5, c);
                if (NORM) { const f32x4 g = *(const f32x4*)(F.in[I_N1G] + (size_t)l * DM + c); mv[(1 * 4 + j) * 64 + F.lane] = g * (mod4(F, l, b, 1, c) + 1.0f); mv[(2 * 4 + j) * 64 + F.lane] = mod4(F, l, b, 0, c); } } }
        __syncthreads();
        float lacc = 0.f;
#pragma unroll 1
        for (int rr = 0; rr < 16; rr += 2) {
            const int row = chunk * 128 + F.wave * 16 + rr;
            f32x4 v[2][4];
#pragma unroll
            for (int u = 0; u < 2; ++u)
#pragma unroll
                for (int j = 0; j < 4; ++j) v[u][j] = ld_row4<S16>(xsrc, (size_t)(row + u) * DM + 256 * j + 4 * F.lane);
            int mofs = F.lane; asm volatile("" : "+v"(mofs));
            if (COMBINE) {
#pragma unroll
                for (int u = 0; u < 2; ++u) {
                    f32x4 s[4];
#pragma unroll
                    for (int j = 0; j < 4; ++j) s[j] = (f32x4){0.f, 0.f, 0.f, 0.f};
#pragma unroll
                    for (int k = 0; k < TOPK; ++k) { const float w = topw[(row + u) * 4 + k]; const int slot = tokslot[(row + u) * 4 + k];
#pragma unroll
                        for (int j = 0; j < 4; ++j) s[j] += fp8x4_to_f32(*(const unsigned*)(Y + (size_t)slot * DM + 256 * j + 4 * F.lane)) * w; }
#pragma unroll
                    for (int j = 0; j < 4; ++j) { v[u][j] += mv[(0 * 4 + j) * 64 + mofs] * s[j]; st_row4<D16>(xdst, (size_t)(row + u) * DM + 256 * j + 4 * F.lane, v[u][j]); }
                }
            }
            if (NORM) {
                float ss[2];
#pragma unroll
                for (int u = 0; u < 2; ++u) { float s = 0.f;
#pragma unroll
                    for (int j = 0; j < 4; ++j) s += (v[u][j].x * v[u][j].x + v[u][j].y * v[u][j].y) + (v[u][j].z * v[u][j].z + v[u][j].w * v[u][j].w);
                    ss[u] = s; }
#pragma unroll
                for (int o = 1; o < 32; o <<= 1) { ss[0] += shx(ss[0], o, F.lane); ss[1] += shx(ss[1], o, F.lane); }
                ss[0] = add_other_half(ss[0]); ss[1] = add_other_half(ss[1]);
                float fl[2][6];
                int lofs = F.lane; asm volatile("" : "+v"(lofs));
#pragma unroll
                for (int u = 0; u < 2; ++u) { const float rstd = 1.0f / sqrtf(ss[u] * (1.0f / DM) + EPS);
#pragma unroll
                    for (int q = 0; q < 6; ++q) fl[u][q] = 0.f;
#pragma unroll
                    for (int j = 0; j < 4; ++j) { const f32x4 hv = v[u][j] * rstd * mv[(1 * 4 + j) * 64 + mofs] + mv[(2 * 4 + j) * 64 + mofs];
                        if (P2_FP8) *(unsigned*)((unsigned char*)H + (size_t)(row + u) * DM + 256 * j + 4 * F.lane) = pg8::pk4_fp8(hv.x, hv.y, hv.z, hv.w);
                        else { v2u o; o.x = pk2(hv.x, hv.y); o.y = pk2(hv.z, hv.w); *(v2u*)(H + (size_t)(row + u) * DM + 256 * j + 4 * F.lane) = o; }
#pragma unroll
                        for (int i = 0; i < 4; ++i) { const f32x4 wa = wl4[(4 * j + i) * 64 + lofs]; const f32x2 wb = wl2[(4 * j + i) * 64 + lofs]; const float hx = hv[i];
                            fl[u][0] += hx * wa.x; fl[u][1] += hx * wa.y; fl[u][2] += hx * wa.z; fl[u][3] += hx * wa.w; fl[u][4] += hx * wb.x; fl[u][5] += hx * wb.y; } } }
#pragma unroll
                for (int o = 1; o < 32; o <<= 1)
#pragma unroll
                    for (int u = 0; u < 2; ++u)
#pragma unroll
                        for (int q = 0; q < 6; ++q) fl[u][q] += shx(fl[u][q], o, F.lane);
#pragma unroll
                for (int u = 0; u < 2; ++u)
#pragma unroll
                    for (int q = 0; q < 6; ++q) fl[u][q] = add_other_half(fl[u][q]);
                if (F.lane < 6) {
#pragma unroll
                    for (int u = 0; u < 2; ++u) { float z = fl[u][0];
#pragma unroll
                        for (int q = 1; q < 6; ++q) z = (F.lane == q) ? fl[u][q] : z;
                        z += F.in[I_FXFB][l * 6 + F.lane];
                        const float lg = fminf(z, 0.f) - __logf(1.0f + __expf(-fabsf(z)));
                        logf[(size_t)(row + u) * 6 + F.lane] = lg; lacc += lg; } }
            }
        }
        if (NORM) {
            if (F.lane < 6) part[F.wave * 8 + F.lane] = lacc;
            __syncthreads();
            if (F.tid < 12) { const int g = F.tid / 6, h = F.tid % 6; gsum[(size_t)(chunk * 2 + g) * 6 + h] = (part[(4 * g) * 8 + h] + part[(4 * g + 1) * 8 + h]) + (part[(4 * g + 2) * 8 + h] + part[(4 * g + 3) * 8 + h]); }
            __syncthreads();
        }
    }
    __syncthreads();
}
__device__ __forceinline__ void p3_postproj(Frame& F, int l) {
    bf16* proj = (bf16*)(F.ws + WS_PROJ); bf16* ymix = (bf16*)(F.ws + WS_YMIX);
    const float* ong = F.in[I_ONG] + (size_t)l * DM;
    const int c4 = 4 * F.lane;
    f32x4 cw[3];
#pragma unroll
    for (int w = 0; w < 3; ++w) cw[w] = *(const f32x4*)(F.in[I_CONVW] + (size_t)(l * 3 + w) * 256 + c4);
    const f32x4 cg = *(const f32x4*)(ong + c4);
    const int e0 = 8 * (F.lane & 7);
    float gq[3][8]; int colv[3];
#pragma unroll
    for (int i = 0; i < 3; ++i) { const int vi = 8 * i + (F.lane >> 3); const int ty = vi / 6;
        colv[i] = (vi < 12 ? COL_SQ + 64 * vi : COL_FQ + 64 * (vi - 12)) + e0;
        const float* gp = (ty == 0 ? F.in[I_SBQG] : ty == 1 ? F.in[I_SBKG] : ty == 2 ? F.in[I_FXQG] : F.in[I_FXKG]) + (size_t)l * 64 + e0; const float sc = (ty == 0 || ty == 2) ? QSCALE : 1.0f;
#pragma unroll
        for (int q = 0; q < 8; ++q) gq[i][q] = gp[q] * sc; }
    LAS unsigned char* scr = F.lds + F.wave * (64 * 144);
    for (int tile = F.blk; tile < NTOK / 64; tile += F.G) {
        const int b = tile / (SEQ / 64), s0 = (tile % (SEQ / 64)) * 64; const size_t row0 = (size_t)b * SEQ + s0;
        {
            const int sw0 = s0 + F.wave * 8;
            f32x4 vm2 = (f32x4){0.f, 0.f, 0.f, 0.f}, vm1 = vm2;
            if (sw0 >= 2) {
                const bf16* p2 = proj + ((size_t)b * SEQ + sw0 - 2) * NPROJ; const bf16* p1 = p2 + NPROJ;
                const v2u c2 = *(const v2u*)(p2 + COL_CC + c4), u2 = *(const v2u*)(p2 + COL_CU + c4), c1 = *(const v2u*)(p1 + COL_CC + c4), u1 = *(const v2u*)(p1 + COL_CU + c4);
                vm2 = (f32x4){bflo(c2.x) * bflo(u2.x), bfhi(c2.x) * bfhi(u2.x), bflo(c2.y) * bflo(u2.y), bfhi(c2.y) * bfhi(u2.y)};
                vm1 = (f32x4){bflo(c1.x) * bflo(u1.x), bfhi(c1.x) * bfhi(u1.x), bflo(c1.y) * bflo(u1.y), bfhi(c1.y) * bfhi(u1.y)}; }
#pragma unroll 1
            for (int tt = 0; tt < 8; tt += 2) {
                bf16* pr[2]; v2u cb[2], cc[2], cu[2]; v4u xq[2][3];
#pragma unroll
                for (int u = 0; u < 2; ++u) { pr[u] = proj + ((size_t)b * SEQ + sw0 + tt + u) * NPROJ;
                    cb[u] = *(const v2u*)(pr[u] + COL_CB + c4); cc[u] = *(const v2u*)(pr[u] + COL_CC + c4); cu[u] = *(const v2u*)(pr[u] + COL_CU + c4);
#pragma unroll
                    for (int i = 0; i < 3; ++i) xq[u][i] = *(const v4u*)(pr[u] + colv[i]); }
                f32x4 y[2]; float ss[2], q2[2][3];
#pragma unroll
                for (int u = 0; u < 2; ++u) {
                    const f32x4 v0 = (f32x4){bflo(cc[u].x) * bflo(cu[u].x), bfhi(cc[u].x) * bfhi(cu[u].x), bflo(cc[u].y) * bflo(cu[u].y), bfhi(cc[u].y) * bfhi(cu[u].y)};
                    y[u] = cw[0] * vm2 + cw[1] * vm1 + cw[2] * v0; vm2 = vm1; vm1 = v0;
                    y[u] = y[u] * (f32x4){bflo(cb[u].x), bfhi(cb[u].x), bflo(cb[u].y), bfhi(cb[u].y)};
                    ss[u] = (y[u].x * y[u].x + y[u].y * y[u].y) + (y[u].z * y[u].z + y[u].w * y[u].w);
#pragma unroll
                    for (int i = 0; i < 3; ++i) { const v4u x = xq[u][i]; const float f[8] = {bflo(x.x), bfhi(x.x), bflo(x.y), bfhi(x.y), bflo(x.z), bfhi(x.z), bflo(x.w), bfhi(x.w)};
                        float a = 0.f;
#pragma unroll
                        for (int k = 0; k < 8; ++k) a += f[k] * f[k];
                        q2[u][i] = a; } }
#pragma unroll
                for (int o = 1; o < 16; o <<= 1)
#pragma unroll
                    for (int u = 0; u < 2; ++u) { ss[u] += shx(ss[u], o, F.lane);
                        if (o < 8) {
#pragma unroll
                            for (int i = 0; i < 3; ++i) q2[u][i] += shx(q2[u][i], o, F.lane); } }
#pragma unroll
                for (int u = 0; u < 2; ++u) {
                    const float rinv = 1.0f / sqrtf(ss[u] * (1.0f / 64.0f) + EPS);
                    const f32x4 yo = y[u] * rinv * cg;
                    v2u o; o.x = pk2(yo.x, yo.y); o.y = pk2(yo.z, yo.w); *(v2u*)(ymix + ((size_t)b * SEQ + sw0 + tt + u) * DM + c4) = o;
#pragma unroll
                    for (int i = 0; i < 3; ++i) { const v4u x = xq[u][i]; const float f[8] = {bflo(x.x), bfhi(x.x), bflo(x.y), bfhi(x.y), bflo(x.z), bfhi(x.z), bflo(x.w), bfhi(x.w)};
                        const float ri = 1.0f / sqrtf(q2[u][i] * (1.0f / 64.0f) + EPS);
                        v4u w; w.x = pk2(f[0] * ri * gq[i][0], f[1] * ri * gq[i][1]); w.y = pk2(f[2] * ri * gq[i][2], f[3] * ri * gq[i][3]);
                        w.z = pk2(f[4] * ri * gq[i][4], f[5] * ri * gq[i][5]); w.w = pk2(f[6] * ri * gq[i][6], f[7] * ri * gq[i][7]);
                        *(v4u*)(pr[u] + colv[i]) = w; } }
            }
        }
        for (int t = F.wave; t < 12; t += 8) {
            const int kind = t / 6, h = t % 6; const int col = (kind ? COL_FV : COL_SV) + 64 * h;
            const bf16* src = proj + (row0 + F.lane) * NPROJ + col;
#pragma unroll
            for (int pc = 0; pc < 8; ++pc) { const v4u x = *(const v4u*)(src + 8 * pc);
                const unsigned xs[4] = {x.x, x.y, x.z, x.w};
#pragma unroll
                for (int q = 0; q < 4; ++q) { *(LAS unsigned short*)(scr + (8 * pc + 2 * q) * 144 + 2 * F.lane) = (unsigned short)(xs[q] & 0xffffu);
                                              *(LAS unsigned short*)(scr + (8 * pc + 2 * q + 1) * 144 + 2 * F.lane) = (unsigned short)(xs[q] >> 16); } }
            asm volatile("s_waitcnt lgkmcnt(0)" ::: "memory");
            bf16* dst = (bf16*)(F.ws + WS_VT) + (size_t)kind * (48 * 64 * SEQ) + ((size_t)(b * 6 + h) * 64 + F.lane) * SEQ + s0;
#pragma unroll
            for (int pc = 0; pc < 8; ++pc) *(v4u*)(dst + 8 * pc) = *(const LAS v4u*)(scr + F.lane * 144 + 16 * pc);
            asm volatile("s_waitcnt lgkmcnt(0)" ::: "memory");
        }
        if (F.wave == 7) { const int gt = tile % (SEQ / 64); const float* gs = (const float*)(F.ws + WS_GSUM) + (size_t)(b * (SEQ / 64)) * 6; const float* lf = (const float*)(F.ws + WS_LOGF) + (row0 + F.lane) * 6;
            float* fo = (float*)(F.ws + WS_FCUM) + (size_t)(b * 6) * SEQ + s0 + F.lane;
#pragma unroll
            for (int h = 0; h < 6; ++h) { float base = (F.lane < gt) ? gs[F.lane * 6 + h] : 0.f; base = wave_sum(base, F.lane);
                float inc = lf[h];
#pragma unroll
                for (int o = 1; o < 64; o <<= 1) { const float t = shup(inc, o, F.lane); if (F.lane >= o) inc += t; }
                fo[(size_t)h * SEQ] = (base + inc) * LOG2E; } }
    }
}

__device__ __forceinline__ void p4_attention(Frame& F, int l) {
    att::Tensors Ts, Tf;
    Ts.proj = (const bf16*)(F.ws + WS_PROJ); Ts.vt = (const bf16*)(F.ws + WS_VT); Ts.fcum = (const float*)(F.ws + WS_FCUM); Ts.ymix = (bf16*)(F.ws + WS_YMIX); Ts.ong = F.in[I_ONG] + (size_t)l * DM;
    Ts.colq = COL_SQ; Ts.colk = COL_SK; Ts.coly = 256; Ts.tprobe = (void*)(F.ws + WS_CTL + 512);
    Tf = Ts; Tf.vt = Ts.vt + (size_t)48 * 64 * SEQ; Tf.colq = COL_FQ; Tf.colk = COL_FK; Tf.coly = 640;
    {
        float gq = fabsf(F.in[I_FXQG][l * 64 + F.lane]), gk = fabsf(F.in[I_FXKG][l * 64 + F.lane]);
#pragma unroll
        for (int o = 1; o < 32; o <<= 1) { gq = fmaxf(gq, shx(gq, o, F.lane)); gk = fmaxf(gk, shx(gk, o, F.lane)); }
        { auto rq = __builtin_amdgcn_permlane32_swap(__float_as_uint(gq), __float_as_uint(gq), false, false); gq = fmaxf(__uint_as_float(rq[0]), __uint_as_float(rq[1]));
          auto rk = __builtin_amdgcn_permlane32_swap(__float_as_uint(gk), __float_as_uint(gk), false, false); gk = fmaxf(__uint_as_float(rk[0]), __uint_as_float(rk[1])); }
        Tf.z2max = 64.0f * gq * gk * QSCALE * 1.02f; Ts.z2max = 0.f;
    }
    const int NU = 48 * 16;
    for (int i = 0; i * F.G < NU; ++i) {
        const int L = (i & 1) ? (i + 1) * F.G - 1 - F.blk : i * F.G + F.blk;
        if (L >= NU) continue;
        const int qb = 15 - L / 48, bh = L % 48;
#if defined(ATT_HYB) && (ATT_HYB & 1)
        { att_old::Tensors To; To.proj = Ts.proj; To.ymix = Ts.ymix; To.ong = Ts.ong; To.fcum = Ts.fcum; To.vt = Ts.vt; To.colq = Ts.colq; To.colk = Ts.colk; To.coly = Ts.coly; att_old::unit<0>(To, bh / 6, bh % 6, qb, F.lds, F.wave); }
#else
        att::unit<0>(Ts, bh / 6, bh % 6, qb, F.lds, F.wave);
#endif
    }
    for (int i = 0; i * F.G < NU; ++i) {
        const int L = (i & 1) ? (i + 1) * F.G - 1 - F.blk : i * F.G + F.blk;
        if (L >= NU) continue;
        const int qb = 15 - L / 48, bh = L % 48;
#if defined(ATT_HYB) && (ATT_HYB & 2)
        { att_old::Tensors To; To.proj = Tf.proj; To.ymix = Tf.ymix; To.ong = Tf.ong; To.fcum = Tf.fcum; To.vt = Tf.vt; To.colq = Tf.colq; To.colk = Tf.colk; To.coly = Tf.coly; att_old::unit<1>(To, bh / 6, bh % 6, qb, F.lds, F.wave); }
#else
        att::unit<1>(Tf, bh / 6, bh % 6, qb, F.lds, F.wave);
#endif
    }
}

__device__ __forceinline__ void top4of8(const float (&v)[8], const int (&ix)[8], float (&tv)[4], int (&ti)[4]) {
    float w[8];
#pragma unroll
    for (int j = 0; j < 8; ++j) w[j] = v[j];
#pragma unroll
    for (int k = 0; k < 4; ++k) { float bv = w[0]; int bi = ix[0];
#pragma unroll
        for (int j = 1; j < 8; ++j) { const bool t = (w[j] > bv) || (w[j] == bv && ix[j] < bi); bv = t ? w[j] : bv; bi = t ? ix[j] : bi; }
        tv[k] = bv; ti[k] = bi;
#pragma unroll
        for (int j = 0; j < 8; ++j) w[j] = (ix[j] == bi) ? -INFINITY : w[j]; }
}
__device__ __forceinline__ void p6_norm_router(Frame& F, int l, const bf16* x1) {
    bf16* H = (bf16*)(F.ws + WS_H); unsigned char* H8 = F.ws + WS_H8; float* topw = (float*)(F.ws + WS_TOPW); int* route = (int*)(F.ws + WS_ROUTE); int* hist = (int*)(F.ws + WS_HIST);
    const float* rw = F.in[I_RW] + (size_t)l * DM * NEXP; const float* rb = F.in[I_RB] + (size_t)l * NEXP;
#ifdef P6SEG
    unsigned long long sg_acc = 0ull, sg_t = __builtin_readcyclecounter();
#define SEG(n) do { const unsigned long long t_ = __builtin_readcyclecounter(); if ((n) == P6SEG) sg_acc += t_ - sg_t; sg_t = t_; asm volatile("" :: "s"(t_)); } while (0)
#else
#define SEG(n) do {} while (0)
#endif
    constexpr int RWP = 2064;
    LAS unsigned char* rwt = F.lds;
    LAS int* cnt = (LAS int*)(F.lds + MISC_OFF + 256);
    {
        f32x4 t[16];
#pragma unroll
        for (int i = 0; i < 16; ++i) t[i] = *(const f32x4*)(rw + (size_t)(2 * F.tid) * NEXP + 4 * i);
#pragma unroll
        for (int i = 0; i < 8; ++i)
#pragma unroll
            for (int c = 0; c < 4; ++c) *(LAS unsigned*)(rwt + (4 * i + c) * RWP + 4 * F.tid) = f2bf(t[i][c]) | (f2bf(t[8 + i][c]) << 16);
    }
    __syncthreads();
    SEG(0);
    const int fr = F.lane & 15, fq = F.lane >> 4;
    float rbv[8]; int eix[8];
#pragma unroll
    for (int i = 0; i < 4; ++i) { eix[i] = 4 * fq + i; eix[4 + i] = 16 + 4 * fq + i; rbv[i] = rb[4 * fq + i]; rbv[4 + i] = rb[16 + 4 * fq + i]; }
    for (int chunk = F.blk; chunk < NTOK / 128; chunk += F.G) {
        const int b = chunk / (SEQ / 128);
        if (F.tid < 32) cnt[F.tid] = 0;
        __syncthreads();
        f32x4 A[4], Bv[4];
#pragma unroll
        for (int j = 0; j < 4; ++j) { const int c = 256 * j + 4 * F.lane; const f32x4 g = *(const f32x4*)(F.in[I_N2G] + (size_t)l * DM + c); A[j] = g * (mod4(F, l, b, 4, c) + 1.0f); Bv[j] = mod4(F, l, b, 3, c); }
        const int row0 = chunk * 128 + F.wave * 16;
        SEG(1);
#pragma unroll 1
        for (int rr = 0; rr < 16; rr += 4) {
            f32x4 v[4][4]; float ss[4];
#pragma unroll
            for (int u = 0; u < 4; ++u)
#pragma unroll
                for (int j = 0; j < 4; ++j) v[u][j] = ld_row4<true>(x1, (size_t)(row0 + rr + u) * DM + 256 * j + 4 * F.lane);
#pragma unroll
            for (int u = 0; u < 4; ++u) { float s = 0.f;
#pragma unroll
                for (int j = 0; j < 4; ++j) s += (v[u][j].x * v[u][j].x + v[u][j].y * v[u][j].y) + (v[u][j].z * v[u][j].z + v[u][j].w * v[u][j].w);
                ss[u] = s; }
#pragma unroll
            for (int o = 1; o < 32; o <<= 1) { ss[0] += shx(ss[0], o, F.lane); ss[1] += shx(ss[1], o, F.lane); ss[2] += shx(ss[2], o, F.lane); ss[3] += shx(ss[3], o, F.lane); }
            ss[0] = add_other_half(ss[0]); ss[1] = add_other_half(ss[1]); ss[2] = add_other_half(ss[2]); ss[3] = add_other_half(ss[3]);
#pragma unroll
            for (int u = 0; u < 4; ++u) { const float rstd = 1.0f / sqrtf(ss[u] * (1.0f / DM) + EPS);
#pragma unroll
                for (int j = 0; j < 4; ++j) { const f32x4 hv = v[u][j] * rstd * A[j] + Bv[j];
                    v2u o; o.x = pk2(hv.x, hv.y); o.y = pk2(hv.z, hv.w); *(v2u*)(H + (size_t)(row0 + rr + u) * DM + 256 * j + 4 * F.lane) = o;
                    *(unsigned*)(H8 + (size_t)(row0 + rr + u) * DM + 256 * j + 4 * F.lane) = pg8::pk4_fp8(hv.x, hv.y, hv.z, hv.w); } }
        }
        SEG(2);
        asm volatile("s_waitcnt vmcnt(0)" ::: "memory");
        f32x4 acc0 = (f32x4){0.f, 0.f, 0.f, 0.f}, acc1 = (f32x4){0.f, 0.f, 0.f, 0.f};
        { const bf16* hp = H + (size_t)(row0 + fr) * DM + 8 * fq; const LAS unsigned char* wp = rwt + fr * RWP + 16 * fq;
#pragma unroll 8
          for (int s = 0; s < 32; ++s) { const v4u hb = __builtin_nontemporal_load((const v4u*)(hp + 32 * s));
              const bf16x8 a0 = *(const LAS bf16x8*)(wp + 64 * s), a1 = *(const LAS bf16x8*)(wp + 16 * RWP + 64 * s);
              acc0 = __builtin_amdgcn_mfma_f32_16x16x32_bf16(a0, __builtin_bit_cast(bf16x8, hb), acc0, 0, 0, 0);
              acc1 = __builtin_amdgcn_mfma_f32_16x16x32_bf16(a1, __builtin_bit_cast(bf16x8, hb), acc1, 0, 0, 0); } }
        SEG(3);
        float cv[8], tv[4], ov[8]; int ti[4], oi[8];
#pragma unroll
        for (int i = 0; i < 4; ++i) { cv[i] = acc0[i] + rbv[i]; cv[4 + i] = acc1[i] + rbv[4 + i]; }
        top4of8(cv, eix, tv, ti);
        {
#pragma unroll
            for (int k = 0; k < 4; ++k) { ov[k] = tv[k]; oi[k] = ti[k]; ov[4 + k] = shx(tv[k], 16, F.lane); oi[4 + k] = shxi(ti[k], 16, F.lane); }
            top4of8(ov, oi, tv, ti);
#pragma unroll
            for (int k = 0; k < 4; ++k) { auto rv = __builtin_amdgcn_permlane32_swap(__float_as_uint(tv[k]), __float_as_uint(tv[k]), false, false); auto ri = __builtin_amdgcn_permlane32_swap((unsigned)ti[k], (unsigned)ti[k], false, false);
                ov[k] = __uint_as_float(rv[0]); oi[k] = (int)ri[0]; ov[4 + k] = __uint_as_float(rv[1]); oi[4 + k] = (int)ri[1]; }
            top4of8(ov, oi, tv, ti); }
        const float e1 = __expf(tv[1] - tv[0]), e2 = __expf(tv[2] - tv[0]), e3 = __expf(tv[3] - tv[0]); const float inv = 1.0f / (1.0f + e1 + e2 + e3);
        { const int row = row0 + fr, k = fq;
          const float w = (k == 0 ? 1.0f : k == 1 ? e1 : k == 2 ? e2 : e3) * inv; const int ex = (k == 0 ? ti[0] : k == 1 ? ti[1] : k == 2 ? ti[2] : ti[3]);
          const int pos = __hip_atomic_fetch_add(cnt + ex, 1, __ATOMIC_RELAXED, __HIP_MEMORY_SCOPE_WORKGROUP);
          topw[row * 4 + k] = w; route[row * 4 + k] = ex + 32 * pos; }
        SEG(4);
        __syncthreads();
        if (F.tid < 32) hist[chunk * 32 + F.tid] = cnt[F.tid];
        __syncthreads();
        SEG(5);
    }
#ifdef P6SEG
    if (F.blk == 0 && F.tid == 0) atomicAdd((unsigned long long*)(F.ws + WS_CTL + 512), sg_acc);
#endif
}

__device__ __forceinline__ void p7_scatter(Frame& F) {
    const int* hist = (const int*)(F.ws + WS_HIST); const int* route = (const int*)(F.ws + WS_ROUTE);
    int* tokslot = (int*)(F.ws + WS_TOKSLOT); int* slottok = (int*)(F.ws + WS_SLOTTOK); int* moetab = (int*)(F.ws + WS_MOETAB);
    LAS int* pre = (LAS int*)F.lds;
    LAS int* base = (LAS int*)(F.lds + 32768);
    for (int i = F.tid; i < 256 * 32; i += 512) pre[i] = hist[i];
    __syncthreads();
    if (F.tid < 32) { int run = 0;
        for (int c = 0; c < 256; ++c) { const int v = pre[c * 32 + F.tid]; pre[c * 32 + F.tid] = run; run += v; }
        base[64 + F.tid] = run; }
    __syncthreads();
    if (F.tid == 0) { int run = 0; for (int ex = 0; ex < NEXP; ++ex) { base[ex] = run; run += (base[64 + ex] + 255) & ~255; } base[NEXP] = run; }
    __syncthreads();
    if (F.blk == 0 && F.tid <= NEXP) moetab[F.tid] = base[F.tid] >> 8;
    for (int chunk = F.blk; chunk < NTOK / 128; chunk += F.G) {
        const int t = chunk * 128 + (F.tid >> 2), k = F.tid & 3; const int rt = route[t * 4 + k]; const int ex = rt & 31, pos = rt >> 5;
        const int slot = base[ex] + pre[chunk * 32 + ex] + pos;
        tokslot[t * 4 + k] = slot; slottok[slot] = t;
    }
    for (int ex = F.blk; ex < NEXP; ex += F.G) { const int lo = base[ex] + base[64 + ex], hi = base[ex + 1]; for (int s = lo + F.tid; s < hi; s += 512) slottok[s] = 0; }
    __syncthreads();
}

struct Args { const float* in[21]; float* out; unsigned char* ws; int ph_lo, ph_hi; };
__device__ __forceinline__ void launder(Frame& F, int wave) {
#if 1
    int t = threadIdx.x; asm volatile("" : "+v"(t)); F.tid = t; F.lane = t & 63; F.wave = __builtin_amdgcn_readfirstlane(t >> 6); (void)wave;
#else
    int t = lane_id(); asm volatile("" : "+v"(t)); F.lane = t; F.wave = wave; F.tid = wave * 64 + t;
#endif
    const __attribute__((address_space(4))) Args* ap = (const __attribute__((address_space(4))) Args*)__builtin_amdgcn_kernarg_segment_ptr(); asm volatile("" : "+s"(ap));
#pragma unroll
    for (int i = 0; i < 21; ++i) F.in[i] = ap->in[i];
    F.out = ap->out; F.ws = ap->ws; }
constexpr int N_PHASES = 1 + 9 * NLAYER + 1;

#define PHASE_FN __device__ __forceinline__
__device__ __forceinline__ void make_frame(Frame& F, LAS unsigned char* lds, int wave) { F.lds = lds; int bk = blockIdx.x, gd = gridDim.x; asm volatile("" : "+s"(bk), "+s"(gd)); F.blk = bk; F.G = gd; launder(F, wave); }
PHASE_FN void ph_prologue(LAS unsigned char* lds, int wave) { Frame F; make_frame(F, lds, wave); p0_prologue(F); }
PHASE_FN void ph_norm1(LAS unsigned char* lds, int wave, int l) { Frame F; make_frame(F, lds, wave);
    if (l == 0) row_phase<false, true, false, false>(F, 0, F.in[I_X], nullptr); else row_phase<true, true, true, true>(F, l, F.ws + WS_XA, F.ws + WS_XB); }
PHASE_FN void ph_proj(LAS unsigned char* lds, int wave, int l) { Frame F; make_frame(F, lds, wave);
    pg8::Gemm g{(const bf16*)(F.ws + WS_H), (const bf16*)(F.ws + WS_WIN + (size_t)l * NPROJ * DM * (P2_FP8 ? 1 : 2)), nullptr, P2_FP8 ? DM / 2 : DM};
    pg8::StaticOrder S; S.init(NTOK, NPROJ, F.G, F.blk);
    pg8::EpiProj E{(bf16*)(F.ws + WS_PROJ), NPROJ};
    pg8::gemm_phase<pg8::EpiProj, pg8::StaticOrder, false, P2_FP8 != 0>(F.lds, g, S, E, F.wave); }
PHASE_FN void ph_postproj(LAS unsigned char* lds, int wave, int l) { Frame F; make_frame(F, lds, wave); p3_postproj(F, l); }
PHASE_FN void ph_attn(LAS unsigned char* lds, int wave, int l) { Frame F; make_frame(F, lds, wave); p4_attention(F, l); }
PHASE_FN void ph_out(LAS unsigned char* lds, int wave, int l) { Frame F; make_frame(F, lds, wave);
    pg8::Gemm g{(const bf16*)(F.ws + WS_YMIX), (const bf16*)(F.ws + WS_WOUT) + (size_t)l * DM * DM, nullptr, DM};
    pg8::StaticOrder S; S.init(NTOK, DM, F.G, F.blk);
    const float* gb = F.in[I_BADA] + (size_t)l * 6144 + 2 * DM; const float* gp = (const float*)(F.ws + WS_MODP) + (size_t)l * 4 * NB * 6144 + 2 * DM;
    if (l == 0) { pg8::EpiResGate<false> E{F.in[I_X], (bf16*)(F.ws + WS_XA), gb, gp}; pg8::gemm_phase<pg8::EpiResGate<false>, pg8::StaticOrder, false>(F.lds, g, S, E, F.wave); }
    else { pg8::EpiResGate<true> E{F.ws + WS_XB, (bf16*)(F.ws + WS_XA), gb, gp}; pg8::gemm_phase<pg8::EpiResGate<true>, pg8::StaticOrder, false>(F.lds, g, S, E, F.wave); } }
PHASE_FN void ph_router(LAS unsigned char* lds, int wave, int l) { Frame F; make_frame(F, lds, wave); p6_norm_router(F, l, (const bf16*)(F.ws + WS_XA)); }
PHASE_FN void ph_scatter(LAS unsigned char* lds, int wave) { Frame F; make_frame(F, lds, wave); p7_scatter(F); }
__device__ __forceinline__ LAS int* moe_table(Frame& F) { LAS int* tb = (LAS int*)(F.lds + MISC_OFF + 64);
    if (F.tid <= NEXP) tb[F.tid] = ((const int*)(F.ws + WS_MOETAB))[F.tid];
    __syncthreads(); return tb; }
PHASE_FN void ph_moe_up(LAS unsigned char* lds, int wave, int l) { Frame F; make_frame(F, lds, wave); LAS int* tb = moe_table(F);
    pg8::Gemm g{(const bf16*)(F.ws + WS_H8), (const bf16*)(F.ws + WS_W1 + (size_t)l * NEXP * 2048 * DM), (const int*)(F.ws + WS_SLOTTOK), DM / 2};
    pg8::MoeOrder S; S.init(tb, 8, F.G, F.blk);
    pg8::EpiSwiglu8 E{F.ws + WS_ACT, F.in[I_B1] + (size_t)l * NEXP * 2048};
    pg8::gemm_phase<pg8::EpiSwiglu8, pg8::MoeOrder, true, true>(F.lds, g, S, E, F.wave); }
struct EpiNull { static constexpr bool PERM = true; __device__ __forceinline__ void operator()(const f32x4 (&acc)[2][2][4][2], const pg8::Unit& u, int wr, int wc, int fr, int fq) const { float s = 0.f;
#pragma unroll
    for (int a = 0; a < 2; ++a)
#pragma unroll
        for (int b = 0; b < 2; ++b)
#pragma unroll
            for (int m = 0; m < 4; ++m)
#pragma unroll
                for (int n = 0; n < 2; ++n) s += acc[a][b][m][n][0] + acc[a][b][m][n][1] + acc[a][b][m][n][2] + acc[a][b][m][n][3];
    asm volatile("" :: "v"(s)); } };
PHASE_FN void ph_moe_down_nostore(LAS unsigned char* lds, int wave, int l) { Frame F; make_frame(F, lds, wave); LAS int* tb = moe_table(F);
    pg8::Gemm g{(const bf16*)(F.ws + WS_ACT), (const bf16*)(F.ws + WS_W2 + (size_t)l * NEXP * DM * DM), nullptr, DM / 2};
    pg8::MoeOrder S; S.init(tb, 4, F.G, F.blk);
#if EXP_NOSTORE == 2
    pg8::EpiY E{F.ws + WS_PROJ, nullptr};
    pg8::gemm_phase<pg8::EpiY, pg8::MoeOrder, false, true>(F.lds, g, S, E, F.wave); }
#else
    EpiNull E;
    pg8::gemm_phase<EpiNull, pg8::MoeOrder, false, true>(F.lds, g, S, E, F.wave); }
#endif
PHASE_FN void ph_moe_down(LAS unsigned char* lds, int wave, int l) { Frame F; make_frame(F, lds, wave); LAS int* tb = moe_table(F);
    pg8::Gemm g{(const bf16*)(F.ws + WS_ACT), (const bf16*)(F.ws + WS_W2 + (size_t)l * NEXP * DM * DM), nullptr, DM / 2, (void*)(F.ws + WS_CTL + 512)};
    pg8::MoeOrder S; S.init(tb, 4, F.G, F.blk);
    pg8::EpiY E{F.ws + WS_Y, F.in[I_B2] + (size_t)l * NEXP * DM};
    pg8::gemm_phase<pg8::EpiY, pg8::MoeOrder, false, true>(F.lds, g, S, E, F.wave); }
PHASE_FN void ph_final(LAS unsigned char* lds, int wave) { Frame F; make_frame(F, lds, wave); row_phase<true, false, true, false>(F, NLAYER, F.ws + WS_XA, F.out); }

#ifndef REP_MASK
#define REP_MASK 0
#endif
#ifndef MK_SPLIT
#define MK_SPLIT 0
#endif
#if !MK_SPLIT
__global__ void __launch_bounds__(512, 2) fwd_kernel(Args args) {
    extern __shared__ __attribute__((aligned(16))) unsigned char lds_raw[];
    LAS unsigned char* lds = (LAS unsigned char*)lds_raw;
    volatile LAS unsigned* MISC = (volatile LAS unsigned*)(lds + MISC_OFF);
    if (threadIdx.x < 16) MISC[threadIdx.x] = 0u;
    const int wave = __builtin_amdgcn_readfirstlane(threadIdx.x >> 6);
    __syncthreads();
    const XcdBarrier bar = xcd_barrier_post((unsigned*)(args.ws + WS_CTL) + CW_BAR, MISC, wave);
#define IN(k) true
#define SEAM(k) xcd_barrier(bar)
#define REPS(j) for (int rep_ = 0; rep_ < (((REP_MASK >> (j)) & 1) ? 2 : 1); ++rep_)
#ifdef PT_SEL
    unsigned long long pt_acc = 0ull, pt_t0 = 0ull;
#define PT_BEGIN(j) do { if ((j) == PT_SEL) pt_t0 = __builtin_amdgcn_s_memrealtime(); } while (0)
#define PT_END(j) do { if ((j) == PT_SEL) { const unsigned long long t1_ = __builtin_amdgcn_s_memrealtime(); pt_acc += t1_ - pt_t0; } } while (0)
#else
#define PT_BEGIN(j) do {} while (0)
#define PT_END(j) do {} while (0)
#endif
    if (IN(0)) { REPS(0) { PT_BEGIN(0); ph_prologue(lds, wave); SEAM(0); PT_END(0); } }
    for (int l = 0; l < NLAYER; ++l) {
        const int p = 1 + 9 * l;
        if (IN(p + 0)) { REPS(1) { PT_BEGIN(1); ph_norm1(lds, wave, l); SEAM(p + 0); PT_END(1); } }
        if (IN(p + 1)) { REPS(2) { PT_BEGIN(2); ph_proj(lds, wave, l); SEAM(p + 1); PT_END(2); } }
        if (IN(p + 2)) { PT_BEGIN(3); ph_postproj(lds, wave, l); SEAM(p + 2); PT_END(3); }
        if (IN(p + 3)) { REPS(4) { PT_BEGIN(4); ph_attn(lds, wave, l); SEAM(p + 3); PT_END(4); } }
        if (IN(p + 4)) { REPS(5) { PT_BEGIN(5); ph_out(lds, wave, l); SEAM(p + 4); PT_END(5); } }
        if (IN(p + 5)) { REPS(6) { PT_BEGIN(6); ph_router(lds, wave, l); SEAM(p + 5); PT_END(6); } }
        if (IN(p + 6)) { REPS(7) { PT_BEGIN(7); ph_scatter(lds, wave); SEAM(p + 6); PT_END(7); } }
        if (IN(p + 7)) { REPS(8) { PT_BEGIN(8); ph_moe_up(lds, wave, l); SEAM(p + 7); PT_END(8); } }
        if (IN(p + 8)) { REPS(9) { PT_BEGIN(9); ph_moe_down(lds, wave, l); SEAM(p + 8); PT_END(9); } }
    }
    if (IN(N_PHASES - 1)) { REPS(10) { PT_BEGIN(10); ph_final(lds, wave); PT_END(10); } }
#ifdef PT_SEL
    if (blockIdx.x == 0 && wave == 0 && lane_id() == 0) { const unsigned long long t0_ = __builtin_amdgcn_s_memrealtime(); while (__builtin_amdgcn_s_memrealtime() - t0_ < pt_acc * PT_K) __builtin_amdgcn_s_sleep(8); }
#endif
#ifdef P6SEG
    if (blockIdx.x == 0 && wave == 0 && lane_id() == 0) { __builtin_amdgcn_s_waitcnt(0);
        const unsigned long long acc = __hip_atomic_load((unsigned long long*)(args.ws + WS_CTL + 512), __ATOMIC_RELAXED, __HIP_MEMORY_SCOPE_AGENT) * 4ull;
        const unsigned long long t0 = __builtin_readcyclecounter(); while (__builtin_readcyclecounter() - t0 < acc) __builtin_amdgcn_s_sleep(4); }
#endif
#ifdef TPG
    if (blockIdx.x == 3 && wave == 0 && lane_id() == 0) { __builtin_amdgcn_s_waitcnt(0);
        const unsigned long long acc = __hip_atomic_load((unsigned long long*)(args.ws + WS_CTL + 512), __ATOMIC_RELAXED, __HIP_MEMORY_SCOPE_AGENT) * ((TPG == 1) ? 1ull : 100000ull);
        const unsigned long long t0 = __builtin_readcyclecounter(); while (__builtin_readcyclecounter() - t0 < acc) __builtin_amdgcn_s_sleep(4); }
#endif
#ifdef TPROBE
    if (blockIdx.x == TPROBE_BLK && wave == 0 && lane_id() == 0) {
        __builtin_amdgcn_s_waitcnt(0);
        const unsigned long long acc = __hip_atomic_load((unsigned long long*)(args.ws + WS_CTL + 512), __ATOMIC_RELAXED, __HIP_MEMORY_SCOPE_AGENT) * TPROBE_K;
        const unsigned long long t0 = __builtin_readcyclecounter();
        while (__builtin_readcyclecounter() - t0 < acc) __builtin_amdgcn_s_sleep(4);
    }
#endif
#if defined(UBENCH) && UBENCH >= 4
    {
        f32x4 c[16]; v8i a8, b8; bf16x8 a4, b4;
#pragma unroll
        for (int i = 0; i < 16; ++i) c[i] = (f32x4){0.f, 0.f, 0.f, 0.f};
#pragma unroll
        for (int i = 0; i < 8; ++i) { a8[i] = 0x38383838; b8[i] = 0x38383838; a4[i] = 0x3c00; b4[i] = 0x3c00; }
        const int sw = 0x7F7F7F7F;
        for (int it = 0; it < UBENCH_ITERS; ++it) {
#pragma unroll
            for (int i = 0; i < 16; ++i) {
#if UBENCH == 4
                asm volatile("v_mfma_scale_f32_16x16x128_f8f6f4 %0, %1, %2, %0, %3, %4 op_sel_hi:[0,0,0]" : "+v"(c[i]) : "v"(a8), "v"(b8), "v"(sw), "v"(sw));
#else
                c[i] = __builtin_amdgcn_mfma_f32_16x16x32_bf16(a4, b4, c[i], 0, 0, 0);
#endif
            }
        }
        float s = 0.f;
#pragma unroll
        for (int i = 0; i < 16; ++i) s += c[i][0];
        if (s == 123.456f) ((float*)(args.ws + WS_GSUM + 14000))[0] = s;
    }
#elif defined(UBENCH)
    {
        float v[32];
#pragma unroll
        for (int i = 0; i < 32; ++i) v[i] = (float)(lane_id() + i) * 1e-3f;
        for (int it = 0; it < UBENCH_ITERS; ++it) {
#pragma unroll
            for (int i = 0; i < 32; ++i) {
#if UBENCH == 1
                v[i] = __builtin_amdgcn_exp2f(v[i]);
#elif UBENCH == 2
                v[i] = v[i] * 1.0001f + 0.5f;
#elif UBENCH == 3
                v[i] = __builtin_amdgcn_logf(v[i]);
#endif
            }
            asm volatile("" ::: "memory");
        }
        float s = 0.f;
#pragma unroll
        for (int i = 0; i < 32; ++i) s += v[i];
        if (s == 123.456f) ((float*)(args.ws + WS_GSUM + 14000))[0] = s;
    }
#endif
#undef IN
#undef SEAM
#undef REPS
}

#endif
template <int KIND> __global__ void __launch_bounds__(512, 2) phase_kernel(Args args, int l) {
    extern __shared__ __attribute__((aligned(16))) unsigned char lds_raw[];
    LAS unsigned char* lds = (LAS unsigned char*)lds_raw; const int wave = __builtin_amdgcn_readfirstlane(threadIdx.x >> 6);
    if (KIND == 0) ph_prologue(lds, wave); if (KIND == 1) ph_norm1(lds, wave, l); if (KIND == 2) ph_proj(lds, wave, l); if (KIND == 3) ph_postproj(lds, wave, l); if (KIND == 4) ph_attn(lds, wave, l);
    if (KIND == 5) ph_out(lds, wave, l); if (KIND == 6) ph_router(lds, wave, l); if (KIND == 7) ph_scatter(lds, wave); if (KIND == 8) ph_moe_up(lds, wave, l); if (KIND == 9) ph_moe_down(lds, wave, l); if (KIND == 10) ph_final(lds, wave);
#ifdef EXP_NOSTORE
    if (KIND == 11) ph_moe_down_nostore(lds, wave, l);
#endif
}
template <int KIND> static void launch_phase(const Args& a, int l, int grid, hipStream_t stream) {
    static bool attr = false;
    if (!attr) { (void)hipFuncSetAttribute((const void*)phase_kernel<KIND>, hipFuncAttributeMaxDynamicSharedMemorySize, LDS_BYTES); attr = true; }
    for (int rep = 0; rep < (((REP_MASK >> KIND) & 1) ? 2 : 1); ++rep) hipLaunchKernelGGL(phase_kernel<KIND>, dim3(grid), dim3(512), LDS_BYTES, stream, a, l);
}

extern "C" void kernel_launch(void* const* d_in, const int* in_sizes, int n_in, void* d_out, int out_size, void* d_ws, size_t ws_size, hipStream_t stream) {
    static int grid = 0;
    if (grid == 0) {
        if (n_in != 21 || in_sizes[0] != NTOK * DM || out_size != NTOK * DM || ws_size < WS_END) {
            fprintf(stderr, "kernel_launch: unexpected shapes: n_in %d in0 %d out %d ws %zu (need %zu)\n", n_in, n_in > 0 ? in_sizes[0] : -1, out_size, ws_size, (size_t)WS_END); grid = -1; return; }
        int dev = 0, cus = 0, per_cu = 0;
        if (hipGetDevice(&dev) != hipSuccess || hipDeviceGetAttribute(&cus, hipDeviceAttributeMultiprocessorCount, dev) != hipSuccess) { fprintf(stderr, "kernel_launch: device query failed\n"); grid = -1; return; }
#if !MK_SPLIT
        if (hipFuncSetAttribute((const void*)fwd_kernel, hipFuncAttributeMaxDynamicSharedMemorySize, LDS_BYTES) != hipSuccess) { fprintf(stderr, "kernel_launch: hipFuncSetAttribute failed\n"); grid = -1; return; }
        if (hipOccupancyMaxActiveBlocksPerMultiprocessor(&per_cu, (const void*)fwd_kernel, 512, LDS_BYTES) != hipSuccess || per_cu < 1) fprintf(stderr, "kernel_launch: note: occupancy query says %d\n", per_cu);
        (void)hipGetLastError();
#endif
        grid = cus;
    }
    if (grid < 0) return;
    (void)hipMemsetAsync((char*)d_ws + WS_CTL, 0, CTL_ZERO_BYTES, stream);
    Args a{};
    for (int i = 0; i < 21; ++i) a.in[i] = (const float*)d_in[i];
    a.out = (float*)d_out; a.ws = (unsigned char*)d_ws;
#if MK_SPLIT
    a.ph_lo = 0; a.ph_hi = 0;
    launch_phase<0>(a, 0, grid, stream);
    for (int l = 0; l < NLAYER; ++l) { launch_phase<1>(a, l, grid, stream); launch_phase<2>(a, l, grid, stream); launch_phase<3>(a, l, grid, stream); launch_phase<4>(a, l, grid, stream); launch_phase<5>(a, l, grid, stream);
        launch_phase<6>(a, l, grid, stream); launch_phase<7>(a, l, grid, stream); launch_phase<8>(a, l, grid, stream);
#ifdef EXP_NOSTORE
        launch_phase<11>(a, l, grid, stream);
#endif
        launch_phase<9>(a, l, grid, stream); }
    launch_phase<10>(a, 0, grid, stream);
#else
    a.ph_lo = 0; a.ph_hi = N_PHASES; hipLaunchKernelGGL(fwd_kernel, dim3(grid), dim3(512), LDS_BYTES, stream, a);
#endif
}
```

```cpp
#include <hip/hip_runtime.h>
#include <cstdio>
#include <cstdint>

#define GAS __attribute__((address_space(1)))
#define LAS __attribute__((address_space(3)))
typedef unsigned short bf16;
typedef unsigned v4u __attribute__((ext_vector_type(4)));
typedef unsigned v2u __attribute__((ext_vector_type(2)));
typedef float f32x4 __attribute__((ext_vector_type(4)));
typedef float f32x2 __attribute__((ext_vector_type(2)));
typedef float f32x16 __attribute__((ext_vector_type(16)));
typedef short bf16x8 __attribute__((ext_vector_type(8)));
typedef _Float16 f16x8 __attribute__((ext_vector_type(8)));
typedef _Float16 f16x2 __attribute__((ext_vector_type(2)));
typedef int v4i __attribute__((ext_vector_type(4)));
typedef int v8i __attribute__((ext_vector_type(8)));

namespace pg8 {
constexpr int BM = 256, BK = 64, HALF = 128, HTB = HALF * BK * 2  , STAGE_BYTES = 8 * HTB, NXCD = 8, WGM = 8;

__host__ __device__ __forceinline__ int lds_byte(int r, int c) { const int st = (r >> 4) * 2 + (c >> 5), rr = r & 15, cc = c & 31, ob = rr * 64 + cc * 2; return st * 1024 + (ob ^ (((ob >> 9) & 1) << 5)); }
__host__ __device__ __forceinline__ void stage_rc(int b, int& R, int& C) { const int st = b / 1024, sb = b % 1024, swz = sb ^ (((sb >> 9) & 1) << 5); R = (st >> 1) * 16 + swz / 64; C = (st & 1) * 32 + (swz % 64) / 2; }
__host__ __device__ __forceinline__ int perm32(int rho) { const int n = rho >> 4, i = rho & 15; return 8 * (i >> 2) + 4 * n + (i & 3); }

struct Unit { int pm, pn, pb; };
struct Gemm { const bf16* A; const bf16* Bt; const int* rowmap; int K; void* tprobe = nullptr; };

__device__ __forceinline__ unsigned cvt_pk_bf16(float lo, float hi) { unsigned r; asm volatile("v_cvt_pk_bf16_f32 %0, %1, %2" : "=v"(r) : "v"(lo), "v"(hi)); return r; }

template <class Epi, class Sched, bool GATHER, bool FP8 = false>
__device__ __forceinline__ void gemm_phase(LAS unsigned char* lds, const Gemm g, const Sched& S, const Epi& E, int wave) {
    int lane_ = (int)__builtin_amdgcn_mbcnt_hi(~0u, __builtin_amdgcn_mbcnt_lo(~0u, 0u)); asm volatile("" : "+v"(lane_));
    const int wid = wave, lane = lane_, tid = wid * 64 + lane, wr = wid >> 2, wc = wid & 3, fr = lane & 15, fq = lane >> 4;
    const int K = g.K, nt = K / BK;
    unsigned voffA[2], voffB[2]; int RA[2], CA[2];
#pragma unroll
    for (int i = 0; i < 2; ++i) { int R, C; stage_rc(tid * 16 + i * 8192, R, C); const int Rb = Epi::PERM ? ((R & ~31) + perm32(R & 31)) : R; RA[i] = R; CA[i] = C;
        voffA[i] = (unsigned)(R * K + C) * 2u; voffB[i] = (unsigned)(Rb * K + C) * 2u; }
    const size_t kstep = (size_t)(BK * 2);
    const size_t hstep = (size_t)HALF * K * 2;
    const size_t tstep = 2 * hstep;
    const unsigned ldsw = (unsigned)wid * 1024u;
    const int aoff = lds_byte(wr * 64 + fr, fq * 8), boff = lds_byte(wc * 32 + fr, fq * 8);
#define PG8_SA(b, h) (((b) * 2 + (h)) * HTB)
#define PG8_SB(b, h) ((4 + (b) * 2 + (h)) * HTB)
#define PG8_STAGE(bufoff, gbase, voff) do { _Pragma("unroll") for (int _i = 0; _i < 2; ++_i) \
        __builtin_amdgcn_global_load_lds((const unsigned*)((const char*)(gbase) + (voff)[_i]), (LAS unsigned*)(lds + (bufoff) + ldsw + _i * 8192), 16, 0, 0); } while (0)
#define PG8_STAGEA(bufoff, pbase, h, nx) do { if constexpr (GATHER) { _Pragma("unroll") for (int _i = 0; _i < 2; ++_i) \
        __builtin_amdgcn_global_load_lds((const unsigned*)((const char*)(pbase) + ((nx) ? gn[h][_i] : gc[h][_i])), (LAS unsigned*)(lds + (bufoff) + ldsw + _i * 8192), 16, 0, 0); } \
        else { PG8_STAGE(bufoff, (const char*)(pbase) + (h) * hstep, voffA); } } while (0)
#define PG8_LDA(dst, b, h) do { if constexpr (FP8) { _Pragma("unroll") for (int m = 0; m < 4; ++m) dst##8[m] = __builtin_shufflevector(*(const LAS v4i*)(lds + PG8_SA(b, h) + aoff + m * 2048), *(const LAS v4i*)(lds + PG8_SA(b, h) + aoff + m * 2048 + 1024), 0, 1, 2, 3, 4, 5, 6, 7); } \
        else { _Pragma("unroll") for (int m = 0; m < 4; ++m) _Pragma("unroll") for (int k = 0; k < 2; ++k) dst[m][k] = *(const LAS bf16x8*)(lds + PG8_SA(b, h) + aoff + m * 2048 + k * 1024); } } while (0)
#define PG8_LDB(dst, b, h) do { if constexpr (FP8) { _Pragma("unroll") for (int n = 0; n < 2; ++n) dst##8[n] = __builtin_shufflevector(*(const LAS v4i*)(lds + PG8_SB(b, h) + boff + n * 2048), *(const LAS v4i*)(lds + PG8_SB(b, h) + boff + n * 2048 + 1024), 0, 1, 2, 3, 4, 5, 6, 7); } \
        else { _Pragma("unroll") for (int n = 0; n < 2; ++n) _Pragma("unroll") for (int k = 0; k < 2; ++k) dst[n][k] = *(const LAS bf16x8*)(lds + PG8_SB(b, h) + boff + n * 2048 + k * 1024); } } while (0)
#define PG8_MMA(ai, bj, At, Bt) do { __builtin_amdgcn_s_setprio(1); if constexpr (FP8) { _Pragma("unroll") for (int m = 0; m < 4; ++m) _Pragma("unroll") for (int n = 0; n < 2; ++n) \
        asm volatile("v_mfma_scale_f32_16x16x128_f8f6f4 %0, %1, %2, %0, %3, %4 op_sel_hi:[0,0,0]" : "+v"(acc[ai][bj][m][n]) : "v"(Bt##8[n]), "v"(At##8[m]), "v"(sclw), "v"(scla)); } \
        else { _Pragma("unroll") for (int m = 0; m < 4; ++m) _Pragma("unroll") for (int n = 0; n < 2; ++n) _Pragma("unroll") for (int k = 0; k < 2; ++k) \
        acc[ai][bj][m][n] = __builtin_amdgcn_mfma_f32_16x16x32_bf16(Bt[n][k], At[m][k], acc[ai][bj][m][n], 0, 0, 0); } __builtin_amdgcn_s_setprio(0); } while (0)
#define PG8_WAIT_V(n) asm volatile("s_waitcnt vmcnt(" #n ")" ::: "memory")
#define PG8_WAIT_L(n) asm volatile("s_waitcnt lgkmcnt(" #n ")" ::: "memory")
#define PG8_BAR __builtin_amdgcn_s_barrier()
#define PG8_SCHED __builtin_amdgcn_sched_barrier(0)
    Unit cur, nxt; int ui = 0;
    if (!S.next(0, cur)) return;
#ifdef GEMM_STAGGER
    {
        const unsigned long long t0 = __builtin_amdgcn_s_memrealtime(); const unsigned long long d = (unsigned long long)((blockIdx.x >> 3) & 3) * GEMM_STAGGER;
        while (__builtin_amdgcn_s_memrealtime() - t0 < d) __builtin_amdgcn_s_sleep(16);
    }
#endif
    f32x4 acc[2][2][4][2];
    E.init(acc, cur, wr, wc, fr, fq);
    bf16x8 At[4][2], B0[2][2], B1[2][2]; v8i At8[4], B08[2], B18[2];
    const int sclw = 0x7A7A7A7A, scla = 0x7F7F7F7F;
    unsigned gc[2][2], gn[2][2];
    if constexpr (GATHER) {
#pragma unroll
        for (int h = 0; h < 2; ++h)
#pragma unroll
            for (int i = 0; i < 2; ++i) { gc[h][i] = (unsigned)(g.rowmap[cur.pm * BM + h * HALF + RA[i]] * K + CA[i]) * 2u; gn[h][i] = gc[h][i]; }
    } else { gc[0][0] = gc[0][1] = gc[1][0] = gc[1][1] = 0u; gn[0][0] = gn[0][1] = gn[1][0] = gn[1][1] = 0u; }
    const char* cA = GATHER ? (const char*)g.A : (const char*)g.A + (size_t)cur.pm * tstep; const char* cB = (const char*)g.Bt + (size_t)cur.pb * tstep;
    PG8_STAGE(PG8_SB(0, 0), cB, voffB); PG8_STAGE(PG8_SB(0, 1), cB + hstep, voffB); PG8_STAGEA(PG8_SA(0, 0), cA, 0, false); PG8_STAGEA(PG8_SA(0, 1), cA, 1, false);
    if (wr == 1) PG8_BAR;
    PG8_WAIT_V(2); PG8_BAR;
    PG8_STAGE(PG8_SB(1, 0), cB + kstep, voffB); PG8_STAGEA(PG8_SA(1, 0), cA + kstep, 0, false); PG8_STAGE(PG8_SB(1, 1), cB + hstep + kstep, voffB);
    PG8_WAIT_V(6); PG8_BAR;
    for (;;) {
        const bool has_next = S.next(ui + 1, nxt);
        if constexpr (GATHER) { if (has_next) {
#pragma unroll
            for (int h = 0; h < 2; ++h)
#pragma unroll
                for (int i = 0; i < 2; ++i) gn[h][i] = (unsigned)(g.rowmap[nxt.pm * BM + h * HALF + RA[i]] * K + CA[i]) * 2u; } }
        const char* nA = GATHER ? cA : (has_next ? (const char*)g.A + (size_t)nxt.pm * tstep : cA); const char* nB = has_next ? (const char*)g.Bt + (size_t)nxt.pb * tstep : cB;
#ifdef TPG
        const unsigned long long tg0 = __builtin_readcyclecounter();
#endif
        for (int t = 0; t < nt; t += 2) {
            const bool last = (t == nt - 2);
            const char* a1 = cA + (size_t)(t + 1) * kstep;
            const char* a2 = last ? nA : cA + (size_t)(t + 2) * kstep; const char* b2 = last ? nB : cB + (size_t)(t + 2) * kstep;
            const char* a3 = a2 + kstep; const char* b3 = b2 + kstep;
            PG8_LDB(B0, 0, 0); PG8_LDB(B1, 0, 1); PG8_SCHED; PG8_LDA(At, 0, 0); PG8_STAGEA(PG8_SA(1, 1), a1, 1, false);
            PG8_WAIT_V(8); PG8_WAIT_L(0); PG8_BAR; PG8_MMA(0, 0, At, B0); PG8_MMA(0, 1, At, B1); PG8_BAR; PG8_SCHED;
            PG8_LDA(At, 0, 1); PG8_STAGE(PG8_SB(0, 0), b2, voffB); PG8_STAGE(PG8_SB(0, 1), b2 + hstep, voffB); PG8_STAGEA(PG8_SA(0, 0), a2, 0, last);
            PG8_WAIT_V(8); PG8_WAIT_L(0); PG8_BAR; PG8_MMA(1, 0, At, B0); PG8_MMA(1, 1, At, B1); PG8_BAR; PG8_SCHED;
            PG8_LDB(B0, 1, 0); PG8_LDB(B1, 1, 1); PG8_SCHED; PG8_LDA(At, 1, 0); PG8_STAGEA(PG8_SA(0, 1), a2, 1, last);
            PG8_WAIT_V(8); PG8_WAIT_L(0); PG8_BAR; PG8_MMA(0, 0, At, B0); PG8_MMA(0, 1, At, B1); PG8_BAR; PG8_SCHED;
            PG8_LDA(At, 1, 1); PG8_STAGE(PG8_SB(1, 0), b3, voffB); PG8_STAGE(PG8_SB(1, 1), b3 + hstep, voffB); PG8_STAGEA(PG8_SA(1, 0), a3, 0, last);
            PG8_WAIT_V(8); PG8_WAIT_L(0); PG8_BAR; PG8_MMA(1, 0, At, B0); PG8_MMA(1, 1, At, B1); PG8_BAR; PG8_SCHED;
        }
#ifdef TPG
        { const unsigned long long tg1 = __builtin_readcyclecounter(); asm volatile("" :: "s"(tg0), "s"(tg1));
          if (FP8 && !GATHER && blockIdx.x == 3 && tid == 0) atomicAdd((unsigned long long*)g.tprobe, (TPG == 1) ? (tg1 - tg0) : 1ull); }
#endif
        if (wr == 0) PG8_BAR;
        if constexpr (FP8) asm volatile("s_nop 15\n\ts_nop 7" ::: "memory");
        E(acc, cur, wr, wc, fr, fq);
        if (!has_next) break;
        E.init(acc, nxt, wr, wc, fr, fq);
        cur = nxt; cA = nA; cB = nB; ++ui;
        if constexpr (GATHER) {
#pragma unroll
            for (int h = 0; h < 2; ++h)
#pragma unroll
                for (int i = 0; i < 2; ++i) gc[h][i] = gn[h][i]; }
        if (wr == 1) PG8_BAR;
    }
    PG8_WAIT_V(0);
    PG8_BAR;
#undef PG8_SA
#undef PG8_SB
#undef PG8_STAGE
#undef PG8_STAGEA
#undef PG8_LDA
#undef PG8_LDB
#undef PG8_MMA
#undef PG8_WAIT_V
#undef PG8_WAIT_L
#undef PG8_BAR
#undef PG8_SCHED
}
}
constexpr int DM = 1024, NB = 8, SEQ = 4096, NTOK = NB * SEQ, NLAYER = 2;
constexpr int NPROJ = 3072;
constexpr int D_IN = 3078;
constexpr int NEXP = 32, TOPK = 4;
constexpr int NSLOT_MAX = NTOK * TOPK + NEXP * 256;
constexpr int NTILE_MAX = NSLOT_MAX / 256;
constexpr int COL_CB = 0, COL_CC = 256, COL_CU = 512, COL_SQ = 768, COL_SK = 1152, COL_SV = 1536, COL_FQ = 1920, COL_FK = 2304, COL_FV = 2688;
constexpr float EPS = 1e-6f;
constexpr float LOG2E = 1.4426950408889634f;
constexpr float QSCALE = 0.125f * LOG2E;

namespace pg8 {
struct StaticOrder {
    int nM, nN, nwg, G, c;
    __device__ __forceinline__ void init(int M, int N, int G_, int c_) { nM = M / BM; nN = N / BM; nwg = nM * nN; G = G_; c = c_; }
    __device__ __forceinline__ bool next(int i, Unit& u) const {
        const long L = (long)i * G + c; if (L >= nwg) return false;
        int wgid = (int)L; { const int q = nwg / NXCD, r = nwg % NXCD, xcd = wgid % NXCD, off = wgid / NXCD; wgid = (xcd < r ? xcd * (q + 1) : r * (q + 1) + (xcd - r) * q) + off; }
        const int nig = WGM * nN, gid = wgid / nig, fm = gid * WGM, gsz = (nM - fm) < WGM ? (nM - fm) : WGM;
        u.pm = fm + ((wgid % nig) % gsz); u.pn = (wgid % nig) / gsz; u.pb = u.pn; return true;
    }
};
struct MoeOrder {
    int nM, nN, nwg, G, c; const LAS int* tb;
    __device__ __forceinline__ void init(const LAS int* tb_, int nN_, int G_, int c_) { tb = tb_; nM = tb_[NEXP]; nN = nN_; nwg = nM * nN; G = G_; c = c_; }
    __device__ __forceinline__ bool next(int i, Unit& u) const {
        const long L = (long)i * G + c; if (L >= nwg) return false;
        int wgid = (int)L; { const int q = nwg / NXCD, r = nwg % NXCD, xcd = wgid % NXCD, off = wgid / NXCD; wgid = (xcd < r ? xcd * (q + 1) : r * (q + 1) + (xcd - r) * q) + off; }
        const int nig = WGM * nN, gid = wgid / nig, fm = gid * WGM, gsz = (nM - fm) < WGM ? (nM - fm) : WGM;
        u.pm = fm + ((wgid % nig) % gsz); u.pn = (wgid % nig) / gsz;
        int e = 0;
#pragma unroll 1
        for (int j = 1; j < NEXP; ++j) e += (tb[j] <= u.pm) ? 1 : 0;
        u.pb = e * nN + u.pn; return true;
    }
};

struct EpiProj {
    static constexpr bool PERM = true;
    bf16* O; int ldc;
    __device__ __forceinline__ void init(f32x4 (&acc)[2][2][4][2], const Unit&, int, int, int, int) const {
#pragma unroll
        for (int a = 0; a < 2; ++a)
#pragma unroll
            for (int b = 0; b < 2; ++b)
#pragma unroll
                for (int m = 0; m < 4; ++m)
#pragma unroll
                    for (int n = 0; n < 2; ++n) acc[a][b][m][n] = (f32x4){0.f, 0.f, 0.f, 0.f}; }
    __device__ __forceinline__ void operator()(const f32x4 (&acc)[2][2][4][2], const Unit& u, int wr, int wc, int fr, int fq) const {
        const int row0 = u.pm * BM + wr * 64 + fr, col0 = u.pn * BM + wc * 32 + 8 * fq;
#pragma unroll
        for (int ai = 0; ai < 2; ++ai)
#pragma unroll
            for (int m = 0; m < 4; ++m) { bf16* rowp = O + (size_t)(row0 + ai * HALF + m * 16) * ldc + col0;
#pragma unroll
                for (int bj = 0; bj < 2; ++bj) { const f32x4 v0 = acc[ai][bj][m][0], v1 = acc[ai][bj][m][1];
                    v4u w; w.x = cvt_pk_bf16(v0[0], v0[1]); w.y = cvt_pk_bf16(v0[2], v0[3]); w.z = cvt_pk_bf16(v1[0], v1[1]); w.w = cvt_pk_bf16(v1[2], v1[3]);
                    *(v4u*)(rowp + bj * HALF) = w; } }
    }
};
template <bool BASE16> struct EpiResGate {
    static constexpr bool PERM = true;
    const void* base; bf16* out; const float* gbias; const float* gpart;
    __device__ __forceinline__ void init(f32x4 (&acc)[2][2][4][2], const Unit&, int, int, int, int) const {
#pragma unroll
        for (int a = 0; a < 2; ++a)
#pragma unroll
            for (int b = 0; b < 2; ++b)
#pragma unroll
                for (int m = 0; m < 4; ++m)
#pragma unroll
                    for (int n = 0; n < 2; ++n) acc[a][b][m][n] = (f32x4){0.f, 0.f, 0.f, 0.f}; }
    __device__ __forceinline__ void operator()(const f32x4 (&acc)[2][2][4][2], const Unit& u, int wr, int wc, int fr, int fq) const {
        const int row0 = u.pm * BM + wr * 64 + fr, col0 = u.pn * BM + wc * 32 + 8 * fq; const int b = (u.pm * BM) / SEQ;
#pragma unroll
        for (int bj = 0; bj < 2; ++bj) { const int c = col0 + bj * HALF; f32x4 g0 = *(const f32x4*)(gbias + c), g1 = *(const f32x4*)(gbias + c + 4);
#pragma unroll
            for (int ks = 0; ks < 4; ++ks) { g0 += *(const f32x4*)(gpart + (size_t)(ks * NB + b) * 6144 + c); g1 += *(const f32x4*)(gpart + (size_t)(ks * NB + b) * 6144 + c + 4); }
#pragma unroll
            for (int ai = 0; ai < 2; ++ai)
#pragma unroll
                for (int m = 0; m < 4; ++m) { const size_t off = (size_t)(row0 + ai * HALF + m * 16) * DM + c; f32x4 b0, b1;
                    if (BASE16) { const v4u t = *(const v4u*)((const bf16*)base + off); b0 = (f32x4){__builtin_bit_cast(float, t.x << 16), __builtin_bit_cast(float, t.x & 0xffff0000u), __builtin_bit_cast(float, t.y << 16), __builtin_bit_cast(float, t.y & 0xffff0000u)};
                        b1 = (f32x4){__builtin_bit_cast(float, t.z << 16), __builtin_bit_cast(float, t.z & 0xffff0000u), __builtin_bit_cast(float, t.w << 16), __builtin_bit_cast(float, t.w & 0xffff0000u)}; }
                    else { b0 = *(const f32x4*)((const float*)base + off); b1 = *(const f32x4*)((const float*)base + off + 4); }
                    const f32x4 v0 = b0 + g0 * acc[ai][bj][m][0], v1 = b1 + g1 * acc[ai][bj][m][1];
                    v4u w; w.x = cvt_pk_bf16(v0[0], v0[1]); w.y = cvt_pk_bf16(v0[2], v0[3]); w.z = cvt_pk_bf16(v1[0], v1[1]); w.w = cvt_pk_bf16(v1[2], v1[3]);
                    *(v4u*)(out + off) = w; } }
    }
};
struct EpiSwiglu {
    static constexpr bool PERM = true;
    bf16* O; const float* b1;
    __device__ __forceinline__ void init(f32x4 (&acc)[2][2][4][2], const Unit&, int, int, int, int) const {
#pragma unroll
        for (int a = 0; a < 2; ++a)
#pragma unroll
            for (int b = 0; b < 2; ++b)
#pragma unroll
                for (int m = 0; m < 4; ++m)
#pragma unroll
                    for (int n = 0; n < 2; ++n) acc[a][b][m][n] = (f32x4){0.f, 0.f, 0.f, 0.f}; }
    __device__ __forceinline__ void operator()(const f32x4 (&acc)[2][2][4][2], const Unit& u, int wr, int wc, int fr, int fq) const {
        const int row0 = u.pm * BM + wr * 64 + fr; const int e = u.pb >> 3; const int j0 = u.pn * 128 + wc * 32 + 8 * fq;
        const float* bp = b1 + (size_t)e * 2048 + 2 * j0;
        f32x4 bb[4];
#pragma unroll
        for (int q = 0; q < 4; ++q) bb[q] = *(const f32x4*)(bp + 4 * q);
        float bg[8], bl[8];
#pragma unroll
        for (int q = 0; q < 4; ++q) { bg[2 * q] = bb[q][0]; bl[2 * q] = bb[q][1]; bg[2 * q + 1] = bb[q][2]; bl[2 * q + 1] = bb[q][3]; }
#pragma unroll
        for (int ai = 0; ai < 2; ++ai)
#pragma unroll
            for (int m = 0; m < 4; ++m) { bf16* rowp = O + (size_t)(row0 + ai * HALF + m * 16) * DM + j0;
                float a[8];
#pragma unroll
                for (int n = 0; n < 2; ++n)
#pragma unroll
                    for (int i = 0; i < 4; ++i) { float gl = acc[ai][0][m][n][i] + bg[4 * n + i], li = acc[ai][1][m][n][i] + bl[4 * n + i];
                        gl = fminf(gl, 7.0f); li = fminf(fmaxf(li, -7.0f), 7.0f);
                        const float sg = __builtin_amdgcn_rcpf(1.0f + __builtin_amdgcn_exp2f(-1.702f * LOG2E * gl));
                        a[4 * n + i] = gl * sg * (li + 1.0f); }
                v4u w; w.x = cvt_pk_bf16(a[0], a[1]); w.y = cvt_pk_bf16(a[2], a[3]); w.z = cvt_pk_bf16(a[4], a[5]); w.w = cvt_pk_bf16(a[6], a[7]);
                *(v4u*)rowp = w; }
    }
};
__device__ __forceinline__ float clamp448(float v) { return __builtin_amdgcn_fmed3f(v, -448.0f, 448.0f); }
__device__ __forceinline__ unsigned pk4_fp8(float a, float b, float c, float d) { unsigned r = 0; r = __builtin_amdgcn_cvt_pk_fp8_f32(clamp448(a), clamp448(b), r, false); r = __builtin_amdgcn_cvt_pk_fp8_f32(clamp448(c), clamp448(d), r, true); return r; }
struct EpiSwiglu8 {
    static constexpr bool PERM = true;
    unsigned char* O; const float* b1;
    __device__ __forceinline__ void init(f32x4 (&acc)[2][2][4][2], const Unit& u, int, int wc, int, int fq) const {
        const int e = u.pb >> 3; const int j0 = u.pn * 128 + wc * 32 + 8 * fq; const float* bp = b1 + (size_t)e * 2048 + 2 * j0;
        f32x4 bb[4];
#pragma unroll
        for (int q = 0; q < 4; ++q) bb[q] = *(const f32x4*)(bp + 4 * q);
        const f32x4 g0 = (f32x4){bb[0][0], bb[0][2], bb[1][0], bb[1][2]}, g1 = (f32x4){bb[2][0], bb[2][2], bb[3][0], bb[3][2]};
        const f32x4 l0 = (f32x4){bb[0][1], bb[0][3], bb[1][1], bb[1][3]}, l1 = (f32x4){bb[2][1], bb[2][3], bb[3][1], bb[3][3]};
#pragma unroll
        for (int a = 0; a < 2; ++a)
#pragma unroll
            for (int m = 0; m < 4; ++m) { acc[a][0][m][0] = g0; acc[a][0][m][1] = g1; acc[a][1][m][0] = l0; acc[a][1][m][1] = l1; } }
    __device__ __forceinline__ void operator()(const f32x4 (&acc)[2][2][4][2], const Unit& u, int wr, int wc, int fr, int fq) const {
        const int row0 = u.pm * BM + wr * 64 + fr; const int j0 = u.pn * 128 + wc * 32 + 8 * fq;
#pragma unroll
        for (int ai = 0; ai < 2; ++ai)
#pragma unroll
            for (int m = 0; m < 4; ++m) { unsigned char* rowp = O + (size_t)(row0 + ai * HALF + m * 16) * DM + j0;
                float a[8];
#pragma unroll
                for (int n = 0; n < 2; ++n)
#pragma unroll
                    for (int i = 0; i < 4; ++i) { float gl = acc[ai][0][m][n][i], li = acc[ai][1][m][n][i];
                        gl = fminf(gl, 7.0f); li = fminf(fmaxf(li, -7.0f), 7.0f);
                        const float sg = __builtin_amdgcn_rcpf(1.0f + __builtin_amdgcn_exp2f(-1.702f * LOG2E * gl));
                        a[4 * n + i] = gl * sg * (li + 1.0f); }
                v2u w; w.x = pk4_fp8(a[0], a[1], a[2], a[3]); w.y = pk4_fp8(a[4], a[5], a[6], a[7]);
                *(v2u*)rowp = w; }
    }
};
struct EpiY {
    static constexpr bool PERM = true;
    unsigned char* O; const float* b2;
    __device__ __forceinline__ void init(f32x4 (&acc)[2][2][4][2], const Unit& u, int, int wc, int, int fq) const {
        const int e = u.pb >> 2; const int col0 = u.pn * BM + wc * 32 + 8 * fq;
#pragma unroll
        for (int bj = 0; bj < 2; ++bj)
#pragma unroll
            for (int n = 0; n < 2; ++n) { const f32x4 bv = b2 ? *(const f32x4*)(b2 + (size_t)e * DM + col0 + bj * HALF + 4 * n) : (f32x4){0.f, 0.f, 0.f, 0.f};
#pragma unroll
                for (int a = 0; a < 2; ++a)
#pragma unroll
                    for (int m = 0; m < 4; ++m) acc[a][bj][m][n] = bv; } }
    __device__ __forceinline__ void operator()(const f32x4 (&acc)[2][2][4][2], const Unit& u, int wr, int wc, int fr, int fq) const {
        const int row0 = u.pm * BM + wr * 64 + fr; const int col0 = u.pn * BM + wc * 32 + 8 * fq;
#pragma unroll
        for (int ai = 0; ai < 2; ++ai)
#pragma unroll
            for (int m = 0; m < 4; ++m) { unsigned char* rowp = O + (size_t)(row0 + ai * HALF + m * 16) * DM + col0;
#pragma unroll
                for (int bj = 0; bj < 2; ++bj) { const f32x4 v0 = acc[ai][bj][m][0], v1 = acc[ai][bj][m][1];
                    v2u w; w.x = pk4_fp8(v0[0], v0[1], v0[2], v0[3]); w.y = pk4_fp8(v1[0], v1[1], v1[2], v1[3]);
                    *(v2u*)(rowp + bj * HALF) = w; } }
    }
};
}
namespace att {
constexpr int KROW = 128;
constexpr int TILE_B = 64 * KROW;
constexpr int OFF_K = 0, OFF_V = 2 * TILE_B, OFF_F = 4 * TILE_B, OFF_Q = OFF_F + 512, OFF_FLAG = OFF_Q + 8 * 4608, LDS_BYTES = OFF_FLAG + 64;
__device__ __forceinline__ int pim(int m) { const int a = m >> 3, h = (m >> 2) & 1, b = m & 3; return 16 * (a >> 1) + 8 * h + 4 * (a & 1) + b; }
typedef __bf16 bf16x2_t __attribute__((ext_vector_type(2)));
__device__ __forceinline__ unsigned pk_bf16(float lo, float hi) { const f32x2 v = {lo, hi}; const bf16x2_t b = __builtin_convertvector(v, bf16x2_t); return __builtin_bit_cast(unsigned, b); }
__device__ __forceinline__ unsigned pk_f16(float lo, float hi) { return __builtin_bit_cast(unsigned, __builtin_amdgcn_cvt_pkrtz(lo, hi)); }
__device__ __forceinline__ float half_sum(float v) { auto rr = __builtin_amdgcn_permlane32_swap(__float_as_uint(v), __float_as_uint(v), false, false); return __uint_as_float(rr[0]) + __uint_as_float(rr[1]); }
__device__ __forceinline__ float half_max(float v) { auto rr = __builtin_amdgcn_permlane32_swap(__float_as_uint(v), __float_as_uint(v), false, false); return fmaxf(__uint_as_float(rr[0]), __uint_as_float(rr[1])); }
__device__ __forceinline__ void glds16(const void* gsrc, unsigned lds_dst) { unsigned keep;
    asm volatile("s_mov_b32 %0, m0\n\ts_mov_b32 m0, %2\n\ts_nop 0\n\tglobal_load_lds_dwordx4 %1, off\n\ts_mov_b32 m0, %0" : "=&s"(keep) : "v"(gsrc), "s"(lds_dst) : "memory"); }
#define ATT_SB() __builtin_amdgcn_sched_barrier(0)
#define ATT_MFMA(a, b, c) __builtin_amdgcn_mfma_f32_32x32x16_bf16((a), (b), (c), 0, 0, 0)
#define ATT_MFMAH(a, b, c) __builtin_amdgcn_mfma_f32_32x32x16_f16((a), (b), (c), 0, 0, 0)

struct Tensors {
    const bf16* proj;
    const bf16* vt;
    const float* fcum;
    bf16* ymix;
    const float* ong;
    int colq, colk, coly;
    void* tprobe;
    float z2max;
};
struct WaveCtx { int r32, hi, qabs; int ko[4]; const LAS unsigned char* qb; f16x8 mtri0, mtri1, mones; };

__device__ __forceinline__ void qk_only(f32x16& p0, f32x16& p1, const LAS unsigned char* Kb, const WaveCtx& W) {
#pragma unroll
    for (int r = 0; r < 16; ++r) { p0[r] = 0.f; p1[r] = 0.f; }
#pragma unroll
    for (int d0 = 0; d0 < 4; ++d0) { const bf16x8 ka = *(const LAS bf16x8*)(Kb + W.ko[d0]), kb2 = *(const LAS bf16x8*)(Kb + 32 * KROW + W.ko[d0]);
        const bf16x8 qv = *(const LAS bf16x8*)(W.qb + 32 * d0);
        p0 = ATT_MFMA(ka, qv, p0); p1 = ATT_MFMA(kb2, qv, p1); }
}

template <int KIND, bool DIAG>
__device__ __forceinline__ void tile(f32x16& p0, f32x16& p1, f32x16& o0, f32x16& o1, float& carry, float& lsum, const LAS unsigned char* Kn, const LAS unsigned char* Vb, const LAS float* Fb, int kt, const WaveCtx& W) {
    const int kbase = kt * 64 + 8 * W.hi;
#define ATT_KF(i) (*(const LAS bf16x8*)(Kn + ((i) & 1) * 32 * KROW + W.ko[(i) >> 1]))
#define ATT_VF(i) (*(const LAS bf16x8*)(Vb + ((i) & 1) * 32 * KROW + W.ko[(i) >> 1]))
#define ATT_QF(d0) (*(const LAS bf16x8*)(W.qb + 32 * (d0)))
    bf16x8 kcur = ATT_KF(0), knxt = kcur, qcur = ATT_QF(0), qnxt = qcur;
    f32x16 n0, n1;
#pragma unroll
    for (int r = 0; r < 16; ++r) { n0[r] = 0.f; n1[r] = 0.f; }
    v4u wf[4];
    if (KIND == 0) {
        v4u lf[4]; float lfirst = 0.f, pz0 = 0.f;
#pragma unroll
        for (int i = 0; i < 8; ++i) {
            if (i < 7) { knxt = ATT_KF(i + 1); if (i & 1) qnxt = ATT_QF((i + 1) >> 1); }
#pragma unroll
            for (int jj = 0; jj < 2; ++jj) { const int r = (4 * i + 2 * jj) & 15; float lg[2];
#pragma unroll
                for (int e = 0; e < 2; ++e) { const float z = (i < 4) ? p0[r + e] : p1[r + e]; float g = __builtin_amdgcn_logf(1.0f + __builtin_amdgcn_exp2f(z));
                    if (i < 4) p0[r + e] = z - g; else p1[r + e] = z - g;
                    if (DIAG) { const int key = kbase + (i < 4 ? 0 : 32) + 16 * ((r + e) >> 3) + ((r + e) & 7); g = (key < W.qabs) ? g : 0.f; }
                    lg[e] = g; }
                if (i == 0 && jj == 0) { lfirst = -lg[0]; pz0 = p0[0]; }
                lf[2 * (i >> 2) + (r >> 3)][(r & 7) >> 1] = pk_f16(-lg[0], -lg[1]);
                if (jj == 1) asm volatile("" : "+v"(kcur) : "v"(lf[2 * (i >> 2) + (r >> 3)][(r & 7) >> 1])); }
            if (i & 1) { n1 = ATT_MFMA(kcur, qcur, n1); qcur = qnxt; } else n0 = ATT_MFMA(kcur, qcur, n0);
            kcur = knxt;
            ATT_SB();
        }
        bf16x8 va = ATT_VF(0), vb = ATT_VF(1), vna = va, vnb = vb;
#pragma unroll
        for (int r = 0; r < 16; ++r) { p0[r] += carry; p1[r] += carry; }
        p0 = ATT_MFMAH(W.mtri0, __builtin_bit_cast(f16x8, lf[0]), p0); p1 = ATT_MFMAH(W.mtri0, __builtin_bit_cast(f16x8, lf[2]), p1);
        p0 = ATT_MFMAH(W.mtri1, __builtin_bit_cast(f16x8, lf[1]), p0); p1 = ATT_MFMAH(W.mtri1, __builtin_bit_cast(f16x8, lf[3]), p1);
        p0 = ATT_MFMAH(W.mones, __builtin_bit_cast(f16x8, lf[2]), p0);
        p0 = ATT_MFMAH(W.mones, __builtin_bit_cast(f16x8, lf[3]), p0);
        ATT_SB();
        const float t00 = p0[0];
#pragma unroll
        for (int c = 0; c < 4; ++c) {
            if (c < 3) { vna = ATT_VF(2 * c + 2); vnb = ATT_VF(2 * c + 3); }
#pragma unroll
            for (int j = 0; j < 4; ++j) { const int r = 8 * (c & 1) + 2 * j; float w[2];
#pragma unroll
                for (int e = 0; e < 2; ++e) { const float t = (c < 2) ? p0[r + e] : p1[r + e]; float x = __builtin_amdgcn_exp2f(t);
                    if (DIAG) { const int key = kbase + (c < 2 ? 0 : 32) + 16 * ((r + e) >> 3) + ((r + e) & 7); x = (key < W.qabs) ? x : 0.f; }
                    w[e] = x; }
                wf[c][j] = pk_bf16(w[0], w[1]); }
            o0 = ATT_MFMA(va, __builtin_bit_cast(bf16x8, wf[c]), o0); o1 = ATT_MFMA(vb, __builtin_bit_cast(bf16x8, wf[c]), o1);
            va = vna; vb = vnb;
            ATT_SB();
        }
        carry = half_sum(W.hi == 0 ? (t00 - pz0) + lfirst : 0.f);
    } else {
#define ATT_FBV(i) (*(const LAS f32x4*)(Fb + 8 * W.hi + 32 * ((i) >> 2) + 16 * (((i) >> 1) & 1) + 4 * ((i) & 1)))
        f32x4 fcur = ATT_FBV(0), fnxt = fcur;
        float mx = -1e30f;
#pragma unroll
        for (int i = 0; i < 8; ++i) {
            if (i < 7) { knxt = ATT_KF(i + 1); fnxt = ATT_FBV(i + 1); if (i & 1) qnxt = ATT_QF((i + 1) >> 1); }
#pragma unroll
            for (int e = 0; e < 4; ++e) { const int r = (4 * i + e) & 15; float s = ((i < 4) ? p0[r] : p1[r]) - fcur[e];
                if (DIAG) { const int key = kbase + (i < 4 ? 0 : 32) + 16 * (r >> 3) + (r & 7); s = (key > W.qabs) ? -1e30f : s; }
                if (i < 4) p0[r] = s; else p1[r] = s; mx = fmaxf(mx, s); }
            asm volatile("" : "+v"(kcur) : "v"(mx));
            if (i & 1) { n1 = ATT_MFMA(kcur, qcur, n1); qcur = qnxt; } else n0 = ATT_MFMA(kcur, qcur, n0);
            kcur = knxt; fcur = fnxt;
            ATT_SB();
        }
        bf16x8 va = ATT_VF(0), vb = ATT_VF(1), vna = va, vnb = vb;
        mx = half_max(mx);
        if (__any(mx > carry)) {
            const float mnew = fmaxf(carry, mx), alpha = __builtin_amdgcn_exp2f(carry - mnew); carry = mnew; lsum *= alpha;
#pragma unroll
            for (int r = 0; r < 16; ++r) { o0[r] *= alpha; o1[r] *= alpha; }
        }
        ATT_SB();
        float ps = 0.f;
#pragma unroll
        for (int c = 0; c < 4; ++c) {
            if (c < 3) { vna = ATT_VF(2 * c + 2); vnb = ATT_VF(2 * c + 3); }
#pragma unroll
            for (int j = 0; j < 4; ++j) { const int r = 8 * (c & 1) + 2 * j;
                const float a = __builtin_amdgcn_exp2f(((c < 2) ? p0[r] : p1[r]) - carry), d = __builtin_amdgcn_exp2f(((c < 2) ? p0[r + 1] : p1[r + 1]) - carry);
                ps += a + d; wf[c][j] = pk_bf16(a, d); }
            o0 = ATT_MFMA(va, __builtin_bit_cast(bf16x8, wf[c]), o0); o1 = ATT_MFMA(vb, __builtin_bit_cast(bf16x8, wf[c]), o1);
            va = vna; vb = vnb;
            ATT_SB();
        }
        lsum += half_sum(ps);
    }
    p0 = n0; p1 = n1;
#undef ATT_KF
#undef ATT_QF
#undef ATT_VF
#undef ATT_FBV
}

template <int KIND>
__device__ __forceinline__ void unit(const Tensors& T, int b, int h, int qb, LAS unsigned char* lds, int wave) {
    int lane_ = (int)__builtin_amdgcn_mbcnt_hi(~0u, __builtin_amdgcn_mbcnt_lo(~0u, 0u)); asm volatile("" : "+v"(lane_));
    const int wid = wave, lane = lane_, tid = wid * 64 + lane;
    WaveCtx W; W.r32 = lane & 31; W.hi = lane >> 5;
    const int q0 = qb * 256, qw0 = q0 + wid * 32; W.qabs = qw0 + W.r32;
    const size_t rowbase = (size_t)b * SEQ;
    const int ktd = qw0 >> 6;
    const int kt_hi = (q0 + 255) >> 6;
    const int srow = tid >> 3, cg = (tid & 7) ^ ((srow >> 1) & 7);
    const bf16* kg = T.proj + (rowbase + srow) * NPROJ + T.colk + h * 64 + cg * 8;
    const bf16* vg = T.vt + ((size_t)(b * 6 + h) * 64 + srow) * SEQ + cg * 8;
    const float* fg = T.fcum + (size_t)(b * 6 + h) * SEQ;
    LAS unsigned char* qlds = lds + OFF_Q + wid * 4608;
    W.qb = qlds + W.r32 * 144 + W.hi * 16;
    { const bf16* qp = T.proj + (rowbase + W.qabs) * NPROJ + T.colq + h * 64 + W.hi * 8;
      v4u qt[4];
#pragma unroll
      for (int d0 = 0; d0 < 4; ++d0) qt[d0] = *(const v4u*)(qp + d0 * 16);
#pragma unroll
      for (int d0 = 0; d0 < 4; ++d0) *(LAS v4u*)(qlds + W.r32 * 144 + W.hi * 16 + 32 * d0) = qt[d0]; }
    const int pm = pim(W.r32);
#pragma unroll
    for (int j = 0; j < 4; ++j) W.ko[j] = pm * KROW + (((2 * j + W.hi) ^ ((pm >> 1) & 7)) << 4);
#pragma unroll
    for (int i = 0; i < 8; ++i) { W.mtri0[i] = (_Float16)((8 * W.hi + i > pm) ? 1.0f : 0.0f); W.mtri1[i] = (_Float16)((16 + 8 * W.hi + i > pm) ? 1.0f : 0.0f); W.mones[i] = (_Float16)1.0f; }
    f32x16 o0, o1, p0, p1;
#pragma unroll
    for (int r = 0; r < 16; ++r) { o0[r] = 0.f; o1[r] = 0.f; p0[r] = 0.f; p1[r] = 0.f; }
    float carry = (KIND == 1) ? -1e30f : 0.f, lsum = 0.f;
#define ATT_KB(t) (lds + OFF_K + ((t) & 1) * TILE_B)
#define ATT_VB(t) (lds + OFF_V + ((t) & 1) * TILE_B)
#define ATT_FB(t) ((LAS float*)(lds + OFF_F + ((t) & 1) * 256))
#define ATT_DMA(gsrc, ldst) glds16((gsrc), (unsigned)__builtin_amdgcn_readfirstlane((int)(uintptr_t)((ldst) + wid * 1024)))
    ATT_DMA(kg + (size_t)kt_hi * 64 * NPROJ, ATT_KB(kt_hi)); ATT_DMA(vg + kt_hi * 64, ATT_VB(kt_hi)); ATT_DMA(kg + (size_t)(kt_hi - 1) * 64 * NPROJ, ATT_KB(kt_hi - 1));
    if (KIND == 1 && tid < 64) ATT_FB(kt_hi)[tid] = fg[kt_hi * 64 + tid];
    asm volatile("s_waitcnt vmcnt(0)" ::: "memory");
    __syncthreads();
    if (ktd == kt_hi) qk_only(p0, p1, ATT_KB(kt_hi), W);
    __syncthreads();
#ifdef TPROBE
    unsigned long long tacc = 0ull;
#endif
    constexpr float EXIT_LOG2 = -64.0f;
    LAS int* flags = (LAS int*)(lds + OFF_FLAG);
    bool wdone = false;
    for (int kt = kt_hi; kt >= 0; --kt) {
        float freg = 0.f, fnx = 0.f;
        if (KIND == 1 && kt >= 1) fnx = fg[kt * 64 - 1];
#ifdef TPROBE
        const unsigned long long tp0 = __builtin_readcyclecounter();
#endif
        if (kt >= 2) ATT_DMA(kg + (size_t)(kt - 2) * 64 * NPROJ, ATT_KB(kt - 2));
        if (kt >= 1) { ATT_DMA(vg + (kt - 1) * 64, ATT_VB(kt - 1)); if (KIND == 1 && tid < 64) freg = fg[(kt - 1) * 64 + tid]; }
#ifdef TPROBE
        const unsigned long long tp1 = __builtin_readcyclecounter();
#endif
        if (kt <= ktd) {
            if (!wdone) {
                if (kt == ktd) tile<KIND, true>(p0, p1, o0, o1, carry, lsum, ATT_KB(kt - 1), ATT_VB(kt), ATT_FB(kt), kt, W);
                else tile<KIND, false>(p0, p1, o0, o1, carry, lsum, ATT_KB(kt - 1), ATT_VB(kt), ATT_FB(kt), kt, W);
                const float slack = (KIND == 0) ? carry : (T.z2max - fnx) - carry;
                wdone = !__any(!(slack < EXIT_LOG2));
            }
        } else if (kt - 1 == ktd) qk_only(p0, p1, ATT_KB(kt - 1), W);
        if (lane == 0) flags[(kt & 1) * 8 + wid] = wdone ? 1 : 0;
        if (KIND == 1 && kt >= 1 && tid < 64) ATT_FB(kt - 1)[tid] = freg;
#ifdef TPROBE
        const unsigned long long tp2 = __builtin_readcyclecounter();
#endif
        asm volatile("s_waitcnt vmcnt(0)" ::: "memory");
#ifdef ATT_LDSFLUSH
        { unsigned dummy; asm volatile("ds_read_b32 %0, %1\n\ts_waitcnt lgkmcnt(0)" : "=v"(dummy) : "v"((unsigned)(uintptr_t)(lds + OFF_V + wid * 1024 + lane * 16)) : "memory"); }
#endif
        __syncthreads();
        if (__all(flags[(kt & 1) * 8 + (lane & 7)] != 0)) break;
#ifdef TPROBE
        const unsigned long long tp3 = __builtin_readcyclecounter();
        tacc += (TPROBE == 1) ? (tp3 - tp2) : (TPROBE == 2) ? (tp3 - tp0) : (TPROBE == 3) ? (tp2 - tp1) : (tp1 - tp0);
        asm volatile("" :: "s"(tp0), "s"(tp1), "s"(tp2), "s"(tp3));
#endif
    }
#ifdef TPROBE
    if (blockIdx.x == TPROBE_BLK && tid == TPROBE_WAVE * 64) atomicAdd((unsigned long long*)T.tprobe, tacc);
#endif
#undef ATT_KB
#undef ATT_VB
#undef ATT_FB
#undef ATT_DMA
    if (KIND == 1) { const float inv = 1.0f / lsum;
#pragma unroll
        for (int r = 0; r < 16; ++r) { o0[r] *= inv; o1[r] *= inv; } }
    float ss = 0.f;
#pragma unroll
    for (int r = 0; r < 16; ++r) ss += o0[r] * o0[r] + o1[r] * o1[r];
    ss = half_sum(ss);
    const float rinv = 1.0f / sqrtf(ss * (1.0f / 64.0f) + EPS);
    const float* gp = T.ong + T.coly + h * 64 + 8 * W.hi;
    bf16* yp = T.ymix + (rowbase + W.qabs) * DM + T.coly + h * 64 + 8 * W.hi;
#pragma unroll
    for (int d0 = 0; d0 < 2; ++d0)
#pragma unroll
        for (int g = 0; g < 2; ++g) { const f32x4 ga = *(const f32x4*)(gp + 32 * d0 + 16 * g), gb = *(const f32x4*)(gp + 32 * d0 + 16 * g + 4);
            float v[8];
#pragma unroll
            for (int i = 0; i < 8; ++i) v[i] = (d0 == 0 ? o0[8 * g + i] : o1[8 * g + i]) * rinv * (i < 4 ? ga[i & 3] : gb[i & 3]);
            v4u w; w.x = pk_bf16(v[0], v[1]); w.y = pk_bf16(v[2], v[3]); w.z = pk_bf16(v[4], v[5]); w.w = pk_bf16(v[6], v[7]);
            *(v4u*)(yp + 32 * d0 + 16 * g) = w; }
}
}
constexpr size_t MiB = 1u << 20;
constexpr size_t WS_CTL = 0, CTL_ZERO_BYTES = 1 * MiB;
constexpr size_t WS_MODP = 1 * MiB;
constexpr size_t WS_TOPW = 3 * MiB;
constexpr size_t WS_ROUTE = WS_TOPW + 512 * 1024;
constexpr size_t WS_TOKSLOT = WS_ROUTE + 512 * 1024;
constexpr size_t WS_SLOTTOK = WS_TOKSLOT + 512 * 1024;
constexpr size_t WS_HIST = WS_SLOTTOK + 576 * 1024;
constexpr size_t WS_MOETAB = WS_HIST + 32 * 1024;
constexpr size_t WS_LOGF = 6 * MiB;
constexpr size_t WS_FCUM = 7 * MiB;
constexpr size_t WS_WIN = 8 * MiB, WS_WOUT = 20 * MiB, WS_W1 = 24 * MiB, WS_W2 = 280 * MiB;
constexpr size_t WS_H = 408 * MiB;
constexpr size_t WS_PROJ = 472 * MiB;
constexpr size_t WS_VT = 664 * MiB;
constexpr size_t WS_YMIX = 712 * MiB;
constexpr size_t WS_XA = 776 * MiB, WS_XB = 904 * MiB;
constexpr size_t WS_ACT = 1032 * MiB, WS_Y = 1304 * MiB, WS_H8 = 1576 * MiB, WS_END = 1608 * MiB;
static_assert(WS_MOETAB + 256 <= WS_LOGF && (size_t)NSLOT_MAX * 4 <= 576 * 1024 && (size_t)NSLOT_MAX * DM * 2 <= 272 * MiB, "ws map");
#ifndef P2_FP8
#define P2_FP8 0
#endif
constexpr int CW_BAR = 4096;

constexpr int RING_BYTES = 131072;
constexpr int MISC_OFF = RING_BYTES;
constexpr int LDS_BYTES = 147456;

#define RLX_AGENT __ATOMIC_RELAXED, __HIP_MEMORY_SCOPE_AGENT
__device__ __forceinline__ unsigned f2bf(float f) { unsigned u = __builtin_bit_cast(unsigned, f); return (u + 0x7fffu + ((u >> 16) & 1u)) >> 16; }
__device__ __forceinline__ unsigned pk2(float lo, float hi) { return f2bf(lo) | (f2bf(hi) << 16); }
__device__ __forceinline__ float bflo(unsigned u) { return __builtin_bit_cast(float, u << 16); }
__device__ __forceinline__ float bfhi(unsigned u) { return __builtin_bit_cast(float, u & 0xffff0000u); }
__device__ __forceinline__ int shxi(int v, int o, int lane) {
    if (o == 1) return __builtin_amdgcn_mov_dpp(v, 0xB1, 0xf, 0xf, true);
    if (o == 2) return __builtin_amdgcn_mov_dpp(v, 0x4E, 0xf, 0xf, true);
    if (o == 4) return __builtin_amdgcn_ds_swizzle(v, 0x101F);
    if (o == 8) return __builtin_amdgcn_ds_swizzle(v, 0x201F);
    if (o == 16) return __builtin_amdgcn_ds_swizzle(v, 0x401F);
    return __builtin_amdgcn_ds_bpermute((lane ^ o) << 2, v);
}
__device__ __forceinline__ float shx(float v, int o, int lane) { return __builtin_bit_cast(float, shxi(__builtin_bit_cast(int, v), o, lane)); }
__device__ __forceinline__ float shup(float v, int o, int lane) { return __builtin_bit_cast(float, __builtin_amdgcn_ds_bpermute(((lane - o) & 63) << 2, __builtin_bit_cast(int, v))); }
__device__ __forceinline__ float add_other_half(float v) { auto rr = __builtin_amdgcn_permlane32_swap(__float_as_uint(v), __float_as_uint(v), false, false); return __uint_as_float(rr[0]) + __uint_as_float(rr[1]); }
__device__ __forceinline__ float wave_sum(float v, int lane) {
    v += shx(v, 1, lane); v += shx(v, 2, lane); v += shx(v, 4, lane); v += shx(v, 8, lane); v += shx(v, 16, lane);
    return add_other_half(v);
}

#define XB_TMO      128
#define XB_XCNT(j)  (256  + 64 * (j))
#define XB_XSUB(j)  (1280 + 64 * (j))
#define XB_XGEN(j)  (2304 + 64 * (j))
#define XB_TOP      3328
#define XB_TOPGEN   3392
#define XCD_BAR_WORDS 3456
#define XB_SPIN_CAP (1u << 18)
__device__ __forceinline__ unsigned xb_ld(unsigned* p)              { return __hip_atomic_load(p, __ATOMIC_RELAXED, __HIP_MEMORY_SCOPE_AGENT); }
__device__ __forceinline__ unsigned xb_add(unsigned* p, unsigned v) { return __hip_atomic_fetch_add(p, v, __ATOMIC_RELAXED, __HIP_MEMORY_SCOPE_AGENT); }
__device__ __forceinline__ unsigned xb_xcc_id() { return (unsigned)__builtin_amdgcn_s_getreg((3 << 11) | 20) & 0xFu; }
#define XB_SPIN(cond, bar) do { unsigned _sp = 0; while (cond) { __builtin_amdgcn_s_sleep(1); \
    if ((++_sp & 255u) == 0u) { if (xb_ld(&(bar)[XB_TMO])) break; if (_sp > XB_SPIN_CAP) { atomicAdd(&(bar)[XB_TMO], 1u); break; } } } } while (0)
__device__ __forceinline__ int lane_id() { return (int)__builtin_amdgcn_mbcnt_hi(~0u, __builtin_amdgcn_mbcnt_lo(~0u, 0u)); }
struct XcdBarrier { unsigned* bar; unsigned x; volatile LAS unsigned* st; int wave; };
__device__ __forceinline__ XcdBarrier xcd_barrier_post(unsigned* bar, volatile LAS unsigned* st, int wave) {
    XcdBarrier b; b.bar = bar; b.x = (unsigned)__builtin_amdgcn_readfirstlane((int)xb_xcc_id()); b.st = st; b.wave = wave;
    if (wave == 0 && lane_id() == 0) (void)xb_add(&bar[XB_XCNT(b.x)], 1u);
    return b;
}
__device__ __forceinline__ void xcd_barrier_complete(unsigned* bar, unsigned x, unsigned& nloc, unsigned& nx) {
    const unsigned G = gridDim.x * gridDim.y * gridDim.z;
    unsigned sum, cnt, mine, sp = 0u;
    for (;;) {
        sum = 0u; cnt = 0u; mine = 0u;
#pragma unroll
        for (unsigned j = 0; j < 16; ++j) { const unsigned c = xb_ld(&bar[XB_XCNT(j)]); sum += c; cnt += (c > 0u) ? 1u : 0u; mine = (j == x) ? c : mine; }
        if (sum == G) break;
        __builtin_amdgcn_s_sleep(1);
        if ((++sp & 255u) == 0u) { if (xb_ld(&bar[XB_TMO])) break; if (sp > XB_SPIN_CAP) { atomicAdd(&bar[XB_TMO], 1u); break; } }
    }
    nloc = mine > 0u ? mine : 1u; nx = cnt > 0u ? cnt : 1u;
}
__device__ __forceinline__ void xcd_barrier(const XcdBarrier& b) {
    asm volatile("s_waitcnt vmcnt(0)" ::: "memory");
    __syncthreads();
    if (b.wave == 0 && lane_id() == 0) {
        unsigned* bar = b.bar; const unsigned bx = (unsigned)__builtin_amdgcn_readfirstlane((int)xb_xcc_id());
        __builtin_amdgcn_s_waitcnt(0);
        unsigned nloc = b.st[0], nx = b.st[1];
        if (nloc == 0u) { xcd_barrier_complete(bar, bx, nloc, nx); b.st[0] = nloc; b.st[1] = nx; }
        const unsigned old = xb_add(&bar[XB_XSUB(bx)], 1u);
        const unsigned gen = old / nloc;
        if (old + 1u == (gen + 1u) * nloc) {
            __builtin_amdgcn_fence(__ATOMIC_RELEASE, "agent");
            asm volatile("s_waitcnt vmcnt(0)" ::: "memory");
            const unsigned og = xb_add(&bar[XB_TOP], 1u);
            const unsigned tg = og / nx;
            if (og + 1u == (tg + 1u) * nx) xb_add(&bar[XB_TOPGEN], 1u);
            else XB_SPIN(xb_ld(&bar[XB_TOPGEN]) == tg, bar);
            __builtin_amdgcn_fence(__ATOMIC_ACQUIRE, "agent");
            xb_add(&bar[XB_XGEN(bx)], 1u);
            asm volatile("s_waitcnt vmcnt(0)" ::: "memory");
        } else {
            XB_SPIN(xb_ld(&bar[XB_XGEN(bx)]) == gen, bar);
            __builtin_amdgcn_fence(__ATOMIC_ACQUIRE, "agent");
            asm volatile("s_waitcnt vmcnt(0)" ::: "memory");
        }
    }
    __syncthreads();
}

struct Frame {
    LAS unsigned char* lds;
    int tid, lane, wave, blk, G;
    const float* in[21];
    float* out; unsigned char* ws;
};
enum { I_X = 0, I_C, I_N1G, I_WADA, I_BADA, I_WIN, I_CONVW, I_SBQG, I_SBKG, I_FXQG, I_FXKG, I_FXFB, I_ONG, I_WOUT, I_N2G, I_RW, I_RB, I_W1, I_B1, I_W2, I_B2 };

template <int MAP, bool WIDE, bool OUT8 = false>
__device__ __forceinline__ void p0_transpose_item(const float* W, int ldw, bf16* WT, LAS float* scr, int k0, int n0, int lane) {
    if (WIDE) {
        f32x4 t[8];
#pragma unroll
        for (int i = 0; i < 8; ++i) t[i] = __builtin_nontemporal_load((const f32x4*)(W + (size_t)(k0 + 8 * i + (lane >> 3)) * ldw + n0 + 4 * (lane & 7)));
#pragma unroll
        for (int i = 0; i < 8; ++i) { LAS float* d = scr + (8 * i + (lane >> 3)) * 33 + 4 * (lane & 7); d[0] = t[i].x; d[1] = t[i].y; d[2] = t[i].z; d[3] = t[i].w; }
    } else {
#pragma unroll 8
        for (int i = 0; i < 32; ++i) { const int kk = 2 * i + (lane >> 5); scr[kk * 33 + (lane & 31)] = W[(size_t)(k0 + kk) * ldw + n0 + (lane & 31)]; }
    }
    asm volatile("s_waitcnt lgkmcnt(0)" ::: "memory");
    const int c = lane & 7;
#pragma unroll
    for (int j = 0; j < 4; ++j) { const int n = (lane >> 3) + 8 * j; const LAS float* s = scr + (8 * c) * 33 + n;
        v4u o; o.x = pk2(s[0 * 33], s[1 * 33]); o.y = pk2(s[2 * 33], s[3 * 33]); o.z = pk2(s[4 * 33], s[5 * 33]); o.w = pk2(s[6 * 33], s[7 * 33]);
        const int cn = n0 + n; int row = cn;
        if (MAP == 1) { const int jj = cn >> 1, t = cn & 1; row = 256 * (jj >> 7) + 128 * t + (jj & 127); }
        if (OUT8) { v2u o8; o8.x = pg8::pk4_fp8(32.0f * s[0 * 33], 32.0f * s[1 * 33], 32.0f * s[2 * 33], 32.0f * s[3 * 33]); o8.y = pg8::pk4_fp8(32.0f * s[4 * 33], 32.0f * s[5 * 33], 32.0f * s[6 * 33], 32.0f * s[7 * 33]);
            *(v2u*)((unsigned char*)WT + (size_t)row * 1024 + k0 + 8 * c) = o8; }
        else *(v4u*)(WT + (size_t)row * 1024 + k0 + 8 * c) = o; }
    asm volatile("s_waitcnt lgkmcnt(0)" ::: "memory");
}
__device__ __forceinline__ void p0_prologue(Frame& F) {
    LAS float* scr = (LAS float*)(F.lds + F.wave * 16384);
    const int gw = F.blk * 8 + F.wave, NGW = F.G * 8;
    constexpr int N_ADA = NLAYER * 4 * 24;
    if (F.blk * 8 < N_ADA) {
        LAS float* sl = (LAS float*)(F.lds + 8 * 16384 - 32768);
        for (int i = F.tid; i < NB * DM; i += 512) { const float cv = F.in[I_C][i]; sl[i] = cv / (1.0f + __expf(-cv)); }
        __syncthreads();
        if (gw < N_ADA) {
            const int it = gw; const int l = it / 96, ks = (it / 24) & 3, nc = it % 24;
            const float* W = F.in[I_WADA] + (size_t)l * DM * 6144 + nc * 256 + F.lane * 4;
            f32x4 acc[NB];
#pragma unroll
            for (int b = 0; b < NB; ++b) acc[b] = (f32x4){0.f, 0.f, 0.f, 0.f};
#pragma unroll 8
            for (int k = ks * 256; k < ks * 256 + 256; ++k) {
                const f32x4 w = __builtin_nontemporal_load((const f32x4*)(W + (size_t)k * 6144));
#pragma unroll
                for (int b = 0; b < NB; ++b) acc[b] += w * sl[b * DM + k];
            }
            float* dst = (float*)(F.ws + WS_MODP) + ((size_t)(l * 4 + ks) * NB) * 6144 + nc * 256 + F.lane * 4;
#pragma unroll
            for (int b = 0; b < NB; ++b) *(f32x4*)(dst + (size_t)b * 6144) = acc[b];
        }
        __syncthreads();
    }
    constexpr int I_IN = 16 * 96, I_OUT = 16 * 32, I_1 = 16 * 64, I_2 = 16 * 32;
    constexpr int N_IN = NLAYER * I_IN, N_OUT = NLAYER * I_OUT, N_1 = NLAYER * NEXP * I_1, N_2 = NLAYER * NEXP * I_2;
#pragma unroll 1
    for (int it = gw; it < N_IN + N_OUT; it += NGW) {
        int r = it;
        if (r < N_IN) { const int l = r / I_IN, q = r % I_IN, kb = q / 96, nb = q % 96;
            p0_transpose_item<0, false, P2_FP8>(F.in[I_WIN] + (size_t)l * DM * D_IN, D_IN, (bf16*)(F.ws + WS_WIN + (size_t)l * NPROJ * DM * (P2_FP8 ? 1 : 2)), scr, 64 * kb, 32 * nb, F.lane); continue; }
        r -= N_IN;
        { const int l = r / I_OUT, q = r % I_OUT, kb = q / 32, nb = q % 32;
            p0_transpose_item<0, true>(F.in[I_WOUT] + (size_t)l * DM * DM, DM, (bf16*)(F.ws + WS_WOUT) + (size_t)l * DM * DM, scr, 64 * kb, 32 * nb, F.lane); }
    }
    constexpr int ADA_SKIP = 6, NE = N_1 + N_2;
    const bool adaw = gw < N_ADA; const int pool = adaw ? -1 : (gw - N_ADA < N_ADA * ADA_SKIP ? gw - N_ADA : -1);
    const int pool_it = (pool >= 0) ? (pool % N_ADA) + (pool / N_ADA) * NGW : -1;
    f32x4 cur[8], nxt[8];
#define P0_LOAD(dst, itx_) do { const int it_ = ((itx_) < 0) ? pool_it : (itx_); const float* s_; int ldw_; \
        if (it_ < N_1) { const int le = it_ / I_1, q = it_ % I_1, kb = q / 64, nb = q % 64; ldw_ = 2048; s_ = F.in[I_W1] + (size_t)le * DM * 2048 + (size_t)(64 * kb + (F.lane >> 3)) * 2048 + 32 * nb + 4 * (F.lane & 7); } \
        else { const int r_ = it_ - N_1; const int le = r_ / I_2, q = r_ % I_2, kb = q / 32, nb = q % 32; ldw_ = DM; s_ = F.in[I_W2] + (size_t)le * DM * DM + (size_t)(64 * kb + (F.lane >> 3)) * DM + 32 * nb + 4 * (F.lane & 7); } \
        _Pragma("unroll") for (int i = 0; i < 8; ++i) dst[i] = __builtin_nontemporal_load((const f32x4*)(s_ + (size_t)(8 * i) * ldw_)); } while (0)
    int itx = adaw ? gw + ADA_SKIP * NGW : (pool >= 0 ? gw - NGW : gw);
    if (itx < NE) P0_LOAD(cur, itx);
#pragma unroll 1
    for (; itx < NE; itx += NGW) {
        if (itx + NGW < NE) P0_LOAD(nxt, itx + NGW);
#pragma unroll
        for (int i = 0; i < 8; ++i) { LAS float* d = scr + (8 * i + (F.lane >> 3)) * 33 + 4 * (F.lane & 7); d[0] = cur[i].x; d[1] = cur[i].y; d[2] = cur[i].z; d[3] = cur[i].w; }
        asm volatile("s_waitcnt lgkmcnt(0)" ::: "memory");
        { const int it = (itx < 0) ? pool_it : itx; const bool isw1 = it < N_1; const int r = isw1 ? it : it - N_1;
          const int per = isw1 ? I_1 : I_2, nbn = isw1 ? 64 : 32; const int le = r / per, q = r % per, kb = q / nbn, nb = q % nbn;
          unsigned char* WT = isw1 ? F.ws + WS_W1 + (size_t)le * 2048 * DM : F.ws + WS_W2 + (size_t)le * DM * DM;
          const int c = F.lane & 7;
#pragma unroll
          for (int j = 0; j < 4; ++j) { const int n = (F.lane >> 3) + 8 * j; const LAS float* s = scr + (8 * c) * 33 + n;
              v2u o8; o8.x = pg8::pk4_fp8(32.0f * s[0 * 33], 32.0f * s[1 * 33], 32.0f * s[2 * 33], 32.0f * s[3 * 33]); o8.y = pg8::pk4_fp8(32.0f * s[4 * 33], 32.0f * s[5 * 33], 32.0f * s[6 * 33], 32.0f * s[7 * 33]);
              const int cn = 32 * nb + n; int row = cn;
              if (isw1) { const int jj = cn >> 1, t = cn & 1; row = 256 * (jj >> 7) + 128 * t + (jj & 127); }
              *(v2u*)(WT + (size_t)row * 1024 + 64 * kb + 8 * c) = o8; } }
        asm volatile("s_waitcnt lgkmcnt(0)" ::: "memory");
#pragma unroll
        for (int i = 0; i < 8; ++i) cur[i] = nxt[i];
    }
#undef P0_LOAD
}

__device__ __forceinline__ f32x4 mod4(const Frame& F, int l, int b, int which, int c) {
    const int n = which * DM + c;
    f32x4 s = *(const f32x4*)(F.in[I_BADA] + (size_t)l * 6144 + n);
    const float* p = (const float*)(F.ws + WS_MODP) + ((size_t)(l * 4) * NB + b) * 6144 + n;
#pragma unroll
    for (int ks = 0; ks < 4; ++ks) s += *(const f32x4*)(p + (size_t)ks * NB * 6144);
    return s;
}

constexpr size_t WS_GSUM = WS_FCUM + 800 * 1024;
static_assert(WS_GSUM + 16384 <= WS_WIN, "ws map");
template <bool S16> __device__ __forceinline__ f32x4 ld_row4(const void* base, size_t idx) {
    if (S16) { const v2u t = *(const v2u*)((const bf16*)base + idx); return (f32x4){bflo(t.x), bfhi(t.x), bflo(t.y), bfhi(t.y)}; }
    return *(const f32x4*)((const float*)base + idx); }
template <bool D16> __device__ __forceinline__ void st_row4(void* base, size_t idx, f32x4 v) {
    if (D16) { v2u o; o.x = pk2(v.x, v.y); o.y = pk2(v.z, v.w); *(v2u*)((bf16*)base + idx) = o; }
    else *(f32x4*)((float*)base + idx) = v; }
__device__ __forceinline__ f32x4 fp8x4_to_f32(unsigned w) { return (f32x4){__builtin_amdgcn_cvt_f32_fp8(w, 0), __builtin_amdgcn_cvt_f32_fp8(w, 1), __builtin_amdgcn_cvt_f32_fp8(w, 2), __builtin_amdgcn_cvt_f32_fp8(w, 3)}; }
template <bool COMBINE, bool NORM, bool S16, bool D16>
__device__ __forceinline__ void row_phase(Frame& F, int l, const void* xsrc, void* xdst) {
    const float* topw = (const float*)(F.ws + WS_TOPW); const int* tokslot = (const int*)(F.ws + WS_TOKSLOT); const unsigned char* Y = F.ws + WS_Y;
    bf16* H = (bf16*)(F.ws + WS_H); float* logf = (float*)(F.ws + WS_LOGF); float* gsum = (float*)(F.ws + WS_GSUM);
    LAS f32x4* wl4 = (LAS f32x4*)F.lds; LAS f32x2* wl2 = (LAS f32x2*)(F.lds + 16384); LAS float* part = (LAS float*)(F.lds + 16384 + 8192);
    if (NORM) { for (int k = F.tid; k < DM; k += 512) { const float* wp = F.in[I_WIN] + (size_t)l * DM * D_IN + (size_t)k * D_IN + NPROJ; const int idx = (4 * (k >> 8) + (k & 3)) * 64 + ((k >> 2) & 63);
            wl4[idx] = (f32x4){wp[0], wp[1], wp[2], wp[3]}; wl2[idx] = (f32x2){wp[4], wp[5]}; }
        __syncthreads(); }
    for (int chunk = F.blk; chunk < NTOK / 128; chunk += F.G) {
        const int b = chunk / (SEQ / 128);
        LAS f32x4* mv = (LAS f32x4*)(F.lds + 32768);
        __syncthreads();
        if (F.wave == 0) {
#pragma unroll
            for (int j = 0; j < 4; ++j) { const int c = 256 * j + 4 * F.lane;
                if (COMBINE) mv[(0 * 4 + j) * 64 + F.lane] = mod4(F, l - 1, b, 5, c);
                if (NORM) { const f32x4 g = *(const f32x4*)(F.in[I_N1G] + (size_t)l * DM + c); mv[(1 * 4 + j) * 64 + F.lane] = g * (mod4(F, l, b, 1, c) + 1.0f); mv[(2 * 4 + j) * 64 + F.lane] = mod4(F, l, b, 0, c); } } }
        __syncthreads();
        float lacc = 0.f;
#pragma unroll 1
        for (int rr = 0; rr < 16; rr += 2) {
            const int row = chunk * 128 + F.wave * 16 + rr;
            f32x4 v[2][4];
#pragma unroll
            for (int u = 0; u < 2; ++u)
#pragma unroll
                for (int j = 0; j < 4; ++j) v[u][j] = ld_row4<S16>(xsrc, (size_t)(row + u) * DM + 256 * j + 4 * F.lane);
            int mofs = F.lane; asm volatile("" : "+v"(mofs));
            if (COMBINE) {
#pragma unroll
                for (int u = 0; u < 2; ++u) {
                    f32x4 s[4];
#pragma unroll
                    for (int j = 0; j < 4; ++j) s[j] = (f32x4){0.f, 0.f, 0.f, 0.f};
#pragma unroll
                    for (int k = 0; k < TOPK; ++k) { const float w = topw[(row + u) * 4 + k]; const int slot = tokslot[(row + u) * 4 + k];
#pragma unroll
                        for (int j = 0; j < 4; ++j) s[j] += fp8x4_to_f32(*(const unsigned*)(Y + (size_t)slot * DM + 256 * j + 4 * F.lane)) * w; }
#pragma unroll
                    for (int j = 0; j < 4; ++j) { v[u][j] += mv[(0 * 4 + j) * 64 + mofs] * s[j]; st_row4<D16>(xdst, (size_t)(row + u) * DM + 256 * j + 4 * F.lane, v[u][j]); }
                }
            }
            if (NORM) {
                float ss[2];
#pragma unroll
                for (int u = 0; u < 2; ++u) { float s = 0.f;
#pragma unroll
                    for (int j = 0; j < 4; ++j) s += (v[u][j].x * v[u][j].x + v[u][j].y * v[u][j].y) + (v[u][j].z * v[u][j].z + v[u][j].w * v[u][j].w);
                    ss[u] = s; }
#pragma unroll
                for (int o = 1; o < 32; o <<= 1) { ss[0] += shx(ss[0], o, F.lane); ss[1] += shx(ss[1], o, F.lane); }
                ss[0] = add_other_half(ss[0]); ss[1] = add_other_half(ss[1]);
                float fl[2][6];
                int lofs = F.lane; asm volatile("" : "+v"(lofs));
#pragma unroll
                for (int u = 0; u < 2; ++u) { const float rstd = 1.0f / sqrtf(ss[u] * (1.0f / DM) + EPS);
#pragma unroll
                    for (int q = 0; q < 6; ++q) fl[u][q] = 0.f;
#pragma unroll
                    for (int j = 0; j < 4; ++j) { const f32x4 hv = v[u][j] * rstd * mv[(1 * 4 + j) * 64 + mofs] + mv[(2 * 4 + j) * 64 + mofs];
                        if (P2_FP8) *(unsigned*)((unsigned char*)H + (size_t)(row + u) * DM + 256 * j + 4 * F.lane) = pg8::pk4_fp8(hv.x, hv.y, hv.z, hv.w);
                        else { v2u o; o.x = pk2(hv.x, hv.y); o.y = pk2(hv.z, hv.w); *(v2u*)(H + (size_t)(row + u) * DM + 256 * j + 4 * F.lane) = o; }
#pragma unroll
                        for (int i = 0; i < 4; ++i) { const f32x4 wa = wl4[(4 * j + i) * 64 + lofs]; const f32x2 wb = wl2[(4 * j + i) * 64 + lofs]; const float hx = hv[i];
                            fl[u][0] += hx * wa.x; fl[u][1] += hx * wa.y; fl[u][2] += hx * wa.z; fl[u][3] += hx * wa.w; fl[u][4] += hx * wb.x; fl[u][5] += hx * wb.y; } } }
#pragma unroll
                for (int o = 1; o < 32; o <<= 1)
#pragma unroll
                    for (int u = 0; u < 2; ++u)
#pragma unroll
                        for (int q = 0; q < 6; ++q) fl[u][q] += shx(fl[u][q], o, F.lane);
#pragma unroll
                for (int u = 0; u < 2; ++u)
#pragma unroll
                    for (int q = 0; q < 6; ++q) fl[u][q] = add_other_half(fl[u][q]);
                if (F.lane < 6) {
#pragma unroll
                    for (int u = 0; u < 2; ++u) { float z = fl[u][0];
#pragma unroll
                        for (int q = 1; q < 6; ++q) z = (F.lane == q) ? fl[u][q] : z;
                        z += F.in[I_FXFB][l * 6 + F.lane];
                        const float lg = fminf(z, 0.f) - __logf(1.0f + __expf(-fabsf(z)));
                        logf[(size_t)(row + u) * 6 + F.lane] = lg; lacc += lg; } }
            }
        }
        if (NORM) {
            if (F.lane < 6) part[F.wave * 8 + F.lane] = lacc;
            __syncthreads();
            if (F.tid < 12) { const int g = F.tid / 6, h = F.tid % 6; gsum[(size_t)(chunk * 2 + g) * 6 + h] = (part[(4 * g) * 8 + h] + part[(4 * g + 1) * 8 + h]) + (part[(4 * g + 2) * 8 + h] + part[(4 * g + 3) * 8 + h]); }
            __syncthreads();
        }
    }
    __syncthreads();
}
__device__ __forceinline__ void p3_postproj(Frame& F, int l) {
    bf16* proj = (bf16*)(F.ws + WS_PROJ); bf16* ymix = (bf16*)(F.ws + WS_YMIX);
    const float* ong = F.in[I_ONG] + (size_t)l * DM;
    const int c4 = 4 * F.lane;
    f32x4 cw[3];
#pragma unroll
    for (int w = 0; w < 3; ++w) cw[w] = *(const f32x4*)(F.in[I_CONVW] + (size_t)(l * 3 + w) * 256 + c4);
    const f32x4 cg = *(const f32x4*)(ong + c4);
    const int e0 = 8 * (F.lane & 7);
    float gq[3][8]; int colv[3];
#pragma unroll
    for (int i = 0; i < 3; ++i) { const int vi = 8 * i + (F.lane >> 3); const int ty = vi / 6;
        colv[i] = (vi < 12 ? COL_SQ + 64 * vi : COL_FQ + 64 * (vi - 12)) + e0;
        const float* gp = (ty == 0 ? F.in[I_SBQG] : ty == 1 ? F.in[I_SBKG] : ty == 2 ? F.in[I_FXQG] : F.in[I_FXKG]) + (size_t)l * 64 + e0; const float sc = (ty == 0 || ty == 2) ? QSCALE : 1.0f;
#pragma unroll
        for (int q = 0; q < 8; ++q) gq[i][q] = gp[q] * sc; }
    LAS unsigned char* scr = F.lds + F.wave * (64 * 144);
    for (int tile = F.blk; tile < NTOK / 64; tile += F.G) {
        const int b = tile / (SEQ / 64), s0 = (tile % (SEQ / 64)) * 64; const size_t row0 = (size_t)b * SEQ + s0;
        {
            const int sw0 = s0 + F.wave * 8;
            f32x4 vm2 = (f32x4){0.f, 0.f, 0.f, 0.f}, vm1 = vm2;
            if (sw0 >= 2) {
                const bf16* p2 = proj + ((size_t)b * SEQ + sw0 - 2) * NPROJ; const bf16* p1 = p2 + NPROJ;
                const v2u c2 = *(const v2u*)(p2 + COL_CC + c4), u2 = *(const v2u*)(p2 + COL_CU + c4), c1 = *(const v2u*)(p1 + COL_CC + c4), u1 = *(const v2u*)(p1 + COL_CU + c4);
                vm2 = (f32x4){bflo(c2.x) * bflo(u2.x), bfhi(c2.x) * bfhi(u2.x), bflo(c2.y) * bflo(u2.y), bfhi(c2.y) * bfhi(u2.y)};
                vm1 = (f32x4){bflo(c1.x) * bflo(u1.x), bfhi(c1.x) * bfhi(u1.x), bflo(c1.y) * bflo(u1.y), bfhi(c1.y) * bfhi(u1.y)}; }
#pragma unroll 1
            for (int tt = 0; tt < 8; tt += 2) {
                bf16* pr[2]; v2u cb[2], cc[2], cu[2]; v4u xq[2][3];
#pragma unroll
                for (int u = 0; u < 2; ++u) { pr[u] = proj + ((size_t)b * SEQ + sw0 + tt + u) * NPROJ;
                    cb[u] = *(const v2u*)(pr[u] + COL_CB + c4); cc[u] = *(const v2u*)(pr[u] + COL_CC + c4); cu[u] = *(const v2u*)(pr[u] + COL_CU + c4);
#pragma unroll
                    for (int i = 0; i < 3; ++i) xq[u][i] = *(const v4u*)(pr[u] + colv[i]); }
                f32x4 y[2]; float ss[2], q2[2][3];
#pragma unroll
                for (int u = 0; u < 2; ++u) {
                    const f32x4 v0 = (f32x4){bflo(cc[u].x) * bflo(cu[u].x), bfhi(cc[u].x) * bfhi(cu[u].x), bflo(cc[u].y) * bflo(cu[u].y), bfhi(cc[u].y) * bfhi(cu[u].y)};
                    y[u] = cw[0] * vm2 + cw[1] * vm1 + cw[2] * v0; vm2 = vm1; vm1 = v0;
                    y[u] = y[u] * (f32x4){bflo(cb[u].x), bfhi(cb[u].x), bflo(cb[u].y), bfhi(cb[u].y)};
                    ss[u] = (y[u].x * y[u].x + y[u].y * y[u].y) + (y[u].z * y[u].z + y[u].w * y[u].w);
#pragma unroll
                    for (int i = 0; i < 3; ++i) { const v4u x = xq[u][i]; const float f[8] = {bflo(x.x), bfhi(x.x), bflo(x.y), bfhi(x.y), bflo(x.z), bfhi(x.z), bflo(x.w), bfhi(x.w)};
                        float a = 0.f;
#pragma unroll
                        for (int k = 0; k < 8; ++k) a += f[k] * f[k];
                        q2[u][i] = a; } }
#pragma unroll
                for (int o = 1; o < 16; o <<= 1)
#pragma unroll
                    for (int u = 0; u < 2; ++u) { ss[u] += shx(ss[u], o, F.lane);
                        if (o < 8) {
#pragma unroll
                            for (int i = 0; i < 3; ++i) q2[u][i] += shx(q2[u][i], o, F.lane); } }
#pragma unroll
                for (int u = 0; u < 2; ++u) {
                    const float rinv = 1.0f / sqrtf(ss[u] * (1.0f / 64.0f) + EPS);
                    const f32x4 yo = y[u] * rinv * cg;
                    v2u o; o.x = pk2(yo.x, yo.y); o.y = pk2(yo.z, yo.w); *(v2u*)(ymix + ((size_t)b * SEQ + sw0 + tt + u) * DM + c4) = o;
#pragma unroll
                    for (int i = 0; i < 3; ++i) { const v4u x = xq[u][i]; const float f[8] = {bflo(x.x), bfhi(x.x), bflo(x.y), bfhi(x.y), bflo(x.z), bfhi(x.z), bflo(x.w), bfhi(x.w)};
                        const float ri = 1.0f / sqrtf(q2[u][i] * (1.0f / 64.0f) + EPS);
                        v4u w; w.x = pk2(f[0] * ri * gq[i][0], f[1] * ri * gq[i][1]); w.y = pk2(f[2] * ri * gq[i][2], f[3] * ri * gq[i][3]);
                        w.z = pk2(f[4] * ri * gq[i][4], f[5] * ri * gq[i][5]); w.w = pk2(f[6] * ri * gq[i][6], f[7] * ri * gq[i][7]);
                        *(v4u*)(pr[u] + colv[i]) = w; } }
            }
        }
        for (int t = F.wave; t < 12; t += 8) {
            const int kind = t / 6, h = t % 6; const int col = (kind ? COL_FV : COL_SV) + 64 * h;
            const bf16* src = proj + (row0 + F.lane) * NPROJ + col;
#pragma unroll
            for (int pc = 0; pc < 8; ++pc) { const v4u x = *(const v4u*)(src + 8 * pc);
                const unsigned xs[4] = {x.x, x.y, x.z, x.w};
#pragma unroll
                for (int q = 0; q < 4; ++q) { *(LAS unsigned short*)(scr + (8 * pc + 2 * q) * 144 + 2 * F.lane) = (unsigned short)(xs[q] & 0xffffu);
                                              *(LAS unsigned short*)(scr + (8 * pc + 2 * q + 1) * 144 + 2 * F.lane) = (unsigned short)(xs[q] >> 16); } }
            asm volatile("s_waitcnt lgkmcnt(0)" ::: "memory");
            bf16* dst = (bf16*)(F.ws + WS_VT) + (size_t)kind * (48 * 64 * SEQ) + ((size_t)(b * 6 + h) * 64 + F.lane) * SEQ + s0;
#pragma unroll
            for (int pc = 0; pc < 8; ++pc) *(v4u*)(dst + 8 * pc) = *(const LAS v4u*)(scr + F.lane * 144 + 16 * pc);
            asm volatile("s_waitcnt lgkmcnt(0)" ::: "memory");
        }
        if (F.wave == 7) { const int gt = tile % (SEQ / 64); const float* gs = (const float*)(F.ws + WS_GSUM) + (size_t)(b * (SEQ / 64)) * 6; const float* lf = (const float*)(F.ws + WS_LOGF) + (row0 + F.lane) * 6;
            float* fo = (float*)(F.ws + WS_FCUM) + (size_t)(b * 6) * SEQ + s0 + F.lane;
#pragma unroll
            for (int h = 0; h < 6; ++h) { float base = (F.lane < gt) ? gs[F.lane * 6 + h] : 0.f; base = wave_sum(base, F.lane);
                float inc = lf[h];
#pragma unroll
                for (int o = 1; o < 64; o <<= 1) { const float t = shup(inc, o, F.lane); if (F.lane >= o) inc += t; }
                fo[(size_t)h * SEQ] = (base + inc) * LOG2E; } }
    }
}

__device__ __forceinline__ void p4_attention(Frame& F, int l) {
    att::Tensors Ts, Tf;
    Ts.proj = (const bf16*)(F.ws + WS_PROJ); Ts.vt = (const bf16*)(F.ws + WS_VT); Ts.fcum = (const float*)(F.ws + WS_FCUM); Ts.ymix = (bf16*)(F.ws + WS_YMIX); Ts.ong = F.in[I_ONG] + (size_t)l * DM;
    Ts.colq = COL_SQ; Ts.colk = COL_SK; Ts.coly = 256; Ts.tprobe = (void*)(F.ws + WS_CTL + 512);
    Tf = Ts; Tf.vt = Ts.vt + (size_t)48 * 64 * SEQ; Tf.colq = COL_FQ; Tf.colk = COL_FK; Tf.coly = 640;
    {
        float gq = fabsf(F.in[I_FXQG][l * 64 + F.lane]), gk = fabsf(F.in[I_FXKG][l * 64 + F.lane]);
#pragma unroll
        for (int o = 1; o < 32; o <<= 1) { gq = fmaxf(gq, shx(gq, o, F.lane)); gk = fmaxf(gk, shx(gk, o, F.lane)); }
        { auto rq = __builtin_amdgcn_permlane32_swap(__float_as_uint(gq), __float_as_uint(gq), false, false); gq = fmaxf(__uint_as_float(rq[0]), __uint_as_float(rq[1]));
          auto rk = __builtin_amdgcn_permlane32_swap(__float_as_uint(gk), __float_as_uint(gk), false, false); gk = fmaxf(__uint_as_float(rk[0]), __uint_as_float(rk[1])); }
        Tf.z2max = 64.0f * gq * gk * QSCALE * 1.02f; Ts.z2max = 0.f;
    }
    const int NU = 48 * 16;
    for (int i = 0; i * F.G < NU; ++i) {
        const int L = (i & 1) ? (i + 1) * F.G - 1 - F.blk : i * F.G + F.blk;
        if (L >= NU) continue;
        const int qb = 15 - L / 48, bh = L % 48;
#if defined(ATT_HYB) && (ATT_HYB & 1)
        { att_old::Tensors To; To.proj = Ts.proj; To.ymix = Ts.ymix; To.ong = Ts.ong; To.fcum = Ts.fcum; To.vt = Ts.vt; To.colq = Ts.colq; To.colk = Ts.colk; To.coly = Ts.coly; att_old::unit<0>(To, bh / 6, bh % 6, qb, F.lds, F.wave); }
#else
        att::unit<0>(Ts, bh / 6, bh % 6, qb, F.lds, F.wave);
#endif
    }
    for (int i = 0; i * F.G < NU; ++i) {
        const int L = (i & 1) ? (i + 1) * F.G - 1 - F.blk : i * F.G + F.blk;
        if (L >= NU) continue;
        const int qb = 15 - L / 48, bh = L % 48;
#if defined(ATT_HYB) && (ATT_HYB & 2)
        { att_old::Tensors To; To.proj = Tf.proj; To.ymix = Tf.ymix; To.ong = Tf.ong; To.fcum = Tf.fcum; To.vt = Tf.vt; To.colq = Tf.colq; To.colk = Tf.colk; To.coly = Tf.coly; att_old::unit<1>(To, bh / 6, bh % 6, qb, F.lds, F.wave); }
#else
        att::unit<1>(Tf, bh / 6, bh % 6, qb, F.lds, F.wave);
#endif
    }
}

__device__ __forceinline__ void top4of8(const float (&v)[8], const int (&ix)[8], float (&tv)[4], int (&ti)[4]) {
    float w[8];
#pragma unroll
    for (int j = 0; j < 8; ++j) w[j] = v[j];
#pragma unroll
    for (int k = 0; k < 4; ++k) { float bv = w[0]; int bi = ix[0];
#pragma unroll
        for (int j = 1; j < 8; ++j) { const bool t = (w[j] > bv) || (w[j] == bv && ix[j] < bi); bv = t ? w[j] : bv; bi = t ? ix[j] : bi; }
        tv[k] = bv; ti[k] = bi;
#pragma unroll
        for (int j = 0; j < 8; ++j) w[j] = (ix[j] == bi) ? -INFINITY : w[j]; }
}
__device__ __forceinline__ void p6_norm_router(Frame& F, int l, const bf16* x1) {
    bf16* H = (bf16*)(F.ws + WS_H); unsigned char* H8 = F.ws + WS_H8; float* topw = (float*)(F.ws + WS_TOPW); int* route = (int*)(F.ws + WS_ROUTE); int* hist = (int*)(F.ws + WS_HIST);
    const float* rw = F.in[I_RW] + (size_t)l * DM * NEXP; const float* rb = F.in[I_RB] + (size_t)l * NEXP;
#ifdef P6SEG
    unsigned long long sg_acc = 0ull, sg_t = __builtin_readcyclecounter();
#define SEG(n) do { const unsigned long long t_ = __builtin_readcyclecounter(); if ((n) == P6SEG) sg_acc += t_ - sg_t; sg_t = t_; asm volatile("" :: "s"(t_)); } while (0)
#else
#define SEG(n) do {} while (0)
#endif
    constexpr int RWP = 2064;
    LAS unsigned char* rwt = F.lds;
    LAS int* cnt = (LAS int*)(F.lds + MISC_OFF + 256);
    {
        f32x4 t[16];
#pragma unroll
        for (int i = 0; i < 16; ++i) t[i] = *(const f32x4*)(rw + (size_t)(2 * F.tid) * NEXP + 4 * i);
#pragma unroll
        for (int i = 0; i < 8; ++i)
#pragma unroll
            for (int c = 0; c < 4; ++c) *(LAS unsigned*)(rwt + (4 * i + c) * RWP + 4 * F.tid) = f2bf(t[i][c]) | (f2bf(t[8 + i][c]) << 16);
    }
    __syncthreads();
    SEG(0);
    const int fr = F.lane & 15, fq = F.lane >> 4;
    float rbv[8]; int eix[8];
#pragma unroll
    for (int i = 0; i < 4; ++i) { eix[i] = 4 * fq + i; eix[4 + i] = 16 + 4 * fq + i; rbv[i] = rb[4 * fq + i]; rbv[4 + i] = rb[16 + 4 * fq + i]; }
    for (int chunk = F.blk; chunk < NTOK / 128; chunk += F.G) {
        const int b = chunk / (SEQ / 128);
        if (F.tid < 32) cnt[F.tid] = 0;
        __syncthreads();
        f32x4 A[4], Bv[4];
#pragma unroll
        for (int j = 0; j < 4; ++j) { const int c = 256 * j + 4 * F.lane; const f32x4 g = *(const f32x4*)(F.in[I_N2G] + (size_t)l * DM + c); A[j] = g * (mod4(F, l, b, 4, c) + 1.0f); Bv[j] = mod4(F, l, b, 3, c); }
        const int row0 = chunk * 128 + F.wave * 16;
        SEG(1);
#pragma unroll 1
        for (int rr = 0; rr < 16; rr += 4) {
            f32x4 v[4][4]; float ss[4];
#pragma unroll
            for (int u = 0; u < 4; ++u)
#pragma unroll
                for (int j = 0; j < 4; ++j) v[u][j] = ld_row4<true>(x1, (size_t)(row0 + rr + u) * DM + 256 * j + 4 * F.lane);
#pragma unroll
            for (int u = 0; u < 4; ++u) { float s = 0.f;
#pragma unroll
                for (int j = 0; j < 4; ++j) s += (v[u][j].x * v[u][j].x + v[u][j].y * v[u][j].y) + (v[u][j].z * v[u][j].z + v[u][j].w * v[u][j].w);
                ss[u] = s; }
#pragma unroll
            for (int o = 1; o < 32; o <<= 1) { ss[0] += shx(ss[0], o, F.lane); ss[1] += shx(ss[1], o, F.lane); ss[2] += shx(ss[2], o, F.lane); ss[3] += shx(ss[3], o, F.lane); }
            ss[0] = add_other_half(ss[0]); ss[1] = add_other_half(ss[1]); ss[2] = add_other_half(ss[2]); ss[3] = add_other_half(ss[3]);
#pragma unroll
            for (int u = 0; u < 4; ++u) { const float rstd = 1.0f / sqrtf(ss[u] * (1.0f / DM) + EPS);
#pragma unroll
                for (int j = 0; j < 4; ++j) { const f32x4 hv = v[u][j] * rstd * A[j] + Bv[j];
                    v2u o; o.x = pk2(hv.x, hv.y); o.y = pk2(hv.z, hv.w); *(v2u*)(H + (size_t)(row0 + rr + u) * DM + 256 * j + 4 * F.lane) = o;
                    *(unsigned*)(H8 + (size_t)(row0 + rr + u) * DM + 256 * j + 4 * F.lane) = pg8::pk4_fp8(hv.x, hv.y, hv.z, hv.w); } }
        }
        SEG(2);
        asm volatile("s_waitcnt vmcnt(0)" ::: "memory");
        f32x4 acc0 = (f32x4){0.f, 0.f, 0.f, 0.f}, acc1 = (f32x4){0.f, 0.f, 0.f, 0.f};
        { const bf16* hp = H + (size_t)(row0 + fr) * DM + 8 * fq; const LAS unsigned char* wp = rwt + fr * RWP + 16 * fq;
#pragma unroll 8
          for (int s = 0; s < 32; ++s) { const v4u hb = __builtin_nontemporal_load((const v4u*)(hp + 32 * s));
              const bf16x8 a0 = *(const LAS bf16x8*)(wp + 64 * s), a1 = *(const LAS bf16x8*)(wp + 16 * RWP + 64 * s);
              acc0 = __builtin_amdgcn_mfma_f32_16x16x32_bf16(a0, __builtin_bit_cast(bf16x8, hb), acc0, 0, 0, 0);
              acc1 = __builtin_amdgcn_mfma_f32_16x16x32_bf16(a1, __builtin_bit_cast(bf16x8, hb), acc1, 0, 0, 0); } }
        SEG(3);
        float cv[8], tv[4], ov[8]; int ti[4], oi[8];
#pragma unroll
        for (int i = 0; i < 4; ++i) { cv[i] = acc0[i] + rbv[i]; cv[4 + i] = acc1[i] + rbv[4 + i]; }
        top4of8(cv, eix, tv, ti);
        {
#pragma unroll
            for (int k = 0; k < 4; ++k) { ov[k] = tv[k]; oi[k] = ti[k]; ov[4 + k] = shx(tv[k], 16, F.lane); oi[4 + k] = shxi(ti[k], 16, F.lane); }
            top4of8(ov, oi, tv, ti);
#pragma unroll
            for (int k = 0; k < 4; ++k) { auto rv = __builtin_amdgcn_permlane32_swap(__float_as_uint(tv[k]), __float_as_uint(tv[k]), false, false); auto ri = __builtin_amdgcn_permlane32_swap((unsigned)ti[k], (unsigned)ti[k], false, false);
                ov[k] = __uint_as_float(rv[0]); oi[k] = (int)ri[0]; ov[4 + k] = __uint_as_float(rv[1]); oi[4 + k] = (int)ri[1]; }
            top4of8(ov, oi, tv, ti); }
        const float e1 = __expf(tv[1] - tv[0]), e2 = __expf(tv[2] - tv[0]), e3 = __expf(tv[3] - tv[0]); const float inv = 1.0f / (1.0f + e1 + e2 + e3);
        { const int row = row0 + fr, k = fq;
          const float w = (k == 0 ? 1.0f : k == 1 ? e1 : k == 2 ? e2 : e3) * inv; const int ex = (k == 0 ? ti[0] : k == 1 ? ti[1] : k == 2 ? ti[2] : ti[3]);
          const int pos = __hip_atomic_fetch_add(cnt + ex, 1, __ATOMIC_RELAXED, __HIP_MEMORY_SCOPE_WORKGROUP);
          topw[row * 4 + k] = w; route[row * 4 + k] = ex + 32 * pos; }
        SEG(4);
        __syncthreads();
        if (F.tid < 32) hist[chunk * 32 + F.tid] = cnt[F.tid];
        __syncthreads();
        SEG(5);
    }
#ifdef P6SEG
    if (F.blk == 0 && F.tid == 0) atomicAdd((unsigned long long*)(F.ws + WS_CTL + 512), sg_acc);
#endif
}

__device__ __forceinline__ void p7_scatter(Frame& F) {
    const int* hist = (const int*)(F.ws + WS_HIST); const int* route = (const int*)(F.ws + WS_ROUTE);
    int* tokslot = (int*)(F.ws + WS_TOKSLOT); int* slottok = (int*)(F.ws + WS_SLOTTOK); int* moetab = (int*)(F.ws + WS_MOETAB);
    LAS int* pre = (LAS int*)F.lds;
    LAS int* base = (LAS int*)(F.lds + 32768);
    for (int i = F.tid; i < 256 * 32; i += 512) pre[i] = hist[i];
    __syncthreads();
    if (F.tid < 32) { int run = 0;
        for (int c = 0; c < 256; ++c) { const int v = pre[c * 32 + F.tid]; pre[c * 32 + F.tid] = run; run += v; }
        base[64 + F.tid] = run; }
    __syncthreads();
    if (F.tid == 0) { int run = 0; for (int ex = 0; ex < NEXP; ++ex) { base[ex] = run; run += (base[64 + ex] + 255) & ~255; } base[NEXP] = run; }
    __syncthreads();
    if (F.blk == 0 && F.tid <= NEXP) moetab[F.tid] = base[F.tid] >> 8;
    for (int chunk = F.blk; chunk < NTOK / 128; chunk += F.G) {
        const int t = chunk * 128 + (F.tid >> 2), k = F.tid & 3; const int rt = route[t * 4 + k]; const int ex = rt & 31, pos = rt >> 5;
        const int slot = base[ex] + pre[chunk * 32 + ex] + pos;
        tokslot[t * 4 + k] = slot; slottok[slot] = t;
    }
    for (int ex = F.blk; ex < NEXP; ex += F.G) { const int lo = base[ex] + base[64 + ex], hi = base[ex + 1]; for (int s = lo + F.tid; s < hi; s += 512) slottok[s] = 0; }
    __syncthreads();
}

struct Args { const float* in[21]; float* out; unsigned char* ws; int ph_lo, ph_hi; };
__device__ __forceinline__ void launder(Frame& F, int wave) {
#if 0
    int t = threadIdx.x; asm volatile("" : "+v"(t)); F.tid = t; F.lane = t & 63; F.wave = __builtin_amdgcn_readfirstlane(t >> 6); (void)wave;
#else
    int t = lane_id(); asm volatile("" : "+v"(t)); F.lane = t & 63; F.wave = wave; F.tid = wave * 64 + F.lane;
#endif
    const __attribute__((address_space(4))) Args* ap = (const __attribute__((address_space(4))) Args*)__builtin_amdgcn_kernarg_segment_ptr(); asm volatile("" : "+s"(ap));
#pragma unroll
    for (int i = 0; i < 21; ++i) F.in[i] = ap->in[i];
    F.out = ap->out; F.ws = ap->ws; }
constexpr int N_PHASES = 1 + 9 * NLAYER + 1;

#define PHASE_FN __device__ __forceinline__
__device__ __forceinline__ void make_frame(Frame& F, LAS unsigned char* lds, int wave) { F.lds = lds; int bk = blockIdx.x, gd = gridDim.x; asm volatile("" : "+s"(bk), "+s"(gd)); F.blk = bk; F.G = gd; launder(F, wave); }
PHASE_FN void ph_prologue(LAS unsigned char* lds, int wave) { Frame F; make_frame(F, lds, wave); p0_prologue(F); }
PHASE_FN void ph_norm1(LAS unsigned char* lds, int wave, int l) { Frame F; make_frame(F, lds, wave);
    if (l == 0) row_phase<false, true, false, false>(F, 0, F.in[I_X], nullptr); else row_phase<true, true, true, true>(F, l, F.ws + WS_XA, F.ws + WS_XB); }
PHASE_FN void ph_proj(LAS unsigned char* lds, int wave, int l) { Frame F; make_frame(F, lds, wave);
    pg8::Gemm g{(const bf16*)(F.ws + WS_H), (const bf16*)(F.ws + WS_WIN + (size_t)l * NPROJ * DM * (P2_FP8 ? 1 : 2)), nullptr, P2_FP8 ? DM / 2 : DM};
    pg8::StaticOrder S; S.init(NTOK, NPROJ, F.G, F.blk);
    pg8::EpiProj E{(bf16*)(F.ws + WS_PROJ), NPROJ};
    pg8::gemm_phase<pg8::EpiProj, pg8::StaticOrder, false, P2_FP8 != 0>(F.lds, g, S, E, F.wave); }
PHASE_FN void ph_postproj(LAS unsigned char* lds, int wave, int l) { Frame F; make_frame(F, lds, wave); p3_postproj(F, l); }
PHASE_FN void ph_attn(LAS unsigned char* lds, int wave, int l) { Frame F; make_frame(F, lds, wave); p4_attention(F, l); }
PHASE_FN void ph_out(LAS unsigned char* lds, int wave, int l) { Frame F; make_frame(F, lds, wave);
    pg8::Gemm g{(const bf16*)(F.ws + WS_YMIX), (const bf16*)(F.ws + WS_WOUT) + (size_t)l * DM * DM, nullptr, DM};
    pg8::StaticOrder S; S.init(NTOK, DM, F.G, F.blk);
    const float* gb = F.in[I_BADA] + (size_t)l * 6144 + 2 * DM; const float* gp = (const float*)(F.ws + WS_MODP) + (size_t)l * 4 * NB * 6144 + 2 * DM;
    if (l == 0) { pg8::EpiResGate<false> E{F.in[I_X], (bf16*)(F.ws + WS_XA), gb, gp}; pg8::gemm_phase<pg8::EpiResGate<false>, pg8::StaticOrder, false>(F.lds, g, S, E, F.wave); }
    else { pg8::EpiResGate<true> E{F.ws + WS_XB, (bf16*)(F.ws + WS_XA), gb, gp}; pg8::gemm_phase<pg8::EpiResGate<true>, pg8::StaticOrder, false>(F.lds, g, S, E, F.wave); } }
PHASE_FN void ph_router(LAS unsigned char* lds, int wave, int l) { Frame F; make_frame(F, lds, wave); p6_norm_router(F, l, (const bf16*)(F.ws + WS_XA)); }
PHASE_FN void ph_scatter(LAS unsigned char* lds, int wave) { Frame F; make_frame(F, lds, wave); p7_scatter(F); }
__device__ __forceinline__ LAS int* moe_table(Frame& F) { LAS int* tb = (LAS int*)(F.lds + MISC_OFF + 64);
    if (F.tid <= NEXP) tb[F.tid] = ((const int*)(F.ws + WS_MOETAB))[F.tid];
    __syncthreads(); return tb; }
PHASE_FN void ph_moe_up(LAS unsigned char* lds, int wave, int l) { Frame F; make_frame(F, lds, wave); LAS int* tb = moe_table(F);
    pg8::Gemm g{(const bf16*)(F.ws + WS_H8), (const bf16*)(F.ws + WS_W1 + (size_t)l * NEXP * 2048 * DM), (const int*)(F.ws + WS_SLOTTOK), DM / 2};
    pg8::MoeOrder S; S.init(tb, 8, F.G, F.blk);
    pg8::EpiSwiglu8 E{F.ws + WS_ACT, F.in[I_B1] + (size_t)l * NEXP * 2048};
    pg8::gemm_phase<pg8::EpiSwiglu8, pg8::MoeOrder, true, true>(F.lds, g, S, E, F.wave); }
struct EpiNull { static constexpr bool PERM = true;
    __device__ __forceinline__ void init(f32x4 (&acc)[2][2][4][2], const pg8::Unit&, int, int, int, int) const {
#pragma unroll
        for (int a = 0; a < 2; ++a)
#pragma unroll
            for (int b = 0; b < 2; ++b)
#pragma unroll
                for (int m = 0; m < 4; ++m)
#pragma unroll
                    for (int n = 0; n < 2; ++n) acc[a][b][m][n] = (f32x4){0.f, 0.f, 0.f, 0.f}; }
    __device__ __forceinline__ void operator()(const f32x4 (&acc)[2][2][4][2], const pg8::Unit& u, int wr, int wc, int fr, int fq) const { float s = 0.f;
#pragma unroll
    for (int a = 0; a < 2; ++a)
#pragma unroll
        for (int b = 0; b < 2; ++b)
#pragma unroll
            for (int m = 0; m < 4; ++m)
#pragma unroll
                for (int n = 0; n < 2; ++n) s += acc[a][b][m][n][0] + acc[a][b][m][n][1] + acc[a][b][m][n][2] + acc[a][b][m][n][3];
    asm volatile("" :: "v"(s)); } };
PHASE_FN void ph_moe_down_nostore(LAS unsigned char* lds, int wave, int l) { Frame F; make_frame(F, lds, wave); LAS int* tb = moe_table(F);
    pg8::Gemm g{(const bf16*)(F.ws + WS_ACT), (const bf16*)(F.ws + WS_W2 + (size_t)l * NEXP * DM * DM), nullptr, DM / 2};
    pg8::MoeOrder S; S.init(tb, 4, F.G, F.blk);
#if EXP_NOSTORE == 2
    pg8::EpiY E{F.ws + WS_PROJ, nullptr};
    pg8::gemm_phase<pg8::EpiY, pg8::MoeOrder, false, true>(F.lds, g, S, E, F.wave); }
#else
    EpiNull E;
    pg8::gemm_phase<EpiNull, pg8::MoeOrder, false, true>(F.lds, g, S, E, F.wave); }
#endif
PHASE_FN void ph_moe_down(LAS unsigned char* lds, int wave, int l) { Frame F; make_frame(F, lds, wave); LAS int* tb = moe_table(F);
    pg8::Gemm g{(const bf16*)(F.ws + WS_ACT), (const bf16*)(F.ws + WS_W2 + (size_t)l * NEXP * DM * DM), nullptr, DM / 2, (void*)(F.ws + WS_CTL + 512)};
    pg8::MoeOrder S; S.init(tb, 4, F.G, F.blk);
    pg8::EpiY E{F.ws + WS_Y, F.in[I_B2] + (size_t)l * NEXP * DM};
    pg8::gemm_phase<pg8::EpiY, pg8::MoeOrder, false, true>(F.lds, g, S, E, F.wave); }
PHASE_FN void ph_final(LAS unsigned char* lds, int wave) { Frame F; make_frame(F, lds, wave); row_phase<true, false, true, false>(F, NLAYER, F.ws + WS_XA, F.out); }

#ifndef REP_MASK
#define REP_MASK 0
#endif
#ifndef MK_SPLIT
#define MK_SPLIT 0
#endif
#if !MK_SPLIT
__global__ void __launch_bounds__(512, 2) fwd_kernel(Args args) {
    extern __shared__ __attribute__((aligned(16))) unsigned char lds_raw[];
    LAS unsigned char* lds = (LAS unsigned char*)lds_raw;
    volatile LAS unsigned* MISC = (volatile LAS unsigned*)(lds + MISC_OFF);
    if (threadIdx.x < 16) MISC[threadIdx.x] = 0u;
    const int wave = __builtin_amdgcn_readfirstlane(threadIdx.x >> 6);
    __syncthreads();
    const XcdBarrier bar = xcd_barrier_post((unsigned*)(args.ws + WS_CTL) + CW_BAR, MISC, wave);
#define IN(k) true
#define SEAM(k) xcd_barrier(bar)
#define REPS(j) for (int rep_ = 0; rep_ < (((REP_MASK >> (j)) & 1) ? 2 : 1); ++rep_)
#ifdef PT_SEL
    unsigned long long pt_acc = 0ull, pt_t0 = 0ull;
#define PT_BEGIN(j) do { if ((j) == PT_SEL) pt_t0 = __builtin_amdgcn_s_memrealtime(); } while (0)
#define PT_END(j) do { if ((j) == PT_SEL) { const unsigned long long t1_ = __builtin_amdgcn_s_memrealtime(); pt_acc += t1_ - pt_t0; } } while (0)
#else
#define PT_BEGIN(j) do {} while (0)
#define PT_END(j) do {} while (0)
#endif
    if (IN(0)) { REPS(0) { PT_BEGIN(0); ph_prologue(lds, wave); SEAM(0); PT_END(0); } }
    for (int l = 0; l < NLAYER; ++l) {
        const int p = 1 + 9 * l;
        if (IN(p + 0)) { REPS(1) { PT_BEGIN(1); ph_norm1(lds, wave, l); SEAM(p + 0); PT_END(1); } }
        if (IN(p + 1)) { REPS(2) { PT_BEGIN(2); ph_proj(lds, wave, l); SEAM(p + 1); PT_END(2); } }
        if (IN(p + 2)) { PT_BEGIN(3); ph_postproj(lds, wave, l); SEAM(p + 2); PT_END(3); }
        if (IN(p + 3)) { REPS(4) { PT_BEGIN(4); ph_attn(lds, wave, l); SEAM(p + 3); PT_END(4); } }
        if (IN(p + 4)) { REPS(5) { PT_BEGIN(5); ph_out(lds, wave, l); SEAM(p + 4); PT_END(5); } }
        if (IN(p + 5)) { REPS(6) { PT_BEGIN(6); ph_router(lds, wave, l); SEAM(p + 5); PT_END(6); } }
        if (IN(p + 6)) { REPS(7) { PT_BEGIN(7); ph_scatter(lds, wave); SEAM(p + 6); PT_END(7); } }
        if (IN(p + 7)) { REPS(8) { PT_BEGIN(8); ph_moe_up(lds, wave, l); SEAM(p + 7); PT_END(8); } }
        if (IN(p + 8)) { REPS(9) { PT_BEGIN(9); ph_moe_down(lds, wave, l); SEAM(p + 8); PT_END(9); } }
    }
    if (IN(N_PHASES - 1)) { REPS(10) { PT_BEGIN(10); ph_final(lds, wave); PT_END(10); } }
#ifdef PT_SEL
    if (blockIdx.x == 0 && wave == 0 && lane_id() == 0) { const unsigned long long t0_ = __builtin_amdgcn_s_memrealtime(); while (__builtin_amdgcn_s_memrealtime() - t0_ < pt_acc * PT_K) __builtin_amdgcn_s_sleep(8); }
#endif
#ifdef P6SEG
    if (blockIdx.x == 0 && wave == 0 && lane_id() == 0) { __builtin_amdgcn_s_waitcnt(0);
        const unsigned long long acc = __hip_atomic_load((unsigned long long*)(args.ws + WS_CTL + 512), __ATOMIC_RELAXED, __HIP_MEMORY_SCOPE_AGENT) * 4ull;
        const unsigned long long t0 = __builtin_readcyclecounter(); while (__builtin_readcyclecounter() - t0 < acc) __builtin_amdgcn_s_sleep(4); }
#endif
#ifdef TPG
    if (blockIdx.x == 3 && wave == 0 && lane_id() == 0) { __builtin_amdgcn_s_waitcnt(0);
        const unsigned long long acc = __hip_atomic_load((unsigned long long*)(args.ws + WS_CTL + 512), __ATOMIC_RELAXED, __HIP_MEMORY_SCOPE_AGENT) * ((TPG == 1) ? 1ull : 100000ull);
        const unsigned long long t0 = __builtin_readcyclecounter(); while (__builtin_readcyclecounter() - t0 < acc) __builtin_amdgcn_s_sleep(4); }
#endif
#ifdef TPROBE
    if (blockIdx.x == TPROBE_BLK && wave == 0 && lane_id() == 0) {
        __builtin_amdgcn_s_waitcnt(0);
        const unsigned long long acc = __hip_atomic_load((unsigned long long*)(args.ws + WS_CTL + 512), __ATOMIC_RELAXED, __HIP_MEMORY_SCOPE_AGENT) * TPROBE_K;
        const unsigned long long t0 = __builtin_readcyclecounter();
        while (__builtin_readcyclecounter() - t0 < acc) __builtin_amdgcn_s_sleep(4);
    }
#endif
#if defined(UBENCH) && UBENCH >= 4
    {
        f32x4 c[16]; v8i a8, b8; bf16x8 a4, b4;
#pragma unroll
        for (int i = 0; i < 16; ++i) c[i] = (f32x4){0.f, 0.f, 0.f, 0.f};
#pragma unroll
        for (int i = 0; i < 8; ++i) { a8[i] = 0x38383838; b8[i] = 0x38383838; a4[i] = 0x3c00; b4[i] = 0x3c00; }
        const int sw = 0x7F7F7F7F;
        for (int it = 0; it < UBENCH_ITERS; ++it) {
#pragma unroll
            for (int i = 0; i < 16; ++i) {
#if UBENCH == 4
                asm volatile("v_mfma_scale_f32_16x16x128_f8f6f4 %0, %1, %2, %0, %3, %4 op_sel_hi:[0,0,0]" : "+v"(c[i]) : "v"(a8), "v"(b8), "v"(sw), "v"(sw));
#else
                c[i] = __builtin_amdgcn_mfma_f32_16x16x32_bf16(a4, b4, c[i], 0, 0, 0);
#endif
            }
        }
        float s = 0.f;
#pragma unroll
        for (int i = 0; i < 16; ++i) s += c[i][0];
        if (s == 123.456f) ((float*)(args.ws + WS_GSUM + 14000))[0] = s;
    }
#elif defined(UBENCH)
    {
        float v[32];
#pragma unroll
        for (int i = 0; i < 32; ++i) v[i] = (float)(lane_id() + i) * 1e-3f;
        for (int it = 0; it < UBENCH_ITERS; ++it) {
#pragma unroll
            for (int i = 0; i < 32; ++i) {
#if UBENCH == 1
                v[i] = __builtin_amdgcn_exp2f(v[i]);
#elif UBENCH == 2
                v[i] = v[i] * 1.0001f + 0.5f;
#elif UBENCH == 3
                v[i] = __builtin_amdgcn_logf(v[i]);
#endif
            }
            asm volatile("" ::: "memory");
        }
        float s = 0.f;
#pragma unroll
        for (int i = 0; i < 32; ++i) s += v[i];
        if (s == 123.456f) ((float*)(args.ws + WS_GSUM + 14000))[0] = s;
    }
#endif
#undef IN
#undef SEAM
#undef REPS
}

#endif
template <int KIND> __global__ void __launch_bounds__(512, 2) phase_kernel(Args args, int l) {
    extern __shared__ __attribute__((aligned(16))) unsigned char lds_raw[];
    LAS unsigned char* lds = (LAS unsigned char*)lds_raw; const int wave = __builtin_amdgcn_readfirstlane(threadIdx.x >> 6);
    if (KIND == 0) ph_prologue(lds, wave); if (KIND == 1) ph_norm1(lds, wave, l); if (KIND == 2) ph_proj(lds, wave, l); if (KIND == 3) ph_postproj(lds, wave, l); if (KIND == 4) ph_attn(lds, wave, l);
    if (KIND == 5) ph_out(lds, wave, l); if (KIND == 6) ph_router(lds, wave, l); if (KIND == 7) ph_scatter(lds, wave); if (KIND == 8) ph_moe_up(lds, wave, l); if (KIND == 9) ph_moe_down(lds, wave, l); if (KIND == 10) ph_final(lds, wave);
#ifdef EXP_NOSTORE
    if (KIND == 11) ph_moe_down_nostore(lds, wave, l);
#endif
}
template <int KIND> static void launch_phase(const Args& a, int l, int grid, hipStream_t stream) {
    static bool attr = false;
    if (!attr) { (void)hipFuncSetAttribute((const void*)phase_kernel<KIND>, hipFuncAttributeMaxDynamicSharedMemorySize, LDS_BYTES); attr = true; }
    for (int rep = 0; rep < (((REP_MASK >> KIND) & 1) ? 2 : 1); ++rep) hipLaunchKernelGGL(phase_kernel<KIND>, dim3(grid), dim3(512), LDS_BYTES, stream, a, l);
}

extern "C" void kernel_launch(void* const* d_in, const int* in_sizes, int n_in, void* d_out, int out_size, void* d_ws, size_t ws_size, hipStream_t stream) {
    static int grid = 0;
    if (grid == 0) {
        if (n_in != 21 || in_sizes[0] != NTOK * DM || out_size != NTOK * DM || ws_size < WS_END) {
            fprintf(stderr, "kernel_launch: unexpected shapes: n_in %d in0 %d out %d ws %zu (need %zu)\n", n_in, n_in > 0 ? in_sizes[0] : -1, out_size, ws_size, (size_t)WS_END); grid = -1; return; }
        int dev = 0, cus = 0, per_cu = 0;
        if (hipGetDevice(&dev) != hipSuccess || hipDeviceGetAttribute(&cus, hipDeviceAttributeMultiprocessorCount, dev) != hipSuccess) { fprintf(stderr, "kernel_launch: device query failed\n"); grid = -1; return; }
#if !MK_SPLIT
        if (hipFuncSetAttribute((const void*)fwd_kernel, hipFuncAttributeMaxDynamicSharedMemorySize, LDS_BYTES) != hipSuccess) { fprintf(stderr, "kernel_launch: hipFuncSetAttribute failed\n"); grid = -1; return; }
        if (hipOccupancyMaxActiveBlocksPerMultiprocessor(&per_cu, (const void*)fwd_kernel, 512, LDS_BYTES) != hipSuccess || per_cu < 1) fprintf(stderr, "kernel_launch: note: occupancy query says %d\n", per_cu);
        (void)hipGetLastError();
#endif
        grid = cus;
    }
    if (grid < 0) return;
    (void)hipMemsetAsync((char*)d_ws + WS_CTL, 0, CTL_ZERO_BYTES, stream);
    Args a{};
    for (int i = 0; i < 21; ++i) a.in[i] = (const float*)d_in[i];
    a.out = (float*)d_out; a.ws = (unsigned char*)d_ws;
#if MK_SPLIT
    a.ph_lo = 0; a.ph_hi = 0;
    launch_phase<0>(a, 0, grid, stream);
    for (int l = 0; l < NLAYER; ++l) { launch_phase<1>(a, l, grid, stream); launch_phase<2>(a, l, grid, stream); launch_phase<3>(a, l, grid, stream); launch_phase<4>(a, l, grid, stream); launch_phase<5>(a, l, grid, stream);
        launch_phase<6>(a, l, grid, stream); launch_phase<7>(a, l, grid, stream); launch_phase<8>(a, l, grid, stream);
#ifdef EXP_NOSTORE
        launch_phase<11>(a, l, grid, stream);
#endif
        launch_phase<9>(a, l, grid, stream); }
    launch_phase<10>(a, 0, grid, stream);
#else
    a.ph_lo = 0; a.ph_hi = N_PHASES; hipLaunchKernelGGL(fwd_kernel, dim3(grid), dim3(512), LDS_BYTES, stream, a);
#endif
}
```

```cpp
#include <hip/hip_runtime.h>
#include <cstdio>
#include <cstdint>

#define GAS __attribute__((address_space(1)))
#define LAS __attribute__((address_space(3)))
typedef unsigned short bf16;
typedef unsigned v4u __attribute__((ext_vector_type(4)));
typedef unsigned v2u __attribute__((ext_vector_type(2)));
typedef float f32x4 __attribute__((ext_vector_type(4)));
typedef float f32x2 __attribute__((ext_vector_type(2)));
typedef float f32x16 __attribute__((ext_vector_type(16)));
typedef short bf16x8 __attribute__((ext_vector_type(8)));
typedef _Float16 f16x8 __attribute__((ext_vector_type(8)));
typedef _Float16 f16x2 __attribute__((ext_vector_type(2)));
typedef int v4i __attribute__((ext_vector_type(4)));
typedef int v8i __attribute__((ext_vector_type(8)));

namespace pg8 {
constexpr int BM = 256, BK = 64, HALF = 128, HTB = HALF * BK * 2  , STAGE_BYTES = 8 * HTB, NXCD = 8, WGM = 8;

__host__ __device__ __forceinline__ int lds_byte(int r, int c) { const int st = (r >> 4) * 2 + (c >> 5), rr = r & 15, cc = c & 31, ob = rr * 64 + cc * 2; return st * 1024 + (ob ^ (((ob >> 9) & 1) << 5)); }
__host__ __device__ __forceinline__ void stage_rc(int b, int& R, int& C) { const int st = b / 1024, sb = b % 1024, swz = sb ^ (((sb >> 9) & 1) << 5); R = (st >> 1) * 16 + swz / 64; C = (st & 1) * 32 + (swz % 64) / 2; }
__host__ __device__ __forceinline__ int perm32(int rho) { const int n = rho >> 4, i = rho & 15; return 8 * (i >> 2) + 4 * n + (i & 3); }

struct Unit { int pm, pn, pb; };
struct Gemm { const bf16* A; const bf16* Bt; const int* rowmap; int K; void* tprobe = nullptr; };

__device__ __forceinline__ unsigned cvt_pk_bf16(float lo, float hi) { unsigned r; asm volatile("v_cvt_pk_bf16_f32 %0, %1, %2" : "=v"(r) : "v"(lo), "v"(hi)); return r; }

template <class Epi, class Sched, bool GATHER, bool FP8 = false>
__device__ __forceinline__ void gemm_phase(LAS unsigned char* lds, const Gemm g, const Sched& S, const Epi& E, int wave) {
    int lane_ = (int)__builtin_amdgcn_mbcnt_hi(~0u, __builtin_amdgcn_mbcnt_lo(~0u, 0u)); asm volatile("" : "+v"(lane_));
    const int wid = wave, lane = lane_, tid = wid * 64 + lane, wr = wid >> 2, wc = wid & 3, fr = lane & 15, fq = lane >> 4;
    const int K = g.K, nt = K / BK;
    unsigned voffA[2], voffB[2]; int RA[2], CA[2];
#pragma unroll
    for (int i = 0; i < 2; ++i) { int R, C; stage_rc(tid * 16 + i * 8192, R, C); const int Rb = Epi::PERM ? ((R & ~31) + perm32(R & 31)) : R; RA[i] = R; CA[i] = C;
        voffA[i] = (unsigned)(R * K + C) * 2u; voffB[i] = (unsigned)(Rb * K + C) * 2u; }
    const size_t kstep = (size_t)(BK * 2);
    const size_t hstep = (size_t)HALF * K * 2;
    const size_t tstep = 2 * hstep;
    const unsigned ldsw = (unsigned)wid * 1024u;
    const int aoff = lds_byte(wr * 64 + fr, fq * 8), boff = lds_byte(wc * 32 + fr, fq * 8);
#define PG8_SA(b, h) (((b) * 2 + (h)) * HTB)
#define PG8_SB(b, h) ((4 + (b) * 2 + (h)) * HTB)
#define PG8_STAGE(bufoff, gbase, voff) do { _Pragma("unroll") for (int _i = 0; _i < 2; ++_i) \
        __builtin_amdgcn_global_load_lds((const unsigned*)((const char*)(gbase) + (voff)[_i]), (LAS unsigned*)(lds + (bufoff) + ldsw + _i * 8192), 16, 0, 0); } while (0)
#define PG8_STAGEA(bufoff, pbase, h, nx) do { if constexpr (GATHER) { _Pragma("unroll") for (int _i = 0; _i < 2; ++_i) \
        __builtin_amdgcn_global_load_lds((const unsigned*)((const char*)(pbase) + ((nx) ? gn[h][_i] : gc[h][_i])), (LAS unsigned*)(lds + (bufoff) + ldsw + _i * 8192), 16, 0, 0); } \
        else { PG8_STAGE(bufoff, (const char*)(pbase) + (h) * hstep, voffA); } } while (0)
#define PG8_LDA(dst, b, h) do { if constexpr (FP8) { _Pragma("unroll") for (int m = 0; m < 4; ++m) dst##8[m] = __builtin_shufflevector(*(const LAS v4i*)(lds + PG8_SA(b, h) + aoff + m * 2048), *(const LAS v4i*)(lds + PG8_SA(b, h) + aoff + m * 2048 + 1024), 0, 1, 2, 3, 4, 5, 6, 7); } \
        else { _Pragma("unroll") for (int m = 0; m < 4; ++m) _Pragma("unroll") for (int k = 0; k < 2; ++k) dst[m][k] = *(const LAS bf16x8*)(lds + PG8_SA(b, h) + aoff + m * 2048 + k * 1024); } } while (0)
#define PG8_LDB(dst, b, h) do { if constexpr (FP8) { _Pragma("unroll") for (int n = 0; n < 2; ++n) dst##8[n] = __builtin_shufflevector(*(const LAS v4i*)(lds + PG8_SB(b, h) + boff + n * 2048), *(const LAS v4i*)(lds + PG8_SB(b, h) + boff + n * 2048 + 1024), 0, 1, 2, 3, 4, 5, 6, 7); } \
        else { _Pragma("unroll") for (int n = 0; n < 2; ++n) _Pragma("unroll") for (int k = 0; k < 2; ++k) dst[n][k] = *(const LAS bf16x8*)(lds + PG8_SB(b, h) + boff + n * 2048 + k * 1024); } } while (0)
#define PG8_MMA(ai, bj, At, Bt) do { __builtin_amdgcn_s_setprio(1); if constexpr (FP8) { _Pragma("unroll") for (int m = 0; m < 4; ++m) _Pragma("unroll") for (int n = 0; n < 2; ++n) \
        asm volatile("v_mfma_scale_f32_16x16x128_f8f6f4 %0, %1, %2, %0, %3, %4 op_sel_hi:[0,0,0]" : "+v"(acc[ai][bj][m][n]) : "v"(Bt##8[n]), "v"(At##8[m]), "v"(sclw), "v"(scla)); } \
        else { _Pragma("unroll") for (int m = 0; m < 4; ++m) _Pragma("unroll") for (int n = 0; n < 2; ++n) _Pragma("unroll") for (int k = 0; k < 2; ++k) \
        acc[ai][bj][m][n] = __builtin_amdgcn_mfma_f32_16x16x32_bf16(Bt[n][k], At[m][k], acc[ai][bj][m][n], 0, 0, 0); } __builtin_amdgcn_s_setprio(0); } while (0)
#define PG8_WAIT_V(n) asm volatile("s_waitcnt vmcnt(" #n ")" ::: "memory")
#define PG8_WAIT_L(n) asm volatile("s_waitcnt lgkmcnt(" #n ")" ::: "memory")
#define PG8_BAR __builtin_amdgcn_s_barrier()
#define PG8_SCHED __builtin_amdgcn_sched_barrier(0)
    Unit cur, nxt; int ui = 0;
    if (!S.next(0, cur)) return;
#ifdef GEMM_STAGGER
    {
        const unsigned long long t0 = __builtin_amdgcn_s_memrealtime(); const unsigned long long d = (unsigned long long)((blockIdx.x >> 3) & 3) * GEMM_STAGGER;
        while (__builtin_amdgcn_s_memrealtime() - t0 < d) __builtin_amdgcn_s_sleep(16);
    }
#endif
    f32x4 acc[2][2][4][2];
    E.init(acc, cur, wr, wc, fr, fq);
    bf16x8 At[4][2], B0[2][2], B1[2][2]; v8i At8[4], B08[2], B18[2];
    const int sclw = 0x7A7A7A7A, scla = 0x7F7F7F7F;
    unsigned gc[2][2], gn[2][2];
    if constexpr (GATHER) {
#pragma unroll
        for (int h = 0; h < 2; ++h)
#pragma unroll
            for (int i = 0; i < 2; ++i) { gc[h][i] = (unsigned)(g.rowmap[cur.pm * BM + h * HALF + RA[i]] * K + CA[i]) * 2u; gn[h][i] = gc[h][i]; }
    } else { gc[0][0] = gc[0][1] = gc[1][0] = gc[1][1] = 0u; gn[0][0] = gn[0][1] = gn[1][0] = gn[1][1] = 0u; }
    const char* cA = GATHER ? (const char*)g.A : (const char*)g.A + (size_t)cur.pm * tstep; const char* cB = (const char*)g.Bt + (size_t)cur.pb * tstep;
    PG8_STAGE(PG8_SB(0, 0), cB, voffB); PG8_STAGE(PG8_SB(0, 1), cB + hstep, voffB); PG8_STAGEA(PG8_SA(0, 0), cA, 0, false); PG8_STAGEA(PG8_SA(0, 1), cA, 1, false);
    if (wr == 1) PG8_BAR;
    PG8_WAIT_V(2); PG8_BAR;
    PG8_STAGE(PG8_SB(1, 0), cB + kstep, voffB); PG8_STAGEA(PG8_SA(1, 0), cA + kstep, 0, false); PG8_STAGE(PG8_SB(1, 1), cB + hstep + kstep, voffB);
    PG8_WAIT_V(6); PG8_BAR;
    for (;;) {
        const bool has_next = S.next(ui + 1, nxt);
        if constexpr (GATHER) { if (has_next) {
#pragma unroll
            for (int h = 0; h < 2; ++h)
#pragma unroll
                for (int i = 0; i < 2; ++i) gn[h][i] = (unsigned)(g.rowmap[nxt.pm * BM + h * HALF + RA[i]] * K + CA[i]) * 2u; } }
        const char* nA = GATHER ? cA : (has_next ? (const char*)g.A + (size_t)nxt.pm * tstep : cA); const char* nB = has_next ? (const char*)g.Bt + (size_t)nxt.pb * tstep : cB;
#ifdef TPG
        const unsigned long long tg0 = __builtin_readcyclecounter();
#endif
        for (int t = 0; t < nt; t += 2) {
            const bool last = (t == nt - 2);
            const char* a1 = cA + (size_t)(t + 1) * kstep;
            const char* a2 = last ? nA : cA + (size_t)(t + 2) * kstep; const char* b2 = last ? nB : cB + (size_t)(t + 2) * kstep;
            const char* a3 = a2 + kstep; const char* b3 = b2 + kstep;
            PG8_LDB(B0, 0, 0); PG8_LDB(B1, 0, 1); PG8_SCHED; PG8_LDA(At, 0, 0); PG8_STAGEA(PG8_SA(1, 1), a1, 1, false);
            PG8_WAIT_V(8); PG8_WAIT_L(0); PG8_BAR; PG8_MMA(0, 0, At, B0); PG8_MMA(0, 1, At, B1); PG8_BAR; PG8_SCHED;
            PG8_LDA(At, 0, 1); PG8_STAGE(PG8_SB(0, 0), b2, voffB); PG8_STAGE(PG8_SB(0, 1), b2 + hstep, voffB); PG8_STAGEA(PG8_SA(0, 0), a2, 0, last);
            PG8_WAIT_V(8); PG8_WAIT_L(0); PG8_BAR; PG8_MMA(1, 0, At, B0); PG8_MMA(1, 1, At, B1); PG8_BAR; PG8_SCHED;
            PG8_LDB(B0, 1, 0); PG8_LDB(B1, 1, 1); PG8_SCHED; PG8_LDA(At, 1, 0); PG8_STAGEA(PG8_SA(0, 1), a2, 1, last);
            PG8_WAIT_V(8); PG8_WAIT_L(0); PG8_BAR; PG8_MMA(0, 0, At, B0); PG8_MMA(0, 1, At, B1); PG8_BAR; PG8_SCHED;
            PG8_LDA(At, 1, 1); PG8_STAGE(PG8_SB(1, 0), b3, voffB); PG8_STAGE(PG8_SB(1, 1), b3 + hstep, voffB); PG8_STAGEA(PG8_SA(1, 0), a3, 0, last);
            PG8_WAIT_V(8); PG8_WAIT_L(0); PG8_BAR; PG8_MMA(1, 0, At, B0); PG8_MMA(1, 1, At, B1); PG8_BAR; PG8_SCHED;
        }
#ifdef TPG
        { const unsigned long long tg1 = __builtin_readcyclecounter(); asm volatile("" :: "s"(tg0), "s"(tg1));
          if (FP8 && !GATHER && blockIdx.x == 3 && tid == 0) atomicAdd((unsigned long long*)g.tprobe, (TPG == 1) ? (tg1 - tg0) : 1ull); }
#endif
        if (wr == 0) PG8_BAR;
        if constexpr (FP8) asm volatile("s_nop 15\n\ts_nop 7" ::: "memory");
        E(acc, cur, wr, wc, fr, fq);
        if (!has_next) break;
        E.init(acc, nxt, wr, wc, fr, fq);
        cur = nxt; cA = nA; cB = nB; ++ui;
        if constexpr (GATHER) {
#pragma unroll
            for (int h = 0; h < 2; ++h)
#pragma unroll
                for (int i = 0; i < 2; ++i) gc[h][i] = gn[h][i]; }
        if (wr == 1) PG8_BAR;
    }
    PG8_WAIT_V(0);
    PG8_BAR;
#undef PG8_SA
#undef PG8_SB
#undef PG8_STAGE
#undef PG8_STAGEA
#undef PG8_LDA
#undef PG8_LDB
#undef PG8_MMA
#undef PG8_WAIT_V
#undef PG8_WAIT_L
#undef PG8_BAR
#undef PG8_SCHED
}
}
constexpr int DM = 1024, NB = 8, SEQ = 4096, NTOK = NB * SEQ, NLAYER = 2;
constexpr int NPROJ = 3072;
constexpr int D_IN = 3078;
constexpr int NEXP = 32, TOPK = 4;
constexpr int NSLOT_MAX = NTOK * TOPK + NEXP * 256;
constexpr int NTILE_MAX = NSLOT_MAX / 256;
constexpr int COL_CB = 0, COL_CC = 256, COL_CU = 512, COL_SQ = 768, COL_SK = 1152, COL_SV = 1536, COL_FQ = 1920, COL_FK = 2304, COL_FV = 2688;
constexpr float EPS = 1e-6f;
constexpr float LOG2E = 1.4426950408889634f;
constexpr float QSCALE = 0.125f * LOG2E;

namespace pg8 {
struct StaticOrder {
    int nM, nN, nwg, G, c;
    __device__ __forceinline__ void init(int M, int N, int G_, int c_) { nM = M / BM; nN = N / BM; nwg = nM * nN; G = G_; c = c_; }
    __device__ __forceinline__ bool next(int i, Unit& u) const {
        const long L = (long)i * G + c; if (L >= nwg) return false;
        int wgid = (int)L; { const int q = nwg / NXCD, r = nwg % NXCD, xcd = wgid % NXCD, off = wgid / NXCD; wgid = (xcd < r ? xcd * (q + 1) : r * (q + 1) + (xcd - r) * q) + off; }
        const int nig = WGM * nN, gid = wgid / nig, fm = gid * WGM, gsz = (nM - fm) < WGM ? (nM - fm) : WGM;
        u.pm = fm + ((wgid % nig) % gsz); u.pn = (wgid % nig) / gsz; u.pb = u.pn; return true;
    }
};
struct MoeOrder {
    int nM, nN, nwg, G, c; const LAS int* tb;
    __device__ __forceinline__ void init(const LAS int* tb_, int nN_, int G_, int c_) { tb = tb_; nM = tb_[NEXP]; nN = nN_; nwg = nM * nN; G = G_; c = c_; }
    __device__ __forceinline__ bool next(int i, Unit& u) const {
        const long L = (long)i * G + c; if (L >= nwg) return false;
        int wgid = (int)L; { const int q = nwg / NXCD, r = nwg % NXCD, xcd = wgid % NXCD, off = wgid / NXCD; wgid = (xcd < r ? xcd * (q + 1) : r * (q + 1) + (xcd - r) * q) + off; }
        const int nig = WGM * nN, gid = wgid / nig, fm = gid * WGM, gsz = (nM - fm) < WGM ? (nM - fm) : WGM;
        u.pm = fm + ((wgid % nig) % gsz); u.pn = (wgid % nig) / gsz;
        int e = 0;
#pragma unroll 1
        for (int j = 1; j < NEXP; ++j) e += (tb[j] <= u.pm) ? 1 : 0;
        u.pb = e * nN + u.pn; return true;
    }
};

struct EpiProj {
    static constexpr bool PERM = true;
    bf16* O; int ldc;
    __device__ __forceinline__ void init(f32x4 (&acc)[2][2][4][2], const Unit&, int, int, int, int) const {
#pragma unroll
        for (int a = 0; a < 2; ++a)
#pragma unroll
            for (int b = 0; b < 2; ++b)
#pragma unroll
                for (int m = 0; m < 4; ++m)
#pragma unroll
                    for (int n = 0; n < 2; ++n) acc[a][b][m][n] = (f32x4){0.f, 0.f, 0.f, 0.f}; }
    __device__ __forceinline__ void operator()(const f32x4 (&acc)[2][2][4][2], const Unit& u, int wr, int wc, int fr, int fq) const {
        const int row0 = u.pm * BM + wr * 64 + fr, col0 = u.pn * BM + wc * 32 + 8 * fq;
#pragma unroll
        for (int ai = 0; ai < 2; ++ai)
#pragma unroll
            for (int m = 0; m < 4; ++m) { bf16* rowp = O + (size_t)(row0 + ai * HALF + m * 16) * ldc + col0;
#pragma unroll
                for (int bj = 0; bj < 2; ++bj) { const f32x4 v0 = acc[ai][bj][m][0], v1 = acc[ai][bj][m][1];
                    v4u w; w.x = cvt_pk_bf16(v0[0], v0[1]); w.y = cvt_pk_bf16(v0[2], v0[3]); w.z = cvt_pk_bf16(v1[0], v1[1]); w.w = cvt_pk_bf16(v1[2], v1[3]);
                    *(v4u*)(rowp + bj * HALF) = w; } }
    }
};
template <bool BASE16> struct EpiResGate {
    static constexpr bool PERM = true;
    const void* base; bf16* out; const float* gbias; const float* gpart;
    __device__ __forceinline__ void init(f32x4 (&acc)[2][2][4][2], const Unit&, int, int, int, int) const {
#pragma unroll
        for (int a = 0; a < 2; ++a)
#pragma unroll
            for (int b = 0; b < 2; ++b)
#pragma unroll
                for (int m = 0; m < 4; ++m)
#pragma unroll
                    for (int n = 0; n < 2; ++n) acc[a][b][m][n] = (f32x4){0.f, 0.f, 0.f, 0.f}; }
    __device__ __forceinline__ void operator()(const f32x4 (&acc)[2][2][4][2], const Unit& u, int wr, int wc, int fr, int fq) const {
        const int row0 = u.pm * BM + wr * 64 + fr, col0 = u.pn * BM + wc * 32 + 8 * fq; const int b = (u.pm * BM) / SEQ;
#pragma unroll
        for (int bj = 0; bj < 2; ++bj) { const int c = col0 + bj * HALF; f32x4 g0 = *(const f32x4*)(gbias + c), g1 = *(const f32x4*)(gbias + c + 4);
#pragma unroll
            for (int ks = 0; ks < 4; ++ks) { g0 += *(const f32x4*)(gpart + (size_t)(ks * NB + b) * 6144 + c); g1 += *(const f32x4*)(gpart + (size_t)(ks * NB + b) * 6144 + c + 4); }
#pragma unroll
            for (int ai = 0; ai < 2; ++ai)
#pragma unroll
                for (int m = 0; m < 4; ++m) { const size_t off = (size_t)(row0 + ai * HALF + m * 16) * DM + c; f32x4 b0, b1;
                    if (BASE16) { const v4u t = *(const v4u*)((const bf16*)base + off); b0 = (f32x4){__builtin_bit_cast(float, t.x << 16), __builtin_bit_cast(float, t.x & 0xffff0000u), __builtin_bit_cast(float, t.y << 16), __builtin_bit_cast(float, t.y & 0xffff0000u)};
                        b1 = (f32x4){__builtin_bit_cast(float, t.z << 16), __builtin_bit_cast(float, t.z & 0xffff0000u), __builtin_bit_cast(float, t.w << 16), __builtin_bit_cast(float, t.w & 0xffff0000u)}; }
                    else { b0 = *(const f32x4*)((const float*)base + off); b1 = *(const f32x4*)((const float*)base + off + 4); }
                    const f32x4 v0 = b0 + g0 * acc[ai][bj][m][0], v1 = b1 + g1 * acc[ai][bj][m][1];
                    v4u w; w.x = cvt_pk_bf16(v0[0], v0[1]); w.y = cvt_pk_bf16(v0[2], v0[3]); w.z = cvt_pk_bf16(v1[0], v1[1]); w.w = cvt_pk_bf16(v1[2], v1[3]);
                    *(v4u*)(out + off) = w; } }
    }
};
struct EpiSwiglu {
    static constexpr bool PERM = true;
    bf16* O; const float* b1;
    __device__ __forceinline__ void init(f32x4 (&acc)[2][2][4][2], const Unit&, int, int, int, int) const {
#pragma unroll
        for (int a = 0; a < 2; ++a)
#pragma unroll
            for (int b = 0; b < 2; ++b)
#pragma unroll
                for (int m = 0; m < 4; ++m)
#pragma unroll
                    for (int n = 0; n < 2; ++n) acc[a][b][m][n] = (f32x4){0.f, 0.f, 0.f, 0.f}; }
    __device__ __forceinline__ void operator()(const f32x4 (&acc)[2][2][4][2], const Unit& u, int wr, int wc, int fr, int fq) const {
        const int row0 = u.pm * BM + wr * 64 + fr; const int e = u.pb >> 3; const int j0 = u.pn * 128 + wc * 32 + 8 * fq;
        const float* bp = b1 + (size_t)e * 2048 + 2 * j0;
        f32x4 bb[4];
#pragma unroll
        for (int q = 0; q < 4; ++q) bb[q] = *(const f32x4*)(bp + 4 * q);
        float bg[8], bl[8];
#pragma unroll
        for (int q = 0; q < 4; ++q) { bg[2 * q] = bb[q][0]; bl[2 * q] = bb[q][1]; bg[2 * q + 1] = bb[q][2]; bl[2 * q + 1] = bb[q][3]; }
#pragma unroll
        for (int ai = 0; ai < 2; ++ai)
#pragma unroll
            for (int m = 0; m < 4; ++m) { bf16* rowp = O + (size_t)(row0 + ai * HALF + m * 16) * DM + j0;
                float a[8];
#pragma unroll
                for (int n = 0; n < 2; ++n)
#pragma unroll
                    for (int i = 0; i < 4; ++i) { float gl = acc[ai][0][m][n][i] + bg[4 * n + i], li = acc[ai][1][m][n][i] + bl[4 * n + i];
                        gl = fminf(gl, 7.0f); li = fminf(fmaxf(li, -7.0f), 7.0f);
                        const float sg = __builtin_amdgcn_rcpf(1.0f + __builtin_amdgcn_exp2f(-1.702f * LOG2E * gl));
                        a[4 * n + i] = gl * sg * (li + 1.0f); }
                v4u w; w.x = cvt_pk_bf16(a[0], a[1]); w.y = cvt_pk_bf16(a[2], a[3]); w.z = cvt_pk_bf16(a[4], a[5]); w.w = cvt_pk_bf16(a[6], a[7]);
                *(v4u*)rowp = w; }
    }
};
__device__ __forceinline__ float clamp448(float v) { return __builtin_amdgcn_fmed3f(v, -448.0f, 448.0f); }
__device__ __forceinline__ unsigned pk4_fp8(float a, float b, float c, float d) { unsigned r = 0; r = __builtin_amdgcn_cvt_pk_fp8_f32(clamp448(a), clamp448(b), r, false); r = __builtin_amdgcn_cvt_pk_fp8_f32(clamp448(c), clamp448(d), r, true); return r; }
struct EpiSwiglu8 {
    static constexpr bool PERM = true;
    unsigned char* O; const float* b1;
    __device__ __forceinline__ void init(f32x4 (&acc)[2][2][4][2], const Unit& u, int, int wc, int, int fq) const {
        const int e = u.pb >> 3; const int j0 = u.pn * 128 + wc * 32 + 8 * fq; const float* bp = b1 + (size_t)e * 2048 + 2 * j0;
        f32x4 bb[4];
#pragma unroll
        for (int q = 0; q < 4; ++q) bb[q] = *(const f32x4*)(bp + 4 * q);
        const f32x4 g0 = (f32x4){bb[0][0], bb[0][2], bb[1][0], bb[1][2]}, g1 = (f32x4){bb[2][0], bb[2][2], bb[3][0], bb[3][2]};
        const f32x4 l0 = (f32x4){bb[0][1], bb[0][3], bb[1][1], bb[1][3]}, l1 = (f32x4){bb[2][1], bb[2][3], bb[3][1], bb[3][3]};
#pragma unroll
        for (int a = 0; a < 2; ++a)
#pragma unroll
            for (int m = 0; m < 4; ++m) { acc[a][0][m][0] = g0; acc[a][0][m][1] = g1; acc[a][1][m][0] = l0; acc[a][1][m][1] = l1; } }
    __device__ __forceinline__ void operator()(const f32x4 (&acc)[2][2][4][2], const Unit& u, int wr, int wc, int fr, int fq) const {
        const int row0 = u.pm * BM + wr * 64 + fr; const int j0 = u.pn * 128 + wc * 32 + 8 * fq;
#pragma unroll
        for (int ai = 0; ai < 2; ++ai)
#pragma unroll
            for (int m = 0; m < 4; ++m) { unsigned char* rowp = O + (size_t)(row0 + ai * HALF + m * 16) * DM + j0;
                float a[8];
#pragma unroll
                for (int n = 0; n < 2; ++n)
#pragma unroll
                    for (int i = 0; i < 4; ++i) { float gl = acc[ai][0][m][n][i], li = acc[ai][1][m][n][i];
                        gl = fminf(gl, 7.0f); li = fminf(fmaxf(li, -7.0f), 7.0f);
                        const float sg = __builtin_amdgcn_rcpf(1.0f + __builtin_amdgcn_exp2f(-1.702f * LOG2E * gl));
                        a[4 * n + i] = gl * sg * (li + 1.0f); }
                v2u w; w.x = pk4_fp8(a[0], a[1], a[2], a[3]); w.y = pk4_fp8(a[4], a[5], a[6], a[7]);
                *(v2u*)rowp = w; }
    }
};
struct EpiY {
    static constexpr bool PERM = true;
    unsigned char* O; const float* b2;
    __device__ __forceinline__ void init(f32x4 (&acc)[2][2][4][2], const Unit& u, int, int wc, int, int fq) const {
        const int e = u.pb >> 2; const int col0 = u.pn * BM + wc * 32 + 8 * fq;
#pragma unroll
        for (int bj = 0; bj < 2; ++bj)
#pragma unroll
            for (int n = 0; n < 2; ++n) { const f32x4 bv = b2 ? *(const f32x4*)(b2 + (size_t)e * DM + col0 + bj * HALF + 4 * n) : (f32x4){0.f, 0.f, 0.f, 0.f};
#pragma unroll
                for (int a = 0; a < 2; ++a)
#pragma unroll
                    for (int m = 0; m < 4; ++m) acc[a][bj][m][n] = bv; } }
    __device__ __forceinline__ void operator()(const f32x4 (&acc)[2][2][4][2], const Unit& u, int wr, int wc, int fr, int fq) const {
        const int row0 = u.pm * BM + wr * 64 + fr; const int col0 = u.pn * BM + wc * 32 + 8 * fq;
#pragma unroll
        for (int ai = 0; ai < 2; ++ai)
#pragma unroll
            for (int m = 0; m < 4; ++m) { unsigned char* rowp = O + (size_t)(row0 + ai * HALF + m * 16) * DM + col0;
#pragma unroll
                for (int bj = 0; bj < 2; ++bj) { const f32x4 v0 = acc[ai][bj][m][0], v1 = acc[ai][bj][m][1];
                    v2u w; w.x = pk4_fp8(v0[0], v0[1], v0[2], v0[3]); w.y = pk4_fp8(v1[0], v1[1], v1[2], v1[3]);
                    *(v2u*)(rowp + bj * HALF) = w; } }
    }
};
}
namespace att {
constexpr int KROW = 128;
constexpr int TILE_B = 64 * KROW;
constexpr int OFF_K = 0, OFF_V = 2 * TILE_B, OFF_F = 4 * TILE_B, OFF_Q = OFF_F + 512, OFF_FLAG = OFF_Q + 8 * 4608, LDS_BYTES = OFF_FLAG + 64;
__device__ __forceinline__ int pim(int m) { const int a = m >> 3, h = (m >> 2) & 1, b = m & 3; return 16 * (a >> 1) + 8 * h + 4 * (a & 1) + b; }
typedef __bf16 bf16x2_t __attribute__((ext_vector_type(2)));
__device__ __forceinline__ unsigned pk_bf16(float lo, float hi) { const f32x2 v = {lo, hi}; const bf16x2_t b = __builtin_convertvector(v, bf16x2_t); return __builtin_bit_cast(unsigned, b); }
__device__ __forceinline__ unsigned pk_f16(float lo, float hi) { return __builtin_bit_cast(unsigned, __builtin_amdgcn_cvt_pkrtz(lo, hi)); }
__device__ __forceinline__ float half_sum(float v) { auto rr = __builtin_amdgcn_permlane32_swap(__float_as_uint(v), __float_as_uint(v), false, false); return __uint_as_float(rr[0]) + __uint_as_float(rr[1]); }
__device__ __forceinline__ float half_max(float v) { auto rr = __builtin_amdgcn_permlane32_swap(__float_as_uint(v), __float_as_uint(v), false, false); return fmaxf(__uint_as_float(rr[0]), __uint_as_float(rr[1])); }
__device__ __forceinline__ void glds16(const void* gsrc, unsigned lds_dst) { unsigned keep;
    asm volatile("s_mov_b32 %0, m0\n\ts_mov_b32 m0, %2\n\ts_nop 0\n\tglobal_load_lds_dwordx4 %1, off\n\ts_mov_b32 m0, %0" : "=&s"(keep) : "v"(gsrc), "s"(lds_dst) : "memory"); }
#define ATT_SB() __builtin_amdgcn_sched_barrier(0)
#define ATT_MFMA(a, b, c) __builtin_amdgcn_mfma_f32_32x32x16_bf16((a), (b), (c), 0, 0, 0)
#define ATT_MFMAH(a, b, c) __builtin_amdgcn_mfma_f32_32x32x16_f16((a), (b), (c), 0, 0, 0)

struct Tensors {
    const bf16* proj;
    const bf16* vt;
    const float* fcum;
    bf16* ymix;
    const float* ong;
    int colq, colk, coly;
    void* tprobe;
    float z2max;
};
struct WaveCtx { int r32, hi, qabs; int ko[4]; const LAS unsigned char* qb; f16x8 mtri0, mtri1, mones; };

__device__ __forceinline__ void qk_only(f32x16& p0, f32x16& p1, const LAS unsigned char* Kb, const WaveCtx& W) {
#pragma unroll
    for (int r = 0; r < 16; ++r) { p0[r] = 0.f; p1[r] = 0.f; }
#pragma unroll
    for (int d0 = 0; d0 < 4; ++d0) { const bf16x8 ka = *(const LAS bf16x8*)(Kb + W.ko[d0]), kb2 = *(const LAS bf16x8*)(Kb + 32 * KROW + W.ko[d0]);
        const bf16x8 qv = *(const LAS bf16x8*)(W.qb + 32 * d0);
        p0 = ATT_MFMA(ka, qv, p0); p1 = ATT_MFMA(kb2, qv, p1); }
}

template <int KIND, bool DIAG>
__device__ __forceinline__ void tile(f32x16& p0, f32x16& p1, f32x16& o0, f32x16& o1, float& carry, float& lsum, const LAS unsigned char* Kn, const LAS unsigned char* Vb, const LAS float* Fb, int kt, const WaveCtx& W) {
    const int kbase = kt * 64 + 8 * W.hi;
#define ATT_KF(i) (*(const LAS bf16x8*)(Kn + ((i) & 1) * 32 * KROW + W.ko[(i) >> 1]))
#define ATT_VF(i) (*(const LAS bf16x8*)(Vb + ((i) & 1) * 32 * KROW + W.ko[(i) >> 1]))
#define ATT_QF(d0) (*(const LAS bf16x8*)(W.qb + 32 * (d0)))
    bf16x8 kcur = ATT_KF(0), knxt = kcur, qcur = ATT_QF(0), qnxt = qcur;
    f32x16 n0, n1;
#pragma unroll
    for (int r = 0; r < 16; ++r) { n0[r] = 0.f; n1[r] = 0.f; }
    v4u wf[4];
    if (KIND == 0) {
        v4u lf[4]; float lfirst = 0.f, pz0 = 0.f;
#pragma unroll
        for (int i = 0; i < 8; ++i) {
            if (i < 7) { knxt = ATT_KF(i + 1); if (i & 1) qnxt = ATT_QF((i + 1) >> 1); }
#pragma unroll
            for (int jj = 0; jj < 2; ++jj) { const int r = (4 * i + 2 * jj) & 15; float lg[2];
#pragma unroll
                for (int e = 0; e < 2; ++e) { const float z = (i < 4) ? p0[r + e] : p1[r + e]; float g = __builtin_amdgcn_logf(1.0f + __builtin_amdgcn_exp2f(z));
                    if (i < 4) p0[r + e] = z - g; else p1[r + e] = z - g;
                    if (DIAG) { const int key = kbase + (i < 4 ? 0 : 32) + 16 * ((r + e) >> 3) + ((r + e) & 7); g = (key < W.qabs) ? g : 0.f; }
                    lg[e] = g; }
                if (i == 0 && jj == 0) { lfirst = -lg[0]; pz0 = p0[0]; }
                lf[2 * (i >> 2) + (r >> 3)][(r & 7) >> 1] = pk_f16(-lg[0], -lg[1]);
                if (jj == 1) asm volatile("" : "+v"(kcur) : "v"(lf[2 * (i >> 2) + (r >> 3)][(r & 7) >> 1])); }
            if (i & 1) { n1 = ATT_MFMA(kcur, qcur, n1); qcur = qnxt; } else n0 = ATT_MFMA(kcur, qcur, n0);
            kcur = knxt;
            ATT_SB();
        }
        bf16x8 va = ATT_VF(0), vb = ATT_VF(1), vna = va, vnb = vb;
#pragma unroll
        for (int r = 0; r < 16; ++r) { p0[r] += carry; p1[r] += carry; }
        p0 = ATT_MFMAH(W.mtri0, __builtin_bit_cast(f16x8, lf[0]), p0); p1 = ATT_MFMAH(W.mtri0, __builtin_bit_cast(f16x8, lf[2]), p1);
        p0 = ATT_MFMAH(W.mtri1, __builtin_bit_cast(f16x8, lf[1]), p0); p1 = ATT_MFMAH(W.mtri1, __builtin_bit_cast(f16x8, lf[3]), p1);
        p0 = ATT_MFMAH(W.mones, __builtin_bit_cast(f16x8, lf[2]), p0);
        p0 = ATT_MFMAH(W.mones, __builtin_bit_cast(f16x8, lf[3]), p0);
        ATT_SB();
        const float t00 = p0[0];
#pragma unroll
        for (int c = 0; c < 4; ++c) {
            if (c < 3) { vna = ATT_VF(2 * c + 2); vnb = ATT_VF(2 * c + 3); }
#pragma unroll
            for (int j = 0; j < 4; ++j) { const int r = 8 * (c & 1) + 2 * j; float w[2];
#pragma unroll
                for (int e = 0; e < 2; ++e) { const float t = (c < 2) ? p0[r + e] : p1[r + e]; float x = __builtin_amdgcn_exp2f(t);
                    if (DIAG) { const int key = kbase + (c < 2 ? 0 : 32) + 16 * ((r + e) >> 3) + ((r + e) & 7); x = (key < W.qabs) ? x : 0.f; }
                    w[e] = x; }
                wf[c][j] = pk_bf16(w[0], w[1]); }
            o0 = ATT_MFMA(va, __builtin_bit_cast(bf16x8, wf[c]), o0); o1 = ATT_MFMA(vb, __builtin_bit_cast(bf16x8, wf[c]), o1);
            va = vna; vb = vnb;
            ATT_SB();
        }
        carry = half_sum(W.hi == 0 ? (t00 - pz0) + lfirst : 0.f);
    } else {
#define ATT_FBV(i) (*(const LAS f32x4*)(Fb + 8 * W.hi + 32 * ((i) >> 2) + 16 * (((i) >> 1) & 1) + 4 * ((i) & 1)))
        f32x4 fcur = ATT_FBV(0), fnxt = fcur;
        float mx = -1e30f;
#pragma unroll
        for (int i = 0; i < 8; ++i) {
            if (i < 7) { knxt = ATT_KF(i + 1); fnxt = ATT_FBV(i + 1); if (i & 1) qnxt = ATT_QF((i + 1) >> 1); }
#pragma unroll
            for (int e = 0; e < 4; ++e) { const int r = (4 * i + e) & 15; float s = ((i < 4) ? p0[r] : p1[r]) - fcur[e];
                if (DIAG) { const int key = kbase + (i < 4 ? 0 : 32) + 16 * (r >> 3) + (r & 7); s = (key > W.qabs) ? -1e30f : s; }
                if (i < 4) p0[r] = s; else p1[r] = s; mx = fmaxf(mx, s); }
            asm volatile("" : "+v"(kcur) : "v"(mx));
            if (i & 1) { n1 = ATT_MFMA(kcur, qcur, n1); qcur = qnxt; } else n0 = ATT_MFMA(kcur, qcur, n0);
            kcur = knxt; fcur = fnxt;
            ATT_SB();
        }
        bf16x8 va = ATT_VF(0), vb = ATT_VF(1), vna = va, vnb = vb;
        mx = half_max(mx);
        if (__any(mx > carry)) {
            const float mnew = fmaxf(carry, mx), alpha = __builtin_amdgcn_exp2f(carry - mnew); carry = mnew; lsum *= alpha;
#pragma unroll
            for (int r = 0; r < 16; ++r) { o0[r] *= alpha; o1[r] *= alpha; }
        }
        ATT_SB();
        float ps = 0.f;
#pragma unroll
        for (int c = 0; c < 4; ++c) {
            if (c < 3) { vna = ATT_VF(2 * c + 2); vnb = ATT_VF(2 * c + 3); }
#pragma unroll
            for (int j = 0; j < 4; ++j) { const int r = 8 * (c & 1) + 2 * j;
                const float a = __builtin_amdgcn_exp2f(((c < 2) ? p0[r] : p1[r]) - carry), d = __builtin_amdgcn_exp2f(((c < 2) ? p0[r + 1] : p1[r + 1]) - carry);
                ps += a + d; wf[c][j] = pk_bf16(a, d); }
            o0 = ATT_MFMA(va, __builtin_bit_cast(bf16x8, wf[c]), o0); o1 = ATT_MFMA(vb, __builtin_bit_cast(bf16x8, wf[c]), o1);
            va = vna; vb = vnb;
            ATT_SB();
        }
        lsum += half_sum(ps);
    }
    p0 = n0; p1 = n1;
#undef ATT_KF
#undef ATT_QF
#undef ATT_VF
#undef ATT_FBV
}

template <int KIND>
__device__ __forceinline__ void unit(const Tensors& T, int b, int h, int qb, LAS unsigned char* lds, int wave) {
    int lane_ = (int)__builtin_amdgcn_mbcnt_hi(~0u, __builtin_amdgcn_mbcnt_lo(~0u, 0u)); asm volatile("" : "+v"(lane_));
    const int wid = wave, lane = lane_, tid = wid * 64 + lane;
    WaveCtx W; W.r32 = lane & 31; W.hi = lane >> 5;
    const int q0 = qb * 256, qw0 = q0 + wid * 32; W.qabs = qw0 + W.r32;
    const size_t rowbase = (size_t)b * SEQ;
    const int ktd = qw0 >> 6;
    const int kt_hi = (q0 + 255) >> 6;
    const int srow = tid >> 3, cg = (tid & 7) ^ ((srow >> 1) & 7);
    const bf16* kg = T.proj + (rowbase + srow) * NPROJ + T.colk + h * 64 + cg * 8;
    const bf16* vg = T.vt + ((size_t)(b * 6 + h) * 64 + srow) * SEQ + cg * 8;
    const float* fg = T.fcum + (size_t)(b * 6 + h) * SEQ;
    LAS unsigned char* qlds = lds + OFF_Q + wid * 4608;
    W.qb = qlds + W.r32 * 144 + W.hi * 16;
    { const bf16* qp = T.proj + (rowbase + W.qabs) * NPROJ + T.colq + h * 64 + W.hi * 8;
      v4u qt[4];
#pragma unroll
      for (int d0 = 0; d0 < 4; ++d0) qt[d0] = *(const v4u*)(qp + d0 * 16);
#pragma unroll
      for (int d0 = 0; d0 < 4; ++d0) *(LAS v4u*)(qlds + W.r32 * 144 + W.hi * 16 + 32 * d0) = qt[d0]; }
    const int pm = pim(W.r32);
#pragma unroll
    for (int j = 0; j < 4; ++j) W.ko[j] = pm * KROW + (((2 * j + W.hi) ^ ((pm >> 1) & 7)) << 4);
#pragma unroll
    for (int i = 0; i < 8; ++i) { W.mtri0[i] = (_Float16)((8 * W.hi + i > pm) ? 1.0f : 0.0f); W.mtri1[i] = (_Float16)((16 + 8 * W.hi + i > pm) ? 1.0f : 0.0f); W.mones[i] = (_Float16)1.0f; }
    f32x16 o0, o1, p0, p1;
#pragma unroll
    for (int r = 0; r < 16; ++r) { o0[r] = 0.f; o1[r] = 0.f; p0[r] = 0.f; p1[r] = 0.f; }
    float carry = (KIND == 1) ? -1e30f : 0.f, lsum = 0.f;
#define ATT_KB(t) (lds + OFF_K + ((t) & 1) * TILE_B)
#define ATT_VB(t) (lds + OFF_V + ((t) & 1) * TILE_B)
#define ATT_FB(t) ((LAS float*)(lds + OFF_F + ((t) & 1) * 256))
#define ATT_DMA(gsrc, ldst) glds16((gsrc), (unsigned)__builtin_amdgcn_readfirstlane((int)(uintptr_t)((ldst) + wid * 1024)))
    ATT_DMA(kg + (size_t)kt_hi * 64 * NPROJ, ATT_KB(kt_hi)); ATT_DMA(vg + kt_hi * 64, ATT_VB(kt_hi)); ATT_DMA(kg + (size_t)(kt_hi - 1) * 64 * NPROJ, ATT_KB(kt_hi - 1));
    if (KIND == 1 && tid < 64) ATT_FB(kt_hi)[tid] = fg[kt_hi * 64 + tid];
    asm volatile("s_waitcnt vmcnt(0)" ::: "memory");
    __syncthreads();
    if (ktd == kt_hi) qk_only(p0, p1, ATT_KB(kt_hi), W);
    __syncthreads();
#ifdef TPROBE
    unsigned long long tacc = 0ull;
#endif
    constexpr float EXIT_LOG2 = -40.0f;
    LAS int* flags = (LAS int*)(lds + OFF_FLAG);
    bool wdone = false;
    for (int kt = kt_hi; kt >= 0; --kt) {
        float freg = 0.f, fnx = 0.f;
        if (KIND == 1 && kt >= 1) fnx = fg[kt * 64 - 1];
#ifdef TPROBE
        const unsigned long long tp0 = __builtin_readcyclecounter();
#endif
        if (kt >= 2) ATT_DMA(kg + (size_t)(kt - 2) * 64 * NPROJ, ATT_KB(kt - 2));
        if (kt >= 1) { ATT_DMA(vg + (kt - 1) * 64, ATT_VB(kt - 1)); if (KIND == 1 && tid < 64) freg = fg[(kt - 1) * 64 + tid]; }
#ifdef TPROBE
        const unsigned long long tp1 = __builtin_readcyclecounter();
#endif
        if (kt <= ktd) {
            if (!wdone) {
                if (kt == ktd) tile<KIND, true>(p0, p1, o0, o1, carry, lsum, ATT_KB(kt - 1), ATT_VB(kt), ATT_FB(kt), kt, W);
                else tile<KIND, false>(p0, p1, o0, o1, carry, lsum, ATT_KB(kt - 1), ATT_VB(kt), ATT_FB(kt), kt, W);
                const float slack = (KIND == 0) ? carry : (T.z2max - fnx) - carry;
                wdone = !__any(!(slack < EXIT_LOG2));
            }
        } else if (kt - 1 == ktd) qk_only(p0, p1, ATT_KB(kt - 1), W);
        if (lane == 0) flags[(kt & 1) * 8 + wid] = wdone ? 1 : 0;
        if (KIND == 1 && kt >= 1 && tid < 64) ATT_FB(kt - 1)[tid] = freg;
#ifdef TPROBE
        const unsigned long long tp2 = __builtin_readcyclecounter();
#endif
        asm volatile("s_waitcnt vmcnt(0)" ::: "memory");
#ifdef ATT_LDSFLUSH
        { unsigned dummy; asm volatile("ds_read_b32 %0, %1\n\ts_waitcnt lgkmcnt(0)" : "=v"(dummy) : "v"((unsigned)(uintptr_t)(lds + OFF_V + wid * 1024 + lane * 16)) : "memory"); }
#endif
        __syncthreads();
        if (__all(flags[(kt & 1) * 8 + (lane & 7)] != 0)) break;
#ifdef TPROBE
        const unsigned long long tp3 = __builtin_readcyclecounter();
        tacc += (TPROBE == 1) ? (tp3 - tp2) : (TPROBE == 2) ? (tp3 - tp0) : (TPROBE == 3) ? (tp2 - tp1) : (tp1 - tp0);
        asm volatile("" :: "s"(tp0), "s"(tp1), "s"(tp2), "s"(tp3));
#endif
    }
#ifdef TPROBE
    if (blockIdx.x == TPROBE_BLK && tid == TPROBE_WAVE * 64) atomicAdd((unsigned long long*)T.tprobe, tacc);
#endif
#undef ATT_KB
#undef ATT_VB
#undef ATT_FB
#undef ATT_DMA
    if (KIND == 1) { const float inv = 1.0f / lsum;
#pragma unroll
        for (int r = 0; r < 16; ++r) { o0[r] *= inv; o1[r] *= inv; } }
    float ss = 0.f;
#pragma unroll
    for (int r = 0; r < 16; ++r) ss += o0[r] * o0[r] + o1[r] * o1[r];
    ss = half_sum(ss);
    const float rinv = 1.0f / sqrtf(ss * (1.0f / 64.0f) + EPS);
    const float* gp = T.ong + T.coly + h * 64 + 8 * W.hi;
    bf16* yp = T.ymix + (rowbase + W.qabs) * DM + T.coly + h * 64 + 8 * W.hi;
#pragma unroll
    for (int d0 = 0; d0 < 2; ++d0)
#pragma unroll
        for (int g = 0; g < 2; ++g) { const f32x4 ga = *(const f32x4*)(gp + 32 * d0 + 16 * g), gb = *(const f32x4*)(gp + 32 * d0 + 16 * g + 4);
            float v[8];
#pragma unroll
            for (int i = 0; i < 8; ++i) v[i] = (d0 == 0 ? o0[8 * g + i] : o1[8 * g + i]) * rinv * (i < 4 ? ga[i & 3] : gb[i & 3]);
            v4u w; w.x = pk_bf16(v[0], v[1]); w.y = pk_bf16(v[2], v[3]); w.z = pk_bf16(v[4], v[5]); w.w = pk_bf16(v[6], v[7]);
            *(v4u*)(yp + 32 * d0 + 16 * g) = w; }
}
}
constexpr size_t MiB = 1u << 20;
constexpr size_t WS_CTL = 0, CTL_ZERO_BYTES = 1 * MiB;
constexpr size_t WS_MODP = 1 * MiB;
constexpr size_t WS_TOPW = 3 * MiB;
constexpr size_t WS_ROUTE = WS_TOPW + 512 * 1024;
constexpr size_t WS_TOKSLOT = WS_ROUTE + 512 * 1024;
constexpr size_t WS_SLOTTOK = WS_TOKSLOT + 512 * 1024;
constexpr size_t WS_HIST = WS_SLOTTOK + 576 * 1024;
constexpr size_t WS_MOETAB = WS_HIST + 32 * 1024;
constexpr size_t WS_LOGF = 6 * MiB;
constexpr size_t WS_FCUM = 7 * MiB;
constexpr size_t WS_WIN = 8 * MiB, WS_WOUT = 20 * MiB, WS_W1 = 24 * MiB, WS_W2 = 280 * MiB;
constexpr size_t WS_H = 408 * MiB;
constexpr size_t WS_PROJ = 472 * MiB;
constexpr size_t WS_VT = 664 * MiB;
constexpr size_t WS_YMIX = 712 * MiB;
constexpr size_t WS_XA = 776 * MiB, WS_XB = 904 * MiB;
constexpr size_t WS_ACT = 1032 * MiB, WS_Y = 1304 * MiB, WS_H8 = 1576 * MiB, WS_END = 1608 * MiB;
static_assert(WS_MOETAB + 256 <= WS_LOGF && (size_t)NSLOT_MAX * 4 <= 576 * 1024 && (size_t)NSLOT_MAX * DM * 2 <= 272 * MiB, "ws map");
#ifndef P2_FP8
#define P2_FP8 0
#endif
constexpr int CW_BAR = 4096;

constexpr int RING_BYTES = 131072;
constexpr int MISC_OFF = RING_BYTES;
constexpr int LDS_BYTES = 147456;

#define RLX_AGENT __ATOMIC_RELAXED, __HIP_MEMORY_SCOPE_AGENT
__device__ __forceinline__ unsigned f2bf(float f) { unsigned u = __builtin_bit_cast(unsigned, f); return (u + 0x7fffu + ((u >> 16) & 1u)) >> 16; }
__device__ __forceinline__ unsigned pk2(float lo, float hi) { return f2bf(lo) | (f2bf(hi) << 16); }
__device__ __forceinline__ float bflo(unsigned u) { return __builtin_bit_cast(float, u << 16); }
__device__ __forceinline__ float bfhi(unsigned u) { return __builtin_bit_cast(float, u & 0xffff0000u); }
__device__ __forceinline__ int shxi(int v, int o, int lane) {
    if (o == 1) return __builtin_amdgcn_mov_dpp(v, 0xB1, 0xf, 0xf, true);
    if (o == 2) return __builtin_amdgcn_mov_dpp(v, 0x4E, 0xf, 0xf, true);
    if (o == 4) return __builtin_amdgcn_ds_swizzle(v, 0x101F);
    if (o == 8) return __builtin_amdgcn_ds_swizzle(v, 0x201F);
    if (o == 16) return __builtin_amdgcn_ds_swizzle(v, 0x401F);
    return __builtin_amdgcn_ds_bpermute((lane ^ o) << 2, v);
}
__device__ __forceinline__ float shx(float v, int o, int lane) { return __builtin_bit_cast(float, shxi(__builtin_bit_cast(int, v), o, lane)); }
__device__ __forceinline__ float shup(float v, int o, int lane) { return __builtin_bit_cast(float, __builtin_amdgcn_ds_bpermute(((lane - o) & 63) << 2, __builtin_bit_cast(int, v))); }
__device__ __forceinline__ float add_other_half(float v) { auto rr = __builtin_amdgcn_permlane32_swap(__float_as_uint(v), __float_as_uint(v), false, false); return __uint_as_float(rr[0]) + __uint_as_float(rr[1]); }
__device__ __forceinline__ float wave_sum(float v, int lane) {
    v += shx(v, 1, lane); v += shx(v, 2, lane); v += shx(v, 4, lane); v += shx(v, 8, lane); v += shx(v, 16, lane);
    return add_other_half(v);
}

#define XB_TMO      128
#define XB_XCNT(j)  (256  + 64 * (j))
#define XB_XSUB(j)  (1280 + 64 * (j))
#define XB_XGEN(j)  (2304 + 64 * (j))
#define XB_TOP      3328
#define XB_TOPGEN   3392
#define XCD_BAR_WORDS 3456
#define XB_SPIN_CAP (1u << 18)
__device__ __forceinline__ unsigned xb_ld(unsigned* p)              { return __hip_atomic_load(p, __ATOMIC_RELAXED, __HIP_MEMORY_SCOPE_AGENT); }
__device__ __forceinline__ unsigned xb_add(unsigned* p, unsigned v) { return __hip_atomic_fetch_add(p, v, __ATOMIC_RELAXED, __HIP_MEMORY_SCOPE_AGENT); }
__device__ __forceinline__ unsigned xb_xcc_id() { return (unsigned)__builtin_amdgcn_s_getreg((3 << 11) | 20) & 0xFu; }
#define XB_SPIN(cond, bar) do { unsigned _sp = 0; while (cond) { __builtin_amdgcn_s_sleep(1); \
    if ((++_sp & 255u) == 0u) { if (xb_ld(&(bar)[XB_TMO])) break; if (_sp > XB_SPIN_CAP) { atomicAdd(&(bar)[XB_TMO], 1u); break; } } } } while (0)
__device__ __forceinline__ int lane_id() { return (int)__builtin_amdgcn_mbcnt_hi(~0u, __builtin_amdgcn_mbcnt_lo(~0u, 0u)); }
struct XcdBarrier { unsigned* bar; unsigned x; volatile LAS unsigned* st; int wave; };
__device__ __forceinline__ XcdBarrier xcd_barrier_post(unsigned* bar, volatile LAS unsigned* st, int wave) {
    XcdBarrier b; b.bar = bar; b.x = (unsigned)__builtin_amdgcn_readfirstlane((int)xb_xcc_id()); b.st = st; b.wave = wave;
    if (wave == 0 && lane_id() == 0) (void)xb_add(&bar[XB_XCNT(b.x)], 1u);
    return b;
}
__device__ __forceinline__ void xcd_barrier_complete(unsigned* bar, unsigned x, unsigned& nloc, unsigned& nx) {
    const unsigned G = gridDim.x * gridDim.y * gridDim.z;
    unsigned sum, cnt, mine, sp = 0u;
    for (;;) {
        sum = 0u; cnt = 0u; mine = 0u;
#pragma unroll
        for (unsigned j = 0; j < 16; ++j) { const unsigned c = xb_ld(&bar[XB_XCNT(j)]); sum += c; cnt += (c > 0u) ? 1u : 0u; mine = (j == x) ? c : mine; }
        if (sum == G) break;
        __builtin_amdgcn_s_sleep(1);
        if ((++sp & 255u) == 0u) { if (xb_ld(&bar[XB_TMO])) break; if (sp > XB_SPIN_CAP) { atomicAdd(&bar[XB_TMO], 1u); break; } }
    }
    nloc = mine > 0u ? mine : 1u; nx = cnt > 0u ? cnt : 1u;
}
__device__ __forceinline__ void xcd_barrier(const XcdBarrier& b) {
    asm volatile("s_waitcnt vmcnt(0)" ::: "memory");
    __syncthreads();
    if (b.wave == 0 && lane_id() == 0) {
        unsigned* bar = b.bar; const unsigned bx = (unsigned)__builtin_amdgcn_readfirstlane((int)xb_xcc_id());
        __builtin_amdgcn_s_waitcnt(0);
        unsigned nloc = b.st[0], nx = b.st[1];
        if (nloc == 0u) { xcd_barrier_complete(bar, bx, nloc, nx); b.st[0] = nloc; b.st[1] = nx; }
        const unsigned old = xb_add(&bar[XB_XSUB(bx)], 1u);
        const unsigned gen = old / nloc;
        if (old + 1u == (gen + 1u) * nloc) {
            __builtin_amdgcn_fence(__ATOMIC_RELEASE, "agent");
            asm volatile("s_waitcnt vmcnt(0)" ::: "memory");
            const unsigned og = xb_add(&bar[XB_TOP], 1u);
            const unsigned tg = og / nx;
            if (og + 1u == (tg + 1u) * nx) xb_add(&bar[XB_TOPGEN], 1u);
            else XB_SPIN(xb_ld(&bar[XB_TOPGEN]) == tg, bar);
            __builtin_amdgcn_fence(__ATOMIC_ACQUIRE, "agent");
            xb_add(&bar[XB_XGEN(bx)], 1u);
            asm volatile("s_waitcnt vmcnt(0)" ::: "memory");
        } else {
            XB_SPIN(xb_ld(&bar[XB_XGEN(bx)]) == gen, bar);
            __builtin_amdgcn_fence(__ATOMIC_ACQUIRE, "agent");
            asm volatile("s_waitcnt vmcnt(0)" ::: "memory");
        }
    }
    __syncthreads();
}

struct Frame {
    LAS unsigned char* lds;
    int tid, lane, wave, blk, G;
    const float* in[21];
    float* out; unsigned char* ws;
};
enum { I_X = 0, I_C, I_N1G, I_WADA, I_BADA, I_WIN, I_CONVW, I_SBQG, I_SBKG, I_FXQG, I_FXKG, I_FXFB, I_ONG, I_WOUT, I_N2G, I_RW, I_RB, I_W1, I_B1, I_W2, I_B2 };

template <int MAP, bool WIDE, bool OUT8 = false>
__device__ __forceinline__ void p0_transpose_item(const float* W, int ldw, bf16* WT, LAS float* scr, int k0, int n0, int lane) {
    if (WIDE) {
        f32x4 t[8];
#pragma unroll
        for (int i = 0; i < 8; ++i) t[i] = __builtin_nontemporal_load((const f32x4*)(W + (size_t)(k0 + 8 * i + (lane >> 3)) * ldw + n0 + 4 * (lane & 7)));
#pragma unroll
        for (int i = 0; i < 8; ++i) { LAS float* d = scr + (8 * i + (lane >> 3)) * 33 + 4 * (lane & 7); d[0] = t[i].x; d[1] = t[i].y; d[2] = t[i].z; d[3] = t[i].w; }
    } else {
#pragma unroll 8
        for (int i = 0; i < 32; ++i) { const int kk = 2 * i + (lane >> 5); scr[kk * 33 + (lane & 31)] = W[(size_t)(k0 + kk) * ldw + n0 + (lane & 31)]; }
    }
    asm volatile("s_waitcnt lgkmcnt(0)" ::: "memory");
    const int c = lane & 7;
#pragma unroll
    for (int j = 0; j < 4; ++j) { const int n = (lane >> 3) + 8 * j; const LAS float* s = scr + (8 * c) * 33 + n;
        v4u o; o.x = pk2(s[0 * 33], s[1 * 33]); o.y = pk2(s[2 * 33], s[3 * 33]); o.z = pk2(s[4 * 33], s[5 * 33]); o.w = pk2(s[6 * 33], s[7 * 33]);
        const int cn = n0 + n; int row = cn;
        if (MAP == 1) { const int jj = cn >> 1, t = cn & 1; row = 256 * (jj >> 7) + 128 * t + (jj & 127); }
        if (OUT8) { v2u o8; o8.x = pg8::pk4_fp8(32.0f * s[0 * 33], 32.0f * s[1 * 33], 32.0f * s[2 * 33], 32.0f * s[3 * 33]); o8.y = pg8::pk4_fp8(32.0f * s[4 * 33], 32.0f * s[5 * 33], 32.0f * s[6 * 33], 32.0f * s[7 * 33]);
            *(v2u*)((unsigned char*)WT + (size_t)row * 1024 + k0 + 8 * c) = o8; }
        else *(v4u*)(WT + (size_t)row * 1024 + k0 + 8 * c) = o; }
    asm volatile("s_waitcnt lgkmcnt(0)" ::: "memory");
}
__device__ __forceinline__ void p0_prologue(Frame& F) {
    LAS float* scr = (LAS float*)(F.lds + F.wave * 16384);
    const int gw = F.blk * 8 + F.wave, NGW = F.G * 8;
    constexpr int N_ADA = NLAYER * 4 * 24;
    if (F.blk * 8 < N_ADA) {
        LAS float* sl = (LAS float*)(F.lds + 8 * 16384 - 32768);
        for (int i = F.tid; i < NB * DM; i += 512) { const float cv = F.in[I_C][i]; sl[i] = cv / (1.0f + __expf(-cv)); }
        __syncthreads();
        if (gw < N_ADA) {
            const int it = gw; const int l = it / 96, ks = (it / 24) & 3, nc = it % 24;
            const float* W = F.in[I_WADA] + (size_t)l * DM * 6144 + nc * 256 + F.lane * 4;
            f32x4 acc[NB];
#pragma unroll
            for (int b = 0; b < NB; ++b) acc[b] = (f32x4){0.f, 0.f, 0.f, 0.f};
#pragma unroll 8
            for (int k = ks * 256; k < ks * 256 + 256; ++k) {
                const f32x4 w = __builtin_nontemporal_load((const f32x4*)(W + (size_t)k * 6144));
#pragma unroll
                for (int b = 0; b < NB; ++b) acc[b] += w * sl[b * DM + k];
            }
            float* dst = (float*)(F.ws + WS_MODP) + ((size_t)(l * 4 + ks) * NB) * 6144 + nc * 256 + F.lane * 4;
#pragma unroll
            for (int b = 0; b < NB; ++b) *(f32x4*)(dst + (size_t)b * 6144) = acc[b];
        }
        __syncthreads();
    }
    constexpr int I_IN = 16 * 96, I_OUT = 16 * 32, I_1 = 16 * 64, I_2 = 16 * 32;
    constexpr int N_IN = NLAYER * I_IN, N_OUT = NLAYER * I_OUT, N_1 = NLAYER * NEXP * I_1, N_2 = NLAYER * NEXP * I_2;
#pragma unroll 1
    for (int it = gw; it < N_IN + N_OUT; it += NGW) {
        int r = it;
        if (r < N_IN) { const int l = r / I_IN, q = r % I_IN, kb = q / 96, nb = q % 96;
            p0_transpose_item<0, false, P2_FP8>(F.in[I_WIN] + (size_t)l * DM * D_IN, D_IN, (bf16*)(F.ws + WS_WIN + (size_t)l * NPROJ * DM * (P2_FP8 ? 1 : 2)), scr, 64 * kb, 32 * nb, F.lane); continue; }
        r -= N_IN;
        { const int l = r / I_OUT, q = r % I_OUT, kb = q / 32, nb = q % 32;
            p0_transpose_item<0, true>(F.in[I_WOUT] + (size_t)l * DM * DM, DM, (bf16*)(F.ws + WS_WOUT) + (size_t)l * DM * DM, scr, 64 * kb, 32 * nb, F.lane); }
    }
    constexpr int ADA_SKIP = 6, NE = N_1 + N_2;
    const bool adaw = gw < N_ADA; const int pool = adaw ? -1 : (gw - N_ADA < N_ADA * ADA_SKIP ? gw - N_ADA : -1);
    const int pool_it = (pool >= 0) ? (pool % N_ADA) + (pool / N_ADA) * NGW : -1;
    f32x4 cur[8], nxt[8];
#define P0_LOAD(dst, itx_) do { const int it_ = ((itx_) < 0) ? pool_it : (itx_); const float* s_; int ldw_; \
        if (it_ < N_1) { const int le = it_ / I_1, q = it_ % I_1, kb = q / 64, nb = q % 64; ldw_ = 2048; s_ = F.in[I_W1] + (size_t)le * DM * 2048 + (size_t)(64 * kb + (F.lane >> 3)) * 2048 + 32 * nb + 4 * (F.lane & 7); } \
        else { const int r_ = it_ - N_1; const int le = r_ / I_2, q = r_ % I_2, kb = q / 32, nb = q % 32; ldw_ = DM; s_ = F.in[I_W2] + (size_t)le * DM * DM + (size_t)(64 * kb + (F.lane >> 3)) * DM + 32 * nb + 4 * (F.lane & 7); } \
        _Pragma("unroll") for (int i = 0; i < 8; ++i) dst[i] = __builtin_nontemporal_load((const f32x4*)(s_ + (size_t)(8 * i) * ldw_)); } while (0)
    int itx = adaw ? gw + ADA_SKIP * NGW : (pool >= 0 ? gw - NGW : gw);
    if (itx < NE) P0_LOAD(cur, itx);
#pragma unroll 1
    for (; itx < NE; itx += NGW) {
        if (itx + NGW < NE) P0_LOAD(nxt, itx + NGW);
#pragma unroll
        for (int i = 0; i < 8; ++i) { LAS float* d = scr + (8 * i + (F.lane >> 3)) * 33 + 4 * (F.lane & 7); d[0] = cur[i].x; d[1] = cur[i].y; d[2] = cur[i].z; d[3] = cur[i].w; }
        asm volatile("s_waitcnt lgkmcnt(0)" ::: "memory");
        { const int it = (itx < 0) ? pool_it : itx; const bool isw1 = it < N_1; const int r = isw1 ? it : it - N_1;
          const int per = isw1 ? I_1 : I_2, nbn = isw1 ? 64 : 32; const int le = r / per, q = r % per, kb = q / nbn, nb = q % nbn;
          unsigned char* WT = isw1 ? F.ws + WS_W1 + (size_t)le * 2048 * DM : F.ws + WS_W2 + (size_t)le * DM * DM;
          const int c = F.lane & 7;
#pragma unroll
          for (int j = 0; j < 4; ++j) { const int n = (F.lane >> 3) + 8 * j; const LAS float* s = scr + (8 * c) * 33 + n;
              v2u o8; o8.x = pg8::pk4_fp8(32.0f * s[0 * 33], 32.0f * s[1 * 33], 32.0f * s[2 * 33], 32.0f * s[3 * 33]); o8.y = pg8::pk4_fp8(32.0f * s[4 * 33], 32.0f * s[5 * 33], 32.0f * s[6 * 33], 32.0f * s[7 * 33]);
              const int cn = 32 * nb + n; int row = cn;
              if (isw1) { const int jj = cn >> 1, t = cn & 1; row = 256 * (jj >> 7) + 128 * t + (jj & 127); }
              *(v2u*)(WT + (size_t)row * 1024 + 64 * kb + 8 * c) = o8; } }
        asm volatile("s_waitcnt lgkmcnt(0)" ::: "memory");
#pragma unroll
        for (int i = 0; i < 8; ++i) cur[i] = nxt[i];
    }
#undef P0_LOAD
}

__device__ __forceinline__ f32x4 mod4(const Frame& F, int l, int b, int which, int c) {
    const int n = which * DM + c;
    f32x4 s = *(const f32x4*)(F.in[I_BADA] + (size_t)l * 6144 + n);
    const float* p = (const float*)(F.ws + WS_MODP) + ((size_t)(l * 4) * NB + b) * 6144 + n;
#pragma unroll
    for (int ks = 0; ks < 4; ++ks) s += *(const f32x4*)(p + (size_t)ks * NB * 6144);
    return s;
}

constexpr size_t WS_GSUM = WS_FCUM + 800 * 1024;
static_assert(WS_GSUM + 16384 <= WS_WIN, "ws map");
template <bool S16> __device__ __forceinline__ f32x4 ld_row4(const void* base, size_t idx) {
    if (S16) { const v2u t = *(const v2u*)((const bf16*)base + idx); return (f32x4){bflo(t.x), bfhi(t.x), bflo(t.y), bfhi(t.y)}; }
    return *(const f32x4*)((const float*)base + idx); }
template <bool D16> __device__ __forceinline__ void st_row4(void* base, size_t idx, f32x4 v) {
    if (D16) { v2u o; o.x = pk2(v.x, v.y); o.y = pk2(v.z, v.w); *(v2u*)((bf16*)base + idx) = o; }
    else *(f32x4*)((float*)base + idx) = v; }
__device__ __forceinline__ f32x4 fp8x4_to_f32(unsigned w) { return (f32x4){__builtin_amdgcn_cvt_f32_fp8(w, 0), __builtin_amdgcn_cvt_f32_fp8(w, 1), __builtin_amdgcn_cvt_f32_fp8(w, 2), __builtin_amdgcn_cvt_f32_fp8(w, 3)}; }
template <bool COMBINE, bool NORM, bool S16, bool D16>
__device__ __forceinline__ void row_phase(Frame& F, int l, const void* xsrc, void* xdst) {
    const float* topw = (const float*)(F.ws + WS_TOPW); const int* tokslot = (const int*)(F.ws + WS_TOKSLOT); const unsigned char* Y = F.ws + WS_Y;
    bf16* H = (bf16*)(F.ws + WS_H); float* logf = (float*)(F.ws + WS_LOGF); float* gsum = (float*)(F.ws + WS_GSUM);
    LAS f32x4* wl4 = (LAS f32x4*)F.lds; LAS f32x2* wl2 = (LAS f32x2*)(F.lds + 16384); LAS float* part = (LAS float*)(F.lds + 16384 + 8192);
    if (NORM) { for (int k = F.tid; k < DM; k += 512) { const float* wp = F.in[I_WIN] + (size_t)l * DM * D_IN + (size_t)k * D_IN + NPROJ; const int idx = (4 * (k >> 8) + (k & 3)) * 64 + ((k >> 2) & 63);
            wl4[idx] = (f32x4){wp[0], wp[1], wp[2], wp[3]}; wl2[idx] = (f32x2){wp[4], wp[5]}; }
        __syncthreads(); }
    for (int chunk = F.blk; chunk < NTOK / 128; chunk += F.G) {
        const int b = chunk / (SEQ / 128);
        LAS f32x4* mv = (LAS f32x4*)(F.lds + 32768);
        __syncthreads();
        if (F.wave == 0) {
#pragma unroll
            for (int j = 0; j < 4; ++j) { const int c = 256 * j + 4 * F.lane;
                if (COMBINE) mv[(0 * 4 + j) * 64 + F.lane] = mod4(F, l - 1, b, 5, c);
                if (NORM) { const f32x4 g = *(const f32x4*)(F.in[I_N1G] + (size_t)l * DM + c); mv[(1 * 4 + j) * 64 + F.lane] = g * (mod4(F, l, b, 1, c) + 1.0f); mv[(2 * 4 + j) * 64 + F.lane] = mod4(F, l, b, 0, c); } } }
        __syncthreads();
        float lacc = 0.f;
#pragma unroll 1
        for (int rr = 0; rr < 16; rr += 2) {
            const int row = chunk * 128 + F.wave * 16 + rr;
            f32x4 v[2][4];
#pragma unroll
            for (int u = 0; u < 2; ++u)
#pragma unroll
                for (int j = 0; j < 4; ++j) v[u][j] = ld_row4<S16>(xsrc, (size_t)(row + u) * DM + 256 * j + 4 * F.lane);
            int mofs = F.lane; asm volatile("" : "+v"(mofs));
            if (COMBINE) {
#pragma unroll
                for (int u = 0; u < 2; ++u) {
                    f32x4 s[4];
#pragma unroll
                    for (int j = 0; j < 4; ++j) s[j] = (f32x4){0.f, 0.f, 0.f, 0.f};
#pragma unroll
                    for (int k = 0; k < TOPK; ++k) { const float w = topw[(row + u) * 4 + k]; const int slot = tokslot[(row + u) * 4 + k];
#pragma unroll
                        for (int j = 0; j < 4; ++j) s[j] += fp8x4_to_f32(*(const unsigned*)(Y + (size_t)slot * DM + 256 * j + 4 * F.lane)) * w; }
#pragma unroll
                    for (int j = 0; j < 4; ++j) { v[u][j] += mv[(0 * 4 + j) * 64 + mofs] * s[j]; st_row4<D16>(xdst, (size_t)(row + u) * DM + 256 * j + 4 * F.lane, v[u][j]); }
                }
            }
            if (NORM) {
                float ss[2];
#pragma unroll
                for (int u = 0; u < 2; ++u) { float s = 0.f;
#pragma unroll
                    for (int j = 0; j < 4; ++j) s += (v[u][j].x * v[u][j].x + v[u][j].y * v[u][j].y) + (v[u][j].z * v[u][j].z + v[u][j].w * v[u][j].w);
                    ss[u] = s; }
#pragma unroll
                for (int o = 1; o < 32; o <<= 1) { ss[0] += shx(ss[0], o, F.lane); ss[1] += shx(ss[1], o, F.lane); }
                ss[0] = add_other_half(ss[0]); ss[1] = add_other_half(ss[1]);
                float fl[2][6];
                int lofs = F.lane; asm volatile("" : "+v"(lofs));
#pragma unroll
                for (int u = 0; u < 2; ++u) { const float rstd = 1.0f / sqrtf(ss[u] * (1.0f / DM) + EPS);
#pragma unroll
                    for (int q = 0; q < 6; ++q) fl[u][q] = 0.f;
#pragma unroll
                    for (int j = 0; j < 4; ++j) { const f32x4 hv = v[u][j] * rstd * mv[(1 * 4 + j) * 64 + mofs] + mv[(2 * 4 + j) * 64 + mofs];
                        if (P2_FP8) *(unsigned*)((unsigned char*)H + (size_t)(row + u) * DM + 256 * j + 4 * F.lane) = pg8::pk4_fp8(hv.x, hv.y, hv.z, hv.w);
                        else { v2u o; o.x = pk2(hv.x, hv.y); o.y = pk2(hv.z, hv.w); *(v2u*)(H + (size_t)(row + u) * DM + 256 * j + 4 * F.lane) = o; }
#pragma unroll
                        for (int i = 0; i < 4; ++i) { const f32x4 wa = wl4[(4 * j + i) * 64 + lofs]; const f32x2 wb = wl2[(4 * j + i) * 64 + lofs]; const float hx = hv[i];
                            fl[u][0] += hx * wa.x; fl[u][1] += hx * wa.y; fl[u][2] += hx * wa.z; fl[u][3] += hx * wa.w; fl[u][4] += hx * wb.x; fl[u][5] += hx * wb.y; } } }
#pragma unroll
                for (int o = 1; o < 32; o <<= 1)
#pragma unroll
                    for (int u = 0; u < 2; ++u)
#pragma unroll
                        for (int q = 0; q < 6; ++q) fl[u][q] += shx(fl[u][q], o, F.lane);
#pragma unroll
                for (int u = 0; u < 2; ++u)
#pragma unroll
                    for (int q = 0; q < 6; ++q) fl[u][q] = add_other_half(fl[u][q]);
                if (F.lane < 6) {
#pragma unroll
                    for (int u = 0; u < 2; ++u) { float z = fl[u][0];
#pragma unroll
                        for (int q = 1; q < 6; ++q) z = (F.lane == q) ? fl[u][q] : z;
                        z += F.in[I_FXFB][l * 6 + F.lane];
                        const float lg = fminf(z, 0.f) - __logf(1.0f + __expf(-fabsf(z)));
                        logf[(size_t)(row + u) * 6 + F.lane] = lg; lacc += lg; } }
            }
        }
        if (NORM) {
            if (F.lane < 6) part[F.wave * 8 + F.lane] = lacc;
            __syncthreads();
            if (F.tid < 12) { const int g = F.tid / 6, h = F.tid % 6; gsum[(size_t)(chunk * 2 + g) * 6 + h] = (part[(4 * g) * 8 + h] + part[(4 * g + 1) * 8 + h]) + (part[(4 * g + 2) * 8 + h] + part[(4 * g + 3) * 8 + h]); }
            __syncthreads();
        }
    }
    __syncthreads();
}
__device__ __forceinline__ void p3_postproj(Frame& F, int l) {
    bf16* proj = (bf16*)(F.ws + WS_PROJ); bf16* ymix = (bf16*)(F.ws + WS_YMIX);
    const float* ong = F.in[I_ONG] + (size_t)l * DM;
    const int c4 = 4 * F.lane;
    f32x4 cw[3];
#pragma unroll
    for (int w = 0; w < 3; ++w) cw[w] = *(const f32x4*)(F.in[I_CONVW] + (size_t)(l * 3 + w) * 256 + c4);
    const f32x4 cg = *(const f32x4*)(ong + c4);
    const int e0 = 8 * (F.lane & 7);
    float gq[3][8]; int colv[3];
#pragma unroll
    for (int i = 0; i < 3; ++i) { const int vi = 8 * i + (F.lane >> 3); const int ty = vi / 6;
        colv[i] = (vi < 12 ? COL_SQ + 64 * vi : COL_FQ + 64 * (vi - 12)) + e0;
        const float* gp = (ty == 0 ? F.in[I_SBQG] : ty == 1 ? F.in[I_SBKG] : ty == 2 ? F.in[I_FXQG] : F.in[I_FXKG]) + (size_t)l * 64 + e0; const float sc = (ty == 0 || ty == 2) ? QSCALE : 1.0f;
#pragma unroll
        for (int q = 0; q < 8; ++q) gq[i][q] = gp[q] * sc; }
    LAS unsigned char* scr = F.lds + F.wave * (64 * 144);
    for (int tile = F.blk; tile < NTOK / 64; tile += F.G) {
        const int b = tile / (SEQ / 64), s0 = (tile % (SEQ / 64)) * 64; const size_t row0 = (size_t)b * SEQ + s0;
        {
            const int sw0 = s0 + F.wave * 8;
            f32x4 vm2 = (f32x4){0.f, 0.f, 0.f, 0.f}, vm1 = vm2;
            if (sw0 >= 2) {
                const bf16* p2 = proj + ((size_t)b * SEQ + sw0 - 2) * NPROJ; const bf16* p1 = p2 + NPROJ;
                const v2u c2 = *(const v2u*)(p2 + COL_CC + c4), u2 = *(const v2u*)(p2 + COL_CU + c4), c1 = *(const v2u*)(p1 + COL_CC + c4), u1 = *(const v2u*)(p1 + COL_CU + c4);
                vm2 = (f32x4){bflo(c2.x) * bflo(u2.x), bfhi(c2.x) * bfhi(u2.x), bflo(c2.y) * bflo(u2.y), bfhi(c2.y) * bfhi(u2.y)};
                vm1 = (f32x4){bflo(c1.x) * bflo(u1.x), bfhi(c1.x) * bfhi(u1.x), bflo(c1.y) * bflo(u1.y), bfhi(c1.y) * bfhi(u1.y)}; }
#pragma unroll 1
            for (int tt = 0; tt < 8; tt += 2) {
                bf16* pr[2]; v2u cb[2], cc[2], cu[2]; v4u xq[2][3];
#pragma unroll
                for (int u = 0; u < 2; ++u) { pr[u] = proj + ((size_t)b * SEQ + sw0 + tt + u) * NPROJ;
                    cb[u] = *(const v2u*)(pr[u] + COL_CB + c4); cc[u] = *(const v2u*)(pr[u] + COL_CC + c4); cu[u] = *(const v2u*)(pr[u] + COL_CU + c4);
#pragma unroll
                    for (int i = 0; i < 3; ++i) xq[u][i] = *(const v4u*)(pr[u] + colv[i]); }
                f32x4 y[2]; float ss[2], q2[2][3];
#pragma unroll
                for (int u = 0; u < 2; ++u) {
                    const f32x4 v0 = (f32x4){bflo(cc[u].x) * bflo(cu[u].x), bfhi(cc[u].x) * bfhi(cu[u].x), bflo(cc[u].y) * bflo(cu[u].y), bfhi(cc[u].y) * bfhi(cu[u].y)};
                    y[u] = cw[0] * vm2 + cw[1] * vm1 + cw[2] * v0; vm2 = vm1; vm1 = v0;
                    y[u] = y[u] * (f32x4){bflo(cb[u].x), bfhi(cb[u].x), bflo(cb[u].y), bfhi(cb[u].y)};
                    ss[u] = (y[u].x * y[u].x + y[u].y * y[u].y) + (y[u].z * y[u].z + y[u].w * y[u].w);
#pragma unroll
                    for (int i = 0; i < 3; ++i) { const v4u x = xq[u][i]; const float f[8] = {bflo(x.x), bfhi(x.x), bflo(x.y), bfhi(x.y), bflo(x.z), bfhi(x.z), bflo(x.w), bfhi(x.w)};
                        float a = 0.f;
#pragma unroll
                        for (int k = 0; k < 8; ++k) a += f[k] * f[k];
                        q2[u][i] = a; } }
#pragma unroll
                for (int o = 1; o < 16; o <<= 1)
#pragma unroll
                    for (int u = 0; u < 2; ++u) { ss[u] += shx(ss[u], o, F.lane);
                        if (o < 8) {
#pragma unroll
                            for (int i = 0; i < 3; ++i) q2[u][i] += shx(q2[u][i], o, F.lane); } }
#pragma unroll
                for (int u = 0; u < 2; ++u) {
                    const float rinv = 1.0f / sqrtf(ss[u] * (1.0f / 64.0f) + EPS);
                    const f32x4 yo = y[u] * rinv * cg;
                    v2u o; o.x = pk2(yo.x, yo.y); o.y = pk2(yo.z, yo.w); *(v2u*)(ymix + ((size_t)b * SEQ + sw0 + tt + u) * DM + c4) = o;
#pragma unroll
                    for (int i = 0; i < 3; ++i) { const v4u x = xq[u][i]; const float f[8] = {bflo(x.x), bfhi(x.x), bflo(x.y), bfhi(x.y), bflo(x.z), bfhi(x.z), bflo(x.w), bfhi(x.w)};
                        const float ri = 1.0f / sqrtf(q2[u][i] * (1.0f / 64.0f) + EPS);
                        v4u w; w.x = pk2(f[0] * ri * gq[i][0], f[1] * ri * gq[i][1]); w.y = pk2(f[2] * ri * gq[i][2], f[3] * ri * gq[i][3]);
                        w.z = pk2(f[4] * ri * gq[i][4], f[5] * ri * gq[i][5]); w.w = pk2(f[6] * ri * gq[i][6], f[7] * ri * gq[i][7]);
                        *(v4u*)(pr[u] + colv[i]) = w; } }
            }
        }
        for (int t = F.wave; t < 12; t += 8) {
            const int kind = t / 6, h = t % 6; const int col = (kind ? COL_FV : COL_SV) + 64 * h;
            const bf16* src = proj + (row0 + F.lane) * NPROJ + col;
#pragma unroll
            for (int pc = 0; pc < 8; ++pc) { const v4u x = *(const v4u*)(src + 8 * pc);
                const unsigned xs[4] = {x.x, x.y, x.z, x.w};
#pragma unroll
                for (int q = 0; q < 4; ++q) { *(LAS unsigned short*)(scr + (8 * pc + 2 * q) * 144 + 2 * F.lane) = (unsigned short)(xs[q] & 0xffffu);
                                              *(LAS unsigned short*)(scr + (8 * pc + 2 * q + 1) * 144 + 2 * F.lane) = (unsigned short)(xs[q] >> 16); } }
            asm volatile("s_waitcnt lgkmcnt(0)" ::: "memory");
            bf16* dst = (bf16*)(F.ws + WS_VT) + (size_t)kind * (48 * 64 * SEQ) + ((size_t)(b * 6 + h) * 64 + F.lane) * SEQ + s0;
#pragma unroll
            for (int pc = 0; pc < 8; ++pc) *(v4u*)(dst + 8 * pc) = *(const LAS v4u*)(scr + F.lane * 144 + 16 * pc);
            asm volatile("s_waitcnt lgkmcnt(0)" ::: "memory");
        }
        if (F.wave == 7) { const int gt = tile % (SEQ / 64); const float* gs = (const float*)(F.ws + WS_GSUM) + (size_t)(b * (SEQ / 64)) * 6; const float* lf = (const float*)(F.ws + WS_LOGF) + (row0 + F.lane) * 6;
            float* fo = (float*)(F.ws + WS_FCUM) + (size_t)(b * 6) * SEQ + s0 + F.lane;
#pragma unroll
            for (int h = 0; h < 6; ++h) { float base = (F.lane < gt) ? gs[F.lane * 6 + h] : 0.f; base = wave_sum(base, F.lane);
                float inc = lf[h];
#pragma unroll
                for (int o = 1; o < 64; o <<= 1) { const float t = shup(inc, o, F.lane); if (F.lane >= o) inc += t; }
                fo[(size_t)h * SEQ] = (base + inc) * LOG2E; } }
    }
}

__device__ __forceinline__ void p4_attention(Frame& F, int l) {
    att::Tensors Ts, Tf;
    Ts.proj = (const bf16*)(F.ws + WS_PROJ); Ts.vt = (const bf16*)(F.ws + WS_VT); Ts.fcum = (const float*)(F.ws + WS_FCUM); Ts.ymix = (bf16*)(F.ws + WS_YMIX); Ts.ong = F.in[I_ONG] + (size_t)l * DM;
    Ts.colq = COL_SQ; Ts.colk = COL_SK; Ts.coly = 256; Ts.tprobe = (void*)(F.ws + WS_CTL + 512);
    Tf = Ts; Tf.vt = Ts.vt + (size_t)48 * 64 * SEQ; Tf.colq = COL_FQ; Tf.colk = COL_FK; Tf.coly = 640;
    {
        float gq = fabsf(F.in[I_FXQG][l * 64 + F.lane]), gk = fabsf(F.in[I_FXKG][l * 64 + F.lane]);
#pragma unroll
        for (int o = 1; o < 32; o <<= 1) { gq = fmaxf(gq, shx(gq, o, F.lane)); gk = fmaxf(gk, shx(gk, o, F.lane)); }
        { auto rq = __builtin_amdgcn_permlane32_swap(__float_as_uint(gq), __float_as_uint(gq), false, false); gq = fmaxf(__uint_as_float(rq[0]), __uint_as_float(rq[1]));
          auto rk = __builtin_amdgcn_permlane32_swap(__float_as_uint(gk), __float_as_uint(gk), false, false); gk = fmaxf(__uint_as_float(rk[0]), __uint_as_float(rk[1])); }
        Tf.z2max = 64.0f * gq * gk * QSCALE * 1.02f; Ts.z2max = 0.f;
    }
    const int NU = 48 * 16;
    for (int i = 0; i * F.G < NU; ++i) {
        const int L = (i & 1) ? (i + 1) * F.G - 1 - F.blk : i * F.G + F.blk;
        if (L >= NU) continue;
        const int qb = 15 - L / 48, bh = L % 48;
#if defined(ATT_HYB) && (ATT_HYB & 1)
        { att_old::Tensors To; To.proj = Ts.proj; To.ymix = Ts.ymix; To.ong = Ts.ong; To.fcum = Ts.fcum; To.vt = Ts.vt; To.colq = Ts.colq; To.colk = Ts.colk; To.coly = Ts.coly; att_old::unit<0>(To, bh / 6, bh % 6, qb, F.lds, F.wave); }
#else
        att::unit<0>(Ts, bh / 6, bh % 6, qb, F.lds, F.wave);
#endif
    }
    for (int i = 0; i * F.G < NU; ++i) {
        const int L = (i & 1) ? (i + 1) * F.G - 1 - F.blk : i * F.G + F.blk;
        if (L >= NU) continue;
        const int qb = 15 - L / 48, bh = L % 48;
#if defined(ATT_HYB) && (ATT_HYB & 2)
        { att_old::Tensors To; To.proj = Tf.proj; To.ymix = Tf.ymix; To.ong = Tf.ong; To.fcum = Tf.fcum; To.vt = Tf.vt; To.colq = Tf.colq; To.colk = Tf.colk; To.coly = Tf.coly; att_old::unit<1>(To, bh / 6, bh % 6, qb, F.lds, F.wave); }
#else
        att::unit<1>(Tf, bh / 6, bh % 6, qb, F.lds, F.wave);
#endif
    }
}

__device__ __forceinline__ void top4of8(const float (&v)[8], const int (&ix)[8], float (&tv)[4], int (&ti)[4]) {
    float w[8];
#pragma unroll
    for (int j = 0; j < 8; ++j) w[j] = v[j];
#pragma unroll
    for (int k = 0; k < 4; ++k) { float bv = w[0]; int bi = ix[0];
#pragma unroll
        for (int j = 1; j < 8; ++j) { const bool t = (w[j] > bv) || (w[j] == bv && ix[j] < bi); bv = t ? w[j] : bv; bi = t ? ix[j] : bi; }
        tv[k] = bv; ti[k] = bi;
#pragma unroll
        for (int j = 0; j < 8; ++j) w[j] = (ix[j] == bi) ? -INFINITY : w[j]; }
}
__device__ __forceinline__ void p6_norm_router(Frame& F, int l, const bf16* x1) {
    bf16* H = (bf16*)(F.ws + WS_H); unsigned char* H8 = F.ws + WS_H8; float* topw = (float*)(F.ws + WS_TOPW); int* route = (int*)(F.ws + WS_ROUTE); int* hist = (int*)(F.ws + WS_HIST);
    const float* rw = F.in[I_RW] + (size_t)l * DM * NEXP; const float* rb = F.in[I_RB] + (size_t)l * NEXP;
#ifdef P6SEG
    unsigned long long sg_acc = 0ull, sg_t = __builtin_readcyclecounter();
#define SEG(n) do { const unsigned long long t_ = __builtin_readcyclecounter(); if ((n) == P6SEG) sg_acc += t_ - sg_t; sg_t = t_; asm volatile("" :: "s"(t_)); } while (0)
#else
#define SEG(n) do {} while (0)
#endif
    constexpr int RWP = 2064;
    LAS unsigned char* rwt = F.lds;
    LAS int* cnt = (LAS int*)(F.lds + MISC_OFF + 256);
    {
        f32x4 t[16];
#pragma unroll
        for (int i = 0; i < 16; ++i) t[i] = *(const f32x4*)(rw + (size_t)(2 * F.tid) * NEXP + 4 * i);
#pragma unroll
        for (int i = 0; i < 8; ++i)
#pragma unroll
            for (int c = 0; c < 4; ++c) *(LAS unsigned*)(rwt + (4 * i + c) * RWP + 4 * F.tid) = f2bf(t[i][c]) | (f2bf(t[8 + i][c]) << 16);
    }
    __syncthreads();
    SEG(0);
    const int fr = F.lane & 15, fq = F.lane >> 4;
    float rbv[8]; int eix[8];
#pragma unroll
    for (int i = 0; i < 4; ++i) { eix[i] = 4 * fq + i; eix[4 + i] = 16 + 4 * fq + i; rbv[i] = rb[4 * fq + i]; rbv[4 + i] = rb[16 + 4 * fq + i]; }
    for (int chunk = F.blk; chunk < NTOK / 128; chunk += F.G) {
        const int b = chunk / (SEQ / 128);
        if (F.tid < 32) cnt[F.tid] = 0;
        __syncthreads();
        f32x4 A[4], Bv[4];
#pragma unroll
        for (int j = 0; j < 4; ++j) { const int c = 256 * j + 4 * F.lane; const f32x4 g = *(const f32x4*)(F.in[I_N2G] + (size_t)l * DM + c); A[j] = g * (mod4(F, l, b, 4, c) + 1.0f); Bv[j] = mod4(F, l, b, 3, c); }
        const int row0 = chunk * 128 + F.wave * 16;
        SEG(1);
#pragma unroll 1
        for (int rr = 0; rr < 16; rr += 4) {
            f32x4 v[4][4]; float ss[4];
#pragma unroll
            for (int u = 0; u < 4; ++u)
#pragma unroll
                for (int j = 0; j < 4; ++j) v[u][j] = ld_row4<true>(x1, (size_t)(row0 + rr + u) * DM + 256 * j + 4 * F.lane);
#pragma unroll
            for (int u = 0; u < 4; ++u) { float s = 0.f;
#pragma unroll
                for (int j = 0; j < 4; ++j) s += (v[u][j].x * v[u][j].x + v[u][j].y * v[u][j].y) + (v[u][j].z * v[u][j].z + v[u][j].w * v[u][j].w);
                ss[u] = s; }
#pragma unroll
            for (int o = 1; o < 32; o <<= 1) { ss[0] += shx(ss[0], o, F.lane); ss[1] += shx(ss[1], o, F.lane); ss[2] += shx(ss[2], o, F.lane); ss[3] += shx(ss[3], o, F.lane); }
            ss[0] = add_other_half(ss[0]); ss[1] = add_other_half(ss[1]); ss[2] = add_other_half(ss[2]); ss[3] = add_other_half(ss[3]);
#pragma unroll
            for (int u = 0; u < 4; ++u) { const float rstd = 1.0f / sqrtf(ss[u] * (1.0f / DM) + EPS);
#pragma unroll
                for (int j = 0; j < 4; ++j) { const f32x4 hv = v[u][j] * rstd * A[j] + Bv[j];
                    v2u o; o.x = pk2(hv.x, hv.y); o.y = pk2(hv.z, hv.w); *(v2u*)(H + (size_t)(row0 + rr + u) * DM + 256 * j + 4 * F.lane) = o;
                    *(unsigned*)(H8 + (size_t)(row0 + rr + u) * DM + 256 * j + 4 * F.lane) = pg8::pk4_fp8(hv.x, hv.y, hv.z, hv.w); } }
        }
        SEG(2);
        asm volatile("s_waitcnt vmcnt(0)" ::: "memory");
        f32x4 acc0 = (f32x4){0.f, 0.f, 0.f, 0.f}, acc1 = (f32x4){0.f, 0.f, 0.f, 0.f};
        { const bf16* hp = H + (size_t)(row0 + fr) * DM + 8 * fq; const LAS unsigned char* wp = rwt + fr * RWP + 16 * fq;
#pragma unroll 8
          for (int s = 0; s < 32; ++s) { const v4u hb = __builtin_nontemporal_load((const v4u*)(hp + 32 * s));
              const bf16x8 a0 = *(const LAS bf16x8*)(wp + 64 * s), a1 = *(const LAS bf16x8*)(wp + 16 * RWP + 64 * s);
              acc0 = __builtin_amdgcn_mfma_f32_16x16x32_bf16(a0, __builtin_bit_cast(bf16x8, hb), acc0, 0, 0, 0);
              acc1 = __builtin_amdgcn_mfma_f32_16x16x32_bf16(a1, __builtin_bit_cast(bf16x8, hb), acc1, 0, 0, 0); } }
        SEG(3);
        float cv[8], tv[4], ov[8]; int ti[4], oi[8];
#pragma unroll
        for (int i = 0; i < 4; ++i) { cv[i] = acc0[i] + rbv[i]; cv[4 + i] = acc1[i] + rbv[4 + i]; }
        top4of8(cv, eix, tv, ti);
        {
#pragma unroll
            for (int k = 0; k < 4; ++k) { ov[k] = tv[k]; oi[k] = ti[k]; ov[4 + k] = shx(tv[k], 16, F.lane); oi[4 + k] = shxi(ti[k], 16, F.lane); }
            top4of8(ov, oi, tv, ti);
#pragma unroll
            for (int k = 0; k < 4; ++k) { auto rv = __builtin_amdgcn_permlane32_swap(__float_as_uint(tv[k]), __float_as_uint(tv[k]), false, false); auto ri = __builtin_amdgcn_permlane32_swap((unsigned)ti[k], (unsigned)ti[k], false, false);
                ov[k] = __uint_as_float(rv[0]); oi[k] = (int)ri[0]; ov[4 + k] = __uint_as_float(rv[1]); oi[4 + k] = (int)ri[1]; }
            top4of8(ov, oi, tv, ti); }
        const float e1 = __expf(tv[1] - tv[0]), e2 = __expf(tv[2] - tv[0]), e3 = __expf(tv[3] - tv[0]); const float inv = 1.0f / (1.0f + e1 + e2 + e3);
        { const int row = row0 + fr, k = fq;
          const float w = (k == 0 ? 1.0f : k == 1 ? e1 : k == 2 ? e2 : e3) * inv; const int ex = (k == 0 ? ti[0] : k == 1 ? ti[1] : k == 2 ? ti[2] : ti[3]);
          const int pos = __hip_atomic_fetch_add(cnt + ex, 1, __ATOMIC_RELAXED, __HIP_MEMORY_SCOPE_WORKGROUP);
          topw[row * 4 + k] = w; route[row * 4 + k] = ex + 32 * pos; }
        SEG(4);
        __syncthreads();
        if (F.tid < 32) hist[chunk * 32 + F.tid] = cnt[F.tid];
        __syncthreads();
        SEG(5);
    }
#ifdef P6SEG
    if (F.blk == 0 && F.tid == 0) atomicAdd((unsigned long long*)(F.ws + WS_CTL + 512), sg_acc);
#endif
}

__device__ __forceinline__ void p7_scatter(Frame& F) {
    const int* hist = (const int*)(F.ws + WS_HIST); const int* route = (const int*)(F.ws + WS_ROUTE);
    int* tokslot = (int*)(F.ws + WS_TOKSLOT); int* slottok = (int*)(F.ws + WS_SLOTTOK); int* moetab = (int*)(F.ws + WS_MOETAB);
    LAS int* pre = (LAS int*)F.lds;
    LAS int* base = (LAS int*)(F.lds + 32768);
    for (int i = F.tid; i < 256 * 32; i += 512) pre[i] = hist[i];
    __syncthreads();
    if (F.tid < 32) { int run = 0;
        for (int c = 0; c < 256; ++c) { const int v = pre[c * 32 + F.tid]; pre[c * 32 + F.tid] = run; run += v; }
        base[64 + F.tid] = run; }
    __syncthreads();
    if (F.tid == 0) { int run = 0; for (int ex = 0; ex < NEXP; ++ex) { base[ex] = run; run += (base[64 + ex] + 255) & ~255; } base[NEXP] = run; }
    __syncthreads();
    if (F.blk == 0 && F.tid <= NEXP) moetab[F.tid] = base[F.tid] >> 8;
    for (int chunk = F.blk; chunk < NTOK / 128; chunk += F.G) {
        const int t = chunk * 128 + (F.tid >> 2), k = F.tid & 3; const int rt = route[t * 4 + k]; const int ex = rt & 31, pos = rt >> 5;
        const int slot = base[ex] + pre[chunk * 32 + ex] + pos;
        tokslot[t * 4 + k] = slot; slottok[slot] = t;
    }
    for (int ex = F.blk; ex < NEXP; ex += F.G) { const int lo = base[ex] + base[64 + ex], hi = base[ex + 1]; for (int s = lo + F.tid; s < hi; s += 512) slottok[s] = 0; }
    __syncthreads();
}

struct Args { const float* in[21]; float* out; unsigned char* ws; int ph_lo, ph_hi; };
__device__ __forceinline__ void launder(Frame& F, int wave) {
#if 0
    int t = threadIdx.x; asm volatile("" : "+v"(t)); F.tid = t; F.lane = t & 63; F.wave = __builtin_amdgcn_readfirstlane(t >> 6); (void)wave;
#else
    int t = lane_id(); asm volatile("" : "+v"(t)); F.lane = t & 63; F.wave = wave; F.tid = wave * 64 + F.lane;
#endif
    const __attribute__((address_space(4))) Args* ap = (const __attribute__((address_space(4))) Args*)__builtin_amdgcn_kernarg_segment_ptr(); asm volatile("" : "+s"(ap));
#pragma unroll
    for (int i = 0; i < 21; ++i) F.in[i] = ap->in[i];
    F.out = ap->out; F.ws = ap->ws; }
constexpr int N_PHASES = 1 + 9 * NLAYER + 1;

#define PHASE_FN __device__ __forceinline__
__device__ __forceinline__ void make_frame(Frame& F, LAS unsigned char* lds, int wave) { F.lds = lds; int bk = blockIdx.x, gd = gridDim.x; asm volatile("" : "+s"(bk), "+s"(gd)); F.blk = bk; F.G = gd; launder(F, wave); }
PHASE_FN void ph_prologue(LAS unsigned char* lds, int wave) { Frame F; make_frame(F, lds, wave); p0_prologue(F); }
PHASE_FN void ph_norm1(LAS unsigned char* lds, int wave, int l) { Frame F; make_frame(F, lds, wave);
    if (l == 0) row_phase<false, true, false, false>(F, 0, F.in[I_X], nullptr); else row_phase<true, true, true, true>(F, l, F.ws + WS_XA, F.ws + WS_XB); }
PHASE_FN void ph_proj(LAS unsigned char* lds, int wave, int l) { Frame F; make_frame(F, lds, wave);
    pg8::Gemm g{(const bf16*)(F.ws + WS_H), (const bf16*)(F.ws + WS_WIN + (size_t)l * NPROJ * DM * (P2_FP8 ? 1 : 2)), nullptr, P2_FP8 ? DM / 2 : DM};
    pg8::StaticOrder S; S.init(NTOK, NPROJ, F.G, F.blk);
    pg8::EpiProj E{(bf16*)(F.ws + WS_PROJ), NPROJ};
    pg8::gemm_phase<pg8::EpiProj, pg8::StaticOrder, false, P2_FP8 != 0>(F.lds, g, S, E, F.wave); }
PHASE_FN void ph_postproj(LAS unsigned char* lds, int wave, int l) { Frame F; make_frame(F, lds, wave); p3_postproj(F, l); }
PHASE_FN void ph_attn(LAS unsigned char* lds, int wave, int l) { Frame F; make_frame(F, lds, wave); p4_attention(F, l); }
PHASE_FN void ph_out(LAS unsigned char* lds, int wave, int l) { Frame F; make_frame(F, lds, wave);
    pg8::Gemm g{(const bf16*)(F.ws + WS_YMIX), (const bf16*)(F.ws + WS_WOUT) + (size_t)l * DM * DM, nullptr, DM};
    pg8::StaticOrder S; S.init(NTOK, DM, F.G, F.blk);
    const float* gb = F.in[I_BADA] + (size_t)l * 6144 + 2 * DM; const float* gp = (const float*)(F.ws + WS_MODP) + (size_t)l * 4 * NB * 6144 + 2 * DM;
    if (l == 0) { pg8::EpiResGate<false> E{F.in[I_X], (bf16*)(F.ws + WS_XA), gb, gp}; pg8::gemm_phase<pg8::EpiResGate<false>, pg8::StaticOrder, false>(F.lds, g, S, E, F.wave); }
    else { pg8::EpiResGate<true> E{F.ws + WS_XB, (bf16*)(F.ws + WS_XA), gb, gp}; pg8::gemm_phase<pg8::EpiResGate<true>, pg8::StaticOrder, false>(F.lds, g, S, E, F.wave); } }
PHASE_FN void ph_router(LAS unsigned char* lds, int wave, int l) { Frame F; make_frame(F, lds, wave); p6_norm_router(F, l, (const bf16*)(F.ws + WS_XA)); }
PHASE_FN void ph_scatter(LAS unsigned char* lds, int wave) { Frame F; make_frame(F, lds, wave); p7_scatter(F); }
__device__ __forceinline__ LAS int* moe_table(Frame& F) { LAS int* tb = (LAS int*)(F.lds + MISC_OFF + 64);
    if (F.tid <= NEXP) tb[F.tid] = ((const int*)(F.ws + WS_MOETAB))[F.tid];
    __syncthreads(); return tb; }
PHASE_FN void ph_moe_up(LAS unsigned char* lds, int wave, int l) { Frame F; make_frame(F, lds, wave); LAS int* tb = moe_table(F);
    pg8::Gemm g{(const bf16*)(F.ws + WS_H8), (const bf16*)(F.ws + WS_W1 + (size_t)l * NEXP * 2048 * DM), (const int*)(F.ws + WS_SLOTTOK), DM / 2};
    pg8::MoeOrder S; S.init(tb, 8, F.G, F.blk);
    pg8::EpiSwiglu8 E{F.ws + WS_ACT, F.in[I_B1] + (size_t)l * NEXP * 2048};
    pg8::gemm_phase<pg8::EpiSwiglu8, pg8::MoeOrder, true, true>(F.lds, g, S, E, F.wave); }
struct EpiNull { static constexpr bool PERM = true;
    __device__ __forceinline__ void init(f32x4 (&acc)[2][2][4][2], const pg8::Unit&, int, int, int, int) const {
#pragma unroll
        for (int a = 0; a < 2; ++a)
#pragma unroll
            for (int b = 0; b < 2; ++b)
#pragma unroll
                for (int m = 0; m < 4; ++m)
#pragma unroll
                    for (int n = 0; n < 2; ++n) acc[a][b][m][n] = (f32x4){0.f, 0.f, 0.f, 0.f}; }
    __device__ __forceinline__ void operator()(const f32x4 (&acc)[2][2][4][2], const pg8::Unit& u, int wr, int wc, int fr, int fq) const { float s = 0.f;
#pragma unroll
    for (int a = 0; a < 2; ++a)
#pragma unroll
        for (int b = 0; b < 2; ++b)
#pragma unroll
            for (int m = 0; m < 4; ++m)
#pragma unroll
                for (int n = 0; n < 2; ++n) s += acc[a][b][m][n][0] + acc[a][b][m][n][1] + acc[a][b][m][n][2] + acc[a][b][m][n][3];
    asm volatile("" :: "v"(s)); } };
PHASE_FN void ph_moe_down_nostore(LAS unsigned char* lds, int wave, int l) { Frame F; make_frame(F, lds, wave); LAS int* tb = moe_table(F);
    pg8::Gemm g{(const bf16*)(F.ws + WS_ACT), (const bf16*)(F.ws + WS_W2 + (size_t)l * NEXP * DM * DM), nullptr, DM / 2};
    pg8::MoeOrder S; S.init(tb, 4, F.G, F.blk);
#if EXP_NOSTORE == 2
    pg8::EpiY E{F.ws + WS_PROJ, nullptr};
    pg8::gemm_phase<pg8::EpiY, pg8::MoeOrder, false, true>(F.lds, g, S, E, F.wave); }
#else
    EpiNull E;
    pg8::gemm_phase<EpiNull, pg8::MoeOrder, false, true>(F.lds, g, S, E, F.wave); }
#endif
PHASE_FN void ph_moe_down(LAS unsigned char* lds, int wave, int l) { Frame F; make_frame(F, lds, wave); LAS int* tb = moe_table(F);
    pg8::Gemm g{(const bf16*)(F.ws + WS_ACT), (const bf16*)(F.ws + WS_W2 + (size_t)l * NEXP * DM * DM), nullptr, DM / 2, (void*)(F.ws + WS_CTL + 512)};
    pg8::MoeOrder S; S.init(tb, 4, F.G, F.blk);
    pg8::EpiY E{F.ws + WS_Y, F.in[I_B2] + (size_t)l * NEXP * DM};
    pg8::gemm_phase<pg8::EpiY, pg8::MoeOrder, false, true>(F.lds, g, S, E, F.wave); }
PHASE_FN void ph_final(LAS unsigned char* lds, int wave) { Frame F; make_frame(F, lds, wave); row_phase<true, false, true, false>(F, NLAYER, F.ws + WS_XA, F.out); }

#ifndef REP_MASK
#define REP_MASK 0
#endif
#ifndef MK_SPLIT
#define MK_SPLIT 0
#endif
#if !MK_SPLIT
__global__ void __launch_bounds__(512, 2) fwd_kernel(Args args) {
    extern __shared__ __attribute__((aligned(16))) unsigned char lds_raw[];
    LAS unsigned char* lds = (LAS unsigned char*)lds_raw;
    volatile LAS unsigned* MISC = (volatile LAS unsigned*)(lds + MISC_OFF);
    if (threadIdx.x < 16) MISC[threadIdx.x] = 0u;
    const int wave = __builtin_amdgcn_readfirstlane(threadIdx.x >> 6);
    __syncthreads();
    const XcdBarrier bar = xcd_barrier_post((unsigned*)(args.ws + WS_CTL) + CW_BAR, MISC, wave);
#define IN(k) true
#define SEAM(k) xcd_barrier(bar)
#define REPS(j) for (int rep_ = 0; rep_ < (((REP_MASK >> (j)) & 1) ? 2 : 1); ++rep_)
#ifdef PT_SEL
    unsigned long long pt_acc = 0ull, pt_t0 = 0ull;
#define PT_BEGIN(j) do { if ((j) == PT_SEL) pt_t0 = __builtin_amdgcn_s_memrealtime(); } while (0)
#define PT_END(j) do { if ((j) == PT_SEL) { const unsigned long long t1_ = __builtin_amdgcn_s_memrealtime(); pt_acc += t1_ - pt_t0; } } while (0)
#else
#define PT_BEGIN(j) do {} while (0)
#define PT_END(j) do {} while (0)
#endif
    if (IN(0)) { REPS(0) { PT_BEGIN(0); ph_prologue(lds, wave); SEAM(0); PT_END(0); } }
    for (int l = 0; l < NLAYER; ++l) {
        const int p = 1 + 9 * l;
        if (IN(p + 0)) { REPS(1) { PT_BEGIN(1); ph_norm1(lds, wave, l); SEAM(p + 0); PT_END(1); } }
        if (IN(p + 1)) { REPS(2) { PT_BEGIN(2); ph_proj(lds, wave, l); SEAM(p + 1); PT_END(2); } }
        if (IN(p + 2)) { PT_BEGIN(3); ph_postproj(lds, wave, l); SEAM(p + 2); PT_END(3); }
        if (IN(p + 3)) { REPS(4) { PT_BEGIN(4); ph_attn(lds, wave, l); SEAM(p + 3); PT_END(4); } }
        if (IN(p + 4)) { REPS(5) { PT_BEGIN(5); ph_out(lds, wave, l); SEAM(p + 4); PT_END(5); } }
        if (IN(p + 5)) { REPS(6) { PT_BEGIN(6); ph_router(lds, wave, l); SEAM(p + 5); PT_END(6); } }
        if (IN(p + 6)) { REPS(7) { PT_BEGIN(7); ph_scatter(lds, wave); SEAM(p + 6); PT_END(7); } }
        if (IN(p + 7)) { REPS(8) { PT_BEGIN(8); ph_moe_up(lds, wave, l); SEAM(p + 7); PT_END(8); } }
        if (IN(p + 8)) { REPS(9) { PT_BEGIN(9); ph_moe_down(lds, wave, l); SEAM(p + 8); PT_END(9); } }
    }
    if (IN(N_PHASES - 1)) { REPS(10) { PT_BEGIN(10); ph_final(lds, wave); PT_END(10); } }
#ifdef PT_SEL
    if (blockIdx.x == 0 && wave == 0 && lane_id() == 0) { const unsigned long long t0_ = __builtin_amdgcn_s_memrealtime(); while (__builtin_amdgcn_s_memrealtime() - t0_ < pt_acc * PT_K) __builtin_amdgcn_s_sleep(8); }
#endif
#ifdef P6SEG
    if (blockIdx.x == 0 && wave == 0 && lane_id() == 0) { __builtin_amdgcn_s_waitcnt(0);
        const unsigned long long acc = __hip_atomic_load((unsigned long long*)(args.ws + WS_CTL + 512), __ATOMIC_RELAXED, __HIP_MEMORY_SCOPE_AGENT) * 4ull;
        const unsigned long long t0 = __builtin_readcyclecounter(); while (__builtin_readcyclecounter() - t0 < acc) __builtin_amdgcn_s_sleep(4); }
#endif
#ifdef TPG
    if (blockIdx.x == 3 && wave == 0 && lane_id() == 0) { __builtin_amdgcn_s_waitcnt(0);
        const unsigned long long acc = __hip_atomic_load((unsigned long long*)(args.ws + WS_CTL + 512), __ATOMIC_RELAXED, __HIP_MEMORY_SCOPE_AGENT) * ((TPG == 1) ? 1ull : 100000ull);
        const unsigned long long t0 = __builtin_readcyclecounter(); while (__builtin_readcyclecounter() - t0 < acc) __builtin_amdgcn_s_sleep(4); }
#endif
#ifdef TPROBE
    if (blockIdx.x == TPROBE_BLK && wave == 0 && lane_id() == 0) {
        __builtin_amdgcn_s_waitcnt(0);
        const unsigned long long acc = __hip_atomic_load((unsigned long long*)(args.ws + WS_CTL + 512), __ATOMIC_RELAXED, __HIP_MEMORY_SCOPE_AGENT) * TPROBE_K;
        const unsigned long long t0 = __builtin_readcyclecounter();
        while (__builtin_readcyclecounter() - t0 < acc) __builtin_amdgcn_s_sleep(4);
    }
#endif
#if defined(UBENCH) && UBENCH >= 4
    {
        f32x4 c[16]; v8i a8, b8; bf16x8 a4, b4;
#pragma unroll
        for (int i = 0; i < 16; ++i) c[i] = (f32x4){0.f, 0.f, 0.f, 0.f};
#pragma unroll
        for (int i = 0; i < 8; ++i) { a8[i] = 0x38383838; b8[i] = 0x38383838; a4[i] = 0x3c00; b4[i] = 0x3c00; }
        const int sw = 0x7F7F7F7F;
        for (int it = 0; it < UBENCH_ITERS; ++it) {
#pragma unroll
            for (int i = 0; i < 16; ++i) {
#if UBENCH == 4
                asm volatile("v_mfma_scale_f32_16x16x128_f8f6f4 %0, %1, %2, %0, %3, %4 op_sel_hi:[0,0,0]" : "+v"(c[i]) : "v"(a8), "v"(b8), "v"(sw), "v"(sw));
#else
                c[i] = __builtin_amdgcn_mfma_f32_16x16x32_bf16(a4, b4, c[i], 0, 0, 0);
#endif
            }
        }
        float s = 0.f;
#pragma unroll
        for (int i = 0; i < 16; ++i) s += c[i][0];
        if (s == 123.456f) ((float*)(args.ws + WS_GSUM + 14000))[0] = s;
    }
#elif defined(UBENCH)
    {
        float v[32];
#pragma unroll
        for (int i = 0; i < 32; ++i) v[i] = (float)(lane_id() + i) * 1e-3f;
        for (int it = 0; it < UBENCH_ITERS; ++it) {
#pragma unroll
            for (int i = 0; i < 32; ++i) {
#if UBENCH == 1
                v[i] = __builtin_amdgcn_exp2f(v[i]);
#elif UBENCH == 2
                v[i] = v[i] * 1.0001f + 0.5f;
#elif UBENCH == 3
                v[i] = __builtin_amdgcn_logf(v[i]);
#endif
            }
            asm volatile("" ::: "memory");
        }
        float s = 0.f;
#pragma unroll
        for (int i = 0; i < 32; ++i) s += v[i];
        if (s == 123.456f) ((float*)(args.ws + WS_GSUM + 14000))[0] = s;
    }
#endif
#undef IN
#undef SEAM
#undef REPS
}

#endif
template <int KIND> __global__ void __launch_bounds__(512, 2) phase_kernel(Args args, int l) {
    extern __shared__ __attribute__((aligned(16))) unsigned char lds_raw[];
    LAS unsigned char* lds = (LAS unsigned char*)lds_raw; const int wave = __builtin_amdgcn_readfirstlane(threadIdx.x >> 6);
    if (KIND == 0) ph_prologue(lds, wave); if (KIND == 1) ph_norm1(lds, wave, l); if (KIND == 2) ph_proj(lds, wave, l); if (KIND == 3) ph_postproj(lds, wave, l); if (KIND == 4) ph_attn(lds, wave, l);
    if (KIND == 5) ph_out(lds, wave, l); if (KIND == 6) ph_router(lds, wave, l); if (KIND == 7) ph_scatter(lds, wave); if (KIND == 8) ph_moe_up(lds, wave, l); if (KIND == 9) ph_moe_down(lds, wave, l); if (KIND == 10) ph_final(lds, wave);
#ifdef EXP_NOSTORE
    if (KIND == 11) ph_moe_down_nostore(lds, wave, l);
#endif
}
template <int KIND> static void launch_phase(const Args& a, int l, int grid, hipStream_t stream) {
    static bool attr = false;
    if (!attr) { (void)hipFuncSetAttribute((const void*)phase_kernel<KIND>, hipFuncAttributeMaxDynamicSharedMemorySize, LDS_BYTES); attr = true; }
    for (int rep = 0; rep < (((REP_MASK >> KIND) & 1) ? 2 : 1); ++rep) hipLaunchKernelGGL(phase_kernel<KIND>, dim3(grid), dim3(512), LDS_BYTES, stream, a, l);
}

extern "C" void kernel_launch(void* const* d_in, const int* in_sizes, int n_in, void* d_out, int out_size, void* d_ws, size_t ws_size, hipStream_t stream) {
    static int grid = 0;
    if (grid == 0) {
        if (n_in != 21 || in_sizes[0] != NTOK * DM || out_size != NTOK * DM || ws_size < WS_END) {
            fprintf(stderr, "kernel_launch: unexpected shapes: n_in %d in0 %d out %d ws %zu (need %zu)\n", n_in, n_in > 0 ? in_sizes[0] : -1, out_size, ws_size, (size_t)WS_END); grid = -1; return; }
        int dev = 0, cus = 0, per_cu = 0;
        if (hipGetDevice(&dev) != hipSuccess || hipDeviceGetAttribute(&cus, hipDeviceAttributeMultiprocessorCount, dev) != hipSuccess) { fprintf(stderr, "kernel_launch: device query failed\n"); grid = -1; return; }
#if !MK_SPLIT
        if (hipFuncSetAttribute((const void*)fwd_kernel, hipFuncAttributeMaxDynamicSharedMemorySize, LDS_BYTES) != hipSuccess) { fprintf(stderr, "kernel_launch: hipFuncSetAttribute failed\n"); grid = -1; return; }
        if (hipOccupancyMaxActiveBlocksPerMultiprocessor(&per_cu, (const void*)fwd_kernel, 512, LDS_BYTES) != hipSuccess || per_cu < 1) fprintf(stderr, "kernel_launch: note: occupancy query says %d\n", per_cu);
        (void)hipGetLastError();
#endif
        grid = cus;
    }
    if (grid < 0) return;
    (void)hipMemsetAsync((char*)d_ws + WS_CTL, 0, CTL_ZERO_BYTES, stream);
    Args a{};
    for (int i = 0; i < 21; ++i) a.in[i] = (const float*)d_in[i];
    a.out = (float*)d_out; a.ws = (unsigned char*)d_ws;
#if MK_SPLIT
    a.ph_lo = 0; a.ph_hi = 0;
    launch_phase<0>(a, 0, grid, stream);
    for (int l = 0; l < NLAYER; ++l) { launch_phase<1>(a, l, grid, stream); launch_phase<2>(a, l, grid, stream); launch_phase<3>(a, l, grid, stream); launch_phase<4>(a, l, grid, stream); launch_phase<5>(a, l, grid, stream);
        launch_phase<6>(a, l, grid, stream); launch_phase<7>(a, l, grid, stream); launch_phase<8>(a, l, grid, stream);
#ifdef EXP_NOSTORE
        launch_phase<11>(a, l, grid, stream);
#endif
        launch_phase<9>(a, l, grid, stream); }
    launch_phase<10>(a, 0, grid, stream);
#else
    a.ph_lo = 0; a.ph_hi = N_PHASES; hipLaunchKernelGGL(fwd_kernel, dim3(grid), dim3(512), LDS_BYTES, stream, a);
#endif
}
```

```cpp
#include <hip/hip_runtime.h>
#include <cstdio>
#include <cstdint>

#define GAS __attribute__((address_space(1)))
#define LAS __attribute__((address_space(3)))
typedef unsigned short bf16;
typedef unsigned v4u __attribute__((ext_vector_type(4)));
typedef unsigned v2u __attribute__((ext_vector_type(2)));
typedef float f32x4 __attribute__((ext_vector_type(4)));
typedef float f32x2 __attribute__((ext_vector_type(2)));
typedef float f32x16 __attribute__((ext_vector_type(16)));
typedef short bf16x8 __attribute__((ext_vector_type(8)));
typedef _Float16 f16x8 __attribute__((ext_vector_type(8)));
typedef _Float16 f16x2 __attribute__((ext_vector_type(2)));
typedef int v4i __attribute__((ext_vector_type(4)));
typedef int v8i __attribute__((ext_vector_type(8)));

namespace pg8 {
constexpr int BM = 256, BK = 64, HALF = 128, HTB = HALF * BK * 2  , STAGE_BYTES = 8 * HTB, NXCD = 8, WGM = 8;

__host__ __device__ __forceinline__ int lds_byte(int r, int c) { const int st = (r >> 4) * 2 + (c >> 5), rr = r & 15, cc = c & 31, ob = rr * 64 + cc * 2; return st * 1024 + (ob ^ (((ob >> 9) & 1) << 5)); }
__host__ __device__ __forceinline__ void stage_rc(int b, int& R, int& C) { const int st = b / 1024, sb = b % 1024, swz = sb ^ (((sb >> 9) & 1) << 5); R = (st >> 1) * 16 + swz / 64; C = (st & 1) * 32 + (swz % 64) / 2; }
__host__ __device__ __forceinline__ int perm32(int rho) { const int n = rho >> 4, i = rho & 15; return 8 * (i >> 2) + 4 * n + (i & 3); }

struct Unit { int pm, pn, pb; };
struct Gemm { const bf16* A; const bf16* Bt; const int* rowmap; int K; void* tprobe = nullptr; };

__device__ __forceinline__ unsigned cvt_pk_bf16(float lo, float hi) { unsigned r; asm volatile("v_cvt_pk_bf16_f32 %0, %1, %2" : "=v"(r) : "v"(lo), "v"(hi)); return r; }

template <class Epi, class Sched, bool GATHER, bool FP8 = false>
__device__ __forceinline__ void gemm_phase(LAS unsigned char* lds, const Gemm g, const Sched& S, const Epi& E, int wave) {
    int lane_ = (int)__builtin_amdgcn_mbcnt_hi(~0u, __builtin_amdgcn_mbcnt_lo(~0u, 0u)); asm volatile("" : "+v"(lane_));
    const int wid = wave, lane = lane_, tid = wid * 64 + lane, wr = wid >> 2, wc = wid & 3, fr = lane & 15, fq = lane >> 4;
    const int K = g.K, nt = K / BK;
    unsigned voffA[2], voffB[2]; int RA[2], CA[2];
#pragma unroll
    for (int i = 0; i < 2; ++i) { int R, C; stage_rc(tid * 16 + i * 8192, R, C); const int Rb = Epi::PERM ? ((R & ~31) + perm32(R & 31)) : R; RA[i] = R; CA[i] = C;
        voffA[i] = (unsigned)(R * K + C) * 2u; voffB[i] = (unsigned)(Rb * K + C) * 2u; }
    const size_t kstep = (size_t)(BK * 2);
    const size_t hstep = (size_t)HALF * K * 2;
    const size_t tstep = 2 * hstep;
    const unsigned ldsw = (unsigned)wid * 1024u;
    const int aoff = lds_byte(wr * 64 + fr, fq * 8), boff = lds_byte(wc * 32 + fr, fq * 8);
#define PG8_SA(b, h) (((b) * 2 + (h)) * HTB)
#define PG8_SB(b, h) ((4 + (b) * 2 + (h)) * HTB)
#define PG8_STAGE(bufoff, gbase, voff) do { _Pragma("unroll") for (int _i = 0; _i < 2; ++_i) \
        __builtin_amdgcn_global_load_lds((const unsigned*)((const char*)(gbase) + (voff)[_i]), (LAS unsigned*)(lds + (bufoff) + ldsw + _i * 8192), 16, 0, 0); } while (0)
#define PG8_STAGEA(bufoff, pbase, h, nx) do { if constexpr (GATHER) { _Pragma("unroll") for (int _i = 0; _i < 2; ++_i) \
        __builtin_amdgcn_global_load_lds((const unsigned*)((const char*)(pbase) + ((nx) ? gn[h][_i] : gc[h][_i])), (LAS unsigned*)(lds + (bufoff) + ldsw + _i * 8192), 16, 0, 0); } \
        else { PG8_STAGE(bufoff, (const char*)(pbase) + (h) * hstep, voffA); } } while (0)
#define PG8_LDA(dst, b, h) do { if constexpr (FP8) { _Pragma("unroll") for (int m = 0; m < 4; ++m) dst##8[m] = __builtin_shufflevector(*(const LAS v4i*)(lds + PG8_SA(b, h) + aoff + m * 2048), *(const LAS v4i*)(lds + PG8_SA(b, h) + aoff + m * 2048 + 1024), 0, 1, 2, 3, 4, 5, 6, 7); } \
        else { _Pragma("unroll") for (int m = 0; m < 4; ++m) _Pragma("unroll") for (int k = 0; k < 2; ++k) dst[m][k] = *(const LAS bf16x8*)(lds + PG8_SA(b, h) + aoff + m * 2048 + k * 1024); } } while (0)
#define PG8_LDB(dst, b, h) do { if constexpr (FP8) { _Pragma("unroll") for (int n = 0; n < 2; ++n) dst##8[n] = __builtin_shufflevector(*(const LAS v4i*)(lds + PG8_SB(b, h) + boff + n * 2048), *(const LAS v4i*)(lds + PG8_SB(b, h) + boff + n * 2048 + 1024), 0, 1, 2, 3, 4, 5, 6, 7); } \
        else { _Pragma("unroll") for (int n = 0; n < 2; ++n) _Pragma("unroll") for (int k = 0; k < 2; ++k) dst[n][k] = *(const LAS bf16x8*)(lds + PG8_SB(b, h) + boff + n * 2048 + k * 1024); } } while (0)
#define PG8_MMA(ai, bj, At, Bt) do { __builtin_amdgcn_s_setprio(1); if constexpr (FP8) { _Pragma("unroll") for (int m = 0; m < 4; ++m) _Pragma("unroll") for (int n = 0; n < 2; ++n) \
        asm volatile("v_mfma_scale_f32_16x16x128_f8f6f4 %0, %1, %2, %0, %3, %4 op_sel_hi:[0,0,0]" : "+v"(acc[ai][bj][m][n]) : "v"(Bt##8[n]), "v"(At##8[m]), "v"(sclw), "v"(scla)); } \
        else { _Pragma("unroll") for (int m = 0; m < 4; ++m) _Pragma("unroll") for (int n = 0; n < 2; ++n) _Pragma("unroll") for (int k = 0; k < 2; ++k) \
        acc[ai][bj][m][n] = __builtin_amdgcn_mfma_f32_16x16x32_bf16(Bt[n][k], At[m][k], acc[ai][bj][m][n], 0, 0, 0); } __builtin_amdgcn_s_setprio(0); } while (0)
#define PG8_WAIT_V(n) asm volatile("s_waitcnt vmcnt(" #n ")" ::: "memory")
#define PG8_WAIT_L(n) asm volatile("s_waitcnt lgkmcnt(" #n ")" ::: "memory")
#define PG8_BAR __builtin_amdgcn_s_barrier()
#define PG8_SCHED __builtin_amdgcn_sched_barrier(0)
    Unit cur, nxt; int ui = 0;
    if (!S.next(0, cur)) return;
#ifdef GEMM_STAGGER
    {
        const unsigned long long t0 = __builtin_amdgcn_s_memrealtime(); const unsigned long long d = (unsigned long long)((blockIdx.x >> 3) & 3) * GEMM_STAGGER;
        while (__builtin_amdgcn_s_memrealtime() - t0 < d) __builtin_amdgcn_s_sleep(16);
    }
#endif
    f32x4 acc[2][2][4][2];
    E.init(acc, cur, wr, wc, fr, fq);
    bf16x8 At[4][2], B0[2][2], B1[2][2]; v8i At8[4], B08[2], B18[2];
    const int sclw = 0x7A7A7A7A, scla = 0x7F7F7F7F;
    unsigned gc[2][2], gn[2][2];
    if constexpr (GATHER) {
#pragma unroll
        for (int h = 0; h < 2; ++h)
#pragma unroll
            for (int i = 0; i < 2; ++i) { gc[h][i] = (unsigned)(g.rowmap[cur.pm * BM + h * HALF + RA[i]] * K + CA[i]) * 2u; gn[h][i] = gc[h][i]; }
    } else { gc[0][0] = gc[0][1] = gc[1][0] = gc[1][1] = 0u; gn[0][0] = gn[0][1] = gn[1][0] = gn[1][1] = 0u; }
    const char* cA = GATHER ? (const char*)g.A : (const char*)g.A + (size_t)cur.pm * tstep; const char* cB = (const char*)g.Bt + (size_t)cur.pb * tstep;
    PG8_STAGE(PG8_SB(0, 0), cB, voffB); PG8_STAGE(PG8_SB(0, 1), cB + hstep, voffB); PG8_STAGEA(PG8_SA(0, 0), cA, 0, false); PG8_STAGEA(PG8_SA(0, 1), cA, 1, false);
    if (wr == 1) PG8_BAR;
    PG8_WAIT_V(2); PG8_BAR;
    PG8_STAGE(PG8_SB(1, 0), cB + kstep, voffB); PG8_STAGEA(PG8_SA(1, 0), cA + kstep, 0, false); PG8_STAGE(PG8_SB(1, 1), cB + hstep + kstep, voffB);
    PG8_WAIT_V(6); PG8_BAR;
    for (;;) {
        const bool has_next = S.next(ui + 1, nxt);
        if constexpr (GATHER) { if (has_next) {
#pragma unroll
            for (int h = 0; h < 2; ++h)
#pragma unroll
                for (int i = 0; i < 2; ++i) gn[h][i] = (unsigned)(g.rowmap[nxt.pm * BM + h * HALF + RA[i]] * K + CA[i]) * 2u; } }
        const char* nA = GATHER ? cA : (has_next ? (const char*)g.A + (size_t)nxt.pm * tstep : cA); const char* nB = has_next ? (const char*)g.Bt + (size_t)nxt.pb * tstep : cB;
#ifdef TPG
        const unsigned long long tg0 = __builtin_readcyclecounter();
#endif
        for (int t = 0; t < nt; t += 2) {
            const bool last = (t == nt - 2);
            const char* a1 = cA + (size_t)(t + 1) * kstep;
            const char* a2 = last ? nA : cA + (size_t)(t + 2) * kstep; const char* b2 = last ? nB : cB + (size_t)(t + 2) * kstep;
            const char* a3 = a2 + kstep; const char* b3 = b2 + kstep;
            PG8_LDB(B0, 0, 0); PG8_LDB(B1, 0, 1); PG8_SCHED; PG8_LDA(At, 0, 0); PG8_STAGEA(PG8_SA(1, 1), a1, 1, false);
            PG8_WAIT_V(8); PG8_WAIT_L(0); PG8_BAR; PG8_MMA(0, 0, At, B0); PG8_MMA(0, 1, At, B1); PG8_BAR; PG8_SCHED;
            PG8_LDA(At, 0, 1); PG8_STAGE(PG8_SB(0, 0), b2, voffB); PG8_STAGE(PG8_SB(0, 1), b2 + hstep, voffB); PG8_STAGEA(PG8_SA(0, 0), a2, 0, last);
            PG8_WAIT_V(8); PG8_WAIT_L(0); PG8_BAR; PG8_MMA(1, 0, At, B0); PG8_MMA(1, 1, At, B1); PG8_BAR; PG8_SCHED;
            PG8_LDB(B0, 1, 0); PG8_LDB(B1, 1, 1); PG8_SCHED; PG8_LDA(At, 1, 0); PG8_STAGEA(PG8_SA(0, 1), a2, 1, last);
            PG8_WAIT_V(8); PG8_WAIT_L(0); PG8_BAR; PG8_MMA(0, 0, At, B0); PG8_MMA(0, 1, At, B1); PG8_BAR; PG8_SCHED;
            PG8_LDA(At, 1, 1); PG8_STAGE(PG8_SB(1, 0), b3, voffB); PG8_STAGE(PG8_SB(1, 1), b3 + hstep, voffB); PG8_STAGEA(PG8_SA(1, 0), a3, 0, last);
            PG8_WAIT_V(8); PG8_WAIT_L(0); PG8_BAR; PG8_MMA(1, 0, At, B0); PG8_MMA(1, 1, At, B1); PG8_BAR; PG8_SCHED;
        }
#ifdef TPG
        { const unsigned long long tg1 = __builtin_readcyclecounter(); asm volatile("" :: "s"(tg0), "s"(tg1));
          if (FP8 && !GATHER && blockIdx.x == 3 && tid == 0) atomicAdd((unsigned long long*)g.tprobe, (TPG == 1) ? (tg1 - tg0) : 1ull); }
#endif
        if (wr == 0) PG8_BAR;
        if constexpr (FP8) asm volatile("s_nop 15\n\ts_nop 7" ::: "memory");
        E(acc, cur, wr, wc, fr, fq);
        if (!has_next) break;
        E.init(acc, nxt, wr, wc, fr, fq);
        cur = nxt; cA = nA; cB = nB; ++ui;
        if constexpr (GATHER) {
#pragma unroll
            for (int h = 0; h < 2; ++h)
#pragma unroll
                for (int i = 0; i < 2; ++i) gc[h][i] = gn[h][i]; }
        if (wr == 1) PG8_BAR;
    }
    PG8_WAIT_V(0);
    PG8_BAR;
#undef PG8_SA
#undef PG8_SB
#undef PG8_STAGE
#undef PG8_STAGEA
#undef PG8_LDA
#undef PG8_LDB
#undef PG8_MMA
#undef PG8_WAIT_V
#undef PG8_WAIT_L
#undef PG8_BAR
#undef PG8_SCHED
}
}
constexpr int DM = 1024, NB = 8, SEQ = 4096, NTOK = NB * SEQ, NLAYER = 2;
constexpr int NPROJ = 3072;
constexpr int D_IN = 3078;
constexpr int NEXP = 32, TOPK = 4;
constexpr int NSLOT_MAX = NTOK * TOPK + NEXP * 256;
constexpr int NTILE_MAX = NSLOT_MAX / 256;
constexpr int COL_CB = 0, COL_CC = 256, COL_CU = 512, COL_SQ = 768, COL_SK = 1152, COL_SV = 1536, COL_FQ = 1920, COL_FK = 2304, COL_FV = 2688;
constexpr float EPS = 1e-6f;
constexpr float LOG2E = 1.4426950408889634f;
constexpr float QSCALE = 0.125f * LOG2E;

namespace pg8 {
struct StaticOrder {
    int nM, nN, nwg, G, c;
    __device__ __forceinline__ void init(int M, int N, int G_, int c_) { nM = M / BM; nN = N / BM; nwg = nM * nN; G = G_; c = c_; }
    __device__ __forceinline__ bool next(int i, Unit& u) const {
        const long L = (long)i * G + c; if (L >= nwg) return false;
        int wgid = (int)L; { const int q = nwg / NXCD, r = nwg % NXCD, xcd = wgid % NXCD, off = wgid / NXCD; wgid = (xcd < r ? xcd * (q + 1) : r * (q + 1) + (xcd - r) * q) + off; }
        const int nig = WGM * nN, gid = wgid / nig, fm = gid * WGM, gsz = (nM - fm) < WGM ? (nM - fm) : WGM;
        u.pm = fm + ((wgid % nig) % gsz); u.pn = (wgid % nig) / gsz; u.pb = u.pn; return true;
    }
};
struct MoeOrder {
    int nM, nN, nwg, G, c; const LAS int* tb;
    __device__ __forceinline__ void init(const LAS int* tb_, int nN_, int G_, int c_) { tb = tb_; nM = tb_[NEXP]; nN = nN_; nwg = nM * nN; G = G_; c = c_; }
    __device__ __forceinline__ bool next(int i, Unit& u) const {
        const long L = (long)i * G + c; if (L >= nwg) return false;
        int wgid = (int)L; { const int q = nwg / NXCD, r = nwg % NXCD, xcd = wgid % NXCD, off = wgid / NXCD; wgid = (xcd < r ? xcd * (q + 1) : r * (q + 1) + (xcd - r) * q) + off; }
        const int nig = WGM * nN, gid = wgid / nig, fm = gid * WGM, gsz = (nM - fm) < WGM ? (nM - fm) : WGM;
        u.pm = fm + ((wgid % nig) % gsz); u.pn = (wgid % nig) / gsz;
        int e = 0;
#pragma unroll 1
        for (int j = 1; j < NEXP; ++j) e += (tb[j] <= u.pm) ? 1 : 0;
        u.pb = e * nN + u.pn; return true;
    }
};

struct EpiProj {
    static constexpr bool PERM = true;
    bf16* O; int ldc;
    __device__ __forceinline__ void init(f32x4 (&acc)[2][2][4][2], const Unit&, int, int, int, int) const {
#pragma unroll
        for (int a = 0; a < 2; ++a)
#pragma unroll
            for (int b = 0; b < 2; ++b)
#pragma unroll
                for (int m = 0; m < 4; ++m)
#pragma unroll
                    for (int n = 0; n < 2; ++n) acc[a][b][m][n] = (f32x4){0.f, 0.f, 0.f, 0.f}; }
    __device__ __forceinline__ void operator()(const f32x4 (&acc)[2][2][4][2], const Unit& u, int wr, int wc, int fr, int fq) const {
        const int row0 = u.pm * BM + wr * 64 + fr, col0 = u.pn * BM + wc * 32 + 8 * fq;
#pragma unroll
        for (int ai = 0; ai < 2; ++ai)
#pragma unroll
            for (int m = 0; m < 4; ++m) { bf16* rowp = O + (size_t)(row0 + ai * HALF + m * 16) * ldc + col0;
#pragma unroll
                for (int bj = 0; bj < 2; ++bj) { const f32x4 v0 = acc[ai][bj][m][0], v1 = acc[ai][bj][m][1];
                    v4u w; w.x = cvt_pk_bf16(v0[0], v0[1]); w.y = cvt_pk_bf16(v0[2], v0[3]); w.z = cvt_pk_bf16(v1[0], v1[1]); w.w = cvt_pk_bf16(v1[2], v1[3]);
                    *(v4u*)(rowp + bj * HALF) = w; } }
    }
};
template <bool BASE16> struct EpiResGate {
    static constexpr bool PERM = true;
    const void* base; bf16* out; const float* gate;
    __device__ __forceinline__ void init(f32x4 (&acc)[2][2][4][2], const Unit&, int, int, int, int) const {
#pragma unroll
        for (int a = 0; a < 2; ++a)
#pragma unroll
            for (int b = 0; b < 2; ++b)
#pragma unroll
                for (int m = 0; m < 4; ++m)
#pragma unroll
                    for (int n = 0; n < 2; ++n) acc[a][b][m][n] = (f32x4){0.f, 0.f, 0.f, 0.f}; }
    __device__ __forceinline__ void operator()(const f32x4 (&acc)[2][2][4][2], const Unit& u, int wr, int wc, int fr, int fq) const {
        const int row0 = u.pm * BM + wr * 64 + fr, col0 = u.pn * BM + wc * 32 + 8 * fq; const int b = (u.pm * BM) / SEQ;
#pragma unroll
        for (int bj = 0; bj < 2; ++bj) { const int c = col0 + bj * HALF; const f32x4 g0 = *(const f32x4*)(gate + (size_t)b * 6144 + c), g1 = *(const f32x4*)(gate + (size_t)b * 6144 + c + 4);
#pragma unroll
            for (int ai = 0; ai < 2; ++ai)
#pragma unroll
                for (int m = 0; m < 4; ++m) { const size_t off = (size_t)(row0 + ai * HALF + m * 16) * DM + c; f32x4 b0, b1;
                    if (BASE16) { const v4u t = *(const v4u*)((const bf16*)base + off); b0 = (f32x4){__builtin_bit_cast(float, t.x << 16), __builtin_bit_cast(float, t.x & 0xffff0000u), __builtin_bit_cast(float, t.y << 16), __builtin_bit_cast(float, t.y & 0xffff0000u)};
                        b1 = (f32x4){__builtin_bit_cast(float, t.z << 16), __builtin_bit_cast(float, t.z & 0xffff0000u), __builtin_bit_cast(float, t.w << 16), __builtin_bit_cast(float, t.w & 0xffff0000u)}; }
                    else { b0 = *(const f32x4*)((const float*)base + off); b1 = *(const f32x4*)((const float*)base + off + 4); }
                    const f32x4 v0 = b0 + g0 * acc[ai][bj][m][0], v1 = b1 + g1 * acc[ai][bj][m][1];
                    v4u w; w.x = cvt_pk_bf16(v0[0], v0[1]); w.y = cvt_pk_bf16(v0[2], v0[3]); w.z = cvt_pk_bf16(v1[0], v1[1]); w.w = cvt_pk_bf16(v1[2], v1[3]);
                    *(v4u*)(out + off) = w; } }
    }
};
struct EpiSwiglu {
    static constexpr bool PERM = true;
    bf16* O; const float* b1;
    __device__ __forceinline__ void init(f32x4 (&acc)[2][2][4][2], const Unit&, int, int, int, int) const {
#pragma unroll
        for (int a = 0; a < 2; ++a)
#pragma unroll
            for (int b = 0; b < 2; ++b)
#pragma unroll
                for (int m = 0; m < 4; ++m)
#pragma unroll
                    for (int n = 0; n < 2; ++n) acc[a][b][m][n] = (f32x4){0.f, 0.f, 0.f, 0.f}; }
    __device__ __forceinline__ void operator()(const f32x4 (&acc)[2][2][4][2], const Unit& u, int wr, int wc, int fr, int fq) const {
        const int row0 = u.pm * BM + wr * 64 + fr; const int e = u.pb >> 3; const int j0 = u.pn * 128 + wc * 32 + 8 * fq;
        const float* bp = b1 + (size_t)e * 2048 + 2 * j0;
        f32x4 bb[4];
#pragma unroll
        for (int q = 0; q < 4; ++q) bb[q] = *(const f32x4*)(bp + 4 * q);
        float bg[8], bl[8];
#pragma unroll
        for (int q = 0; q < 4; ++q) { bg[2 * q] = bb[q][0]; bl[2 * q] = bb[q][1]; bg[2 * q + 1] = bb[q][2]; bl[2 * q + 1] = bb[q][3]; }
#pragma unroll
        for (int ai = 0; ai < 2; ++ai)
#pragma unroll
            for (int m = 0; m < 4; ++m) { bf16* rowp = O + (size_t)(row0 + ai * HALF + m * 16) * DM + j0;
                float a[8];
#pragma unroll
                for (int n = 0; n < 2; ++n)
#pragma unroll
                    for (int i = 0; i < 4; ++i) { float gl = acc[ai][0][m][n][i] + bg[4 * n + i], li = acc[ai][1][m][n][i] + bl[4 * n + i];
                        gl = fminf(gl, 7.0f); li = fminf(fmaxf(li, -7.0f), 7.0f);
                        const float sg = __builtin_amdgcn_rcpf(1.0f + __builtin_amdgcn_exp2f(-1.702f * LOG2E * gl));
                        a[4 * n + i] = gl * sg * (li + 1.0f); }
                v4u w; w.x = cvt_pk_bf16(a[0], a[1]); w.y = cvt_pk_bf16(a[2], a[3]); w.z = cvt_pk_bf16(a[4], a[5]); w.w = cvt_pk_bf16(a[6], a[7]);
                *(v4u*)rowp = w; }
    }
};
__device__ __forceinline__ float clamp448(float v) { return __builtin_amdgcn_fmed3f(v, -448.0f, 448.0f); }
__device__ __forceinline__ unsigned pk4_fp8(float a, float b, float c, float d) { unsigned r = 0; r = __builtin_amdgcn_cvt_pk_fp8_f32(clamp448(a), clamp448(b), r, false); r = __builtin_amdgcn_cvt_pk_fp8_f32(clamp448(c), clamp448(d), r, true); return r; }
struct EpiSwiglu8 {
    static constexpr bool PERM = true;
    unsigned char* O; const float* b1;
    __device__ __forceinline__ void init(f32x4 (&acc)[2][2][4][2], const Unit& u, int, int wc, int, int fq) const {
        const int e = u.pb >> 3; const int j0 = u.pn * 128 + wc * 32 + 8 * fq; const float* bp = b1 + (size_t)e * 2048 + 2 * j0;
        f32x4 bb[4];
#pragma unroll
        for (int q = 0; q < 4; ++q) bb[q] = *(const f32x4*)(bp + 4 * q);
        const f32x4 g0 = (f32x4){bb[0][0], bb[0][2], bb[1][0], bb[1][2]}, g1 = (f32x4){bb[2][0], bb[2][2], bb[3][0], bb[3][2]};
        const f32x4 l0 = (f32x4){bb[0][1], bb[0][3], bb[1][1], bb[1][3]}, l1 = (f32x4){bb[2][1], bb[2][3], bb[3][1], bb[3][3]};
#pragma unroll
        for (int a = 0; a < 2; ++a)
#pragma unroll
            for (int m = 0; m < 4; ++m) { acc[a][0][m][0] = g0; acc[a][0][m][1] = g1; acc[a][1][m][0] = l0; acc[a][1][m][1] = l1; } }
    __device__ __forceinline__ void operator()(const f32x4 (&acc)[2][2][4][2], const Unit& u, int wr, int wc, int fr, int fq) const {
        const int row0 = u.pm * BM + wr * 64 + fr; const int j0 = u.pn * 128 + wc * 32 + 8 * fq;
#pragma unroll
        for (int ai = 0; ai < 2; ++ai)
#pragma unroll
            for (int m = 0; m < 4; ++m) { unsigned char* rowp = O + (size_t)(row0 + ai * HALF + m * 16) * DM + j0;
                float a[8];
#pragma unroll
                for (int n = 0; n < 2; ++n)
#pragma unroll
                    for (int i = 0; i < 4; ++i) { float gl = acc[ai][0][m][n][i], li = acc[ai][1][m][n][i];
                        gl = fminf(gl, 7.0f); li = fminf(fmaxf(li, -7.0f), 7.0f);
                        const float sg = __builtin_amdgcn_rcpf(1.0f + __builtin_amdgcn_exp2f(-1.702f * LOG2E * gl));
                        a[4 * n + i] = gl * sg * (li + 1.0f); }
                v2u w; w.x = pk4_fp8(a[0], a[1], a[2], a[3]); w.y = pk4_fp8(a[4], a[5], a[6], a[7]);
                *(v2u*)rowp = w; }
    }
};
struct EpiY {
    static constexpr bool PERM = true;
    unsigned char* O; const float* b2;
    __device__ __forceinline__ void init(f32x4 (&acc)[2][2][4][2], const Unit& u, int, int wc, int, int fq) const {
        const int e = u.pb >> 2; const int col0 = u.pn * BM + wc * 32 + 8 * fq;
#pragma unroll
        for (int bj = 0; bj < 2; ++bj)
#pragma unroll
            for (int n = 0; n < 2; ++n) { const f32x4 bv = b2 ? *(const f32x4*)(b2 + (size_t)e * DM + col0 + bj * HALF + 4 * n) : (f32x4){0.f, 0.f, 0.f, 0.f};
#pragma unroll
                for (int a = 0; a < 2; ++a)
#pragma unroll
                    for (int m = 0; m < 4; ++m) acc[a][bj][m][n] = bv; } }
    __device__ __forceinline__ void operator()(const f32x4 (&acc)[2][2][4][2], const Unit& u, int wr, int wc, int fr, int fq) const {
        const int row0 = u.pm * BM + wr * 64 + fr; const int col0 = u.pn * BM + wc * 32 + 8 * fq;
#pragma unroll
        for (int ai = 0; ai < 2; ++ai)
#pragma unroll
            for (int m = 0; m < 4; ++m) { unsigned char* rowp = O + (size_t)(row0 + ai * HALF + m * 16) * DM + col0;
#pragma unroll
                for (int bj = 0; bj < 2; ++bj) { const f32x4 v0 = acc[ai][bj][m][0], v1 = acc[ai][bj][m][1];
                    v2u w; w.x = pk4_fp8(v0[0], v0[1], v0[2], v0[3]); w.y = pk4_fp8(v1[0], v1[1], v1[2], v1[3]);
                    *(v2u*)(rowp + bj * HALF) = w; } }
    }
};
}
namespace att {
constexpr int KROW = 128;
constexpr int TILE_B = 64 * KROW;
constexpr int OFF_K = 0, OFF_V = 2 * TILE_B, OFF_F = 4 * TILE_B, OFF_Q = OFF_F + 512, OFF_FLAG = OFF_Q + 8 * 4608, LDS_BYTES = OFF_FLAG + 64;
__device__ __forceinline__ int pim(int m) { const int a = m >> 3, h = (m >> 2) & 1, b = m & 3; return 16 * (a >> 1) + 8 * h + 4 * (a & 1) + b; }
typedef __bf16 bf16x2_t __attribute__((ext_vector_type(2)));
__device__ __forceinline__ unsigned pk_bf16(float lo, float hi) { const f32x2 v = {lo, hi}; const bf16x2_t b = __builtin_convertvector(v, bf16x2_t); return __builtin_bit_cast(unsigned, b); }
__device__ __forceinline__ unsigned pk_f16(float lo, float hi) { return __builtin_bit_cast(unsigned, __builtin_amdgcn_cvt_pkrtz(lo, hi)); }
__device__ __forceinline__ float half_sum(float v) { auto rr = __builtin_amdgcn_permlane32_swap(__float_as_uint(v), __float_as_uint(v), false, false); return __uint_as_float(rr[0]) + __uint_as_float(rr[1]); }
__device__ __forceinline__ float half_max(float v) { auto rr = __builtin_amdgcn_permlane32_swap(__float_as_uint(v), __float_as_uint(v), false, false); return fmaxf(__uint_as_float(rr[0]), __uint_as_float(rr[1])); }
__device__ __forceinline__ void glds16(const void* gsrc, unsigned lds_dst) { unsigned keep;
    asm volatile("s_mov_b32 %0, m0\n\ts_mov_b32 m0, %2\n\ts_nop 0\n\tglobal_load_lds_dwordx4 %1, off\n\ts_mov_b32 m0, %0" : "=&s"(keep) : "v"(gsrc), "s"(lds_dst) : "memory"); }
#define ATT_SB() __builtin_amdgcn_sched_barrier(0)
#define ATT_MFMA(a, b, c) __builtin_amdgcn_mfma_f32_32x32x16_bf16((a), (b), (c), 0, 0, 0)
#define ATT_MFMAH(a, b, c) __builtin_amdgcn_mfma_f32_32x32x16_f16((a), (b), (c), 0, 0, 0)

struct Tensors {
    const bf16* proj;
    const bf16* vt;
    const float* fcum;
    bf16* ymix;
    const float* ong;
    int colq, colk, coly;
    void* tprobe;
    float z2max;
};
struct WaveCtx { int r32, hi, qabs; int ko[4]; const LAS unsigned char* qb; f16x8 mtri0, mtri1, mones; };

__device__ __forceinline__ void qk_only(f32x16& p0, f32x16& p1, const LAS unsigned char* Kb, const WaveCtx& W) {
#pragma unroll
    for (int r = 0; r < 16; ++r) { p0[r] = 0.f; p1[r] = 0.f; }
#pragma unroll
    for (int d0 = 0; d0 < 4; ++d0) { const bf16x8 ka = *(const LAS bf16x8*)(Kb + W.ko[d0]), kb2 = *(const LAS bf16x8*)(Kb + 32 * KROW + W.ko[d0]);
        const bf16x8 qv = *(const LAS bf16x8*)(W.qb + 32 * d0);
        p0 = ATT_MFMA(ka, qv, p0); p1 = ATT_MFMA(kb2, qv, p1); }
}

template <int KIND, bool DIAG>
__device__ __forceinline__ void tile(f32x16& p0, f32x16& p1, f32x16& o0, f32x16& o1, float& carry, float& lsum, const LAS unsigned char* Kn, const LAS unsigned char* Vb, const LAS float* Fb, int kt, const WaveCtx& W) {
    const int kbase = kt * 64 + 8 * W.hi;
#define ATT_KF(i) (*(const LAS bf16x8*)(Kn + ((i) & 1) * 32 * KROW + W.ko[(i) >> 1]))
#define ATT_VF(i) (*(const LAS bf16x8*)(Vb + ((i) & 1) * 32 * KROW + W.ko[(i) >> 1]))
#define ATT_QF(d0) (*(const LAS bf16x8*)(W.qb + 32 * (d0)))
    bf16x8 kcur = ATT_KF(0), knxt = kcur, qcur = ATT_QF(0), qnxt = qcur;
    f32x16 n0, n1;
#pragma unroll
    for (int r = 0; r < 16; ++r) { n0[r] = 0.f; n1[r] = 0.f; }
    v4u wf[4];
    if (KIND == 0) {
        v4u lf[4]; float lfirst = 0.f, pz0 = 0.f;
#pragma unroll
        for (int i = 0; i < 8; ++i) {
            if (i < 7) { knxt = ATT_KF(i + 1); if (i & 1) qnxt = ATT_QF((i + 1) >> 1); }
#pragma unroll
            for (int jj = 0; jj < 2; ++jj) { const int r = (4 * i + 2 * jj) & 15; float lg[2];
#pragma unroll
                for (int e = 0; e < 2; ++e) { const float z = (i < 4) ? p0[r + e] : p1[r + e]; float g = __builtin_amdgcn_logf(1.0f + __builtin_amdgcn_exp2f(z));
                    if (i < 4) p0[r + e] = z - g; else p1[r + e] = z - g;
                    if (DIAG) { const int key = kbase + (i < 4 ? 0 : 32) + 16 * ((r + e) >> 3) + ((r + e) & 7); g = (key < W.qabs) ? g : 0.f; }
                    lg[e] = g; }
                if (i == 0 && jj == 0) { lfirst = -lg[0]; pz0 = p0[0]; }
                lf[2 * (i >> 2) + (r >> 3)][(r & 7) >> 1] = pk_f16(-lg[0], -lg[1]);
                if (jj == 1) asm volatile("" : "+v"(kcur) : "v"(lf[2 * (i >> 2) + (r >> 3)][(r & 7) >> 1])); }
            if (i & 1) { n1 = ATT_MFMA(kcur, qcur, n1); qcur = qnxt; } else n0 = ATT_MFMA(kcur, qcur, n0);
            kcur = knxt;
            ATT_SB();
        }
        bf16x8 va = ATT_VF(0), vb = ATT_VF(1), vna = va, vnb = vb;
#pragma unroll
        for (int r = 0; r < 16; ++r) { p0[r] += carry; p1[r] += carry; }
        p0 = ATT_MFMAH(W.mtri0, __builtin_bit_cast(f16x8, lf[0]), p0); p1 = ATT_MFMAH(W.mtri0, __builtin_bit_cast(f16x8, lf[2]), p1);
        p0 = ATT_MFMAH(W.mtri1, __builtin_bit_cast(f16x8, lf[1]), p0); p1 = ATT_MFMAH(W.mtri1, __builtin_bit_cast(f16x8, lf[3]), p1);
        p0 = ATT_MFMAH(W.mones, __builtin_bit_cast(f16x8, lf[2]), p0);
        p0 = ATT_MFMAH(W.mones, __builtin_bit_cast(f16x8, lf[3]), p0);
        ATT_SB();
        const float t00 = p0[0];
#pragma unroll
        for (int c = 0; c < 4; ++c) {
            if (c < 3) { vna = ATT_VF(2 * c + 2); vnb = ATT_VF(2 * c + 3); }
#pragma unroll
            for (int j = 0; j < 4; ++j) { const int r = 8 * (c & 1) + 2 * j; float w[2];
#pragma unroll
                for (int e = 0; e < 2; ++e) { const float t = (c < 2) ? p0[r + e] : p1[r + e]; float x = __builtin_amdgcn_exp2f(t);
                    if (DIAG) { const int key = kbase + (c < 2 ? 0 : 32) + 16 * ((r + e) >> 3) + ((r + e) & 7); x = (key < W.qabs) ? x : 0.f; }
                    w[e] = x; }
                wf[c][j] = pk_bf16(w[0], w[1]); }
            o0 = ATT_MFMA(va, __builtin_bit_cast(bf16x8, wf[c]), o0); o1 = ATT_MFMA(vb, __builtin_bit_cast(bf16x8, wf[c]), o1);
            va = vna; vb = vnb;
            ATT_SB();
        }
        carry = half_sum(W.hi == 0 ? (t00 - pz0) + lfirst : 0.f);
    } else {
#define ATT_FBV(i) (*(const LAS f32x4*)(Fb + 8 * W.hi + 32 * ((i) >> 2) + 16 * (((i) >> 1) & 1) + 4 * ((i) & 1)))
        f32x4 fcur = ATT_FBV(0), fnxt = fcur;
        float mx = -1e30f;
#pragma unroll
        for (int i = 0; i < 8; ++i) {
            if (i < 7) { knxt = ATT_KF(i + 1); fnxt = ATT_FBV(i + 1); if (i & 1) qnxt = ATT_QF((i + 1) >> 1); }
#pragma unroll
            for (int e = 0; e < 4; ++e) { const int r = (4 * i + e) & 15; float s = ((i < 4) ? p0[r] : p1[r]) - fcur[e];
                if (DIAG) { const int key = kbase + (i < 4 ? 0 : 32) + 16 * (r >> 3) + (r & 7); s = (key > W.qabs) ? -1e30f : s; }
                if (i < 4) p0[r] = s; else p1[r] = s; mx = fmaxf(mx, s); }
            asm volatile("" : "+v"(kcur) : "v"(mx));
            if (i & 1) { n1 = ATT_MFMA(kcur, qcur, n1); qcur = qnxt; } else n0 = ATT_MFMA(kcur, qcur, n0);
            kcur = knxt; fcur = fnxt;
            ATT_SB();
        }
        bf16x8 va = ATT_VF(0), vb = ATT_VF(1), vna = va, vnb = vb;
        mx = half_max(mx);
        if (__any(mx > carry)) {
            const float mnew = fmaxf(carry, mx), alpha = __builtin_amdgcn_exp2f(carry - mnew); carry = mnew; lsum *= alpha;
#pragma unroll
            for (int r = 0; r < 16; ++r) { o0[r] *= alpha; o1[r] *= alpha; }
        }
        ATT_SB();
        float ps = 0.f;
#pragma unroll
        for (int c = 0; c < 4; ++c) {
            if (c < 3) { vna = ATT_VF(2 * c + 2); vnb = ATT_VF(2 * c + 3); }
#pragma unroll
            for (int j = 0; j < 4; ++j) { const int r = 8 * (c & 1) + 2 * j;
                const float a = __builtin_amdgcn_exp2f(((c < 2) ? p0[r] : p1[r]) - carry), d = __builtin_amdgcn_exp2f(((c < 2) ? p0[r + 1] : p1[r + 1]) - carry);
                ps += a + d; wf[c][j] = pk_bf16(a, d); }
            o0 = ATT_MFMA(va, __builtin_bit_cast(bf16x8, wf[c]), o0); o1 = ATT_MFMA(vb, __builtin_bit_cast(bf16x8, wf[c]), o1);
            va = vna; vb = vnb;
            ATT_SB();
        }
        lsum += half_sum(ps);
    }
    p0 = n0; p1 = n1;
#undef ATT_KF
#undef ATT_QF
#undef ATT_VF
#undef ATT_FBV
}

template <int KIND>
__device__ __forceinline__ void unit(const Tensors& T, int b, int h, int qb, LAS unsigned char* lds, int wave) {
    int lane_ = (int)__builtin_amdgcn_mbcnt_hi(~0u, __builtin_amdgcn_mbcnt_lo(~0u, 0u)); asm volatile("" : "+v"(lane_));
    const int wid = wave, lane = lane_, tid = wid * 64 + lane;
    WaveCtx W; W.r32 = lane & 31; W.hi = lane >> 5;
    const int q0 = qb * 256, qw0 = q0 + wid * 32; W.qabs = qw0 + W.r32;
    const size_t rowbase = (size_t)b * SEQ;
    const int ktd = qw0 >> 6;
    const int kt_hi = (q0 + 255) >> 6;
    const int srow = tid >> 3, cg = (tid & 7) ^ ((srow >> 1) & 7);
    const bf16* kg = T.proj + (rowbase + srow) * NPROJ + T.colk + h * 64 + cg * 8;
    const bf16* vg = T.vt + ((size_t)(b * 6 + h) * 64 + srow) * SEQ + cg * 8;
    const float* fg = T.fcum + (size_t)(b * 6 + h) * SEQ;
    LAS unsigned char* qlds = lds + OFF_Q + wid * 4608;
    W.qb = qlds + W.r32 * 144 + W.hi * 16;
    { const bf16* qp = T.proj + (rowbase + W.qabs) * NPROJ + T.colq + h * 64 + W.hi * 8;
      v4u qt[4];
#pragma unroll
      for (int d0 = 0; d0 < 4; ++d0) qt[d0] = *(const v4u*)(qp + d0 * 16);
#pragma unroll
      for (int d0 = 0; d0 < 4; ++d0) *(LAS v4u*)(qlds + W.r32 * 144 + W.hi * 16 + 32 * d0) = qt[d0]; }
    const int pm = pim(W.r32);
#pragma unroll
    for (int j = 0; j < 4; ++j) W.ko[j] = pm * KROW + (((2 * j + W.hi) ^ ((pm >> 1) & 7)) << 4);
#pragma unroll
    for (int i = 0; i < 8; ++i) { W.mtri0[i] = (_Float16)((8 * W.hi + i > pm) ? 1.0f : 0.0f); W.mtri1[i] = (_Float16)((16 + 8 * W.hi + i > pm) ? 1.0f : 0.0f); W.mones[i] = (_Float16)1.0f; }
    f32x16 o0, o1, p0, p1;
#pragma unroll
    for (int r = 0; r < 16; ++r) { o0[r] = 0.f; o1[r] = 0.f; p0[r] = 0.f; p1[r] = 0.f; }
    float carry = (KIND == 1) ? -1e30f : 0.f, lsum = 0.f;
#define ATT_KB(t) (lds + OFF_K + ((t) & 1) * TILE_B)
#define ATT_VB(t) (lds + OFF_V + ((t) & 1) * TILE_B)
#define ATT_FB(t) ((LAS float*)(lds + OFF_F + ((t) & 1) * 256))
#define ATT_DMA(gsrc, ldst) glds16((gsrc), (unsigned)__builtin_amdgcn_readfirstlane((int)(uintptr_t)((ldst) + wid * 1024)))
    ATT_DMA(kg + (size_t)kt_hi * 64 * NPROJ, ATT_KB(kt_hi)); ATT_DMA(vg + kt_hi * 64, ATT_VB(kt_hi)); ATT_DMA(kg + (size_t)(kt_hi - 1) * 64 * NPROJ, ATT_KB(kt_hi - 1));
    if (KIND == 1 && tid < 64) ATT_FB(kt_hi)[tid] = fg[kt_hi * 64 + tid];
    asm volatile("s_waitcnt vmcnt(0)" ::: "memory");
    __syncthreads();
    if (ktd == kt_hi) qk_only(p0, p1, ATT_KB(kt_hi), W);
    __syncthreads();
#ifdef TPROBE
    unsigned long long tacc = 0ull;
#endif
    constexpr float EXIT_LOG2 = -40.0f;
    LAS int* flags = (LAS int*)(lds + OFF_FLAG);
    bool wdone = false;
    for (int kt = kt_hi; kt >= 0; --kt) {
        float freg = 0.f, fnx = 0.f;
        if (KIND == 1 && kt >= 1) fnx = fg[kt * 64 - 1];
#ifdef TPROBE
        const unsigned long long tp0 = __builtin_readcyclecounter();
#endif
        if (kt >= 2) ATT_DMA(kg + (size_t)(kt - 2) * 64 * NPROJ, ATT_KB(kt - 2));
        if (kt >= 1) { ATT_DMA(vg + (kt - 1) * 64, ATT_VB(kt - 1)); if (KIND == 1 && tid < 64) freg = fg[(kt - 1) * 64 + tid]; }
#ifdef TPROBE
        const unsigned long long tp1 = __builtin_readcyclecounter();
#endif
        if (kt <= ktd) {
            if (!wdone) {
                if (kt == ktd) tile<KIND, true>(p0, p1, o0, o1, carry, lsum, ATT_KB(kt - 1), ATT_VB(kt), ATT_FB(kt), kt, W);
                else tile<KIND, false>(p0, p1, o0, o1, carry, lsum, ATT_KB(kt - 1), ATT_VB(kt), ATT_FB(kt), kt, W);
                const float slack = (KIND == 0) ? carry : (T.z2max - fnx) - carry;
                wdone = !__any(!(slack < EXIT_LOG2));
            }
        } else if (kt - 1 == ktd) qk_only(p0, p1, ATT_KB(kt - 1), W);
        if (lane == 0) flags[(kt & 1) * 8 + wid] = wdone ? 1 : 0;
        if (KIND == 1 && kt >= 1 && tid < 64) ATT_FB(kt - 1)[tid] = freg;
#ifdef TPROBE
        const unsigned long long tp2 = __builtin_readcyclecounter();
#endif
        asm volatile("s_waitcnt vmcnt(0)" ::: "memory");
#ifdef ATT_LDSFLUSH
        { unsigned dummy; asm volatile("ds_read_b32 %0, %1\n\ts_waitcnt lgkmcnt(0)" : "=v"(dummy) : "v"((unsigned)(uintptr_t)(lds + OFF_V + wid * 1024 + lane * 16)) : "memory"); }
#endif
        __syncthreads();
        if (__all(flags[(kt & 1) * 8 + (lane & 7)] != 0)) break;
#ifdef TPROBE
        const unsigned long long tp3 = __builtin_readcyclecounter();
        tacc += (TPROBE == 1) ? (tp3 - tp2) : (TPROBE == 2) ? (tp3 - tp0) : (TPROBE == 3) ? (tp2 - tp1) : (tp1 - tp0);
        asm volatile("" :: "s"(tp0), "s"(tp1), "s"(tp2), "s"(tp3));
#endif
    }
#ifdef TPROBE
    if (blockIdx.x == TPROBE_BLK && tid == TPROBE_WAVE * 64) atomicAdd((unsigned long long*)T.tprobe, tacc);
#endif
#undef ATT_KB
#undef ATT_VB
#undef ATT_FB
#undef ATT_DMA
    if (KIND == 1) { const float inv = 1.0f / lsum;
#pragma unroll
        for (int r = 0; r < 16; ++r) { o0[r] *= inv; o1[r] *= inv; } }
    float ss = 0.f;
#pragma unroll
    for (int r = 0; r < 16; ++r) ss += o0[r] * o0[r] + o1[r] * o1[r];
    ss = half_sum(ss);
    const float rinv = 1.0f / sqrtf(ss * (1.0f / 64.0f) + EPS);
    const float* gp = T.ong + T.coly + h * 64 + 8 * W.hi;
    bf16* yp = T.ymix + (rowbase + W.qabs) * DM + T.coly + h * 64 + 8 * W.hi;
#pragma unroll
    for (int d0 = 0; d0 < 2; ++d0)
#pragma unroll
        for (int g = 0; g < 2; ++g) { const f32x4 ga = *(const f32x4*)(gp + 32 * d0 + 16 * g), gb = *(const f32x4*)(gp + 32 * d0 + 16 * g + 4);
            float v[8];
#pragma unroll
            for (int i = 0; i < 8; ++i) v[i] = (d0 == 0 ? o0[8 * g + i] : o1[8 * g + i]) * rinv * (i < 4 ? ga[i & 3] : gb[i & 3]);
            v4u w; w.x = pk_bf16(v[0], v[1]); w.y = pk_bf16(v[2], v[3]); w.z = pk_bf16(v[4], v[5]); w.w = pk_bf16(v[6], v[7]);
            *(v4u*)(yp + 32 * d0 + 16 * g) = w; }
}
}
constexpr size_t MiB = 1u << 20;
constexpr size_t WS_CTL = 0, CTL_ZERO_BYTES = 1 * MiB;
constexpr size_t WS_MODP = 1 * MiB;
constexpr size_t WS_MODF = 1 * MiB + 1536 * 1024;
constexpr size_t WS_TOPW = 3 * MiB;
constexpr size_t WS_ROUTE = WS_TOPW + 512 * 1024;
constexpr size_t WS_TOKSLOT = WS_ROUTE + 512 * 1024;
constexpr size_t WS_SLOTTOK = WS_TOKSLOT + 512 * 1024;
constexpr size_t WS_HIST = WS_SLOTTOK + 576 * 1024;
constexpr size_t WS_MOETAB = WS_HIST + 32 * 1024;
constexpr size_t WS_LOGF = 6 * MiB;
constexpr size_t WS_FCUM = 7 * MiB;
constexpr size_t WS_WIN = 8 * MiB, WS_WOUT = 20 * MiB, WS_W1 = 24 * MiB, WS_W2 = 280 * MiB;
constexpr size_t WS_H = 408 * MiB;
constexpr size_t WS_PROJ = 472 * MiB;
constexpr size_t WS_VT = 664 * MiB;
constexpr size_t WS_YMIX = 712 * MiB;
constexpr size_t WS_XA = 776 * MiB, WS_XB = 904 * MiB;
constexpr size_t WS_ACT = 1032 * MiB, WS_Y = 1304 * MiB, WS_H8 = 1576 * MiB, WS_END = 1608 * MiB;
static_assert(WS_MOETAB + 256 <= WS_LOGF && (size_t)NSLOT_MAX * 4 <= 576 * 1024 && (size_t)NSLOT_MAX * DM * 2 <= 272 * MiB, "ws map");
#ifndef P2_FP8
#define P2_FP8 0
#endif
constexpr int CW_BAR = 4096;

constexpr int RING_BYTES = 131072;
constexpr int MISC_OFF = RING_BYTES;
constexpr int LDS_BYTES = 147456;

#define RLX_AGENT __ATOMIC_RELAXED, __HIP_MEMORY_SCOPE_AGENT
__device__ __forceinline__ unsigned f2bf(float f) { unsigned u = __builtin_bit_cast(unsigned, f); return (u + 0x7fffu + ((u >> 16) & 1u)) >> 16; }
__device__ __forceinline__ unsigned pk2(float lo, float hi) { return f2bf(lo) | (f2bf(hi) << 16); }
__device__ __forceinline__ float bflo(unsigned u) { return __builtin_bit_cast(float, u << 16); }
__device__ __forceinline__ float bfhi(unsigned u) { return __builtin_bit_cast(float, u & 0xffff0000u); }
__device__ __forceinline__ int shxi(int v, int o, int lane) {
    if (o == 1) return __builtin_amdgcn_mov_dpp(v, 0xB1, 0xf, 0xf, true);
    if (o == 2) return __builtin_amdgcn_mov_dpp(v, 0x4E, 0xf, 0xf, true);
    if (o == 4) return __builtin_amdgcn_ds_swizzle(v, 0x101F);
    if (o == 8) return __builtin_amdgcn_ds_swizzle(v, 0x201F);
    if (o == 16) return __builtin_amdgcn_ds_swizzle(v, 0x401F);
    return __builtin_amdgcn_ds_bpermute((lane ^ o) << 2, v);
}
__device__ __forceinline__ float shx(float v, int o, int lane) { return __builtin_bit_cast(float, shxi(__builtin_bit_cast(int, v), o, lane)); }
__device__ __forceinline__ float shup(float v, int o, int lane) { return __builtin_bit_cast(float, __builtin_amdgcn_ds_bpermute(((lane - o) & 63) << 2, __builtin_bit_cast(int, v))); }
__device__ __forceinline__ float add_other_half(float v) { auto rr = __builtin_amdgcn_permlane32_swap(__float_as_uint(v), __float_as_uint(v), false, false); return __uint_as_float(rr[0]) + __uint_as_float(rr[1]); }
__device__ __forceinline__ float wave_sum(float v, int lane) {
    v += shx(v, 1, lane); v += shx(v, 2, lane); v += shx(v, 4, lane); v += shx(v, 8, lane); v += shx(v, 16, lane);
    return add_other_half(v);
}

#define XB_TMO      128
#define XB_XCNT(j)  (256  + 64 * (j))
#define XB_XSUB(j)  (1280 + 64 * (j))
#define XB_XGEN(j)  (2304 + 64 * (j))
#define XB_TOP      3328
#define XB_TOPGEN   3392
#define XCD_BAR_WORDS 3456
#define XB_SPIN_CAP (1u << 18)
__device__ __forceinline__ unsigned xb_ld(unsigned* p)              { return __hip_atomic_load(p, __ATOMIC_RELAXED, __HIP_MEMORY_SCOPE_AGENT); }
__device__ __forceinline__ unsigned xb_add(unsigned* p, unsigned v) { return __hip_atomic_fetch_add(p, v, __ATOMIC_RELAXED, __HIP_MEMORY_SCOPE_AGENT); }
__device__ __forceinline__ unsigned xb_xcc_id() { return (unsigned)__builtin_amdgcn_s_getreg((3 << 11) | 20) & 0xFu; }
#define XB_SPIN(cond, bar) do { unsigned _sp = 0; while (cond) { __builtin_amdgcn_s_sleep(1); \
    if ((++_sp & 255u) == 0u) { if (xb_ld(&(bar)[XB_TMO])) break; if (_sp > XB_SPIN_CAP) { atomicAdd(&(bar)[XB_TMO], 1u); break; } } } } while (0)
__device__ __forceinline__ int lane_id() { return (int)__builtin_amdgcn_mbcnt_hi(~0u, __builtin_amdgcn_mbcnt_lo(~0u, 0u)); }
struct XcdBarrier { unsigned* bar; unsigned x; volatile LAS unsigned* st; int wave; };
__device__ __forceinline__ XcdBarrier xcd_barrier_post(unsigned* bar, volatile LAS unsigned* st, int wave) {
    XcdBarrier b; b.bar = bar; b.x = (unsigned)__builtin_amdgcn_readfirstlane((int)xb_xcc_id()); b.st = st; b.wave = wave;
    if (wave == 0 && lane_id() == 0) (void)xb_add(&bar[XB_XCNT(b.x)], 1u);
    return b;
}
__device__ __forceinline__ void xcd_barrier_complete(unsigned* bar, unsigned x, unsigned& nloc, unsigned& nx) {
    const unsigned G = gridDim.x * gridDim.y * gridDim.z;
    unsigned sum, cnt, mine, sp = 0u;
    for (;;) {
        sum = 0u; cnt = 0u; mine = 0u;
#pragma unroll
        for (unsigned j = 0; j < 16; ++j) { const unsigned c = xb_ld(&bar[XB_XCNT(j)]); sum += c; cnt += (c > 0u) ? 1u : 0u; mine = (j == x) ? c : mine; }
        if (sum == G) break;
        __builtin_amdgcn_s_sleep(1);
        if ((++sp & 255u) == 0u) { if (xb_ld(&bar[XB_TMO])) break; if (sp > XB_SPIN_CAP) { atomicAdd(&bar[XB_TMO], 1u); break; } }
    }
    nloc = mine > 0u ? mine : 1u; nx = cnt > 0u ? cnt : 1u;
}
__device__ __forceinline__ void xcd_barrier(const XcdBarrier& b) {
    asm volatile("s_waitcnt vmcnt(0)" ::: "memory");
    __syncthreads();
    if (b.wave == 0 && lane_id() == 0) {
        unsigned* bar = b.bar; const unsigned bx = (unsigned)__builtin_amdgcn_readfirstlane((int)xb_xcc_id());
        __builtin_amdgcn_s_waitcnt(0);
        unsigned nloc = b.st[0], nx = b.st[1];
        if (nloc == 0u) { xcd_barrier_complete(bar, bx, nloc, nx); b.st[0] = nloc; b.st[1] = nx; }
        const unsigned old = xb_add(&bar[XB_XSUB(bx)], 1u);
        const unsigned gen = old / nloc;
        if (old + 1u == (gen + 1u) * nloc) {
            __builtin_amdgcn_fence(__ATOMIC_RELEASE, "agent");
            asm volatile("s_waitcnt vmcnt(0)" ::: "memory");
            const unsigned og = xb_add(&bar[XB_TOP], 1u);
            const unsigned tg = og / nx;
            if (og + 1u == (tg + 1u) * nx) xb_add(&bar[XB_TOPGEN], 1u);
            else XB_SPIN(xb_ld(&bar[XB_TOPGEN]) == tg, bar);
            __builtin_amdgcn_fence(__ATOMIC_ACQUIRE, "agent");
            xb_add(&bar[XB_XGEN(bx)], 1u);
            asm volatile("s_waitcnt vmcnt(0)" ::: "memory");
        } else {
            XB_SPIN(xb_ld(&bar[XB_XGEN(bx)]) == gen, bar);
            __builtin_amdgcn_fence(__ATOMIC_ACQUIRE, "agent");
            asm volatile("s_waitcnt vmcnt(0)" ::: "memory");
        }
    }
    __syncthreads();
}

struct Frame {
    LAS unsigned char* lds;
    int tid, lane, wave, blk, G;
    const float* in[21];
    float* out; unsigned char* ws;
};
enum { I_X = 0, I_C, I_N1G, I_WADA, I_BADA, I_WIN, I_CONVW, I_SBQG, I_SBKG, I_FXQG, I_FXKG, I_FXFB, I_ONG, I_WOUT, I_N2G, I_RW, I_RB, I_W1, I_B1, I_W2, I_B2 };

template <int MAP, bool WIDE, bool OUT8 = false>
__device__ __forceinline__ void p0_transpose_item(const float* W, int ldw, bf16* WT, LAS float* scr, int k0, int n0, int lane) {
    if (WIDE) {
        f32x4 t[8];
#pragma unroll
        for (int i = 0; i < 8; ++i) t[i] = __builtin_nontemporal_load((const f32x4*)(W + (size_t)(k0 + 8 * i + (lane >> 3)) * ldw + n0 + 4 * (lane & 7)));
#pragma unroll
        for (int i = 0; i < 8; ++i) { LAS float* d = scr + (8 * i + (lane >> 3)) * 33 + 4 * (lane & 7); d[0] = t[i].x; d[1] = t[i].y; d[2] = t[i].z; d[3] = t[i].w; }
    } else {
#pragma unroll 8
        for (int i = 0; i < 32; ++i) { const int kk = 2 * i + (lane >> 5); scr[kk * 33 + (lane & 31)] = W[(size_t)(k0 + kk) * ldw + n0 + (lane & 31)]; }
    }
    asm volatile("s_waitcnt lgkmcnt(0)" ::: "memory");
    const int c = lane & 7;
#pragma unroll
    for (int j = 0; j < 4; ++j) { const int n = (lane >> 3) + 8 * j; const LAS float* s = scr + (8 * c) * 33 + n;
        v4u o; o.x = pk2(s[0 * 33], s[1 * 33]); o.y = pk2(s[2 * 33], s[3 * 33]); o.z = pk2(s[4 * 33], s[5 * 33]); o.w = pk2(s[6 * 33], s[7 * 33]);
        const int cn = n0 + n; int row = cn;
        if (MAP == 1) { const int jj = cn >> 1, t = cn & 1; row = 256 * (jj >> 7) + 128 * t + (jj & 127); }
        if (OUT8) { v2u o8; o8.x = pg8::pk4_fp8(32.0f * s[0 * 33], 32.0f * s[1 * 33], 32.0f * s[2 * 33], 32.0f * s[3 * 33]); o8.y = pg8::pk4_fp8(32.0f * s[4 * 33], 32.0f * s[5 * 33], 32.0f * s[6 * 33], 32.0f * s[7 * 33]);
            *(v2u*)((unsigned char*)WT + (size_t)row * 1024 + k0 + 8 * c) = o8; }
        else *(v4u*)(WT + (size_t)row * 1024 + k0 + 8 * c) = o; }
    asm volatile("s_waitcnt lgkmcnt(0)" ::: "memory");
}
__device__ __forceinline__ void p0_prologue(Frame& F) {
    LAS float* scr = (LAS float*)(F.lds + F.wave * 16384);
    const int gw = F.blk * 8 + F.wave, NGW = F.G * 8;
    constexpr int N_ADA = NLAYER * 4 * 24;
    if (F.blk * 8 < N_ADA) {
        LAS float* sl = (LAS float*)(F.lds + 8 * 16384 - 32768);
        for (int i = F.tid; i < NB * DM; i += 512) { const float cv = F.in[I_C][i]; sl[i] = cv / (1.0f + __expf(-cv)); }
        __syncthreads();
        if (gw < N_ADA) {
            const int it = gw; const int l = it / 96, ks = (it / 24) & 3, nc = it % 24;
            const float* W = F.in[I_WADA] + (size_t)l * DM * 6144 + nc * 256 + F.lane * 4;
            f32x4 acc[NB];
#pragma unroll
            for (int b = 0; b < NB; ++b) acc[b] = (f32x4){0.f, 0.f, 0.f, 0.f};
#pragma unroll 8
            for (int k = ks * 256; k < ks * 256 + 256; ++k) {
                const f32x4 w = __builtin_nontemporal_load((const f32x4*)(W + (size_t)k * 6144));
#pragma unroll
                for (int b = 0; b < NB; ++b) acc[b] += w * sl[b * DM + k];
            }
            float* dst = (float*)(F.ws + WS_MODP) + ((size_t)(l * 4 + ks) * NB) * 6144 + nc * 256 + F.lane * 4;
#pragma unroll
            for (int b = 0; b < NB; ++b) *(f32x4*)(dst + (size_t)b * 6144) = acc[b];
            asm volatile("s_waitcnt vmcnt(0)" ::: "memory");
            __builtin_amdgcn_fence(__ATOMIC_RELEASE, "agent");
            asm volatile("s_waitcnt vmcnt(0)" ::: "memory");
            unsigned old = 0u;
            if (F.lane == 0) old = __hip_atomic_fetch_add((unsigned*)(F.ws + WS_CTL + 1024) + (l * 24 + nc), 1u, __ATOMIC_RELAXED, __HIP_MEMORY_SCOPE_AGENT);
            old = (unsigned)__builtin_amdgcn_readfirstlane((int)old);
            if (old == 3u) {
                __builtin_amdgcn_fence(__ATOMIC_ACQUIRE, "agent");
                asm volatile("s_waitcnt vmcnt(0)" ::: "memory");
                const float* pp = (const float*)(F.ws + WS_MODP) + ((size_t)(l * 4) * NB) * 6144 + nc * 256 + F.lane * 4;
                float* fo = (float*)(F.ws + WS_MODF) + ((size_t)l * NB) * 6144 + nc * 256 + F.lane * 4;
                const f32x4 bias = *(const f32x4*)(F.in[I_BADA] + (size_t)l * 6144 + nc * 256 + F.lane * 4);
#pragma unroll
                for (int b = 0; b < NB; ++b) { f32x4 s = bias;
#pragma unroll
                    for (int k2 = 0; k2 < 4; ++k2) s += (k2 == ks) ? acc[b] : *(const f32x4*)(pp + ((size_t)k2 * NB + b) * 6144);
                    *(f32x4*)(fo + (size_t)b * 6144) = s; }
            }
        }
        __syncthreads();
    }
    constexpr int I_IN = 16 * 96, I_OUT = 16 * 32, I_1 = 16 * 64, I_2 = 16 * 32;
    constexpr int N_IN = NLAYER * I_IN, N_OUT = NLAYER * I_OUT, N_1 = NLAYER * NEXP * I_1, N_2 = NLAYER * NEXP * I_2;
#pragma unroll 1
    for (int it = gw; it < N_IN + N_OUT; it += NGW) {
        int r = it;
        if (r < N_IN) { const int l = r / I_IN, q = r % I_IN, kb = q / 96, nb = q % 96;
            p0_transpose_item<0, false, P2_FP8>(F.in[I_WIN] + (size_t)l * DM * D_IN, D_IN, (bf16*)(F.ws + WS_WIN + (size_t)l * NPROJ * DM * (P2_FP8 ? 1 : 2)), scr, 64 * kb, 32 * nb, F.lane); continue; }
        r -= N_IN;
        { const int l = r / I_OUT, q = r % I_OUT, kb = q / 32, nb = q % 32;
            p0_transpose_item<0, true>(F.in[I_WOUT] + (size_t)l * DM * DM, DM, (bf16*)(F.ws + WS_WOUT) + (size_t)l * DM * DM, scr, 64 * kb, 32 * nb, F.lane); }
    }
    constexpr int ADA_SKIP = 6, NE = N_1 + N_2;
    const bool adaw = gw < N_ADA; const int pool = adaw ? -1 : (gw - N_ADA < N_ADA * ADA_SKIP ? gw - N_ADA : -1);
    const int pool_it = (pool >= 0) ? (pool % N_ADA) + (pool / N_ADA) * NGW : -1;
    f32x4 cur[8], nxt[8];
#define P0_LOAD(dst, itx_) do { const int it_ = ((itx_) < 0) ? pool_it : (itx_); const float* s_; int ldw_; \
        if (it_ < N_1) { const int le = it_ / I_1, q = it_ % I_1, kb = q / 64, nb = q % 64; ldw_ = 2048; s_ = F.in[I_W1] + (size_t)le * DM * 2048 + (size_t)(64 * kb + (F.lane >> 3)) * 2048 + 32 * nb + 4 * (F.lane & 7); } \
        else { const int r_ = it_ - N_1; const int le = r_ / I_2, q = r_ % I_2, kb = q / 32, nb = q % 32; ldw_ = DM; s_ = F.in[I_W2] + (size_t)le * DM * DM + (size_t)(64 * kb + (F.lane >> 3)) * DM + 32 * nb + 4 * (F.lane & 7); } \
        _Pragma("unroll") for (int i = 0; i < 8; ++i) dst[i] = __builtin_nontemporal_load((const f32x4*)(s_ + (size_t)(8 * i) * ldw_)); } while (0)
    int itx = adaw ? gw + ADA_SKIP * NGW : (pool >= 0 ? gw - NGW : gw);
    if (itx < NE) P0_LOAD(cur, itx);
#pragma unroll 1
    for (; itx < NE; itx += NGW) {
        if (itx + NGW < NE) P0_LOAD(nxt, itx + NGW);
#pragma unroll
        for (int i = 0; i < 8; ++i) { LAS float* d = scr + (8 * i + (F.lane >> 3)) * 33 + 4 * (F.lane & 7); d[0] = cur[i].x; d[1] = cur[i].y; d[2] = cur[i].z; d[3] = cur[i].w; }
        asm volatile("s_waitcnt lgkmcnt(0)" ::: "memory");
        { const int it = (itx < 0) ? pool_it : itx; const bool isw1 = it < N_1; const int r = isw1 ? it : it - N_1;
          const int per = isw1 ? I_1 : I_2, nbn = isw1 ? 64 : 32; const int le = r / per, q = r % per, kb = q / nbn, nb = q % nbn;
          unsigned char* WT = isw1 ? F.ws + WS_W1 + (size_t)le * 2048 * DM : F.ws + WS_W2 + (size_t)le * DM * DM;
          const int c = F.lane & 7;
#pragma unroll
          for (int j = 0; j < 4; ++j) { const int n = (F.lane >> 3) + 8 * j; const LAS float* s = scr + (8 * c) * 33 + n;
              v2u o8; o8.x = pg8::pk4_fp8(32.0f * s[0 * 33], 32.0f * s[1 * 33], 32.0f * s[2 * 33], 32.0f * s[3 * 33]); o8.y = pg8::pk4_fp8(32.0f * s[4 * 33], 32.0f * s[5 * 33], 32.0f * s[6 * 33], 32.0f * s[7 * 33]);
              const int cn = 32 * nb + n; int row = cn;
              if (isw1) { const int jj = cn >> 1, t = cn & 1; row = 256 * (jj >> 7) + 128 * t + (jj & 127); }
              *(v2u*)(WT + (size_t)row * 1024 + 64 * kb + 8 * c) = o8; } }
        asm volatile("s_waitcnt lgkmcnt(0)" ::: "memory");
#pragma unroll
        for (int i = 0; i < 8; ++i) cur[i] = nxt[i];
    }
#undef P0_LOAD
}

__device__ __forceinline__ f32x4 mod4(const Frame& F, int l, int b, int which, int c) { return *(const f32x4*)((const float*)(F.ws + WS_MODF) + ((size_t)l * NB + b) * 6144 + which * DM + c); }
__device__ __forceinline__ f32x4 mod4_old(const Frame& F, int l, int b, int which, int c) {
    const int n = which * DM + c;
    f32x4 s = *(const f32x4*)(F.in[I_BADA] + (size_t)l * 6144 + n);
    const float* p = (const float*)(F.ws + WS_MODP) + ((size_t)(l * 4) * NB + b) * 6144 + n;
#pragma unroll
    for (int ks = 0; ks < 4; ++ks) s += *(const f32x4*)(p + (size_t)ks * NB * 6144);
    return s;
}

constexpr size_t WS_GSUM = WS_FCUM + 800 * 1024;
static_assert(WS_GSUM + 16384 <= WS_WIN, "ws map");
template <bool S16> __device__ __forceinline__ f32x4 ld_row4(const void* base, size_t idx) {
    if (S16) { const v2u t = *(const v2u*)((const bf16*)base + idx); return (f32x4){bflo(t.x), bfhi(t.x), bflo(t.y), bfhi(t.y)}; }
    return *(const f32x4*)((const float*)base + idx); }
template <bool D16> __device__ __forceinline__ void st_row4(void* base, size_t idx, f32x4 v) {
    if (D16) { v2u o; o.x = pk2(v.x, v.y); o.y = pk2(v.z, v.w); *(v2u*)((bf16*)base + idx) = o; }
    else *(f32x4*)((float*)base + idx) = v; }
__device__ __forceinline__ f32x4 fp8x4_to_f32(unsigned w) { return (f32x4){__builtin_amdgcn_cvt_f32_fp8(w, 0), __builtin_amdgcn_cvt_f32_fp8(w, 1), __builtin_amdgcn_cvt_f32_fp8(w, 2), __builtin_amdgcn_cvt_f32_fp8(w, 3)}; }
template <bool COMBINE, bool NORM, bool S16, bool D16>
__device__ __forceinline__ void row_phase(Frame& F, int l, const void* xsrc, void* xdst) {
    const float* topw = (const float*)(F.ws + WS_TOPW); const int* tokslot = (const int*)(F.ws + WS_TOKSLOT); const unsigned char* Y = F.ws + WS_Y;
    bf16* H = (bf16*)(F.ws + WS_H); float* logf = (float*)(F.ws + WS_LOGF); float* gsum = (float*)(F.ws + WS_GSUM);
    LAS f32x4* wl4 = (LAS f32x4*)F.lds; LAS f32x2* wl2 = (LAS f32x2*)(F.lds + 16384); LAS float* part = (LAS float*)(F.lds + 16384 + 8192);
    if (NORM) { for (int k = F.tid; k < DM; k += 512) { const float* wp = F.in[I_WIN] + (size_t)l * DM * D_IN + (size_t)k * D_IN + NPROJ; const int idx = (4 * (k >> 8) + (k & 3)) * 64 + ((k >> 2) & 63);
            wl4[idx] = (f32x4){wp[0], wp[1], wp[2], wp[3]}; wl2[idx] = (f32x2){wp[4], wp[5]}; }
        __syncthreads(); }
    for (int chunk = F.blk; chunk < NTOK / 128; chunk += F.G) {
        const int b = chunk / (SEQ / 128);
        LAS f32x4* mv = (LAS f32x4*)(F.lds + 32768);
        __syncthreads();
        if (F.wave == 0) {
#pragma unroll
            for (int j = 0; j < 4; ++j) { const int c = 256 * j + 4 * F.lane;
                if (COMBINE) mv[(0 * 4 + j) * 64 + F.lane] = mod4_old(F, l - 1, b, 5, c);
                if (NORM) { const f32x4 g = *(const f32x4*)(F.in[I_N1G] + (size_t)l * DM + c); mv[(1 * 4 + j) * 64 + F.lane] = g * (mod4_old(F, l, b, 1, c) + 1.0f); mv[(2 * 4 + j) * 64 + F.lane] = mod4_old(F, l, b, 0, c); } } }
        __syncthreads();
        float lacc = 0.f;
#pragma unroll 1
        for (int rr = 0; rr < 16; rr += 2) {
            const int row = chunk * 128 + F.wave * 16 + rr;
            f32x4 v[2][4];
#pragma unroll
            for (int u = 0; u < 2; ++u)
#pragma unroll
                for (int j = 0; j < 4; ++j) v[u][j] = ld_row4<S16>(xsrc, (size_t)(row + u) * DM + 256 * j + 4 * F.lane);
            int mofs = F.lane; asm volatile("" : "+v"(mofs));
            if (COMBINE) {
#pragma unroll
                for (int u = 0; u < 2; ++u) {
                    f32x4 s[4];
#pragma unroll
                    for (int j = 0; j < 4; ++j) s[j] = (f32x4){0.f, 0.f, 0.f, 0.f};
#pragma unroll
                    for (int k = 0; k < TOPK; ++k) { const float w = topw[(row + u) * 4 + k]; const int slot = tokslot[(row + u) * 4 + k];
#pragma unroll
                        for (int j = 0; j < 4; ++j) s[j] += fp8x4_to_f32(*(const unsigned*)(Y + (size_t)slot * DM + 256 * j + 4 * F.lane)) * w; }
#pragma unroll
                    for (int j = 0; j < 4; ++j) { v[u][j] += mv[(0 * 4 + j) * 64 + mofs] * s[j]; st_row4<D16>(xdst, (size_t)(row + u) * DM + 256 * j + 4 * F.lane, v[u][j]); }
                }
            }
            if (NORM) {
                float ss[2];
#pragma unroll
                for (int u = 0; u < 2; ++u) { float s = 0.f;
#pragma unroll
                    for (int j = 0; j < 4; ++j) s += (v[u][j].x * v[u][j].x + v[u][j].y * v[u][j].y) + (v[u][j].z * v[u][j].z + v[u][j].w * v[u][j].w);
                    ss[u] = s; }
#pragma unroll
                for (int o = 1; o < 32; o <<= 1) { ss[0] += shx(ss[0], o, F.lane); ss[1] += shx(ss[1], o, F.lane); }
                ss[0] = add_other_half(ss[0]); ss[1] = add_other_half(ss[1]);
                float fl[2][6];
                int lofs = F.lane; asm volatile("" : "+v"(lofs));
#pragma unroll
                for (int u = 0; u < 2; ++u) { const float rstd = 1.0f / sqrtf(ss[u] * (1.0f / DM) + EPS);
#pragma unroll
                    for (int q = 0; q < 6; ++q) fl[u][q] = 0.f;
#pragma unroll
                    for (int j = 0; j < 4; ++j) { const f32x4 hv = v[u][j] * rstd * mv[(1 * 4 + j) * 64 + mofs] + mv[(2 * 4 + j) * 64 + mofs];
                        if (P2_FP8) *(unsigned*)((unsigned char*)H + (size_t)(row + u) * DM + 256 * j + 4 * F.lane) = pg8::pk4_fp8(hv.x, hv.y, hv.z, hv.w);
                        else { v2u o; o.x = pk2(hv.x, hv.y); o.y = pk2(hv.z, hv.w); *(v2u*)(H + (size_t)(row + u) * DM + 256 * j + 4 * F.lane) = o; }
#pragma unroll
                        for (int i = 0; i < 4; ++i) { const f32x4 wa = wl4[(4 * j + i) * 64 + lofs]; const f32x2 wb = wl2[(4 * j + i) * 64 + lofs]; const float hx = hv[i];
                            fl[u][0] += hx * wa.x; fl[u][1] += hx * wa.y; fl[u][2] += hx * wa.z; fl[u][3] += hx * wa.w; fl[u][4] += hx * wb.x; fl[u][5] += hx * wb.y; } } }
#pragma unroll
                for (int o = 1; o < 32; o <<= 1)
#pragma unroll
                    for (int u = 0; u < 2; ++u)
#pragma unroll
                        for (int q = 0; q < 6; ++q) fl[u][q] += shx(fl[u][q], o, F.lane);
#pragma unroll
                for (int u = 0; u < 2; ++u)
#pragma unroll
                    for (int q = 0; q < 6; ++q) fl[u][q] = add_other_half(fl[u][q]);
                if (F.lane < 6) {
#pragma unroll
                    for (int u = 0; u < 2; ++u) { float z = fl[u][0];
#pragma unroll
                        for (int q = 1; q < 6; ++q) z = (F.lane == q) ? fl[u][q] : z;
                        z += F.in[I_FXFB][l * 6 + F.lane];
                        const float lg = fminf(z, 0.f) - __logf(1.0f + __expf(-fabsf(z)));
                        logf[(size_t)(row + u) * 6 + F.lane] = lg; lacc += lg; } }
            }
        }
        if (NORM) {
            if (F.lane < 6) part[F.wave * 8 + F.lane] = lacc;
            __syncthreads();
            if (F.tid < 12) { const int g = F.tid / 6, h = F.tid % 6; gsum[(size_t)(chunk * 2 + g) * 6 + h] = (part[(4 * g) * 8 + h] + part[(4 * g + 1) * 8 + h]) + (part[(4 * g + 2) * 8 + h] + part[(4 * g + 3) * 8 + h]); }
            __syncthreads();
        }
    }
    __syncthreads();
}
__device__ __forceinline__ void p3_postproj(Frame& F, int l) {
    bf16* proj = (bf16*)(F.ws + WS_PROJ); bf16* ymix = (bf16*)(F.ws + WS_YMIX);
    const float* ong = F.in[I_ONG] + (size_t)l * DM;
    const int c4 = 4 * F.lane;
    f32x4 cw[3];
#pragma unroll
    for (int w = 0; w < 3; ++w) cw[w] = *(const f32x4*)(F.in[I_CONVW] + (size_t)(l * 3 + w) * 256 + c4);
    const f32x4 cg = *(const f32x4*)(ong + c4);
    const int e0 = 8 * (F.lane & 7);
    float gq[3][8]; int colv[3];
#pragma unroll
    for (int i = 0; i < 3; ++i) { const int vi = 8 * i + (F.lane >> 3); const int ty = vi / 6;
        colv[i] = (vi < 12 ? COL_SQ + 64 * vi : COL_FQ + 64 * (vi - 12)) + e0;
        const float* gp = (ty == 0 ? F.in[I_SBQG] : ty == 1 ? F.in[I_SBKG] : ty == 2 ? F.in[I_FXQG] : F.in[I_FXKG]) + (size_t)l * 64 + e0; const float sc = (ty == 0 || ty == 2) ? QSCALE : 1.0f;
#pragma unroll
        for (int q = 0; q < 8; ++q) gq[i][q] = gp[q] * sc; }
    LAS unsigned char* scr = F.lds + F.wave * (64 * 144);
    for (int tile = F.blk; tile < NTOK / 64; tile += F.G) {
        const int b = tile / (SEQ / 64), s0 = (tile % (SEQ / 64)) * 64; const size_t row0 = (size_t)b * SEQ + s0;
        {
            const int sw0 = s0 + F.wave * 8;
            f32x4 vm2 = (f32x4){0.f, 0.f, 0.f, 0.f}, vm1 = vm2;
            if (sw0 >= 2) {
                const bf16* p2 = proj + ((size_t)b * SEQ + sw0 - 2) * NPROJ; const bf16* p1 = p2 + NPROJ;
                const v2u c2 = *(const v2u*)(p2 + COL_CC + c4), u2 = *(const v2u*)(p2 + COL_CU + c4), c1 = *(const v2u*)(p1 + COL_CC + c4), u1 = *(const v2u*)(p1 + COL_CU + c4);
                vm2 = (f32x4){bflo(c2.x) * bflo(u2.x), bfhi(c2.x) * bfhi(u2.x), bflo(c2.y) * bflo(u2.y), bfhi(c2.y) * bfhi(u2.y)};
                vm1 = (f32x4){bflo(c1.x) * bflo(u1.x), bfhi(c1.x) * bfhi(u1.x), bflo(c1.y) * bflo(u1.y), bfhi(c1.y) * bfhi(u1.y)}; }
#pragma unroll 1
            for (int tt = 0; tt < 8; tt += 2) {
                bf16* pr[2]; v2u cb[2], cc[2], cu[2]; v4u xq[2][3];
#pragma unroll
                for (int u = 0; u < 2; ++u) { pr[u] = proj + ((size_t)b * SEQ + sw0 + tt + u) * NPROJ;
                    cb[u] = *(const v2u*)(pr[u] + COL_CB + c4); cc[u] = *(const v2u*)(pr[u] + COL_CC + c4); cu[u] = *(const v2u*)(pr[u] + COL_CU + c4);
#pragma unroll
                    for (int i = 0; i < 3; ++i) xq[u][i] = *(const v4u*)(pr[u] + colv[i]); }
                f32x4 y[2]; float ss[2], q2[2][3];
#pragma unroll
                for (int u = 0; u < 2; ++u) {
                    const f32x4 v0 = (f32x4){bflo(cc[u].x) * bflo(cu[u].x), bfhi(cc[u].x) * bfhi(cu[u].x), bflo(cc[u].y) * bflo(cu[u].y), bfhi(cc[u].y) * bfhi(cu[u].y)};
                    y[u] = cw[0] * vm2 + cw[1] * vm1 + cw[2] * v0; vm2 = vm1; vm1 = v0;
                    y[u] = y[u] * (f32x4){bflo(cb[u].x), bfhi(cb[u].x), bflo(cb[u].y), bfhi(cb[u].y)};
                    ss[u] = (y[u].x * y[u].x + y[u].y * y[u].y) + (y[u].z * y[u].z + y[u].w * y[u].w);
#pragma unroll
                    for (int i = 0; i < 3; ++i) { const v4u x = xq[u][i]; const float f[8] = {bflo(x.x), bfhi(x.x), bflo(x.y), bfhi(x.y), bflo(x.z), bfhi(x.z), bflo(x.w), bfhi(x.w)};
                        float a = 0.f;
#pragma unroll
                        for (int k = 0; k < 8; ++k) a += f[k] * f[k];
                        q2[u][i] = a; } }
#pragma unroll
                for (int o = 1; o < 16; o <<= 1)
#pragma unroll
                    for (int u = 0; u < 2; ++u) { ss[u] += shx(ss[u], o, F.lane);
                        if (o < 8) {
#pragma unroll
                            for (int i = 0; i < 3; ++i) q2[u][i] += shx(q2[u][i], o, F.lane); } }
#pragma unroll
                for (int u = 0; u < 2; ++u) {
                    const float rinv = 1.0f / sqrtf(ss[u] * (1.0f / 64.0f) + EPS);
                    const f32x4 yo = y[u] * rinv * cg;
                    v2u o; o.x = pk2(yo.x, yo.y); o.y = pk2(yo.z, yo.w); *(v2u*)(ymix + ((size_t)b * SEQ + sw0 + tt + u) * DM + c4) = o;
#pragma unroll
                    for (int i = 0; i < 3; ++i) { const v4u x = xq[u][i]; const float f[8] = {bflo(x.x), bfhi(x.x), bflo(x.y), bfhi(x.y), bflo(x.z), bfhi(x.z), bflo(x.w), bfhi(x.w)};
                        const float ri = 1.0f / sqrtf(q2[u][i] * (1.0f / 64.0f) + EPS);
                        v4u w; w.x = pk2(f[0] * ri * gq[i][0], f[1] * ri * gq[i][1]); w.y = pk2(f[2] * ri * gq[i][2], f[3] * ri * gq[i][3]);
                        w.z = pk2(f[4] * ri * gq[i][4], f[5] * ri * gq[i][5]); w.w = pk2(f[6] * ri * gq[i][6], f[7] * ri * gq[i][7]);
                        *(v4u*)(pr[u] + colv[i]) = w; } }
            }
        }
        for (int t = F.wave; t < 12; t += 8) {
            const int kind = t / 6, h = t % 6; const int col = (kind ? COL_FV : COL_SV) + 64 * h;
            const bf16* src = proj + (row0 + F.lane) * NPROJ + col;
#pragma unroll
            for (int pc = 0; pc < 8; ++pc) { const v4u x = *(const v4u*)(src + 8 * pc);
                const unsigned xs[4] = {x.x, x.y, x.z, x.w};
#pragma unroll
                for (int q = 0; q < 4; ++q) { *(LAS unsigned short*)(scr + (8 * pc + 2 * q) * 144 + 2 * F.lane) = (unsigned short)(xs[q] & 0xffffu);
                                              *(LAS unsigned short*)(scr + (8 * pc + 2 * q + 1) * 144 + 2 * F.lane) = (unsigned short)(xs[q] >> 16); } }
            asm volatile("s_waitcnt lgkmcnt(0)" ::: "memory");
            bf16* dst = (bf16*)(F.ws + WS_VT) + (size_t)kind * (48 * 64 * SEQ) + ((size_t)(b * 6 + h) * 64 + F.lane) * SEQ + s0;
#pragma unroll
            for (int pc = 0; pc < 8; ++pc) *(v4u*)(dst + 8 * pc) = *(const LAS v4u*)(scr + F.lane * 144 + 16 * pc);
            asm volatile("s_waitcnt lgkmcnt(0)" ::: "memory");
        }
        if (F.wave == 7) { const int gt = tile % (SEQ / 64); const float* gs = (const float*)(F.ws + WS_GSUM) + (size_t)(b * (SEQ / 64)) * 6; const float* lf = (const float*)(F.ws + WS_LOGF) + (row0 + F.lane) * 6;
            float* fo = (float*)(F.ws + WS_FCUM) + (size_t)(b * 6) * SEQ + s0 + F.lane;
#pragma unroll
            for (int h = 0; h < 6; ++h) { float base = (F.lane < gt) ? gs[F.lane * 6 + h] : 0.f; base = wave_sum(base, F.lane);
                float inc = lf[h];
#pragma unroll
                for (int o = 1; o < 64; o <<= 1) { const float t = shup(inc, o, F.lane); if (F.lane >= o) inc += t; }
                fo[(size_t)h * SEQ] = (base + inc) * LOG2E; } }
    }
}

__device__ __forceinline__ void p4_attention(Frame& F, int l) {
    att::Tensors Ts, Tf;
    Ts.proj = (const bf16*)(F.ws + WS_PROJ); Ts.vt = (const bf16*)(F.ws + WS_VT); Ts.fcum = (const float*)(F.ws + WS_FCUM); Ts.ymix = (bf16*)(F.ws + WS_YMIX); Ts.ong = F.in[I_ONG] + (size_t)l * DM;
    Ts.colq = COL_SQ; Ts.colk = COL_SK; Ts.coly = 256; Ts.tprobe = (void*)(F.ws + WS_CTL + 512);
    Tf = Ts; Tf.vt = Ts.vt + (size_t)48 * 64 * SEQ; Tf.colq = COL_FQ; Tf.colk = COL_FK; Tf.coly = 640;
    {
        float gq = fabsf(F.in[I_FXQG][l * 64 + F.lane]), gk = fabsf(F.in[I_FXKG][l * 64 + F.lane]);
#pragma unroll
        for (int o = 1; o < 32; o <<= 1) { gq = fmaxf(gq, shx(gq, o, F.lane)); gk = fmaxf(gk, shx(gk, o, F.lane)); }
        { auto rq = __builtin_amdgcn_permlane32_swap(__float_as_uint(gq), __float_as_uint(gq), false, false); gq = fmaxf(__uint_as_float(rq[0]), __uint_as_float(rq[1]));
          auto rk = __builtin_amdgcn_permlane32_swap(__float_as_uint(gk), __float_as_uint(gk), false, false); gk = fmaxf(__uint_as_float(rk[0]), __uint_as_float(rk[1])); }
        Tf.z2max = 64.0f * gq * gk * QSCALE * 1.02f; Ts.z2max = 0.f;
    }
    const int NU = 48 * 16;
    for (int i = 0; i * F.G < NU; ++i) {
        const int L = (i & 1) ? (i + 1) * F.G - 1 - F.blk : i * F.G + F.blk;
        if (L >= NU) continue;
        const int qb = 15 - L / 48, bh = L % 48;
#if defined(ATT_HYB) && (ATT_HYB & 1)
        { att_old::Tensors To; To.proj = Ts.proj; To.ymix = Ts.ymix; To.ong = Ts.ong; To.fcum = Ts.fcum; To.vt = Ts.vt; To.colq = Ts.colq; To.colk = Ts.colk; To.coly = Ts.coly; att_old::unit<0>(To, bh / 6, bh % 6, qb, F.lds, F.wave); }
#else
        att::unit<0>(Ts, bh / 6, bh % 6, qb, F.lds, F.wave);
#endif
    }
    for (int i = 0; i * F.G < NU; ++i) {
        const int L = (i & 1) ? (i + 1) * F.G - 1 - F.blk : i * F.G + F.blk;
        if (L >= NU) continue;
        const int qb = 15 - L / 48, bh = L % 48;
#if defined(ATT_HYB) && (ATT_HYB & 2)
        { att_old::Tensors To; To.proj = Tf.proj; To.ymix = Tf.ymix; To.ong = Tf.ong; To.fcum = Tf.fcum; To.vt = Tf.vt; To.colq = Tf.colq; To.colk = Tf.colk; To.coly = Tf.coly; att_old::unit<1>(To, bh / 6, bh % 6, qb, F.lds, F.wave); }
#else
        att::unit<1>(Tf, bh / 6, bh % 6, qb, F.lds, F.wave);
#endif
    }
}

__device__ __forceinline__ void top4of8(const float (&v)[8], const int (&ix)[8], float (&tv)[4], int (&ti)[4]) {
    float w[8];
#pragma unroll
    for (int j = 0; j < 8; ++j) w[j] = v[j];
#pragma unroll
    for (int k = 0; k < 4; ++k) { float bv = w[0]; int bi = ix[0];
#pragma unroll
        for (int j = 1; j < 8; ++j) { const bool t = (w[j] > bv) || (w[j] == bv && ix[j] < bi); bv = t ? w[j] : bv; bi = t ? ix[j] : bi; }
        tv[k] = bv; ti[k] = bi;
#pragma unroll
        for (int j = 0; j < 8; ++j) w[j] = (ix[j] == bi) ? -INFINITY : w[j]; }
}
__device__ __forceinline__ void p6_norm_router(Frame& F, int l, const bf16* x1) {
    unsigned char* H8 = F.ws + WS_H8; float* topw = (float*)(F.ws + WS_TOPW); int* route = (int*)(F.ws + WS_ROUTE); int* hist = (int*)(F.ws + WS_HIST);
    const float* rw = F.in[I_RW] + (size_t)l * DM * NEXP; const float* rb = F.in[I_RB] + (size_t)l * NEXP;
#ifdef P6SEG
    unsigned long long sg_acc = 0ull, sg_t = __builtin_readcyclecounter();
#define SEG(n) do { const unsigned long long t_ = __builtin_readcyclecounter(); if ((n) == P6SEG) sg_acc += t_ - sg_t; sg_t = t_; asm volatile("" :: "s"(t_)); } while (0)
#else
#define SEG(n) do {} while (0)
#endif
    constexpr int RWP = 2064;
    LAS unsigned char* rwt = F.lds;
    LAS int* cnt = (LAS int*)(F.lds + MISC_OFF + 256);
    {
        f32x4 t[16];
#pragma unroll
        for (int i = 0; i < 16; ++i) t[i] = *(const f32x4*)(rw + (size_t)(2 * F.tid) * NEXP + 4 * i);
#pragma unroll
        for (int i = 0; i < 8; ++i)
#pragma unroll
            for (int c = 0; c < 4; ++c) *(LAS unsigned*)(rwt + (4 * i + c) * RWP + 4 * F.tid) = f2bf(t[i][c]) | (f2bf(t[8 + i][c]) << 16);
    }
    __syncthreads();
    SEG(0);
    const int fr = F.lane & 15, fq = F.lane >> 4;
    float rbv[8]; int eix[8];
#pragma unroll
    for (int i = 0; i < 4; ++i) { eix[i] = 4 * fq + i; eix[4 + i] = 16 + 4 * fq + i; rbv[i] = rb[4 * fq + i]; rbv[4 + i] = rb[16 + 4 * fq + i]; }
    for (int chunk = F.blk; chunk < NTOK / 128; chunk += F.G) {
        const int b = chunk / (SEQ / 128);
        if (F.tid < 32) cnt[F.tid] = 0;
        f32x4 A[4], Bv[4];
        LAS f32x4* Al = (LAS f32x4*)(F.lds + 66560); LAS f32x4* Bl = (LAS f32x4*)(F.lds + 70656); LAS float* rsl = (LAS float*)(F.lds + 74752);
#pragma unroll
        for (int j = 0; j < 4; ++j) { const int c = 256 * j + 4 * F.lane; const f32x4 g = *(const f32x4*)(F.in[I_N2G] + (size_t)l * DM + c); A[j] = g * (mod4(F, l, b, 4, c) + 1.0f); Bv[j] = mod4(F, l, b, 3, c);
            if (F.wave == 0) { Al[64 * j + F.lane] = A[j]; Bl[64 * j + F.lane] = Bv[j]; } }
        __syncthreads();
        const int row0 = chunk * 128 + F.wave * 16;
        SEG(1);
#pragma unroll 1
        for (int rr = 0; rr < 16; rr += 4) {
            f32x4 v[4][4]; float ss[4];
#pragma unroll
            for (int u = 0; u < 4; ++u)
#pragma unroll
                for (int j = 0; j < 4; ++j) v[u][j] = ld_row4<true>(x1, (size_t)(row0 + rr + u) * DM + 256 * j + 4 * F.lane);
#pragma unroll
            for (int u = 0; u < 4; ++u) { float s = 0.f;
#pragma unroll
                for (int j = 0; j < 4; ++j) s += (v[u][j].x * v[u][j].x + v[u][j].y * v[u][j].y) + (v[u][j].z * v[u][j].z + v[u][j].w * v[u][j].w);
                ss[u] = s; }
#pragma unroll
            for (int o = 1; o < 32; o <<= 1) { ss[0] += shx(ss[0], o, F.lane); ss[1] += shx(ss[1], o, F.lane); ss[2] += shx(ss[2], o, F.lane); ss[3] += shx(ss[3], o, F.lane); }
            ss[0] = add_other_half(ss[0]); ss[1] = add_other_half(ss[1]); ss[2] = add_other_half(ss[2]); ss[3] = add_other_half(ss[3]);
#pragma unroll
            for (int u = 0; u < 4; ++u) { const float rstd = 1.0f / sqrtf(ss[u] * (1.0f / DM) + EPS);
                if (F.lane == 0) rsl[F.wave * 16 + rr + u] = rstd;
#pragma unroll
                for (int j = 0; j < 4; ++j) { const f32x4 hv = v[u][j] * rstd * A[j] + Bv[j];
                    *(unsigned*)(H8 + (size_t)(row0 + rr + u) * DM + 256 * j + 4 * F.lane) = pg8::pk4_fp8(hv.x, hv.y, hv.z, hv.w); } }
        }
        SEG(2);
        f32x4 acc0 = (f32x4){0.f, 0.f, 0.f, 0.f}, acc1 = (f32x4){0.f, 0.f, 0.f, 0.f};
        { const bf16* xp = x1 + (size_t)(row0 + fr) * DM + 8 * fq; const LAS unsigned char* wp = rwt + fr * RWP + 16 * fq; const float rs = rsl[F.wave * 16 + fr];
#pragma unroll 4
          for (int s = 0; s < 32; ++s) { const v4u xb = *(const v4u*)(xp + 32 * s);
              const f32x4 a0 = Al[8 * s + 2 * fq], a1v = Al[8 * s + 2 * fq + 1], b0 = Bl[8 * s + 2 * fq], b1v = Bl[8 * s + 2 * fq + 1];
              const f32x4 h0 = (f32x4){bflo(xb.x), bfhi(xb.x), bflo(xb.y), bfhi(xb.y)} * rs * a0 + b0, h1 = (f32x4){bflo(xb.z), bfhi(xb.z), bflo(xb.w), bfhi(xb.w)} * rs * a1v + b1v;
              v4u hb; hb.x = pk2(h0.x, h0.y); hb.y = pk2(h0.z, h0.w); hb.z = pk2(h1.x, h1.y); hb.w = pk2(h1.z, h1.w);
              const bf16x8 a0w = *(const LAS bf16x8*)(wp + 64 * s), a1w = *(const LAS bf16x8*)(wp + 16 * RWP + 64 * s);
              acc0 = __builtin_amdgcn_mfma_f32_16x16x32_bf16(a0w, __builtin_bit_cast(bf16x8, hb), acc0, 0, 0, 0);
              acc1 = __builtin_amdgcn_mfma_f32_16x16x32_bf16(a1w, __builtin_bit_cast(bf16x8, hb), acc1, 0, 0, 0); } }
        SEG(3);
        float cv[8], tv[4], ov[8]; int ti[4], oi[8];
#pragma unroll
        for (int i = 0; i < 4; ++i) { cv[i] = acc0[i] + rbv[i]; cv[4 + i] = acc1[i] + rbv[4 + i]; }
        top4of8(cv, eix, tv, ti);
        {
#pragma unroll
            for (int k = 0; k < 4; ++k) { ov[k] = tv[k]; oi[k] = ti[k]; ov[4 + k] = shx(tv[k], 16, F.lane); oi[4 + k] = shxi(ti[k], 16, F.lane); }
            top4of8(ov, oi, tv, ti);
#pragma unroll
            for (int k = 0; k < 4; ++k) { auto rv = __builtin_amdgcn_permlane32_swap(__float_as_uint(tv[k]), __float_as_uint(tv[k]), false, false); auto ri = __builtin_amdgcn_permlane32_swap((unsigned)ti[k], (unsigned)ti[k], false, false);
                ov[k] = __uint_as_float(rv[0]); oi[k] = (int)ri[0]; ov[4 + k] = __uint_as_float(rv[1]); oi[4 + k] = (int)ri[1]; }
            top4of8(ov, oi, tv, ti); }
        const float e1 = __expf(tv[1] - tv[0]), e2 = __expf(tv[2] - tv[0]), e3 = __expf(tv[3] - tv[0]); const float inv = 1.0f / (1.0f + e1 + e2 + e3);
        { const int row = row0 + fr, k = fq;
          const float w = (k == 0 ? 1.0f : k == 1 ? e1 : k == 2 ? e2 : e3) * inv; const int ex = (k == 0 ? ti[0] : k == 1 ? ti[1] : k == 2 ? ti[2] : ti[3]);
          const int pos = __hip_atomic_fetch_add(cnt + ex, 1, __ATOMIC_RELAXED, __HIP_MEMORY_SCOPE_WORKGROUP);
          topw[row * 4 + k] = w; route[row * 4 + k] = ex + 32 * pos; }
        SEG(4);
        __syncthreads();
        if (F.tid < 32) hist[chunk * 32 + F.tid] = cnt[F.tid];
        __syncthreads();
        SEG(5);
    }
#ifdef P6SEG
    if (F.blk == 0 && F.tid == 0) atomicAdd((unsigned long long*)(F.ws + WS_CTL + 512), sg_acc);
#endif
}

__device__ __forceinline__ void p7_scatter(Frame& F) {
    const int* hist = (const int*)(F.ws + WS_HIST); const int* route = (const int*)(F.ws + WS_ROUTE);
    int* tokslot = (int*)(F.ws + WS_TOKSLOT); int* slottok = (int*)(F.ws + WS_SLOTTOK); int* moetab = (int*)(F.ws + WS_MOETAB);
    LAS int* pre = (LAS int*)F.lds;
    LAS int* base = (LAS int*)(F.lds + 32768);
    for (int i = F.tid; i < 256 * 32; i += 512) pre[i] = hist[i];
    __syncthreads();
    if (F.tid < 32) { int run = 0;
        for (int c = 0; c < 256; ++c) { const int v = pre[c * 32 + F.tid]; pre[c * 32 + F.tid] = run; run += v; }
        base[64 + F.tid] = run; }
    __syncthreads();
    if (F.tid == 0) { int run = 0; for (int ex = 0; ex < NEXP; ++ex) { base[ex] = run; run += (base[64 + ex] + 255) & ~255; } base[NEXP] = run; }
    __syncthreads();
    if (F.blk == 0 && F.tid <= NEXP) moetab[F.tid] = base[F.tid] >> 8;
    for (int chunk = F.blk; chunk < NTOK / 128; chunk += F.G) {
        const int t = chunk * 128 + (F.tid >> 2), k = F.tid & 3; const int rt = route[t * 4 + k]; const int ex = rt & 31, pos = rt >> 5;
        const int slot = base[ex] + pre[chunk * 32 + ex] + pos;
        tokslot[t * 4 + k] = slot; slottok[slot] = t;
    }
    for (int ex = F.blk; ex < NEXP; ex += F.G) { const int lo = base[ex] + base[64 + ex], hi = base[ex + 1]; for (int s = lo + F.tid; s < hi; s += 512) slottok[s] = 0; }
    __syncthreads();
}

struct Args { const float* in[21]; float* out; unsigned char* ws; int ph_lo, ph_hi; };
__device__ __forceinline__ void launder(Frame& F, int wave) {
#if 0
    int t = threadIdx.x; asm volatile("" : "+v"(t)); F.tid = t; F.lane = t & 63; F.wave = __builtin_amdgcn_readfirstlane(t >> 6); (void)wave;
#else
    int t = lane_id(); asm volatile("" : "+v"(t)); F.lane = t & 63; F.wave = wave; F.tid = wave * 64 + F.lane;
#endif
    const __attribute__((address_space(4))) Args* ap = (const __attribute__((address_space(4))) Args*)__builtin_amdgcn_kernarg_segment_ptr(); asm volatile("" : "+s"(ap));
#pragma unroll
    for (int i = 0; i < 21; ++i) F.in[i] = ap->in[i];
    F.out = ap->out; F.ws = ap->ws; }
constexpr int N_PHASES = 1 + 9 * NLAYER + 1;

#define PHASE_FN __device__ __forceinline__
__device__ __forceinline__ void make_frame(Frame& F, LAS unsigned char* lds, int wave) { F.lds = lds; int bk = blockIdx.x, gd = gridDim.x; asm volatile("" : "+s"(bk), "+s"(gd)); F.blk = bk; F.G = gd; launder(F, wave); }
PHASE_FN void ph_prologue(LAS unsigned char* lds, int wave) { Frame F; make_frame(F, lds, wave); p0_prologue(F); }
PHASE_FN void ph_norm1(LAS unsigned char* lds, int wave, int l) { Frame F; make_frame(F, lds, wave);
    if (l == 0) row_phase<false, true, false, false>(F, 0, F.in[I_X], nullptr); else row_phase<true, true, true, true>(F, l, F.ws + WS_XA, F.ws + WS_XB); }
PHASE_FN void ph_proj(LAS unsigned char* lds, int wave, int l) { Frame F; make_frame(F, lds, wave);
    pg8::Gemm g{(const bf16*)(F.ws + WS_H), (const bf16*)(F.ws + WS_WIN + (size_t)l * NPROJ * DM * (P2_FP8 ? 1 : 2)), nullptr, P2_FP8 ? DM / 2 : DM};
    pg8::StaticOrder S; S.init(NTOK, NPROJ, F.G, F.blk);
    pg8::EpiProj E{(bf16*)(F.ws + WS_PROJ), NPROJ};
    pg8::gemm_phase<pg8::EpiProj, pg8::StaticOrder, false, P2_FP8 != 0>(F.lds, g, S, E, F.wave); }
PHASE_FN void ph_postproj(LAS unsigned char* lds, int wave, int l) { Frame F; make_frame(F, lds, wave); p3_postproj(F, l); }
PHASE_FN void ph_attn(LAS unsigned char* lds, int wave, int l) { Frame F; make_frame(F, lds, wave); p4_attention(F, l); }
PHASE_FN void ph_out(LAS unsigned char* lds, int wave, int l) { Frame F; make_frame(F, lds, wave);
    pg8::Gemm g{(const bf16*)(F.ws + WS_YMIX), (const bf16*)(F.ws + WS_WOUT) + (size_t)l * DM * DM, nullptr, DM};
    pg8::StaticOrder S; S.init(NTOK, DM, F.G, F.blk);
    const float* gt = (const float*)(F.ws + WS_MODF) + (size_t)l * NB * 6144 + 2 * DM;
    if (l == 0) { pg8::EpiResGate<false> E{F.in[I_X], (bf16*)(F.ws + WS_XA), gt}; pg8::gemm_phase<pg8::EpiResGate<false>, pg8::StaticOrder, false>(F.lds, g, S, E, F.wave); }
    else { pg8::EpiResGate<true> E{F.ws + WS_XB, (bf16*)(F.ws + WS_XA), gt}; pg8::gemm_phase<pg8::EpiResGate<true>, pg8::StaticOrder, false>(F.lds, g, S, E, F.wave); } }
PHASE_FN void ph_router(LAS unsigned char* lds, int wave, int l) { Frame F; make_frame(F, lds, wave); p6_norm_router(F, l, (const bf16*)(F.ws + WS_XA)); }
PHASE_FN void ph_scatter(LAS unsigned char* lds, int wave) { Frame F; make_frame(F, lds, wave); p7_scatter(F); }
__device__ __forceinline__ LAS int* moe_table(Frame& F) { LAS int* tb = (LAS int*)(F.lds + MISC_OFF + 64);
    if (F.tid <= NEXP) tb[F.tid] = ((const int*)(F.ws + WS_MOETAB))[F.tid];
    __syncthreads(); return tb; }
PHASE_FN void ph_moe_up(LAS unsigned char* lds, int wave, int l) { Frame F; make_frame(F, lds, wave); LAS int* tb = moe_table(F);
    pg8::Gemm g{(const bf16*)(F.ws + WS_H8), (const bf16*)(F.ws + WS_W1 + (size_t)l * NEXP * 2048 * DM), (const int*)(F.ws + WS_SLOTTOK), DM / 2};
    pg8::MoeOrder S; S.init(tb, 8, F.G, F.blk);
    pg8::EpiSwiglu8 E{F.ws + WS_ACT, F.in[I_B1] + (size_t)l * NEXP * 2048};
    pg8::gemm_phase<pg8::EpiSwiglu8, pg8::MoeOrder, true, true>(F.lds, g, S, E, F.wave); }
struct EpiNull { static constexpr bool PERM = true;
    __device__ __forceinline__ void init(f32x4 (&acc)[2][2][4][2], const pg8::Unit&, int, int, int, int) const {
#pragma unroll
        for (int a = 0; a < 2; ++a)
#pragma unroll
            for (int b = 0; b < 2; ++b)
#pragma unroll
                for (int m = 0; m < 4; ++m)
#pragma unroll
                    for (int n = 0; n < 2; ++n) acc[a][b][m][n] = (f32x4){0.f, 0.f, 0.f, 0.f}; }
    __device__ __forceinline__ void operator()(const f32x4 (&acc)[2][2][4][2], const pg8::Unit& u, int wr, int wc, int fr, int fq) const { float s = 0.f;
#pragma unroll
    for (int a = 0; a < 2; ++a)
#pragma unroll
        for (int b = 0; b < 2; ++b)
#pragma unroll
            for (int m = 0; m < 4; ++m)
#pragma unroll
                for (int n = 0; n < 2; ++n) s += acc[a][b][m][n][0] + acc[a][b][m][n][1] + acc[a][b][m][n][2] + acc[a][b][m][n][3];
    asm volatile("" :: "v"(s)); } };
PHASE_FN void ph_moe_down_nostore(LAS unsigned char* lds, int wave, int l) { Frame F; make_frame(F, lds, wave); LAS int* tb = moe_table(F);
    pg8::Gemm g{(const bf16*)(F.ws + WS_ACT), (const bf16*)(F.ws + WS_W2 + (size_t)l * NEXP * DM * DM), nullptr, DM / 2};
    pg8::MoeOrder S; S.init(tb, 4, F.G, F.blk);
#if EXP_NOSTORE == 2
    pg8::EpiY E{F.ws + WS_PROJ, nullptr};
    pg8::gemm_phase<pg8::EpiY, pg8::MoeOrder, false, true>(F.lds, g, S, E, F.wave); }
#else
    EpiNull E;
    pg8::gemm_phase<EpiNull, pg8::MoeOrder, false, true>(F.lds, g, S, E, F.wave); }
#endif
PHASE_FN void ph_moe_down(LAS unsigned char* lds, int wave, int l) { Frame F; make_frame(F, lds, wave); LAS int* tb = moe_table(F);
    pg8::Gemm g{(const bf16*)(F.ws + WS_ACT), (const bf16*)(F.ws + WS_W2 + (size_t)l * NEXP * DM * DM), nullptr, DM / 2, (void*)(F.ws + WS_CTL + 512)};
    pg8::MoeOrder S; S.init(tb, 4, F.G, F.blk);
    pg8::EpiY E{F.ws + WS_Y, F.in[I_B2] + (size_t)l * NEXP * DM};
    pg8::gemm_phase<pg8::EpiY, pg8::MoeOrder, false, true>(F.lds, g, S, E, F.wave); }
PHASE_FN void ph_final(LAS unsigned char* lds, int wave) { Frame F; make_frame(F, lds, wave); row_phase<true, false, true, false>(F, NLAYER, F.ws + WS_XA, F.out); }

#ifndef REP_MASK
#define REP_MASK 0
#endif
#ifndef MK_SPLIT
#define MK_SPLIT 0
#endif
#if !MK_SPLIT
__global__ void __launch_bounds__(512, 2) fwd_kernel(Args args) {
    extern __shared__ __attribute__((aligned(16))) unsigned char lds_raw[];
    LAS unsigned char* lds = (LAS unsigned char*)lds_raw;
    volatile LAS unsigned* MISC = (volatile LAS unsigned*)(lds + MISC_OFF);
    if (threadIdx.x < 16) MISC[threadIdx.x] = 0u;
    const int wave = __builtin_amdgcn_readfirstlane(threadIdx.x >> 6);
    __syncthreads();
    const XcdBarrier bar = xcd_barrier_post((unsigned*)(args.ws + WS_CTL) + CW_BAR, MISC, wave);
#define IN(k) true
#define SEAM(k) xcd_barrier(bar)
#define REPS(j) for (int rep_ = 0; rep_ < (((REP_MASK >> (j)) & 1) ? 2 : 1); ++rep_)
#ifdef PT_SEL
    unsigned long long pt_acc = 0ull, pt_t0 = 0ull;
#define PT_BEGIN(j) do { if ((j) == PT_SEL) pt_t0 = __builtin_amdgcn_s_memrealtime(); } while (0)
#define PT_END(j) do { if ((j) == PT_SEL) { const unsigned long long t1_ = __builtin_amdgcn_s_memrealtime(); pt_acc += t1_ - pt_t0; } } while (0)
#else
#define PT_BEGIN(j) do {} while (0)
#define PT_END(j) do {} while (0)
#endif
    if (IN(0)) { REPS(0) { PT_BEGIN(0); ph_prologue(lds, wave); SEAM(0); PT_END(0); } }
    for (int l = 0; l < NLAYER; ++l) {
        const int p = 1 + 9 * l;
        if (IN(p + 0)) { REPS(1) { PT_BEGIN(1); ph_norm1(lds, wave, l); SEAM(p + 0); PT_END(1); } }
        if (IN(p + 1)) { REPS(2) { PT_BEGIN(2); ph_proj(lds, wave, l); SEAM(p + 1); PT_END(2); } }
        if (IN(p + 2)) { PT_BEGIN(3); ph_postproj(lds, wave, l); SEAM(p + 2); PT_END(3); }
        if (IN(p + 3)) { REPS(4) { PT_BEGIN(4); ph_attn(lds, wave, l); SEAM(p + 3); PT_END(4); } }
        if (IN(p + 4)) { REPS(5) { PT_BEGIN(5); ph_out(lds, wave, l); SEAM(p + 4); PT_END(5); } }
        if (IN(p + 5)) { REPS(6) { PT_BEGIN(6); ph_router(lds, wave, l); SEAM(p + 5); PT_END(6); } }
        if (IN(p + 6)) { REPS(7) { PT_BEGIN(7); ph_scatter(lds, wave); SEAM(p + 6); PT_END(7); } }
        if (IN(p + 7)) { REPS(8) { PT_BEGIN(8); ph_moe_up(lds, wave, l); SEAM(p + 7); PT_END(8); } }
        if (IN(p + 8)) { REPS(9) { PT_BEGIN(9); ph_moe_down(lds, wave, l); SEAM(p + 8); PT_END(9); } }
    }
    if (IN(N_PHASES - 1)) { REPS(10) { PT_BEGIN(10); ph_final(lds, wave); PT_END(10); } }
#ifdef PT_SEL
    if (blockIdx.x == 0 && wave == 0 && lane_id() == 0) { const unsigned long long t0_ = __builtin_amdgcn_s_memrealtime(); while (__builtin_amdgcn_s_memrealtime() - t0_ < pt_acc * PT_K) __builtin_amdgcn_s_sleep(8); }
#endif
#ifdef P6SEG
    if (blockIdx.x == 0 && wave == 0 && lane_id() == 0) { __builtin_amdgcn_s_waitcnt(0);
        const unsigned long long acc = __hip_atomic_load((unsigned long long*)(args.ws + WS_CTL + 512), __ATOMIC_RELAXED, __HIP_MEMORY_SCOPE_AGENT) * 4ull;
        const unsigned long long t0 = __builtin_readcyclecounter(); while (__builtin_readcyclecounter() - t0 < acc) __builtin_amdgcn_s_sleep(4); }
#endif
#ifdef TPG
    if (blockIdx.x == 3 && wave == 0 && lane_id() == 0) { __builtin_amdgcn_s_waitcnt(0);
        const unsigned long long acc = __hip_atomic_load((unsigned long long*)(args.ws + WS_CTL + 512), __ATOMIC_RELAXED, __HIP_MEMORY_SCOPE_AGENT) * ((TPG == 1) ? 1ull : 100000ull);
        const unsigned long long t0 = __builtin_readcyclecounter(); while (__builtin_readcyclecounter() - t0 < acc) __builtin_amdgcn_s_sleep(4); }
#endif
#ifdef TPROBE
    if (blockIdx.x == TPROBE_BLK && wave == 0 && lane_id() == 0) {
        __builtin_amdgcn_s_waitcnt(0);
        const unsigned long long acc = __hip_atomic_load((unsigned long long*)(args.ws + WS_CTL + 512), __ATOMIC_RELAXED, __HIP_MEMORY_SCOPE_AGENT) * TPROBE_K;
        const unsigned long long t0 = __builtin_readcyclecounter();
        while (__builtin_readcyclecounter() - t0 < acc) __builtin_amdgcn_s_sleep(4);
    }
#endif
#if defined(UBENCH) && UBENCH >= 4
    {
        f32x4 c[16]; v8i a8, b8; bf16x8 a4, b4;
#pragma unroll
        for (int i = 0; i < 16; ++i) c[i] = (f32x4){0.f, 0.f, 0.f, 0.f};
#pragma unroll
        for (int i = 0; i < 8; ++i) { a8[i] = 0x38383838; b8[i] = 0x38383838; a4[i] = 0x3c00; b4[i] = 0x3c00; }
        const int sw = 0x7F7F7F7F;
        for (int it = 0; it < UBENCH_ITERS; ++it) {
#pragma unroll
            for (int i = 0; i < 16; ++i) {
#if UBENCH == 4
                asm volatile("v_mfma_scale_f32_16x16x128_f8f6f4 %0, %1, %2, %0, %3, %4 op_sel_hi:[0,0,0]" : "+v"(c[i]) : "v"(a8), "v"(b8), "v"(sw), "v"(sw));
#else
                c[i] = __builtin_amdgcn_mfma_f32_16x16x32_bf16(a4, b4, c[i], 0, 0, 0);
#endif
            }
        }
        float s = 0.f;
#pragma unroll
        for (int i = 0; i < 16; ++i) s += c[i][0];
        if (s == 123.456f) ((float*)(args.ws + WS_GSUM + 14000))[0] = s;
    }
#elif defined(UBENCH)
    {
        float v[32];
#pragma unroll
        for (int i = 0; i < 32; ++i) v[i] = (float)(lane_id() + i) * 1e-3f;
        for (int it = 0; it < UBENCH_ITERS; ++it) {
#pragma unroll
            for (int i = 0; i < 32; ++i) {
#if UBENCH == 1
                v[i] = __builtin_amdgcn_exp2f(v[i]);
#elif UBENCH == 2
                v[i] = v[i] * 1.0001f + 0.5f;
#elif UBENCH == 3
                v[i] = __builtin_amdgcn_logf(v[i]);
#endif
            }
            asm volatile("" ::: "memory");
        }
        float s = 0.f;
#pragma unroll
        for (int i = 0; i < 32; ++i) s += v[i];
        if (s == 123.456f) ((float*)(args.ws + WS_GSUM + 14000))[0] = s;
    }
#endif
#undef IN
#undef SEAM
#undef REPS
}

#endif
template <int KIND> __global__ void __launch_bounds__(512, 2) phase_kernel(Args args, int l) {
    extern __shared__ __attribute__((aligned(16))) unsigned char lds_raw[];
    LAS unsigned char* lds = (LAS unsigned char*)lds_raw; const int wave = __builtin_amdgcn_readfirstlane(threadIdx.x >> 6);
    if (KIND == 0) ph_prologue(lds, wave); if (KIND == 1) ph_norm1(lds, wave, l); if (KIND == 2) ph_proj(lds, wave, l); if (KIND == 3) ph_postproj(lds, wave, l); if (KIND == 4) ph_attn(lds, wave, l);
    if (KIND == 5) ph_out(lds, wave, l); if (KIND == 6) ph_router(lds, wave, l); if (KIND == 7) ph_scatter(lds, wave); if (KIND == 8) ph_moe_up(lds, wave, l); if (KIND == 9) ph_moe_down(lds, wave, l); if (KIND == 10) ph_final(lds, wave);
#ifdef EXP_NOSTORE
    if (KIND == 11) ph_moe_down_nostore(lds, wave, l);
#endif
}
template <int KIND> static void launch_phase(const Args& a, int l, int grid, hipStream_t stream) {
    static bool attr = false;
    if (!attr) { (void)hipFuncSetAttribute((const void*)phase_kernel<KIND>, hipFuncAttributeMaxDynamicSharedMemorySize, LDS_BYTES); attr = true; }
    for (int rep = 0; rep < (((REP_MASK >> KIND) & 1) ? 2 : 1); ++rep) hipLaunchKernelGGL(phase_kernel<KIND>, dim3(grid), dim3(512), LDS_BYTES, stream, a, l);
}

extern "C" void kernel_launch(void* const* d_in, const int* in_sizes, int n_in, void* d_out, int out_size, void* d_ws, size_t ws_size, hipStream_t stream) {
    static int grid = 0;
    if (grid == 0) {
        if (n_in != 21 || in_sizes[0] != NTOK * DM || out_size != NTOK * DM || ws_size < WS_END) {
            fprintf(stderr, "kernel_launch: unexpected shapes: n_in %d in0 %d out %d ws %zu (need %zu)\n", n_in, n_in > 0 ? in_sizes[0] : -1, out_size, ws_size, (size_t)WS_END); grid = -1; return; }
        int dev = 0, cus = 0, per_cu = 0;
        if (hipGetDevice(&dev) != hipSuccess || hipDeviceGetAttribute(&cus, hipDeviceAttributeMultiprocessorCount, dev) != hipSuccess) { fprintf(stderr, "kernel_launch: device query failed\n"); grid = -1; return; }
#if !MK_SPLIT
        if (hipFuncSetAttribute((const void*)fwd_kernel, hipFuncAttributeMaxDynamicSharedMemorySize, LDS_BYTES) != hipSuccess) { fprintf(stderr, "kernel_launch: hipFuncSetAttribute failed\n"); grid = -1; return; }
        if (hipOccupancyMaxActiveBlocksPerMultiprocessor(&per_cu, (const void*)fwd_kernel, 512, LDS_BYTES) != hipSuccess || per_cu < 1) fprintf(stderr, "kernel_launch: note: occupancy query says %d\n", per_cu);
        (void)hipGetLastError();
#endif
        grid = cus;
    }
    if (grid < 0) return;
    (void)hipMemsetAsync((char*)d_ws + WS_CTL, 0, CTL_ZERO_BYTES, stream);
    Args a{};
    for (int i = 0; i < 21; ++i) a.in[i] = (const float*)d_in[i];
    a.out = (float*)d_out; a.ws = (unsigned char*)d_ws;
#if MK_SPLIT
    a.ph_lo = 0; a.ph_hi = 0;
    launch_phase<0>(a, 0, grid, stream);
    for (int l = 0; l < NLAYER; ++l) { launch_phase<1>(a, l, grid, stream); launch_phase<2>(a, l, grid, stream); launch_phase<3>(a, l, grid, stream); launch_phase<4>(a, l, grid, stream); launch_phase<5>(a, l, grid, stream);
        launch_phase<6>(a, l, grid, stream); launch_phase<7>(a, l, grid, stream); launch_phase<8>(a, l, grid, stream);
#ifdef EXP_NOSTORE
        launch_phase<11>(a, l, grid, stream);
#endif
        launch_phase<9>(a, l, grid, stream); }
    launch_phase<10>(a, 0, grid, stream);
#else
    a.ph_lo = 0; a.ph_hi = N_PHASES; hipLaunchKernelGGL(fwd_kernel, dim3(grid), dim3(512), LDS_BYTES, stream, a);
#endif
}
```

```cpp
#include <hip/hip_runtime.h>
#ifndef P5_FP8
#define P5_FP8 0
#endif
#include <cstdio>
#include <cstdint>

#define GAS __attribute__((address_space(1)))
#define LAS __attribute__((address_space(3)))
typedef unsigned short bf16;
typedef unsigned v4u __attribute__((ext_vector_type(4)));
typedef unsigned v2u __attribute__((ext_vector_type(2)));
typedef float f32x4 __attribute__((ext_vector_type(4)));
typedef float f32x2 __attribute__((ext_vector_type(2)));
typedef float f32x16 __attribute__((ext_vector_type(16)));
typedef short bf16x8 __attribute__((ext_vector_type(8)));
typedef _Float16 f16x8 __attribute__((ext_vector_type(8)));
typedef _Float16 f16x2 __attribute__((ext_vector_type(2)));
typedef int v4i __attribute__((ext_vector_type(4)));
typedef int v8i __attribute__((ext_vector_type(8)));

namespace pg8 {
constexpr int BM = 256, BK = 64, HALF = 128, HTB = HALF * BK * 2  , STAGE_BYTES = 8 * HTB, NXCD = 8, WGM = 4;

__host__ __device__ __forceinline__ int lds_byte(int r, int c) { const int st = (r >> 4) * 2 + (c >> 5), rr = r & 15, cc = c & 31, ob = rr * 64 + cc * 2; return st * 1024 + (ob ^ (((ob >> 9) & 1) << 5)); }
__host__ __device__ __forceinline__ void stage_rc(int b, int& R, int& C) { const int st = b / 1024, sb = b % 1024, swz = sb ^ (((sb >> 9) & 1) << 5); R = (st >> 1) * 16 + swz / 64; C = (st & 1) * 32 + (swz % 64) / 2; }
__host__ __device__ __forceinline__ int perm32(int rho) { const int n = rho >> 4, i = rho & 15; return 8 * (i >> 2) + 4 * n + (i & 3); }

struct Unit { int pm, pn, pb; };
struct Gemm { const bf16* A; const bf16* Bt; const int* rowmap; int K; void* tprobe = nullptr; };

__device__ __forceinline__ unsigned cvt_pk_bf16(float lo, float hi) { unsigned r; asm volatile("v_cvt_pk_bf16_f32 %0, %1, %2" : "=v"(r) : "v"(lo), "v"(hi)); return r; }

template <class Epi, class Sched, bool GATHER, bool FP8 = false>
__device__ __forceinline__ void gemm_phase(LAS unsigned char* lds, const Gemm g, const Sched& S, const Epi& E, int wave) {
    int lane_; asm volatile("v_mbcnt_lo_u32_b32 %0, -1, 0\n\tv_mbcnt_hi_u32_b32 %0, -1, %0" : "=v"(lane_));
    const int wid = wave, lane = lane_, tid = wid * 64 + lane, wr = wid >> 2, wc = wid & 3, fr = lane & 15, fq = lane >> 4;
    const int K = g.K, nt = K / BK;
    unsigned voffA[2], voffB[2]; int RA[2], CA[2];
#pragma unroll
    for (int i = 0; i < 2; ++i) { int R, C; stage_rc(tid * 16 + i * 8192, R, C); const int Rb = Epi::PERM ? ((R & ~31) + perm32(R & 31)) : R; RA[i] = R; CA[i] = C;
        voffA[i] = (unsigned)(R * K + C) * 2u; voffB[i] = (unsigned)(Rb * K + C) * 2u; }
    const size_t kstep = (size_t)(BK * 2);
    const size_t hstep = (size_t)HALF * K * 2;
    const size_t tstep = 2 * hstep;
    const unsigned ldsw = (unsigned)wid * 1024u;
    const int aoff = lds_byte(wr * 64 + fr, fq * 8), boff = lds_byte(wc * 32 + fr, fq * 8);
#define PG8_SA(b, h) (((b) * 2 + (h)) * HTB)
#define PG8_SB(b, h) ((4 + (b) * 2 + (h)) * HTB)
#define PG8_STAGE(bufoff, gbase, voff) do { _Pragma("unroll") for (int _i = 0; _i < 2; ++_i) \
        __builtin_amdgcn_global_load_lds((const unsigned*)((const char*)(gbase) + (voff)[_i]), (LAS unsigned*)(lds + (bufoff) + ldsw + _i * 8192), 16, 0, 0); } while (0)
#define PG8_STAGEA(bufoff, pbase, h, nx) do { if constexpr (GATHER) { _Pragma("unroll") for (int _i = 0; _i < 2; ++_i) \
        __builtin_amdgcn_global_load_lds((const unsigned*)((const char*)(pbase) + ((nx) ? gn[h][_i] : gc[h][_i])), (LAS unsigned*)(lds + (bufoff) + ldsw + _i * 8192), 16, 0, 0); } \
        else { PG8_STAGE(bufoff, (const char*)(pbase) + (h) * hstep, voffA); } } while (0)
#define PG8_LDA(dst, b, h) do { if constexpr (FP8) { _Pragma("unroll") for (int m = 0; m < 4; ++m) dst##8[m] = __builtin_shufflevector(*(const LAS v4i*)(lds + PG8_SA(b, h) + aoff + m * 2048), *(const LAS v4i*)(lds + PG8_SA(b, h) + aoff + m * 2048 + 1024), 0, 1, 2, 3, 4, 5, 6, 7); } \
        else { _Pragma("unroll") for (int m = 0; m < 4; ++m) _Pragma("unroll") for (int k = 0; k < 2; ++k) dst[m][k] = *(const LAS bf16x8*)(lds + PG8_SA(b, h) + aoff + m * 2048 + k * 1024); } } while (0)
#define PG8_LDB(dst, b, h) do { if constexpr (FP8) { _Pragma("unroll") for (int n = 0; n < 2; ++n) dst##8[n] = __builtin_shufflevector(*(const LAS v4i*)(lds + PG8_SB(b, h) + boff + n * 2048), *(const LAS v4i*)(lds + PG8_SB(b, h) + boff + n * 2048 + 1024), 0, 1, 2, 3, 4, 5, 6, 7); } \
        else { _Pragma("unroll") for (int n = 0; n < 2; ++n) _Pragma("unroll") for (int k = 0; k < 2; ++k) dst[n][k] = *(const LAS bf16x8*)(lds + PG8_SB(b, h) + boff + n * 2048 + k * 1024); } } while (0)
#define PG8_MMA(ai, bj, At, Bt) do { __builtin_amdgcn_s_setprio(1); if constexpr (FP8) { _Pragma("unroll") for (int m = 0; m < 4; ++m) _Pragma("unroll") for (int n = 0; n < 2; ++n) \
        asm volatile("v_mfma_scale_f32_16x16x128_f8f6f4 %0, %1, %2, %0, %3, %4 op_sel_hi:[0,0,0]" : "+v"(acc[ai][bj][m][n]) : "v"(Bt##8[n]), "v"(At##8[m]), "v"(sclw), "v"(scla)); } \
        else { _Pragma("unroll") for (int m = 0; m < 4; ++m) _Pragma("unroll") for (int n = 0; n < 2; ++n) _Pragma("unroll") for (int k = 0; k < 2; ++k) \
        acc[ai][bj][m][n] = __builtin_amdgcn_mfma_f32_16x16x32_bf16(Bt[n][k], At[m][k], acc[ai][bj][m][n], 0, 0, 0); } __builtin_amdgcn_s_setprio(0); } while (0)
#define PG8_WAIT_V(n) asm volatile("s_waitcnt vmcnt(" #n ")" ::: "memory")
#define PG8_WAIT_VN(n) asm volatile("s_waitcnt vmcnt(%0)" :: "n"(n) : "memory")
#define PG8_WAIT_RLX(flag, nrel) asm volatile("s_waitcnt vmcnt(%1)\n\ts_cmp_lg_u32 %0, 0\n\ts_cbranch_scc1 .Lrlx%=\n\ts_waitcnt vmcnt(8)\n.Lrlx%=:" :: "s"(flag), "n"(nrel) : "memory", "scc")
#define PG8_WAIT_L(n) asm volatile("s_waitcnt lgkmcnt(" #n ")" ::: "memory")
#define PG8_BAR __builtin_amdgcn_s_barrier()
#define PG8_SCHED __builtin_amdgcn_sched_barrier(0)
    Unit cur, nxt; int ui = 0;
    if (!S.next(0, cur)) return;
#ifdef GEMM_STAGGER
    {
        const unsigned long long t0 = __builtin_amdgcn_s_memrealtime(); const unsigned long long d = (unsigned long long)((blockIdx.x >> 3) & 3) * GEMM_STAGGER;
        while (__builtin_amdgcn_s_memrealtime() - t0 < d) __builtin_amdgcn_s_sleep(16);
    }
#endif
    f32x4 acc[2][2][4][2];
    E.init(acc, cur, wr, wc, fr, fq);
    bf16x8 At[4][2], B0[2][2], B1[2][2]; v8i At8[4], B08[2], B18[2];
    const int sclw = 0x7A7A7A7A, scla = 0x7F7F7F7F;
    unsigned gc[2][2], gn[2][2];
    if constexpr (GATHER) {
#pragma unroll
        for (int h = 0; h < 2; ++h)
#pragma unroll
            for (int i = 0; i < 2; ++i) { gc[h][i] = (unsigned)(g.rowmap[cur.pm * BM + h * HALF + RA[i]] * K + CA[i]) * 2u; gn[h][i] = gc[h][i]; }
    } else { gc[0][0] = gc[0][1] = gc[1][0] = gc[1][1] = 0u; gn[0][0] = gn[0][1] = gn[1][0] = gn[1][1] = 0u; }
    const char* cA = GATHER ? (const char*)g.A : (const char*)g.A + (size_t)cur.pm * tstep; const char* cB = (const char*)g.Bt + (size_t)cur.pb * tstep;
    PG8_STAGE(PG8_SB(0, 0), cB, voffB); PG8_STAGE(PG8_SB(0, 1), cB + hstep, voffB); PG8_STAGEA(PG8_SA(0, 0), cA, 0, false); PG8_STAGEA(PG8_SA(0, 1), cA, 1, false);
    if (wr == 1) PG8_BAR;
    PG8_WAIT_V(2); PG8_BAR;
    PG8_STAGE(PG8_SB(1, 0), cB + kstep, voffB); PG8_STAGEA(PG8_SA(1, 0), cA + kstep, 0, false); PG8_STAGE(PG8_SB(1, 1), cB + hstep + kstep, voffB);
    PG8_WAIT_V(6); PG8_BAR;
    for (;;) {
        const bool has_next = S.next(ui + 1, nxt);
        if constexpr (GATHER) { if (has_next) {
#pragma unroll
            for (int h = 0; h < 2; ++h)
#pragma unroll
                for (int i = 0; i < 2; ++i) gn[h][i] = (unsigned)(g.rowmap[nxt.pm * BM + h * HALF + RA[i]] * K + CA[i]) * 2u; } }
        const char* nA = GATHER ? cA : (has_next ? (const char*)g.A + (size_t)nxt.pm * tstep : cA); const char* nB = has_next ? (const char*)g.Bt + (size_t)nxt.pb * tstep : cB;
#ifdef TPG
        const unsigned long long tg0 = __builtin_readcyclecounter();
#endif
#define PG8_ITER(t_, WV_) do {             const bool last = (t_ == nt - 2), relax = (t_ == 0) && (ui > 0); const int rlx = __builtin_amdgcn_readfirstlane(relax ? 1 : 0); \
            const char* a1 = cA + (size_t)(t_ + 1) * kstep; \
            const char* a2 = last ? nA : cA + (size_t)(t_ + 2) * kstep; const char* b2 = last ? nB : cB + (size_t)(t_ + 2) * kstep; \
            const char* a3 = a2 + kstep; const char* b3 = b2 + kstep; \
            PG8_LDB(B0, 0, 0); PG8_LDB(B1, 0, 1); PG8_SCHED; PG8_LDA(At, 0, 0); PG8_STAGEA(PG8_SA(1, 1), a1, 1, false); \
            PG8_WAIT_RLX(rlx, 8 + Epi::NST); PG8_WAIT_L(0); PG8_BAR; PG8_MMA(0, 0, At, B0); PG8_MMA(0, 1, At, B1); PG8_BAR; PG8_SCHED; \
            PG8_LDA(At, 0, 1); PG8_STAGE(PG8_SB(0, 0), b2, voffB); PG8_STAGE(PG8_SB(0, 1), b2 + hstep, voffB); PG8_STAGEA(PG8_SA(0, 0), a2, 0, last); \
            PG8_WAIT_RLX(rlx, 8 + Epi::NST); PG8_WAIT_L(0); PG8_BAR; PG8_MMA(1, 0, At, B0); PG8_MMA(1, 1, At, B1); PG8_BAR; PG8_SCHED; \
            PG8_LDB(B0, 1, 0); PG8_LDB(B1, 1, 1); PG8_SCHED; PG8_LDA(At, 1, 0); PG8_STAGEA(PG8_SA(0, 1), a2, 1, last); \
            PG8_WAIT_RLX(rlx, 8 + Epi::NST); PG8_WAIT_L(0); PG8_BAR; PG8_MMA(0, 0, At, B0); PG8_MMA(0, 1, At, B1); PG8_BAR; PG8_SCHED; \
            PG8_LDA(At, 1, 1); PG8_STAGE(PG8_SB(1, 0), b3, voffB); PG8_STAGE(PG8_SB(1, 1), b3 + hstep, voffB); PG8_STAGEA(PG8_SA(1, 0), a3, 0, last); \
            PG8_WAIT_V(8); PG8_WAIT_L(0); PG8_BAR; PG8_MMA(1, 0, At, B0); PG8_MMA(1, 1, At, B1); PG8_BAR; PG8_SCHED; } while (0)
        for (int t = 0; t < nt; t += 2) PG8_ITER(t, 8);
#undef PG8_ITER
#ifdef TPG
        { const unsigned long long tg1 = __builtin_readcyclecounter(); asm volatile("" :: "s"(tg0), "s"(tg1));
          if (FP8 && !GATHER && blockIdx.x == 3 && tid == 0) atomicAdd((unsigned long long*)g.tprobe, (TPG == 1) ? (tg1 - tg0) : 1ull); }
#endif
        if (wr == 0) PG8_BAR;
        if constexpr (FP8) asm volatile("s_nop 15\n\ts_nop 7" ::: "memory");
        E(acc, cur, wr, wc, fr, fq);
        if (!has_next) break;
        E.init(acc, nxt, wr, wc, fr, fq);
        cur = nxt; cA = nA; cB = nB; ++ui;
        if constexpr (GATHER) {
#pragma unroll
            for (int h = 0; h < 2; ++h)
#pragma unroll
                for (int i = 0; i < 2; ++i) gc[h][i] = gn[h][i]; }
        if (wr == 1) PG8_BAR;
    }
    PG8_WAIT_V(0);
    PG8_BAR;
#undef PG8_SA
#undef PG8_SB
#undef PG8_STAGE
#undef PG8_STAGEA
#undef PG8_LDA
#undef PG8_LDB
#undef PG8_MMA
#undef PG8_WAIT_V
#undef PG8_WAIT_VN
#undef PG8_WAIT_RLX
#undef PG8_WAIT_L
#undef PG8_BAR
#undef PG8_SCHED
}
}
constexpr int DM = 1024, NB = 8, SEQ = 4096, NTOK = NB * SEQ, NLAYER = 2;
constexpr int NPROJ = 3072;
constexpr int D_IN = 3078;
constexpr int NEXP = 32, TOPK = 4;
constexpr int NSLOT_MAX = NTOK * TOPK + NEXP * 256;
constexpr int NTILE_MAX = NSLOT_MAX / 256;
constexpr int COL_CB = 0, COL_CC = 256, COL_CU = 512, COL_SQ = 768, COL_SK = 1152, COL_SV = 1536, COL_FQ = 1920, COL_FK = 2304, COL_FV = 2688;
constexpr float EPS = 1e-6f;
constexpr float LOG2E = 1.4426950408889634f;
constexpr float QSCALE = 0.125f * LOG2E;

namespace pg8 {
struct StaticOrder {
    int nM, nN, nwg, G, c;
    __device__ __forceinline__ void init(int M, int N, int G_, int c_) { nM = M / BM; nN = N / BM; nwg = nM * nN; G = G_; c = c_; }
    __device__ __forceinline__ bool next(int i, Unit& u) const {
        const long L = (long)i * G + c; if (L >= nwg) return false;
        int wgid = (int)L; { const int q = nwg / NXCD, r = nwg % NXCD, xcd = wgid % NXCD, off = wgid / NXCD; wgid = (xcd < r ? xcd * (q + 1) : r * (q + 1) + (xcd - r) * q) + off; }
        const int nig = WGM * nN, gid = wgid / nig, fm = gid * WGM, gsz = (nM - fm) < WGM ? (nM - fm) : WGM;
        u.pm = fm + ((wgid % nig) % gsz); u.pn = (wgid % nig) / gsz; u.pb = u.pn; return true;
    }
};
struct MoeOrder {
    int nM, nN, nwg, G, c; const LAS int* tb;
    __device__ __forceinline__ void init(const LAS int* tb_, int nN_, int G_, int c_) { tb = tb_; nM = tb_[NEXP]; nN = nN_; nwg = nM * nN; G = G_; c = c_; }
    __device__ __forceinline__ bool next(int i, Unit& u) const {
        const long L = (long)i * G + c; if (L >= nwg) return false;
        int wgid = (int)L; { const int q = nwg / NXCD, r = nwg % NXCD, xcd = wgid % NXCD, off = wgid / NXCD; wgid = (xcd < r ? xcd * (q + 1) : r * (q + 1) + (xcd - r) * q) + off; }
        const int nig = WGM * nN, gid = wgid / nig, fm = gid * WGM, gsz = (nM - fm) < WGM ? (nM - fm) : WGM;
        u.pm = fm + ((wgid % nig) % gsz); u.pn = (wgid % nig) / gsz;
        int e = 0;
#pragma unroll 1
        for (int j = 1; j < NEXP; ++j) e += (tb[j] <= u.pm) ? 1 : 0;
        u.pb = e * nN + u.pn; return true;
    }
};

struct EpiProj {
    static constexpr bool PERM = true; static constexpr int NST = 16;
    bf16* O; int ldc; const float* qkg;
    __device__ __forceinline__ void init(f32x4 (&acc)[2][2][4][2], const Unit&, int, int, int, int) const {
#pragma unroll
        for (int a = 0; a < 2; ++a)
#pragma unroll
            for (int b = 0; b < 2; ++b)
#pragma unroll
                for (int m = 0; m < 4; ++m)
#pragma unroll
                    for (int n = 0; n < 2; ++n) acc[a][b][m][n] = (f32x4){0.f, 0.f, 0.f, 0.f}; }
    __device__ __forceinline__ void operator()(const f32x4 (&acc)[2][2][4][2], const Unit& u, int wr, int wc, int fr, int fq) const {
        const int row0 = u.pm * BM + wr * 64 + fr, hg = __builtin_amdgcn_readfirstlane(u.pn * 4 + wc), col0 = hg * 64 + 8 * fq;
        const int t = hg - COL_SQ / 64;
        const bool isq = (t >= 0 && t < 6) || (t >= 18 && t < 24), isk = (t >= 6 && t < 12) || (t >= 24 && t < 30);
        if (isq || isk) {
            const float* gp = qkg + 64 * ((t < 6) ? 0 : (t < 12) ? 1 : (t < 24) ? 2 : 3);
            float gg[2][8];
#pragma unroll
            for (int bj = 0; bj < 2; ++bj) { const f32x4 g0 = *(const f32x4*)(gp + 32 * bj + 8 * fq), g1 = *(const f32x4*)(gp + 32 * bj + 8 * fq + 4);
#pragma unroll
                for (int j = 0; j < 4; ++j) { gg[bj][j] = g0[j]; gg[bj][4 + j] = g1[j]; } }
#pragma unroll
            for (int ai = 0; ai < 2; ++ai)
#pragma unroll
                for (int m = 0; m < 4; ++m) {
                    float ss = 0.f;
#pragma unroll
                    for (int bj = 0; bj < 2; ++bj)
#pragma unroll
                        for (int n = 0; n < 2; ++n)
#pragma unroll
                            for (int j = 0; j < 4; ++j) ss += acc[ai][bj][m][n][j] * acc[ai][bj][m][n][j];
                    ss += __builtin_bit_cast(float, __builtin_amdgcn_ds_swizzle(__builtin_bit_cast(int, ss), 0x401F));
                    { auto rr = __builtin_amdgcn_permlane32_swap(__float_as_uint(ss), __float_as_uint(ss), false, false); ss = __uint_as_float(rr[0]) + __uint_as_float(rr[1]); }
                    const float ri = 1.0f / sqrtf(ss * (1.0f / 64.0f) + EPS);
                    bf16* rowp = O + (size_t)(row0 + ai * HALF + m * 16) * ldc + col0;
#pragma unroll
                    for (int bj = 0; bj < 2; ++bj) { const f32x4 v0 = acc[ai][bj][m][0], v1 = acc[ai][bj][m][1];
                        v4u w; w.x = cvt_pk_bf16(v0[0] * ri * gg[bj][0], v0[1] * ri * gg[bj][1]); w.y = cvt_pk_bf16(v0[2] * ri * gg[bj][2], v0[3] * ri * gg[bj][3]);
                        w.z = cvt_pk_bf16(v1[0] * ri * gg[bj][4], v1[1] * ri * gg[bj][5]); w.w = cvt_pk_bf16(v1[2] * ri * gg[bj][6], v1[3] * ri * gg[bj][7]);
                        *(v4u*)(rowp + bj * 32) = w; }
                    __builtin_amdgcn_sched_barrier(0); }
        } else {
#pragma unroll
            for (int ai = 0; ai < 2; ++ai)
#pragma unroll
                for (int m = 0; m < 4; ++m) { bf16* rowp = O + (size_t)(row0 + ai * HALF + m * 16) * ldc + col0;
#pragma unroll
                    for (int bj = 0; bj < 2; ++bj) { const f32x4 v0 = acc[ai][bj][m][0], v1 = acc[ai][bj][m][1];
                        v4u w; w.x = cvt_pk_bf16(v0[0], v0[1]); w.y = cvt_pk_bf16(v0[2], v0[3]); w.z = cvt_pk_bf16(v1[0], v1[1]); w.w = cvt_pk_bf16(v1[2], v1[3]);
                        *(v4u*)(rowp + bj * 32) = w; } }
        }
    }
};
template <bool BASE16> struct EpiResGate {
    static constexpr bool PERM = true; static constexpr int NST = 4;
    const void* base; bf16* out; const float* gate;
    __device__ __forceinline__ void init(f32x4 (&acc)[2][2][4][2], const Unit&, int, int, int, int) const {
#pragma unroll
        for (int a = 0; a < 2; ++a)
#pragma unroll
            for (int b = 0; b < 2; ++b)
#pragma unroll
                for (int m = 0; m < 4; ++m)
#pragma unroll
                    for (int n = 0; n < 2; ++n) acc[a][b][m][n] = (f32x4){0.f, 0.f, 0.f, 0.f}; }
    __device__ __forceinline__ void operator()(const f32x4 (&acc)[2][2][4][2], const Unit& u, int wr, int wc, int fr, int fq) const {
        const int row0 = u.pm * BM + wr * 64 + fr, col0 = u.pn * BM + wc * 32 + 8 * fq; const int b = (u.pm * BM) / SEQ;
#pragma unroll
        for (int bj = 0; bj < 2; ++bj) { const int c = col0 + bj * HALF; const f32x4 g0 = *(const f32x4*)(gate + (size_t)b * 6144 + c), g1 = *(const f32x4*)(gate + (size_t)b * 6144 + c + 4);
            constexpr int NA = BASE16 ? 2 : 1;
#pragma unroll
            for (int a0 = 0; a0 < 2; a0 += NA) {
                v4u t16[2][4]; f32x4 t32[4][2];
#pragma unroll
                for (int ai = a0; ai < a0 + NA; ++ai)
#pragma unroll
                    for (int m = 0; m < 4; ++m) { const size_t off = (size_t)(row0 + ai * HALF + m * 16) * DM + c;
                        if (BASE16) t16[ai][m] = *(const v4u*)((const bf16*)base + off);
                        else { t32[m][0] = __builtin_nontemporal_load((const f32x4*)((const float*)base + off)); t32[m][1] = __builtin_nontemporal_load((const f32x4*)((const float*)base + off + 4)); } }
                __builtin_amdgcn_sched_barrier(0);
#pragma unroll
                for (int ai = a0; ai < a0 + NA; ++ai)
#pragma unroll
                    for (int m = 0; m < 4; ++m) { const size_t off = (size_t)(row0 + ai * HALF + m * 16) * DM + c; f32x4 b0, b1;
                        if (BASE16) { const v4u t = t16[ai][m]; b0 = (f32x4){__builtin_bit_cast(float, t.x << 16), __builtin_bit_cast(float, t.x & 0xffff0000u), __builtin_bit_cast(float, t.y << 16), __builtin_bit_cast(float, t.y & 0xffff0000u)};
                            b1 = (f32x4){__builtin_bit_cast(float, t.z << 16), __builtin_bit_cast(float, t.z & 0xffff0000u), __builtin_bit_cast(float, t.w << 16), __builtin_bit_cast(float, t.w & 0xffff0000u)}; }
                        else { b0 = t32[m][0]; b1 = t32[m][1]; }
                        const f32x4 v0 = b0 + g0 * acc[ai][bj][m][0], v1 = b1 + g1 * acc[ai][bj][m][1];
                        v4u w; w.x = cvt_pk_bf16(v0[0], v0[1]); w.y = cvt_pk_bf16(v0[2], v0[3]); w.z = cvt_pk_bf16(v1[0], v1[1]); w.w = cvt_pk_bf16(v1[2], v1[3]);
                        *(v4u*)(out + off) = w; }
                __builtin_amdgcn_sched_barrier(0); } }
    }
};
struct EpiSwiglu {
    static constexpr bool PERM = true; static constexpr int NST = 0;
    bf16* O; const float* b1;
    __device__ __forceinline__ void init(f32x4 (&acc)[2][2][4][2], const Unit&, int, int, int, int) const {
#pragma unroll
        for (int a = 0; a < 2; ++a)
#pragma unroll
            for (int b = 0; b < 2; ++b)
#pragma unroll
                for (int m = 0; m < 4; ++m)
#pragma unroll
                    for (int n = 0; n < 2; ++n) acc[a][b][m][n] = (f32x4){0.f, 0.f, 0.f, 0.f}; }
    __device__ __forceinline__ void operator()(const f32x4 (&acc)[2][2][4][2], const Unit& u, int wr, int wc, int fr, int fq) const {
        const int row0 = u.pm * BM + wr * 64 + fr; const int e = u.pb >> 3; const int j0 = u.pn * 128 + wc * 32 + 8 * fq;
        const float* bp = b1 + (size_t)e * 2048 + 2 * j0;
        f32x4 bb[4];
#pragma unroll
        for (int q = 0; q < 4; ++q) bb[q] = *(const f32x4*)(bp + 4 * q);
        float bg[8], bl[8];
#pragma unroll
        for (int q = 0; q < 4; ++q) { bg[2 * q] = bb[q][0]; bl[2 * q] = bb[q][1]; bg[2 * q + 1] = bb[q][2]; bl[2 * q + 1] = bb[q][3]; }
#pragma unroll
        for (int ai = 0; ai < 2; ++ai)
#pragma unroll
            for (int m = 0; m < 4; ++m) { bf16* rowp = O + (size_t)(row0 + ai * HALF + m * 16) * DM + j0;
                float a[8];
#pragma unroll
                for (int n = 0; n < 2; ++n)
#pragma unroll
                    for (int i = 0; i < 4; ++i) { float gl = acc[ai][0][m][n][i] + bg[4 * n + i], li = acc[ai][1][m][n][i] + bl[4 * n + i];
                        gl = fminf(gl, 7.0f); li = fminf(fmaxf(li, -7.0f), 7.0f);
                        const float sg = __builtin_amdgcn_rcpf(1.0f + __builtin_amdgcn_exp2f(-1.702f * LOG2E * gl));
                        a[4 * n + i] = gl * sg * (li + 1.0f); }
                v4u w; w.x = cvt_pk_bf16(a[0], a[1]); w.y = cvt_pk_bf16(a[2], a[3]); w.z = cvt_pk_bf16(a[4], a[5]); w.w = cvt_pk_bf16(a[6], a[7]);
                *(v4u*)rowp = w; }
    }
};
__device__ __forceinline__ float clamp448(float v) { return __builtin_amdgcn_fmed3f(v, -448.0f, 448.0f); }
__device__ __forceinline__ unsigned pk4_fp8(float a, float b, float c, float d) { unsigned r = 0; r = __builtin_amdgcn_cvt_pk_fp8_f32(clamp448(a), clamp448(b), r, false); r = __builtin_amdgcn_cvt_pk_fp8_f32(clamp448(c), clamp448(d), r, true); return r; }
__device__ __forceinline__ void store_pair16(unsigned char* rowa, unsigned char* rowb, int col0, int fq, v2u wa, v2u wb) {
    const bool odd = fq & 1; const v2u snd = odd ? wa : wb; v2u rcv;
    rcv.x = (unsigned)__builtin_amdgcn_ds_swizzle((int)snd.x, 0x401F); rcv.y = (unsigned)__builtin_amdgcn_ds_swizzle((int)snd.y, 0x401F);
    const v4u o = odd ? (v4u){rcv.x, rcv.y, wb.x, wb.y} : (v4u){wa.x, wa.y, rcv.x, rcv.y};
    *(v4u*)((odd ? rowb : rowa) + (col0 & ~15)) = o;
}
struct EpiSwiglu8 {
    static constexpr bool PERM = true; static constexpr int NST = 4;
    unsigned char* O; const float* b1;
    __device__ __forceinline__ void init(f32x4 (&acc)[2][2][4][2], const Unit& u, int, int wc, int, int fq) const {
        const int e = u.pb >> 3; const int j0 = u.pn * 128 + wc * 32 + 8 * fq; const float* bp = b1 + (size_t)e * 2048 + 2 * j0;
        f32x4 bb[4];
#pragma unroll
        for (int q = 0; q < 4; ++q) bb[q] = *(const f32x4*)(bp + 4 * q);
        const f32x4 g0 = (f32x4){bb[0][0], bb[0][2], bb[1][0], bb[1][2]}, g1 = (f32x4){bb[2][0], bb[2][2], bb[3][0], bb[3][2]};
        const f32x4 l0 = (f32x4){bb[0][1], bb[0][3], bb[1][1], bb[1][3]}, l1 = (f32x4){bb[2][1], bb[2][3], bb[3][1], bb[3][3]};
#pragma unroll
        for (int a = 0; a < 2; ++a)
#pragma unroll
            for (int m = 0; m < 4; ++m) { acc[a][0][m][0] = g0; acc[a][0][m][1] = g1; acc[a][1][m][0] = l0; acc[a][1][m][1] = l1; } }
    __device__ __forceinline__ void operator()(const f32x4 (&acc)[2][2][4][2], const Unit& u, int wr, int wc, int fr, int fq) const {
        const int row0 = u.pm * BM + wr * 64 + fr; const int j0 = u.pn * 128 + wc * 32 + 8 * fq;
#pragma unroll
        for (int ai = 0; ai < 2; ++ai)
#pragma unroll
            for (int mp = 0; mp < 4; mp += 2) { v2u w[2];
#pragma unroll
                for (int mm = 0; mm < 2; ++mm) { const int m = mp + mm; float a[8];
#pragma unroll
                    for (int n = 0; n < 2; ++n)
#pragma unroll
                        for (int i = 0; i < 4; ++i) { float gl = acc[ai][0][m][n][i], li = acc[ai][1][m][n][i];
                            gl = fminf(gl, 7.0f); li = fminf(fmaxf(li, -7.0f), 7.0f);
                            const float sg = __builtin_amdgcn_rcpf(1.0f + __builtin_amdgcn_exp2f(-1.702f * LOG2E * gl));
                            a[4 * n + i] = gl * sg * (li + 1.0f); }
                    w[mm].x = pk4_fp8(a[0], a[1], a[2], a[3]); w[mm].y = pk4_fp8(a[4], a[5], a[6], a[7]); }
                unsigned char* ra = O + (size_t)(row0 + ai * HALF + mp * 16) * DM;
                store_pair16(ra, ra + (size_t)16 * DM, j0, fq, w[0], w[1]); }
    }
};
struct EpiY {
    static constexpr bool PERM = true; static constexpr int NST = 8;
    unsigned char* O; const float* b2;
    __device__ __forceinline__ void init(f32x4 (&acc)[2][2][4][2], const Unit& u, int, int wc, int, int fq) const {
        const int e = u.pb >> 2; const int col0 = u.pn * BM + wc * 32 + 8 * fq;
#pragma unroll
        for (int bj = 0; bj < 2; ++bj)
#pragma unroll
            for (int n = 0; n < 2; ++n) { const f32x4 bv = b2 ? *(const f32x4*)(b2 + (size_t)e * DM + col0 + bj * HALF + 4 * n) : (f32x4){0.f, 0.f, 0.f, 0.f};
#pragma unroll
                for (int a = 0; a < 2; ++a)
#pragma unroll
                    for (int m = 0; m < 4; ++m) acc[a][bj][m][n] = bv; } }
    __device__ __forceinline__ void operator()(const f32x4 (&acc)[2][2][4][2], const Unit& u, int wr, int wc, int fr, int fq) const {
        const int row0 = u.pm * BM + wr * 64 + fr; const int col0 = u.pn * BM + wc * 32 + 8 * fq;
#pragma unroll
        for (int ai = 0; ai < 2; ++ai)
#pragma unroll
            for (int mp = 0; mp < 4; mp += 2) { unsigned char* ra = O + (size_t)(row0 + ai * HALF + mp * 16) * DM;
#pragma unroll
                for (int bj = 0; bj < 2; ++bj) { v2u w[2];
#pragma unroll
                    for (int mm = 0; mm < 2; ++mm) { const f32x4 v0 = acc[ai][bj][mp + mm][0], v1 = acc[ai][bj][mp + mm][1];
                        w[mm].x = pk4_fp8(v0[0], v0[1], v0[2], v0[3]); w[mm].y = pk4_fp8(v1[0], v1[1], v1[2], v1[3]); }
                    store_pair16(ra, ra + (size_t)16 * DM, col0 + bj * HALF, fq, w[0], w[1]); } }
    }
};
}
namespace att {
constexpr int KROW = 128;
constexpr int TILE_B = 64 * KROW;
constexpr int OFF_K = 0, OFF_V = 2 * TILE_B, OFF_F = 4 * TILE_B, OFF_Q = OFF_F + 512, OFF_FLAG = OFF_Q + 8 * 4608, RING1 = (OFF_FLAG + 64 + 1023) & ~1023, LDS_BYTES = RING1 + OFF_Q;
__device__ __forceinline__ int pim(int m) { const int a = m >> 3, h = (m >> 2) & 1, b = m & 3; return 16 * (a >> 1) + 8 * h + 4 * (a & 1) + b; }
typedef __bf16 bf16x2_t __attribute__((ext_vector_type(2)));
__device__ __forceinline__ unsigned pk_bf16(float lo, float hi) { const f32x2 v = {lo, hi}; const bf16x2_t b = __builtin_convertvector(v, bf16x2_t); return __builtin_bit_cast(unsigned, b); }
__device__ __forceinline__ unsigned pk_f16(float lo, float hi) { return __builtin_bit_cast(unsigned, __builtin_amdgcn_cvt_pkrtz(lo, hi)); }
__device__ __forceinline__ float half_sum(float v) { auto rr = __builtin_amdgcn_permlane32_swap(__float_as_uint(v), __float_as_uint(v), false, false); return __uint_as_float(rr[0]) + __uint_as_float(rr[1]); }
__device__ __forceinline__ float half_max(float v) { auto rr = __builtin_amdgcn_permlane32_swap(__float_as_uint(v), __float_as_uint(v), false, false); return fmaxf(__uint_as_float(rr[0]), __uint_as_float(rr[1])); }
__device__ __forceinline__ void glds16(const void* gsrc, unsigned lds_dst) { unsigned keep;
    asm volatile("s_mov_b32 %0, m0\n\ts_mov_b32 m0, %2\n\ts_nop 0\n\tglobal_load_lds_dwordx4 %1, off\n\ts_mov_b32 m0, %0" : "=&s"(keep) : "v"(gsrc), "s"(lds_dst) : "memory"); }
__device__ __forceinline__ void glds4(const void* gsrc, unsigned lds_dst) { unsigned keep;
    asm volatile("s_mov_b32 %0, m0\n\ts_mov_b32 m0, %2\n\ts_nop 0\n\tglobal_load_lds_dword %1, off\n\ts_mov_b32 m0, %0" : "=&s"(keep) : "v"(gsrc), "s"(lds_dst) : "memory"); }
#define ATT_SB() __builtin_amdgcn_sched_barrier(0)
#define ATT_MFMA(a, b, c) __builtin_amdgcn_mfma_f32_32x32x16_bf16((a), (b), (c), 0, 0, 0)
#define ATT_MFMAH(a, b, c) __builtin_amdgcn_mfma_f32_32x32x16_f16((a), (b), (c), 0, 0, 0)

typedef short v4s16 __attribute__((ext_vector_type(4)));
typedef short v8s16 __attribute__((ext_vector_type(8)));
__device__ __forceinline__ bf16x8 vfrag(const LAS unsigned char* p) {
    const v4s16 a = __builtin_amdgcn_ds_read_tr16_b64_v4i16((LAS v4s16*)p), b = __builtin_amdgcn_ds_read_tr16_b64_v4i16((LAS v4s16*)(p + 4 * KROW));
    return __builtin_bit_cast(bf16x8, __builtin_shufflevector(a, b, 0, 1, 2, 3, 4, 5, 6, 7)); }

struct Tensors {
    const bf16* proj;
    const float* fcum;
    bf16* ymix;
    const float* ong;
    int colq, colk, colv, coly;
    void* tprobe;
    float z2max;
};
struct WaveCtx { int r32, hi, qabs; int ko[4]; int vo[2]; const LAS unsigned char* qb; f16x8 mtri0, mtri1, mones; };

__device__ __forceinline__ void qk_only(f32x16& p0, f32x16& p1, const LAS unsigned char* Kb, const WaveCtx& W) {
#pragma unroll
    for (int r = 0; r < 16; ++r) { p0[r] = 0.f; p1[r] = 0.f; }
#pragma unroll
    for (int d0 = 0; d0 < 4; ++d0) { const bf16x8 ka = *(const LAS bf16x8*)(Kb + W.ko[d0]), kb2 = *(const LAS bf16x8*)(Kb + 32 * KROW + W.ko[d0]);
        const bf16x8 qv = *(const LAS bf16x8*)(W.qb + 32 * d0);
        p0 = ATT_MFMA(ka, qv, p0); p1 = ATT_MFMA(kb2, qv, p1); }
}

template <int KIND, bool DIAG>
__device__ __forceinline__ void tile(f32x16& p0, f32x16& p1, f32x16& o0, f32x16& o1, float& carry, float& lsum, const LAS unsigned char* Kn, const LAS unsigned char* Vb, const LAS float* Fb, int kt, const WaveCtx& W) {
    const int kbase = kt * 64 + 8 * W.hi;
#define ATT_KF(i) (*(const LAS bf16x8*)(Kn + ((i) & 1) * 32 * KROW + W.ko[(i) >> 1]))
#define ATT_VF(i) vfrag(Vb + W.vo[(i) & 1] + ((i) >> 1) * 16 * KROW)
#define ATT_QF(d0) (*(const LAS bf16x8*)(W.qb + 32 * (d0)))
    bf16x8 kcur = ATT_KF(0), knxt = kcur, qcur = ATT_QF(0), qnxt = qcur;
    f32x16 n0, n1;
#pragma unroll
    for (int r = 0; r < 16; ++r) { n0[r] = 0.f; n1[r] = 0.f; }
    v4u wf[4];
    if (KIND == 0) {
        v4u lf[4]; float lfirst = 0.f, pz0 = 0.f;
#pragma unroll
        for (int i = 0; i < 8; ++i) {
            if (i < 7) { knxt = ATT_KF(i + 1); if (i & 1) qnxt = ATT_QF((i + 1) >> 1); }
#pragma unroll
            for (int jj = 0; jj < 2; ++jj) { const int r = (4 * i + 2 * jj) & 15; float lg[2];
#pragma unroll
                for (int e = 0; e < 2; ++e) { const float z = (i < 4) ? p0[r + e] : p1[r + e]; float g = __builtin_amdgcn_logf(1.0f + __builtin_amdgcn_exp2f(z));
                    if (i < 4) p0[r + e] = z - g; else p1[r + e] = z - g;
                    if (DIAG) { const int key = kbase + (i < 4 ? 0 : 32) + 16 * ((r + e) >> 3) + ((r + e) & 7); g = (key < W.qabs) ? g : 0.f; }
                    lg[e] = g; }
                if (i == 0 && jj == 0) { lfirst = -lg[0]; pz0 = p0[0]; }
                lf[2 * (i >> 2) + (r >> 3)][(r & 7) >> 1] = pk_f16(-lg[0], -lg[1]);
                if (jj == 1) asm volatile("" : "+v"(kcur) : "v"(lf[2 * (i >> 2) + (r >> 3)][(r & 7) >> 1])); }
            if (i & 1) { n1 = ATT_MFMA(kcur, qcur, n1); qcur = qnxt; } else n0 = ATT_MFMA(kcur, qcur, n0);
            kcur = knxt;
            ATT_SB();
        }
        bf16x8 va = ATT_VF(0), vb = ATT_VF(1), vna = va, vnb = vb;
#pragma unroll
        for (int r = 0; r < 16; ++r) { p0[r] += carry; p1[r] += carry; }
        p0 = ATT_MFMAH(W.mtri0, __builtin_bit_cast(f16x8, lf[0]), p0); p1 = ATT_MFMAH(W.mtri0, __builtin_bit_cast(f16x8, lf[2]), p1);
        p0 = ATT_MFMAH(W.mtri1, __builtin_bit_cast(f16x8, lf[1]), p0); p1 = ATT_MFMAH(W.mtri1, __builtin_bit_cast(f16x8, lf[3]), p1);
        p0 = ATT_MFMAH(W.mones, __builtin_bit_cast(f16x8, lf[2]), p0);
        p0 = ATT_MFMAH(W.mones, __builtin_bit_cast(f16x8, lf[3]), p0);
        ATT_SB();
        const float t00 = p0[0];
#pragma unroll
        for (int c = 0; c < 4; ++c) {
            if (c < 3) { vna = ATT_VF(2 * c + 2); vnb = ATT_VF(2 * c + 3); }
#pragma unroll
            for (int j = 0; j < 4; ++j) { const int r = 8 * (c & 1) + 2 * j; float w[2];
#pragma unroll
                for (int e = 0; e < 2; ++e) { const float t = (c < 2) ? p0[r + e] : p1[r + e]; float x = __builtin_amdgcn_exp2f(t);
                    if (DIAG) { const int key = kbase + (c < 2 ? 0 : 32) + 16 * ((r + e) >> 3) + ((r + e) & 7); x = (key < W.qabs) ? x : 0.f; }
                    w[e] = x; }
                wf[c][j] = pk_bf16(w[0], w[1]); }
            o0 = ATT_MFMA(va, __builtin_bit_cast(bf16x8, wf[c]), o0); o1 = ATT_MFMA(vb, __builtin_bit_cast(bf16x8, wf[c]), o1);
            va = vna; vb = vnb;
            ATT_SB();
        }
        carry = half_sum(W.hi == 0 ? (t00 - pz0) + lfirst : 0.f);
    } else {
#define ATT_FBV(i) (*(const LAS f32x4*)(Fb + 8 * W.hi + 32 * ((i) >> 2) + 16 * (((i) >> 1) & 1) + 4 * ((i) & 1)))
        f32x4 fcur = ATT_FBV(0), fnxt = fcur;
        float mx = -1e30f;
#pragma unroll
        for (int i = 0; i < 8; ++i) {
            if (i < 7) { knxt = ATT_KF(i + 1); fnxt = ATT_FBV(i + 1); if (i & 1) qnxt = ATT_QF((i + 1) >> 1); }
#pragma unroll
            for (int e = 0; e < 4; ++e) { const int r = (4 * i + e) & 15; float s = ((i < 4) ? p0[r] : p1[r]) - fcur[e];
                if (DIAG) { const int key = kbase + (i < 4 ? 0 : 32) + 16 * (r >> 3) + (r & 7); s = (key > W.qabs) ? -1e30f : s; }
                if (i < 4) p0[r] = s; else p1[r] = s; mx = fmaxf(mx, s); }
            asm volatile("" : "+v"(kcur) : "v"(mx));
            if (i & 1) { n1 = ATT_MFMA(kcur, qcur, n1); qcur = qnxt; } else n0 = ATT_MFMA(kcur, qcur, n0);
            kcur = knxt; fcur = fnxt;
            ATT_SB();
        }
        bf16x8 va = ATT_VF(0), vb = ATT_VF(1), vna = va, vnb = vb;
        mx = half_max(mx);
        if (__any(mx > carry)) {
            const float mnew = fmaxf(carry, mx), alpha = __builtin_amdgcn_exp2f(carry - mnew); carry = mnew; lsum *= alpha;
#pragma unroll
            for (int r = 0; r < 16; ++r) { o0[r] *= alpha; o1[r] *= alpha; }
        }
        ATT_SB();
        float ps = 0.f;
#pragma unroll
        for (int c = 0; c < 4; ++c) {
            if (c < 3) { vna = ATT_VF(2 * c + 2); vnb = ATT_VF(2 * c + 3); }
#pragma unroll
            for (int j = 0; j < 4; ++j) { const int r = 8 * (c & 1) + 2 * j;
                const float a = __builtin_amdgcn_exp2f(((c < 2) ? p0[r] : p1[r]) - carry), d = __builtin_amdgcn_exp2f(((c < 2) ? p0[r + 1] : p1[r + 1]) - carry);
                ps += a + d; wf[c][j] = pk_bf16(a, d); }
            o0 = ATT_MFMA(va, __builtin_bit_cast(bf16x8, wf[c]), o0); o1 = ATT_MFMA(vb, __builtin_bit_cast(bf16x8, wf[c]), o1);
            va = vna; vb = vnb;
            ATT_SB();
        }
        lsum += half_sum(ps);
    }
    p0 = n0; p1 = n1;
#undef ATT_KF
#undef ATT_QF
#undef ATT_VF
#undef ATT_FBV
}

template <int KIND>
__device__ __forceinline__ void unit(const Tensors& T, int b, int h, int qb, LAS unsigned char* lds, int wave, int ring, bool pref, bool nv, int nb, int nh, int nqb, int ncolk, int ncolv, bool nfox) {
    int lane_; asm volatile("v_mbcnt_lo_u32_b32 %0, -1, 0\n\tv_mbcnt_hi_u32_b32 %0, -1, %0" : "=v"(lane_));
    const int wid = wave, lane = lane_, tid = wid * 64 + lane;
    WaveCtx W; W.r32 = lane & 31; W.hi = lane >> 5;
    const int q0 = qb * 256, qw0 = q0 + wid * 32; W.qabs = qw0 + W.r32;
    const size_t rowbase = (size_t)b * SEQ;
    const int ktd = qw0 >> 6;
    const int kt_hi = (q0 + 255) >> 6;
    const int srow = tid >> 3, cg = (tid & 7) ^ ((srow >> 1) & 7);
    const bf16* kg = T.proj + (rowbase + srow) * NPROJ + T.colk + h * 64 + cg * 8;
    const bf16* vg = T.proj + (rowbase + srow) * NPROJ + T.colv + h * 64 + ((tid & 7) ^ (4 * ((srow >> 1) & 1))) * 8;
    const float* fg = T.fcum + (size_t)(b * 6 + h) * SEQ;
    LAS unsigned char* qlds = lds + OFF_Q + wid * 4608;
    W.qb = qlds + W.r32 * 144 + W.hi * 16;
    const int pm = pim(W.r32);
#pragma unroll
    for (int j = 0; j < 4; ++j) W.ko[j] = pm * KROW + (((2 * j + W.hi) ^ ((pm >> 1) & 7)) << 4);
    {
        const int g = lane >> 4, r = (lane >> 2) & 3, c = lane & 3;
#pragma unroll
        for (int bb = 0; bb < 2; ++bb) W.vo[bb] = (8 * (g >> 1) + r) * KROW + (((4 * bb + 2 * (g & 1) + (c & 1)) ^ (4 * ((r >> 1) & 1))) << 4) + 8 * (c >> 1); }
#pragma unroll
    for (int i = 0; i < 8; ++i) { W.mtri0[i] = (_Float16)((8 * W.hi + i > pm) ? 1.0f : 0.0f); W.mtri1[i] = (_Float16)((16 + 8 * W.hi + i > pm) ? 1.0f : 0.0f); W.mones[i] = (_Float16)1.0f; }
    f32x16 o0, o1, p0, p1;
#pragma unroll
    for (int r = 0; r < 16; ++r) { o0[r] = 0.f; o1[r] = 0.f; p0[r] = 0.f; p1[r] = 0.f; }
    float carry = (KIND == 1) ? -1e30f : 0.f, lsum = 0.f;
    LAS unsigned char* rl = lds + ring * RING1;
#define ATT_KB(t) (rl + OFF_K + ((t) & 1) * TILE_B)
#define ATT_VB(t) (rl + OFF_V + ((t) & 1) * TILE_B)
#define ATT_FB(t) ((LAS float*)(rl + OFF_F + ((t) & 1) * 256))
#define ATT_DMA(gsrc, ldst) glds16((gsrc), (unsigned)__builtin_amdgcn_readfirstlane((int)(uintptr_t)((ldst) + wid * 1024)))
    if (!pref) { ATT_DMA(kg + (size_t)kt_hi * 64 * NPROJ, ATT_KB(kt_hi)); ATT_DMA(vg + (size_t)kt_hi * 64 * NPROJ, ATT_VB(kt_hi)); ATT_DMA(kg + (size_t)(kt_hi - 1) * 64 * NPROJ, ATT_KB(kt_hi - 1)); }
    { const bf16* qp = T.proj + (rowbase + W.qabs) * NPROJ + T.colq + h * 64 + W.hi * 8;
      v4u qt[4];
#pragma unroll
      for (int d0 = 0; d0 < 4; ++d0) qt[d0] = *(const v4u*)(qp + d0 * 16);
#pragma unroll
      for (int d0 = 0; d0 < 4; ++d0) *(LAS v4u*)(qlds + W.r32 * 144 + W.hi * 16 + 32 * d0) = qt[d0]; }
    if (KIND == 1 && !pref && tid < 64) ATT_FB(kt_hi)[tid] = fg[kt_hi * 64 + tid];
    asm volatile("s_waitcnt vmcnt(0)" ::: "memory");
    if (nv) {
        LAS unsigned char* nl = lds + (ring ^ 1) * RING1; const int nkt = (nqb * 256 + 255) >> 6; const size_t nrow = (size_t)nb * SEQ;
        const bf16* nkg = T.proj + (nrow + srow) * NPROJ + ncolk + nh * 64 + cg * 8; const bf16* nvg = T.proj + (nrow + srow) * NPROJ + ncolv + nh * 64 + ((tid & 7) ^ (4 * ((srow >> 1) & 1))) * 8;
        glds16(nkg + (size_t)nkt * 64 * NPROJ, (unsigned)__builtin_amdgcn_readfirstlane((int)(uintptr_t)(nl + OFF_K + (nkt & 1) * TILE_B + wid * 1024)));
        glds16(nvg + (size_t)nkt * 64 * NPROJ, (unsigned)__builtin_amdgcn_readfirstlane((int)(uintptr_t)(nl + OFF_V + (nkt & 1) * TILE_B + wid * 1024)));
        glds16(nkg + (size_t)(nkt - 1) * 64 * NPROJ, (unsigned)__builtin_amdgcn_readfirstlane((int)(uintptr_t)(nl + OFF_K + ((nkt - 1) & 1) * TILE_B + wid * 1024)));
        if (nfox && wid == 0) glds4(T.fcum + (size_t)(nb * 6 + nh) * SEQ + nkt * 64 + lane, (unsigned)__builtin_amdgcn_readfirstlane((int)(uintptr_t)(nl + OFF_F + (nkt & 1) * 256)));
    }
    __syncthreads();
    if (ktd == kt_hi) qk_only(p0, p1, ATT_KB(kt_hi), W);
    __syncthreads();
#ifdef TPROBE
    unsigned long long tacc = 0ull;
#endif
    constexpr float EXIT_LOG2 = -40.0f;
    LAS int* flags = (LAS int*)(lds + OFF_FLAG);
    bool wdone = false;
    for (int kt = kt_hi; kt >= 0; --kt) {
        float freg = 0.f, fnx = 0.f;
        if (KIND == 1 && kt >= 1) fnx = fg[kt * 64 - 1];
#ifdef TPROBE
        const unsigned long long tp0 = __builtin_readcyclecounter();
#endif
        if (kt >= 2) ATT_DMA(kg + (size_t)(kt - 2) * 64 * NPROJ, ATT_KB(kt - 2));
        if (kt >= 1) { ATT_DMA(vg + (size_t)(kt - 1) * 64 * NPROJ, ATT_VB(kt - 1)); if (KIND == 1 && tid < 64) freg = fg[(kt - 1) * 64 + tid]; }
#ifdef TPROBE
        const unsigned long long tp1 = __builtin_readcyclecounter();
#endif
        if (kt <= ktd) {
            if (!wdone) {
                if (kt == ktd) tile<KIND, true>(p0, p1, o0, o1, carry, lsum, ATT_KB(kt - 1), ATT_VB(kt), ATT_FB(kt), kt, W);
                else tile<KIND, false>(p0, p1, o0, o1, carry, lsum, ATT_KB(kt - 1), ATT_VB(kt), ATT_FB(kt), kt, W);
                const float slack = (KIND == 0) ? carry : (T.z2max - fnx) - carry;
                wdone = !__any(!(slack < EXIT_LOG2));
            }
        } else if (kt - 1 == ktd) qk_only(p0, p1, ATT_KB(kt - 1), W);
        if (lane == 0) flags[(kt & 1) * 8 + wid] = wdone ? 1 : 0;
        if (KIND == 1 && kt >= 1 && tid < 64) ATT_FB(kt - 1)[tid] = freg;
#ifdef TPROBE
        const unsigned long long tp2 = __builtin_readcyclecounter();
#endif
        asm volatile("s_waitcnt vmcnt(0)" ::: "memory");
#ifdef ATT_LDSFLUSH
        { unsigned dummy; asm volatile("ds_read_b32 %0, %1\n\ts_waitcnt lgkmcnt(0)" : "=v"(dummy) : "v"((unsigned)(uintptr_t)(lds + OFF_V + wid * 1024 + lane * 16)) : "memory"); }
#endif
        __syncthreads();
        if (__all(flags[(kt & 1) * 8 + (lane & 7)] != 0)) break;
#ifdef TPROBE
        const unsigned long long tp3 = __builtin_readcyclecounter();
        tacc += (TPROBE == 1) ? (tp3 - tp2) : (TPROBE == 2) ? (tp3 - tp0) : (TPROBE == 3) ? (tp2 - tp1) : (tp1 - tp0);
        asm volatile("" :: "s"(tp0), "s"(tp1), "s"(tp2), "s"(tp3));
#endif
    }
#ifdef TPROBE
    if (blockIdx.x == TPROBE_BLK && tid == TPROBE_WAVE * 64) atomicAdd((unsigned long long*)T.tprobe, tacc);
#endif
#undef ATT_KB
#undef ATT_VB
#undef ATT_FB
#undef ATT_DMA
    if (KIND == 1) { const float inv = 1.0f / lsum;
#pragma unroll
        for (int r = 0; r < 16; ++r) { o0[r] *= inv; o1[r] *= inv; } }
    float ss = 0.f;
#pragma unroll
    for (int r = 0; r < 16; ++r) ss += o0[r] * o0[r] + o1[r] * o1[r];
    ss = half_sum(ss);
    const float rinv = 1.0f / sqrtf(ss * (1.0f / 64.0f) + EPS);
    const float* gp = T.ong + T.coly + h * 64 + 8 * W.hi;
    bf16* yp = T.ymix + (rowbase + W.qabs) * DM + T.coly + h * 64 + 8 * W.hi;
#pragma unroll
    for (int d0 = 0; d0 < 2; ++d0)
#pragma unroll
        for (int g = 0; g < 2; ++g) { const f32x4 ga = *(const f32x4*)(gp + 32 * d0 + 16 * g), gb = *(const f32x4*)(gp + 32 * d0 + 16 * g + 4);
            float v[8];
#pragma unroll
            for (int i = 0; i < 8; ++i) v[i] = (d0 == 0 ? o0[8 * g + i] : o1[8 * g + i]) * rinv * (i < 4 ? ga[i & 3] : gb[i & 3]);
            if (P5_FP8) { v2u w8; w8.x = pg8::pk4_fp8(v[0], v[1], v[2], v[3]); w8.y = pg8::pk4_fp8(v[4], v[5], v[6], v[7]);
                *(v2u*)((unsigned char*)T.ymix + (rowbase + W.qabs) * DM + T.coly + h * 64 + 8 * W.hi + 32 * d0 + 16 * g) = w8; }
            else { v4u w; w.x = pk_bf16(v[0], v[1]); w.y = pk_bf16(v[2], v[3]); w.z = pk_bf16(v[4], v[5]); w.w = pk_bf16(v[6], v[7]);
                *(v4u*)(yp + 32 * d0 + 16 * g) = w; } }
}
}
constexpr size_t MiB = 1u << 20;
constexpr size_t WS_CTL = 0, CTL_ZERO_BYTES = 32 * 1024;
constexpr size_t WS_MODP = 1 * MiB;
constexpr size_t WS_MODF = 1 * MiB + 1536 * 1024;
constexpr size_t WS_QKG = 3 * MiB - 4096;
constexpr size_t WS_TOPW = 3 * MiB;
constexpr size_t WS_ROUTE = WS_TOPW + 512 * 1024;
constexpr size_t WS_TOKSLOT = WS_ROUTE + 512 * 1024;
constexpr size_t WS_SLOTTOK = WS_TOKSLOT + 512 * 1024;
constexpr size_t WS_HIST = WS_SLOTTOK + 576 * 1024;
constexpr size_t WS_MOETAB = WS_HIST + 32 * 1024;
constexpr size_t WS_LOGF = 6 * MiB;
constexpr size_t WS_FCUM = 7 * MiB;
constexpr size_t WS_WIN = 8 * MiB, WS_WOUT = 20 * MiB, WS_W1 = 24 * MiB, WS_W2 = 280 * MiB;
constexpr size_t WS_H = 408 * MiB;
constexpr size_t WS_PROJ = 472 * MiB;
constexpr size_t WS_VT = 664 * MiB;
constexpr size_t WS_YMIX = 712 * MiB;
constexpr size_t WS_XA = 776 * MiB, WS_XB = 904 * MiB;
constexpr size_t WS_ACT = 1032 * MiB, WS_Y = 1304 * MiB, WS_H8 = 1576 * MiB, WS_END = 1608 * MiB;
static_assert(WS_MOETAB + 256 <= WS_LOGF && (size_t)NSLOT_MAX * 4 <= 576 * 1024 && (size_t)NSLOT_MAX * DM * 2 <= 272 * MiB, "ws map");
#ifndef P2_FP8
#define P2_FP8 0
#endif
constexpr int CW_BAR = 4096;

constexpr int RING_BYTES = 131072;
constexpr int MISC_OFF = RING_BYTES;
constexpr int LDS_BYTES = 147456;

#define RLX_AGENT __ATOMIC_RELAXED, __HIP_MEMORY_SCOPE_AGENT
__device__ __forceinline__ unsigned f2bf(float f) { unsigned u = __builtin_bit_cast(unsigned, f); return (u + 0x7fffu + ((u >> 16) & 1u)) >> 16; }
__device__ __forceinline__ unsigned pk2(float lo, float hi) { return f2bf(lo) | (f2bf(hi) << 16); }
__device__ __forceinline__ float bflo(unsigned u) { return __builtin_bit_cast(float, u << 16); }
__device__ __forceinline__ float bfhi(unsigned u) { return __builtin_bit_cast(float, u & 0xffff0000u); }
__device__ __forceinline__ int shxi(int v, int o, int lane) {
    if (o == 1) return __builtin_amdgcn_mov_dpp(v, 0xB1, 0xf, 0xf, true);
    if (o == 2) return __builtin_amdgcn_mov_dpp(v, 0x4E, 0xf, 0xf, true);
    if (o == 4) return __builtin_amdgcn_ds_swizzle(v, 0x101F);
    if (o == 8) return __builtin_amdgcn_ds_swizzle(v, 0x201F);
    if (o == 16) return __builtin_amdgcn_ds_swizzle(v, 0x401F);
    return __builtin_amdgcn_ds_bpermute((lane ^ o) << 2, v);
}
__device__ __forceinline__ float shx(float v, int o, int lane) { return __builtin_bit_cast(float, shxi(__builtin_bit_cast(int, v), o, lane)); }
__device__ __forceinline__ float shup(float v, int o, int lane) { return __builtin_bit_cast(float, __builtin_amdgcn_ds_bpermute(((lane - o) & 63) << 2, __builtin_bit_cast(int, v))); }
__device__ __forceinline__ float add_other_half(float v) { auto rr = __builtin_amdgcn_permlane32_swap(__float_as_uint(v), __float_as_uint(v), false, false); return __uint_as_float(rr[0]) + __uint_as_float(rr[1]); }
__device__ __forceinline__ float wave_sum(float v, int lane) {
    v += shx(v, 1, lane); v += shx(v, 2, lane); v += shx(v, 4, lane); v += shx(v, 8, lane); v += shx(v, 16, lane);
    return add_other_half(v);
}

#define XB_TMO      128
#define XB_XCNT(j)  (256  + 64 * (j))
#define XB_XSUB(j)  (1280 + 64 * (j))
#define XB_XGEN(j)  (2304 + 64 * (j))
#define XB_TOP      3328
#define XB_TOPGEN   3392
#define XCD_BAR_WORDS 3456
#define XB_SPIN_CAP (1u << 18)
__device__ __forceinline__ unsigned xb_ld(unsigned* p)              { return __hip_atomic_load(p, __ATOMIC_RELAXED, __HIP_MEMORY_SCOPE_AGENT); }
__device__ __forceinline__ unsigned xb_add(unsigned* p, unsigned v) { return __hip_atomic_fetch_add(p, v, __ATOMIC_RELAXED, __HIP_MEMORY_SCOPE_AGENT); }
__device__ __forceinline__ unsigned xb_xcc_id() { return (unsigned)__builtin_amdgcn_s_getreg((3 << 11) | 20) & 0xFu; }
#define XB_SPIN(cond, bar) do { unsigned _sp = 0; while (cond) { __builtin_amdgcn_s_sleep(1); \
    if ((++_sp & 255u) == 0u) { if (xb_ld(&(bar)[XB_TMO])) break; if (_sp > XB_SPIN_CAP) { atomicAdd(&(bar)[XB_TMO], 1u); break; } } } } while (0)
__device__ __forceinline__ int lane_id() { int lane_; asm volatile("v_mbcnt_lo_u32_b32 %0, -1, 0\n\tv_mbcnt_hi_u32_b32 %0, -1, %0" : "=v"(lane_)); return lane_; }
struct XcdBarrier { unsigned* bar; unsigned x; volatile LAS unsigned* st; int wave; };
__device__ __forceinline__ XcdBarrier xcd_barrier_post(unsigned* bar, volatile LAS unsigned* st, int wave) {
    XcdBarrier b; b.bar = bar; b.x = (unsigned)__builtin_amdgcn_readfirstlane((int)xb_xcc_id()); b.st = st; b.wave = wave;
    if (wave == 0 && lane_id() == 0) (void)xb_add(&bar[XB_XCNT(b.x)], 1u);
    return b;
}
__device__ __forceinline__ void xcd_barrier_complete(unsigned* bar, unsigned x, unsigned& nloc, unsigned& nx) {
    const unsigned G = gridDim.x * gridDim.y * gridDim.z;
    unsigned sum, cnt, mine, sp = 0u;
    for (;;) {
        sum = 0u; cnt = 0u; mine = 0u;
#pragma unroll
        for (unsigned j = 0; j < 16; ++j) { const unsigned c = xb_ld(&bar[XB_XCNT(j)]); sum += c; cnt += (c > 0u) ? 1u : 0u; mine = (j == x) ? c : mine; }
        if (sum == G) break;
        __builtin_amdgcn_s_sleep(1);
        if ((++sp & 255u) == 0u) { if (xb_ld(&bar[XB_TMO])) break; if (sp > XB_SPIN_CAP) { atomicAdd(&bar[XB_TMO], 1u); break; } }
    }
    nloc = mine > 0u ? mine : 1u; nx = cnt > 0u ? cnt : 1u;
}
__device__ __forceinline__ void xcd_barrier(const XcdBarrier& b) {
    asm volatile("s_waitcnt vmcnt(0)" ::: "memory");
    __syncthreads();
    if (b.wave == 0 && lane_id() == 0) {
        unsigned* bar = b.bar; const unsigned bx = (unsigned)__builtin_amdgcn_readfirstlane((int)xb_xcc_id());
        __builtin_amdgcn_s_waitcnt(0);
        unsigned nloc = b.st[0], nx = b.st[1];
        if (nloc == 0u) { xcd_barrier_complete(bar, bx, nloc, nx); b.st[0] = nloc; b.st[1] = nx; }
        const unsigned old = xb_add(&bar[XB_XSUB(bx)], 1u);
        const unsigned gen = old / nloc;
        if (old + 1u == (gen + 1u) * nloc) {
            __builtin_amdgcn_fence(__ATOMIC_RELEASE, "agent");
            asm volatile("s_waitcnt vmcnt(0)" ::: "memory");
            const unsigned og = xb_add(&bar[XB_TOP], 1u);
            const unsigned tg = og / nx;
            if (og + 1u == (tg + 1u) * nx) xb_add(&bar[XB_TOPGEN], 1u);
            else XB_SPIN(xb_ld(&bar[XB_TOPGEN]) == tg, bar);
            __builtin_amdgcn_fence(__ATOMIC_ACQUIRE, "agent");
            xb_add(&bar[XB_XGEN(bx)], 1u);
            asm volatile("s_waitcnt vmcnt(0)" ::: "memory");
        } else {
            XB_SPIN(xb_ld(&bar[XB_XGEN(bx)]) == gen, bar);
            __builtin_amdgcn_fence(__ATOMIC_ACQUIRE, "agent");
            asm volatile("s_waitcnt vmcnt(0)" ::: "memory");
        }
    }
    __syncthreads();
}

struct Frame {
    LAS unsigned char* lds;
    int tid, lane, wave, blk, G;
    const float* in[21];
    float* out; unsigned char* ws;
};
enum { I_X = 0, I_C, I_N1G, I_WADA, I_BADA, I_WIN, I_CONVW, I_SBQG, I_SBKG, I_FXQG, I_FXKG, I_FXFB, I_ONG, I_WOUT, I_N2G, I_RW, I_RB, I_W1, I_B1, I_W2, I_B2 };

template <int MAP, bool WIDE, bool OUT8 = false>
__device__ __forceinline__ void p0_transpose_item(const float* W, int ldw, bf16* WT, LAS float* scr, int k0, int n0, int lane, int d0 = -1) {
    if (WIDE) {
        f32x4 t[8];
#pragma unroll
        for (int i = 0; i < 8; ++i) t[i] = __builtin_nontemporal_load((const f32x4*)(W + (size_t)(k0 + 8 * i + (lane >> 3)) * ldw + n0 + 4 * (lane & 7)));
#pragma unroll
        for (int i = 0; i < 8; ++i) { LAS float* d = scr + (8 * i + (lane >> 3)) * 33 + 4 * (lane & 7); d[0] = t[i].x; d[1] = t[i].y; d[2] = t[i].z; d[3] = t[i].w; }
    } else {
#pragma unroll 8
        for (int i = 0; i < 32; ++i) { const int kk = 2 * i + (lane >> 5); scr[kk * 33 + (lane & 31)] = W[(size_t)(k0 + kk) * ldw + n0 + (lane & 31)]; }
    }
    asm volatile("s_waitcnt lgkmcnt(0)" ::: "memory");
    const int c = lane & 7;
#pragma unroll
    for (int j = 0; j < 4; ++j) { const int n = (lane >> 3) + 8 * j; const LAS float* s = scr + (8 * c) * 33 + n;
        v4u o; o.x = pk2(s[0 * 33], s[1 * 33]); o.y = pk2(s[2 * 33], s[3 * 33]); o.z = pk2(s[4 * 33], s[5 * 33]); o.w = pk2(s[6 * 33], s[7 * 33]);
        const int cn = n0 + n; int row = (d0 >= 0) ? d0 + n : cn;
        if (MAP == 1) { const int jj = cn >> 1, t = cn & 1; row = 256 * (jj >> 7) + 128 * t + (jj & 127); }
        if (OUT8) { v2u o8; o8.x = pg8::pk4_fp8(32.0f * s[0 * 33], 32.0f * s[1 * 33], 32.0f * s[2 * 33], 32.0f * s[3 * 33]); o8.y = pg8::pk4_fp8(32.0f * s[4 * 33], 32.0f * s[5 * 33], 32.0f * s[6 * 33], 32.0f * s[7 * 33]);
            *(v2u*)((unsigned char*)WT + (size_t)row * 1024 + k0 + 8 * c) = o8; }
        else *(v4u*)(WT + (size_t)row * 1024 + k0 + 8 * c) = o; }
    asm volatile("s_waitcnt lgkmcnt(0)" ::: "memory");
}
__device__ __forceinline__ void p0_prologue(Frame& F) {
    LAS float* scr = (LAS float*)(F.lds + F.wave * 16384);
    const int gw = F.blk * 8 + F.wave, NGW = F.G * 8;
    constexpr int N_ADA = NLAYER * 4 * 24;
    if (F.blk * 8 < N_ADA) {
        LAS float* sl = (LAS float*)(F.lds + 8 * 16384 - 32768);
        for (int i = F.tid; i < NB * DM; i += 512) { const float cv = F.in[I_C][i]; sl[i] = cv / (1.0f + __expf(-cv)); }
        __syncthreads();
        if (gw < N_ADA) {
            const int it = gw; const int l = it / 96, ks = (it / 24) & 3, nc = it % 24;
            const float* W = F.in[I_WADA] + (size_t)l * DM * 6144 + nc * 256 + F.lane * 4;
            f32x4 acc[NB];
#pragma unroll
            for (int b = 0; b < NB; ++b) acc[b] = (f32x4){0.f, 0.f, 0.f, 0.f};
#pragma unroll 8
            for (int k = ks * 256; k < ks * 256 + 256; ++k) {
                const f32x4 w = __builtin_nontemporal_load((const f32x4*)(W + (size_t)k * 6144));
#pragma unroll
                for (int b = 0; b < NB; ++b) acc[b] += w * sl[b * DM + k];
            }
            float* dst = (float*)(F.ws + WS_MODP) + ((size_t)(l * 4 + ks) * NB) * 6144 + nc * 256 + F.lane * 4;
#pragma unroll
            for (int b = 0; b < NB; ++b) *(f32x4*)(dst + (size_t)b * 6144) = acc[b];
            asm volatile("s_waitcnt vmcnt(0)" ::: "memory");
            __builtin_amdgcn_fence(__ATOMIC_RELEASE, "agent");
            asm volatile("s_waitcnt vmcnt(0)" ::: "memory");
            unsigned old = 0u;
            if (F.lane == 0) old = __hip_atomic_fetch_add((unsigned*)(F.ws + WS_CTL + 1024) + (l * 24 + nc), 1u, __ATOMIC_RELAXED, __HIP_MEMORY_SCOPE_AGENT);
            old = (unsigned)__builtin_amdgcn_readfirstlane((int)old);
            if (old == 3u) {
                __builtin_amdgcn_fence(__ATOMIC_ACQUIRE, "agent");
                asm volatile("s_waitcnt vmcnt(0)" ::: "memory");
                const float* pp = (const float*)(F.ws + WS_MODP) + ((size_t)(l * 4) * NB) * 6144 + nc * 256 + F.lane * 4;
                float* fo = (float*)(F.ws + WS_MODF) + ((size_t)l * NB) * 6144 + nc * 256 + F.lane * 4;
                const f32x4 bias = *(const f32x4*)(F.in[I_BADA] + (size_t)l * 6144 + nc * 256 + F.lane * 4);
#pragma unroll
                for (int b = 0; b < NB; ++b) { f32x4 s = bias;
#pragma unroll
                    for (int k2 = 0; k2 < 4; ++k2) s += (k2 == ks) ? acc[b] : *(const f32x4*)(pp + ((size_t)k2 * NB + b) * 6144);
                    *(f32x4*)(fo + (size_t)b * 6144) = s; }
            }
        }
        __syncthreads();
    }
    if (F.blk == F.G - 1) {
        float* qg = (float*)(F.ws + WS_QKG); const int l = F.wave >> 2, e = l * 64 + F.lane;
        if ((F.wave & 3) == 0) qg[l * 256 + F.lane] = F.in[I_SBQG][e] * QSCALE;
        if ((F.wave & 3) == 1) qg[l * 256 + 64 + F.lane] = F.in[I_SBKG][e];
        if ((F.wave & 3) == 2) qg[l * 256 + 128 + F.lane] = F.in[I_FXQG][e] * QSCALE;
        if ((F.wave & 3) == 3) qg[l * 256 + 192 + F.lane] = F.in[I_FXKG][e];
    }
    constexpr int I_IN = 16 * 96, I_OUT = 16 * 32, I_1 = 16 * 64, I_2 = 16 * 32;
    constexpr int N_IN = NLAYER * I_IN, N_OUT = NLAYER * I_OUT, N_1 = NLAYER * NEXP * I_1, N_2 = NLAYER * NEXP * I_2;
#pragma unroll 1
    for (int it = gw; it < N_IN + N_OUT; it += NGW) {
        int r = it;
        if (r < N_IN) { const int l = r / I_IN, q = r % I_IN, kb = q / 96, nb = q % 96;
            p0_transpose_item<0, false, P2_FP8>(F.in[I_WIN] + (size_t)l * DM * D_IN, D_IN, (bf16*)(F.ws + WS_WIN + (size_t)l * NPROJ * DM * (P2_FP8 ? 1 : 2)), scr, 64 * kb, 32 * nb, F.lane, 32 * ((nb & ~7) + 4 * (nb & 1) + ((nb >> 1) & 3))); continue; }
        r -= N_IN;
        { const int l = r / I_OUT, q = r % I_OUT, kb = q / 32, nb = q % 32;
            p0_transpose_item<0, true, P5_FP8 != 0>(F.in[I_WOUT] + (size_t)l * DM * DM, DM, (bf16*)(F.ws + WS_WOUT + (size_t)l * DM * DM * (P5_FP8 ? 1 : 2)), scr, 64 * kb, 32 * nb, F.lane); }
    }
    constexpr int T_1 = NLAYER * NEXP * 128, T_2 = NLAYER * NEXP * 64, NT = T_1 + T_2, ADA_SKIP = 9, NBA = N_ADA / 8;
    LAS float* tl = (LAS float*)F.lds;
    const bool adab = F.blk < NBA; const int poolb = (!adab && F.blk - NBA < NBA * ADA_SKIP) ? F.blk - NBA : -1;
    const int pool_t = (poolb >= 0) ? (poolb % NBA) + (poolb / NBA) * F.G : -1;
    f32x4 ld[8];
#define P0T_DEC(tv) const int T_ = ((tv) < 0) ? pool_t : (tv); const bool w1_ = T_ < T_1; const int r_ = w1_ ? T_ : T_ - T_1; \
        const int le_ = w1_ ? (r_ >> 7) : (r_ >> 6), q_ = w1_ ? (r_ & 127) : (r_ & 63), kb_ = w1_ ? (q_ >> 4) : (q_ >> 3), nb_ = w1_ ? (q_ & 15) : (q_ & 7); const int ldw_ = w1_ ? 2048 : DM;
#define P0T_LOAD(tv) do { P0T_DEC(tv) const float* s_ = (w1_ ? F.in[I_W1] : F.in[I_W2]) + (size_t)le_ * DM * ldw_ + (size_t)(128 * kb_ + 16 * F.wave + (F.lane >> 5)) * ldw_ + 128 * nb_ + 4 * (F.lane & 31); \
        _Pragma("unroll") for (int i = 0; i < 8; ++i) ld[i] = __builtin_nontemporal_load((const f32x4*)(s_ + (size_t)(2 * i) * ldw_)); } while (0)
    int tx = adab ? F.blk + ADA_SKIP * F.G : (poolb >= 0 ? F.blk - F.G : F.blk);
    __syncthreads();
    if (tx < NT) P0T_LOAD(tx);
#pragma unroll 1
    for (; tx < NT; tx += F.G) {
#pragma unroll
        for (int i = 0; i < 8; ++i) { LAS float* d = tl + (16 * F.wave + 2 * i + (F.lane >> 5)) * 129 + 4 * (F.lane & 31); d[0] = ld[i].x; d[1] = ld[i].y; d[2] = ld[i].z; d[3] = ld[i].w; }
        __syncthreads();
        if (tx + F.G < NT) P0T_LOAD(tx + F.G);
        { P0T_DEC(tx) unsigned char* WT = (w1_ ? F.ws + WS_W1 : F.ws + WS_W2) + (size_t)le_ * ldw_ * DM;
          const int c = F.lane & 15;
#pragma unroll
          for (int j = 0; j < 4; ++j) { const int n = 16 * F.wave + (F.lane >> 4) + 4 * j; const LAS float* sp = tl + (8 * c) * 129 + n;
              v2u o8; o8.x = pg8::pk4_fp8(32.0f * sp[0 * 129], 32.0f * sp[1 * 129], 32.0f * sp[2 * 129], 32.0f * sp[3 * 129]); o8.y = pg8::pk4_fp8(32.0f * sp[4 * 129], 32.0f * sp[5 * 129], 32.0f * sp[6 * 129], 32.0f * sp[7 * 129]);
              const int cn = 128 * nb_ + n; const int jj = cn >> 1, t = cn & 1; const int row = w1_ ? 256 * (jj >> 7) + 128 * t + (jj & 127) : cn;
              __builtin_nontemporal_store(o8, (v2u*)(WT + (size_t)row * 1024 + 128 * kb_ + 8 * c)); } }
        __syncthreads();
    }
#undef P0T_LOAD
#undef P0T_DEC
}

__device__ __forceinline__ f32x4 mod4(const Frame& F, int l, int b, int which, int c) { return *(const f32x4*)((const float*)(F.ws + WS_MODF) + ((size_t)l * NB + b) * 6144 + which * DM + c); }
__device__ __forceinline__ f32x4 mod4_old(const Frame& F, int l, int b, int which, int c) {
    const int n = which * DM + c;
    f32x4 s = *(const f32x4*)(F.in[I_BADA] + (size_t)l * 6144 + n);
    const float* p = (const float*)(F.ws + WS_MODP) + ((size_t)(l * 4) * NB + b) * 6144 + n;
#pragma unroll
    for (int ks = 0; ks < 4; ++ks) s += *(const f32x4*)(p + (size_t)ks * NB * 6144);
    return s;
}

constexpr size_t WS_GSUM = WS_FCUM + 800 * 1024;
static_assert(WS_GSUM + 16384 <= WS_WIN, "ws map");
template <bool S16, bool LAST = false> __device__ __forceinline__ f32x4 ld_row4(const void* base, size_t idx) {
    if (S16) { const v2u t = LAST ? __builtin_nontemporal_load((const v2u*)((const bf16*)base + idx)) : *(const v2u*)((const bf16*)base + idx); return (f32x4){bflo(t.x), bfhi(t.x), bflo(t.y), bfhi(t.y)}; }
    return __builtin_nontemporal_load((const f32x4*)((const float*)base + idx)); }
template <bool D16> __device__ __forceinline__ void st_row4(void* base, size_t idx, f32x4 v) {
    if (D16) { v2u o; o.x = pk2(v.x, v.y); o.y = pk2(v.z, v.w); __builtin_nontemporal_store(o, (v2u*)((bf16*)base + idx)); }
    else __builtin_nontemporal_store(v, (f32x4*)((float*)base + idx)); }
__device__ __forceinline__ f32x4 fp8x4_to_f32(unsigned w) { return (f32x4){__builtin_amdgcn_cvt_f32_fp8(w, 0), __builtin_amdgcn_cvt_f32_fp8(w, 1), __builtin_amdgcn_cvt_f32_fp8(w, 2), __builtin_amdgcn_cvt_f32_fp8(w, 3)}; }
template <bool COMBINE, bool NORM, bool S16, bool D16>
__device__ __forceinline__ void row_phase(Frame& F, int l, const void* xsrc, void* xdst) {
    const float* topw = (const float*)(F.ws + WS_TOPW); const int* tokslot = (const int*)(F.ws + WS_TOKSLOT); const unsigned char* Y = F.ws + WS_Y;
    bf16* H = (bf16*)(F.ws + WS_H); float* logf = (float*)(F.ws + WS_LOGF); float* gsum = (float*)(F.ws + WS_GSUM);
    LAS f32x4* wl4 = (LAS f32x4*)F.lds; LAS f32x2* wl2 = (LAS f32x2*)(F.lds + 16384); LAS float* part = (LAS float*)(F.lds + 16384 + 8192);
    if (NORM) { for (int k = F.tid; k < DM; k += 512) { const float* wp = F.in[I_WIN] + (size_t)l * DM * D_IN + (size_t)k * D_IN + NPROJ; const int idx = (4 * (k >> 8) + (k & 3)) * 64 + ((k >> 2) & 63);
            wl4[idx] = (f32x4){wp[0], wp[1], wp[2], wp[3]}; wl2[idx] = (f32x2){wp[4], wp[5]}; }
        __syncthreads(); }
    for (int chunk0 = F.blk; chunk0 < NTOK / 128; chunk0 += F.G) { const int chunk = (F.G == 256) ? (chunk0 & 7) * 32 + (chunk0 >> 3) : chunk0;
        const int b = chunk / (SEQ / 128);
        LAS f32x4* mv = (LAS f32x4*)(F.lds + 32768);
        __syncthreads();
        {
            const int j = F.wave & 3, c = 256 * j + 4 * F.lane;
            if (F.wave < 4) { if (COMBINE) mv[(0 * 4 + j) * 64 + F.lane] = mod4(F, l - 1, b, 5, c);
                if (NORM) mv[(2 * 4 + j) * 64 + F.lane] = mod4(F, l, b, 0, c); }
            else if (NORM) { const f32x4 g = *(const f32x4*)(F.in[I_N1G] + (size_t)l * DM + c); mv[(1 * 4 + j) * 64 + F.lane] = g * (mod4(F, l, b, 1, c) + 1.0f); }
        }
        __syncthreads();
        float lacc = 0.f;
        int slotv = 0, wvi = 0;
        if (COMBINE) { slotv = tokslot[(chunk * 128 + F.wave * 16) * 4 + F.lane]; wvi = __builtin_bit_cast(int, topw[(chunk * 128 + F.wave * 16) * 4 + F.lane]); }
#pragma unroll 1
        for (int rr = 0; rr < 16; rr += 2) {
            const int row = chunk * 128 + F.wave * 16 + rr;
            f32x4 v[2][4];
#pragma unroll
            for (int u = 0; u < 2; ++u)
#pragma unroll
                for (int j = 0; j < 4; ++j) v[u][j] = ld_row4<S16, true>(xsrc, (size_t)(row + u) * DM + 256 * j + 4 * F.lane);
            int mofs = F.lane; asm volatile("" : "+v"(mofs));
            unsigned yv[2][TOPK][4]; float yw[2][TOPK];
            if (COMBINE) {
#pragma unroll
                for (int u = 0; u < 2; ++u)
#pragma unroll
                    for (int k = 0; k < TOPK; ++k) { yw[u][k] = __builtin_bit_cast(float, __builtin_amdgcn_readlane(wvi, (rr + u) * 4 + k)); const int slot = __builtin_amdgcn_readlane(slotv, (rr + u) * 4 + k);
#pragma unroll
                        for (int j = 0; j < 4; ++j) yv[u][k][j] = __builtin_nontemporal_load((const unsigned*)(Y + (size_t)slot * DM + 256 * j + 4 * F.lane)); }
            }
            __builtin_amdgcn_sched_barrier(0);
            if (COMBINE) {
#pragma unroll
                for (int u = 0; u < 2; ++u) {
                    f32x4 s[4];
#pragma unroll
                    for (int j = 0; j < 4; ++j) s[j] = (f32x4){0.f, 0.f, 0.f, 0.f};
#pragma unroll
                    for (int k = 0; k < TOPK; ++k)
#pragma unroll
                        for (int j = 0; j < 4; ++j) s[j] += fp8x4_to_f32(yv[u][k][j]) * yw[u][k];
#pragma unroll
                    for (int j = 0; j < 4; ++j) { v[u][j] += mv[(0 * 4 + j) * 64 + mofs] * s[j]; st_row4<D16>(xdst, (size_t)(row + u) * DM + 256 * j + 4 * F.lane, v[u][j]); }
                }
            }
            if (NORM) {
                float ss[2];
#pragma unroll
                for (int u = 0; u < 2; ++u) { float s = 0.f;
#pragma unroll
                    for (int j = 0; j < 4; ++j) s += (v[u][j].x * v[u][j].x + v[u][j].y * v[u][j].y) + (v[u][j].z * v[u][j].z + v[u][j].w * v[u][j].w);
                    ss[u] = s; }
#pragma unroll
                for (int o = 1; o < 32; o <<= 1) { ss[0] += shx(ss[0], o, F.lane); ss[1] += shx(ss[1], o, F.lane); }
                ss[0] = add_other_half(ss[0]); ss[1] = add_other_half(ss[1]);
                float fl[2][6];
                int lofs = F.lane; asm volatile("" : "+v"(lofs));
#pragma unroll
                for (int u = 0; u < 2; ++u) { const float rstd = 1.0f / sqrtf(ss[u] * (1.0f / DM) + EPS);
#pragma unroll
                    for (int q = 0; q < 6; ++q) fl[u][q] = 0.f;
#pragma unroll
                    for (int j = 0; j < 4; ++j) { const f32x4 hv = v[u][j] * rstd * mv[(1 * 4 + j) * 64 + mofs] + mv[(2 * 4 + j) * 64 + mofs];
                        if (P2_FP8) *(unsigned*)((unsigned char*)H + (size_t)(row + u) * DM + 256 * j + 4 * F.lane) = pg8::pk4_fp8(hv.x, hv.y, hv.z, hv.w);
                        else { v2u o; o.x = pk2(hv.x, hv.y); o.y = pk2(hv.z, hv.w); *(v2u*)(H + (size_t)(row + u) * DM + 256 * j + 4 * F.lane) = o; }
#pragma unroll
                        for (int i = 0; i < 4; ++i) { const f32x4 wa = wl4[(4 * j + i) * 64 + lofs]; const f32x2 wb = wl2[(4 * j + i) * 64 + lofs]; const float hx = hv[i];
                            fl[u][0] += hx * wa.x; fl[u][1] += hx * wa.y; fl[u][2] += hx * wa.z; fl[u][3] += hx * wa.w; fl[u][4] += hx * wb.x; fl[u][5] += hx * wb.y; } } }
#pragma unroll
                for (int o = 1; o < 32; o <<= 1)
#pragma unroll
                    for (int u = 0; u < 2; ++u)
#pragma unroll
                        for (int q = 0; q < 6; ++q) fl[u][q] += shx(fl[u][q], o, F.lane);
#pragma unroll
                for (int u = 0; u < 2; ++u)
#pragma unroll
                    for (int q = 0; q < 6; ++q) fl[u][q] = add_other_half(fl[u][q]);
                if (F.lane < 6) {
#pragma unroll
                    for (int u = 0; u < 2; ++u) { float z = fl[u][0];
#pragma unroll
                        for (int q = 1; q < 6; ++q) z = (F.lane == q) ? fl[u][q] : z;
                        z += F.in[I_FXFB][l * 6 + F.lane];
                        const float lg = fminf(z, 0.f) - __logf(1.0f + __expf(-fabsf(z)));
                        logf[(size_t)(row + u) * 6 + F.lane] = lg; lacc += lg; } }
            }
        }
        if (NORM) {
            if (F.lane < 6) part[F.wave * 8 + F.lane] = lacc;
            __syncthreads();
            if (F.tid < 12) { const int g = F.tid / 6, h = F.tid % 6; gsum[(size_t)(chunk * 2 + g) * 6 + h] = (part[(4 * g) * 8 + h] + part[(4 * g + 1) * 8 + h]) + (part[(4 * g + 2) * 8 + h] + part[(4 * g + 3) * 8 + h]); }
            __syncthreads();
        }
    }
    __syncthreads();
}
__device__ __forceinline__ void p3_fscan(Frame& F) {
    const int ntile = (NTOK / 64 - F.blk + F.G - 1) / F.G;
    for (int it = F.wave; it < 6 * ntile; it += 8) {
        const int tile = F.blk + (it / 6) * F.G, h = it % 6;
        const int b = tile / (SEQ / 64), s0 = (tile % (SEQ / 64)) * 64, gt = tile % (SEQ / 64); const size_t row0 = (size_t)b * SEQ + s0;
        const float* gs = (const float*)(F.ws + WS_GSUM) + (size_t)(b * (SEQ / 64)) * 6; const float* lf = (const float*)(F.ws + WS_LOGF) + (row0 + F.lane) * 6;
        float* fo = (float*)(F.ws + WS_FCUM) + (size_t)(b * 6) * SEQ + s0 + F.lane;
        float base = (F.lane < gt) ? gs[F.lane * 6 + h] : 0.f; float inc = lf[h];
        base = wave_sum(base, F.lane);
#pragma unroll
        for (int o = 1; o < 64; o <<= 1) { const float t = shup(inc, o, F.lane); if (F.lane >= o) inc += t; }
        fo[(size_t)h * SEQ] = (base + inc) * LOG2E; }
}
__device__ __forceinline__ void p3_postproj(Frame& F, int l) {
#ifdef P3SEG
    unsigned long long sg_acc = 0ull, sg_t = __builtin_readcyclecounter();
#define SEG3(n) do { const unsigned long long t_ = __builtin_readcyclecounter(); if ((n) == P3SEG) sg_acc += t_ - sg_t; sg_t = t_; asm volatile("" :: "s"(t_)); } while (0)
#else
#define SEG3(n) do {} while (0)
#endif
    bf16* proj = (bf16*)(F.ws + WS_PROJ); bf16* ymix = (bf16*)(F.ws + WS_YMIX);
    const float* ong = F.in[I_ONG] + (size_t)l * DM;
    const int c4 = 4 * F.lane;
    f32x4 cw[3];
#pragma unroll
    for (int w = 0; w < 3; ++w) cw[w] = *(const f32x4*)(F.in[I_CONVW] + (size_t)(l * 3 + w) * 256 + c4);
    const f32x4 cg = *(const f32x4*)(ong + c4);
    SEG3(0);
    unsigned* cctr = (unsigned*)(F.ws + WS_CTL + 3072) + 64 * l;
    volatile LAS int* cs = (volatile LAS int*)(F.lds + MISC_OFF + 640);
    if (F.tid == 0) cs[0] = (int)__hip_atomic_fetch_add(cctr, 1u, __ATOMIC_RELAXED, __HIP_MEMORY_SCOPE_AGENT);
    __syncthreads();
#pragma unroll 1
    for (int it = 0;; ++it) {
        const int tile = __builtin_amdgcn_readfirstlane(cs[it & 1]);
        if (tile >= NTOK / 64) break;
        int gnext = 0;
        if (F.tid == 0) gnext = (int)__hip_atomic_fetch_add(cctr, 1u, __ATOMIC_RELAXED, __HIP_MEMORY_SCOPE_AGENT);
        const int b = tile / (SEQ / 64), s0 = (tile % (SEQ / 64)) * 64; const size_t row0 = (size_t)b * SEQ + s0;
        {
            const int sw0 = s0 + F.wave * 8;
            f32x4 vm2 = (f32x4){0.f, 0.f, 0.f, 0.f}, vm1 = vm2;
            v2u c2 = (v2u){0u, 0u}, u2 = c2, c1 = c2, u1 = c2;
            if (sw0 >= 2) {
                const bf16* p2 = proj + ((size_t)b * SEQ + sw0 - 2) * NPROJ; const bf16* p1 = p2 + NPROJ;
                c2 = *(const v2u*)(p2 + COL_CC + c4); u2 = *(const v2u*)(p2 + COL_CU + c4); c1 = *(const v2u*)(p1 + COL_CC + c4); u1 = *(const v2u*)(p1 + COL_CU + c4); }
            v2u cb[8], cc[8], cu[8];
#pragma unroll
            for (int u = 0; u < 8; ++u) { const bf16* pr = proj + ((size_t)b * SEQ + sw0 + u) * NPROJ;
                cb[u] = __builtin_nontemporal_load((const v2u*)(pr + COL_CB + c4)); cc[u] = __builtin_nontemporal_load((const v2u*)(pr + COL_CC + c4)); cu[u] = __builtin_nontemporal_load((const v2u*)(pr + COL_CU + c4)); }
            vm2 = (f32x4){bflo(c2.x) * bflo(u2.x), bfhi(c2.x) * bfhi(u2.x), bflo(c2.y) * bflo(u2.y), bfhi(c2.y) * bfhi(u2.y)};
            vm1 = (f32x4){bflo(c1.x) * bflo(u1.x), bfhi(c1.x) * bfhi(u1.x), bflo(c1.y) * bflo(u1.y), bfhi(c1.y) * bfhi(u1.y)};
            f32x4 y[8]; float ss[8];
#pragma unroll
            for (int u = 0; u < 8; ++u) {
                const f32x4 v0 = (f32x4){bflo(cc[u].x) * bflo(cu[u].x), bfhi(cc[u].x) * bfhi(cu[u].x), bflo(cc[u].y) * bflo(cu[u].y), bfhi(cc[u].y) * bfhi(cu[u].y)};
                y[u] = cw[0] * vm2 + cw[1] * vm1 + cw[2] * v0; vm2 = vm1; vm1 = v0;
                y[u] = y[u] * (f32x4){bflo(cb[u].x), bfhi(cb[u].x), bflo(cb[u].y), bfhi(cb[u].y)};
                ss[u] = (y[u].x * y[u].x + y[u].y * y[u].y) + (y[u].z * y[u].z + y[u].w * y[u].w); }
#pragma unroll
            for (int o = 1; o < 16; o <<= 1)
#pragma unroll
                for (int u = 0; u < 8; ++u) ss[u] += shx(ss[u], o, F.lane);
#pragma unroll
            for (int u = 0; u < 8; ++u) {
                const float rinv = 1.0f / sqrtf(ss[u] * (1.0f / 64.0f) + EPS);
                const f32x4 yo = y[u] * rinv * cg;
                if (P5_FP8) *(unsigned*)((unsigned char*)ymix + ((size_t)b * SEQ + sw0 + u) * DM + c4) = pg8::pk4_fp8(yo.x, yo.y, yo.z, yo.w);
                else { v2u o; o.x = pk2(yo.x, yo.y); o.y = pk2(yo.z, yo.w); *(v2u*)(ymix + ((size_t)b * SEQ + sw0 + u) * DM + c4) = o; } }
        }
        SEG3(1);
        if (F.tid == 0) cs[(it + 1) & 1] = gnext;
        __syncthreads();
    }
#ifdef P3SEG
    if (F.blk == 0 && F.tid == P3WAVE * 64) atomicAdd((unsigned long long*)(F.ws + WS_CTL + 512), sg_acc);
#endif
}

__device__ __forceinline__ void p4_attention(Frame& F, int l) {
    att::Tensors Ts, Tf;
    Ts.proj = (const bf16*)(F.ws + WS_PROJ); Ts.fcum = (const float*)(F.ws + WS_FCUM); Ts.ymix = (bf16*)(F.ws + WS_YMIX); Ts.ong = F.in[I_ONG] + (size_t)l * DM;
    Ts.colq = COL_SQ; Ts.colk = COL_SK; Ts.colv = COL_SV; Ts.coly = 256; Ts.tprobe = (void*)(F.ws + WS_CTL + 512);
    Tf = Ts; Tf.colq = COL_FQ; Tf.colk = COL_FK; Tf.colv = COL_FV; Tf.coly = 640;
    Ts.z2max = 0.f; Tf.z2max = 0.f;
    {
        float gq = fabsf(F.in[I_FXQG][l * 64 + F.lane]), gk = fabsf(F.in[I_FXKG][l * 64 + F.lane]);
#pragma unroll
        for (int o = 1; o < 32; o <<= 1) { gq = fmaxf(gq, shx(gq, o, F.lane)); gk = fmaxf(gk, shx(gk, o, F.lane)); }
        { auto rq = __builtin_amdgcn_permlane32_swap(__float_as_uint(gq), __float_as_uint(gq), false, false); gq = fmaxf(__uint_as_float(rq[0]), __uint_as_float(rq[1]));
          auto rk = __builtin_amdgcn_permlane32_swap(__float_as_uint(gk), __float_as_uint(gk), false, false); gk = fmaxf(__uint_as_float(rk[0]), __uint_as_float(rk[1])); }
        Tf.z2max = __builtin_bit_cast(float, __builtin_amdgcn_readfirstlane(__builtin_bit_cast(int, 64.0f * gq * gk * QSCALE * 1.02f)));
    }
    const int NU = 48 * 16, NR = (NU + F.G - 1) / F.G;
    const bool affine = (F.G == 256);
    auto deal = [&](int j, int& qb, int& bb, int& hh) -> bool {
        if (j >= 2 * NR) return false;
        const int kind = (j >= NR) ? 1 : 0, i = j - kind * NR;
        if (affine) { const int ib = F.blk >> 3, ii = kind ? 31 - ib : ib; const int u = (i & 1) ? (i + 1) * 32 - 1 - ii : i * 32 + ii;
            qb = 15 - u / 6; hh = u % 6; bb = F.blk & 7; return true; }
        const int cb = kind ? F.G - 1 - F.blk : F.blk;
        const int L = (i & 1) ? (i + 1) * F.G - 1 - cb : i * F.G + cb;
        if (L >= NU) return false;
        qb = 15 - L / 48; bb = (L % 48) / 6; hh = (L % 48) % 6; return true; };
    int ring = 0; bool pref = false;
#pragma unroll 1
    for (int j = 0; j < 2 * NR; ++j) {
        const int kind = (j >= NR) ? 1 : 0;
        int qb = 0, bb = 0, hh = 0, nqb = 0, nb = 0, nh = 0;
        if (!deal(j, qb, bb, hh)) { pref = false; continue; }
        const bool nv = deal(j + 1, nqb, nb, nh); const int nkind = (j + 1 >= NR) ? 1 : 0;
        if (kind == 0) att::unit<0>(Ts, bb, hh, qb, F.lds, F.wave, ring, pref, nv, nb, nh, nqb, nkind ? COL_FK : COL_SK, nkind ? COL_FV : COL_SV, nkind != 0);
        else att::unit<1>(Tf, bb, hh, qb, F.lds, F.wave, ring, pref, nv, nb, nh, nqb, COL_FK, COL_FV, true);
        pref = nv; ring ^= 1;
    }
}

__device__ __forceinline__ void top4of8(const float (&v)[8], const int (&ix)[8], float (&tv)[4], int (&ti)[4]) {
    float w[8];
#pragma unroll
    for (int j = 0; j < 8; ++j) w[j] = v[j];
#pragma unroll
    for (int k = 0; k < 4; ++k) { float bv = w[0]; int bi = ix[0];
#pragma unroll
        for (int j = 1; j < 8; ++j) { const bool t = (w[j] > bv) || (w[j] == bv && ix[j] < bi); bv = t ? w[j] : bv; bi = t ? ix[j] : bi; }
        tv[k] = bv; ti[k] = bi;
#pragma unroll
        for (int j = 0; j < 8; ++j) w[j] = (ix[j] == bi) ? -INFINITY : w[j]; }
}
__device__ __forceinline__ void p6_norm_router(Frame& F, int l, const bf16* x1) {
    unsigned char* H8 = F.ws + WS_H8; float* topw = (float*)(F.ws + WS_TOPW); int* route = (int*)(F.ws + WS_ROUTE); int* hist = (int*)(F.ws + WS_HIST);
    const float* rw = F.in[I_RW] + (size_t)l * DM * NEXP; const float* rb = F.in[I_RB] + (size_t)l * NEXP;
#ifdef P6SEG
    unsigned long long sg_acc = 0ull, sg_t = __builtin_readcyclecounter();
#define SEG(n) do { const unsigned long long t_ = __builtin_readcyclecounter(); if ((n) == P6SEG) sg_acc += t_ - sg_t; sg_t = t_; asm volatile("" :: "s"(t_)); } while (0)
#else
#define SEG(n) do {} while (0)
#endif
    constexpr int RWP = 2064;
    LAS unsigned char* rwt = F.lds;
    LAS int* cnt = (LAS int*)(F.lds + MISC_OFF + 256);
    {
        f32x4 t[16];
#pragma unroll
        for (int i = 0; i < 16; ++i) t[i] = *(const f32x4*)(rw + (size_t)(2 * F.tid) * NEXP + 4 * i);
#pragma unroll
        for (int i = 0; i < 8; ++i)
#pragma unroll
            for (int c = 0; c < 4; ++c) *(LAS unsigned*)(rwt + (4 * i + c) * RWP + 4 * F.tid) = f2bf(t[i][c]) | (f2bf(t[8 + i][c]) << 16);
    }
    __syncthreads();
    SEG(0);
    const int fr = F.lane & 15, fq = F.lane >> 4;
    float rbv[8]; int eix[8];
#pragma unroll
    for (int i = 0; i < 4; ++i) { eix[i] = 4 * fq + i; eix[4 + i] = 16 + 4 * fq + i; rbv[i] = rb[4 * fq + i]; rbv[4 + i] = rb[16 + 4 * fq + i]; }
    for (int chunk0 = F.blk; chunk0 < NTOK / 128; chunk0 += F.G) { const int chunk = (F.G == 256) ? (chunk0 & 7) * 32 + (chunk0 >> 3) : chunk0;
        const int b = chunk / (SEQ / 128);
        if (F.tid < 32) cnt[F.tid] = 0;
        f32x4 A[4], Bv[4];
        LAS f32x4* Al = (LAS f32x4*)(F.lds + 66560); LAS f32x4* Bl = (LAS f32x4*)(F.lds + 70656); LAS float* rsl = (LAS float*)(F.lds + 74752);
#pragma unroll
        for (int j = 0; j < 4; ++j) { const int c = 256 * j + 4 * F.lane; A[j] = *(const f32x4*)(F.in[I_N2G] + (size_t)l * DM + c); Bv[j] = mod4(F, l, b, 3, c); }
        f32x4 Sc[4];
#pragma unroll
        for (int j = 0; j < 4; ++j) Sc[j] = mod4(F, l, b, 4, 256 * j + 4 * F.lane);
        __builtin_amdgcn_sched_barrier(0);
#pragma unroll
        for (int j = 0; j < 4; ++j) { A[j] = A[j] * (Sc[j] + 1.0f);
            if (F.wave == 0) { Al[64 * j + F.lane] = A[j]; Bl[64 * j + F.lane] = Bv[j]; } }
        __syncthreads();
        const int row0 = chunk * 128 + F.wave * 16;
        SEG(1);
#pragma unroll 1
        for (int rr = 0; rr < 16; rr += 4) {
            f32x4 v[4][4]; float ss[4];
#pragma unroll
            for (int u = 0; u < 4; ++u)
#pragma unroll
                for (int j = 0; j < 4; ++j) v[u][j] = ld_row4<true>(x1, (size_t)(row0 + rr + u) * DM + 256 * j + 4 * F.lane);
#pragma unroll
            for (int u = 0; u < 4; ++u) { float s = 0.f;
#pragma unroll
                for (int j = 0; j < 4; ++j) s += (v[u][j].x * v[u][j].x + v[u][j].y * v[u][j].y) + (v[u][j].z * v[u][j].z + v[u][j].w * v[u][j].w);
                ss[u] = s; }
#pragma unroll
            for (int o = 1; o < 32; o <<= 1) { ss[0] += shx(ss[0], o, F.lane); ss[1] += shx(ss[1], o, F.lane); ss[2] += shx(ss[2], o, F.lane); ss[3] += shx(ss[3], o, F.lane); }
            ss[0] = add_other_half(ss[0]); ss[1] = add_other_half(ss[1]); ss[2] = add_other_half(ss[2]); ss[3] = add_other_half(ss[3]);
#pragma unroll
            for (int u = 0; u < 4; ++u) { const float rstd = 1.0f / sqrtf(ss[u] * (1.0f / DM) + EPS);
                if (F.lane == 0) rsl[F.wave * 16 + rr + u] = rstd;
#pragma unroll
                for (int j = 0; j < 4; ++j) { const f32x4 hv = v[u][j] * rstd * A[j] + Bv[j];
                    *(unsigned*)(H8 + (size_t)(row0 + rr + u) * DM + 256 * j + 4 * F.lane) = pg8::pk4_fp8(hv.x, hv.y, hv.z, hv.w); } }
        }
        SEG(2);
        f32x4 acc0 = (f32x4){0.f, 0.f, 0.f, 0.f}, acc1 = (f32x4){0.f, 0.f, 0.f, 0.f};
        { const bf16* xp = x1 + (size_t)(row0 + fr) * DM + 8 * fq; const LAS unsigned char* wp = rwt + fr * RWP + 16 * fq; const float rs = rsl[F.wave * 16 + fr];
          int tq = 32 * fq; asm volatile("" : "+v"(tq));
          const LAS f32x4* Alq = (const LAS f32x4*)((const LAS unsigned char*)Al + tq); const LAS f32x4* Blq = (const LAS f32x4*)((const LAS unsigned char*)Bl + tq);
#pragma unroll
          for (int sb = 0; sb < 32; sb += 16) {
          v4u xall[16];
#pragma unroll
          for (int s = 0; s < 16; ++s) xall[s] = *(const v4u*)(xp + 32 * (sb + s));
          __builtin_amdgcn_sched_barrier(0);
#pragma unroll
          for (int s = sb; s < sb + 16; ++s) { const v4u xb = xall[s - sb];
              const f32x4 a0 = Alq[8 * s], a1v = Alq[8 * s + 1], b0 = Blq[8 * s], b1v = Blq[8 * s + 1];
              const f32x4 h0 = (f32x4){bflo(xb.x), bfhi(xb.x), bflo(xb.y), bfhi(xb.y)} * rs * a0 + b0, h1 = (f32x4){bflo(xb.z), bfhi(xb.z), bflo(xb.w), bfhi(xb.w)} * rs * a1v + b1v;
              v4u hb; hb.x = pk2(h0.x, h0.y); hb.y = pk2(h0.z, h0.w); hb.z = pk2(h1.x, h1.y); hb.w = pk2(h1.z, h1.w);
              const bf16x8 a0w = *(const LAS bf16x8*)(wp + 64 * s), a1w = *(const LAS bf16x8*)(wp + 16 * RWP + 64 * s);
              acc0 = __builtin_amdgcn_mfma_f32_16x16x32_bf16(a0w, __builtin_bit_cast(bf16x8, hb), acc0, 0, 0, 0);
              acc1 = __builtin_amdgcn_mfma_f32_16x16x32_bf16(a1w, __builtin_bit_cast(bf16x8, hb), acc1, 0, 0, 0);
              if ((s & 3) == 3) __builtin_amdgcn_sched_barrier(0); } } }
        SEG(3);
        float cv[8], tv[4], ov[8]; int ti[4], oi[8];
#pragma unroll
        for (int i = 0; i < 4; ++i) { cv[i] = acc0[i] + rbv[i]; cv[4 + i] = acc1[i] + rbv[4 + i]; }
        top4of8(cv, eix, tv, ti);
        {
#pragma unroll
            for (int k = 0; k < 4; ++k) { ov[k] = tv[k]; oi[k] = ti[k]; ov[4 + k] = shx(tv[k], 16, F.lane); oi[4 + k] = shxi(ti[k], 16, F.lane); }
            top4of8(ov, oi, tv, ti);
#pragma unroll
            for (int k = 0; k < 4; ++k) { auto rv = __builtin_amdgcn_permlane32_swap(__float_as_uint(tv[k]), __float_as_uint(tv[k]), false, false); auto ri = __builtin_amdgcn_permlane32_swap((unsigned)ti[k], (unsigned)ti[k], false, false);
                ov[k] = __uint_as_float(rv[0]); oi[k] = (int)ri[0]; ov[4 + k] = __uint_as_float(rv[1]); oi[4 + k] = (int)ri[1]; }
            top4of8(ov, oi, tv, ti); }
        const float e1 = __expf(tv[1] - tv[0]), e2 = __expf(tv[2] - tv[0]), e3 = __expf(tv[3] - tv[0]); const float inv = 1.0f / (1.0f + e1 + e2 + e3);
        { const int row = row0 + fr, k = fq;
          const float w = (k == 0 ? 1.0f : k == 1 ? e1 : k == 2 ? e2 : e3) * inv; const int ex = (k == 0 ? ti[0] : k == 1 ? ti[1] : k == 2 ? ti[2] : ti[3]);
          const int pos = __hip_atomic_fetch_add(cnt + ex, 1, __ATOMIC_RELAXED, __HIP_MEMORY_SCOPE_WORKGROUP);
          topw[row * 4 + k] = w; route[row * 4 + k] = ex + 32 * pos; }
        SEG(4);
        __syncthreads();
        if (F.tid < 32) hist[chunk * 32 + F.tid] = cnt[F.tid];
        __syncthreads();
        SEG(5);
    }
#ifdef P6SEG
    if (F.blk == 0 && F.tid == 0) atomicAdd((unsigned long long*)(F.ws + WS_CTL + 512), sg_acc);
#endif
}

__device__ __forceinline__ void p7_scatter(Frame& F) {
    const int* hist = (const int*)(F.ws + WS_HIST); const int* route = (const int*)(F.ws + WS_ROUTE);
    int* tokslot = (int*)(F.ws + WS_TOKSLOT); int* slottok = (int*)(F.ws + WS_SLOTTOK); int* moetab = (int*)(F.ws + WS_MOETAB);
    LAS int* pre = (LAS int*)F.lds;
    LAS int* base = (LAS int*)(F.lds + 32768);
    for (int i = F.tid; i < 256 * 32; i += 512) pre[i] = hist[i];
    __syncthreads();
    if (F.tid < 32) { int run = 0;
        for (int c = 0; c < 256; ++c) { const int v = pre[c * 32 + F.tid]; pre[c * 32 + F.tid] = run; run += v; }
        base[64 + F.tid] = run; }
    __syncthreads();
    if (F.tid == 0) { int run = 0; for (int ex = 0; ex < NEXP; ++ex) { base[ex] = run; run += (base[64 + ex] + 255) & ~255; } base[NEXP] = run; }
    __syncthreads();
    if (F.blk == 0 && F.tid <= NEXP) moetab[F.tid] = base[F.tid] >> 8;
    for (int chunk = F.blk; chunk < NTOK / 128; chunk += F.G) {
        const int t = chunk * 128 + (F.tid >> 2), k = F.tid & 3; const int rt = route[t * 4 + k]; const int ex = rt & 31, pos = rt >> 5;
        const int slot = base[ex] + pre[chunk * 32 + ex] + pos;
        tokslot[t * 4 + k] = slot; slottok[slot] = t;
    }
    for (int ex = F.blk; ex < NEXP; ex += F.G) { const int lo = base[ex] + base[64 + ex], hi = base[ex + 1]; for (int s = lo + F.tid; s < hi; s += 512) slottok[s] = 0; }
    __syncthreads();
}

struct Args { const float* in[21]; float* out; unsigned char* ws; int ph_lo, ph_hi; };
__device__ __forceinline__ void launder(Frame& F, int wave) {
#if 0
    int t = threadIdx.x; asm volatile("" : "+v"(t)); F.tid = t; F.lane = t & 63; F.wave = __builtin_amdgcn_readfirstlane(t >> 6); (void)wave;
#else
    int t = lane_id(); asm volatile("" : "+v"(t)); F.lane = t & 63; F.wave = wave; F.tid = wave * 64 + F.lane;
#endif
    const __attribute__((address_space(4))) Args* ap = (const __attribute__((address_space(4))) Args*)__builtin_amdgcn_kernarg_segment_ptr(); asm volatile("" : "+s"(ap));
#pragma unroll
    for (int i = 0; i < 21; ++i) F.in[i] = ap->in[i];
    F.out = ap->out; F.ws = ap->ws; }
constexpr int N_PHASES = 1 + 9 * NLAYER + 1;

#define PHASE_FN __device__ __forceinline__
__device__ __forceinline__ void make_frame(Frame& F, LAS unsigned char* lds, int wave) { F.lds = lds; int bk = blockIdx.x, gd = gridDim.x; asm volatile("" : "+s"(bk), "+s"(gd)); F.blk = bk; F.G = gd; launder(F, wave); }
PHASE_FN void ph_prologue(LAS unsigned char* lds, int wave) { Frame F; make_frame(F, lds, wave); p0_prologue(F); }
PHASE_FN void ph_norm1(LAS unsigned char* lds, int wave, int l) { Frame F; make_frame(F, lds, wave);
    if (l == 0) row_phase<false, true, false, false>(F, 0, F.in[I_X], nullptr); else row_phase<true, true, true, true>(F, l, F.ws + WS_XA, F.ws + WS_XB); }
PHASE_FN void ph_proj(LAS unsigned char* lds, int wave, int l) { Frame F; make_frame(F, lds, wave);
    pg8::Gemm g{(const bf16*)(F.ws + WS_H), (const bf16*)(F.ws + WS_WIN + (size_t)l * NPROJ * DM * (P2_FP8 ? 1 : 2)), nullptr, P2_FP8 ? DM / 2 : DM};
    p3_fscan(F);
    pg8::StaticOrder S; S.init(NTOK, NPROJ, F.G, F.blk);
    pg8::EpiProj E{(bf16*)(F.ws + WS_PROJ), NPROJ, (const float*)(F.ws + WS_QKG) + (size_t)l * 256};
    pg8::gemm_phase<pg8::EpiProj, pg8::StaticOrder, false, P2_FP8 != 0>(F.lds, g, S, E, F.wave); }
PHASE_FN void ph_postproj(LAS unsigned char* lds, int wave, int l) { Frame F; make_frame(F, lds, wave); p3_postproj(F, l); }
PHASE_FN void ph_attn(LAS unsigned char* lds, int wave, int l) { Frame F; make_frame(F, lds, wave); p4_attention(F, l); p3_postproj(F, l); }
PHASE_FN void ph_out(LAS unsigned char* lds, int wave, int l) { Frame F; make_frame(F, lds, wave);
    pg8::Gemm g{(const bf16*)(F.ws + WS_YMIX), (const bf16*)(F.ws + WS_WOUT + (size_t)l * DM * DM * (P5_FP8 ? 1 : 2)), nullptr, P5_FP8 ? DM / 2 : DM};
    pg8::StaticOrder S; S.init(NTOK, DM, F.G, F.blk);
    const float* gt = (const float*)(F.ws + WS_MODF) + (size_t)l * NB * 6144 + 2 * DM;
    if (l == 0) { pg8::EpiResGate<false> E{F.in[I_X], (bf16*)(F.ws + WS_XA), gt}; pg8::gemm_phase<pg8::EpiResGate<false>, pg8::StaticOrder, false, P5_FP8 != 0>(F.lds, g, S, E, F.wave); }
    else { pg8::EpiResGate<true> E{F.ws + WS_XB, (bf16*)(F.ws + WS_XA), gt}; pg8::gemm_phase<pg8::EpiResGate<true>, pg8::StaticOrder, false, P5_FP8 != 0>(F.lds, g, S, E, F.wave); } }
PHASE_FN void ph_router(LAS unsigned char* lds, int wave, int l) { Frame F; make_frame(F, lds, wave); p6_norm_router(F, l, (const bf16*)(F.ws + WS_XA)); }
PHASE_FN void ph_scatter(LAS unsigned char* lds, int wave) { Frame F; make_frame(F, lds, wave); p7_scatter(F); }
__device__ __forceinline__ LAS int* moe_table(Frame& F) { LAS int* tb = (LAS int*)(F.lds + MISC_OFF + 64);
    if (F.tid <= NEXP) tb[F.tid] = ((const int*)(F.ws + WS_MOETAB))[F.tid];
    __syncthreads(); return tb; }
PHASE_FN void ph_moe_up(LAS unsigned char* lds, int wave, int l) { Frame F; make_frame(F, lds, wave); LAS int* tb = moe_table(F);
    pg8::Gemm g{(const bf16*)(F.ws + WS_H8), (const bf16*)(F.ws + WS_W1 + (size_t)l * NEXP * 2048 * DM), (const int*)(F.ws + WS_SLOTTOK), DM / 2};
    pg8::MoeOrder S; S.init(tb, 8, F.G, F.blk);
    pg8::EpiSwiglu8 E{F.ws + WS_ACT, F.in[I_B1] + (size_t)l * NEXP * 2048};
    pg8::gemm_phase<pg8::EpiSwiglu8, pg8::MoeOrder, true, true>(F.lds, g, S, E, F.wave); }
struct EpiNull { static constexpr bool PERM = true; static constexpr int NST = 0;
    __device__ __forceinline__ void init(f32x4 (&acc)[2][2][4][2], const pg8::Unit&, int, int, int, int) const {
#pragma unroll
        for (int a = 0; a < 2; ++a)
#pragma unroll
            for (int b = 0; b < 2; ++b)
#pragma unroll
                for (int m = 0; m < 4; ++m)
#pragma unroll
                    for (int n = 0; n < 2; ++n) acc[a][b][m][n] = (f32x4){0.f, 0.f, 0.f, 0.f}; }
    __device__ __forceinline__ void operator()(const f32x4 (&acc)[2][2][4][2], const pg8::Unit& u, int wr, int wc, int fr, int fq) const { float s = 0.f;
#pragma unroll
    for (int a = 0; a < 2; ++a)
#pragma unroll
        for (int b = 0; b < 2; ++b)
#pragma unroll
            for (int m = 0; m < 4; ++m)
#pragma unroll
                for (int n = 0; n < 2; ++n) s += acc[a][b][m][n][0] + acc[a][b][m][n][1] + acc[a][b][m][n][2] + acc[a][b][m][n][3];
    asm volatile("" :: "v"(s)); } };
PHASE_FN void ph_moe_down_nostore(LAS unsigned char* lds, int wave, int l) { Frame F; make_frame(F, lds, wave); LAS int* tb = moe_table(F);
    pg8::Gemm g{(const bf16*)(F.ws + WS_ACT), (const bf16*)(F.ws + WS_W2 + (size_t)l * NEXP * DM * DM), nullptr, DM / 2};
    pg8::MoeOrder S; S.init(tb, 4, F.G, F.blk);
#if EXP_NOSTORE == 2
    pg8::EpiY E{F.ws + WS_PROJ, nullptr};
    pg8::gemm_phase<pg8::EpiY, pg8::MoeOrder, false, true>(F.lds, g, S, E, F.wave); }
#else
    EpiNull E;
    pg8::gemm_phase<EpiNull, pg8::MoeOrder, false, true>(F.lds, g, S, E, F.wave); }
#endif
PHASE_FN void ph_moe_down(LAS unsigned char* lds, int wave, int l) { Frame F; make_frame(F, lds, wave); LAS int* tb = moe_table(F);
    pg8::Gemm g{(const bf16*)(F.ws + WS_ACT), (const bf16*)(F.ws + WS_W2 + (size_t)l * NEXP * DM * DM), nullptr, DM / 2, (void*)(F.ws + WS_CTL + 512)};
    pg8::MoeOrder S; S.init(tb, 4, F.G, F.blk);
    pg8::EpiY E{F.ws + WS_Y, F.in[I_B2] + (size_t)l * NEXP * DM};
    pg8::gemm_phase<pg8::EpiY, pg8::MoeOrder, false, true>(F.lds, g, S, E, F.wave); }
PHASE_FN void ph_final(LAS unsigned char* lds, int wave) { Frame F; make_frame(F, lds, wave); row_phase<true, false, true, false>(F, NLAYER, F.ws + WS_XA, F.out); }

#ifndef REP_MASK
#define REP_MASK 0
#endif
#ifndef MK_SPLIT
#define MK_SPLIT 0
#endif
#if !MK_SPLIT
__global__ void __launch_bounds__(512, 2) fwd_kernel(Args args) {
    extern __shared__ __attribute__((aligned(16))) unsigned char lds_raw[];
    LAS unsigned char* lds = (LAS unsigned char*)lds_raw;
    volatile LAS unsigned* MISC = (volatile LAS unsigned*)(lds + MISC_OFF);
    if (threadIdx.x < 16) MISC[threadIdx.x] = 0u;
    const int wave = __builtin_amdgcn_readfirstlane(threadIdx.x >> 6);
    __syncthreads();
    const XcdBarrier bar = xcd_barrier_post((unsigned*)(args.ws + WS_CTL) + CW_BAR, MISC, wave);
#define IN(k) true
#define SEAM(k) xcd_barrier(bar)
#define REPS(j) for (int rep_ = 0; rep_ < (((REP_MASK >> (j)) & 1) ? 2 : 1); ++rep_)
#ifdef PT_SEL
    unsigned long long pt_acc = 0ull, pt_t0 = 0ull;
#define PT_HIT(j) (PT_SEL >= 100 ? (((PT_SEL - 100) >> (j)) & 1) : ((j) == PT_SEL))
#define PT_BEGIN(j) do { if (PT_HIT(j)) pt_t0 = __builtin_amdgcn_s_memrealtime(); } while (0)
#define PT_END(j) do { if (PT_HIT(j)) { const unsigned long long t1_ = __builtin_amdgcn_s_memrealtime(); pt_acc += t1_ - pt_t0; } } while (0)
#else
#define PT_BEGIN(j) do {} while (0)
#define PT_END(j) do {} while (0)
#endif
    if (IN(0)) { REPS(0) { PT_BEGIN(0); ph_prologue(lds, wave); SEAM(0); PT_END(0); } }
    for (int l = 0; l < NLAYER; ++l) {
        const int p = 1 + 9 * l;
        if (IN(p + 0)) { REPS(1) { PT_BEGIN(1); ph_norm1(lds, wave, l); SEAM(p + 0); PT_END(1); } }
        if (IN(p + 1)) { REPS(2) { PT_BEGIN(2); ph_proj(lds, wave, l); SEAM(p + 1); PT_END(2); } }
        if (IN(p + 3)) { REPS(4) { PT_BEGIN(4); ph_attn(lds, wave, l); SEAM(p + 3); PT_END(4); } }
        if (IN(p + 4)) { REPS(5) { PT_BEGIN(5); ph_out(lds, wave, l); SEAM(p + 4); PT_END(5); } }
        if (IN(p + 5)) { REPS(6) { PT_BEGIN(6); ph_router(lds, wave, l); SEAM(p + 5); PT_END(6); } }
        if (IN(p + 6)) { REPS(7) { PT_BEGIN(7); ph_scatter(lds, wave); SEAM(p + 6); PT_END(7); } }
        if (IN(p + 7)) { REPS(8) { PT_BEGIN(8); ph_moe_up(lds, wave, l); SEAM(p + 7); PT_END(8); } }
        if (IN(p + 8)) { REPS(9) { PT_BEGIN(9); ph_moe_down(lds, wave, l); SEAM(p + 8); PT_END(9); } }
    }
    if (IN(N_PHASES - 1)) { REPS(10) { PT_BEGIN(10); ph_final(lds, wave); PT_END(10); } }
#ifdef PT_SEL
    if (blockIdx.x == 0 && wave == 0 && lane_id() == 0) { const unsigned long long t0_ = __builtin_amdgcn_s_memrealtime(); while (__builtin_amdgcn_s_memrealtime() - t0_ < pt_acc * PT_K) __builtin_amdgcn_s_sleep(8); }
#endif
#if defined(P6SEG) || defined(P3SEG)
    if (blockIdx.x == 0 && wave == 0 && lane_id() == 0) { __builtin_amdgcn_s_waitcnt(0);
        const unsigned long long acc = __hip_atomic_load((unsigned long long*)(args.ws + WS_CTL + 512), __ATOMIC_RELAXED, __HIP_MEMORY_SCOPE_AGENT) * 4ull;
        const unsigned long long t0 = __builtin_readcyclecounter(); while (__builtin_readcyclecounter() - t0 < acc) __builtin_amdgcn_s_sleep(4); }
#endif
#ifdef TPG
    if (blockIdx.x == 3 && wave == 0 && lane_id() == 0) { __builtin_amdgcn_s_waitcnt(0);
        const unsigned long long acc = __hip_atomic_load((unsigned long long*)(args.ws + WS_CTL + 512), __ATOMIC_RELAXED, __HIP_MEMORY_SCOPE_AGENT) * ((TPG == 1) ? 1ull : 100000ull);
        const unsigned long long t0 = __builtin_readcyclecounter(); while (__builtin_readcyclecounter() - t0 < acc) __builtin_amdgcn_s_sleep(4); }
#endif
#ifdef TPROBE
    if (blockIdx.x == TPROBE_BLK && wave == 0 && lane_id() == 0) {
        __builtin_amdgcn_s_waitcnt(0);
        const unsigned long long acc = __hip_atomic_load((unsigned long long*)(args.ws + WS_CTL + 512), __ATOMIC_RELAXED, __HIP_MEMORY_SCOPE_AGENT) * TPROBE_K;
        const unsigned long long t0 = __builtin_readcyclecounter();
        while (__builtin_readcyclecounter() - t0 < acc) __builtin_amdgcn_s_sleep(4);
    }
#endif
#if defined(UBENCH) && UBENCH >= 4
    {
        f32x4 c[16]; v8i a8, b8; bf16x8 a4, b4;
#pragma unroll
        for (int i = 0; i < 16; ++i) c[i] = (f32x4){0.f, 0.f, 0.f, 0.f};
#pragma unroll
        for (int i = 0; i < 8; ++i) { a8[i] = 0x38383838; b8[i] = 0x38383838; a4[i] = 0x3c00; b4[i] = 0x3c00; }
        const int sw = 0x7F7F7F7F;
        for (int it = 0; it < UBENCH_ITERS; ++it) {
#pragma unroll
            for (int i = 0; i < 16; ++i) {
#if UBENCH == 4
                asm volatile("v_mfma_scale_f32_16x16x128_f8f6f4 %0, %1, %2, %0, %3, %4 op_sel_hi:[0,0,0]" : "+v"(c[i]) : "v"(a8), "v"(b8), "v"(sw), "v"(sw));
#else
                c[i] = __builtin_amdgcn_mfma_f32_16x16x32_bf16(a4, b4, c[i], 0, 0, 0);
#endif
            }
        }
        float s = 0.f;
#pragma unroll
        for (int i = 0; i < 16; ++i) s += c[i][0];
        if (s == 123.456f) ((float*)(args.ws + WS_GSUM + 14000))[0] = s;
    }
#elif defined(UBENCH)
    {
        float v[32];
#pragma unroll
        for (int i = 0; i < 32; ++i) v[i] = (float)(lane_id() + i) * 1e-3f;
        for (int it = 0; it < UBENCH_ITERS; ++it) {
#pragma unroll
            for (int i = 0; i < 32; ++i) {
#if UBENCH == 1
                v[i] = __builtin_amdgcn_exp2f(v[i]);
#elif UBENCH == 2
                v[i] = v[i] * 1.0001f + 0.5f;
#elif UBENCH == 3
                v[i] = __builtin_amdgcn_logf(v[i]);
#endif
            }
            asm volatile("" ::: "memory");
        }
        float s = 0.f;
#pragma unroll
        for (int i = 0; i < 32; ++i) s += v[i];
        if (s == 123.456f) ((float*)(args.ws + WS_GSUM + 14000))[0] = s;
    }
#endif
#undef IN
#undef SEAM
#undef REPS
}

#endif
template <int KIND> __global__ void __launch_bounds__(512, 2) phase_kernel(Args args, int l) {
    extern __shared__ __attribute__((aligned(16))) unsigned char lds_raw[];
    LAS unsigned char* lds = (LAS unsigned char*)lds_raw; const int wave = __builtin_amdgcn_readfirstlane(threadIdx.x >> 6);
    if (KIND == 0) ph_prologue(lds, wave); if (KIND == 1) ph_norm1(lds, wave, l); if (KIND == 2) ph_proj(lds, wave, l); if (KIND == 3) ph_postproj(lds, wave, l); if (KIND == 4) ph_attn(lds, wave, l);
    if (KIND == 5) ph_out(lds, wave, l); if (KIND == 6) ph_router(lds, wave, l); if (KIND == 7) ph_scatter(lds, wave); if (KIND == 8) ph_moe_up(lds, wave, l); if (KIND == 9) ph_moe_down(lds, wave, l); if (KIND == 10) ph_final(lds, wave);
#ifdef EXP_NOSTORE
    if (KIND == 11) ph_moe_down_nostore(lds, wave, l);
#endif
}
template <int KIND> static void launch_phase(const Args& a, int l, int grid, hipStream_t stream) {
    static bool attr = false;
    if (!attr) { (void)hipFuncSetAttribute((const void*)phase_kernel<KIND>, hipFuncAttributeMaxDynamicSharedMemorySize, LDS_BYTES); attr = true; }
    for (int rep = 0; rep < (((REP_MASK >> KIND) & 1) ? 2 : 1); ++rep) hipLaunchKernelGGL(phase_kernel<KIND>, dim3(grid), dim3(512), LDS_BYTES, stream, a, l);
}

extern "C" void kernel_launch(void* const* d_in, const int* in_sizes, int n_in, void* d_out, int out_size, void* d_ws, size_t ws_size, hipStream_t stream) {
    static int grid = 0;
    if (grid == 0) {
        if (n_in != 21 || in_sizes[0] != NTOK * DM || out_size != NTOK * DM || ws_size < WS_END) {
            fprintf(stderr, "kernel_launch: unexpected shapes: n_in %d in0 %d out %d ws %zu (need %zu)\n", n_in, n_in > 0 ? in_sizes[0] : -1, out_size, ws_size, (size_t)WS_END); grid = -1; return; }
        int dev = 0, cus = 0, per_cu = 0;
        if (hipGetDevice(&dev) != hipSuccess || hipDeviceGetAttribute(&cus, hipDeviceAttributeMultiprocessorCount, dev) != hipSuccess) { fprintf(stderr, "kernel_launch: device query failed\n"); grid = -1; return; }
#if !MK_SPLIT
        if (hipFuncSetAttribute((const void*)fwd_kernel, hipFuncAttributeMaxDynamicSharedMemorySize, LDS_BYTES) != hipSuccess) { fprintf(stderr, "kernel_launch: hipFuncSetAttribute failed\n"); grid = -1; return; }
        if (hipOccupancyMaxActiveBlocksPerMultiprocessor(&per_cu, (const void*)fwd_kernel, 512, LDS_BYTES) != hipSuccess || per_cu < 1) fprintf(stderr, "kernel_launch: note: occupancy query says %d\n", per_cu);
        (void)hipGetLastError();
#endif
        grid = cus;
    }
    if (grid < 0) return;
    (void)hipMemsetAsync((char*)d_ws + WS_CTL, 0, CTL_ZERO_BYTES, stream);
    Args a{};
    for (int i = 0; i < 21; ++i) a.in[i] = (const float*)d_in[i];
    a.out = (float*)d_out; a.ws = (unsigned char*)d_ws;
#if MK_SPLIT
    a.ph_lo = 0; a.ph_hi = 0;
    launch_phase<0>(a, 0, grid, stream);
    for (int l = 0; l < NLAYER; ++l) { launch_phase<1>(a, l, grid, stream); launch_phase<2>(a, l, grid, stream); launch_phase<3>(a, l, grid, stream); launch_phase<4>(a, l, grid, stream); launch_phase<5>(a, l, grid, stream);
        launch_phase<6>(a, l, grid, stream); launch_phase<7>(a, l, grid, stream); launch_phase<8>(a, l, grid, stream);
#ifdef EXP_NOSTORE
        launch_phase<11>(a, l, grid, stream);
#endif
        launch_phase<9>(a, l, grid, stream); }
    launch_phase<10>(a, 0, grid, stream);
#else
    a.ph_lo = 0; a.ph_hi = N_PHASES; hipLaunchKernelGGL(fwd_kernel, dim3(grid), dim3(512), LDS_BYTES, stream, a);
#endif
}
```
